# Optimizing an MI355X kernel written in HIP

```python
import math
import jax, jax.numpy as jnp
from jax import lax
import numpy as np

D_MODEL = 2048
BATCH = 4
SEQ = 2048
DEPTH = 1
DEC_BATCH = 128
DEC_SEQ = 1
PAST_LEN = 16384
PAGE_SIZE = 128

D_S5 = D_MODEL // 2
S5_GROUP = 16
G_S5 = D_S5 // S5_GROUP
P_S5 = 64
D_RW = D_MODEL // 2
RW_HEAD = 64
H_RW = D_RW // RW_HEAD
LORA_W = 64
LORA_A = 64

RMS_EPS = 1e-6
GN_EPS = 64e-5

OFF_S5_U = 0
OFF_S5_Z = D_S5
OFF_RW = 2 * D_S5
N_SHIFT = 3 * D_RW + LORA_W + LORA_A
OFF_RW_Z = OFF_RW + N_SHIFT
OFF_GATE_S5 = OFF_RW_Z + D_RW
OFF_GATE_RW = OFF_GATE_S5 + D_MODEL
N_IN = OFF_GATE_RW + D_MODEL

kernel_name = "hybrid_s5_rwkv7_adaln_step"


def rmsnorm(x, g):
    xf = x.astype(jnp.float32)
    y = xf * lax.rsqrt(jnp.mean(xf * xf, axis=-1, keepdims=True) + RMS_EPS)
    return (y * g.astype(jnp.float32)).astype(x.dtype)


def s5_branch(u, z, x0_re, x0_im, A_re, A_im, log_step, B_re, B_im, C_re, C_im, D_skip, w_glu, b_glu):
    bsz, T, _ = u.shape
    f32 = jnp.float32
    ug = u.astype(f32).reshape(bsz, T, G_S5, S5_GROUP)
    step = jnp.exp(log_step.astype(f32))[:, None]
    lam_re = jnp.minimum(A_re.astype(f32), -1e-4)
    lam_im = A_im.astype(f32)
    mag = jnp.exp(lam_re * step)
    ab_re = mag * jnp.cos(lam_im * step)
    ab_im = mag * jnp.sin(lam_im * step)
    den = lam_re * lam_re + lam_im * lam_im
    f_re = ((ab_re - 1.0) * lam_re + ab_im * lam_im) / den
    f_im = (ab_im * lam_re - (ab_re - 1.0) * lam_im) / den
    Br, Bi = B_re.astype(f32), B_im.astype(f32)
    bb_re = f_re[:, :, None] * Br - f_im[:, :, None] * Bi
    bb_im = f_re[:, :, None] * Bi + f_im[:, :, None] * Br
    bu_re = jnp.einsum('btgc,gpc->btgp', ug, bb_re)
    bu_im = jnp.einsum('btgc,gpc->btgp', ug, bb_im)
    a_re = jnp.broadcast_to(ab_re, bu_re.shape)
    a_im = jnp.broadcast_to(ab_im, bu_im.shape)

    def combine(e1, e2):
        a1r, a1i, b1r, b1i = e1
        a2r, a2i, b2r, b2i = e2
        return (a2r * a1r - a2i * a1i,
                a2r * a1i + a2i * a1r,
                a2r * b1r - a2i * b1i + b2r,
                a2r * b1i + a2i * b1r + b2i)

    pr, pi, sr, si = lax.associative_scan(combine, (a_re, a_im, bu_re, bu_im), axis=1)
    x0r = x0_re.astype(f32)[:, None]
    x0i = x0_im.astype(f32)[:, None]
    xr = sr + pr * x0r - pi * x0i
    xi = si + pr * x0i + pi * x0r
    y = (jnp.einsum('btgp,gcp->btgc', xr, C_re.astype(f32))
         - jnp.einsum('btgp,gcp->btgc', xi, C_im.astype(f32))
         + D_skip.astype(f32) * ug)
    y = jax.nn.gelu(y.reshape(bsz, T, D_S5)).astype(u.dtype)
    y = y * jax.nn.sigmoid(y @ w_glu + b_glu)
    out = y * jax.nn.silu(z)
    return out, xr[:, -1].astype(x0_re.dtype), xi[:, -1].astype(x0_im.dtype)


def rwkv_branch(cur, prev, z, S0, mu_rw, w0, w2, a0, a2, k_k, k_a, r_k, gn_w, gn_b):
    bsz, T, _ = cur.shape
    f32 = jnp.float32
    xs = cur + (prev - cur) * mu_rw
    r = xs[..., :D_RW]
    k = xs[..., D_RW:2 * D_RW]
    v = xs[..., 2 * D_RW:3 * D_RW]
    wd = xs[..., 3 * D_RW:3 * D_RW + LORA_W]
    ad = xs[..., 3 * D_RW + LORA_W:]
    w = -jax.nn.softplus(-(w0 + jnp.tanh(wd) @ w2)) - 0.5
    decay = jnp.exp(-jnp.exp(w.astype(f32)))
    a = jax.nn.sigmoid((a0 + ad @ a2).astype(f32))
    hs = lambda t: t.astype(f32).reshape(bsz, T, H_RW, RW_HEAD)
    r, k, v, decay, a = hs(r), hs(k), hs(v), hs(decay), hs(a)
    kk = k * k_k.astype(f32).reshape(H_RW, RW_HEAD)
    kk = kk / jnp.maximum(jnp.sqrt(jnp.sum(kk * kk, axis=-1, keepdims=True)), 1e-12)
    k = k * (1.0 + (a - 1.0) * k_a.astype(f32).reshape(H_RW, RW_HEAD))
    b = kk * a

    def step(S, inp):
        r_t, d_t, k_t, v_t, kk_t, b_t = inp
        sa = jnp.einsum('bhij,bhj->bhi', S, -kk_t)
        S = S * d_t[:, :, None, :] + sa[..., None] * b_t[:, :, None, :] + v_t[..., None] * k_t[:, :, None, :]
        o = jnp.einsum('bhij,bhj->bhi', S, r_t)
        return S, o

    tm = lambda t: jnp.moveaxis(t, 1, 0)
    S_fin, o = lax.scan(step, S0.astype(f32), (tm(r), tm(decay), tm(k), tm(v), tm(kk), tm(b)))
    o = jnp.moveaxis(o, 0, 1)
    mu = jnp.mean(o, axis=-1, keepdims=True)
    var = jnp.mean((o - mu) ** 2, axis=-1, keepdims=True)
    o = (o - mu) * lax.rsqrt(var + GN_EPS)
    o = o * gn_w.astype(f32).reshape(H_RW, RW_HEAD) + gn_b.astype(f32).reshape(H_RW, RW_HEAD)
    o = o + jnp.sum(r * k * r_k.astype(f32), axis=-1, keepdims=True) * v
    o = o.reshape(bsz, T, D_RW).astype(z.dtype)
    out = o * jax.nn.silu(z)
    return out, S_fin.astype(S0.dtype)


def hybrid_layer(x, c, shift_prev, s5_re0, s5_im0, wkv0,
                 norm_g, w_ada, b_ada, w_in, mu_rw,
                 A_re, A_im, log_step, B_re, B_im, C_re, C_im, D_skip, w_glu, b_glu,
                 w0, w2, a0, a2, k_k, k_a, r_k, gn_w, gn_b, w_out):
    mod = jax.nn.silu(c) @ w_ada + b_ada
    sh = mod[:, None, :D_MODEL]
    sc = mod[:, None, D_MODEL:2 * D_MODEL]
    gt = mod[:, None, 2 * D_MODEL:]
    h = rmsnorm(x, norm_g) * (1.0 + sc) + sh
    h_all = jnp.concatenate([shift_prev[:, None].astype(h.dtype), h], axis=1)
    p_all = h_all @ w_in
    p = p_all[:, 1:]
    p_prev = p_all[:, :-1, OFF_RW:OFF_RW_Z]
    o_s, s5_re, s5_im = s5_branch(p[..., OFF_S5_U:OFF_S5_Z], p[..., OFF_S5_Z:OFF_RW], s5_re0, s5_im0,
                                  A_re, A_im, log_step, B_re, B_im, C_re, C_im, D_skip, w_glu, b_glu)
    o_r, wkv = rwkv_branch(p[..., OFF_RW:OFF_RW_Z], p_prev, p[..., OFF_RW_Z:OFF_GATE_S5], wkv0,
                           mu_rw, w0, w2, a0, a2, k_k, k_a, r_k, gn_w, gn_b)
    mixed = (jax.nn.sigmoid(p[..., OFF_GATE_S5:OFF_GATE_RW]) * (o_s @ w_out[:D_S5])
             + jax.nn.sigmoid(p[..., OFF_GATE_RW:]) * (o_r @ w_out[D_S5:]))
    x = x + gt * mixed
    return x, h[:, -1], s5_re, s5_im, wkv


def setup_inputs(seed: int = 0) -> dict:
    key = jax.random.key(seed)
    ks = jax.random.split(key, 40)
    f32 = jnp.float32
    nrm = lambda k, s, sc: jax.random.normal(k, s, f32) * sc
    L = DEPTH
    inp = {}
    inp["x_prompt"] = nrm(ks[0], (BATCH, SEQ, D_MODEL), 1.0)
    inp["x_sample"] = nrm(ks[1], (DEC_BATCH, DEC_SEQ, D_MODEL), 1.0)
    inp["c_prompt"] = nrm(ks[2], (BATCH, D_MODEL), 1.0)
    inp["c_sample"] = nrm(ks[3], (DEC_BATCH, D_MODEL), 1.0)
    inp["state_s5_re"] = nrm(ks[4], (L, DEC_BATCH, G_S5, P_S5), 0.1)
    inp["state_s5_im"] = nrm(ks[5], (L, DEC_BATCH, G_S5, P_S5), 0.1)
    inp["state_wkv"] = nrm(ks[6], (L, DEC_BATCH, H_RW, RW_HEAD, RW_HEAD), 0.1)
    inp["state_shift"] = nrm(ks[7], (L, DEC_BATCH, D_MODEL), 1.0)
    inp["norm_g"] = 1.0 + nrm(ks[8], (L, D_MODEL), 0.01)
    inp["w_ada"] = nrm(ks[9], (L, D_MODEL, 3 * D_MODEL), 0.5 * D_MODEL ** -0.5)
    inp["b_ada"] = nrm(ks[10], (L, 3 * D_MODEL), 0.01)
    inp["w_in"] = nrm(ks[11], (L, D_MODEL, N_IN), D_MODEL ** -0.5)
    inp["mu_rw"] = jax.random.uniform(ks[12], (L, N_SHIFT), f32)
    inp["A_re"] = -0.5 + nrm(ks[13], (L, G_S5, P_S5), 0.01)
    inp["A_im"] = jnp.pi * jnp.arange(P_S5, dtype=f32) + nrm(ks[14], (L, G_S5, P_S5), 0.01)
    inp["log_step"] = jax.random.uniform(ks[15], (L, G_S5), f32, math.log(1e-3), math.log(1e-1))
    inp["B_re"] = nrm(ks[16], (L, G_S5, P_S5, S5_GROUP), (2.0 * S5_GROUP) ** -0.5)
    inp["B_im"] = nrm(ks[17], (L, G_S5, P_S5, S5_GROUP), (2.0 * S5_GROUP) ** -0.5)
    inp["C_re"] = nrm(ks[18], (L, G_S5, S5_GROUP, P_S5), (2.0 * P_S5) ** -0.5)
    inp["C_im"] = nrm(ks[19], (L, G_S5, S5_GROUP, P_S5), (2.0 * P_S5) ** -0.5)
    inp["D_skip"] = nrm(ks[20], (L, G_S5, S5_GROUP), 1.0)
    inp["w_glu"] = nrm(ks[21], (L, D_S5, D_S5), D_S5 ** -0.5)
    inp["b_glu"] = nrm(ks[22], (L, D_S5), 0.01)
    inp["w0"] = jax.random.uniform(ks[23], (L, D_RW), f32, -6.0, -1.0)
    inp["w2"] = nrm(ks[24], (L, LORA_W, D_RW), 0.5 * LORA_W ** -0.5)
    inp["a0"] = nrm(ks[25], (L, D_RW), 0.1)
    inp["a2"] = nrm(ks[26], (L, LORA_A, D_RW), 0.5 * LORA_A ** -0.5)
    inp["k_k"] = 0.85 + nrm(ks[27], (L, D_RW), 0.02)
    inp["k_a"] = 1.0 + nrm(ks[28], (L, D_RW), 0.02)
    inp["r_k"] = nrm(ks[29], (L, H_RW, RW_HEAD), 0.1)
    inp["gn_w"] = 1.0 + nrm(ks[30], (L, D_RW), 0.01)
    inp["gn_b"] = nrm(ks[31], (L, D_RW), 0.01)
    inp["w_out"] = nrm(ks[32], (L, D_S5 + D_RW, D_MODEL), (D_S5 + D_RW) ** -0.5)
    inp["final_g"] = 1.0 + nrm(ks[33], (D_MODEL,), 0.01)
    return inp


def reference(x_prompt, x_sample, c_prompt, c_sample, state_s5_re, state_s5_im, state_wkv, state_shift,
              norm_g, w_ada, b_ada, w_in, mu_rw, A_re, A_im, log_step, B_re, B_im, C_re, C_im, D_skip,
              w_glu, b_glu, w0, w2, a0, a2, k_k, k_a, r_k, gn_w, gn_b, w_out, final_g):
    xp, xs = x_prompt, x_sample
    p_re, p_im, p_wkv, p_shift = [], [], [], []
    s_re, s_im, s_wkv, s_shift = [], [], [], []
    dt = x_prompt.dtype
    for l in range(DEPTH):
        params = (norm_g[l], w_ada[l], b_ada[l], w_in[l], mu_rw[l],
                  A_re[l], A_im[l], log_step[l], B_re[l], B_im[l], C_re[l], C_im[l], D_skip[l], w_glu[l], b_glu[l],
                  w0[l], w2[l], a0[l], a2[l], k_k[l], k_a[l], r_k[l], gn_w[l], gn_b[l], w_out[l])
        xp, sh_p, re_p, im_p, wkv_p = hybrid_layer(
            xp, c_prompt,
            jnp.zeros((xp.shape[0], D_MODEL), dt),
            jnp.zeros((xp.shape[0], G_S5, P_S5), dt),
            jnp.zeros((xp.shape[0], G_S5, P_S5), dt),
            jnp.zeros((xp.shape[0], H_RW, RW_HEAD, RW_HEAD), dt),
            *params)
        xs, sh_s, re_s, im_s, wkv_s = hybrid_layer(
            xs, c_sample, state_shift[l], state_s5_re[l], state_s5_im[l], state_wkv[l], *params)
        p_re.append(re_p); p_im.append(im_p); p_wkv.append(wkv_p); p_shift.append(sh_p)
        s_re.append(re_s); s_im.append(im_s); s_wkv.append(wkv_s); s_shift.append(sh_s)
    y_prompt = rmsnorm(xp, final_g)
    y_sample = rmsnorm(xs, final_g)
    return (y_prompt, y_sample,
            jnp.stack(p_re), jnp.stack(p_im), jnp.stack(p_wkv), jnp.stack(p_shift),
            jnp.stack(s_re), jnp.stack(s_im), jnp.stack(s_wkv), jnp.stack(s_shift))
```

```cpp
#include <hip/hip_runtime.h>
#include <cstdio>
#include <cstdint>

#ifndef MK_N_LAUNCHES
#define MK_N_LAUNCHES 1
#endif
constexpr int N_PHASES = 7;

#define GAS __attribute__((address_space(1)))
#define LAS __attribute__((address_space(3)))
typedef unsigned short bf16_t;
typedef short bf16x8 __attribute__((ext_vector_type(8)));
typedef float f32x2 __attribute__((ext_vector_type(2)));
typedef float f32x4 __attribute__((ext_vector_type(4)));
typedef float f32x16 __attribute__((ext_vector_type(16)));
typedef unsigned u32x2 __attribute__((ext_vector_type(2)));
typedef unsigned u32x4 __attribute__((ext_vector_type(4)));
typedef GAS unsigned gu32;

constexpr int DM = 2048, SEQ = 2048, NB = 4, NSMP = 128;
constexpr int MP = NB * SEQ;
constexpr int MV = MP + NSMP;
constexpr int MT = MV + NSMP;
constexpr int NIN = 10368, LDP = 10496;
constexpr int NMOD = 6144, NMODROWS = NB + NSMP;
constexpr float RMS_EPS = 1e-6f, GN_EPS = 64e-5f;
constexpr int PC_U = 0, PC_ZS = 1024, PC_R = 2048, PC_K = 3072, PC_V = 4096, PC_ZR = 5120, PC_GS = 6144, PC_GR = 8192, PC_WD = 10240, PC_AD = 10304;

constexpr size_t WS_CTL = 0, CTL_BYTES = 65536;
constexpr size_t WS_MOD = 65536;
constexpr size_t WS_WT = 3342336;
constexpr size_t WS_YG = WS_WT;
constexpr size_t WS_WOUT_T = WS_YG + (size_t)MT * 1024 * 2;
constexpr size_t WS_WGLU_T = WS_WOUT_T + (size_t)2048 * 2048 * 2;
constexpr size_t WS_ROWSS = WS_WGLU_T + (size_t)1024 * 1024 * 2;
constexpr size_t WS_XN = WS_WT + (size_t)LDP * 2048 * 2;
constexpr size_t WS_P = WS_XN + (size_t)MT * 2048 * 2;
constexpr size_t WS_END = WS_P + (size_t)MT * LDP * 2;
static_assert(WS_END <= 268435456, "ws map");
static_assert(WS_ROWSS + (size_t)MT * 32 * 4 <= WS_XN, "ws map 2");
constexpr size_t DO_ORAW = 0, DO_BV = (size_t)MP * 1024 * 2, DO_S5TAB = 2 * DO_BV;
constexpr int S5T_ME = 0, S5T_KT = 65536, S5T_CA = 81920, S5T_C0 = 147456, S5T_DF = 155648, S5T_HDR = 156672, S5T_BYTES = 157696;
static_assert(DO_S5TAB + (size_t)64 * S5T_BYTES <= (size_t)MV * DM * 4, "d_out scratch");
constexpr size_t OUT_Y = 0, OUT_S5RE_P = 17039360, OUT_S5IM_P = 17055744, OUT_WKV_P = 17072128, OUT_SHIFT_P = 17334272,
                 OUT_S5RE_S = 17342464, OUT_S5IM_S = 17866752, OUT_WKV_S = 18391040, OUT_SHIFT_S = 26779648;
constexpr int RING_BYTES = 131072, LDSCTL_OFF = RING_BYTES, MISC_OFF = LDSCTL_OFF + 320, LDS_BYTES = 147456;
constexpr int CW_BAR = 1024;

#define LDS_WAIT() asm volatile("s_waitcnt lgkmcnt(0)" ::: "memory")
#define VM_WAIT() asm volatile("s_waitcnt vmcnt(0)" ::: "memory")
__device__ __forceinline__ unsigned cvt_pk_bf16(float lo, float hi) { unsigned r; asm volatile("v_cvt_pk_bf16_f32 %0, %1, %2" : "=v"(r) : "v"(lo), "v"(hi)); return r; }
__device__ __forceinline__ float bf_lo(unsigned w) { return __uint_as_float(w << 16); }
__device__ __forceinline__ float bf_hi(unsigned w) { return __uint_as_float(w & 0xffff0000u); }
__device__ __forceinline__ float bf2f(bf16_t b) { return __uint_as_float(((unsigned)b) << 16); }
__device__ __forceinline__ bf16_t f2bf(float f) { return (bf16_t)(cvt_pk_bf16(f, 0.f) & 0xffffu); }
__device__ __forceinline__ float sigmoidf_(float x) { return 1.0f / (1.0f + __expf(-x)); }
__device__ __forceinline__ float siluf_(float x) { return x / (1.0f + __expf(-x)); }
__device__ __forceinline__ float tanhf_(float x) { const float e = __expf(2.0f * x); return 1.0f - 2.0f / (e + 1.0f); }
__device__ __forceinline__ float geluf_(float y) { const float z = 0.7978845608028654f * (y + 0.044715f * y * y * y); return 0.5f * y * (1.0f + tanhf_(z)); }
__device__ __forceinline__ float wave_sum(float v) {
#pragma unroll
    for (int o = 1; o < 64; o <<= 1) v += __shfl_xor(v, o);
    return v;
}
template <int CTRL> __device__ __forceinline__ float dpp_f(float x) { return __builtin_bit_cast(float, __builtin_amdgcn_mov_dpp(__builtin_bit_cast(int, x), CTRL, 0xf, 0xf, true)); }
__device__ __forceinline__ float row16_sum(float v) {
    v += dpp_f<0xB1>(v);
    v += dpp_f<0x4E>(v);
    v += dpp_f<0x141>(v);
    v += dpp_f<0x140>(v);
    return v;
}

#define XB_TMO      128
#define XB_XCNT(j)  (256  + 64 * (j))
#define XB_XSUB(j)  (1280 + 64 * (j))
#define XB_XGEN(j)  (2304 + 64 * (j))
#define XB_TOP      3328
#define XB_TOPGEN   3392
#define XCD_BAR_WORDS 3456
#define XB_SPIN_CAP (1u << 20)
__device__ __forceinline__ unsigned xb_ld(unsigned* p)              { return __hip_atomic_load(p, __ATOMIC_RELAXED, __HIP_MEMORY_SCOPE_AGENT); }
__device__ __forceinline__ unsigned xb_add(unsigned* p, unsigned v) { return __hip_atomic_fetch_add(p, v, __ATOMIC_RELAXED, __HIP_MEMORY_SCOPE_AGENT); }
__device__ __forceinline__ unsigned xb_xcc_id() { return (unsigned)__builtin_amdgcn_s_getreg((3 << 11) | 20) & 0xFu; }
#define XB_SPIN(cond, bar) do { unsigned _sp = 0; while (cond) { __builtin_amdgcn_s_sleep(1); \
    if ((++_sp & 255u) == 0u) { if (xb_ld(&(bar)[XB_TMO])) break; if (_sp > XB_SPIN_CAP) { atomicAdd(&(bar)[XB_TMO], 1u); break; } } } } while (0)
struct XcdBarrier { unsigned* bar; unsigned x; volatile LAS unsigned* st; };
__device__ __forceinline__ XcdBarrier xcd_barrier_post(unsigned* bar, volatile LAS unsigned* st) {
    XcdBarrier b; b.bar = bar; b.x = xb_xcc_id(); b.st = st;
    if (threadIdx.x == 0) (void)xb_add(&bar[XB_XCNT(b.x)], 1u);
    return b;
}
__device__ __forceinline__ void xcd_barrier_complete(unsigned* bar, unsigned x, unsigned& nloc, unsigned& nx) {
    const unsigned G = gridDim.x * gridDim.y * gridDim.z;
    unsigned sum, cnt, mine, sp = 0u;
    for (;;) {
        sum = 0u; cnt = 0u; mine = 0u;
#pragma unroll
        for (unsigned j = 0; j < 16; ++j) { const unsigned c = xb_ld(&bar[XB_XCNT(j)]); sum += c; cnt += (c > 0u) ? 1u : 0u; mine = (j == x) ? c : mine; }
        if (sum == G) break;
        __builtin_amdgcn_s_sleep(1);
        if ((++sp & 255u) == 0u) { if (xb_ld(&bar[XB_TMO])) break; if (sp > XB_SPIN_CAP) { atomicAdd(&bar[XB_TMO], 1u); break; } }
    }
    nloc = mine > 0u ? mine : 1u; nx = cnt > 0u ? cnt : 1u;
}
__device__ __forceinline__ void xcd_barrier(const XcdBarrier& b) {
    asm volatile("s_waitcnt vmcnt(0)" ::: "memory");
    __syncthreads();
    if (threadIdx.x == 0) {
        unsigned* bar = b.bar;
        __builtin_amdgcn_s_waitcnt(0);
        unsigned nloc = b.st[0], nx = b.st[1];
        if (nloc == 0u) { xcd_barrier_complete(bar, b.x, nloc, nx); b.st[0] = nloc; b.st[1] = nx; }
        const unsigned old = xb_add(&bar[XB_XSUB(b.x)], 1u);
        const unsigned gen = old / nloc;
        if (old + 1u == (gen + 1u) * nloc) {
            __builtin_amdgcn_fence(__ATOMIC_RELEASE, "agent");
            asm volatile("s_waitcnt vmcnt(0)" ::: "memory");
            const unsigned og = xb_add(&bar[XB_TOP], 1u);
            const unsigned tg = og / nx;
            if (og + 1u == (tg + 1u) * nx) xb_add(&bar[XB_TOPGEN], 1u);
            else XB_SPIN(xb_ld(&bar[XB_TOPGEN]) == tg, bar);
            __builtin_amdgcn_fence(__ATOMIC_ACQUIRE, "agent");
            xb_add(&bar[XB_XGEN(b.x)], 1u);
            asm volatile("s_waitcnt vmcnt(0)" ::: "memory");
        } else {
            XB_SPIN(xb_ld(&bar[XB_XGEN(b.x)]) == gen, bar);
            __builtin_amdgcn_fence(__ATOMIC_ACQUIRE, "agent");
            asm volatile("s_waitcnt vmcnt(0)" ::: "memory");
        }
    }
    __syncthreads();
}

namespace pg8 {
constexpr int BM = 256, BK = 64, HALF = 128, HTB = HALF * BK * 2, STAGE_BYTES = 8 * HTB, NXCD = 8, WGM = 8;
__host__ __device__ __forceinline__ int lds_byte(int r, int c) { const int st = (r >> 4) * 2 + (c >> 5), rr = r & 15, cc = c & 31, ob = rr * 64 + cc * 2; return st * 1024 + (ob ^ (((ob >> 9) & 1) << 5)); }
__host__ __device__ __forceinline__ void stage_rc(int b, int& R, int& C) { const int st = b / 1024, sb = b % 1024, swz = sb ^ (((sb >> 9) & 1) << 5); R = (st >> 1) * 16 + swz / 64; C = (st & 1) * 32 + (swz % 64) / 2; }
__host__ __device__ __forceinline__ int perm32(int rho) { const int n = rho >> 4, i = rho & 15; return 8 * (i >> 2) + 4 * n + (i & 3); }
struct Unit { int pm, pn, koff; };
struct Gemm { const bf16_t* A; const bf16_t* Bt; int ld, K; };
struct StaticOrder {
    int nM, nN, nwg, G, c;
    __device__ void init(int M, int N, int G_, int c_) { nM = M / BM; nN = N / BM; nwg = nM * nN; G = G_; c = c_; }
    __device__ __forceinline__ void tile(int L, Unit& u) const {
        int wgid = L; { const int q = nwg / NXCD, r = nwg % NXCD, xcd = wgid % NXCD, off = wgid / NXCD; wgid = (xcd < r ? xcd * (q + 1) : r * (q + 1) + (xcd - r) * q) + off; }
        const int nig = WGM * nN, gid = wgid / nig, fm = gid * WGM, gsz = (nM - fm) < WGM ? (nM - fm) : WGM;
        u.pm = fm + ((wgid % nig) % gsz); u.pn = (wgid % nig) / gsz; u.koff = 0;
    }
    __device__ __forceinline__ bool next(int i, Unit& u) const { const long L = (long)i * G + c; if (L >= nwg) return false; tile((int)L, u); return true; }
};
struct TwoHalfOrder : StaticOrder {
    __device__ __forceinline__ bool next(int i, Unit& u) const { const long L = (long)(i >> 1) * G + c; if (L >= nwg) return false; tile((int)L, u); u.koff = (i & 1) * 1024; return true; }
};

template <class Epi, class Sched>
__device__ __forceinline__ void gemm_phase(LAS unsigned char* lds, const Gemm g, const Sched& S, const Epi& E) {
    const int tid = threadIdx.x, wid = __builtin_amdgcn_readfirstlane(tid >> 6), lane = tid & 63, wr = wid >> 2, wc = wid & 3, fr = lane & 15, fq = lane >> 4;
    const int K = g.K, nt = K / BK, ld = g.ld;
    unsigned voffA[2], voffB[2];
#pragma unroll
    for (int i = 0; i < 2; ++i) { int R, C; stage_rc(tid * 16 + i * 8192, R, C); const int Rb = Epi::PERM ? ((R & ~31) + perm32(R & 31)) : R;
        voffA[i] = (unsigned)(R * ld + C) * 2u; voffB[i] = (unsigned)(Rb * ld + C) * 2u; }
    const size_t kstep = (size_t)(BK * 2);
    const size_t hstep = (size_t)HALF * ld * 2;
    const size_t tstep = 2 * hstep;
    const unsigned ldsw = (unsigned)wid * 1024u;
    const int aoff = lds_byte(wr * 64 + fr, fq * 8), boff = lds_byte(wc * 32 + fr, fq * 8);
#define PG8_SA(b, h) (((b) * 2 + (h)) * HTB)
#define PG8_SB(b, h) ((4 + (b) * 2 + (h)) * HTB)
#define PG8_STAGE(bufoff, gbase, voff) do { _Pragma("unroll") for (int _i = 0; _i < 2; ++_i) \
        __builtin_amdgcn_global_load_lds((const unsigned*)((const char*)(gbase) + (voff)[_i]), (LAS unsigned*)(lds + (bufoff) + ldsw + _i * 8192), 16, 0, 0); } while (0)
#define PG8_LDA(dst, b, h) do { _Pragma("unroll") for (int m = 0; m < 4; ++m) _Pragma("unroll") for (int k = 0; k < 2; ++k) dst[m][k] = *(const LAS bf16x8*)(lds + PG8_SA(b, h) + aoff + m * 2048 + k * 1024); } while (0)
#define PG8_LDB(dst, b, h) do { _Pragma("unroll") for (int n = 0; n < 2; ++n) _Pragma("unroll") for (int k = 0; k < 2; ++k) dst[n][k] = *(const LAS bf16x8*)(lds + PG8_SB(b, h) + boff + n * 2048 + k * 1024); } while (0)
#define PG8_MMA(ai, bj, At, Bt) do { __builtin_amdgcn_s_setprio(1); _Pragma("unroll") for (int m = 0; m < 4; ++m) _Pragma("unroll") for (int n = 0; n < 2; ++n) _Pragma("unroll") for (int k = 0; k < 2; ++k) \
        acc[ai][bj][m][n] = __builtin_amdgcn_mfma_f32_16x16x32_bf16(Bt[n][k], At[m][k], acc[ai][bj][m][n], 0, 0, 0); __builtin_amdgcn_s_setprio(0); } while (0)
#define PG8_WAIT_V(n) asm volatile("s_waitcnt vmcnt(" #n ")" ::: "memory")
#define PG8_WAIT_L(n) asm volatile("s_waitcnt lgkmcnt(" #n ")" ::: "memory")
#define PG8_BAR __builtin_amdgcn_s_barrier()
#define PG8_SCHED __builtin_amdgcn_sched_barrier(0)
    Unit cur, nxt; int ui = 0;
    if (!S.next(0, cur)) return;
    f32x4 acc[2][2][4][2];
#pragma unroll
    for (int a = 0; a < 2; ++a)
#pragma unroll
        for (int b = 0; b < 2; ++b)
#pragma unroll
            for (int m = 0; m < 4; ++m)
#pragma unroll
                for (int n = 0; n < 2; ++n) acc[a][b][m][n] = (f32x4){0.f, 0.f, 0.f, 0.f};
    bf16x8 At[4][2], B0[2][2], B1[2][2];
    const char* cA = (const char*)g.A + (size_t)cur.pm * tstep + (size_t)cur.koff * 2; const char* cB = (const char*)g.Bt + (size_t)cur.pn * tstep + (size_t)cur.koff * 2;
    PG8_STAGE(PG8_SB(0, 0), cB, voffB); PG8_STAGE(PG8_SA(0, 0), cA, voffA); PG8_STAGE(PG8_SB(0, 1), cB + hstep, voffB); PG8_STAGE(PG8_SA(0, 1), cA + hstep, voffA);
    if (wr == 1) PG8_BAR;
    PG8_WAIT_V(4); PG8_BAR;
    PG8_STAGE(PG8_SB(1, 0), cB + kstep, voffB); PG8_STAGE(PG8_SA(1, 0), cA + kstep, voffA); PG8_STAGE(PG8_SB(1, 1), cB + hstep + kstep, voffB);
    PG8_WAIT_V(6); PG8_BAR;
    for (;;) {
        const bool has_next = S.next(ui + 1, nxt);
        const char* nA = has_next ? (const char*)g.A + (size_t)nxt.pm * tstep + (size_t)nxt.koff * 2 : cA; const char* nB = has_next ? (const char*)g.Bt + (size_t)nxt.pn * tstep + (size_t)nxt.koff * 2 : cB;
        for (int t = 0; t < nt; t += 2) {
            const bool last = (t == nt - 2);
            const char* a1 = cA + (size_t)(t + 1) * kstep;
            const char* a2 = last ? nA : cA + (size_t)(t + 2) * kstep; const char* b2 = last ? nB : cB + (size_t)(t + 2) * kstep;
            const char* a3 = a2 + kstep; const char* b3 = b2 + kstep;
            PG8_LDB(B0, 0, 0); PG8_SCHED; PG8_LDA(At, 0, 0); PG8_STAGE(PG8_SA(1, 1), a1 + hstep, voffA);
            PG8_WAIT_L(8); PG8_BAR; PG8_WAIT_L(0); PG8_MMA(0, 0, At, B0); PG8_BAR; PG8_SCHED;
            PG8_LDB(B1, 0, 1); PG8_STAGE(PG8_SB(0, 0), b2, voffB);
            PG8_BAR; PG8_WAIT_L(0); PG8_MMA(0, 1, At, B1); PG8_BAR;
            PG8_LDA(At, 0, 1); PG8_STAGE(PG8_SA(0, 0), a2, voffA);
            PG8_BAR; PG8_WAIT_L(0); PG8_MMA(1, 0, At, B0); PG8_BAR; PG8_SCHED;
            PG8_STAGE(PG8_SB(0, 1), b2 + hstep, voffB);
            PG8_WAIT_V(6); PG8_BAR; PG8_MMA(1, 1, At, B1); PG8_BAR;
            PG8_LDB(B0, 1, 0); PG8_SCHED; PG8_LDA(At, 1, 0); PG8_STAGE(PG8_SA(0, 1), a2 + hstep, voffA);
            PG8_WAIT_L(8); PG8_BAR; PG8_WAIT_L(0); PG8_MMA(0, 0, At, B0); PG8_BAR; PG8_SCHED;
            PG8_LDB(B1, 1, 1); PG8_STAGE(PG8_SB(1, 0), b3, voffB);
            PG8_BAR; PG8_WAIT_L(0); PG8_MMA(0, 1, At, B1); PG8_BAR;
            PG8_LDA(At, 1, 1); PG8_STAGE(PG8_SA(1, 0), a3, voffA);
            PG8_BAR; PG8_WAIT_L(0); PG8_MMA(1, 0, At, B0); PG8_BAR; PG8_SCHED;
            PG8_STAGE(PG8_SB(1, 1), b3 + hstep, voffB);
            PG8_WAIT_V(6); PG8_BAR; PG8_MMA(1, 1, At, B1); PG8_BAR;
        }
        E(acc, cur, wr, wc, fr, fq);
        if (!has_next) break;
#pragma unroll
        for (int a = 0; a < 2; ++a)
#pragma unroll
            for (int b = 0; b < 2; ++b)
#pragma unroll
                for (int m = 0; m < 4; ++m)
#pragma unroll
                    for (int n = 0; n < 2; ++n) acc[a][b][m][n] = (f32x4){0.f, 0.f, 0.f, 0.f};
        cur = nxt; cA = nA; cB = nB; ++ui;
    }
    PG8_WAIT_V(0);
    if (wr == 0) PG8_BAR;
    PG8_BAR;
#undef PG8_SA
#undef PG8_SB
#undef PG8_STAGE
#undef PG8_LDA
#undef PG8_LDB
#undef PG8_MMA
#undef PG8_WAIT_V
#undef PG8_WAIT_L
#undef PG8_BAR
#undef PG8_SCHED
}
}

struct EpiP {
    static constexpr bool PERM = true;
    bf16_t* P;
    __device__ __forceinline__ void operator()(const f32x4 (&acc)[2][2][4][2], const pg8::Unit& u, int wr, int wc, int fr, int fq) const {
        const int row0 = u.pm * 256 + wr * 64 + fr, col0 = u.pn * 256 + wc * 32 + 8 * fq;
        const int act = ((u.pn >= 4 && u.pn < 8) || (u.pn >= 20 && u.pn < 24)) ? 1 : ((u.pn >= 24 && u.pn < 40) ? 2 : 0);
#pragma unroll
        for (int ai = 0; ai < 2; ++ai)
#pragma unroll
            for (int m = 0; m < 4; ++m) { bf16_t* rowp = P + (size_t)(row0 + ai * 128 + m * 16) * LDP + col0;
#pragma unroll
                for (int bj = 0; bj < 2; ++bj) { f32x4 v0 = acc[ai][bj][m][0], v1 = acc[ai][bj][m][1];
                    if (act == 1) {
#pragma unroll
                        for (int j = 0; j < 4; ++j) { v0[j] = siluf_(v0[j]); v1[j] = siluf_(v1[j]); } }
                    else if (act == 2) {
#pragma unroll
                        for (int j = 0; j < 4; ++j) { v0[j] = sigmoidf_(v0[j]); v1[j] = sigmoidf_(v1[j]); } }
                    u32x4 w; w.x = cvt_pk_bf16(v0[0], v0[1]); w.y = cvt_pk_bf16(v0[2], v0[3]); w.z = cvt_pk_bf16(v1[0], v1[1]); w.w = cvt_pk_bf16(v1[2], v1[3]);
                    *(u32x4*)(rowp + bj * 128) = w; } }
    }
};
struct EpiGlu {
    static constexpr bool PERM = true;
    const bf16_t* Yg; const bf16_t* P; const float* bglu; bf16_t* A2;
    __device__ __forceinline__ void operator()(const f32x4 (&acc)[2][2][4][2], const pg8::Unit& u, int wr, int wc, int fr, int fq) const {
        const int row0 = u.pm * 256 + wr * 64 + fr, col0 = u.pn * 256 + wc * 32 + 8 * fq;
        f32x4 bv[2][2];
#pragma unroll
        for (int bj = 0; bj < 2; ++bj)
#pragma unroll
            for (int n = 0; n < 2; ++n) bv[bj][n] = *(const f32x4*)(bglu + col0 + bj * 128 + 4 * n);
#pragma unroll
        for (int ai = 0; ai < 2; ++ai)
#pragma unroll
            for (int m = 0; m < 4; ++m) { const size_t row = (size_t)(row0 + ai * 128 + m * 16);
#pragma unroll
                for (int bj = 0; bj < 2; ++bj) { const int c = col0 + bj * 128;
                    const u32x4 yg = *(const u32x4*)(Yg + row * 1024 + c), sz = *(const u32x4*)(P + row * LDP + PC_ZS + c);
                    const f32x4 a0 = acc[ai][bj][m][0] + bv[bj][0], a1 = acc[ai][bj][m][1] + bv[bj][1];
                    float o[8];
                    o[0] = bf_lo(yg.x) * sigmoidf_(a0[0]) * bf_lo(sz.x); o[1] = bf_hi(yg.x) * sigmoidf_(a0[1]) * bf_hi(sz.x);
                    o[2] = bf_lo(yg.y) * sigmoidf_(a0[2]) * bf_lo(sz.y); o[3] = bf_hi(yg.y) * sigmoidf_(a0[3]) * bf_hi(sz.y);
                    o[4] = bf_lo(yg.z) * sigmoidf_(a1[0]) * bf_lo(sz.z); o[5] = bf_hi(yg.z) * sigmoidf_(a1[1]) * bf_hi(sz.z);
                    o[6] = bf_lo(yg.w) * sigmoidf_(a1[2]) * bf_lo(sz.w); o[7] = bf_hi(yg.w) * sigmoidf_(a1[3]) * bf_hi(sz.w);
                    u32x4 w; w.x = cvt_pk_bf16(o[0], o[1]); w.y = cvt_pk_bf16(o[2], o[3]); w.z = cvt_pk_bf16(o[4], o[5]); w.w = cvt_pk_bf16(o[6], o[7]);
                    *(u32x4*)(A2 + row * 2048 + c) = w; } }
    }
};
struct EpiOut {
    static constexpr bool PERM = false;
    const bf16_t* P; const float* xp; const float* xs; const float* mod; float* out; float* rowss;
    __device__ __forceinline__ void operator()(const f32x4 (&acc)[2][2][4][2], const pg8::Unit& u, int wr, int wc, int fr, int fq) const {
        const int row0 = u.pm * 256 + wr * 64 + fr, col0 = u.pn * 256 + wc * 32 + 4 * fq;
        const bool second = u.koff != 0;
#pragma unroll
        for (int ai = 0; ai < 2; ++ai) {
            if (u.pm * 256 + ai * 128 >= MV) continue;
#pragma unroll
            for (int m = 0; m < 4; ++m) { const int row = row0 + ai * 128 + m * 16;
                float* orow = out + (size_t)row * DM + col0;
                const bf16_t* prow = P + (size_t)row * LDP + (second ? PC_GR : PC_GS) + col0;
                if (!second) {
#pragma unroll
                    for (int bj = 0; bj < 2; ++bj)
#pragma unroll
                        for (int n = 0; n < 2; ++n) { const u32x2 gg = *(const u32x2*)(prow + bj * 128 + n * 16); const f32x4 a = acc[ai][bj][m][n];
                            f32x4 t; t[0] = bf_lo(gg.x) * a[0]; t[1] = bf_hi(gg.x) * a[1]; t[2] = bf_lo(gg.y) * a[2]; t[3] = bf_hi(gg.y) * a[3];
                            *(f32x4*)(orow + bj * 128 + n * 16) = t; }
                } else {
                    const float* xrow = (row < MP) ? xp + (size_t)row * DM + col0 : xs + (size_t)(row - MP) * DM + col0;
                    const int mrow = (row < MP) ? (row >> 11) : (NB + row - MP);
                    const float* gtrow = mod + (size_t)mrow * NMOD + 2 * DM + col0;
                    float ss = 0.f;
#pragma unroll
                    for (int bj = 0; bj < 2; ++bj)
#pragma unroll
                        for (int n = 0; n < 2; ++n) { const int o = bj * 128 + n * 16; const u32x2 gg = *(const u32x2*)(prow + o); const f32x4 a = acc[ai][bj][m][n];
                            const f32x4 t = *(const f32x4*)(orow + o), xv = *(const f32x4*)(xrow + o), gt = *(const f32x4*)(gtrow + o);
                            f32x4 r; r[0] = xv[0] + gt[0] * (t[0] + bf_lo(gg.x) * a[0]); r[1] = xv[1] + gt[1] * (t[1] + bf_hi(gg.x) * a[1]);
                            r[2] = xv[2] + gt[2] * (t[2] + bf_lo(gg.y) * a[2]); r[3] = xv[3] + gt[3] * (t[3] + bf_hi(gg.y) * a[3]);
                            ss += (r[0] * r[0] + r[1] * r[1]) + (r[2] * r[2] + r[3] * r[3]);
                            *(f32x4*)(orow + o) = r; }
                    ss += __shfl_xor(ss, 16); ss += __shfl_xor(ss, 32);
                    if (fq == 0) rowss[(size_t)row * 32 + u.pn * 4 + wc] = ss;
                }
            }
        }
    }
};

struct Args { const float* in[34]; float* out; unsigned char* ws; int ph_lo, ph_hi, li, pad; };
enum { I_XP = 0, I_XS, I_CP, I_CS, I_S5RE, I_S5IM, I_WKV, I_SHIFT, I_NORMG, I_WADA, I_BADA, I_WIN, I_MU, I_ARE, I_AIM, I_LOGSTEP, I_BRE, I_BIM, I_CRE, I_CIM, I_DSKIP,
       I_WGLU, I_BGLU, I_W0, I_W2, I_A0, I_A2, I_KK, I_KA, I_RK, I_GNW, I_GNB, I_WOUT, I_FINALG };

__device__ __forceinline__ void transpose_item(const float* W, int ldw, int K, int csrc, bf16_t* WT, int rdst, int k0, LAS float* scr, int lane, bool zero) {
    if (zero) {
#pragma unroll
        for (int j = 0; j < 4; ++j) { const int n = (lane >> 3) + 8 * j; *(u32x4*)(WT + (size_t)(rdst + n) * K + k0 + 8 * (lane & 7)) = (u32x4){0u, 0u, 0u, 0u}; }
        return;
    }
#pragma unroll 8
    for (int i = 0; i < 32; ++i) { const int kk = 2 * i + (lane >> 5); scr[kk * 33 + (lane & 31)] = W[(size_t)(k0 + kk) * ldw + csrc + (lane & 31)]; }
    LDS_WAIT(); asm volatile("" ::: "memory");
    const int c = lane & 7;
#pragma unroll
    for (int j = 0; j < 4; ++j) { const int n = (lane >> 3) + 8 * j; const LAS float* s = scr + (8 * c) * 33 + n;
        u32x4 o; o.x = cvt_pk_bf16(s[0 * 33], s[1 * 33]); o.y = cvt_pk_bf16(s[2 * 33], s[3 * 33]); o.z = cvt_pk_bf16(s[4 * 33], s[5 * 33]); o.w = cvt_pk_bf16(s[6 * 33], s[7 * 33]);
        *(u32x4*)(WT + (size_t)(rdst + n) * K + k0 + 8 * c) = o; }
    LDS_WAIT(); asm volatile("" ::: "memory");
}

__device__ __forceinline__ void p0_mod(const Args& a, LAS unsigned char* lds, int s, int wave, int lane) {
    const float* cp = a.in[I_CP]; const float* cs = a.in[I_CS]; const float* W = a.in[I_WADA]; const float* bias = a.in[I_BADA];
    float* mod = (float*)(a.ws + WS_MOD);
    const int n0 = 32 * s, k0 = 256 * wave, r31 = lane & 31, h = lane >> 5;
    f32x16 acc[5];
#pragma unroll
    for (int t = 0; t < 5; ++t)
#pragma unroll
        for (int r = 0; r < 16; ++r) acc[t][r] = 0.f;
    for (int ks = 0; ks < 16; ++ks) {
        const int kb = k0 + 16 * ks + 8 * h;
        float bw[8];
#pragma unroll
        for (int j = 0; j < 8; ++j) bw[j] = W[(size_t)(kb + j) * NMOD + n0 + r31];
        bf16x8 bfr; { u32x4 t; t.x = cvt_pk_bf16(bw[0], bw[1]); t.y = cvt_pk_bf16(bw[2], bw[3]); t.z = cvt_pk_bf16(bw[4], bw[5]); t.w = cvt_pk_bf16(bw[6], bw[7]); bfr = __builtin_bit_cast(bf16x8, t); }
#pragma unroll
        for (int t = 0; t < 5; ++t) {
            const int R = 32 * t + r31;
            f32x4 c0 = (f32x4){0.f, 0.f, 0.f, 0.f}, c1 = c0;
            if (R < NMODROWS) { const float* src = (R < NB) ? cp + (size_t)R * DM + kb : cs + (size_t)(R - NB) * DM + kb; c0 = *(const f32x4*)src; c1 = *(const f32x4*)(src + 4); }
            u32x4 w; w.x = cvt_pk_bf16(siluf_(c0[0]), siluf_(c0[1])); w.y = cvt_pk_bf16(siluf_(c0[2]), siluf_(c0[3])); w.z = cvt_pk_bf16(siluf_(c1[0]), siluf_(c1[1])); w.w = cvt_pk_bf16(siluf_(c1[2]), siluf_(c1[3]));
            acc[t] = __builtin_amdgcn_mfma_f32_32x32x16_bf16(__builtin_bit_cast(bf16x8, w), bfr, acc[t], 0, 0, 0);
        }
    }
    LAS float* red = (LAS float*)lds;
#pragma unroll
    for (int step = 4; step >= 1; step >>= 1) {
        if (wave >= step && wave < 2 * step) {
#pragma unroll
            for (int t = 0; t < 5; ++t)
#pragma unroll
                for (int r = 0; r < 16; ++r) red[(((wave - step) * 5 + t) * 16 + r) * 64 + lane] = acc[t][r];
        }
        __syncthreads();
        if (wave < step) {
#pragma unroll
            for (int t = 0; t < 5; ++t)
#pragma unroll
                for (int r = 0; r < 16; ++r) acc[t][r] += red[((wave * 5 + t) * 16 + r) * 64 + lane];
        }
        __syncthreads();
    }
    if (wave == 0) {
        const float bc = bias[n0 + r31];
#pragma unroll
        for (int t = 0; t < 5; ++t)
#pragma unroll
            for (int r = 0; r < 16; ++r) { const int R = 32 * t + (r & 3) + 8 * (r >> 2) + 4 * h; if (R < NMODROWS) mod[(size_t)R * NMOD + n0 + r31] = acc[t][r] + bc; }
    }
}

__device__ __forceinline__ void p0_s5_tables(const Args& a, LAS unsigned char* lds, int g, int tid) {
    LAS float* pw = (LAS float*)lds;
    LAS float* bbL = pw + 17 * 128;
    LAS float* ccL = bbL + 2048;
    LAS float* KF = ccL + 2048;
    LAS float* DL = KF + 4096;
    unsigned char* tab = (unsigned char*)a.out + DO_S5TAB + (size_t)g * S5T_BYTES;
    {
        const int p = tid & 63;
        const float step = expf(a.in[I_LOGSTEP][g]);
        const float lre = fminf(a.in[I_ARE][g * 64 + p], -1e-4f), lim = a.in[I_AIM][g * 64 + p];
        const float mag = expf(lre * step); float sn, cs; sincosf(lim * step, &sn, &cs);
        const float abr = mag * cs, abi = mag * sn, den = lre * lre + lim * lim;
        const float fr = ((abr - 1.0f) * lre + abi * lim) / den, fi = (abi * lre - (abr - 1.0f) * lim) / den;
        if (tid < 64) { float pr = 1.f, pi = 0.f;
            for (int e = 0; e <= 16; ++e) { pw[(e * 64 + p) * 2] = pr; pw[(e * 64 + p) * 2 + 1] = pi; const float nr = pr * abr - pi * abi, ni = pr * abi + pi * abr; pr = nr; pi = ni; } }
#pragma unroll
        for (int i = 0; i < 2; ++i) { const int c = (tid >> 6) + 8 * i; const float br = a.in[I_BRE][(g * 64 + p) * 16 + c], bi = a.in[I_BIM][(g * 64 + p) * 16 + c];
            bbL[(p * 16 + c) * 2] = fr * br - fi * bi; bbL[(p * 16 + c) * 2 + 1] = fr * bi + fi * br;
            ccL[(c * 64 + p) * 2] = a.in[I_CRE][(g * 16 + c) * 64 + p]; ccL[(c * 64 + p) * 2 + 1] = a.in[I_CIM][(g * 16 + c) * 64 + p]; }
        if (tid < 16) DL[tid] = a.in[I_DSKIP][g * 16 + tid];
    }
    __syncthreads();
    for (int idx = tid; idx < 4096; idx += 512) { const int e = idx >> 8, c = (idx >> 4) & 15, c2 = idx & 15; float s = 0.f;
        for (int p = 0; p < 64; ++p) { const float cr = ccL[(c * 64 + p) * 2], ci = ccL[(c * 64 + p) * 2 + 1], pr = pw[(e * 64 + p) * 2], pi = pw[(e * 64 + p) * 2 + 1];
            const float ar = cr * pr - ci * pi, ai = cr * pi + ci * pr; s += ar * bbL[(p * 16 + c2) * 2] - ai * bbL[(p * 16 + c2) * 2 + 1]; }
        if (e == 0 && c == c2) s += DL[c];
        KF[idx] = s; }
    __syncthreads();
    for (int it = tid; it < 4096; it += 512) { const int l = it & 63, s = (it >> 6) & 15, mtile = it >> 10; const int m = 32 * mtile + (l & 31), h = l >> 5, p = m & 63, im = m >> 6;
        const float pr = pw[((15 - s) * 64 + p) * 2], pi = pw[((15 - s) * 64 + p) * 2 + 1]; float v[8];
#pragma unroll
        for (int j = 0; j < 8; ++j) { const float br = bbL[(p * 16 + 8 * h + j) * 2], bi = bbL[(p * 16 + 8 * h + j) * 2 + 1]; v[j] = im ? (pr * bi + pi * br) : (pr * br - pi * bi); }
        u32x4 w; w.x = cvt_pk_bf16(v[0], v[1]); w.y = cvt_pk_bf16(v[2], v[3]); w.z = cvt_pk_bf16(v[4], v[5]); w.w = cvt_pk_bf16(v[6], v[7]);
        *(u32x4*)(tab + S5T_ME + (size_t)it * 16) = w; }
    for (int it = tid; it < 1024; it += 512) { const int l = it & 63, ti = it >> 6; const int rho = l & 31, dt = rho >> 4, c = rho & 15, h = l >> 5, e = ti - 1 + dt; float v[8];
#pragma unroll
        for (int j = 0; j < 8; ++j) v[j] = (e < 0) ? 0.f : KF[(e * 16 + c) * 16 + 8 * h + j];
        u32x4 w; w.x = cvt_pk_bf16(v[0], v[1]); w.y = cvt_pk_bf16(v[2], v[3]); w.z = cvt_pk_bf16(v[4], v[5]); w.w = cvt_pk_bf16(v[6], v[7]);
        *(u32x4*)(tab + S5T_KT + (size_t)it * 16) = w; }
    for (int it = tid; it < 4096; it += 512) { const int l = it & 63, ks = (it >> 6) & 7, mt = it >> 9; const int rho = l & 31, dt = rho >> 4, c = rho & 15, h = l >> 5, t = 2 * mt + dt; float v[8];
#pragma unroll
        for (int j = 0; j < 8; ++j) { const int m = 16 * ks + 8 * h + j, p = m & 63; const float cr = ccL[(c * 64 + p) * 2], ci = ccL[(c * 64 + p) * 2 + 1], pr = pw[((t + 1) * 64 + p) * 2], pi = pw[((t + 1) * 64 + p) * 2 + 1];
            v[j] = (m < 64) ? (cr * pr - ci * pi) : -(cr * pi + ci * pr); }
        u32x4 w; w.x = cvt_pk_bf16(v[0], v[1]); w.y = cvt_pk_bf16(v[2], v[3]); w.z = cvt_pk_bf16(v[4], v[5]); w.w = cvt_pk_bf16(v[6], v[7]);
        *(u32x4*)(tab + S5T_CA + (size_t)it * 16) = w; }
    { const int it = tid; const int l = it & 63, sp = (it >> 6) & 1, mtile = it >> 7; const int rho = l & 31, h = l >> 5; float v[8];
#pragma unroll
        for (int j = 0; j < 8; ++j) { const int m = 32 * mtile + 16 * sp + 8 * (j >> 2) + 4 * h + (j & 3), p = m & 63; v[j] = (rho < 16) ? ((m < 64) ? ccL[(rho * 64 + p) * 2] : -ccL[(rho * 64 + p) * 2 + 1]) : 0.f; }
        u32x4 w; w.x = cvt_pk_bf16(v[0], v[1]); w.y = cvt_pk_bf16(v[2], v[3]); w.z = cvt_pk_bf16(v[4], v[5]); w.w = cvt_pk_bf16(v[6], v[7]);
        *(u32x4*)(tab + S5T_C0 + (size_t)it * 16) = w; }
    if (tid < 64) { const int l = tid, rho = l & 31, h = l >> 5; float v[8];
#pragma unroll
        for (int j = 0; j < 8; ++j) v[j] = (rho < 16 && rho == 8 * h + j) ? DL[rho] : 0.f;
        u32x4 w; w.x = cvt_pk_bf16(v[0], v[1]); w.y = cvt_pk_bf16(v[2], v[3]); w.z = cvt_pk_bf16(v[4], v[5]); w.w = cvt_pk_bf16(v[6], v[7]);
        *(u32x4*)(tab + S5T_DF + (size_t)l * 16) = w;
        float* hdr = (float*)(tab + S5T_HDR);
        hdr[l] = pw[(16 * 64 + l) * 2]; hdr[64 + l] = pw[(16 * 64 + l) * 2 + 1]; hdr[128 + l] = pw[(64 + l) * 2]; hdr[192 + l] = pw[(64 + l) * 2 + 1]; }
    __syncthreads();
}

__device__ __forceinline__ void p1_row(const Args& a, int m, int lane) {
    bf16_t* XN = (bf16_t*)(a.ws + WS_XN) + (size_t)m * DM;
    if (m >= MV) {
        const float* src = a.in[I_SHIFT] + (size_t)(m - MV) * DM;
#pragma unroll
        for (int j = 0; j < 8; ++j) { const f32x4 v = *(const f32x4*)(src + 4 * lane + 256 * j); u32x2 w; w.x = cvt_pk_bf16(v[0], v[1]); w.y = cvt_pk_bf16(v[2], v[3]); *(u32x2*)(XN + 4 * lane + 256 * j) = w; }
        return;
    }
    const float* x = (m < MP) ? a.in[I_XP] + (size_t)m * DM : a.in[I_XS] + (size_t)(m - MP) * DM;
    const int mrow = (m < MP) ? (m >> 11) : (NB + m - MP);
    const float* mod = (const float*)(a.ws + WS_MOD) + (size_t)mrow * NMOD;
    const float* g = a.in[I_NORMG];
    f32x4 v[8]; float ss = 0.f;
#pragma unroll
    for (int j = 0; j < 8; ++j) { v[j] = *(const f32x4*)(x + 4 * lane + 256 * j); ss += (v[j][0] * v[j][0] + v[j][1] * v[j][1]) + (v[j][2] * v[j][2] + v[j][3] * v[j][3]); }
    const float rstd = rsqrtf(wave_sum(ss) * (1.0f / DM) + RMS_EPS);
    float* sh_out = nullptr;
    if (m >= MP) sh_out = a.out + OUT_SHIFT_S + (size_t)(m - MP) * DM;
    else if ((m & (SEQ - 1)) == SEQ - 1) sh_out = a.out + OUT_SHIFT_P + (size_t)(m >> 11) * DM;
#pragma unroll
    for (int j = 0; j < 8; ++j) { const int k = 4 * lane + 256 * j; const f32x4 gv = *(const f32x4*)(g + k), sh = *(const f32x4*)(mod + k), sc = *(const f32x4*)(mod + DM + k);
        f32x4 hv;
#pragma unroll
        for (int q = 0; q < 4; ++q) hv[q] = v[j][q] * rstd * gv[q] * (1.0f + sc[q]) + sh[q];
        u32x2 w; w.x = cvt_pk_bf16(hv[0], hv[1]); w.y = cvt_pk_bf16(hv[2], hv[3]); *(u32x2*)(XN + k) = w;
        if (sh_out) *(f32x4*)(sh_out + k) = hv; }
}

constexpr int RW_TB = 32;
constexpr int RW_KK = 0, RW_DR = 2048, RW_DD = 4096, RW_BB = 6144, RW_KP = 8192, RW_VV = 10240, RW_SC = 11264, RW_LW = 11392, RW_LA = 13440, RW_OB = 15488, RW_BVB = 16512, RW_END = 17536;
__device__ __forceinline__ void lerp8(const bf16_t* cur, const bf16_t* prev, bool has_prev, const float* mu, float (&o)[8]) {
    const u32x4 c = *(const u32x4*)cur; u32x4 p = (u32x4){0u, 0u, 0u, 0u}; if (has_prev) p = *(const u32x4*)prev;
    const f32x4 m0 = *(const f32x4*)mu, m1 = *(const f32x4*)(mu + 4);
    const float cf[8] = {bf_lo(c.x), bf_hi(c.x), bf_lo(c.y), bf_hi(c.y), bf_lo(c.z), bf_hi(c.z), bf_lo(c.w), bf_hi(c.w)};
    const float pf[8] = {bf_lo(p.x), bf_hi(p.x), bf_lo(p.y), bf_hi(p.y), bf_lo(p.z), bf_hi(p.z), bf_lo(p.w), bf_hi(p.w)};
    const float mf[8] = {m0[0], m0[1], m0[2], m0[3], m1[0], m1[1], m1[2], m1[3]};
#pragma unroll
    for (int j = 0; j < 8; ++j) o[j] = cf[j] + (pf[j] - cf[j]) * mf[j];
}
struct RwTok { float kk, dr, dd, bb, kp, v, br, kr, bonus; };
__device__ __forceinline__ RwTok rw_token(const Args& a, int hj, float r, float k, float v, float lw, float la) {
    RwTok o;
    const float wpre = a.in[I_W0][hj] + lw;
    const float nz = -wpre;
    const float sp = fmaxf(nz, 0.f) + log1pf(__expf(-fabsf(nz)));
    const float w = -sp - 0.5f;
    o.dd = __expf(-__expf(w));
    const float av = sigmoidf_(a.in[I_A0][hj] + la);
    const float kkv = k * a.in[I_KK][hj];
    const float nrm = sqrtf(wave_sum(kkv * kkv));
    o.kk = kkv / fmaxf(nrm, 1e-12f);
    o.kp = k * (1.0f + (av - 1.0f) * a.in[I_KA][hj]);
    o.bb = o.kk * av;
    o.dr = o.dd * r;
    o.v = v;
    o.br = wave_sum(o.bb * r);
    o.kr = wave_sum(o.kp * r);
    o.bonus = wave_sum(r * o.kp * a.in[I_RK][hj]);
    return o;
}
__device__ __forceinline__ void p3_rwkv_prompt(const Args& a, LAS unsigned char* lds, int unit, int tid, int wave, int lane) {
    const int b = unit >> 5, h = (unit >> 1) & 15, half = unit & 1;
    LAS float* L = (LAS float*)lds;
    const bf16_t* P = (const bf16_t*)(a.ws + WS_P);
    bf16_t* ORAW = (bf16_t*)((unsigned char*)a.out + DO_ORAW); bf16_t* BV = (bf16_t*)((unsigned char*)a.out + DO_BV);
    const float* mu = a.in[I_MU];
    const int r31 = lane & 31, hh = lane >> 5;
    bf16x8 bfr[4];
    if (wave < 4) { const float* W2 = (wave >> 1) ? a.in[I_A2] : a.in[I_W2]; const int col = h * 64 + 32 * (wave & 1) + r31;
#pragma unroll
        for (int ks = 0; ks < 4; ++ks) { float w[8];
#pragma unroll
            for (int j = 0; j < 8; ++j) w[j] = W2[(size_t)(16 * ks + 8 * hh + j) * 1024 + col];
            u32x4 t; t.x = cvt_pk_bf16(w[0], w[1]); t.y = cvt_pk_bf16(w[2], w[3]); t.z = cvt_pk_bf16(w[4], w[5]); t.w = cvt_pk_bf16(w[6], w[7]); bfr[ks] = __builtin_bit_cast(bf16x8, t); } }
    const int srow = 4 * wave + (lane >> 4), cq = lane & 15;
    f32x4 S = (f32x4){0.f, 0.f, 0.f, 0.f};
    for (int t0 = 0; t0 < SEQ; t0 += RW_TB) {
        const size_t rowbase = (size_t)b * SEQ + t0;
        if (wave < 4) { const int mat = wave >> 1, nt2 = wave & 1; const size_t row = rowbase + r31; const bool hp = (t0 + r31) > 0;
            f32x16 acc;
#pragma unroll
            for (int r = 0; r < 16; ++r) acc[r] = 0.f;
#pragma unroll
            for (int ks = 0; ks < 4; ++ks) { const int col = PC_WD + mat * 64 + 16 * ks + 8 * hh; float x8[8];
                lerp8(P + row * LDP + col, P + (row - 1) * LDP + col, hp, mu + 3072 + mat * 64 + 16 * ks + 8 * hh, x8);
                if (mat == 0) {
#pragma unroll
                    for (int j = 0; j < 8; ++j) x8[j] = tanhf_(x8[j]); }
                u32x4 t; t.x = cvt_pk_bf16(x8[0], x8[1]); t.y = cvt_pk_bf16(x8[2], x8[3]); t.z = cvt_pk_bf16(x8[4], x8[5]); t.w = cvt_pk_bf16(x8[6], x8[7]);
                acc = __builtin_amdgcn_mfma_f32_32x32x16_bf16(__builtin_bit_cast(bf16x8, t), bfr[ks], acc, 0, 0, 0); }
            LAS float* dst = L + (mat ? RW_LA : RW_LW);
#pragma unroll
            for (int r = 0; r < 16; ++r) { const int tl = (r & 3) + 8 * (r >> 2) + 4 * hh; dst[tl * 64 + 32 * nt2 + r31] = acc[r]; } }
        __syncthreads();
#pragma unroll 1
        for (int q = 0; q < 4; ++q) { const int tl = wave * 4 + q; const size_t row = rowbase + tl; const bool hp = (t0 + tl) > 0; const int hj = h * 64 + lane;
            const bf16_t* pc = P + row * LDP; const bf16_t* pp = pc - LDP;
            float r = bf2f(pc[PC_R + hj]), k = bf2f(pc[PC_K + hj]), v = bf2f(pc[PC_V + hj]);
            const float pr = hp ? bf2f(pp[PC_R + hj]) : 0.f, pk = hp ? bf2f(pp[PC_K + hj]) : 0.f, pv = hp ? bf2f(pp[PC_V + hj]) : 0.f;
            r += (pr - r) * mu[hj]; k += (pk - k) * mu[1024 + hj]; v += (pv - v) * mu[2048 + hj];
            const RwTok o = rw_token(a, hj, r, k, v, L[RW_LW + tl * 64 + lane], L[RW_LA + tl * 64 + lane]);
            L[RW_KK + tl * 64 + lane] = o.kk; L[RW_DR + tl * 64 + lane] = o.dr; L[RW_DD + tl * 64 + lane] = o.dd; L[RW_BB + tl * 64 + lane] = o.bb; L[RW_KP + tl * 64 + lane] = o.kp;
            if ((lane >> 5) == half) L[RW_VV + tl * 32 + (lane & 31)] = o.v;
            if (lane == 0) { L[RW_SC + tl * 4] = o.br; L[RW_SC + tl * 4 + 1] = o.kr; L[RW_SC + tl * 4 + 2] = o.bonus; } }
        __syncthreads();
#pragma unroll 4
        for (int tl = 0; tl < RW_TB; ++tl) {
            const f32x4 kk4 = *(const LAS f32x4*)(L + RW_KK + tl * 64 + 4 * cq), dr4 = *(const LAS f32x4*)(L + RW_DR + tl * 64 + 4 * cq), d4 = *(const LAS f32x4*)(L + RW_DD + tl * 64 + 4 * cq),
                        b4 = *(const LAS f32x4*)(L + RW_BB + tl * 64 + 4 * cq), k4 = *(const LAS f32x4*)(L + RW_KP + tl * 64 + 4 * cq);
            const float v = L[RW_VV + tl * 32 + srow]; const f32x4 sc = *(const LAS f32x4*)(L + RW_SC + tl * 4);
            float p1 = (S[0] * kk4[0] + S[1] * kk4[1]) + (S[2] * kk4[2] + S[3] * kk4[3]);
            float p2 = (S[0] * dr4[0] + S[1] * dr4[1]) + (S[2] * dr4[2] + S[3] * dr4[3]);
            p1 = row16_sum(p1); p2 = row16_sum(p2);
            const float sa = -p1;
            const float o = p2 + sa * sc[0] + v * sc[1];
#pragma unroll
            for (int j = 0; j < 4; ++j) S[j] = S[j] * d4[j] + sa * b4[j] + v * k4[j];
            if (cq == 0) { L[RW_OB + tl * 32 + srow] = o; L[RW_BVB + tl * 32 + srow] = sc[2] * v; }
        }
        __syncthreads();
        { const int tl = tid >> 4, r2 = 2 * (tid & 15); const size_t off = (rowbase + tl) * 1024 + h * 64 + 32 * half + r2;
          *(unsigned*)(ORAW + off) = cvt_pk_bf16(L[RW_OB + tl * 32 + r2], L[RW_OB + tl * 32 + r2 + 1]);
          *(unsigned*)(BV + off) = cvt_pk_bf16(L[RW_BVB + tl * 32 + r2], L[RW_BVB + tl * 32 + r2 + 1]); }
    }
    *(f32x4*)(a.out + OUT_WKV_P + (((size_t)(b * 16 + h) * 64 + 32 * half + srow) * 64 + 4 * cq)) = S;
    __syncthreads();
}

__device__ __forceinline__ void p3_rwkv_sample(const Args& a, LAS unsigned char* lds, int bs, int wave, int lane) {
    LAS float* Lw = (LAS float*)lds + wave * 768;
    const bf16_t* P = (const bf16_t*)(a.ws + WS_P);
    const bf16_t* pc = P + (size_t)(MP + bs) * LDP; const bf16_t* pp = P + (size_t)(MV + bs) * LDP;
    bf16_t* A2 = (bf16_t*)(a.ws + WS_XN);
    const float* mu = a.in[I_MU];
    { float wd = bf2f(pc[PC_WD + lane]), ad = bf2f(pc[PC_AD + lane]); wd += (bf2f(pp[PC_WD + lane]) - wd) * mu[3072 + lane]; ad += (bf2f(pp[PC_AD + lane]) - ad) * mu[3136 + lane];
      Lw[lane] = tanhf_(wd); Lw[64 + lane] = ad; }
    LDS_WAIT();
    for (int hq = 0; hq < 2; ++hq) { const int h = 2 * wave + hq, hj = h * 64 + lane;
        float lw = 0.f, la = 0.f;
#pragma unroll 8
        for (int m = 0; m < 64; ++m) { lw += Lw[m] * a.in[I_W2][(size_t)m * 1024 + hj]; la += Lw[64 + m] * a.in[I_A2][(size_t)m * 1024 + hj]; }
        float r = bf2f(pc[PC_R + hj]), k = bf2f(pc[PC_K + hj]), v = bf2f(pc[PC_V + hj]);
        r += (bf2f(pp[PC_R + hj]) - r) * mu[hj]; k += (bf2f(pp[PC_K + hj]) - k) * mu[1024 + hj]; v += (bf2f(pp[PC_V + hj]) - v) * mu[2048 + hj];
        const RwTok o = rw_token(a, hj, r, k, v, lw, la);
        Lw[128 + lane] = o.kk; Lw[192 + lane] = o.dr; Lw[256 + lane] = o.dd; Lw[320 + lane] = o.bb; Lw[384 + lane] = o.kp; Lw[448 + lane] = o.v;
        LDS_WAIT();
        const int rg = lane >> 4, cq = lane & 15;
        const f32x4 kk4 = *(const LAS f32x4*)(Lw + 128 + 4 * cq), dr4 = *(const LAS f32x4*)(Lw + 192 + 4 * cq), d4 = *(const LAS f32x4*)(Lw + 256 + 4 * cq), b4 = *(const LAS f32x4*)(Lw + 320 + 4 * cq), k4 = *(const LAS f32x4*)(Lw + 384 + 4 * cq);
        const size_t sbase = ((size_t)(bs * 16 + h) * 64) * 64;
        const float* S0 = a.in[I_WKV] + sbase; float* S1 = a.out + OUT_WKV_S + sbase;
#pragma unroll 4
        for (int it = 0; it < 16; ++it) { const int i = 4 * it + rg; f32x4 S = *(const f32x4*)(S0 + (size_t)i * 64 + 4 * cq); const float vi = Lw[448 + i];
            float p1 = (S[0] * kk4[0] + S[1] * kk4[1]) + (S[2] * kk4[2] + S[3] * kk4[3]);
            float p2 = (S[0] * dr4[0] + S[1] * dr4[1]) + (S[2] * dr4[2] + S[3] * dr4[3]);
            p1 = row16_sum(p1); p2 = row16_sum(p2);
            const float sa = -p1, ov = p2 + sa * o.br + vi * o.kr;
#pragma unroll
            for (int j = 0; j < 4; ++j) S[j] = S[j] * d4[j] + sa * b4[j] + vi * k4[j];
            *(f32x4*)(S1 + (size_t)i * 64 + 4 * cq) = S;
            if (cq == 0) Lw[512 + i] = ov; }
        LDS_WAIT();
        const float ov = Lw[512 + lane];
        const float mean = wave_sum(ov) * (1.0f / 64.0f); const float dv = ov - mean; const float var = wave_sum(dv * dv) * (1.0f / 64.0f);
        float on = dv * rsqrtf(var + GN_EPS) * a.in[I_GNW][hj] + a.in[I_GNB][hj] + o.bonus * o.v;
        on *= bf2f(pc[PC_ZR + hj]);
        A2[(size_t)(MP + bs) * 2048 + 1024 + hj] = f2bf(on);
        LDS_WAIT();
    }
}

constexpr int S5_ELD = 132, S5_XLD = 136;
constexpr int S5_E_OFF = 0, S5_X_OFF = 128 * S5_ELD * 4;
__device__ __forceinline__ bf16x8 ldfrag(const unsigned char* base, int block, int lane) { return *(const bf16x8*)(base + (size_t)block * 1024 + lane * 16); }
__device__ __forceinline__ void p3_s5_prompt(const Args& a, LAS unsigned char* lds, int unit, int tid, int wave, int lane) {
    const int b = unit >> 6, g = unit & 63;
    const unsigned char* tab = (const unsigned char*)a.out + DO_S5TAB + (size_t)g * S5T_BYTES;
    const bf16_t* P = (const bf16_t*)(a.ws + WS_P);
    bf16_t* Yg = (bf16_t*)(a.ws + WS_YG);
    LAS float* EL = (LAS float*)(lds + S5_E_OFF); LAS bf16_t* XL = (LAS bf16_t*)(lds + S5_X_OFF);
    const int nt = wave & 3, hm = wave >> 2, r31 = lane & 31, hh = lane >> 5;
    const int n = 32 * nt + r31;
    f32x16 accY[4], accE[2];
#pragma unroll
    for (int q = 0; q < 4; ++q)
#pragma unroll
        for (int r = 0; r < 16; ++r) accY[q][r] = 0.f;
#pragma unroll
    for (int q = 0; q < 2; ++q)
#pragma unroll
        for (int r = 0; r < 16; ++r) accE[q][r] = 0.f;
    const int mts[4] = {hm ? 1 : 0, hm ? 2 : 3, hm ? 5 : 4, hm ? 6 : 7};
    const bf16_t* ubase = P + ((size_t)b * SEQ + 16 * n) * LDP + PC_U + g * 16 + 8 * hh;
#pragma unroll
    for (int s = 0; s < 16; ++s) {
        const bf16x8 bu = *(const bf16x8*)(ubase + (size_t)s * LDP);
#pragma unroll
        for (int e = 0; e < 2; ++e) accE[e] = __builtin_amdgcn_mfma_f32_32x32x16_bf16(ldfrag(tab + S5T_ME, (2 * hm + e) * 16 + s, lane), bu, accE[e], 0, 0, 0);
#pragma unroll
        for (int q = 0; q < 4; ++q) { const int mt = mts[q]; if (s <= 2 * mt + 1) accY[q] = __builtin_amdgcn_mfma_f32_32x32x16_bf16(ldfrag(tab + S5T_KT, 2 * mt - s + 1, lane), bu, accY[q], 0, 0, 0); }
    }
#pragma unroll
    for (int e = 0; e < 2; ++e)
#pragma unroll
        for (int q4 = 0; q4 < 4; ++q4) { f32x4 v; v[0] = accE[e][4 * q4]; v[1] = accE[e][4 * q4 + 1]; v[2] = accE[e][4 * q4 + 2]; v[3] = accE[e][4 * q4 + 3];
            *(LAS f32x4*)(EL + n * S5_ELD + 32 * (2 * hm + e) + 8 * q4 + 4 * hh) = v; }
    __syncthreads();
    if (wave == 0) { const float* hdr = (const float*)(tab + S5T_HDR); const float ar = hdr[lane], ai = hdr[64 + lane]; float xr = 0.f, xi = 0.f;
#pragma unroll 8
        for (int c = 0; c < 128; ++c) { XL[c * S5_XLD + lane] = f2bf(xr); XL[c * S5_XLD + 64 + lane] = f2bf(xi);
            const float er = EL[c * S5_ELD + lane], ei = EL[c * S5_ELD + 64 + lane];
            const float nr = ar * xr - ai * xi + er, ni = ar * xi + ai * xr + ei; xr = nr; xi = ni; }
        a.out[OUT_S5RE_P + (size_t)(b * 64 + g) * 64 + lane] = xr; a.out[OUT_S5IM_P + (size_t)(b * 64 + g) * 64 + lane] = xi; }
    __syncthreads();
#pragma unroll
    for (int ks = 0; ks < 8; ++ks) { const bf16x8 bx = *(const LAS bf16x8*)(XL + n * S5_XLD + 16 * ks + 8 * hh);
#pragma unroll
        for (int q = 0; q < 4; ++q) accY[q] = __builtin_amdgcn_mfma_f32_32x32x16_bf16(ldfrag(tab + S5T_CA, mts[q] * 8 + ks, lane), bx, accY[q], 0, 0, 0); }
#pragma unroll
    for (int q = 0; q < 4; ++q) { const int mt = mts[q];
#pragma unroll
        for (int q4 = 0; q4 < 4; ++q4) { const int dt = q4 >> 1, c0 = 8 * (q4 & 1) + 4 * hh; const size_t row = (size_t)b * SEQ + 16 * n + 2 * mt + dt;
            u32x2 w; w.x = cvt_pk_bf16(geluf_(accY[q][4 * q4]), geluf_(accY[q][4 * q4 + 1])); w.y = cvt_pk_bf16(geluf_(accY[q][4 * q4 + 2]), geluf_(accY[q][4 * q4 + 3]));
            *(u32x2*)(Yg + row * 1024 + g * 16 + c0) = w; } }
    __syncthreads();
}
__device__ __forceinline__ void p3_s5_sample(const Args& a, int g, int wave, int lane) {
    if (wave >= 4) return;
    const unsigned char* tab = (const unsigned char*)a.out + DO_S5TAB + (size_t)g * S5T_BYTES;
    const float* hdr = (const float*)(tab + S5T_HDR);
    const bf16_t* P = (const bf16_t*)(a.ws + WS_P);
    bf16_t* Yg = (bf16_t*)(a.ws + WS_YG);
    const int r31 = lane & 31, hh = lane >> 5, bs = 32 * wave + r31;
    const bf16x8 bu = *(const bf16x8*)(P + (size_t)(MP + bs) * LDP + PC_U + g * 16 + 8 * hh);
    f32x16 z;
#pragma unroll
    for (int r = 0; r < 16; ++r) z[r] = 0.f;
    f32x16 x[4];
#pragma unroll
    for (int mtile = 0; mtile < 4; ++mtile) x[mtile] = __builtin_amdgcn_mfma_f32_32x32x16_bf16(ldfrag(tab + S5T_ME, mtile * 16 + 15, lane), bu, z, 0, 0, 0);
    const size_t sb = (size_t)(bs * 64 + g) * 64;
#pragma unroll
    for (int pt = 0; pt < 2; ++pt)
#pragma unroll
        for (int q4 = 0; q4 < 4; ++q4) { const int p0 = 32 * pt + 8 * q4 + 4 * hh;
            const f32x4 x0r = *(const f32x4*)(a.in[I_S5RE] + sb + p0), x0i = *(const f32x4*)(a.in[I_S5IM] + sb + p0);
            const f32x4 ar = *(const f32x4*)(hdr + 128 + p0), ai = *(const f32x4*)(hdr + 192 + p0);
            f32x4 nr, ni;
#pragma unroll
            for (int j = 0; j < 4; ++j) { nr[j] = ar[j] * x0r[j] - ai[j] * x0i[j] + x[pt][4 * q4 + j]; ni[j] = ar[j] * x0i[j] + ai[j] * x0r[j] + x[2 + pt][4 * q4 + j]; x[pt][4 * q4 + j] = nr[j]; x[2 + pt][4 * q4 + j] = ni[j]; }
            *(f32x4*)(a.out + OUT_S5RE_S + sb + p0) = nr; *(f32x4*)(a.out + OUT_S5IM_S + sb + p0) = ni; }
    f32x16 y = __builtin_amdgcn_mfma_f32_32x32x16_bf16(ldfrag(tab + S5T_DF, 0, lane), bu, z, 0, 0, 0);
#pragma unroll
    for (int mtile = 0; mtile < 4; ++mtile)
#pragma unroll
        for (int sp = 0; sp < 2; ++sp) { u32x4 t; t.x = cvt_pk_bf16(x[mtile][8 * sp], x[mtile][8 * sp + 1]); t.y = cvt_pk_bf16(x[mtile][8 * sp + 2], x[mtile][8 * sp + 3]);
            t.z = cvt_pk_bf16(x[mtile][8 * sp + 4], x[mtile][8 * sp + 5]); t.w = cvt_pk_bf16(x[mtile][8 * sp + 6], x[mtile][8 * sp + 7]);
            y = __builtin_amdgcn_mfma_f32_32x32x16_bf16(ldfrag(tab + S5T_C0, mtile * 2 + sp, lane), __builtin_bit_cast(bf16x8, t), y, 0, 0, 0); }
#pragma unroll
    for (int q4 = 0; q4 < 2; ++q4) { const int c0 = 8 * q4 + 4 * hh;
        u32x2 w; w.x = cvt_pk_bf16(geluf_(y[4 * q4]), geluf_(y[4 * q4 + 1])); w.y = cvt_pk_bf16(geluf_(y[4 * q4 + 2]), geluf_(y[4 * q4 + 3]));
        *(u32x2*)(Yg + (size_t)(MP + bs) * 1024 + g * 16 + c0) = w; }
}

__device__ __forceinline__ void p4_rwkv_post(const Args& a, int item, int lane) {
    const int row = item >> 4, h = item & 15, hj = h * 64 + lane;
    const bf16_t* ORAW = (const bf16_t*)((const unsigned char*)a.out + DO_ORAW); const bf16_t* BV = (const bf16_t*)((const unsigned char*)a.out + DO_BV);
    const bf16_t* P = (const bf16_t*)(a.ws + WS_P); bf16_t* A2 = (bf16_t*)(a.ws + WS_XN);
    const float ov = bf2f(ORAW[(size_t)row * 1024 + hj]), bv = bf2f(BV[(size_t)row * 1024 + hj]);
    const float mean = wave_sum(ov) * (1.0f / 64.0f); const float dv = ov - mean; const float var = wave_sum(dv * dv) * (1.0f / 64.0f);
    float on = dv * rsqrtf(var + GN_EPS) * a.in[I_GNW][hj] + a.in[I_GNB][hj] + bv;
    on *= bf2f(P[(size_t)row * LDP + PC_ZR + hj]);
    A2[(size_t)row * 2048 + 1024 + hj] = f2bf(on);
}

__device__ __forceinline__ void p6_row(const Args& a, int m, int lane) {
    float* y = a.out + (size_t)m * DM; const float* rs = (const float*)(a.ws + WS_ROWSS) + (size_t)m * 32; const float* fg = a.in[I_FINALG];
    const float ss = wave_sum(rs[lane & 31]) * 0.5f;
    const float rstd = rsqrtf(ss * (1.0f / DM) + RMS_EPS);
#pragma unroll
    for (int j = 0; j < 8; ++j) { const int k = 4 * lane + 256 * j; f32x4 v = *(const f32x4*)(y + k); const f32x4 gv = *(const f32x4*)(fg + k);
#pragma unroll
        for (int q = 0; q < 4; ++q) v[q] = v[q] * rstd * gv[q];
        *(f32x4*)(y + k) = v; }
}

__global__ void __launch_bounds__(512, 2) fwd_kernel(Args args) {
    extern __shared__ __attribute__((aligned(16))) unsigned char lds_raw[];
    LAS unsigned char* lds = (LAS unsigned char*)lds_raw;
    const int tid = threadIdx.x, lane = tid & 63, wave = __builtin_amdgcn_readfirstlane(tid >> 6);
    const int G = gridDim.x, bx = blockIdx.x;
    const int vcu = (G % 8 == 0) ? (bx % 8) * (G / 8) + bx / 8 : bx;
    volatile LAS unsigned* MISC = (volatile LAS unsigned*)(lds + MISC_OFF);
    for (int u = tid; u < (LDS_BYTES - LDSCTL_OFF) / 4; u += 512) ((LAS unsigned*)(lds + LDSCTL_OFF))[u] = 0u;
    __syncthreads();
    unsigned* ctl = (unsigned*)(args.ws + WS_CTL);
    XcdBarrier bar; bar.bar = ctl + CW_BAR + args.li * XCD_BAR_WORDS; bar.x = 0; bar.st = nullptr;
    const bool multi = (args.ph_hi - args.ph_lo) > 1;
    if (multi) bar = xcd_barrier_post(ctl + CW_BAR + args.li * XCD_BAR_WORDS, MISC + 8);
    const int lo = args.ph_lo, hi = args.ph_hi;
#define IN(k) (lo <= (k) && (k) < hi)
#define SEAM(k) do { if (IN(k) && IN((k) + 1)) xcd_barrier(bar); } while (0)
    const int gw = vcu * 8 + wave, NGW = G * 8;

    if (IN(0)) {
        if (vcu < 192) p0_mod(args, lds, vcu, wave, lane);
        else if (vcu - 192 < 64) p0_s5_tables(args, lds, vcu - 192, tid);
        __syncthreads();
        LAS float* scr = (LAS float*)(lds + wave * 16384);
        bf16_t* WT = (bf16_t*)(args.ws + WS_WT);
        for (int it = gw; it < 328 * 32; it += NGW) { const int nb = it >> 5, kb = it & 31; const int p0 = 32 * nb;
            const int src = (p0 < 5120) ? p0 : ((p0 < 10240) ? p0 + 128 : p0 - 5120);
            transpose_item(args.in[I_WIN], NIN, 2048, src, WT, p0, 64 * kb, scr, lane, p0 >= NIN); }
    }
    SEAM(0);
    if (IN(1)) { for (int m = gw; m < MT; m += NGW) p1_row(args, m, lane); }
    SEAM(1);
    if (IN(2)) {
        pg8::Gemm g{(const bf16_t*)(args.ws + WS_XN), (const bf16_t*)(args.ws + WS_WT), 2048, 2048};
        pg8::StaticOrder S; S.init(MT, LDP, G, bx);
        EpiP E{(bf16_t*)(args.ws + WS_P)};
        pg8::gemm_phase<EpiP, pg8::StaticOrder>(lds, g, S, E);
    }
    SEAM(2);
    if (IN(3)) {
        if (vcu < 128) p3_rwkv_prompt(args, lds, vcu, tid, wave, lane);
        else {
            const int j = vcu - 128;
            { LAS float* scr = (LAS float*)(lds + wave * 16384); const int lw = j * 8 + wave;
              for (int it = lw; it < 2048 + 512; it += 1024) {
                  if (it < 2048) { const int nb = it >> 5, kb = it & 31; transpose_item(args.in[I_WOUT], 2048, 2048, 32 * nb, (bf16_t*)(args.ws + WS_WOUT_T), 32 * nb, 64 * kb, scr, lane, false); }
                  else { const int i2 = it - 2048, nb = i2 >> 4, kb = i2 & 15; transpose_item(args.in[I_WGLU], 1024, 1024, 32 * nb, (bf16_t*)(args.ws + WS_WGLU_T), 32 * nb, 64 * kb, scr, lane, false); } } }
            __syncthreads();
            p3_s5_prompt(args, lds, 2 * j, tid, wave, lane);
            p3_s5_prompt(args, lds, 2 * j + 1, tid, wave, lane);
            if ((j & 1) == 0) p3_s5_sample(args, j >> 1, wave, lane);
            __syncthreads();
            p3_rwkv_sample(args, lds, j, wave, lane);
        }
    }
    SEAM(3);
    if (IN(4)) {
        pg8::StaticOrder S; S.init(MT, 1024, G, bx);
        pg8::Unit u0;
        if (S.next(0, u0)) {
            pg8::Gemm g{(const bf16_t*)(args.ws + WS_YG), (const bf16_t*)(args.ws + WS_WGLU_T), 1024, 1024};
            EpiGlu E{(const bf16_t*)(args.ws + WS_YG), (const bf16_t*)(args.ws + WS_P), args.in[I_BGLU], (bf16_t*)(args.ws + WS_XN)};
            pg8::gemm_phase<EpiGlu, pg8::StaticOrder>(lds, g, S, E);
        } else {
            const int nfree = G - 132, j = bx - 132;
            if (j >= 0) for (int it = j * 8 + wave; it < MP * 16; it += nfree * 8) p4_rwkv_post(args, it, lane);
        }
    }
    SEAM(4);
    if (IN(5)) {
        pg8::Gemm g{(const bf16_t*)(args.ws + WS_XN), (const bf16_t*)(args.ws + WS_WOUT_T), 2048, 1024};
        pg8::TwoHalfOrder S; S.init(MT, DM, G, bx);
        EpiOut E{(const bf16_t*)(args.ws + WS_P), args.in[I_XP], args.in[I_XS], (const float*)(args.ws + WS_MOD), args.out, (float*)(args.ws + WS_ROWSS)};
        pg8::gemm_phase<EpiOut, pg8::TwoHalfOrder>(lds, g, S, E);
    }
    SEAM(5);
    if (IN(6)) { for (int m = gw; m < MV; m += NGW) p6_row(args, m, lane); }
#undef IN
#undef SEAM
}

extern "C" void kernel_launch(void* const* d_in, const int* in_sizes, int n_in, void* d_out, int out_size, void* d_ws, size_t ws_size, hipStream_t stream) {
    static int grid = 0;
    if (grid == 0) {
        if (n_in != 34 || ws_size < WS_END) { fprintf(stderr, "kernel_launch: unexpected n_in %d / ws %zu\n", n_in, ws_size); grid = -1; return; }
        int dev = 0, cus = 0;
        if (hipGetDevice(&dev) != hipSuccess || hipDeviceGetAttribute(&cus, hipDeviceAttributeMultiprocessorCount, dev) != hipSuccess) { grid = -1; return; }
        if (hipFuncSetAttribute((const void*)fwd_kernel, hipFuncAttributeMaxDynamicSharedMemorySize, LDS_BYTES) != hipSuccess) { fprintf(stderr, "kernel_launch: hipFuncSetAttribute failed\n"); grid = -1; return; }
        int per_cu = 0;
        if (hipOccupancyMaxActiveBlocksPerMultiprocessor(&per_cu, (const void*)fwd_kernel, 512, LDS_BYTES) != hipSuccess || per_cu < 1) fprintf(stderr, "kernel_launch: occupancy query says %d\n", per_cu);
        (void)hipGetLastError();
        grid = cus;
        if (grid != 256) fprintf(stderr, "kernel_launch: note: %d CUs\n", grid);
    }
    if (grid < 0) return;
    (void)hipMemsetAsync((char*)d_ws + WS_CTL, 0, CTL_BYTES, stream);
    Args a{};
    for (int i = 0; i < 34; ++i) a.in[i] = (const float*)d_in[i];
    a.out = (float*)d_out; a.ws = (unsigned char*)d_ws;
    if (MK_N_LAUNCHES == 1) { a.ph_lo = 0; a.ph_hi = N_PHASES; a.li = 0; hipLaunchKernelGGL(fwd_kernel, dim3(grid), dim3(512), LDS_BYTES, stream, a); }
    else { for (int p = 0; p < N_PHASES; ++p) { a.ph_lo = p; a.ph_hi = p + 1; a.li = 0; hipLaunchKernelGGL(fwd_kernel, dim3(grid), dim3(512), LDS_BYTES, stream, a); } }
}
```

```cpp
#include <hip/hip_runtime.h>
#include <cstdio>
#include <cstdint>

#ifndef MK_N_LAUNCHES
#define MK_N_LAUNCHES 1
#endif
#ifndef PROBE_PHASE
#define PROBE_PHASE -1
#endif
constexpr int N_PHASES = 8;

#define GAS __attribute__((address_space(1)))
#define LAS __attribute__((address_space(3)))
typedef unsigned short bf16_t;
typedef short bf16x8 __attribute__((ext_vector_type(8)));
typedef float f32x2 __attribute__((ext_vector_type(2)));
typedef float f32x4 __attribute__((ext_vector_type(4)));
typedef float f32x16 __attribute__((ext_vector_type(16)));
typedef unsigned u32x2 __attribute__((ext_vector_type(2)));
typedef unsigned u32x4 __attribute__((ext_vector_type(4)));
typedef GAS unsigned gu32;

constexpr int DM = 2048, SEQ = 2048, NB = 4, NSMP = 128;
constexpr int MP = NB * SEQ;
constexpr int MV = MP + NSMP;
constexpr int MT = MV + NSMP;
constexpr int NIN = 10368, LDP = 10496;
constexpr int NMOD = 6144, NMODROWS = NB + NSMP;
constexpr float RMS_EPS = 1e-6f, GN_EPS = 64e-5f;
constexpr int PC_U = 0, PC_ZS = 1024, PC_R = 2048, PC_K = 3072, PC_V = 4096, PC_ZR = 5120, PC_GS = 6144, PC_GR = 8192, PC_WD = 10240, PC_AD = 10304;

constexpr size_t WS_CTL = 0, CTL_BYTES = 65536;
constexpr size_t WS_MOD = 65536;
constexpr size_t WS_WT = 3342336;
constexpr size_t WS_YG = WS_WT;
constexpr size_t WS_WOUT_T = WS_YG + (size_t)MT * 1024 * 2;
constexpr size_t WS_WGLU_T = WS_WOUT_T + (size_t)2048 * 2048 * 2;
constexpr size_t WS_ROWSS = WS_WGLU_T + (size_t)1024 * 1024 * 2;
constexpr size_t WS_XN = WS_WT + (size_t)LDP * 2048 * 2;
constexpr size_t WS_P = WS_XN + (size_t)MT * 2048 * 2;
constexpr size_t WS_RWI = WS_P + (size_t)MT * LDP * 2;
constexpr int RWI_GF = 0, RWI_W2F = 8192, RWI_H1F = 16384, RWI_O1F = 32768, RWI_LAM = 49152, RWI_BYTES = 49408;
constexpr size_t WS_END = WS_RWI + (size_t)2048 * RWI_BYTES;
static_assert(WS_END <= ((size_t)412 << 20), "ws map");
static_assert(WS_ROWSS + (size_t)MT * 32 * 4 <= WS_XN, "ws map 2");
constexpr size_t DO_ORAW = 0, DO_BV = (size_t)MP * 1024 * 2, DO_S5TAB = 2 * DO_BV;
constexpr int S5T_ME = 0, S5T_KT = 65536, S5T_CA = 81920, S5T_C0 = 147456, S5T_DF = 155648, S5T_HDR = 156672, S5T_BYTES = 157696;
static_assert(DO_S5TAB + (size_t)64 * S5T_BYTES <= (size_t)MV * DM * 4, "d_out scratch");
constexpr size_t OUT_Y = 0, OUT_S5RE_P = 17039360, OUT_S5IM_P = 17055744, OUT_WKV_P = 17072128, OUT_SHIFT_P = 17334272,
                 OUT_S5RE_S = 17342464, OUT_S5IM_S = 17866752, OUT_WKV_S = 18391040, OUT_SHIFT_S = 26779648;
constexpr int RING_BYTES = 131072, LDSCTL_OFF = RING_BYTES, MISC_OFF = LDSCTL_OFF + 320, LDS_BYTES = 147456;
constexpr int CW_BAR = 1024;

#define LDS_WAIT() asm volatile("s_waitcnt lgkmcnt(0)" ::: "memory")
#define VM_WAIT() asm volatile("s_waitcnt vmcnt(0)" ::: "memory")
typedef __bf16 bf16x2_t __attribute__((ext_vector_type(2)));
__device__ __forceinline__ unsigned cvt_pk_bf16(float lo, float hi) { const f32x2 v = {lo, hi}; return __builtin_bit_cast(unsigned, __builtin_convertvector(v, bf16x2_t)); }
__device__ __forceinline__ float bf_lo(unsigned w) { return __uint_as_float(w << 16); }
__device__ __forceinline__ float bf_hi(unsigned w) { return __uint_as_float(w & 0xffff0000u); }
__device__ __forceinline__ float bf2f(bf16_t b) { return __uint_as_float(((unsigned)b) << 16); }
__device__ __forceinline__ bf16_t f2bf(float f) { return (bf16_t)(cvt_pk_bf16(f, 0.f) & 0xffffu); }
__device__ __forceinline__ float sigmoidf_(float x) { return 1.0f / (1.0f + __expf(-x)); }
__device__ __forceinline__ float siluf_(float x) { return x / (1.0f + __expf(-x)); }
__device__ __forceinline__ float tanhf_(float x) { const float e = __expf(2.0f * x); return 1.0f - 2.0f / (e + 1.0f); }
__device__ __forceinline__ float geluf_(float y) { const float z = 0.7978845608028654f * (y + 0.044715f * y * y * y); return 0.5f * y * (1.0f + tanhf_(z)); }
__device__ __forceinline__ float wave_sum(float v) {
#pragma unroll
    for (int o = 1; o < 64; o <<= 1) v += __shfl_xor(v, o);
    return v;
}
template <int CTRL> __device__ __forceinline__ float dpp_f(float x) { return __builtin_bit_cast(float, __builtin_amdgcn_mov_dpp(__builtin_bit_cast(int, x), CTRL, 0xf, 0xf, true)); }
__device__ __forceinline__ float row16_sum(float v) {
    v += dpp_f<0xB1>(v);
    v += dpp_f<0x4E>(v);
    v += dpp_f<0x141>(v);
    v += dpp_f<0x140>(v);
    return v;
}

#define XB_TMO      128
#define XB_XCNT(j)  (256  + 64 * (j))
#define XB_XSUB(j)  (1280 + 64 * (j))
#define XB_XGEN(j)  (2304 + 64 * (j))
#define XB_TOP      3328
#define XB_TOPGEN   3392
#define XCD_BAR_WORDS 3456
#define XB_SPIN_CAP (1u << 20)
__device__ __forceinline__ unsigned xb_ld(unsigned* p)              { return __hip_atomic_load(p, __ATOMIC_RELAXED, __HIP_MEMORY_SCOPE_AGENT); }
__device__ __forceinline__ unsigned xb_add(unsigned* p, unsigned v) { return __hip_atomic_fetch_add(p, v, __ATOMIC_RELAXED, __HIP_MEMORY_SCOPE_AGENT); }
__device__ __forceinline__ unsigned xb_xcc_id() { return (unsigned)__builtin_amdgcn_s_getreg((3 << 11) | 20) & 0xFu; }
#define XB_SPIN(cond, bar) do { unsigned _sp = 0; while (cond) { __builtin_amdgcn_s_sleep(1); \
    if ((++_sp & 255u) == 0u) { if (xb_ld(&(bar)[XB_TMO])) break; if (_sp > XB_SPIN_CAP) { atomicAdd(&(bar)[XB_TMO], 1u); break; } } } } while (0)
struct XcdBarrier { unsigned* bar; unsigned x; volatile LAS unsigned* st; };
__device__ __forceinline__ XcdBarrier xcd_barrier_post(unsigned* bar, volatile LAS unsigned* st) {
    XcdBarrier b; b.bar = bar; b.x = xb_xcc_id(); b.st = st;
    if (threadIdx.x == 0) (void)xb_add(&bar[XB_XCNT(b.x)], 1u);
    return b;
}
__device__ __forceinline__ void xcd_barrier_complete(unsigned* bar, unsigned x, unsigned& nloc, unsigned& nx) {
    const unsigned G = gridDim.x * gridDim.y * gridDim.z;
    unsigned sum, cnt, mine, sp = 0u;
    for (;;) {
        sum = 0u; cnt = 0u; mine = 0u;
#pragma unroll
        for (unsigned j = 0; j < 16; ++j) { const unsigned c = xb_ld(&bar[XB_XCNT(j)]); sum += c; cnt += (c > 0u) ? 1u : 0u; mine = (j == x) ? c : mine; }
        if (sum == G) break;
        __builtin_amdgcn_s_sleep(1);
        if ((++sp & 255u) == 0u) { if (xb_ld(&bar[XB_TMO])) break; if (sp > XB_SPIN_CAP) { atomicAdd(&bar[XB_TMO], 1u); break; } }
    }
    nloc = mine > 0u ? mine : 1u; nx = cnt > 0u ? cnt : 1u;
}
__device__ __forceinline__ void xcd_barrier(const XcdBarrier& b) {
    asm volatile("s_waitcnt vmcnt(0)" ::: "memory");
    __syncthreads();
    if (threadIdx.x == 0) {
        unsigned* bar = b.bar;
        __builtin_amdgcn_s_waitcnt(0);
        unsigned nloc = b.st[0], nx = b.st[1];
        if (nloc == 0u) { xcd_barrier_complete(bar, b.x, nloc, nx); b.st[0] = nloc; b.st[1] = nx; }
        const unsigned old = xb_add(&bar[XB_XSUB(b.x)], 1u);
        const unsigned gen = old / nloc;
        if (old + 1u == (gen + 1u) * nloc) {
            __builtin_amdgcn_fence(__ATOMIC_RELEASE, "agent");
            asm volatile("s_waitcnt vmcnt(0)" ::: "memory");
            const unsigned og = xb_add(&bar[XB_TOP], 1u);
            const unsigned tg = og / nx;
            if (og + 1u == (tg + 1u) * nx) xb_add(&bar[XB_TOPGEN], 1u);
            else XB_SPIN(xb_ld(&bar[XB_TOPGEN]) == tg, bar);
            __builtin_amdgcn_fence(__ATOMIC_ACQUIRE, "agent");
            xb_add(&bar[XB_XGEN(b.x)], 1u);
            asm volatile("s_waitcnt vmcnt(0)" ::: "memory");
        } else {
            XB_SPIN(xb_ld(&bar[XB_XGEN(b.x)]) == gen, bar);
            __builtin_amdgcn_fence(__ATOMIC_ACQUIRE, "agent");
            asm volatile("s_waitcnt vmcnt(0)" ::: "memory");
        }
    }
    __syncthreads();
}

namespace pg8 {
constexpr int BM = 256, BK = 64, HALF = 128, HTB = HALF * BK * 2, STAGE_BYTES = 8 * HTB, NXCD = 8, WGM = 8;
__host__ __device__ __forceinline__ int lds_byte(int r, int c) { const int st = (r >> 4) * 2 + (c >> 5), rr = r & 15, cc = c & 31, ob = rr * 64 + cc * 2; return st * 1024 + (ob ^ (((ob >> 9) & 1) << 5)); }
__host__ __device__ __forceinline__ void stage_rc(int b, int& R, int& C) { const int st = b / 1024, sb = b % 1024, swz = sb ^ (((sb >> 9) & 1) << 5); R = (st >> 1) * 16 + swz / 64; C = (st & 1) * 32 + (swz % 64) / 2; }
__host__ __device__ __forceinline__ int perm32(int rho) { const int n = rho >> 4, i = rho & 15; return 8 * (i >> 2) + 4 * n + (i & 3); }
struct Unit { int pm, pn, koff; };
struct Gemm { const bf16_t* A; const bf16_t* Bt; int ld, K; };
struct StaticOrder {
    int nM, nN, nwg, G, c;
    __device__ void init(int M, int N, int G_, int c_) { nM = M / BM; nN = N / BM; nwg = nM * nN; G = G_; c = c_; }
    __device__ __forceinline__ void tile(int L, Unit& u) const {
        int wgid = L; { const int q = nwg / NXCD, r = nwg % NXCD, xcd = wgid % NXCD, off = wgid / NXCD; wgid = (xcd < r ? xcd * (q + 1) : r * (q + 1) + (xcd - r) * q) + off; }
        const int nig = WGM * nN, gid = wgid / nig, fm = gid * WGM, gsz = (nM - fm) < WGM ? (nM - fm) : WGM;
        u.pm = fm + ((wgid % nig) % gsz); u.pn = (wgid % nig) / gsz; u.koff = 0;
    }
    __device__ __forceinline__ bool next(int i, Unit& u) const { const long L = (long)i * G + c; if (L >= nwg) return false; tile((int)L, u); return true; }
};
struct TwoHalfOrder : StaticOrder {
    __device__ __forceinline__ bool next(int i, Unit& u) const { const long L = (long)(i >> 1) * G + c; if (L >= nwg) return false; tile((int)L, u); u.koff = (i & 1) * 1024; return true; }
};

template <class Epi, class Sched>
__device__ __forceinline__ void gemm_phase(LAS unsigned char* lds, const Gemm g, const Sched& S, const Epi& E) {
    const int tid = threadIdx.x, wid = __builtin_amdgcn_readfirstlane(tid >> 6), lane = tid & 63, wr = wid >> 2, wc = wid & 3, fr = lane & 15, fq = lane >> 4;
    const int K = g.K, nt = K / BK, ld = g.ld;
    unsigned voffA[2], voffB[2];
#pragma unroll
    for (int i = 0; i < 2; ++i) { int R, C; stage_rc(tid * 16 + i * 8192, R, C); const int Rb = Epi::PERM ? ((R & ~31) + perm32(R & 31)) : R;
        voffA[i] = (unsigned)(R * ld + C) * 2u; voffB[i] = (unsigned)(Rb * ld + C) * 2u; }
    const size_t kstep = (size_t)(BK * 2);
    const size_t hstep = (size_t)HALF * ld * 2;
    const size_t tstep = 2 * hstep;
    const unsigned ldsw = (unsigned)wid * 1024u;
    const int aoff = lds_byte(wr * 64 + fr, fq * 8), boff = lds_byte(wc * 32 + fr, fq * 8);
#define PG8_SA(b, h) (((b) * 2 + (h)) * HTB)
#define PG8_SB(b, h) ((4 + (b) * 2 + (h)) * HTB)
#define PG8_STAGE(bufoff, gbase, voff) do { _Pragma("unroll") for (int _i = 0; _i < 2; ++_i) \
        __builtin_amdgcn_global_load_lds((const unsigned*)((const char*)(gbase) + (voff)[_i]), (LAS unsigned*)(lds + (bufoff) + ldsw + _i * 8192), 16, 0, 0); } while (0)
#define PG8_LDA(dst, b, h) do { _Pragma("unroll") for (int m = 0; m < 4; ++m) _Pragma("unroll") for (int k = 0; k < 2; ++k) dst[m][k] = *(const LAS bf16x8*)(lds + PG8_SA(b, h) + aoff + m * 2048 + k * 1024); } while (0)
#define PG8_LDB(dst, b, h) do { _Pragma("unroll") for (int n = 0; n < 2; ++n) _Pragma("unroll") for (int k = 0; k < 2; ++k) dst[n][k] = *(const LAS bf16x8*)(lds + PG8_SB(b, h) + boff + n * 2048 + k * 1024); } while (0)
#define PG8_MMA(ai, bj, At, Bt) do { __builtin_amdgcn_s_setprio(1); _Pragma("unroll") for (int m = 0; m < 4; ++m) _Pragma("unroll") for (int n = 0; n < 2; ++n) _Pragma("unroll") for (int k = 0; k < 2; ++k) \
        acc[ai][bj][m][n] = __builtin_amdgcn_mfma_f32_16x16x32_bf16(Bt[n][k], At[m][k], acc[ai][bj][m][n], 0, 0, 0); __builtin_amdgcn_s_setprio(0); } while (0)
#define PG8_WAIT_V(n) asm volatile("s_waitcnt vmcnt(" #n ")" ::: "memory")
#define PG8_WAIT_L(n) asm volatile("s_waitcnt lgkmcnt(" #n ")" ::: "memory")
#define PG8_BAR __builtin_amdgcn_s_barrier()
#define PG8_SCHED __builtin_amdgcn_sched_barrier(0)
    Unit cur, nxt; int ui = 0;
    if (!S.next(0, cur)) return;
    f32x4 acc[2][2][4][2];
#pragma unroll
    for (int a = 0; a < 2; ++a)
#pragma unroll
        for (int b = 0; b < 2; ++b)
#pragma unroll
            for (int m = 0; m < 4; ++m)
#pragma unroll
                for (int n = 0; n < 2; ++n) acc[a][b][m][n] = (f32x4){0.f, 0.f, 0.f, 0.f};
    bf16x8 At[4][2], B0[2][2], B1[2][2];
    const char* cA = (const char*)g.A + (size_t)cur.pm * tstep + (size_t)cur.koff * 2; const char* cB = (const char*)g.Bt + (size_t)cur.pn * tstep + (size_t)cur.koff * 2;
    PG8_STAGE(PG8_SB(0, 0), cB, voffB); PG8_STAGE(PG8_SA(0, 0), cA, voffA); PG8_STAGE(PG8_SB(0, 1), cB + hstep, voffB); PG8_STAGE(PG8_SA(0, 1), cA + hstep, voffA);
    if (wr == 1) PG8_BAR;
    PG8_WAIT_V(4); PG8_BAR;
    PG8_STAGE(PG8_SB(1, 0), cB + kstep, voffB); PG8_STAGE(PG8_SA(1, 0), cA + kstep, voffA); PG8_STAGE(PG8_SB(1, 1), cB + hstep + kstep, voffB);
    PG8_WAIT_V(6); PG8_BAR;
    for (;;) {
        const bool has_next = S.next(ui + 1, nxt);
        const char* nA = has_next ? (const char*)g.A + (size_t)nxt.pm * tstep + (size_t)nxt.koff * 2 : cA; const char* nB = has_next ? (const char*)g.Bt + (size_t)nxt.pn * tstep + (size_t)nxt.koff * 2 : cB;
        for (int t = 0; t < nt; t += 2) {
            const bool last = (t == nt - 2);
            const char* a1 = cA + (size_t)(t + 1) * kstep;
            const char* a2 = last ? nA : cA + (size_t)(t + 2) * kstep; const char* b2 = last ? nB : cB + (size_t)(t + 2) * kstep;
            const char* a3 = a2 + kstep; const char* b3 = b2 + kstep;
            PG8_LDB(B0, 0, 0); PG8_SCHED; PG8_LDA(At, 0, 0); PG8_STAGE(PG8_SA(1, 1), a1 + hstep, voffA);
            PG8_WAIT_L(8); PG8_BAR; PG8_WAIT_L(0); PG8_MMA(0, 0, At, B0); PG8_BAR; PG8_SCHED;
            PG8_LDB(B1, 0, 1); PG8_STAGE(PG8_SB(0, 0), b2, voffB);
            PG8_BAR; PG8_WAIT_L(0); PG8_MMA(0, 1, At, B1); PG8_BAR;
            PG8_LDA(At, 0, 1); PG8_STAGE(PG8_SA(0, 0), a2, voffA);
            PG8_BAR; PG8_WAIT_L(0); PG8_MMA(1, 0, At, B0); PG8_BAR; PG8_SCHED;
            PG8_STAGE(PG8_SB(0, 1), b2 + hstep, voffB);
            PG8_WAIT_V(6); PG8_BAR; PG8_MMA(1, 1, At, B1); PG8_BAR;
            PG8_LDB(B0, 1, 0); PG8_SCHED; PG8_LDA(At, 1, 0); PG8_STAGE(PG8_SA(0, 1), a2 + hstep, voffA);
            PG8_WAIT_L(8); PG8_BAR; PG8_WAIT_L(0); PG8_MMA(0, 0, At, B0); PG8_BAR; PG8_SCHED;
            PG8_LDB(B1, 1, 1); PG8_STAGE(PG8_SB(1, 0), b3, voffB);
            PG8_BAR; PG8_WAIT_L(0); PG8_MMA(0, 1, At, B1); PG8_BAR;
            PG8_LDA(At, 1, 1); PG8_STAGE(PG8_SA(1, 0), a3, voffA);
            PG8_BAR; PG8_WAIT_L(0); PG8_MMA(1, 0, At, B0); PG8_BAR; PG8_SCHED;
            PG8_STAGE(PG8_SB(1, 1), b3 + hstep, voffB);
            PG8_WAIT_V(6); PG8_BAR; PG8_MMA(1, 1, At, B1); PG8_BAR;
        }
        E(acc, cur, wr, wc, fr, fq);
        if (!has_next) break;
#pragma unroll
        for (int a = 0; a < 2; ++a)
#pragma unroll
            for (int b = 0; b < 2; ++b)
#pragma unroll
                for (int m = 0; m < 4; ++m)
#pragma unroll
                    for (int n = 0; n < 2; ++n) acc[a][b][m][n] = (f32x4){0.f, 0.f, 0.f, 0.f};
        cur = nxt; cA = nA; cB = nB; ++ui;
    }
    PG8_WAIT_V(0);
    if (wr == 0) PG8_BAR;
    PG8_BAR;
#undef PG8_SA
#undef PG8_SB
#undef PG8_STAGE
#undef PG8_LDA
#undef PG8_LDB
#undef PG8_MMA
#undef PG8_WAIT_V
#undef PG8_WAIT_L
#undef PG8_BAR
#undef PG8_SCHED
}
}

struct EpiP {
    static constexpr bool PERM = true;
    bf16_t* P;
    __device__ __forceinline__ void operator()(const f32x4 (&acc)[2][2][4][2], const pg8::Unit& u, int wr, int wc, int fr, int fq) const {
        const int row0 = u.pm * 256 + wr * 64 + fr, col0 = u.pn * 256 + wc * 32 + 8 * fq;
        const int act = ((u.pn >= 4 && u.pn < 8) || (u.pn >= 20 && u.pn < 24)) ? 1 : ((u.pn >= 24 && u.pn < 40) ? 2 : 0);
#pragma unroll
        for (int ai = 0; ai < 2; ++ai)
#pragma unroll
            for (int m = 0; m < 4; ++m) { bf16_t* rowp = P + (size_t)(row0 + ai * 128 + m * 16) * LDP + col0;
#pragma unroll
                for (int bj = 0; bj < 2; ++bj) { f32x4 v0 = acc[ai][bj][m][0], v1 = acc[ai][bj][m][1];
                    if (act == 1) {
#pragma unroll
                        for (int j = 0; j < 4; ++j) { v0[j] = siluf_(v0[j]); v1[j] = siluf_(v1[j]); } }
                    else if (act == 2) {
#pragma unroll
                        for (int j = 0; j < 4; ++j) { v0[j] = sigmoidf_(v0[j]); v1[j] = sigmoidf_(v1[j]); } }
                    u32x4 w; w.x = cvt_pk_bf16(v0[0], v0[1]); w.y = cvt_pk_bf16(v0[2], v0[3]); w.z = cvt_pk_bf16(v1[0], v1[1]); w.w = cvt_pk_bf16(v1[2], v1[3]);
                    *(u32x4*)(rowp + bj * 128) = w; } }
    }
};
struct EpiGlu {
    static constexpr bool PERM = true;
    const bf16_t* Yg; const bf16_t* P; const float* bglu; bf16_t* A2;
    __device__ __forceinline__ void operator()(const f32x4 (&acc)[2][2][4][2], const pg8::Unit& u, int wr, int wc, int fr, int fq) const {
        const int row0 = u.pm * 256 + wr * 64 + fr, col0 = u.pn * 256 + wc * 32 + 8 * fq;
        f32x4 bv[2][2];
#pragma unroll
        for (int bj = 0; bj < 2; ++bj)
#pragma unroll
            for (int n = 0; n < 2; ++n) bv[bj][n] = *(const f32x4*)(bglu + col0 + bj * 128 + 4 * n);
#pragma unroll
        for (int ai = 0; ai < 2; ++ai)
#pragma unroll
            for (int m = 0; m < 4; ++m) { const size_t row = (size_t)(row0 + ai * 128 + m * 16);
#pragma unroll
                for (int bj = 0; bj < 2; ++bj) { const int c = col0 + bj * 128;
                    const u32x4 yg = *(const u32x4*)(Yg + row * 1024 + c), sz = *(const u32x4*)(P + row * LDP + PC_ZS + c);
                    const f32x4 a0 = acc[ai][bj][m][0] + bv[bj][0], a1 = acc[ai][bj][m][1] + bv[bj][1];
                    float o[8];
                    o[0] = bf_lo(yg.x) * sigmoidf_(a0[0]) * bf_lo(sz.x); o[1] = bf_hi(yg.x) * sigmoidf_(a0[1]) * bf_hi(sz.x);
                    o[2] = bf_lo(yg.y) * sigmoidf_(a0[2]) * bf_lo(sz.y); o[3] = bf_hi(yg.y) * sigmoidf_(a0[3]) * bf_hi(sz.y);
                    o[4] = bf_lo(yg.z) * sigmoidf_(a1[0]) * bf_lo(sz.z); o[5] = bf_hi(yg.z) * sigmoidf_(a1[1]) * bf_hi(sz.z);
                    o[6] = bf_lo(yg.w) * sigmoidf_(a1[2]) * bf_lo(sz.w); o[7] = bf_hi(yg.w) * sigmoidf_(a1[3]) * bf_hi(sz.w);
                    u32x4 w; w.x = cvt_pk_bf16(o[0], o[1]); w.y = cvt_pk_bf16(o[2], o[3]); w.z = cvt_pk_bf16(o[4], o[5]); w.w = cvt_pk_bf16(o[6], o[7]);
                    *(u32x4*)(A2 + row * 2048 + c) = w; } }
    }
};
struct EpiOut {
    static constexpr bool PERM = false;
    const bf16_t* P; const float* xp; const float* xs; const float* mod; float* out; float* rowss;
    __device__ __forceinline__ void operator()(const f32x4 (&acc)[2][2][4][2], const pg8::Unit& u, int wr, int wc, int fr, int fq) const {
        const int row0 = u.pm * 256 + wr * 64 + fr, col0 = u.pn * 256 + wc * 32 + 4 * fq;
        const bool second = u.koff != 0;
#pragma unroll
        for (int ai = 0; ai < 2; ++ai) {
            if (u.pm * 256 + ai * 128 >= MV) continue;
#pragma unroll
            for (int m = 0; m < 4; ++m) { const int row = row0 + ai * 128 + m * 16;
                float* orow = out + (size_t)row * DM + col0;
                const bf16_t* prow = P + (size_t)row * LDP + (second ? PC_GR : PC_GS) + col0;
                if (!second) {
#pragma unroll
                    for (int bj = 0; bj < 2; ++bj)
#pragma unroll
                        for (int n = 0; n < 2; ++n) { const u32x2 gg = *(const u32x2*)(prow + bj * 128 + n * 16); const f32x4 a = acc[ai][bj][m][n];
                            f32x4 t; t[0] = bf_lo(gg.x) * a[0]; t[1] = bf_hi(gg.x) * a[1]; t[2] = bf_lo(gg.y) * a[2]; t[3] = bf_hi(gg.y) * a[3];
                            *(f32x4*)(orow + bj * 128 + n * 16) = t; }
                } else {
                    const float* xrow = (row < MP) ? xp + (size_t)row * DM + col0 : xs + (size_t)(row - MP) * DM + col0;
                    const int mrow = (row < MP) ? (row >> 11) : (NB + row - MP);
                    const float* gtrow = mod + (size_t)mrow * NMOD + 2 * DM + col0;
                    float ss = 0.f;
#pragma unroll
                    for (int bj = 0; bj < 2; ++bj)
#pragma unroll
                        for (int n = 0; n < 2; ++n) { const int o = bj * 128 + n * 16; const u32x2 gg = *(const u32x2*)(prow + o); const f32x4 a = acc[ai][bj][m][n];
                            const f32x4 t = *(const f32x4*)(orow + o), xv = *(const f32x4*)(xrow + o), gt = *(const f32x4*)(gtrow + o);
                            f32x4 r; r[0] = xv[0] + gt[0] * (t[0] + bf_lo(gg.x) * a[0]); r[1] = xv[1] + gt[1] * (t[1] + bf_hi(gg.x) * a[1]);
                            r[2] = xv[2] + gt[2] * (t[2] + bf_lo(gg.y) * a[2]); r[3] = xv[3] + gt[3] * (t[3] + bf_hi(gg.y) * a[3]);
                            ss += (r[0] * r[0] + r[1] * r[1]) + (r[2] * r[2] + r[3] * r[3]);
                            *(f32x4*)(orow + o) = r; }
                    ss += __shfl_xor(ss, 16); ss += __shfl_xor(ss, 32);
                    if (fq == 0) rowss[(size_t)row * 32 + u.pn * 4 + wc] = ss;
                }
            }
        }
    }
};

struct Args { const float* in[34]; float* out; unsigned char* ws; int ph_lo, ph_hi, li, pad; };
enum { I_XP = 0, I_XS, I_CP, I_CS, I_S5RE, I_S5IM, I_WKV, I_SHIFT, I_NORMG, I_WADA, I_BADA, I_WIN, I_MU, I_ARE, I_AIM, I_LOGSTEP, I_BRE, I_BIM, I_CRE, I_CIM, I_DSKIP,
       I_WGLU, I_BGLU, I_W0, I_W2, I_A0, I_A2, I_KK, I_KA, I_RK, I_GNW, I_GNB, I_WOUT, I_FINALG };

__device__ __forceinline__ void transpose_item(const float* W, int ldw, int K, int csrc, bf16_t* WT, int rdst, int k0, LAS float* scr, int lane, bool zero) {
    if (zero) {
#pragma unroll
        for (int j = 0; j < 4; ++j) { const int n = (lane >> 3) + 8 * j; *(u32x4*)(WT + (size_t)(rdst + n) * K + k0 + 8 * (lane & 7)) = (u32x4){0u, 0u, 0u, 0u}; }
        return;
    }
#pragma unroll 8
    for (int i = 0; i < 32; ++i) { const int kk = 2 * i + (lane >> 5); scr[kk * 33 + (lane & 31)] = W[(size_t)(k0 + kk) * ldw + csrc + (lane & 31)]; }
    LDS_WAIT(); asm volatile("" ::: "memory");
    const int c = lane & 7;
#pragma unroll
    for (int j = 0; j < 4; ++j) { const int n = (lane >> 3) + 8 * j; const LAS float* s = scr + (8 * c) * 33 + n;
        u32x4 o; o.x = cvt_pk_bf16(s[0 * 33], s[1 * 33]); o.y = cvt_pk_bf16(s[2 * 33], s[3 * 33]); o.z = cvt_pk_bf16(s[4 * 33], s[5 * 33]); o.w = cvt_pk_bf16(s[6 * 33], s[7 * 33]);
        *(u32x4*)(WT + (size_t)(rdst + n) * K + k0 + 8 * c) = o; }
    LDS_WAIT(); asm volatile("" ::: "memory");
}

__device__ __forceinline__ void p0_mod(const Args& a, LAS unsigned char* lds, int s, int wave, int lane) {
    const float* cp = a.in[I_CP]; const float* cs = a.in[I_CS]; const float* W = a.in[I_WADA]; const float* bias = a.in[I_BADA];
    float* mod = (float*)(a.ws + WS_MOD);
    const int n0 = 32 * s, k0 = 256 * wave, r31 = lane & 31, h = lane >> 5;
    f32x16 acc[5];
#pragma unroll
    for (int t = 0; t < 5; ++t)
#pragma unroll
        for (int r = 0; r < 16; ++r) acc[t][r] = 0.f;
    for (int ks = 0; ks < 16; ++ks) {
        const int kb = k0 + 16 * ks + 8 * h;
        float bw[8];
#pragma unroll
        for (int j = 0; j < 8; ++j) bw[j] = W[(size_t)(kb + j) * NMOD + n0 + r31];
        bf16x8 bfr; { u32x4 t; t.x = cvt_pk_bf16(bw[0], bw[1]); t.y = cvt_pk_bf16(bw[2], bw[3]); t.z = cvt_pk_bf16(bw[4], bw[5]); t.w = cvt_pk_bf16(bw[6], bw[7]); bfr = __builtin_bit_cast(bf16x8, t); }
#pragma unroll
        for (int t = 0; t < 5; ++t) {
            const int R = 32 * t + r31;
            f32x4 c0 = (f32x4){0.f, 0.f, 0.f, 0.f}, c1 = c0;
            if (R < NMODROWS) { const float* src = (R < NB) ? cp + (size_t)R * DM + kb : cs + (size_t)(R - NB) * DM + kb; c0 = *(const f32x4*)src; c1 = *(const f32x4*)(src + 4); }
            u32x4 w; w.x = cvt_pk_bf16(siluf_(c0[0]), siluf_(c0[1])); w.y = cvt_pk_bf16(siluf_(c0[2]), siluf_(c0[3])); w.z = cvt_pk_bf16(siluf_(c1[0]), siluf_(c1[1])); w.w = cvt_pk_bf16(siluf_(c1[2]), siluf_(c1[3]));
            acc[t] = __builtin_amdgcn_mfma_f32_32x32x16_bf16(__builtin_bit_cast(bf16x8, w), bfr, acc[t], 0, 0, 0);
        }
    }
    LAS float* red = (LAS float*)lds;
#pragma unroll
    for (int step = 4; step >= 1; step >>= 1) {
        if (wave >= step && wave < 2 * step) {
#pragma unroll
            for (int t = 0; t < 5; ++t)
#pragma unroll
                for (int r = 0; r < 16; ++r) red[(((wave - step) * 5 + t) * 16 + r) * 64 + lane] = acc[t][r];
        }
        __syncthreads();
        if (wave < step) {
#pragma unroll
            for (int t = 0; t < 5; ++t)
#pragma unroll
                for (int r = 0; r < 16; ++r) acc[t][r] += red[((wave * 5 + t) * 16 + r) * 64 + lane];
        }
        __syncthreads();
    }
    if (wave == 0) {
        const float bc = bias[n0 + r31];
#pragma unroll
        for (int t = 0; t < 5; ++t)
#pragma unroll
            for (int r = 0; r < 16; ++r) { const int R = 32 * t + (r & 3) + 8 * (r >> 2) + 4 * h; if (R < NMODROWS) mod[(size_t)R * NMOD + n0 + r31] = acc[t][r] + bc; }
    }
}

__device__ __forceinline__ void p0_s5_tables(const Args& a, LAS unsigned char* lds, int g, int tid) {
    LAS float* pw = (LAS float*)lds;
    LAS float* bbL = pw + 17 * 128;
    LAS float* ccL = bbL + 2048;
    LAS float* KF = ccL + 2048;
    LAS float* DL = KF + 4096;
    unsigned char* tab = (unsigned char*)a.out + DO_S5TAB + (size_t)g * S5T_BYTES;
    {
        const int p = tid & 63;
        const float step = expf(a.in[I_LOGSTEP][g]);
        const float lre = fminf(a.in[I_ARE][g * 64 + p], -1e-4f), lim = a.in[I_AIM][g * 64 + p];
        const float mag = expf(lre * step); float sn, cs; sincosf(lim * step, &sn, &cs);
        const float abr = mag * cs, abi = mag * sn, den = lre * lre + lim * lim;
        const float fr = ((abr - 1.0f) * lre + abi * lim) / den, fi = (abi * lre - (abr - 1.0f) * lim) / den;
        if (tid < 64) { float pr = 1.f, pi = 0.f;
            for (int e = 0; e <= 16; ++e) { pw[(e * 64 + p) * 2] = pr; pw[(e * 64 + p) * 2 + 1] = pi; const float nr = pr * abr - pi * abi, ni = pr * abi + pi * abr; pr = nr; pi = ni; } }
#pragma unroll
        for (int i = 0; i < 2; ++i) { const int c = (tid >> 6) + 8 * i; const float br = a.in[I_BRE][(g * 64 + p) * 16 + c], bi = a.in[I_BIM][(g * 64 + p) * 16 + c];
            bbL[(p * 16 + c) * 2] = fr * br - fi * bi; bbL[(p * 16 + c) * 2 + 1] = fr * bi + fi * br;
            ccL[(c * 64 + p) * 2] = a.in[I_CRE][(g * 16 + c) * 64 + p]; ccL[(c * 64 + p) * 2 + 1] = a.in[I_CIM][(g * 16 + c) * 64 + p]; }
        if (tid < 16) DL[tid] = a.in[I_DSKIP][g * 16 + tid];
    }
    __syncthreads();
    for (int idx = tid; idx < 4096; idx += 512) { const int e = idx >> 8, c = (idx >> 4) & 15, c2 = idx & 15; float s = 0.f;
        for (int p = 0; p < 64; ++p) { const float cr = ccL[(c * 64 + p) * 2], ci = ccL[(c * 64 + p) * 2 + 1], pr = pw[(e * 64 + p) * 2], pi = pw[(e * 64 + p) * 2 + 1];
            const float ar = cr * pr - ci * pi, ai = cr * pi + ci * pr; s += ar * bbL[(p * 16 + c2) * 2] - ai * bbL[(p * 16 + c2) * 2 + 1]; }
        if (e == 0 && c == c2) s += DL[c];
        KF[idx] = s; }
    __syncthreads();
    for (int it = tid; it < 4096; it += 512) { const int l = it & 63, s = (it >> 6) & 15, mtile = it >> 10; const int m = 32 * mtile + (l & 31), h = l >> 5, p = m & 63, im = m >> 6;
        const float pr = pw[((15 - s) * 64 + p) * 2], pi = pw[((15 - s) * 64 + p) * 2 + 1]; float v[8];
#pragma unroll
        for (int j = 0; j < 8; ++j) { const float br = bbL[(p * 16 + 8 * h + j) * 2], bi = bbL[(p * 16 + 8 * h + j) * 2 + 1]; v[j] = im ? (pr * bi + pi * br) : (pr * br - pi * bi); }
        u32x4 w; w.x = cvt_pk_bf16(v[0], v[1]); w.y = cvt_pk_bf16(v[2], v[3]); w.z = cvt_pk_bf16(v[4], v[5]); w.w = cvt_pk_bf16(v[6], v[7]);
        *(u32x4*)(tab + S5T_ME + (size_t)it * 16) = w; }
    for (int it = tid; it < 1024; it += 512) { const int l = it & 63, ti = it >> 6; const int rho = l & 31, dt = rho >> 4, c = rho & 15, h = l >> 5, e = ti - 1 + dt; float v[8];
#pragma unroll
        for (int j = 0; j < 8; ++j) v[j] = (e < 0) ? 0.f : KF[(e * 16 + c) * 16 + 8 * h + j];
        u32x4 w; w.x = cvt_pk_bf16(v[0], v[1]); w.y = cvt_pk_bf16(v[2], v[3]); w.z = cvt_pk_bf16(v[4], v[5]); w.w = cvt_pk_bf16(v[6], v[7]);
        *(u32x4*)(tab + S5T_KT + (size_t)it * 16) = w; }
    for (int it = tid; it < 4096; it += 512) { const int l = it & 63, ks = (it >> 6) & 7, mt = it >> 9; const int rho = l & 31, dt = rho >> 4, c = rho & 15, h = l >> 5, t = 2 * mt + dt; float v[8];
#pragma unroll
        for (int j = 0; j < 8; ++j) { const int m = 16 * ks + 8 * h + j, p = m & 63; const float cr = ccL[(c * 64 + p) * 2], ci = ccL[(c * 64 + p) * 2 + 1], pr = pw[((t + 1) * 64 + p) * 2], pi = pw[((t + 1) * 64 + p) * 2 + 1];
            v[j] = (m < 64) ? (cr * pr - ci * pi) : -(cr * pi + ci * pr); }
        u32x4 w; w.x = cvt_pk_bf16(v[0], v[1]); w.y = cvt_pk_bf16(v[2], v[3]); w.z = cvt_pk_bf16(v[4], v[5]); w.w = cvt_pk_bf16(v[6], v[7]);
        *(u32x4*)(tab + S5T_CA + (size_t)it * 16) = w; }
    { const int it = tid; const int l = it & 63, sp = (it >> 6) & 1, mtile = it >> 7; const int rho = l & 31, h = l >> 5; float v[8];
#pragma unroll
        for (int j = 0; j < 8; ++j) { const int m = 32 * mtile + 16 * sp + 8 * (j >> 2) + 4 * h + (j & 3), p = m & 63; v[j] = (rho < 16) ? ((m < 64) ? ccL[(rho * 64 + p) * 2] : -ccL[(rho * 64 + p) * 2 + 1]) : 0.f; }
        u32x4 w; w.x = cvt_pk_bf16(v[0], v[1]); w.y = cvt_pk_bf16(v[2], v[3]); w.z = cvt_pk_bf16(v[4], v[5]); w.w = cvt_pk_bf16(v[6], v[7]);
        *(u32x4*)(tab + S5T_C0 + (size_t)it * 16) = w; }
    if (tid < 64) { const int l = tid, rho = l & 31, h = l >> 5; float v[8];
#pragma unroll
        for (int j = 0; j < 8; ++j) v[j] = (rho < 16 && rho == 8 * h + j) ? DL[rho] : 0.f;
        u32x4 w; w.x = cvt_pk_bf16(v[0], v[1]); w.y = cvt_pk_bf16(v[2], v[3]); w.z = cvt_pk_bf16(v[4], v[5]); w.w = cvt_pk_bf16(v[6], v[7]);
        *(u32x4*)(tab + S5T_DF + (size_t)l * 16) = w;
        float* hdr = (float*)(tab + S5T_HDR);
        hdr[l] = pw[(16 * 64 + l) * 2]; hdr[64 + l] = pw[(16 * 64 + l) * 2 + 1]; hdr[128 + l] = pw[(64 + l) * 2]; hdr[192 + l] = pw[(64 + l) * 2 + 1]; }
    __syncthreads();
}

__device__ __forceinline__ void p1_row(const Args& a, int m, int lane) {
    bf16_t* XN = (bf16_t*)(a.ws + WS_XN) + (size_t)m * DM;
    if (m >= MV) {
        const float* src = a.in[I_SHIFT] + (size_t)(m - MV) * DM;
#pragma unroll
        for (int j = 0; j < 8; ++j) { const f32x4 v = *(const f32x4*)(src + 4 * lane + 256 * j); u32x2 w; w.x = cvt_pk_bf16(v[0], v[1]); w.y = cvt_pk_bf16(v[2], v[3]); *(u32x2*)(XN + 4 * lane + 256 * j) = w; }
        return;
    }
    const float* x = (m < MP) ? a.in[I_XP] + (size_t)m * DM : a.in[I_XS] + (size_t)(m - MP) * DM;
    const int mrow = (m < MP) ? (m >> 11) : (NB + m - MP);
    const float* mod = (const float*)(a.ws + WS_MOD) + (size_t)mrow * NMOD;
    const float* g = a.in[I_NORMG];
    f32x4 v[8]; float ss = 0.f;
#pragma unroll
    for (int j = 0; j < 8; ++j) { v[j] = *(const f32x4*)(x + 4 * lane + 256 * j); ss += (v[j][0] * v[j][0] + v[j][1] * v[j][1]) + (v[j][2] * v[j][2] + v[j][3] * v[j][3]); }
    const float rstd = rsqrtf(wave_sum(ss) * (1.0f / DM) + RMS_EPS);
    float* sh_out = nullptr;
    if (m >= MP) sh_out = a.out + OUT_SHIFT_S + (size_t)(m - MP) * DM;
    else if ((m & (SEQ - 1)) == SEQ - 1) sh_out = a.out + OUT_SHIFT_P + (size_t)(m >> 11) * DM;
#pragma unroll
    for (int j = 0; j < 8; ++j) { const int k = 4 * lane + 256 * j; const f32x4 gv = *(const f32x4*)(g + k), sh = *(const f32x4*)(mod + k), sc = *(const f32x4*)(mod + DM + k);
        f32x4 hv;
#pragma unroll
        for (int q = 0; q < 4; ++q) hv[q] = v[j][q] * rstd * gv[q] * (1.0f + sc[q]) + sh[q];
        u32x2 w; w.x = cvt_pk_bf16(hv[0], hv[1]); w.y = cvt_pk_bf16(hv[2], hv[3]); *(u32x2*)(XN + k) = w;
        if (sh_out) *(f32x4*)(sh_out + k) = hv; }
}

constexpr int RW_TB = 32;
constexpr int RW_KK = 0, RW_DR = 2048, RW_DD = 4096, RW_BB = 6144, RW_KP = 8192, RW_VV = 10240, RW_SC = 11264, RW_LW = 11392, RW_LA = 13440, RW_OB = 15488, RW_BVB = 16512, RW_END = 17536;
__device__ __forceinline__ void lerp8(const bf16_t* cur, const bf16_t* prev, bool has_prev, const float* mu, float (&o)[8]) {
    const u32x4 c = *(const u32x4*)cur; u32x4 p = (u32x4){0u, 0u, 0u, 0u}; if (has_prev) p = *(const u32x4*)prev;
    const f32x4 m0 = *(const f32x4*)mu, m1 = *(const f32x4*)(mu + 4);
    const float cf[8] = {bf_lo(c.x), bf_hi(c.x), bf_lo(c.y), bf_hi(c.y), bf_lo(c.z), bf_hi(c.z), bf_lo(c.w), bf_hi(c.w)};
    const float pf[8] = {bf_lo(p.x), bf_hi(p.x), bf_lo(p.y), bf_hi(p.y), bf_lo(p.z), bf_hi(p.z), bf_lo(p.w), bf_hi(p.w)};
    const float mf[8] = {m0[0], m0[1], m0[2], m0[3], m1[0], m1[1], m1[2], m1[3]};
#pragma unroll
    for (int j = 0; j < 8; ++j) o[j] = cf[j] + (pf[j] - cf[j]) * mf[j];
}
struct RwTok { float kk, dr, dd, bb, kp, v, br, kr, bonus; };
__device__ __forceinline__ RwTok rw_token(const Args& a, int hj, float r, float k, float v, float lw, float la) {
    RwTok o;
    const float wpre = a.in[I_W0][hj] + lw;
    const float nz = -wpre;
    const float sp = fmaxf(nz, 0.f) + log1pf(__expf(-fabsf(nz)));
    const float w = -sp - 0.5f;
    o.dd = __expf(-__expf(w));
    const float av = sigmoidf_(a.in[I_A0][hj] + la);
    const float kkv = k * a.in[I_KK][hj];
    const float nrm = sqrtf(wave_sum(kkv * kkv));
    o.kk = kkv / fmaxf(nrm, 1e-12f);
    o.kp = k * (1.0f + (av - 1.0f) * a.in[I_KA][hj]);
    o.bb = o.kk * av;
    o.dr = o.dd * r;
    o.v = v;
    o.br = wave_sum(o.bb * r);
    o.kr = wave_sum(o.kp * r);
    o.bonus = wave_sum(r * o.kp * a.in[I_RK][hj]);
    return o;
}
__device__ __forceinline__ void p3_rwkv_prompt(const Args& a, LAS unsigned char* lds, int unit, int tid, int wave, int lane) {
    const int b = unit >> 5, h = (unit >> 1) & 15, half = unit & 1;
    LAS float* L = (LAS float*)lds;
    const bf16_t* P = (const bf16_t*)(a.ws + WS_P);
    bf16_t* ORAW = (bf16_t*)((unsigned char*)a.out + DO_ORAW); bf16_t* BV = (bf16_t*)((unsigned char*)a.out + DO_BV);
    const float* mu = a.in[I_MU];
    const int r31 = lane & 31, hh = lane >> 5;
    bf16x8 bfr[4];
    if (wave < 4) { const float* W2 = (wave >> 1) ? a.in[I_A2] : a.in[I_W2]; const int col = h * 64 + 32 * (wave & 1) + r31;
#pragma unroll
        for (int ks = 0; ks < 4; ++ks) { float w[8];
#pragma unroll
            for (int j = 0; j < 8; ++j) w[j] = W2[(size_t)(16 * ks + 8 * hh + j) * 1024 + col];
            u32x4 t; t.x = cvt_pk_bf16(w[0], w[1]); t.y = cvt_pk_bf16(w[2], w[3]); t.z = cvt_pk_bf16(w[4], w[5]); t.w = cvt_pk_bf16(w[6], w[7]); bfr[ks] = __builtin_bit_cast(bf16x8, t); } }
    const int srow = 4 * wave + (lane >> 4), cq = lane & 15;
    f32x4 S = (f32x4){0.f, 0.f, 0.f, 0.f};
    for (int t0 = 0; t0 < SEQ; t0 += RW_TB) {
        const size_t rowbase = (size_t)b * SEQ + t0;
        if (wave < 4) { const int mat = wave >> 1, nt2 = wave & 1; const size_t row = rowbase + r31; const bool hp = (t0 + r31) > 0;
            f32x16 acc;
#pragma unroll
            for (int r = 0; r < 16; ++r) acc[r] = 0.f;
#pragma unroll
            for (int ks = 0; ks < 4; ++ks) { const int col = PC_WD + mat * 64 + 16 * ks + 8 * hh; float x8[8];
                lerp8(P + row * LDP + col, P + (row - 1) * LDP + col, hp, mu + 3072 + mat * 64 + 16 * ks + 8 * hh, x8);
                if (mat == 0) {
#pragma unroll
                    for (int j = 0; j < 8; ++j) x8[j] = tanhf_(x8[j]); }
                u32x4 t; t.x = cvt_pk_bf16(x8[0], x8[1]); t.y = cvt_pk_bf16(x8[2], x8[3]); t.z = cvt_pk_bf16(x8[4], x8[5]); t.w = cvt_pk_bf16(x8[6], x8[7]);
                acc = __builtin_amdgcn_mfma_f32_32x32x16_bf16(__builtin_bit_cast(bf16x8, t), bfr[ks], acc, 0, 0, 0); }
            LAS float* dst = L + (mat ? RW_LA : RW_LW);
#pragma unroll
            for (int r = 0; r < 16; ++r) { const int tl = (r & 3) + 8 * (r >> 2) + 4 * hh; dst[tl * 64 + 32 * nt2 + r31] = acc[r]; } }
        __syncthreads();
#pragma unroll
        for (int q = 0; q < 4; ++q) { const int tl = wave * 4 + q; const size_t row = rowbase + tl; const bool hp = (t0 + tl) > 0; const int hj = h * 64 + lane;
            const bf16_t* pc = P + row * LDP; const bf16_t* pp = pc - LDP;
            float r = bf2f(pc[PC_R + hj]), k = bf2f(pc[PC_K + hj]), v = bf2f(pc[PC_V + hj]);
            const float pr = hp ? bf2f(pp[PC_R + hj]) : 0.f, pk = hp ? bf2f(pp[PC_K + hj]) : 0.f, pv = hp ? bf2f(pp[PC_V + hj]) : 0.f;
            r += (pr - r) * mu[hj]; k += (pk - k) * mu[1024 + hj]; v += (pv - v) * mu[2048 + hj];
            const RwTok o = rw_token(a, hj, r, k, v, L[RW_LW + tl * 64 + lane], L[RW_LA + tl * 64 + lane]);
            L[RW_KK + tl * 64 + lane] = o.kk; L[RW_DR + tl * 64 + lane] = o.dr; L[RW_DD + tl * 64 + lane] = o.dd; L[RW_BB + tl * 64 + lane] = o.bb; L[RW_KP + tl * 64 + lane] = o.kp;
            if ((lane >> 5) == half) L[RW_VV + tl * 32 + (lane & 31)] = o.v;
            if (lane == 0) { L[RW_SC + tl * 4] = o.br; L[RW_SC + tl * 4 + 1] = o.kr; L[RW_SC + tl * 4 + 2] = o.bonus; } }
        __syncthreads();
#pragma unroll 4
        for (int tl = 0; tl < RW_TB; ++tl) {
            const f32x4 kk4 = *(const LAS f32x4*)(L + RW_KK + tl * 64 + 4 * cq), dr4 = *(const LAS f32x4*)(L + RW_DR + tl * 64 + 4 * cq), d4 = *(const LAS f32x4*)(L + RW_DD + tl * 64 + 4 * cq),
                        b4 = *(const LAS f32x4*)(L + RW_BB + tl * 64 + 4 * cq), k4 = *(const LAS f32x4*)(L + RW_KP + tl * 64 + 4 * cq);
            const float v = L[RW_VV + tl * 32 + srow]; const f32x4 sc = *(const LAS f32x4*)(L + RW_SC + tl * 4);
            float p1 = (S[0] * kk4[0] + S[1] * kk4[1]) + (S[2] * kk4[2] + S[3] * kk4[3]);
            float p2 = (S[0] * dr4[0] + S[1] * dr4[1]) + (S[2] * dr4[2] + S[3] * dr4[3]);
            p1 = row16_sum(p1); p2 = row16_sum(p2);
            const float sa = -p1;
            const float o = p2 + sa * sc[0] + v * sc[1];
#pragma unroll
            for (int j = 0; j < 4; ++j) S[j] = S[j] * d4[j] + sa * b4[j] + v * k4[j];
            if (cq == 0) { L[RW_OB + tl * 32 + srow] = o; L[RW_BVB + tl * 32 + srow] = sc[2] * v; }
        }
        __syncthreads();
        { const int tl = tid >> 4, r2 = 2 * (tid & 15); const size_t off = (rowbase + tl) * 1024 + h * 64 + 32 * half + r2;
          *(unsigned*)(ORAW + off) = cvt_pk_bf16(L[RW_OB + tl * 32 + r2], L[RW_OB + tl * 32 + r2 + 1]);
          *(unsigned*)(BV + off) = cvt_pk_bf16(L[RW_BVB + tl * 32 + r2], L[RW_BVB + tl * 32 + r2 + 1]); }
    }
    *(f32x4*)(a.out + OUT_WKV_P + (((size_t)(b * 16 + h) * 64 + 32 * half + srow) * 64 + 4 * cq)) = S;
    __syncthreads();
}


constexpr int RC_LD = 72, RC_MAT = 64 * RC_LD * 2;
constexpr int RC_QK = 0 * RC_MAT, RC_RT = 1 * RC_MAT, RC_KT = 2 * RC_MAT, RC_BT = 3 * RC_MAT, RC_QKT = 4 * RC_MAT, RC_BHT = 5 * RC_MAT, RC_KHT = 6 * RC_MAT, RC_VT = 7 * RC_MAT,
              RC_AKK = 8 * RC_MAT, RC_ARK = 9 * RC_MAT, RC_ARB = 10 * RC_MAT, RC_TB = 11 * RC_MAT, RC_AKB = 12 * RC_MAT, RC_W1T = 12 * RC_MAT, RC_U1T = 13 * RC_MAT,
              RC_AVT = RC_QK, RC_TF = RC_KT, RC_LWA = RC_AKK, RC_SEG = 14 * RC_MAT;
static_assert(RC_SEG + 2048 <= RING_BYTES, "rwkv chunk lds");
#define MFMA32(a, b, c) __builtin_amdgcn_mfma_f32_32x32x16_bf16((a), (b), (c), 0, 0, 0)
#define MFMA16(a, b, c) __builtin_amdgcn_mfma_f32_16x16x32_bf16((a), (b), (c), 0, 0, 0)
__device__ __forceinline__ bf16x8 lds_frag(LAS unsigned char* lds, int mat, int row, int k0) { return *(const LAS bf16x8*)(lds + mat + (row * RC_LD + k0) * 2); }
__device__ __forceinline__ u32x2 pack4(float a, float b, float c, float d) { u32x2 w; w.x = cvt_pk_bf16(a, b); w.y = cvt_pk_bf16(c, d); return w; }

__device__ __forceinline__ void p3_rwkv_chunks(const Args& a, LAS unsigned char* lds, int bh, int seg, int tid, int wave, int lane) {
    const int b = bh >> 4, h = bh & 15, r31_ = lane & 31, hh_ = lane >> 5, hj = h * 64 + lane;
    const bf16_t* P = (const bf16_t*)(a.ws + WS_P);
    bf16_t* BV = (bf16_t*)((unsigned char*)a.out + DO_BV);
    const float* mu = a.in[I_MU];
    LAS float* SEG = (LAS float*)(lds + RC_SEG);
    bf16x8 bfr[4];
    { const float* W2 = (wave >> 2) ? a.in[I_A2] : a.in[I_W2]; const int col = h * 64 + 32 * (wave & 1) + r31_;
#pragma unroll
      for (int ks = 0; ks < 4; ++ks) { float w[8];
#pragma unroll
          for (int j = 0; j < 8; ++j) w[j] = W2[(size_t)(16 * ks + 8 * hh_ + j) * 1024 + col];
          u32x4 t; t.x = cvt_pk_bf16(w[0], w[1]); t.y = cvt_pk_bf16(w[2], w[3]); t.z = cvt_pk_bf16(w[4], w[5]); t.w = cvt_pk_bf16(w[6], w[7]); bfr[ks] = __builtin_bit_cast(bf16x8, t); } }
    const float w0j = a.in[I_W0][hj], a0j = a.in[I_A0][hj], kkj = a.in[I_KK][hj], kaj = a.in[I_KA][hj], rkj = a.in[I_RK][hj];
    const float mur = mu[hj], muk = mu[1024 + hj], muv = mu[2048 + hj];
#pragma unroll 1
    for (int ci = 0; ci < 8; ++ci) {
        const int chunk = seg * 8 + ci; const size_t rowbase = (size_t)b * SEQ + chunk * 64;
        int r31 = r31_, hh = hh_; asm volatile("" : "+v"(r31), "+v"(hh));
        unsigned char* rwi = a.ws + WS_RWI + (size_t)((bh * 32) + chunk) * RWI_BYTES;
        { const int mat = wave >> 2, mtile = (wave >> 1) & 1, nt2 = wave & 1; const int tl = 32 * mtile + r31; const size_t row = rowbase + tl; const bool hp = (chunk * 64 + tl) > 0;
          f32x16 acc;
#pragma unroll
          for (int r = 0; r < 16; ++r) acc[r] = 0.f;
#pragma unroll
          for (int ks = 0; ks < 4; ++ks) { const int col = PC_WD + mat * 64 + 16 * ks + 8 * hh; float x8[8];
              lerp8(P + row * LDP + col, P + (row - 1) * LDP + col, hp, mu + 3072 + mat * 64 + 16 * ks + 8 * hh, x8);
              if (mat == 0) {
#pragma unroll
                  for (int j = 0; j < 8; ++j) x8[j] = tanhf_(x8[j]); }
              u32x4 t; t.x = cvt_pk_bf16(x8[0], x8[1]); t.y = cvt_pk_bf16(x8[2], x8[3]); t.z = cvt_pk_bf16(x8[4], x8[5]); t.w = cvt_pk_bf16(x8[6], x8[7]);
              acc = MFMA32(__builtin_bit_cast(bf16x8, t), bfr[ks], acc); }
          LAS float* dst = (LAS float*)(lds + RC_LWA) + mat * 64 * 68;
#pragma unroll
          for (int r = 0; r < 16; ++r) { const int t2 = 32 * mtile + (r & 3) + 8 * (r >> 2) + 4 * hh; dst[t2 * 68 + 32 * nt2 + r31] = acc[r]; } }
        __syncthreads();
        float r8[8], kp8[8], kk8[8], bb8[8], v8[8], ld8[8], cs8[8];
        { const LAS float* LW = (const LAS float*)(lds + RC_LWA); const LAS float* LA = LW + 64 * 68;
#pragma unroll
          for (int q = 0; q < 8; ++q) { const int tl = 8 * wave + q; const size_t row = rowbase + tl; const bool hp = (chunk * 64 + tl) > 0;
              const bf16_t* pc = P + row * LDP; const bf16_t* pp = pc - LDP;
              float r = bf2f(pc[PC_R + hj]), k = bf2f(pc[PC_K + hj]), v = bf2f(pc[PC_V + hj]);
              const float pr = hp ? bf2f(pp[PC_R + hj]) : 0.f, pk = hp ? bf2f(pp[PC_K + hj]) : 0.f, pv = hp ? bf2f(pp[PC_V + hj]) : 0.f;
              r += (pr - r) * mur; k += (pk - k) * muk; v += (pv - v) * muv;
              const float wpre = w0j + LW[tl * 68 + lane];
              const float nz = -wpre; const float sp = fmaxf(nz, 0.f) + __logf(1.0f + __expf(-fabsf(nz)));
              ld8[q] = -__expf(-sp - 0.5f);
              const float av = sigmoidf_(a0j + LA[tl * 68 + lane]);
              const float kkv = k * kkj; const float nrm = sqrtf(wave_sum(kkv * kkv));
              kk8[q] = kkv / fmaxf(nrm, 1e-12f); kp8[q] = k * (1.0f + (av - 1.0f) * kaj); bb8[q] = kk8[q] * av; r8[q] = r; v8[q] = v;
              const float bonus = wave_sum(r * kp8[q] * rkj);
              BV[row * 1024 + hj] = f2bf(bonus * v); }
          cs8[0] = ld8[0];
#pragma unroll
          for (int q = 1; q < 8; ++q) cs8[q] = cs8[q - 1] + ld8[q];
          SEG[wave * 64 + lane] = cs8[7]; }
        __syncthreads();
        { float off = 0.f, cL = 0.f;
#pragma unroll
          for (int w2 = 0; w2 < 8; ++w2) { const float sg = SEG[w2 * 64 + lane]; cL += sg; if (w2 < wave) off += sg; }
          if (wave == 0) *(float*)(rwi + RWI_LAM + lane * 4) = __expf(cL);
          float qkT[8], bhT[8], khT[8];
#pragma unroll
          for (int q = 0; q < 8; ++q) { const int tl = 8 * wave + q; const float c = off + cs8[q], cp = c - ld8[q];
              const float ec = __expf(c), ecp = __expf(cp), enc = __expf(-c), eL = __expf(cL - c);
              const float qk = kk8[q] * ecp;
              ((LAS bf16_t*)(lds + RC_QK))[tl * RC_LD + lane] = f2bf(qk); ((LAS bf16_t*)(lds + RC_RT))[tl * RC_LD + lane] = f2bf(r8[q] * ec);
              ((LAS bf16_t*)(lds + RC_KT))[tl * RC_LD + lane] = f2bf(kp8[q] * enc); ((LAS bf16_t*)(lds + RC_BT))[tl * RC_LD + lane] = f2bf(bb8[q] * enc);
              qkT[q] = qk; bhT[q] = bb8[q] * eL; khT[q] = kp8[q] * eL; }
          u32x4 t;
          t.x = cvt_pk_bf16(qkT[0], qkT[1]); t.y = cvt_pk_bf16(qkT[2], qkT[3]); t.z = cvt_pk_bf16(qkT[4], qkT[5]); t.w = cvt_pk_bf16(qkT[6], qkT[7]); *(LAS u32x4*)(lds + RC_QKT + (lane * RC_LD + 8 * wave) * 2) = t;
          t.x = cvt_pk_bf16(bhT[0], bhT[1]); t.y = cvt_pk_bf16(bhT[2], bhT[3]); t.z = cvt_pk_bf16(bhT[4], bhT[5]); t.w = cvt_pk_bf16(bhT[6], bhT[7]); *(LAS u32x4*)(lds + RC_BHT + (lane * RC_LD + 8 * wave) * 2) = t;
          t.x = cvt_pk_bf16(khT[0], khT[1]); t.y = cvt_pk_bf16(khT[2], khT[3]); t.z = cvt_pk_bf16(khT[4], khT[5]); t.w = cvt_pk_bf16(khT[6], khT[7]); *(LAS u32x4*)(lds + RC_KHT + (lane * RC_LD + 8 * wave) * 2) = t;
          t.x = cvt_pk_bf16(v8[0], v8[1]); t.y = cvt_pk_bf16(v8[2], v8[3]); t.z = cvt_pk_bf16(v8[4], v8[5]); t.w = cvt_pk_bf16(v8[6], v8[7]); *(LAS u32x4*)(lds + RC_VT + (lane * RC_LD + 8 * wave) * 2) = t; }
        __syncthreads();
#pragma unroll
        for (int jr = 0; jr < 2; ++jr) { const int job = wave + 8 * jr; if (job < 12) {
            const int mat = job / 3, tt = job % 3, ms = (tt == 2) ? 1 : 0, nt2 = (tt == 0) ? 0 : 1;
            const int X = (mat & 1) ? RC_BT : RC_KT, Y = (mat & 2) ? RC_RT : RC_QK;
            f32x16 acc;
#pragma unroll
            for (int r = 0; r < 16; ++r) acc[r] = 0.f;
#pragma unroll
            for (int ks = 0; ks < 4; ++ks) acc = MFMA32(lds_frag(lds, X, 32 * ms + r31, 16 * ks + 8 * hh), lds_frag(lds, Y, 32 * nt2 + r31, 16 * ks + 8 * hh), acc);
            const int t = 32 * nt2 + r31; const bool incl = (mat & 2) != 0;
#pragma unroll
            for (int g4 = 0; g4 < 4; ++g4) { const int s0 = 32 * ms + 8 * g4 + 4 * hh; float v[4];
#pragma unroll
                for (int e = 0; e < 4; ++e) { const int sx = s0 + e; v[e] = (incl ? (sx <= t) : (sx < t)) ? acc[4 * g4 + e] : 0.f; }
                if (mat == 1) *(LAS f32x4*)(lds + RC_AKB + (t * 72 + s0) * 4) = (f32x4){v[0], v[1], v[2], v[3]};
                else { const int dstm = (mat == 0) ? RC_AKK : ((mat == 2) ? RC_ARK : RC_ARB); *(LAS u32x2*)(lds + dstm + (t * RC_LD + s0) * 2) = pack4(v[0], v[1], v[2], v[3]); } } } }
        __syncthreads();
        LAS float* TF = (LAS float*)(lds + RC_TF); const LAS float* AKB = (const LAS float*)(lds + RC_AKB); LAS float* YS = SEG;
        if (wave == 0) {
            const int I = lane >> 4, jj = lane & 15; float x[16];
#pragma unroll
            for (int r = 0; r < 16; ++r) { float sacc = (r == jj) ? 1.f : 0.f;
#pragma unroll
                for (int q = 0; q < r; ++q) sacc -= AKB[(16 * I + r) * 72 + 16 * I + q] * x[q];
                x[r] = sacc; TF[(16 * I + r) * 72 + 16 * I + jj] = sacc; }
        } else if (wave < 4) {
            const int t2 = tid - 64;
            for (int e = t2; e < 512; e += 192) { const int blk = e >> 8, rr = (e >> 4) & 15, cc = e & 15; TF[(32 * blk + rr) * 72 + 32 * blk + 16 + cc] = 0.f; }
        } else {
            const int mt = (wave >> 1) & 1, nt2 = wave & 1; f32x16 acc;
#pragma unroll
            for (int r = 0; r < 16; ++r) acc[r] = 0.f;
#pragma unroll
            for (int ks = 0; ks < 4; ++ks) if (ks < 2 || mt == 1) acc = MFMA32(lds_frag(lds, RC_AKK, 32 * mt + r31, 16 * ks + 8 * hh), lds_frag(lds, RC_VT, 32 * nt2 + r31, 16 * ks + 8 * hh), acc);
#pragma unroll
            for (int g4 = 0; g4 < 4; ++g4) *(LAS u32x2*)(lds + RC_AVT + ((32 * nt2 + r31) * RC_LD + 32 * mt + 8 * g4 + 4 * hh) * 2) = pack4(acc[4 * g4], acc[4 * g4 + 1], acc[4 * g4 + 2], acc[4 * g4 + 3]);
        }
        __syncthreads();
        { const int pr = tid >> 8, i = (tid >> 4) & 15, jj = tid & 15, ba = 2 * pr, bb = 2 * pr + 1;
          float y = 0.f;
#pragma unroll
          for (int q = 0; q < 16; ++q) y += AKB[(16 * bb + i) * 72 + 16 * ba + q] * TF[(16 * ba + q) * 72 + 16 * ba + jj];
          YS[tid] = y; }
        __syncthreads();
        { const int pr = tid >> 8, i = (tid >> 4) & 15, jj = tid & 15, ba = 2 * pr, bb = 2 * pr + 1; float tv = 0.f;
#pragma unroll
          for (int q = 0; q < 16; ++q) tv -= TF[(16 * bb + i) * 72 + 16 * bb + q] * YS[pr * 256 + q * 16 + jj];
          TF[(16 * bb + i) * 72 + 16 * ba + jj] = tv; }
        __syncthreads();
        { const int i = tid >> 4, j0 = (tid & 15) * 2; float z0 = 0.f, z1 = 0.f;
#pragma unroll 8
          for (int q = 0; q < 32; ++q) { const float av = AKB[(32 + i) * 72 + q]; z0 += av * TF[q * 72 + j0]; z1 += av * TF[q * 72 + j0 + 1]; }
          __syncthreads();
          TF[i * 72 + 32 + j0] = z0; TF[i * 72 + 32 + j0 + 1] = z1; }
        __syncthreads();
        { const int i = tid >> 4, j0 = (tid & 15) * 2; float t0 = 0.f, t1 = 0.f;
#pragma unroll 8
          for (int q = 0; q < 32; ++q) { const float tb = TF[(32 + i) * 72 + 32 + q]; t0 -= tb * TF[q * 72 + 32 + j0]; t1 -= tb * TF[q * 72 + 32 + j0 + 1]; }
          TF[(32 + i) * 72 + j0] = t0; TF[(32 + i) * 72 + j0 + 1] = t1; }
        __syncthreads();
        { const int t = tid >> 3, c0 = (tid & 7) * 8; const f32x4 x0 = *(const LAS f32x4*)(TF + t * 72 + c0), x1 = *(const LAS f32x4*)(TF + t * 72 + c0 + 4);
          u32x4 w; w.x = cvt_pk_bf16(x0[0], x0[1]); w.y = cvt_pk_bf16(x0[2], x0[3]); w.z = cvt_pk_bf16(x1[0], x1[1]); w.w = cvt_pk_bf16(x1[2], x1[3]);
          *(LAS u32x4*)(lds + RC_TB + (t * RC_LD + c0) * 2) = w; }
        __syncthreads();
        { const int which = wave >> 2, mt = (wave >> 1) & 1, nt2 = wave & 1; const int Bm = which ? RC_AVT : RC_QKT, Dm = which ? RC_U1T : RC_W1T; f32x16 acc;
#pragma unroll
          for (int r = 0; r < 16; ++r) acc[r] = 0.f;
#pragma unroll
          for (int ks = 0; ks < 4; ++ks) if (ks < 2 || mt == 1) acc = MFMA32(lds_frag(lds, RC_TB, 32 * mt + r31, 16 * ks + 8 * hh), lds_frag(lds, Bm, 32 * nt2 + r31, 16 * ks + 8 * hh), acc);
#pragma unroll
          for (int g4 = 0; g4 < 4; ++g4) *(LAS u32x2*)(lds + Dm + ((32 * nt2 + r31) * RC_LD + 32 * mt + 8 * g4 + 4 * hh) * 2) = pack4(acc[4 * g4], acc[4 * g4 + 1], acc[4 * g4 + 2], acc[4 * g4 + 3]); }
        __syncthreads();
        { const int kind = wave >> 2, mt = (wave >> 1) & 1, nt2 = wave & 1; const int cidx = 32 * nt2 + r31;
          f32x16 acc;
#pragma unroll
          for (int r = 0; r < 16; ++r) acc[r] = 0.f;
          if (kind == 0) {
#pragma unroll
              for (int ks = 0; ks < 4; ++ks) acc = MFMA32(lds_frag(lds, RC_W1T, 32 * mt + r31, 16 * ks + 8 * hh), lds_frag(lds, RC_BHT, cidx, 16 * ks + 8 * hh), acc);
#pragma unroll
              for (int g4 = 0; g4 < 4; ++g4) { const int jo = 8 * g4 + 4 * hh, half = jo >> 4, q2 = (jo & 15) >> 2; const int blk = (cidx >> 4) * 2 + mt, lane2 = (cidx & 15) + 16 * q2;
                  *(u32x2*)(rwi + RWI_GF + (blk * 64 + lane2) * 16 + half * 8) = pack4(-acc[4 * g4], -acc[4 * g4 + 1], -acc[4 * g4 + 2], -acc[4 * g4 + 3]); }
          } else {
#pragma unroll
              for (int ks = 0; ks < 4; ++ks) if (ks < 2 || nt2 == 1) acc = MFMA32(lds_frag(lds, RC_W1T, 32 * mt + r31, 16 * ks + 8 * hh), lds_frag(lds, RC_ARB, cidx, 16 * ks + 8 * hh), acc);
#pragma unroll
              for (int g4 = 0; g4 < 4; ++g4) { const int jo = 8 * g4 + 4 * hh, half = jo >> 4, q2 = (jo & 15) >> 2; const int blk = (cidx >> 4) * 2 + mt, lane2 = (cidx & 15) + 16 * q2;
                  const u32x2 rt = *(const LAS u32x2*)(lds + RC_RT + (cidx * RC_LD + 32 * mt + jo) * 2);
                  *(u32x2*)(rwi + RWI_W2F + (blk * 64 + lane2) * 16 + half * 8) = pack4(bf_lo(rt.x) - acc[4 * g4], bf_hi(rt.x) - acc[4 * g4 + 1], bf_lo(rt.y) - acc[4 * g4 + 2], bf_hi(rt.y) - acc[4 * g4 + 3]); }
          }
          f32x16 ac1, ac2;
#pragma unroll
          for (int r = 0; r < 16; ++r) { ac1[r] = 0.f; ac2[r] = 0.f; }
          if (kind == 0) {
#pragma unroll
              for (int ks = 0; ks < 4; ++ks) { ac1 = MFMA32(lds_frag(lds, RC_KHT, 32 * mt + r31, 16 * ks + 8 * hh), lds_frag(lds, RC_VT, cidx, 16 * ks + 8 * hh), ac1);
                                               ac2 = MFMA32(lds_frag(lds, RC_BHT, 32 * mt + r31, 16 * ks + 8 * hh), lds_frag(lds, RC_U1T, cidx, 16 * ks + 8 * hh), ac2); }
#pragma unroll
              for (int g4 = 0; g4 < 4; ++g4) { const int ro = 32 * mt + 8 * g4 + 4 * hh, mt2 = ro >> 4, q2 = (ro & 15) >> 2, cb = cidx >> 4, lane2 = (cidx & 15) + 16 * q2;
                  *(f32x4*)(rwi + RWI_H1F + ((cb * 4 + mt2) * 64 + lane2) * 16) = (f32x4){ac1[4 * g4] - ac2[4 * g4], ac1[4 * g4 + 1] - ac2[4 * g4 + 1], ac1[4 * g4 + 2] - ac2[4 * g4 + 2], ac1[4 * g4 + 3] - ac2[4 * g4 + 3]}; }
          } else {
#pragma unroll
              for (int ks = 0; ks < 4; ++ks) if (ks < 2 || nt2 == 1) { ac1 = MFMA32(lds_frag(lds, RC_VT, 32 * mt + r31, 16 * ks + 8 * hh), lds_frag(lds, RC_ARK, cidx, 16 * ks + 8 * hh), ac1);
                                                                        ac2 = MFMA32(lds_frag(lds, RC_U1T, 32 * mt + r31, 16 * ks + 8 * hh), lds_frag(lds, RC_ARB, cidx, 16 * ks + 8 * hh), ac2); }
#pragma unroll
              for (int g4 = 0; g4 < 4; ++g4) { const int ro = 32 * mt + 8 * g4 + 4 * hh, cb = ro >> 4, q2 = (ro & 15) >> 2, nt3 = cidx >> 4, lane2 = (cidx & 15) + 16 * q2;
                  *(f32x4*)(rwi + RWI_O1F + ((cb * 4 + nt3) * 64 + lane2) * 16) = (f32x4){ac1[4 * g4] - ac2[4 * g4], ac1[4 * g4 + 1] - ac2[4 * g4 + 1], ac1[4 * g4 + 2] - ac2[4 * g4 + 2], ac1[4 * g4 + 3] - ac2[4 * g4 + 3]}; }
          } }
        __syncthreads();
    }
}

__device__ __forceinline__ void p3_rwkv_seq(const Args& a, int unit, int wave, int lane) {
    if (wave != 0) return;
    const int bh = unit >> 2, cb = unit & 3, b = bh >> 4, h = bh & 15, l15 = lane & 15, q = lane >> 4;
    bf16_t* ORAW = (bf16_t*)((unsigned char*)a.out + DO_ORAW);
    f32x4 hacc[4];
#pragma unroll
    for (int m = 0; m < 4; ++m) hacc[m] = (f32x4){0.f, 0.f, 0.f, 0.f};
    const unsigned char* base = a.ws + WS_RWI + (size_t)(bh * 32) * RWI_BYTES;
    bf16x8 gf[8]; f32x4 h1[4], lam[4];
#define RW2_LOADG(src) do { _Pragma("unroll") for (int k2 = 0; k2 < 8; ++k2) gf[k2] = *(const bf16x8*)((src) + RWI_GF + (k2 * 64 + lane) * 16); \
        _Pragma("unroll") for (int m = 0; m < 4; ++m) { h1[m] = *(const f32x4*)((src) + RWI_H1F + ((cb * 4 + m) * 64 + lane) * 16); lam[m] = *(const f32x4*)((src) + RWI_LAM + (16 * m + 4 * q) * 4); } } while (0)
    RW2_LOADG(base);
#pragma unroll 1
    for (int c = 0; c < 32; ++c) {
        const unsigned char* cur = base + (size_t)c * RWI_BYTES;
        bf16x8 w2f[8]; f32x4 o1[4];
#pragma unroll
        for (int k2 = 0; k2 < 8; ++k2) w2f[k2] = *(const bf16x8*)(cur + RWI_W2F + (k2 * 64 + lane) * 16);
#pragma unroll
        for (int n = 0; n < 4; ++n) o1[n] = *(const f32x4*)(cur + RWI_O1F + ((cb * 4 + n) * 64 + lane) * 16);
        bf16x8 hb[2];
#pragma unroll
        for (int ks = 0; ks < 2; ++ks) { u32x4 t; t.x = cvt_pk_bf16(hacc[2 * ks][0], hacc[2 * ks][1]); t.y = cvt_pk_bf16(hacc[2 * ks][2], hacc[2 * ks][3]);
            t.z = cvt_pk_bf16(hacc[2 * ks + 1][0], hacc[2 * ks + 1][1]); t.w = cvt_pk_bf16(hacc[2 * ks + 1][2], hacc[2 * ks + 1][3]); hb[ks] = __builtin_bit_cast(bf16x8, t); }
        f32x4 nacc[4];
#pragma unroll
        for (int m = 0; m < 4; ++m) { nacc[m] = h1[m] + lam[m] * hacc[m];
#pragma unroll
            for (int ks = 0; ks < 2; ++ks) nacc[m] = MFMA16(gf[m * 2 + ks], hb[ks], nacc[m]); }
        if (c + 1 < 32) RW2_LOADG(cur + RWI_BYTES);
#pragma unroll
        for (int n = 0; n < 4; ++n) { f32x4 oacc = o1[n];
#pragma unroll
            for (int ks = 0; ks < 2; ++ks) oacc = MFMA16(hb[ks], w2f[n * 2 + ks], oacc);
            *(u32x2*)(ORAW + ((size_t)b * SEQ + c * 64 + 16 * n + l15) * 1024 + h * 64 + 16 * cb + 4 * q) = pack4(oacc[0], oacc[1], oacc[2], oacc[3]); }
#pragma unroll
        for (int m = 0; m < 4; ++m) hacc[m] = nacc[m];
    }
#undef RW2_LOADG
#pragma unroll
    for (int m = 0; m < 4; ++m) *(f32x4*)(a.out + OUT_WKV_P + (((size_t)bh * 64 + 16 * cb + l15) * 64 + 16 * m + 4 * q)) = hacc[m];
}

__device__ __forceinline__ void p3_rwkv_sample(const Args& a, LAS unsigned char* lds, int bs, int wave, int lane) {
    LAS float* Lw = (LAS float*)lds + wave * 768;
    const bf16_t* P = (const bf16_t*)(a.ws + WS_P);
    const bf16_t* pc = P + (size_t)(MP + bs) * LDP; const bf16_t* pp = P + (size_t)(MV + bs) * LDP;
    bf16_t* A2 = (bf16_t*)(a.ws + WS_XN);
    const float* mu = a.in[I_MU];
    { float wd = bf2f(pc[PC_WD + lane]), ad = bf2f(pc[PC_AD + lane]); wd += (bf2f(pp[PC_WD + lane]) - wd) * mu[3072 + lane]; ad += (bf2f(pp[PC_AD + lane]) - ad) * mu[3136 + lane];
      Lw[lane] = tanhf_(wd); Lw[64 + lane] = ad; }
    LDS_WAIT();
    for (int hq = 0; hq < 2; ++hq) { const int h = 2 * wave + hq, hj = h * 64 + lane;
        float lw = 0.f, la = 0.f;
#pragma unroll 8
        for (int m = 0; m < 64; ++m) { lw += Lw[m] * a.in[I_W2][(size_t)m * 1024 + hj]; la += Lw[64 + m] * a.in[I_A2][(size_t)m * 1024 + hj]; }
        float r = bf2f(pc[PC_R + hj]), k = bf2f(pc[PC_K + hj]), v = bf2f(pc[PC_V + hj]);
        r += (bf2f(pp[PC_R + hj]) - r) * mu[hj]; k += (bf2f(pp[PC_K + hj]) - k) * mu[1024 + hj]; v += (bf2f(pp[PC_V + hj]) - v) * mu[2048 + hj];
        const RwTok o = rw_token(a, hj, r, k, v, lw, la);
        Lw[128 + lane] = o.kk; Lw[192 + lane] = o.dr; Lw[256 + lane] = o.dd; Lw[320 + lane] = o.bb; Lw[384 + lane] = o.kp; Lw[448 + lane] = o.v;
        LDS_WAIT();
        const int rg = lane >> 4, cq = lane & 15;
        const f32x4 kk4 = *(const LAS f32x4*)(Lw + 128 + 4 * cq), dr4 = *(const LAS f32x4*)(Lw + 192 + 4 * cq), d4 = *(const LAS f32x4*)(Lw + 256 + 4 * cq), b4 = *(const LAS f32x4*)(Lw + 320 + 4 * cq), k4 = *(const LAS f32x4*)(Lw + 384 + 4 * cq);
        const size_t sbase = ((size_t)(bs * 16 + h) * 64) * 64;
        const float* S0 = a.in[I_WKV] + sbase; float* S1 = a.out + OUT_WKV_S + sbase;
#pragma unroll 4
        for (int it = 0; it < 16; ++it) { const int i = 4 * it + rg; f32x4 S = *(const f32x4*)(S0 + (size_t)i * 64 + 4 * cq); const float vi = Lw[448 + i];
            float p1 = (S[0] * kk4[0] + S[1] * kk4[1]) + (S[2] * kk4[2] + S[3] * kk4[3]);
            float p2 = (S[0] * dr4[0] + S[1] * dr4[1]) + (S[2] * dr4[2] + S[3] * dr4[3]);
            p1 = row16_sum(p1); p2 = row16_sum(p2);
            const float sa = -p1, ov = p2 + sa * o.br + vi * o.kr;
#pragma unroll
            for (int j = 0; j < 4; ++j) S[j] = S[j] * d4[j] + sa * b4[j] + vi * k4[j];
            *(f32x4*)(S1 + (size_t)i * 64 + 4 * cq) = S;
            if (cq == 0) Lw[512 + i] = ov; }
        LDS_WAIT();
        const float ov = Lw[512 + lane];
        const float mean = wave_sum(ov) * (1.0f / 64.0f); const float dv = ov - mean; const float var = wave_sum(dv * dv) * (1.0f / 64.0f);
        float on = dv * rsqrtf(var + GN_EPS) * a.in[I_GNW][hj] + a.in[I_GNB][hj] + o.bonus * o.v;
        on *= bf2f(pc[PC_ZR + hj]);
        A2[(size_t)(MP + bs) * 2048 + 1024 + hj] = f2bf(on);
        LDS_WAIT();
    }
}

constexpr int S5_ELD = 132, S5_XLD = 136;
constexpr int S5_E_OFF = 0, S5_X_OFF = 128 * S5_ELD * 4;
__device__ __forceinline__ bf16x8 ldfrag(const unsigned char* base, int block, int lane) { return *(const bf16x8*)(base + (size_t)block * 1024 + lane * 16); }
__device__ __forceinline__ void p3_s5_prompt(const Args& a, LAS unsigned char* lds, int unit, int tid, int wave, int lane) {
    const int b = unit >> 6, g = unit & 63;
    const unsigned char* tab = (const unsigned char*)a.out + DO_S5TAB + (size_t)g * S5T_BYTES;
    const bf16_t* P = (const bf16_t*)(a.ws + WS_P);
    bf16_t* Yg = (bf16_t*)(a.ws + WS_YG);
    LAS float* EL = (LAS float*)(lds + S5_E_OFF); LAS bf16_t* XL = (LAS bf16_t*)(lds + S5_X_OFF);
    const int nt = wave & 3, hm = wave >> 2, r31 = lane & 31, hh = lane >> 5;
    const int n = 32 * nt + r31;
    f32x16 accY[4], accE[2];
#pragma unroll
    for (int q = 0; q < 4; ++q)
#pragma unroll
        for (int r = 0; r < 16; ++r) accY[q][r] = 0.f;
#pragma unroll
    for (int q = 0; q < 2; ++q)
#pragma unroll
        for (int r = 0; r < 16; ++r) accE[q][r] = 0.f;
    const int mts[4] = {hm ? 1 : 0, hm ? 2 : 3, hm ? 5 : 4, hm ? 6 : 7};
    const bf16_t* ubase = P + ((size_t)b * SEQ + 16 * n) * LDP + PC_U + g * 16 + 8 * hh;
#pragma unroll
    for (int s = 0; s < 16; ++s) {
        const bf16x8 bu = *(const bf16x8*)(ubase + (size_t)s * LDP);
#pragma unroll
        for (int e = 0; e < 2; ++e) accE[e] = __builtin_amdgcn_mfma_f32_32x32x16_bf16(ldfrag(tab + S5T_ME, (2 * hm + e) * 16 + s, lane), bu, accE[e], 0, 0, 0);
#pragma unroll
        for (int q = 0; q < 4; ++q) { const int mt = mts[q]; if (s <= 2 * mt + 1) accY[q] = __builtin_amdgcn_mfma_f32_32x32x16_bf16(ldfrag(tab + S5T_KT, 2 * mt - s + 1, lane), bu, accY[q], 0, 0, 0); }
    }
#pragma unroll
    for (int e = 0; e < 2; ++e)
#pragma unroll
        for (int q4 = 0; q4 < 4; ++q4) { f32x4 v; v[0] = accE[e][4 * q4]; v[1] = accE[e][4 * q4 + 1]; v[2] = accE[e][4 * q4 + 2]; v[3] = accE[e][4 * q4 + 3];
            *(LAS f32x4*)(EL + n * S5_ELD + 32 * (2 * hm + e) + 8 * q4 + 4 * hh) = v; }
    __syncthreads();
    if (wave == 0) { const float* hdr = (const float*)(tab + S5T_HDR); const float ar = hdr[lane], ai = hdr[64 + lane]; float xr = 0.f, xi = 0.f;
#pragma unroll 8
        for (int c = 0; c < 128; ++c) { XL[c * S5_XLD + lane] = f2bf(xr); XL[c * S5_XLD + 64 + lane] = f2bf(xi);
            const float er = EL[c * S5_ELD + lane], ei = EL[c * S5_ELD + 64 + lane];
            const float nr = ar * xr - ai * xi + er, ni = ar * xi + ai * xr + ei; xr = nr; xi = ni; }
        a.out[OUT_S5RE_P + (size_t)(b * 64 + g) * 64 + lane] = xr; a.out[OUT_S5IM_P + (size_t)(b * 64 + g) * 64 + lane] = xi; }
    __syncthreads();
#pragma unroll
    for (int ks = 0; ks < 8; ++ks) { const bf16x8 bx = *(const LAS bf16x8*)(XL + n * S5_XLD + 16 * ks + 8 * hh);
#pragma unroll
        for (int q = 0; q < 4; ++q) accY[q] = __builtin_amdgcn_mfma_f32_32x32x16_bf16(ldfrag(tab + S5T_CA, mts[q] * 8 + ks, lane), bx, accY[q], 0, 0, 0); }
#pragma unroll
    for (int q = 0; q < 4; ++q) { const int mt = mts[q];
#pragma unroll
        for (int q4 = 0; q4 < 4; ++q4) { const int dt = q4 >> 1, c0 = 8 * (q4 & 1) + 4 * hh; const size_t row = (size_t)b * SEQ + 16 * n + 2 * mt + dt;
            u32x2 w; w.x = cvt_pk_bf16(geluf_(accY[q][4 * q4]), geluf_(accY[q][4 * q4 + 1])); w.y = cvt_pk_bf16(geluf_(accY[q][4 * q4 + 2]), geluf_(accY[q][4 * q4 + 3]));
            *(u32x2*)(Yg + row * 1024 + g * 16 + c0) = w; } }
    __syncthreads();
}
__device__ __forceinline__ void p3_s5_sample(const Args& a, int g, int wave, int lane) {
    if (wave >= 4) return;
    const unsigned char* tab = (const unsigned char*)a.out + DO_S5TAB + (size_t)g * S5T_BYTES;
    const float* hdr = (const float*)(tab + S5T_HDR);
    const bf16_t* P = (const bf16_t*)(a.ws + WS_P);
    bf16_t* Yg = (bf16_t*)(a.ws + WS_YG);
    const int r31 = lane & 31, hh = lane >> 5, bs = 32 * wave + r31;
    const bf16x8 bu = *(const bf16x8*)(P + (size_t)(MP + bs) * LDP + PC_U + g * 16 + 8 * hh);
    f32x16 z;
#pragma unroll
    for (int r = 0; r < 16; ++r) z[r] = 0.f;
    f32x16 x[4];
#pragma unroll
    for (int mtile = 0; mtile < 4; ++mtile) x[mtile] = __builtin_amdgcn_mfma_f32_32x32x16_bf16(ldfrag(tab + S5T_ME, mtile * 16 + 15, lane), bu, z, 0, 0, 0);
    const size_t sb = (size_t)(bs * 64 + g) * 64;
#pragma unroll
    for (int pt = 0; pt < 2; ++pt)
#pragma unroll
        for (int q4 = 0; q4 < 4; ++q4) { const int p0 = 32 * pt + 8 * q4 + 4 * hh;
            const f32x4 x0r = *(const f32x4*)(a.in[I_S5RE] + sb + p0), x0i = *(const f32x4*)(a.in[I_S5IM] + sb + p0);
            const f32x4 ar = *(const f32x4*)(hdr + 128 + p0), ai = *(const f32x4*)(hdr + 192 + p0);
            f32x4 nr, ni;
#pragma unroll
            for (int j = 0; j < 4; ++j) { nr[j] = ar[j] * x0r[j] - ai[j] * x0i[j] + x[pt][4 * q4 + j]; ni[j] = ar[j] * x0i[j] + ai[j] * x0r[j] + x[2 + pt][4 * q4 + j]; x[pt][4 * q4 + j] = nr[j]; x[2 + pt][4 * q4 + j] = ni[j]; }
            *(f32x4*)(a.out + OUT_S5RE_S + sb + p0) = nr; *(f32x4*)(a.out + OUT_S5IM_S + sb + p0) = ni; }
    f32x16 y = __builtin_amdgcn_mfma_f32_32x32x16_bf16(ldfrag(tab + S5T_DF, 0, lane), bu, z, 0, 0, 0);
#pragma unroll
    for (int mtile = 0; mtile < 4; ++mtile)
#pragma unroll
        for (int sp = 0; sp < 2; ++sp) { u32x4 t; t.x = cvt_pk_bf16(x[mtile][8 * sp], x[mtile][8 * sp + 1]); t.y = cvt_pk_bf16(x[mtile][8 * sp + 2], x[mtile][8 * sp + 3]);
            t.z = cvt_pk_bf16(x[mtile][8 * sp + 4], x[mtile][8 * sp + 5]); t.w = cvt_pk_bf16(x[mtile][8 * sp + 6], x[mtile][8 * sp + 7]);
            y = __builtin_amdgcn_mfma_f32_32x32x16_bf16(ldfrag(tab + S5T_C0, mtile * 2 + sp, lane), __builtin_bit_cast(bf16x8, t), y, 0, 0, 0); }
#pragma unroll
    for (int q4 = 0; q4 < 2; ++q4) { const int c0 = 8 * q4 + 4 * hh;
        u32x2 w; w.x = cvt_pk_bf16(geluf_(y[4 * q4]), geluf_(y[4 * q4 + 1])); w.y = cvt_pk_bf16(geluf_(y[4 * q4 + 2]), geluf_(y[4 * q4 + 3]));
        *(u32x2*)(Yg + (size_t)(MP + bs) * 1024 + g * 16 + c0) = w; }
}

__device__ __forceinline__ void p4_rwkv_post(const Args& a, int item, int lane) {
    const int row = item >> 4, h = item & 15, hj = h * 64 + lane;
    const bf16_t* ORAW = (const bf16_t*)((const unsigned char*)a.out + DO_ORAW); const bf16_t* BV = (const bf16_t*)((const unsigned char*)a.out + DO_BV);
    const bf16_t* P = (const bf16_t*)(a.ws + WS_P); bf16_t* A2 = (bf16_t*)(a.ws + WS_XN);
    const float ov = bf2f(ORAW[(size_t)row * 1024 + hj]), bv = bf2f(BV[(size_t)row * 1024 + hj]);
    const float mean = wave_sum(ov) * (1.0f / 64.0f); const float dv = ov - mean; const float var = wave_sum(dv * dv) * (1.0f / 64.0f);
    float on = dv * rsqrtf(var + GN_EPS) * a.in[I_GNW][hj] + a.in[I_GNB][hj] + bv;
    on *= bf2f(P[(size_t)row * LDP + PC_ZR + hj]);
    A2[(size_t)row * 2048 + 1024 + hj] = f2bf(on);
}

__device__ __forceinline__ void p6_row(const Args& a, int m, int lane) {
    float* y = a.out + (size_t)m * DM; const float* rs = (const float*)(a.ws + WS_ROWSS) + (size_t)m * 32; const float* fg = a.in[I_FINALG];
    const float ss = wave_sum(rs[lane & 31]) * 0.5f;
    const float rstd = rsqrtf(ss * (1.0f / DM) + RMS_EPS);
#pragma unroll
    for (int j = 0; j < 8; ++j) { const int k = 4 * lane + 256 * j; f32x4 v = *(const f32x4*)(y + k); const f32x4 gv = *(const f32x4*)(fg + k);
#pragma unroll
        for (int q = 0; q < 4; ++q) v[q] = v[q] * rstd * gv[q];
        *(f32x4*)(y + k) = v; }
}

__global__ void __launch_bounds__(512, 2) fwd_kernel(Args args) {
    extern __shared__ __attribute__((aligned(16))) unsigned char lds_raw[];
    LAS unsigned char* lds = (LAS unsigned char*)lds_raw;
    const int tid = threadIdx.x, lane = tid & 63, wave = __builtin_amdgcn_readfirstlane(tid >> 6);
    const int G = gridDim.x, bx = blockIdx.x;
    const int vcu = (G % 8 == 0) ? (bx % 8) * (G / 8) + bx / 8 : bx;
    volatile LAS unsigned* MISC = (volatile LAS unsigned*)(lds + MISC_OFF);
    for (int u = tid; u < (LDS_BYTES - LDSCTL_OFF) / 4; u += 512) ((LAS unsigned*)(lds + LDSCTL_OFF))[u] = 0u;
    __syncthreads();
    unsigned* ctl = (unsigned*)(args.ws + WS_CTL);
    XcdBarrier bar; bar.bar = ctl + CW_BAR + args.li * XCD_BAR_WORDS; bar.x = 0; bar.st = nullptr;
    const bool multi = (args.ph_hi - args.ph_lo) > 1;
    if (multi) bar = xcd_barrier_post(ctl + CW_BAR + args.li * XCD_BAR_WORDS, MISC + 8);
    const int lo = args.ph_lo, hi = args.ph_hi;
#define IN(k) (lo <= (k) && (k) < hi)
#define SEAM(k) do { if (IN(k) && IN((k) + 1)) xcd_barrier(bar); } while (0)
    const int gw = vcu * 8 + wave, NGW = G * 8;

    if (IN(0)) {
        if (vcu < 192) p0_mod(args, lds, vcu, wave, lane);
        else if (vcu - 192 < 64) p0_s5_tables(args, lds, vcu - 192, tid);
        __syncthreads();
        LAS float* scr = (LAS float*)(lds + wave * 16384);
        bf16_t* WT = (bf16_t*)(args.ws + WS_WT);
        for (int it = gw; it < 328 * 32; it += NGW) { const int nb = it >> 5, kb = it & 31; const int p0 = 32 * nb;
            const int src = (p0 < 5120) ? p0 : ((p0 < 10240) ? p0 + 128 : p0 - 5120);
            transpose_item(args.in[I_WIN], NIN, 2048, src, WT, p0, 64 * kb, scr, lane, p0 >= NIN); }
    }
    SEAM(0);
    if (IN(1)) { for (int m = gw; m < MT; m += NGW) p1_row(args, m, lane); }
    SEAM(1);
    if (IN(2)) {
        pg8::Gemm g{(const bf16_t*)(args.ws + WS_XN), (const bf16_t*)(args.ws + WS_WT), 2048, 2048};
        pg8::StaticOrder S; S.init(MT, LDP, G, bx);
        EpiP E{(bf16_t*)(args.ws + WS_P)};
        pg8::gemm_phase<EpiP, pg8::StaticOrder>(lds, g, S, E);
    }
    SEAM(2);
    if (IN(3)) {
        p3_rwkv_chunks(args, lds, vcu >> 2, vcu & 3, tid, wave, lane);
        { LAS float* scr = (LAS float*)(lds + wave * 16384);
          for (int it = gw; it < 2048 + 512; it += NGW) {
              if (it < 2048) { const int nb = it >> 5, kb = it & 31; transpose_item(args.in[I_WOUT], 2048, 2048, 32 * nb, (bf16_t*)(args.ws + WS_WOUT_T), 32 * nb, 64 * kb, scr, lane, false); }
              else { const int i2 = it - 2048, nb = i2 >> 4, kb = i2 & 15; transpose_item(args.in[I_WGLU], 1024, 1024, 32 * nb, (bf16_t*)(args.ws + WS_WGLU_T), 32 * nb, 64 * kb, scr, lane, false); } } }
        __syncthreads();
        p3_s5_prompt(args, lds, vcu, tid, wave, lane);
        if (vcu < 64) p3_s5_sample(args, vcu, wave, lane);
        __syncthreads();
        if (vcu >= 128) p3_rwkv_sample(args, lds, vcu - 128, wave, lane);
    }
    SEAM(3);
    if (IN(4)) p3_rwkv_seq(args, vcu, wave, lane);
    SEAM(4);
    if (IN(5)) {
        pg8::StaticOrder S; S.init(MT, 1024, G, bx);
        pg8::Unit u0;
        if (S.next(0, u0)) {
            pg8::Gemm g{(const bf16_t*)(args.ws + WS_YG), (const bf16_t*)(args.ws + WS_WGLU_T), 1024, 1024};
            EpiGlu E{(const bf16_t*)(args.ws + WS_YG), (const bf16_t*)(args.ws + WS_P), args.in[I_BGLU], (bf16_t*)(args.ws + WS_XN)};
            pg8::gemm_phase<EpiGlu, pg8::StaticOrder>(lds, g, S, E);
        } else {
            const int nfree = G - 132, j = bx - 132;
            if (j >= 0) for (int it = (j * 8 + wave) * 4; it < MP * 16; it += nfree * 32) {
#pragma unroll
                for (int q = 0; q < 4; ++q) p4_rwkv_post(args, it + q, lane); }
        }
    }
    SEAM(5);
    if (IN(6)) {
        pg8::Gemm g{(const bf16_t*)(args.ws + WS_XN), (const bf16_t*)(args.ws + WS_WOUT_T), 2048, 1024};
        pg8::TwoHalfOrder S; S.init(MT, DM, G, bx);
        EpiOut E{(const bf16_t*)(args.ws + WS_P), args.in[I_XP], args.in[I_XS], (const float*)(args.ws + WS_MOD), args.out, (float*)(args.ws + WS_ROWSS)};
        pg8::gemm_phase<EpiOut, pg8::TwoHalfOrder>(lds, g, S, E);
    }
    SEAM(6);
    if (IN(7)) { for (int m = gw; m < MV; m += NGW) p6_row(args, m, lane); }
#undef IN
#undef SEAM
}

extern "C" void kernel_launch(void* const* d_in, const int* in_sizes, int n_in, void* d_out, int out_size, void* d_ws, size_t ws_size, hipStream_t stream) {
    static int grid = 0;
    if (grid == 0) {
        if (n_in != 34 || ws_size < WS_END) { fprintf(stderr, "kernel_launch: unexpected n_in %d / ws %zu\n", n_in, ws_size); grid = -1; return; }
        int dev = 0, cus = 0;
        if (hipGetDevice(&dev) != hipSuccess || hipDeviceGetAttribute(&cus, hipDeviceAttributeMultiprocessorCount, dev) != hipSuccess) { grid = -1; return; }
        if (hipFuncSetAttribute((const void*)fwd_kernel, hipFuncAttributeMaxDynamicSharedMemorySize, LDS_BYTES) != hipSuccess) { fprintf(stderr, "kernel_launch: hipFuncSetAttribute failed\n"); grid = -1; return; }
        int per_cu = 0;
        if (hipOccupancyMaxActiveBlocksPerMultiprocessor(&per_cu, (const void*)fwd_kernel, 512, LDS_BYTES) != hipSuccess || per_cu < 1) fprintf(stderr, "kernel_launch: occupancy query says %d\n", per_cu);
        (void)hipGetLastError();
        grid = cus;
        if (grid != 256) fprintf(stderr, "kernel_launch: note: %d CUs\n", grid);
    }
    if (grid < 0) return;
    (void)hipMemsetAsync((char*)d_ws + WS_CTL, 0, CTL_BYTES, stream);
    Args a{};
    for (int i = 0; i < 34; ++i) a.in[i] = (const float*)d_in[i];
    a.out = (float*)d_out; a.ws = (unsigned char*)d_ws;
    if (PROBE_PHASE >= 0) {
        a.ph_lo = 0; a.ph_hi = PROBE_PHASE + 1; a.li = 0; hipLaunchKernelGGL(fwd_kernel, dim3(grid), dim3(512), LDS_BYTES, stream, a);
        a.ph_lo = PROBE_PHASE; a.ph_hi = PROBE_PHASE + 1; a.li = 1; hipLaunchKernelGGL(fwd_kernel, dim3(grid), dim3(512), LDS_BYTES, stream, a);
        if (PROBE_PHASE + 1 < N_PHASES) { a.ph_lo = PROBE_PHASE + 1; a.ph_hi = N_PHASES; a.li = 2; hipLaunchKernelGGL(fwd_kernel, dim3(grid), dim3(512), LDS_BYTES, stream, a); }
    } else if (MK_N_LAUNCHES == 1) { a.ph_lo = 0; a.ph_hi = N_PHASES; a.li = 0; hipLaunchKernelGGL(fwd_kernel, dim3(grid), dim3(512), LDS_BYTES, stream, a); }
    else { for (int p = 0; p < N_PHASES; ++p) { a.ph_lo = p; a.ph_hi = p + 1; a.li = 0; hipLaunchKernelGGL(fwd_kernel, dim3(grid), dim3(512), LDS_BYTES, stream, a); } }
}
```

```cpp
#include <hip/hip_runtime.h>
#include <cstdio>
#include <cstdint>

#ifndef MK_N_LAUNCHES
#define MK_N_LAUNCHES 1
#endif
#ifndef PROBE_PHASE
#define PROBE_PHASE -1
#endif
constexpr int N_PHASES = 8;

#define GAS __attribute__((address_space(1)))
#define LAS __attribute__((address_space(3)))
typedef unsigned short bf16_t;
typedef short bf16x8 __attribute__((ext_vector_type(8)));
typedef float f32x2 __attribute__((ext_vector_type(2)));
typedef float f32x4 __attribute__((ext_vector_type(4)));
typedef float f32x16 __attribute__((ext_vector_type(16)));
typedef unsigned u32x2 __attribute__((ext_vector_type(2)));
typedef unsigned u32x4 __attribute__((ext_vector_type(4)));
typedef GAS unsigned gu32;

constexpr int DM = 2048, SEQ = 2048, NB = 4, NSMP = 128;
constexpr int MP = NB * SEQ;
constexpr int MV = MP + NSMP;
constexpr int MT = MV + NSMP;
constexpr int NIN = 10368, LDP = 10496;
constexpr int NMOD = 6144, NMODROWS = NB + NSMP;
constexpr float RMS_EPS = 1e-6f, GN_EPS = 64e-5f;
constexpr int PC_U = 0, PC_ZS = 1024, PC_R = 2048, PC_K = 3072, PC_V = 4096, PC_ZR = 5120, PC_GS = 6144, PC_GR = 8192, PC_WD = 10240, PC_AD = 10304;

constexpr size_t WS_CTL = 0, CTL_BYTES = 65536;
constexpr size_t WS_MOD = 65536;
constexpr size_t WS_WT = 3342336;
constexpr size_t WS_YG = WS_WT;
constexpr size_t WS_WOUT_T = WS_YG + (size_t)MT * 1024 * 2;
constexpr size_t WS_WGLU_T = WS_WOUT_T + (size_t)2048 * 2048 * 2;
constexpr size_t WS_ROWSS = WS_WGLU_T + (size_t)1024 * 1024 * 2;
constexpr size_t WS_XN = WS_WT + (size_t)LDP * 2048 * 2;
constexpr size_t WS_P = WS_XN + (size_t)MT * 2048 * 2;
constexpr size_t WS_RWI = WS_P + (size_t)MT * LDP * 2;
constexpr int RWI_GF = 0, RWI_W2F = 8192, RWI_H1F = 16384, RWI_O1F = 32768, RWI_LAM = 49152, RWI_BYTES = 49408;
constexpr size_t WS_TMP = WS_RWI + (size_t)2048 * RWI_BYTES;
constexpr size_t WS_SLAB = WS_TMP + (size_t)MP * 2048 * 2;
constexpr size_t WS_END = WS_SLAB + (size_t)8 * NSMP * DM * 4;
static_assert(WS_END <= ((size_t)412 << 20), "ws map");
static_assert(WS_ROWSS + (size_t)MT * 32 * 4 <= WS_XN, "ws map 2");
constexpr size_t DO_ORAW = 0, DO_BV = (size_t)MP * 1024 * 2, DO_S5TAB = 2 * DO_BV;
constexpr int S5T_ME = 0, S5T_KT = 65536, S5T_CA = 81920, S5T_C0 = 147456, S5T_DF = 155648, S5T_HDR = 156672, S5T_BYTES = 157696;
static_assert(DO_S5TAB + (size_t)64 * S5T_BYTES <= (size_t)MV * DM * 4, "d_out scratch");
constexpr size_t OUT_Y = 0, OUT_S5RE_P = 17039360, OUT_S5IM_P = 17055744, OUT_WKV_P = 17072128, OUT_SHIFT_P = 17334272,
                 OUT_S5RE_S = 17342464, OUT_S5IM_S = 17866752, OUT_WKV_S = 18391040, OUT_SHIFT_S = 26779648;
constexpr int RING_BYTES = 131072, LDSCTL_OFF = RING_BYTES, MISC_OFF = LDSCTL_OFF + 320, LDS_BYTES = 147456;
constexpr int CW_BAR = 1024;

#define LDS_WAIT() asm volatile("s_waitcnt lgkmcnt(0)" ::: "memory")
#define VM_WAIT() asm volatile("s_waitcnt vmcnt(0)" ::: "memory")
typedef __bf16 bf16x2_t __attribute__((ext_vector_type(2)));
__device__ __forceinline__ unsigned cvt_pk_bf16(float lo, float hi) { const f32x2 v = {lo, hi}; return __builtin_bit_cast(unsigned, __builtin_convertvector(v, bf16x2_t)); }
__device__ __forceinline__ u32x2 pack4(float a, float b, float c, float d) { u32x2 w; w.x = cvt_pk_bf16(a, b); w.y = cvt_pk_bf16(c, d); return w; }
__device__ __forceinline__ float bf_lo(unsigned w) { return __uint_as_float(w << 16); }
__device__ __forceinline__ float bf_hi(unsigned w) { return __uint_as_float(w & 0xffff0000u); }
__device__ __forceinline__ float bf2f(bf16_t b) { return __uint_as_float(((unsigned)b) << 16); }
__device__ __forceinline__ bf16_t f2bf(float f) { return (bf16_t)(cvt_pk_bf16(f, 0.f) & 0xffffu); }
__device__ __forceinline__ float rcpf_(float x) { return __builtin_amdgcn_rcpf(x); }
__device__ __forceinline__ float sigmoidf_(float x) { return rcpf_(1.0f + __expf(-x)); }
__device__ __forceinline__ float siluf_(float x) { return x * rcpf_(1.0f + __expf(-x)); }
__device__ __forceinline__ float tanhf_(float x) { const float e = __expf(2.0f * x); return 1.0f - 2.0f * rcpf_(e + 1.0f); }
__device__ __forceinline__ float geluf_(float y) { const float z = 0.7978845608028654f * (y + 0.044715f * y * y * y); return 0.5f * y * (1.0f + tanhf_(z)); }
__device__ __forceinline__ float wave_sum(float v) {
#pragma unroll
    for (int o = 1; o < 64; o <<= 1) v += __shfl_xor(v, o);
    return v;
}
template <int CTRL> __device__ __forceinline__ float dpp_f(float x) { return __builtin_bit_cast(float, __builtin_amdgcn_mov_dpp(__builtin_bit_cast(int, x), CTRL, 0xf, 0xf, true)); }
__device__ __forceinline__ float wave_sum_dpp(float v) {
    v += __builtin_bit_cast(float, __builtin_amdgcn_update_dpp(0, __builtin_bit_cast(int, v), 0x111, 0xf, 0xf, true));
    v += __builtin_bit_cast(float, __builtin_amdgcn_update_dpp(0, __builtin_bit_cast(int, v), 0x112, 0xf, 0xf, true));
    v += __builtin_bit_cast(float, __builtin_amdgcn_update_dpp(0, __builtin_bit_cast(int, v), 0x114, 0xf, 0xf, true));
    v += __builtin_bit_cast(float, __builtin_amdgcn_update_dpp(0, __builtin_bit_cast(int, v), 0x118, 0xf, 0xf, true));
    v += __builtin_bit_cast(float, __builtin_amdgcn_update_dpp(0, __builtin_bit_cast(int, v), 0x142, 0xa, 0xf, false));
    v += __builtin_bit_cast(float, __builtin_amdgcn_update_dpp(0, __builtin_bit_cast(int, v), 0x143, 0xc, 0xf, false));
    return __builtin_bit_cast(float, __builtin_amdgcn_readlane(__builtin_bit_cast(int, v), 63));
}
__device__ __forceinline__ float row16_sum(float v) {
    v += dpp_f<0xB1>(v);
    v += dpp_f<0x4E>(v);
    v += dpp_f<0x141>(v);
    v += dpp_f<0x140>(v);
    return v;
}

#define XB_TMO      128
#define XB_XCNT(j)  (256  + 64 * (j))
#define XB_XSUB(j)  (1280 + 64 * (j))
#define XB_XGEN(j)  (2304 + 64 * (j))
#define XB_TOP      3328
#define XB_TOPGEN   3392
#define XCD_BAR_WORDS 3456
#define XB_SPIN_CAP (1u << 20)
__device__ __forceinline__ unsigned xb_ld(unsigned* p)              { return __hip_atomic_load(p, __ATOMIC_RELAXED, __HIP_MEMORY_SCOPE_AGENT); }
__device__ __forceinline__ unsigned xb_add(unsigned* p, unsigned v) { return __hip_atomic_fetch_add(p, v, __ATOMIC_RELAXED, __HIP_MEMORY_SCOPE_AGENT); }
__device__ __forceinline__ unsigned xb_xcc_id() { return (unsigned)__builtin_amdgcn_s_getreg((3 << 11) | 20) & 0xFu; }
#define XB_SPIN(cond, bar) do { unsigned _sp = 0; while (cond) { __builtin_amdgcn_s_sleep(1); \
    if ((++_sp & 255u) == 0u) { if (xb_ld(&(bar)[XB_TMO])) break; if (_sp > XB_SPIN_CAP) { atomicAdd(&(bar)[XB_TMO], 1u); break; } } } } while (0)
struct XcdBarrier { unsigned* bar; unsigned x; volatile LAS unsigned* st; };
__device__ __forceinline__ XcdBarrier xcd_barrier_post(unsigned* bar, volatile LAS unsigned* st) {
    XcdBarrier b; b.bar = bar; b.x = xb_xcc_id(); b.st = st;
    if (threadIdx.x == 0) (void)xb_add(&bar[XB_XCNT(b.x)], 1u);
    return b;
}
__device__ __forceinline__ void xcd_barrier_complete(unsigned* bar, unsigned x, unsigned& nloc, unsigned& nx) {
    const unsigned G = gridDim.x * gridDim.y * gridDim.z;
    unsigned sum, cnt, mine, sp = 0u;
    for (;;) {
        sum = 0u; cnt = 0u; mine = 0u;
#pragma unroll
        for (unsigned j = 0; j < 16; ++j) { const unsigned c = xb_ld(&bar[XB_XCNT(j)]); sum += c; cnt += (c > 0u) ? 1u : 0u; mine = (j == x) ? c : mine; }
        if (sum == G) break;
        __builtin_amdgcn_s_sleep(1);
        if ((++sp & 255u) == 0u) { if (xb_ld(&bar[XB_TMO])) break; if (sp > XB_SPIN_CAP) { atomicAdd(&bar[XB_TMO], 1u); break; } }
    }
    nloc = mine > 0u ? mine : 1u; nx = cnt > 0u ? cnt : 1u;
}
__device__ __forceinline__ void xcd_barrier(const XcdBarrier& b) {
    asm volatile("s_waitcnt vmcnt(0)" ::: "memory");
    __syncthreads();
    if (threadIdx.x == 0) {
        unsigned* bar = b.bar;
        __builtin_amdgcn_s_waitcnt(0);
        unsigned nloc = b.st[0], nx = b.st[1];
        if (nloc == 0u) { xcd_barrier_complete(bar, b.x, nloc, nx); b.st[0] = nloc; b.st[1] = nx; }
        const unsigned old = xb_add(&bar[XB_XSUB(b.x)], 1u);
        const unsigned gen = old / nloc;
        if (old + 1u == (gen + 1u) * nloc) {
            __builtin_amdgcn_fence(__ATOMIC_RELEASE, "agent");
            asm volatile("s_waitcnt vmcnt(0)" ::: "memory");
            const unsigned og = xb_add(&bar[XB_TOP], 1u);
            const unsigned tg = og / nx;
            if (og + 1u == (tg + 1u) * nx) xb_add(&bar[XB_TOPGEN], 1u);
            else XB_SPIN(xb_ld(&bar[XB_TOPGEN]) == tg, bar);
            __builtin_amdgcn_fence(__ATOMIC_ACQUIRE, "agent");
            xb_add(&bar[XB_XGEN(b.x)], 1u);
            asm volatile("s_waitcnt vmcnt(0)" ::: "memory");
        } else {
            XB_SPIN(xb_ld(&bar[XB_XGEN(b.x)]) == gen, bar);
            __builtin_amdgcn_fence(__ATOMIC_ACQUIRE, "agent");
            asm volatile("s_waitcnt vmcnt(0)" ::: "memory");
        }
    }
    __syncthreads();
}

namespace pg8 {
constexpr int BM = 256, BK = 64, HALF = 128, HTB = HALF * BK * 2, STAGE_BYTES = 8 * HTB, NXCD = 8, WGM = 8;
__host__ __device__ __forceinline__ int lds_byte(int r, int c) { const int st = (r >> 4) * 2 + (c >> 5), rr = r & 15, cc = c & 31, ob = rr * 64 + cc * 2; return st * 1024 + (ob ^ (((ob >> 9) & 1) << 5)); }
__host__ __device__ __forceinline__ void stage_rc(int b, int& R, int& C) { const int st = b / 1024, sb = b % 1024, swz = sb ^ (((sb >> 9) & 1) << 5); R = (st >> 1) * 16 + swz / 64; C = (st & 1) * 32 + (swz % 64) / 2; }
__host__ __device__ __forceinline__ int perm32(int rho) { const int n = rho >> 4, i = rho & 15; return 8 * (i >> 2) + 4 * n + (i & 3); }
struct Unit { int pm, pn, koff, kt, mode; };
struct Gemm { const bf16_t* A; const bf16_t* Bt; int ld, K; };
struct StaticOrder {
    int nM, nN, nwg, G, c, kt;
    __device__ void init(int M, int N, int K, int G_, int c_) { nM = M / BM; nN = N / BM; nwg = nM * nN; G = G_; c = c_; kt = K / BK; }
    __device__ __forceinline__ void tile(int L, Unit& u) const {
        int wgid = L; { const int q = nwg / NXCD, r = nwg % NXCD, xcd = wgid % NXCD, off = wgid / NXCD; wgid = (xcd < r ? xcd * (q + 1) : r * (q + 1) + (xcd - r) * q) + off; }
        const int nig = WGM * nN, gid = wgid / nig, fm = gid * WGM, gsz = (nM - fm) < WGM ? (nM - fm) : WGM;
        u.pm = fm + ((wgid % nig) % gsz); u.pn = (wgid % nig) / gsz; u.koff = 0; u.kt = kt; u.mode = 0;
    }
    __device__ __forceinline__ bool next(int i, Unit& u) const { const long L = (long)i * G + c; if (L >= nwg) return false; tile((int)L, u); return true; }
};
struct OutOrder : StaticOrder {
    __device__ __forceinline__ bool next(int i, Unit& u) const {
        if (i < 2) { if (c >= nwg) return false; tile(c, u); u.koff = i * 1024; u.kt = 16; u.mode = i; return true; }
        if (i == 2 && c < 64) { u.pm = 32; u.pn = c >> 3; u.koff = (c & 7) * 256; u.kt = 4; u.mode = 2; return true; }
        return false;
    }
};
template <class Epi, class Sched>
__device__ __forceinline__ void gemm_phase(LAS unsigned char* lds, const Gemm g, const Sched& S, const Epi& E) {
    const int tid = threadIdx.x, wid = __builtin_amdgcn_readfirstlane(tid >> 6), lane = tid & 63, wr = wid >> 2, wc = wid & 3, fr = lane & 15, fq = lane >> 4;
    const int ld = g.ld;
    unsigned voffA[2], voffB[2];
#pragma unroll
    for (int i = 0; i < 2; ++i) { int R, C; stage_rc(tid * 16 + i * 8192, R, C); const int Rb = Epi::PERM ? ((R & ~31) + perm32(R & 31)) : R;
        voffA[i] = (unsigned)(R * ld + C) * 2u; voffB[i] = (unsigned)(Rb * ld + C) * 2u; }
    const size_t kstep = (size_t)(BK * 2);
    const size_t hstep = (size_t)HALF * ld * 2;
    const size_t tstep = 2 * hstep;
    const unsigned ldsw = (unsigned)wid * 1024u;
    const int aoff = lds_byte(wr * 64 + fr, fq * 8), boff = lds_byte(wc * 32 + fr, fq * 8);
#define PG8_SA(b, h) (((b) * 2 + (h)) * HTB)
#define PG8_SB(b, h) ((4 + (b) * 2 + (h)) * HTB)
#define PG8_STAGE(bufoff, gbase, voff) do { _Pragma("unroll") for (int _i = 0; _i < 2; ++_i) \
        __builtin_amdgcn_global_load_lds((const unsigned*)((const char*)(gbase) + (voff)[_i]), (LAS unsigned*)(lds + (bufoff) + ldsw + _i * 8192), 16, 0, 0); } while (0)
#define PG8_LDA(dst, b, h) do { _Pragma("unroll") for (int m = 0; m < 4; ++m) _Pragma("unroll") for (int k = 0; k < 2; ++k) dst[m][k] = *(const LAS bf16x8*)(lds + PG8_SA(b, h) + aoff + m * 2048 + k * 1024); } while (0)
#define PG8_LDB(dst, b, h) do { _Pragma("unroll") for (int n = 0; n < 2; ++n) _Pragma("unroll") for (int k = 0; k < 2; ++k) dst[n][k] = *(const LAS bf16x8*)(lds + PG8_SB(b, h) + boff + n * 2048 + k * 1024); } while (0)
#define PG8_MMA(ai, bj, At, Bt) do { __builtin_amdgcn_s_setprio(1); _Pragma("unroll") for (int m = 0; m < 4; ++m) _Pragma("unroll") for (int n = 0; n < 2; ++n) _Pragma("unroll") for (int k = 0; k < 2; ++k) \
        acc[ai][bj][m][n] = __builtin_amdgcn_mfma_f32_16x16x32_bf16(Bt[n][k], At[m][k], acc[ai][bj][m][n], 0, 0, 0); __builtin_amdgcn_s_setprio(0); } while (0)
#define PG8_WAIT_V(n) asm volatile("s_waitcnt vmcnt(" #n ")" ::: "memory")
#define PG8_WAIT_L(n) asm volatile("s_waitcnt lgkmcnt(" #n ")" ::: "memory")
#define PG8_BAR __builtin_amdgcn_s_barrier()
#define PG8_SCHED __builtin_amdgcn_sched_barrier(0)
    Unit cur, nxt; int ui = 0;
    if (!S.next(0, cur)) return;
    f32x4 acc[2][2][4][2];
#pragma unroll
    for (int a = 0; a < 2; ++a)
#pragma unroll
        for (int b = 0; b < 2; ++b)
#pragma unroll
            for (int m = 0; m < 4; ++m)
#pragma unroll
                for (int n = 0; n < 2; ++n) acc[a][b][m][n] = (f32x4){0.f, 0.f, 0.f, 0.f};
    bf16x8 At[4][2], B0[2][2], B1[2][2];
    const char* cA = (const char*)g.A + (size_t)cur.pm * tstep + (size_t)cur.koff * 2; const char* cB = (const char*)g.Bt + (size_t)cur.pn * tstep + (size_t)cur.koff * 2;
    PG8_STAGE(PG8_SB(0, 0), cB, voffB); PG8_STAGE(PG8_SA(0, 0), cA, voffA); PG8_STAGE(PG8_SB(0, 1), cB + hstep, voffB); PG8_STAGE(PG8_SA(0, 1), cA + hstep, voffA);
    if (wr == 1) PG8_BAR;
    PG8_WAIT_V(4); PG8_BAR;
    PG8_STAGE(PG8_SB(1, 0), cB + kstep, voffB); PG8_STAGE(PG8_SA(1, 0), cA + kstep, voffA); PG8_STAGE(PG8_SB(1, 1), cB + hstep + kstep, voffB);
    PG8_WAIT_V(6); PG8_BAR;
    for (;;) {
        const bool has_next = S.next(ui + 1, nxt);
        const char* nA = has_next ? (const char*)g.A + (size_t)nxt.pm * tstep + (size_t)nxt.koff * 2 : cA; const char* nB = has_next ? (const char*)g.Bt + (size_t)nxt.pn * tstep + (size_t)nxt.koff * 2 : cB;
        const int nt = cur.kt;
        for (int t = 0; t < nt; t += 2) {
            const bool last = (t == nt - 2);
            const char* a1 = cA + (size_t)(t + 1) * kstep;
            const char* a2 = last ? nA : cA + (size_t)(t + 2) * kstep; const char* b2 = last ? nB : cB + (size_t)(t + 2) * kstep;
            const char* a3 = a2 + kstep; const char* b3 = b2 + kstep;
            PG8_LDB(B0, 0, 0); PG8_SCHED; PG8_LDA(At, 0, 0); PG8_STAGE(PG8_SA(1, 1), a1 + hstep, voffA);
            PG8_WAIT_L(8); PG8_BAR; PG8_WAIT_L(0); PG8_MMA(0, 0, At, B0); PG8_BAR; PG8_SCHED;
            PG8_LDB(B1, 0, 1); PG8_STAGE(PG8_SB(0, 0), b2, voffB);
            PG8_BAR; PG8_WAIT_L(0); PG8_MMA(0, 1, At, B1); PG8_BAR;
            PG8_LDA(At, 0, 1); PG8_STAGE(PG8_SA(0, 0), a2, voffA);
            PG8_BAR; PG8_WAIT_L(0); PG8_MMA(1, 0, At, B0); PG8_BAR; PG8_SCHED;
            PG8_STAGE(PG8_SB(0, 1), b2 + hstep, voffB);
            PG8_WAIT_V(6); PG8_BAR; PG8_MMA(1, 1, At, B1); PG8_BAR;
            PG8_LDB(B0, 1, 0); PG8_SCHED; PG8_LDA(At, 1, 0); PG8_STAGE(PG8_SA(0, 1), a2 + hstep, voffA);
            PG8_WAIT_L(8); PG8_BAR; PG8_WAIT_L(0); PG8_MMA(0, 0, At, B0); PG8_BAR; PG8_SCHED;
            PG8_LDB(B1, 1, 1); PG8_STAGE(PG8_SB(1, 0), b3, voffB);
            PG8_BAR; PG8_WAIT_L(0); PG8_MMA(0, 1, At, B1); PG8_BAR;
            PG8_LDA(At, 1, 1); PG8_STAGE(PG8_SA(1, 0), a3, voffA);
            PG8_BAR; PG8_WAIT_L(0); PG8_MMA(1, 0, At, B0); PG8_BAR; PG8_SCHED;
            PG8_STAGE(PG8_SB(1, 1), b3 + hstep, voffB);
            PG8_WAIT_V(6); PG8_BAR; PG8_MMA(1, 1, At, B1); PG8_BAR;
        }
        E(acc, cur, wr, wc, fr, fq);
        if (!has_next) break;
#pragma unroll
        for (int a = 0; a < 2; ++a)
#pragma unroll
            for (int b = 0; b < 2; ++b)
#pragma unroll
                for (int m = 0; m < 4; ++m)
#pragma unroll
                    for (int n = 0; n < 2; ++n) acc[a][b][m][n] = (f32x4){0.f, 0.f, 0.f, 0.f};
        cur = nxt; cA = nA; cB = nB; ++ui;
    }
    PG8_WAIT_V(0);
    if (wr == 0) PG8_BAR;
    PG8_BAR;
#undef PG8_SA
#undef PG8_SB
#undef PG8_STAGE
#undef PG8_LDA
#undef PG8_LDB
#undef PG8_MMA
#undef PG8_WAIT_V
#undef PG8_WAIT_L
#undef PG8_BAR
#undef PG8_SCHED
}
}

struct EpiP {
    static constexpr bool PERM = true;
    bf16_t* P;
    __device__ __forceinline__ void operator()(const f32x4 (&acc)[2][2][4][2], const pg8::Unit& u, int wr, int wc, int fr, int fq) const {
        const int row0 = u.pm * 256 + wr * 64 + fr, col0 = u.pn * 256 + wc * 32 + 8 * fq;
        const int act = ((u.pn >= 4 && u.pn < 8) || (u.pn >= 20 && u.pn < 24)) ? 1 : ((u.pn >= 24 && u.pn < 40) ? 2 : 0);
#pragma unroll
        for (int ai = 0; ai < 2; ++ai)
#pragma unroll
            for (int m = 0; m < 4; ++m) { bf16_t* rowp = P + (size_t)(row0 + ai * 128 + m * 16) * LDP + col0;
#pragma unroll
                for (int bj = 0; bj < 2; ++bj) { f32x4 v0 = acc[ai][bj][m][0], v1 = acc[ai][bj][m][1];
                    if (act == 1) {
#pragma unroll
                        for (int j = 0; j < 4; ++j) { v0[j] = siluf_(v0[j]); v1[j] = siluf_(v1[j]); } }
                    else if (act == 2) {
#pragma unroll
                        for (int j = 0; j < 4; ++j) { v0[j] = sigmoidf_(v0[j]); v1[j] = sigmoidf_(v1[j]); } }
                    u32x4 w; w.x = cvt_pk_bf16(v0[0], v0[1]); w.y = cvt_pk_bf16(v0[2], v0[3]); w.z = cvt_pk_bf16(v1[0], v1[1]); w.w = cvt_pk_bf16(v1[2], v1[3]);
                    *(u32x4*)(rowp + bj * 128) = w; } }
    }
};
struct EpiGlu {
    static constexpr bool PERM = true;
    const bf16_t* Yg; const bf16_t* P; const float* bglu; bf16_t* A2;
    __device__ __forceinline__ void operator()(const f32x4 (&acc)[2][2][4][2], const pg8::Unit& u, int wr, int wc, int fr, int fq) const {
        const int row0 = u.pm * 256 + wr * 64 + fr, col0 = u.pn * 256 + wc * 32 + 8 * fq;
        f32x4 bv[2][2];
#pragma unroll
        for (int bj = 0; bj < 2; ++bj)
#pragma unroll
            for (int n = 0; n < 2; ++n) bv[bj][n] = *(const f32x4*)(bglu + col0 + bj * 128 + 4 * n);
#pragma unroll
        for (int ai = 0; ai < 2; ++ai)
#pragma unroll
            for (int m = 0; m < 4; ++m) { const size_t row = (size_t)(row0 + ai * 128 + m * 16);
#pragma unroll
                for (int bj = 0; bj < 2; ++bj) { const int c = col0 + bj * 128;
                    const u32x4 yg = *(const u32x4*)(Yg + row * 1024 + c), sz = *(const u32x4*)(P + row * LDP + PC_ZS + c);
                    const f32x4 a0 = acc[ai][bj][m][0] + bv[bj][0], a1 = acc[ai][bj][m][1] + bv[bj][1];
                    float o[8];
                    o[0] = bf_lo(yg.x) * sigmoidf_(a0[0]) * bf_lo(sz.x); o[1] = bf_hi(yg.x) * sigmoidf_(a0[1]) * bf_hi(sz.x);
                    o[2] = bf_lo(yg.y) * sigmoidf_(a0[2]) * bf_lo(sz.y); o[3] = bf_hi(yg.y) * sigmoidf_(a0[3]) * bf_hi(sz.y);
                    o[4] = bf_lo(yg.z) * sigmoidf_(a1[0]) * bf_lo(sz.z); o[5] = bf_hi(yg.z) * sigmoidf_(a1[1]) * bf_hi(sz.z);
                    o[6] = bf_lo(yg.w) * sigmoidf_(a1[2]) * bf_lo(sz.w); o[7] = bf_hi(yg.w) * sigmoidf_(a1[3]) * bf_hi(sz.w);
                    u32x4 w; w.x = cvt_pk_bf16(o[0], o[1]); w.y = cvt_pk_bf16(o[2], o[3]); w.z = cvt_pk_bf16(o[4], o[5]); w.w = cvt_pk_bf16(o[6], o[7]);
                    *(u32x4*)(A2 + row * 2048 + c) = w; } }
    }
};
struct EpiOut {
    static constexpr bool PERM = false;
    const bf16_t* P; const float* xp; const float* mod; float* out; float* rowss; bf16_t* tmp; float* slab;
    __device__ __forceinline__ void operator()(const f32x4 (&acc)[2][2][4][2], const pg8::Unit& u, int wr, int wc, int fr, int fq) const {
        const int row0 = u.pm * 256 + wr * 64 + fr, col0 = u.pn * 256 + wc * 32 + 4 * fq;
        if (u.mode == 0) {
#pragma unroll
            for (int ai = 0; ai < 2; ++ai)
#pragma unroll
                for (int m = 0; m < 4; ++m) { const size_t row = (size_t)(row0 + ai * 128 + m * 16); const bf16_t* prow = P + row * LDP + PC_GS + col0; bf16_t* trow = tmp + row * DM + col0;
#pragma unroll
                    for (int bj = 0; bj < 2; ++bj)
#pragma unroll
                        for (int n = 0; n < 2; ++n) { const int o = bj * 128 + n * 16; const u32x2 gg = *(const u32x2*)(prow + o); const f32x4 a = acc[ai][bj][m][n];
                            *(u32x2*)(trow + o) = pack4(bf_lo(gg.x) * a[0], bf_hi(gg.x) * a[1], bf_lo(gg.y) * a[2], bf_hi(gg.y) * a[3]); } }
        } else if (u.mode == 1) {
            f32x4 gt[2][2];
            { const float* gtrow = mod + (size_t)(u.pm >> 3) * NMOD + 2 * DM + col0;
#pragma unroll
              for (int bj = 0; bj < 2; ++bj)
#pragma unroll
                  for (int n = 0; n < 2; ++n) gt[bj][n] = *(const f32x4*)(gtrow + bj * 128 + n * 16); }
#pragma unroll
            for (int ai = 0; ai < 2; ++ai)
#pragma unroll
                for (int m = 0; m < 4; ++m) { const size_t row = (size_t)(row0 + ai * 128 + m * 16);
                    const bf16_t* prow = P + row * LDP + PC_GR + col0; const bf16_t* trow = tmp + row * DM + col0; const float* xrow = xp + row * DM + col0; float* orow = out + row * DM + col0;
                    u32x2 gg[4], tv[4]; f32x4 xv[4];
#pragma unroll
                    for (int q = 0; q < 4; ++q) { const int o = (q >> 1) * 128 + (q & 1) * 16; gg[q] = *(const u32x2*)(prow + o); tv[q] = *(const u32x2*)(trow + o); xv[q] = *(const f32x4*)(xrow + o); }
                    float ss = 0.f;
#pragma unroll
                    for (int q = 0; q < 4; ++q) { const int o = (q >> 1) * 128 + (q & 1) * 16; const f32x4 a = acc[ai][q >> 1][m][q & 1]; const f32x4 g4 = gt[q >> 1][q & 1];
                        f32x4 r; r[0] = xv[q][0] + g4[0] * (bf_lo(tv[q].x) + bf_lo(gg[q].x) * a[0]); r[1] = xv[q][1] + g4[1] * (bf_hi(tv[q].x) + bf_hi(gg[q].x) * a[1]);
                        r[2] = xv[q][2] + g4[2] * (bf_lo(tv[q].y) + bf_lo(gg[q].y) * a[2]); r[3] = xv[q][3] + g4[3] * (bf_hi(tv[q].y) + bf_hi(gg[q].y) * a[3]);
                        ss += (r[0] * r[0] + r[1] * r[1]) + (r[2] * r[2] + r[3] * r[3]);
                        *(f32x4*)(orow + o) = r; }
                    ss += __shfl_xor(ss, 16); ss += __shfl_xor(ss, 32);
                    if (fq == 0) rowss[row * 32 + u.pn * 4 + wc] = ss; }
        } else {
            const int gc = (u.koff < 1024) ? PC_GS : PC_GR; float* sl = slab + (size_t)(u.koff >> 8) * NSMP * DM;
#pragma unroll
            for (int m = 0; m < 4; ++m) { const size_t row = (size_t)(row0 + m * 16); const bf16_t* prow = P + row * LDP + gc + col0; float* srow = sl + (row - MP) * DM + col0;
#pragma unroll
                for (int bj = 0; bj < 2; ++bj)
#pragma unroll
                    for (int n = 0; n < 2; ++n) { const int o = bj * 128 + n * 16; const u32x2 gg = *(const u32x2*)(prow + o); const f32x4 a = acc[0][bj][m][n];
                        *(f32x4*)(srow + o) = (f32x4){bf_lo(gg.x) * a[0], bf_hi(gg.x) * a[1], bf_lo(gg.y) * a[2], bf_hi(gg.y) * a[3]}; } }
        }
    }
};

struct Args { const float* in[34]; float* out; unsigned char* ws; int ph_lo, ph_hi, li, pad; };
enum { I_XP = 0, I_XS, I_CP, I_CS, I_S5RE, I_S5IM, I_WKV, I_SHIFT, I_NORMG, I_WADA, I_BADA, I_WIN, I_MU, I_ARE, I_AIM, I_LOGSTEP, I_BRE, I_BIM, I_CRE, I_CIM, I_DSKIP,
       I_WGLU, I_BGLU, I_W0, I_W2, I_A0, I_A2, I_KK, I_KA, I_RK, I_GNW, I_GNB, I_WOUT, I_FINALG };

__device__ __forceinline__ void transpose_item(const float* W, int ldw, int K, int csrc, bf16_t* WT, int rdst, int k0, LAS float* scr, int lane, bool zero) {
    if (zero) {
#pragma unroll
        for (int j = 0; j < 4; ++j) { const int n = (lane >> 3) + 8 * j; *(u32x4*)(WT + (size_t)(rdst + n) * K + k0 + 8 * (lane & 7)) = (u32x4){0u, 0u, 0u, 0u}; }
        return;
    }
#pragma unroll 8
    for (int i = 0; i < 32; ++i) { const int kk = 2 * i + (lane >> 5); scr[kk * 33 + (lane & 31)] = W[(size_t)(k0 + kk) * ldw + csrc + (lane & 31)]; }
    LDS_WAIT(); asm volatile("" ::: "memory");
    const int c = lane & 7;
#pragma unroll
    for (int j = 0; j < 4; ++j) { const int n = (lane >> 3) + 8 * j; const LAS float* s = scr + (8 * c) * 33 + n;
        u32x4 o; o.x = cvt_pk_bf16(s[0 * 33], s[1 * 33]); o.y = cvt_pk_bf16(s[2 * 33], s[3 * 33]); o.z = cvt_pk_bf16(s[4 * 33], s[5 * 33]); o.w = cvt_pk_bf16(s[6 * 33], s[7 * 33]);
        *(u32x4*)(WT + (size_t)(rdst + n) * K + k0 + 8 * c) = o; }
    LDS_WAIT(); asm volatile("" ::: "memory");
}

__device__ __forceinline__ void p0_mod(const Args& a, LAS unsigned char* lds, int s, int wave, int lane) {
    const float* cp = a.in[I_CP]; const float* cs = a.in[I_CS]; const float* W = a.in[I_WADA]; const float* bias = a.in[I_BADA];
    float* mod = (float*)(a.ws + WS_MOD);
    const int n0 = 32 * s, k0 = 256 * wave, r31 = lane & 31, h = lane >> 5;
    f32x16 acc[5];
#pragma unroll
    for (int t = 0; t < 5; ++t)
#pragma unroll
        for (int r = 0; r < 16; ++r) acc[t][r] = 0.f;
    for (int ks = 0; ks < 16; ++ks) {
        const int kb = k0 + 16 * ks + 8 * h;
        float bw[8];
#pragma unroll
        for (int j = 0; j < 8; ++j) bw[j] = W[(size_t)(kb + j) * NMOD + n0 + r31];
        bf16x8 bfr; { u32x4 t; t.x = cvt_pk_bf16(bw[0], bw[1]); t.y = cvt_pk_bf16(bw[2], bw[3]); t.z = cvt_pk_bf16(bw[4], bw[5]); t.w = cvt_pk_bf16(bw[6], bw[7]); bfr = __builtin_bit_cast(bf16x8, t); }
#pragma unroll
        for (int t = 0; t < 5; ++t) {
            const int R = 32 * t + r31;
            f32x4 c0 = (f32x4){0.f, 0.f, 0.f, 0.f}, c1 = c0;
            if (R < NMODROWS) { const float* src = (R < NB) ? cp + (size_t)R * DM + kb : cs + (size_t)(R - NB) * DM + kb; c0 = *(const f32x4*)src; c1 = *(const f32x4*)(src + 4); }
            u32x4 w; w.x = cvt_pk_bf16(siluf_(c0[0]), siluf_(c0[1])); w.y = cvt_pk_bf16(siluf_(c0[2]), siluf_(c0[3])); w.z = cvt_pk_bf16(siluf_(c1[0]), siluf_(c1[1])); w.w = cvt_pk_bf16(siluf_(c1[2]), siluf_(c1[3]));
            acc[t] = __builtin_amdgcn_mfma_f32_32x32x16_bf16(__builtin_bit_cast(bf16x8, w), bfr, acc[t], 0, 0, 0);
        }
    }
    LAS float* red = (LAS float*)lds;
#pragma unroll
    for (int step = 4; step >= 1; step >>= 1) {
        if (wave >= step && wave < 2 * step) {
#pragma unroll
            for (int t = 0; t < 5; ++t)
#pragma unroll
                for (int r = 0; r < 16; ++r) red[(((wave - step) * 5 + t) * 16 + r) * 64 + lane] = acc[t][r];
        }
        __syncthreads();
        if (wave < step) {
#pragma unroll
            for (int t = 0; t < 5; ++t)
#pragma unroll
                for (int r = 0; r < 16; ++r) acc[t][r] += red[((wave * 5 + t) * 16 + r) * 64 + lane];
        }
        __syncthreads();
    }
    if (wave == 0) {
        const float bc = bias[n0 + r31];
#pragma unroll
        for (int t = 0; t < 5; ++t)
#pragma unroll
            for (int r = 0; r < 16; ++r) { const int R = 32 * t + (r & 3) + 8 * (r >> 2) + 4 * h; if (R < NMODROWS) mod[(size_t)R * NMOD + n0 + r31] = acc[t][r] + bc; }
    }
}

__device__ __forceinline__ void p0_s5_tables(const Args& a, LAS unsigned char* lds, int g, int tid) {
    LAS float* pw = (LAS float*)lds;
    LAS float* bbL = pw + 17 * 128;
    LAS float* ccL = bbL + 2048;
    LAS float* KF = ccL + 2048;
    LAS float* DL = KF + 4096;
    unsigned char* tab = (unsigned char*)a.out + DO_S5TAB + (size_t)g * S5T_BYTES;
    {
        const int p = tid & 63;
        const float step = expf(a.in[I_LOGSTEP][g]);
        const float lre = fminf(a.in[I_ARE][g * 64 + p], -1e-4f), lim = a.in[I_AIM][g * 64 + p];
        const float mag = expf(lre * step); float sn, cs; sincosf(lim * step, &sn, &cs);
        const float abr = mag * cs, abi = mag * sn, den = lre * lre + lim * lim;
        const float fr = ((abr - 1.0f) * lre + abi * lim) / den, fi = (abi * lre - (abr - 1.0f) * lim) / den;
        if (tid < 64) { float pr = 1.f, pi = 0.f;
            for (int e = 0; e <= 16; ++e) { pw[(e * 64 + p) * 2] = pr; pw[(e * 64 + p) * 2 + 1] = pi; const float nr = pr * abr - pi * abi, ni = pr * abi + pi * abr; pr = nr; pi = ni; } }
#pragma unroll
        for (int i = 0; i < 2; ++i) { const int c = (tid >> 6) + 8 * i; const float br = a.in[I_BRE][(g * 64 + p) * 16 + c], bi = a.in[I_BIM][(g * 64 + p) * 16 + c];
            bbL[(p * 16 + c) * 2] = fr * br - fi * bi; bbL[(p * 16 + c) * 2 + 1] = fr * bi + fi * br;
            ccL[(c * 64 + p) * 2] = a.in[I_CRE][(g * 16 + c) * 64 + p]; ccL[(c * 64 + p) * 2 + 1] = a.in[I_CIM][(g * 16 + c) * 64 + p]; }
        if (tid < 16) DL[tid] = a.in[I_DSKIP][g * 16 + tid];
    }
    __syncthreads();
    for (int idx = tid; idx < 4096; idx += 512) { const int e = idx >> 8, c = (idx >> 4) & 15, c2 = idx & 15; float s = 0.f;
        for (int p = 0; p < 64; ++p) { const float cr = ccL[(c * 64 + p) * 2], ci = ccL[(c * 64 + p) * 2 + 1], pr = pw[(e * 64 + p) * 2], pi = pw[(e * 64 + p) * 2 + 1];
            const float ar = cr * pr - ci * pi, ai = cr * pi + ci * pr; s += ar * bbL[(p * 16 + c2) * 2] - ai * bbL[(p * 16 + c2) * 2 + 1]; }
        if (e == 0 && c == c2) s += DL[c];
        KF[idx] = s; }
    __syncthreads();
    for (int it = tid; it < 4096; it += 512) { const int l = it & 63, s = (it >> 6) & 15, mtile = it >> 10; const int m = 32 * mtile + (l & 31), h = l >> 5, p = m & 63, im = m >> 6;
        const float pr = pw[((15 - s) * 64 + p) * 2], pi = pw[((15 - s) * 64 + p) * 2 + 1]; float v[8];
#pragma unroll
        for (int j = 0; j < 8; ++j) { const float br = bbL[(p * 16 + 8 * h + j) * 2], bi = bbL[(p * 16 + 8 * h + j) * 2 + 1]; v[j] = im ? (pr * bi + pi * br) : (pr * br - pi * bi); }
        u32x4 w; w.x = cvt_pk_bf16(v[0], v[1]); w.y = cvt_pk_bf16(v[2], v[3]); w.z = cvt_pk_bf16(v[4], v[5]); w.w = cvt_pk_bf16(v[6], v[7]);
        *(u32x4*)(tab + S5T_ME + (size_t)it * 16) = w; }
    for (int it = tid; it < 1024; it += 512) { const int l = it & 63, ti = it >> 6; const int rho = l & 31, dt = rho >> 4, c = rho & 15, h = l >> 5, e = ti - 1 + dt; float v[8];
#pragma unroll
        for (int j = 0; j < 8; ++j) v[j] = (e < 0) ? 0.f : KF[(e * 16 + c) * 16 + 8 * h + j];
        u32x4 w; w.x = cvt_pk_bf16(v[0], v[1]); w.y = cvt_pk_bf16(v[2], v[3]); w.z = cvt_pk_bf16(v[4], v[5]); w.w = cvt_pk_bf16(v[6], v[7]);
        *(u32x4*)(tab + S5T_KT + (size_t)it * 16) = w; }
    for (int it = tid; it < 4096; it += 512) { const int l = it & 63, ks = (it >> 6) & 7, mt = it >> 9; const int rho = l & 31, dt = rho >> 4, c = rho & 15, h = l >> 5, t = 2 * mt + dt; float v[8];
#pragma unroll
        for (int j = 0; j < 8; ++j) { const int m = 16 * ks + 8 * h + j, p = m & 63; const float cr = ccL[(c * 64 + p) * 2], ci = ccL[(c * 64 + p) * 2 + 1], pr = pw[((t + 1) * 64 + p) * 2], pi = pw[((t + 1) * 64 + p) * 2 + 1];
            v[j] = (m < 64) ? (cr * pr - ci * pi) : -(cr * pi + ci * pr); }
        u32x4 w; w.x = cvt_pk_bf16(v[0], v[1]); w.y = cvt_pk_bf16(v[2], v[3]); w.z = cvt_pk_bf16(v[4], v[5]); w.w = cvt_pk_bf16(v[6], v[7]);
        *(u32x4*)(tab + S5T_CA + (size_t)it * 16) = w; }
    { const int it = tid; const int l = it & 63, sp = (it >> 6) & 1, mtile = it >> 7; const int rho = l & 31, h = l >> 5; float v[8];
#pragma unroll
        for (int j = 0; j < 8; ++j) { const int m = 32 * mtile + 16 * sp + 8 * (j >> 2) + 4 * h + (j & 3), p = m & 63; v[j] = (rho < 16) ? ((m < 64) ? ccL[(rho * 64 + p) * 2] : -ccL[(rho * 64 + p) * 2 + 1]) : 0.f; }
        u32x4 w; w.x = cvt_pk_bf16(v[0], v[1]); w.y = cvt_pk_bf16(v[2], v[3]); w.z = cvt_pk_bf16(v[4], v[5]); w.w = cvt_pk_bf16(v[6], v[7]);
        *(u32x4*)(tab + S5T_C0 + (size_t)it * 16) = w; }
    if (tid < 64) { const int l = tid, rho = l & 31, h = l >> 5; float v[8];
#pragma unroll
        for (int j = 0; j < 8; ++j) v[j] = (rho < 16 && rho == 8 * h + j) ? DL[rho] : 0.f;
        u32x4 w; w.x = cvt_pk_bf16(v[0], v[1]); w.y = cvt_pk_bf16(v[2], v[3]); w.z = cvt_pk_bf16(v[4], v[5]); w.w = cvt_pk_bf16(v[6], v[7]);
        *(u32x4*)(tab + S5T_DF + (size_t)l * 16) = w;
        float* hdr = (float*)(tab + S5T_HDR);
        hdr[l] = pw[(16 * 64 + l) * 2]; hdr[64 + l] = pw[(16 * 64 + l) * 2 + 1]; hdr[128 + l] = pw[(64 + l) * 2]; hdr[192 + l] = pw[(64 + l) * 2 + 1]; }
    __syncthreads();
}

__device__ __forceinline__ void p1_row(const Args& a, int m, int lane) {
    bf16_t* XN = (bf16_t*)(a.ws + WS_XN) + (size_t)m * DM;
    if (m >= MV) {
        const float* src = a.in[I_SHIFT] + (size_t)(m - MV) * DM;
#pragma unroll
        for (int j = 0; j < 8; ++j) { const f32x4 v = *(const f32x4*)(src + 4 * lane + 256 * j); u32x2 w; w.x = cvt_pk_bf16(v[0], v[1]); w.y = cvt_pk_bf16(v[2], v[3]); *(u32x2*)(XN + 4 * lane + 256 * j) = w; }
        return;
    }
    const float* x = (m < MP) ? a.in[I_XP] + (size_t)m * DM : a.in[I_XS] + (size_t)(m - MP) * DM;
    const int mrow = (m < MP) ? (m >> 11) : (NB + m - MP);
    const float* mod = (const float*)(a.ws + WS_MOD) + (size_t)mrow * NMOD;
    const float* g = a.in[I_NORMG];
    f32x4 v[8]; float ss = 0.f;
#pragma unroll
    for (int j = 0; j < 8; ++j) { v[j] = *(const f32x4*)(x + 4 * lane + 256 * j); ss += (v[j][0] * v[j][0] + v[j][1] * v[j][1]) + (v[j][2] * v[j][2] + v[j][3] * v[j][3]); }
    const float rstd = rsqrtf(wave_sum(ss) * (1.0f / DM) + RMS_EPS);
    float* sh_out = nullptr;
    if (m >= MP) sh_out = a.out + OUT_SHIFT_S + (size_t)(m - MP) * DM;
    else if ((m & (SEQ - 1)) == SEQ - 1) sh_out = a.out + OUT_SHIFT_P + (size_t)(m >> 11) * DM;
#pragma unroll
    for (int j = 0; j < 8; ++j) { const int k = 4 * lane + 256 * j; const f32x4 gv = *(const f32x4*)(g + k), sh = *(const f32x4*)(mod + k), sc = *(const f32x4*)(mod + DM + k);
        f32x4 hv;
#pragma unroll
        for (int q = 0; q < 4; ++q) hv[q] = v[j][q] * rstd * gv[q] * (1.0f + sc[q]) + sh[q];
        u32x2 w; w.x = cvt_pk_bf16(hv[0], hv[1]); w.y = cvt_pk_bf16(hv[2], hv[3]); *(u32x2*)(XN + k) = w;
        if (sh_out) *(f32x4*)(sh_out + k) = hv; }
}

constexpr int RW_TB = 32;
constexpr int RW_KK = 0, RW_DR = 2048, RW_DD = 4096, RW_BB = 6144, RW_KP = 8192, RW_VV = 10240, RW_SC = 11264, RW_LW = 11392, RW_LA = 13440, RW_OB = 15488, RW_BVB = 16512, RW_END = 17536;
__device__ __forceinline__ void lerp8(const bf16_t* cur, const bf16_t* prev, bool has_prev, const float* mu, float (&o)[8]) {
    const u32x4 c = *(const u32x4*)cur; u32x4 p = (u32x4){0u, 0u, 0u, 0u}; if (has_prev) p = *(const u32x4*)prev;
    const f32x4 m0 = *(const f32x4*)mu, m1 = *(const f32x4*)(mu + 4);
    const float cf[8] = {bf_lo(c.x), bf_hi(c.x), bf_lo(c.y), bf_hi(c.y), bf_lo(c.z), bf_hi(c.z), bf_lo(c.w), bf_hi(c.w)};
    const float pf[8] = {bf_lo(p.x), bf_hi(p.x), bf_lo(p.y), bf_hi(p.y), bf_lo(p.z), bf_hi(p.z), bf_lo(p.w), bf_hi(p.w)};
    const float mf[8] = {m0[0], m0[1], m0[2], m0[3], m1[0], m1[1], m1[2], m1[3]};
#pragma unroll
    for (int j = 0; j < 8; ++j) o[j] = cf[j] + (pf[j] - cf[j]) * mf[j];
}
struct RwTok { float kk, dr, dd, bb, kp, v, br, kr, bonus; };
__device__ __forceinline__ RwTok rw_token(const Args& a, int hj, float r, float k, float v, float lw, float la) {
    RwTok o;
    const float wpre = a.in[I_W0][hj] + lw;
    const float nz = -wpre;
    const float sp = fmaxf(nz, 0.f) + log1pf(__expf(-fabsf(nz)));
    const float w = -sp - 0.5f;
    o.dd = __expf(-__expf(w));
    const float av = sigmoidf_(a.in[I_A0][hj] + la);
    const float kkv = k * a.in[I_KK][hj];
    const float nrm = sqrtf(wave_sum(kkv * kkv));
    o.kk = kkv / fmaxf(nrm, 1e-12f);
    o.kp = k * (1.0f + (av - 1.0f) * a.in[I_KA][hj]);
    o.bb = o.kk * av;
    o.dr = o.dd * r;
    o.v = v;
    o.br = wave_sum(o.bb * r);
    o.kr = wave_sum(o.kp * r);
    o.bonus = wave_sum(r * o.kp * a.in[I_RK][hj]);
    return o;
}
__device__ __forceinline__ void p3_rwkv_prompt(const Args& a, LAS unsigned char* lds, int unit, int tid, int wave, int lane) {
    const int b = unit >> 5, h = (unit >> 1) & 15, half = unit & 1;
    LAS float* L = (LAS float*)lds;
    const bf16_t* P = (const bf16_t*)(a.ws + WS_P);
    bf16_t* ORAW = (bf16_t*)((unsigned char*)a.out + DO_ORAW); bf16_t* BV = (bf16_t*)((unsigned char*)a.out + DO_BV);
    const float* mu = a.in[I_MU];
    const int r31 = lane & 31, hh = lane >> 5;
    bf16x8 bfr[4];
    if (wave < 4) { const float* W2 = (wave >> 1) ? a.in[I_A2] : a.in[I_W2]; const int col = h * 64 + 32 * (wave & 1) + r31;
#pragma unroll
        for (int ks = 0; ks < 4; ++ks) { float w[8];
#pragma unroll
            for (int j = 0; j < 8; ++j) w[j] = W2[(size_t)(16 * ks + 8 * hh + j) * 1024 + col];
            u32x4 t; t.x = cvt_pk_bf16(w[0], w[1]); t.y = cvt_pk_bf16(w[2], w[3]); t.z = cvt_pk_bf16(w[4], w[5]); t.w = cvt_pk_bf16(w[6], w[7]); bfr[ks] = __builtin_bit_cast(bf16x8, t); } }
    const int srow = 4 * wave + (lane >> 4), cq = lane & 15;
    f32x4 S = (f32x4){0.f, 0.f, 0.f, 0.f};
    for (int t0 = 0; t0 < SEQ; t0 += RW_TB) {
        const size_t rowbase = (size_t)b * SEQ + t0;
        if (wave < 4) { const int mat = wave >> 1, nt2 = wave & 1; const size_t row = rowbase + r31; const bool hp = (t0 + r31) > 0;
            f32x16 acc;
#pragma unroll
            for (int r = 0; r < 16; ++r) acc[r] = 0.f;
#pragma unroll
            for (int ks = 0; ks < 4; ++ks) { const int col = PC_WD + mat * 64 + 16 * ks + 8 * hh; float x8[8];
                lerp8(P + row * LDP + col, P + (row - 1) * LDP + col, hp, mu + 3072 + mat * 64 + 16 * ks + 8 * hh, x8);
                if (mat == 0) {
#pragma unroll
                    for (int j = 0; j < 8; ++j) x8[j] = tanhf_(x8[j]); }
                u32x4 t; t.x = cvt_pk_bf16(x8[0], x8[1]); t.y = cvt_pk_bf16(x8[2], x8[3]); t.z = cvt_pk_bf16(x8[4], x8[5]); t.w = cvt_pk_bf16(x8[6], x8[7]);
                acc = __builtin_amdgcn_mfma_f32_32x32x16_bf16(__builtin_bit_cast(bf16x8, t), bfr[ks], acc, 0, 0, 0); }
            LAS float* dst = L + (mat ? RW_LA : RW_LW);
#pragma unroll
            for (int r = 0; r < 16; ++r) { const int tl = (r & 3) + 8 * (r >> 2) + 4 * hh; dst[tl * 64 + 32 * nt2 + r31] = acc[r]; } }
        __syncthreads();
#pragma unroll
        for (int q = 0; q < 4; ++q) { const int tl = wave * 4 + q; const size_t row = rowbase + tl; const bool hp = (t0 + tl) > 0; const int hj = h * 64 + lane;
            const bf16_t* pc = P + row * LDP; const bf16_t* pp = pc - LDP;
            float r = bf2f(pc[PC_R + hj]), k = bf2f(pc[PC_K + hj]), v = bf2f(pc[PC_V + hj]);
            const float pr = hp ? bf2f(pp[PC_R + hj]) : 0.f, pk = hp ? bf2f(pp[PC_K + hj]) : 0.f, pv = hp ? bf2f(pp[PC_V + hj]) : 0.f;
            r += (pr - r) * mu[hj]; k += (pk - k) * mu[1024 + hj]; v += (pv - v) * mu[2048 + hj];
            const RwTok o = rw_token(a, hj, r, k, v, L[RW_LW + tl * 64 + lane], L[RW_LA + tl * 64 + lane]);
            L[RW_KK + tl * 64 + lane] = o.kk; L[RW_DR + tl * 64 + lane] = o.dr; L[RW_DD + tl * 64 + lane] = o.dd; L[RW_BB + tl * 64 + lane] = o.bb; L[RW_KP + tl * 64 + lane] = o.kp;
            if ((lane >> 5) == half) L[RW_VV + tl * 32 + (lane & 31)] = o.v;
            if (lane == 0) { L[RW_SC + tl * 4] = o.br; L[RW_SC + tl * 4 + 1] = o.kr; L[RW_SC + tl * 4 + 2] = o.bonus; } }
        __syncthreads();
#pragma unroll 4
        for (int tl = 0; tl < RW_TB; ++tl) {
            const f32x4 kk4 = *(const LAS f32x4*)(L + RW_KK + tl * 64 + 4 * cq), dr4 = *(const LAS f32x4*)(L + RW_DR + tl * 64 + 4 * cq), d4 = *(const LAS f32x4*)(L + RW_DD + tl * 64 + 4 * cq),
                        b4 = *(const LAS f32x4*)(L + RW_BB + tl * 64 + 4 * cq), k4 = *(const LAS f32x4*)(L + RW_KP + tl * 64 + 4 * cq);
            const float v = L[RW_VV + tl * 32 + srow]; const f32x4 sc = *(const LAS f32x4*)(L + RW_SC + tl * 4);
            float p1 = (S[0] * kk4[0] + S[1] * kk4[1]) + (S[2] * kk4[2] + S[3] * kk4[3]);
            float p2 = (S[0] * dr4[0] + S[1] * dr4[1]) + (S[2] * dr4[2] + S[3] * dr4[3]);
            p1 = row16_sum(p1); p2 = row16_sum(p2);
            const float sa = -p1;
            const float o = p2 + sa * sc[0] + v * sc[1];
#pragma unroll
            for (int j = 0; j < 4; ++j) S[j] = S[j] * d4[j] + sa * b4[j] + v * k4[j];
            if (cq == 0) { L[RW_OB + tl * 32 + srow] = o; L[RW_BVB + tl * 32 + srow] = sc[2] * v; }
        }
        __syncthreads();
        { const int tl = tid >> 4, r2 = 2 * (tid & 15); const size_t off = (rowbase + tl) * 1024 + h * 64 + 32 * half + r2;
          *(unsigned*)(ORAW + off) = cvt_pk_bf16(L[RW_OB + tl * 32 + r2], L[RW_OB + tl * 32 + r2 + 1]);
          *(unsigned*)(BV + off) = cvt_pk_bf16(L[RW_BVB + tl * 32 + r2], L[RW_BVB + tl * 32 + r2 + 1]); }
    }
    *(f32x4*)(a.out + OUT_WKV_P + (((size_t)(b * 16 + h) * 64 + 32 * half + srow) * 64 + 4 * cq)) = S;
    __syncthreads();
}


constexpr int RC_LD = 72, RC_MAT = 64 * RC_LD * 2;
constexpr int RC_QK = 0 * RC_MAT, RC_RT = 1 * RC_MAT, RC_KT = 2 * RC_MAT, RC_BT = 3 * RC_MAT, RC_QKT = 4 * RC_MAT, RC_BHT = 5 * RC_MAT, RC_KHT = 6 * RC_MAT, RC_VT = 7 * RC_MAT,
              RC_AKK = 8 * RC_MAT, RC_ARK = 9 * RC_MAT, RC_ARB = 10 * RC_MAT, RC_TB = 11 * RC_MAT, RC_AKB = 12 * RC_MAT, RC_W1T = 12 * RC_MAT, RC_U1T = 13 * RC_MAT,
              RC_AVT = RC_QK, RC_TF = RC_KT, RC_LWA = RC_AKK, RC_SEG = 14 * RC_MAT;
static_assert(RC_SEG + 2048 <= RING_BYTES, "rwkv chunk lds");
constexpr int RS_ROWB = 656, RS_BASE = 0;
static_assert(RS_BASE + 65 * RS_ROWB <= RC_AKK, "staging must stay inside R0..R7");
#define MFMA32(a, b, c) __builtin_amdgcn_mfma_f32_32x32x16_bf16((a), (b), (c), 0, 0, 0)
#define MFMA16(a, b, c) __builtin_amdgcn_mfma_f32_16x16x32_bf16((a), (b), (c), 0, 0, 0)
__device__ __forceinline__ bf16x8 lds_frag(LAS unsigned char* lds, int mat, int row, int k0) { return *(const LAS bf16x8*)(lds + mat + (row * RC_LD + k0) * 2); }

__device__ __forceinline__ void p3_rwkv_chunks(const Args& a, LAS unsigned char* lds, int bh, int seg, int tid, int wave, int lane) {
    const int b = bh >> 4, h = bh & 15, r31_ = lane & 31, hh_ = lane >> 5, hj = h * 64 + lane;
    const bf16_t* P = (const bf16_t*)(a.ws + WS_P);
    bf16_t* BV = (bf16_t*)((unsigned char*)a.out + DO_BV);
    const float* mu = a.in[I_MU];
    LAS float* SEG = (LAS float*)(lds + RC_SEG);
    bf16x8 bfr[4];
    { const float* W2 = (wave >> 2) ? a.in[I_A2] : a.in[I_W2]; const int col = h * 64 + 32 * (wave & 1) + r31_;
#pragma unroll
      for (int ks = 0; ks < 4; ++ks) { float w[8];
#pragma unroll
          for (int j = 0; j < 8; ++j) w[j] = W2[(size_t)(16 * ks + 8 * hh_ + j) * 1024 + col];
          u32x4 t; t.x = cvt_pk_bf16(w[0], w[1]); t.y = cvt_pk_bf16(w[2], w[3]); t.z = cvt_pk_bf16(w[4], w[5]); t.w = cvt_pk_bf16(w[6], w[7]); bfr[ks] = __builtin_bit_cast(bf16x8, t); } }
    const float w0j = a.in[I_W0][hj], a0j = a.in[I_A0][hj], kkj = a.in[I_KK][hj], kaj = a.in[I_KA][hj], rkj = a.in[I_RK][hj];
    const float mur = mu[hj], muk = mu[1024 + hj], muv = mu[2048 + hj];
    unsigned goff[6], loff[6]; u32x4 pf[6];
#pragma unroll
    for (int i = 0; i < 6; ++i) { const int idx = tid + 512 * i, row = idx / 40, c = idx - row * 40;
        const int col = (c < 8) ? PC_R + h * 64 + 8 * c : ((c < 16) ? PC_K + h * 64 + 8 * (c - 8) : ((c < 24) ? PC_V + h * 64 + 8 * (c - 16) : PC_WD + 8 * (c - 24)));
        goff[i] = (unsigned)(row * LDP + col) * 2u; loff[i] = (unsigned)(RS_BASE + row * RS_ROWB + c * 16); }
#define RWC_PREFETCH(chunk_) do { const unsigned char* pb_ = (const unsigned char*)(P + ((size_t)b * SEQ + (size_t)(chunk_) * 64 - 1) * LDP); \
        _Pragma("unroll") for (int i = 0; i < 6; ++i) { const bool ok_ = (tid + 512 * i < 2600) && ((chunk_) > 0 || tid + 512 * i >= 40); \
            pf[i] = (u32x4){0u, 0u, 0u, 0u}; if (ok_) pf[i] = *(const u32x4*)(pb_ + goff[i]); } } while (0)
    RWC_PREFETCH(seg * 8);
#pragma unroll 1
    for (int ci = 0; ci < 8; ++ci) {
        const int chunk = seg * 8 + ci; const size_t rowbase = (size_t)b * SEQ + chunk * 64;
#pragma unroll
        for (int i = 0; i < 6; ++i) if (tid + 512 * i < 2600) *(LAS u32x4*)(lds + loff[i]) = pf[i];
        if (ci + 1 < 8) RWC_PREFETCH(chunk + 1);
        __syncthreads();
        int r31 = r31_, hh = hh_; asm volatile("" : "+v"(r31), "+v"(hh));
        unsigned char* rwi = a.ws + WS_RWI + (size_t)((bh * 32) + chunk) * RWI_BYTES;
        { const int mat = wave >> 2, mtile = (wave >> 1) & 1, nt2 = wave & 1; const int tl = 32 * mtile + r31;
          f32x16 acc;
#pragma unroll
          for (int r = 0; r < 16; ++r) acc[r] = 0.f;
#pragma unroll
          for (int ks = 0; ks < 4; ++ks) { float x8[8];
              { const u32x4 c = *(const LAS u32x4*)(lds + RS_BASE + (tl + 1) * RS_ROWB + (24 + mat * 8 + 2 * ks + hh) * 16), p = *(const LAS u32x4*)(lds + RS_BASE + tl * RS_ROWB + (24 + mat * 8 + 2 * ks + hh) * 16);
                const float* mp = mu + 3072 + mat * 64 + 16 * ks + 8 * hh; const f32x4 m0 = *(const f32x4*)mp, m1 = *(const f32x4*)(mp + 4);
                const float cf[8] = {bf_lo(c.x), bf_hi(c.x), bf_lo(c.y), bf_hi(c.y), bf_lo(c.z), bf_hi(c.z), bf_lo(c.w), bf_hi(c.w)};
                const float pf8[8] = {bf_lo(p.x), bf_hi(p.x), bf_lo(p.y), bf_hi(p.y), bf_lo(p.z), bf_hi(p.z), bf_lo(p.w), bf_hi(p.w)};
                const float mf[8] = {m0[0], m0[1], m0[2], m0[3], m1[0], m1[1], m1[2], m1[3]};
#pragma unroll
                for (int j = 0; j < 8; ++j) x8[j] = cf[j] + (pf8[j] - cf[j]) * mf[j]; }
              if (mat == 0) {
#pragma unroll
                  for (int j = 0; j < 8; ++j) x8[j] = tanhf_(x8[j]); }
              u32x4 t; t.x = cvt_pk_bf16(x8[0], x8[1]); t.y = cvt_pk_bf16(x8[2], x8[3]); t.z = cvt_pk_bf16(x8[4], x8[5]); t.w = cvt_pk_bf16(x8[6], x8[7]);
              acc = MFMA32(__builtin_bit_cast(bf16x8, t), bfr[ks], acc); }
          LAS float* dst = (LAS float*)(lds + RC_LWA) + mat * 64 * 68;
#pragma unroll
          for (int r = 0; r < 16; ++r) { const int t2 = 32 * mtile + (r & 3) + 8 * (r >> 2) + 4 * hh; dst[t2 * 68 + 32 * nt2 + r31] = acc[r]; } }
        __syncthreads();
        float r8[8], kp8[8], kk8[8], bb8[8], v8[8], ld8[8], cs8[8];
        { const LAS float* LW = (const LAS float*)(lds + RC_LWA); const LAS float* LA = LW + 64 * 68;
#pragma unroll
          for (int q = 0; q < 8; ++q) { const int tl = 8 * wave + q; const size_t row = rowbase + tl;
              const LAS bf16_t* pc = (const LAS bf16_t*)(lds + RS_BASE + (tl + 1) * RS_ROWB); const LAS bf16_t* pp = (const LAS bf16_t*)(lds + RS_BASE + tl * RS_ROWB);
              float r = bf2f(pc[lane]), k = bf2f(pc[64 + lane]), v = bf2f(pc[128 + lane]);
              const float pr = bf2f(pp[lane]), pk = bf2f(pp[64 + lane]), pv = bf2f(pp[128 + lane]);
              r += (pr - r) * mur; k += (pk - k) * muk; v += (pv - v) * muv;
              ld8[q] = -0.6065306597126334f * sigmoidf_(w0j + LW[tl * 68 + lane]);
              const float av = sigmoidf_(a0j + LA[tl * 68 + lane]);
              const float kkv = k * kkj; const float rn = fminf(__builtin_amdgcn_rsqf(wave_sum_dpp(kkv * kkv)), 1e12f);
              kk8[q] = kkv * rn; kp8[q] = k * (1.0f + (av - 1.0f) * kaj); bb8[q] = kk8[q] * av; r8[q] = r; v8[q] = v;
              const float bonus = wave_sum_dpp(r * kp8[q] * rkj);
              BV[row * 1024 + hj] = f2bf(bonus * v); }
          cs8[0] = ld8[0];
#pragma unroll
          for (int q = 1; q < 8; ++q) cs8[q] = cs8[q - 1] + ld8[q];
          SEG[wave * 64 + lane] = cs8[7]; }
        __syncthreads();
        { float off = 0.f, cL = 0.f;
#pragma unroll
          for (int w2 = 0; w2 < 8; ++w2) { const float sg = SEG[w2 * 64 + lane]; cL += sg; if (w2 < wave) off += sg; }
          if (wave == 0) *(float*)(rwi + RWI_LAM + lane * 4) = __expf(cL);
          float qkT[8], bhT[8], khT[8];
          const float eLtot = __expf(cL); float ecprev = __expf(off);
#pragma unroll
          for (int q = 0; q < 8; ++q) { const int tl = 8 * wave + q; const float c = off + cs8[q];
              const float ec = __expf(c), ecp = ecprev, enc = rcpf_(ec), eL = eLtot * enc; ecprev = ec;
              const float qk = kk8[q] * ecp;
              ((LAS bf16_t*)(lds + RC_QK))[tl * RC_LD + lane] = f2bf(qk); ((LAS bf16_t*)(lds + RC_RT))[tl * RC_LD + lane] = f2bf(r8[q] * ec);
              ((LAS bf16_t*)(lds + RC_KT))[tl * RC_LD + lane] = f2bf(kp8[q] * enc); ((LAS bf16_t*)(lds + RC_BT))[tl * RC_LD + lane] = f2bf(bb8[q] * enc);
              qkT[q] = qk; bhT[q] = bb8[q] * eL; khT[q] = kp8[q] * eL; }
          u32x4 t;
          t.x = cvt_pk_bf16(qkT[0], qkT[1]); t.y = cvt_pk_bf16(qkT[2], qkT[3]); t.z = cvt_pk_bf16(qkT[4], qkT[5]); t.w = cvt_pk_bf16(qkT[6], qkT[7]); *(LAS u32x4*)(lds + RC_QKT + (lane * RC_LD + 8 * wave) * 2) = t;
          t.x = cvt_pk_bf16(bhT[0], bhT[1]); t.y = cvt_pk_bf16(bhT[2], bhT[3]); t.z = cvt_pk_bf16(bhT[4], bhT[5]); t.w = cvt_pk_bf16(bhT[6], bhT[7]); *(LAS u32x4*)(lds + RC_BHT + (lane * RC_LD + 8 * wave) * 2) = t;
          t.x = cvt_pk_bf16(khT[0], khT[1]); t.y = cvt_pk_bf16(khT[2], khT[3]); t.z = cvt_pk_bf16(khT[4], khT[5]); t.w = cvt_pk_bf16(khT[6], khT[7]); *(LAS u32x4*)(lds + RC_KHT + (lane * RC_LD + 8 * wave) * 2) = t;
          t.x = cvt_pk_bf16(v8[0], v8[1]); t.y = cvt_pk_bf16(v8[2], v8[3]); t.z = cvt_pk_bf16(v8[4], v8[5]); t.w = cvt_pk_bf16(v8[6], v8[7]); *(LAS u32x4*)(lds + RC_VT + (lane * RC_LD + 8 * wave) * 2) = t; }
        __syncthreads();
#pragma unroll
        for (int jr = 0; jr < 2; ++jr) { const int job = wave + 8 * jr; if (job < 12) {
            const int mat = job / 3, tt = job % 3, ms = (tt == 2) ? 1 : 0, nt2 = (tt == 0) ? 0 : 1;
            const int X = (mat & 1) ? RC_BT : RC_KT, Y = (mat & 2) ? RC_RT : RC_QK;
            f32x16 acc;
#pragma unroll
            for (int r = 0; r < 16; ++r) acc[r] = 0.f;
#pragma unroll
            for (int ks = 0; ks < 4; ++ks) acc = MFMA32(lds_frag(lds, X, 32 * ms + r31, 16 * ks + 8 * hh), lds_frag(lds, Y, 32 * nt2 + r31, 16 * ks + 8 * hh), acc);
            const int t = 32 * nt2 + r31; const bool incl = (mat & 2) != 0;
#pragma unroll
            for (int g4 = 0; g4 < 4; ++g4) { const int s0 = 32 * ms + 8 * g4 + 4 * hh; float v[4];
#pragma unroll
                for (int e = 0; e < 4; ++e) { const int sx = s0 + e; v[e] = (incl ? (sx <= t) : (sx < t)) ? acc[4 * g4 + e] : 0.f; }
                if (mat == 1) *(LAS f32x4*)(lds + RC_AKB + (t * 72 + s0) * 4) = (f32x4){v[0], v[1], v[2], v[3]};
                else { const int dstm = (mat == 0) ? RC_AKK : ((mat == 2) ? RC_ARK : RC_ARB); *(LAS u32x2*)(lds + dstm + (t * RC_LD + s0) * 2) = pack4(v[0], v[1], v[2], v[3]); } } } }
        __syncthreads();
        LAS float* TF = (LAS float*)(lds + RC_TF); const LAS float* AKB = (const LAS float*)(lds + RC_AKB); LAS float* YS = SEG;
        if (wave == 0) {
            const int I = lane >> 4, jj = lane & 15; float x[16];
#pragma unroll
            for (int r = 0; r < 16; ++r) { float sacc = (r == jj) ? 1.f : 0.f;
#pragma unroll
                for (int q = 0; q < r; ++q) sacc -= AKB[(16 * I + r) * 72 + 16 * I + q] * x[q];
                x[r] = sacc; TF[(16 * I + r) * 72 + 16 * I + jj] = sacc; }
        } else if (wave < 4) {
            const int t2 = tid - 64;
            for (int e = t2; e < 512; e += 192) { const int blk = e >> 8, rr = (e >> 4) & 15, cc = e & 15; TF[(32 * blk + rr) * 72 + 32 * blk + 16 + cc] = 0.f; }
        } else {
            const int mt = (wave >> 1) & 1, nt2 = wave & 1; f32x16 acc;
#pragma unroll
            for (int r = 0; r < 16; ++r) acc[r] = 0.f;
#pragma unroll
            for (int ks = 0; ks < 4; ++ks) if (ks < 2 || mt == 1) acc = MFMA32(lds_frag(lds, RC_AKK, 32 * mt + r31, 16 * ks + 8 * hh), lds_frag(lds, RC_VT, 32 * nt2 + r31, 16 * ks + 8 * hh), acc);
#pragma unroll
            for (int g4 = 0; g4 < 4; ++g4) *(LAS u32x2*)(lds + RC_AVT + ((32 * nt2 + r31) * RC_LD + 32 * mt + 8 * g4 + 4 * hh) * 2) = pack4(acc[4 * g4], acc[4 * g4 + 1], acc[4 * g4 + 2], acc[4 * g4 + 3]);
        }
        __syncthreads();
        { const int pr = tid >> 8, i = (tid >> 4) & 15, jj = tid & 15, ba = 2 * pr, bb = 2 * pr + 1;
          float y = 0.f;
#pragma unroll
          for (int q = 0; q < 16; ++q) y += AKB[(16 * bb + i) * 72 + 16 * ba + q] * TF[(16 * ba + q) * 72 + 16 * ba + jj];
          YS[tid] = y; }
        __syncthreads();
        { const int pr = tid >> 8, i = (tid >> 4) & 15, jj = tid & 15, ba = 2 * pr, bb = 2 * pr + 1; float tv = 0.f;
#pragma unroll
          for (int q = 0; q < 16; ++q) tv -= TF[(16 * bb + i) * 72 + 16 * bb + q] * YS[pr * 256 + q * 16 + jj];
          TF[(16 * bb + i) * 72 + 16 * ba + jj] = tv; }
        __syncthreads();
        { const int i = tid >> 4, j0 = (tid & 15) * 2; float z0 = 0.f, z1 = 0.f;
#pragma unroll 8
          for (int q = 0; q < 32; ++q) { const float av = AKB[(32 + i) * 72 + q]; z0 += av * TF[q * 72 + j0]; z1 += av * TF[q * 72 + j0 + 1]; }
          __syncthreads();
          TF[i * 72 + 32 + j0] = z0; TF[i * 72 + 32 + j0 + 1] = z1; }
        __syncthreads();
        { const int i = tid >> 4, j0 = (tid & 15) * 2; float t0 = 0.f, t1 = 0.f;
#pragma unroll 8
          for (int q = 0; q < 32; ++q) { const float tb = TF[(32 + i) * 72 + 32 + q]; t0 -= tb * TF[q * 72 + 32 + j0]; t1 -= tb * TF[q * 72 + 32 + j0 + 1]; }
          TF[(32 + i) * 72 + j0] = t0; TF[(32 + i) * 72 + j0 + 1] = t1; }
        __syncthreads();
        { const int t = tid >> 3, c0 = (tid & 7) * 8; const f32x4 x0 = *(const LAS f32x4*)(TF + t * 72 + c0), x1 = *(const LAS f32x4*)(TF + t * 72 + c0 + 4);
          u32x4 w; w.x = cvt_pk_bf16(x0[0], x0[1]); w.y = cvt_pk_bf16(x0[2], x0[3]); w.z = cvt_pk_bf16(x1[0], x1[1]); w.w = cvt_pk_bf16(x1[2], x1[3]);
          *(LAS u32x4*)(lds + RC_TB + (t * RC_LD + c0) * 2) = w; }
        __syncthreads();
        { const int which = wave >> 2, mt = (wave >> 1) & 1, nt2 = wave & 1; const int Bm = which ? RC_AVT : RC_QKT, Dm = which ? RC_U1T : RC_W1T; f32x16 acc;
#pragma unroll
          for (int r = 0; r < 16; ++r) acc[r] = 0.f;
#pragma unroll
          for (int ks = 0; ks < 4; ++ks) if (ks < 2 || mt == 1) acc = MFMA32(lds_frag(lds, RC_TB, 32 * mt + r31, 16 * ks + 8 * hh), lds_frag(lds, Bm, 32 * nt2 + r31, 16 * ks + 8 * hh), acc);
#pragma unroll
          for (int g4 = 0; g4 < 4; ++g4) *(LAS u32x2*)(lds + Dm + ((32 * nt2 + r31) * RC_LD + 32 * mt + 8 * g4 + 4 * hh) * 2) = pack4(acc[4 * g4], acc[4 * g4 + 1], acc[4 * g4 + 2], acc[4 * g4 + 3]); }
        __syncthreads();
        { const int kind = wave >> 2, mt = (wave >> 1) & 1, nt2 = wave & 1; const int cidx = 32 * nt2 + r31;
          f32x16 acc;
#pragma unroll
          for (int r = 0; r < 16; ++r) acc[r] = 0.f;
          if (kind == 0) {
#pragma unroll
              for (int ks = 0; ks < 4; ++ks) acc = MFMA32(lds_frag(lds, RC_W1T, 32 * mt + r31, 16 * ks + 8 * hh), lds_frag(lds, RC_BHT, cidx, 16 * ks + 8 * hh), acc);
#pragma unroll
              for (int g4 = 0; g4 < 4; ++g4) { const int jo = 8 * g4 + 4 * hh, half = jo >> 4, q2 = (jo & 15) >> 2; const int blk = (cidx >> 4) * 2 + mt, lane2 = (cidx & 15) + 16 * q2;
                  *(u32x2*)(rwi + RWI_GF + (blk * 64 + lane2) * 16 + half * 8) = pack4(-acc[4 * g4], -acc[4 * g4 + 1], -acc[4 * g4 + 2], -acc[4 * g4 + 3]); }
          } else {
#pragma unroll
              for (int ks = 0; ks < 4; ++ks) if (ks < 2 || nt2 == 1) acc = MFMA32(lds_frag(lds, RC_W1T, 32 * mt + r31, 16 * ks + 8 * hh), lds_frag(lds, RC_ARB, cidx, 16 * ks + 8 * hh), acc);
#pragma unroll
              for (int g4 = 0; g4 < 4; ++g4) { const int jo = 8 * g4 + 4 * hh, half = jo >> 4, q2 = (jo & 15) >> 2; const int blk = (cidx >> 4) * 2 + mt, lane2 = (cidx & 15) + 16 * q2;
                  const u32x2 rt = *(const LAS u32x2*)(lds + RC_RT + (cidx * RC_LD + 32 * mt + jo) * 2);
                  *(u32x2*)(rwi + RWI_W2F + (blk * 64 + lane2) * 16 + half * 8) = pack4(bf_lo(rt.x) - acc[4 * g4], bf_hi(rt.x) - acc[4 * g4 + 1], bf_lo(rt.y) - acc[4 * g4 + 2], bf_hi(rt.y) - acc[4 * g4 + 3]); }
          }
          f32x16 ac1, ac2;
#pragma unroll
          for (int r = 0; r < 16; ++r) { ac1[r] = 0.f; ac2[r] = 0.f; }
          if (kind == 0) {
#pragma unroll
              for (int ks = 0; ks < 4; ++ks) { ac1 = MFMA32(lds_frag(lds, RC_KHT, 32 * mt + r31, 16 * ks + 8 * hh), lds_frag(lds, RC_VT, cidx, 16 * ks + 8 * hh), ac1);
                                               ac2 = MFMA32(lds_frag(lds, RC_BHT, 32 * mt + r31, 16 * ks + 8 * hh), lds_frag(lds, RC_U1T, cidx, 16 * ks + 8 * hh), ac2); }
#pragma unroll
              for (int g4 = 0; g4 < 4; ++g4) { const int ro = 32 * mt + 8 * g4 + 4 * hh, mt2 = ro >> 4, q2 = (ro & 15) >> 2, cb = cidx >> 4, lane2 = (cidx & 15) + 16 * q2;
                  *(f32x4*)(rwi + RWI_H1F + ((cb * 4 + mt2) * 64 + lane2) * 16) = (f32x4){ac1[4 * g4] - ac2[4 * g4], ac1[4 * g4 + 1] - ac2[4 * g4 + 1], ac1[4 * g4 + 2] - ac2[4 * g4 + 2], ac1[4 * g4 + 3] - ac2[4 * g4 + 3]}; }
          } else {
#pragma unroll
              for (int ks = 0; ks < 4; ++ks) if (ks < 2 || nt2 == 1) { ac1 = MFMA32(lds_frag(lds, RC_VT, 32 * mt + r31, 16 * ks + 8 * hh), lds_frag(lds, RC_ARK, cidx, 16 * ks + 8 * hh), ac1);
                                                                        ac2 = MFMA32(lds_frag(lds, RC_U1T, 32 * mt + r31, 16 * ks + 8 * hh), lds_frag(lds, RC_ARB, cidx, 16 * ks + 8 * hh), ac2); }
#pragma unroll
              for (int g4 = 0; g4 < 4; ++g4) { const int ro = 32 * mt + 8 * g4 + 4 * hh, cb = ro >> 4, q2 = (ro & 15) >> 2, nt3 = cidx >> 4, lane2 = (cidx & 15) + 16 * q2;
                  *(f32x4*)(rwi + RWI_O1F + ((cb * 4 + nt3) * 64 + lane2) * 16) = (f32x4){ac1[4 * g4] - ac2[4 * g4], ac1[4 * g4 + 1] - ac2[4 * g4 + 1], ac1[4 * g4 + 2] - ac2[4 * g4 + 2], ac1[4 * g4 + 3] - ac2[4 * g4 + 3]}; }
          } }
        __syncthreads();
    }
}

__device__ __forceinline__ void p3_rwkv_seq(const Args& a, int unit, int lane) {
    const int bh = unit >> 2, cb = unit & 3, b = bh >> 4, h = bh & 15, l15 = lane & 15, q = lane >> 4;
    bf16_t* ORAW = (bf16_t*)((unsigned char*)a.out + DO_ORAW);
    f32x4 hacc[4];
#pragma unroll
    for (int m = 0; m < 4; ++m) hacc[m] = (f32x4){0.f, 0.f, 0.f, 0.f};
    const unsigned char* base = a.ws + WS_RWI + (size_t)(bh * 32) * RWI_BYTES;
    bf16x8 gf[8]; f32x4 h1[4], lam[4];
#define RW2_LOADG(src) do { _Pragma("unroll") for (int k2 = 0; k2 < 8; ++k2) gf[k2] = *(const bf16x8*)((src) + RWI_GF + (k2 * 64 + lane) * 16); \
        _Pragma("unroll") for (int m = 0; m < 4; ++m) { h1[m] = *(const f32x4*)((src) + RWI_H1F + ((cb * 4 + m) * 64 + lane) * 16); lam[m] = *(const f32x4*)((src) + RWI_LAM + (16 * m + 4 * q) * 4); } } while (0)
    RW2_LOADG(base);
#pragma unroll 1
    for (int c = 0; c < 32; ++c) {
        const unsigned char* cur = base + (size_t)c * RWI_BYTES;
        bf16x8 w2f[8]; f32x4 o1[4];
#pragma unroll
        for (int k2 = 0; k2 < 8; ++k2) w2f[k2] = *(const bf16x8*)(cur + RWI_W2F + (k2 * 64 + lane) * 16);
#pragma unroll
        for (int n = 0; n < 4; ++n) o1[n] = *(const f32x4*)(cur + RWI_O1F + ((cb * 4 + n) * 64 + lane) * 16);
        bf16x8 hb[2];
#pragma unroll
        for (int ks = 0; ks < 2; ++ks) { u32x4 t; t.x = cvt_pk_bf16(hacc[2 * ks][0], hacc[2 * ks][1]); t.y = cvt_pk_bf16(hacc[2 * ks][2], hacc[2 * ks][3]);
            t.z = cvt_pk_bf16(hacc[2 * ks + 1][0], hacc[2 * ks + 1][1]); t.w = cvt_pk_bf16(hacc[2 * ks + 1][2], hacc[2 * ks + 1][3]); hb[ks] = __builtin_bit_cast(bf16x8, t); }
        f32x4 nacc[4];
#pragma unroll
        for (int m = 0; m < 4; ++m) { nacc[m] = h1[m] + lam[m] * hacc[m];
#pragma unroll
            for (int ks = 0; ks < 2; ++ks) nacc[m] = MFMA16(gf[m * 2 + ks], hb[ks], nacc[m]); }
        if (c + 1 < 32) RW2_LOADG(cur + RWI_BYTES);
#pragma unroll
        for (int n = 0; n < 4; ++n) { f32x4 oacc = o1[n];
#pragma unroll
            for (int ks = 0; ks < 2; ++ks) oacc = MFMA16(hb[ks], w2f[n * 2 + ks], oacc);
            *(u32x2*)(ORAW + ((size_t)b * SEQ + c * 64 + 16 * n + l15) * 1024 + h * 64 + 16 * cb + 4 * q) = pack4(oacc[0], oacc[1], oacc[2], oacc[3]); }
#pragma unroll
        for (int m = 0; m < 4; ++m) hacc[m] = nacc[m];
    }
#undef RW2_LOADG
#pragma unroll
    for (int m = 0; m < 4; ++m) *(f32x4*)(a.out + OUT_WKV_P + (((size_t)bh * 64 + 16 * cb + l15) * 64 + 16 * m + 4 * q)) = hacc[m];
}

__device__ __forceinline__ void p3_rwkv_sample(const Args& a, LAS unsigned char* lds, int bs, int wave, int lane) {
    LAS float* Lw = (LAS float*)lds + wave * 768;
    const bf16_t* P = (const bf16_t*)(a.ws + WS_P);
    const bf16_t* pc = P + (size_t)(MP + bs) * LDP; const bf16_t* pp = P + (size_t)(MV + bs) * LDP;
    bf16_t* A2 = (bf16_t*)(a.ws + WS_XN);
    const float* mu = a.in[I_MU];
    { float wd = bf2f(pc[PC_WD + lane]), ad = bf2f(pc[PC_AD + lane]); wd += (bf2f(pp[PC_WD + lane]) - wd) * mu[3072 + lane]; ad += (bf2f(pp[PC_AD + lane]) - ad) * mu[3136 + lane];
      Lw[lane] = tanhf_(wd); Lw[64 + lane] = ad; }
    LDS_WAIT();
    for (int hq = 0; hq < 2; ++hq) { const int h = 2 * wave + hq, hj = h * 64 + lane;
        float lw = 0.f, la = 0.f;
#pragma unroll 8
        for (int m = 0; m < 64; ++m) { lw += Lw[m] * a.in[I_W2][(size_t)m * 1024 + hj]; la += Lw[64 + m] * a.in[I_A2][(size_t)m * 1024 + hj]; }
        float r = bf2f(pc[PC_R + hj]), k = bf2f(pc[PC_K + hj]), v = bf2f(pc[PC_V + hj]);
        r += (bf2f(pp[PC_R + hj]) - r) * mu[hj]; k += (bf2f(pp[PC_K + hj]) - k) * mu[1024 + hj]; v += (bf2f(pp[PC_V + hj]) - v) * mu[2048 + hj];
        const RwTok o = rw_token(a, hj, r, k, v, lw, la);
        Lw[128 + lane] = o.kk; Lw[192 + lane] = o.dr; Lw[256 + lane] = o.dd; Lw[320 + lane] = o.bb; Lw[384 + lane] = o.kp; Lw[448 + lane] = o.v;
        LDS_WAIT();
        const int rg = lane >> 4, cq = lane & 15;
        const f32x4 kk4 = *(const LAS f32x4*)(Lw + 128 + 4 * cq), dr4 = *(const LAS f32x4*)(Lw + 192 + 4 * cq), d4 = *(const LAS f32x4*)(Lw + 256 + 4 * cq), b4 = *(const LAS f32x4*)(Lw + 320 + 4 * cq), k4 = *(const LAS f32x4*)(Lw + 384 + 4 * cq);
        const size_t sbase = ((size_t)(bs * 16 + h) * 64) * 64;
        const float* S0 = a.in[I_WKV] + sbase; float* S1 = a.out + OUT_WKV_S + sbase;
#pragma unroll 4
        for (int it = 0; it < 16; ++it) { const int i = 4 * it + rg; f32x4 S = *(const f32x4*)(S0 + (size_t)i * 64 + 4 * cq); const float vi = Lw[448 + i];
            float p1 = (S[0] * kk4[0] + S[1] * kk4[1]) + (S[2] * kk4[2] + S[3] * kk4[3]);
            float p2 = (S[0] * dr4[0] + S[1] * dr4[1]) + (S[2] * dr4[2] + S[3] * dr4[3]);
            p1 = row16_sum(p1); p2 = row16_sum(p2);
            const float sa = -p1, ov = p2 + sa * o.br + vi * o.kr;
#pragma unroll
            for (int j = 0; j < 4; ++j) S[j] = S[j] * d4[j] + sa * b4[j] + vi * k4[j];
            *(f32x4*)(S1 + (size_t)i * 64 + 4 * cq) = S;
            if (cq == 0) Lw[512 + i] = ov; }
        LDS_WAIT();
        const float ov = Lw[512 + lane];
        const float mean = wave_sum(ov) * (1.0f / 64.0f); const float dv = ov - mean; const float var = wave_sum(dv * dv) * (1.0f / 64.0f);
        float on = dv * rsqrtf(var + GN_EPS) * a.in[I_GNW][hj] + a.in[I_GNB][hj] + o.bonus * o.v;
        on *= bf2f(pc[PC_ZR + hj]);
        A2[(size_t)(MP + bs) * 2048 + 1024 + hj] = f2bf(on);
        LDS_WAIT();
    }
}

constexpr int S5_ELD = 132, S5_XLD = 136;
constexpr int S5_E_OFF = 0, S5_X_OFF = 128 * S5_ELD * 4;
__device__ __forceinline__ bf16x8 ldfrag(const unsigned char* base, int block, int lane) { return *(const bf16x8*)(base + (size_t)block * 1024 + lane * 16); }
__device__ __forceinline__ void p3_s5_prompt(const Args& a, LAS unsigned char* lds, int unit, int tid, int wave, int lane) {
    const int b = unit >> 6, g = unit & 63;
    const unsigned char* tab = (const unsigned char*)a.out + DO_S5TAB + (size_t)g * S5T_BYTES;
    const bf16_t* P = (const bf16_t*)(a.ws + WS_P);
    bf16_t* Yg = (bf16_t*)(a.ws + WS_YG);
    LAS float* EL = (LAS float*)(lds + S5_E_OFF); LAS bf16_t* XL = (LAS bf16_t*)(lds + S5_X_OFF);
    const int nt = wave & 3, hm = wave >> 2, r31 = lane & 31, hh = lane >> 5;
    const int n = 32 * nt + r31;
    f32x16 accY[4], accE[2];
#pragma unroll
    for (int q = 0; q < 4; ++q)
#pragma unroll
        for (int r = 0; r < 16; ++r) accY[q][r] = 0.f;
#pragma unroll
    for (int q = 0; q < 2; ++q)
#pragma unroll
        for (int r = 0; r < 16; ++r) accE[q][r] = 0.f;
    const int mts[4] = {hm ? 1 : 0, hm ? 2 : 3, hm ? 5 : 4, hm ? 6 : 7};
    const bf16_t* ubase = P + ((size_t)b * SEQ + 16 * n) * LDP + PC_U + g * 16 + 8 * hh;
#pragma unroll
    for (int s = 0; s < 16; ++s) {
        const bf16x8 bu = *(const bf16x8*)(ubase + (size_t)s * LDP);
#pragma unroll
        for (int e = 0; e < 2; ++e) accE[e] = __builtin_amdgcn_mfma_f32_32x32x16_bf16(ldfrag(tab + S5T_ME, (2 * hm + e) * 16 + s, lane), bu, accE[e], 0, 0, 0);
#pragma unroll
        for (int q = 0; q < 4; ++q) { const int mt = mts[q]; if (s <= 2 * mt + 1) accY[q] = __builtin_amdgcn_mfma_f32_32x32x16_bf16(ldfrag(tab + S5T_KT, 2 * mt - s + 1, lane), bu, accY[q], 0, 0, 0); }
    }
#pragma unroll
    for (int e = 0; e < 2; ++e)
#pragma unroll
        for (int q4 = 0; q4 < 4; ++q4) { f32x4 v; v[0] = accE[e][4 * q4]; v[1] = accE[e][4 * q4 + 1]; v[2] = accE[e][4 * q4 + 2]; v[3] = accE[e][4 * q4 + 3];
            *(LAS f32x4*)(EL + n * S5_ELD + 32 * (2 * hm + e) + 8 * q4 + 4 * hh) = v; }
    __syncthreads();
    if (wave == 0) { const float* hdr = (const float*)(tab + S5T_HDR); const float ar = hdr[lane], ai = hdr[64 + lane]; float xr = 0.f, xi = 0.f;
#pragma unroll 8
        for (int c = 0; c < 128; ++c) { XL[c * S5_XLD + lane] = f2bf(xr); XL[c * S5_XLD + 64 + lane] = f2bf(xi);
            const float er = EL[c * S5_ELD + lane], ei = EL[c * S5_ELD + 64 + lane];
            const float nr = ar * xr - ai * xi + er, ni = ar * xi + ai * xr + ei; xr = nr; xi = ni; }
        a.out[OUT_S5RE_P + (size_t)(b * 64 + g) * 64 + lane] = xr; a.out[OUT_S5IM_P + (size_t)(b * 64 + g) * 64 + lane] = xi; }
    __syncthreads();
#pragma unroll
    for (int ks = 0; ks < 8; ++ks) { const bf16x8 bx = *(const LAS bf16x8*)(XL + n * S5_XLD + 16 * ks + 8 * hh);
#pragma unroll
        for (int q = 0; q < 4; ++q) accY[q] = __builtin_amdgcn_mfma_f32_32x32x16_bf16(ldfrag(tab + S5T_CA, mts[q] * 8 + ks, lane), bx, accY[q], 0, 0, 0); }
#pragma unroll
    for (int q = 0; q < 4; ++q) { const int mt = mts[q];
#pragma unroll
        for (int q4 = 0; q4 < 4; ++q4) { const int dt = q4 >> 1, c0 = 8 * (q4 & 1) + 4 * hh; const size_t row = (size_t)b * SEQ + 16 * n + 2 * mt + dt;
            u32x2 w; w.x = cvt_pk_bf16(geluf_(accY[q][4 * q4]), geluf_(accY[q][4 * q4 + 1])); w.y = cvt_pk_bf16(geluf_(accY[q][4 * q4 + 2]), geluf_(accY[q][4 * q4 + 3]));
            *(u32x2*)(Yg + row * 1024 + g * 16 + c0) = w; } }
    __syncthreads();
}
__device__ __forceinline__ void p3_s5_sample(const Args& a, int g, int wave, int lane) {
    if (wave >= 4) return;
    const unsigned char* tab = (const unsigned char*)a.out + DO_S5TAB + (size_t)g * S5T_BYTES;
    const float* hdr = (const float*)(tab + S5T_HDR);
    const bf16_t* P = (const bf16_t*)(a.ws + WS_P);
    bf16_t* Yg = (bf16_t*)(a.ws + WS_YG);
    const int r31 = lane & 31, hh = lane >> 5, bs = 32 * wave + r31;
    const bf16x8 bu = *(const bf16x8*)(P + (size_t)(MP + bs) * LDP + PC_U + g * 16 + 8 * hh);
    f32x16 z;
#pragma unroll
    for (int r = 0; r < 16; ++r) z[r] = 0.f;
    f32x16 x[4];
#pragma unroll
    for (int mtile = 0; mtile < 4; ++mtile) x[mtile] = __builtin_amdgcn_mfma_f32_32x32x16_bf16(ldfrag(tab + S5T_ME, mtile * 16 + 15, lane), bu, z, 0, 0, 0);
    const size_t sb = (size_t)(bs * 64 + g) * 64;
#pragma unroll
    for (int pt = 0; pt < 2; ++pt)
#pragma unroll
        for (int q4 = 0; q4 < 4; ++q4) { const int p0 = 32 * pt + 8 * q4 + 4 * hh;
            const f32x4 x0r = *(const f32x4*)(a.in[I_S5RE] + sb + p0), x0i = *(const f32x4*)(a.in[I_S5IM] + sb + p0);
            const f32x4 ar = *(const f32x4*)(hdr + 128 + p0), ai = *(const f32x4*)(hdr + 192 + p0);
            f32x4 nr, ni;
#pragma unroll
            for (int j = 0; j < 4; ++j) { nr[j] = ar[j] * x0r[j] - ai[j] * x0i[j] + x[pt][4 * q4 + j]; ni[j] = ar[j] * x0i[j] + ai[j] * x0r[j] + x[2 + pt][4 * q4 + j]; x[pt][4 * q4 + j] = nr[j]; x[2 + pt][4 * q4 + j] = ni[j]; }
            *(f32x4*)(a.out + OUT_S5RE_S + sb + p0) = nr; *(f32x4*)(a.out + OUT_S5IM_S + sb + p0) = ni; }
    f32x16 y = __builtin_amdgcn_mfma_f32_32x32x16_bf16(ldfrag(tab + S5T_DF, 0, lane), bu, z, 0, 0, 0);
#pragma unroll
    for (int mtile = 0; mtile < 4; ++mtile)
#pragma unroll
        for (int sp = 0; sp < 2; ++sp) { u32x4 t; t.x = cvt_pk_bf16(x[mtile][8 * sp], x[mtile][8 * sp + 1]); t.y = cvt_pk_bf16(x[mtile][8 * sp + 2], x[mtile][8 * sp + 3]);
            t.z = cvt_pk_bf16(x[mtile][8 * sp + 4], x[mtile][8 * sp + 5]); t.w = cvt_pk_bf16(x[mtile][8 * sp + 6], x[mtile][8 * sp + 7]);
            y = __builtin_amdgcn_mfma_f32_32x32x16_bf16(ldfrag(tab + S5T_C0, mtile * 2 + sp, lane), __builtin_bit_cast(bf16x8, t), y, 0, 0, 0); }
#pragma unroll
    for (int q4 = 0; q4 < 2; ++q4) { const int c0 = 8 * q4 + 4 * hh;
        u32x2 w; w.x = cvt_pk_bf16(geluf_(y[4 * q4]), geluf_(y[4 * q4 + 1])); w.y = cvt_pk_bf16(geluf_(y[4 * q4 + 2]), geluf_(y[4 * q4 + 3]));
        *(u32x2*)(Yg + (size_t)(MP + bs) * 1024 + g * 16 + c0) = w; }
}

__device__ __forceinline__ void p4_rwkv_post8(const Args& a, int item0, int lane) {
    const int item = item0 + (lane >> 3), cg = lane & 7, row = item >> 4, h = item & 15, ch = h * 64 + 8 * cg;
    const bf16_t* ORAW = (const bf16_t*)((const unsigned char*)a.out + DO_ORAW); const bf16_t* BV = (const bf16_t*)((const unsigned char*)a.out + DO_BV);
    const bf16_t* P = (const bf16_t*)(a.ws + WS_P); bf16_t* A2 = (bf16_t*)(a.ws + WS_XN);
    const u32x4 ow = *(const u32x4*)(ORAW + (size_t)row * 1024 + ch), bw = *(const u32x4*)(BV + (size_t)row * 1024 + ch), zw = *(const u32x4*)(P + (size_t)row * LDP + PC_ZR + ch);
    const f32x4 w0 = *(const f32x4*)(a.in[I_GNW] + ch), w1 = *(const f32x4*)(a.in[I_GNW] + ch + 4), b0 = *(const f32x4*)(a.in[I_GNB] + ch), b1 = *(const f32x4*)(a.in[I_GNB] + ch + 4);
    const float o[8] = {bf_lo(ow.x), bf_hi(ow.x), bf_lo(ow.y), bf_hi(ow.y), bf_lo(ow.z), bf_hi(ow.z), bf_lo(ow.w), bf_hi(ow.w)};
    const float bv[8] = {bf_lo(bw.x), bf_hi(bw.x), bf_lo(bw.y), bf_hi(bw.y), bf_lo(bw.z), bf_hi(bw.z), bf_lo(bw.w), bf_hi(bw.w)};
    const float z[8] = {bf_lo(zw.x), bf_hi(zw.x), bf_lo(zw.y), bf_hi(zw.y), bf_lo(zw.z), bf_hi(zw.z), bf_lo(zw.w), bf_hi(zw.w)};
    const float gw[8] = {w0[0], w0[1], w0[2], w0[3], w1[0], w1[1], w1[2], w1[3]}, gb[8] = {b0[0], b0[1], b0[2], b0[3], b1[0], b1[1], b1[2], b1[3]};
    float sm = ((o[0] + o[1]) + (o[2] + o[3])) + ((o[4] + o[5]) + (o[6] + o[7]));
    sm += dpp_f<0xB1>(sm); sm += dpp_f<0x4E>(sm); sm += dpp_f<0x141>(sm);
    const float mean = sm * (1.0f / 64.0f); float d[8], sq = 0.f;
#pragma unroll
    for (int j = 0; j < 8; ++j) { d[j] = o[j] - mean; sq += d[j] * d[j]; }
    sq += dpp_f<0xB1>(sq); sq += dpp_f<0x4E>(sq); sq += dpp_f<0x141>(sq);
    const float rstd = rsqrtf(sq * (1.0f / 64.0f) + GN_EPS); float r[8];
#pragma unroll
    for (int j = 0; j < 8; ++j) r[j] = (d[j] * rstd * gw[j] + gb[j] + bv[j]) * z[j];
    u32x4 w; w.x = cvt_pk_bf16(r[0], r[1]); w.y = cvt_pk_bf16(r[2], r[3]); w.z = cvt_pk_bf16(r[4], r[5]); w.w = cvt_pk_bf16(r[6], r[7]);
    *(u32x4*)(A2 + (size_t)row * 2048 + 1024 + ch) = w;
}

__device__ __forceinline__ void p6_row(const Args& a, int m, int lane) {
    float* y = a.out + (size_t)m * DM; const float* fg = a.in[I_FINALG];
    if (m < MP) {
        const float* rs = (const float*)(a.ws + WS_ROWSS) + (size_t)m * 32;
        const float ss = wave_sum(rs[lane & 31]) * 0.5f;
        const float rstd = rsqrtf(ss * (1.0f / DM) + RMS_EPS);
#pragma unroll
        for (int j = 0; j < 8; ++j) { const int k = 4 * lane + 256 * j; f32x4 v = *(const f32x4*)(y + k); const f32x4 gv = *(const f32x4*)(fg + k);
#pragma unroll
            for (int q = 0; q < 4; ++q) v[q] = v[q] * rstd * gv[q];
            *(f32x4*)(y + k) = v; }
    } else {
        const int r = m - MP; const float* slab = (const float*)(a.ws + WS_SLAB) + (size_t)r * DM; const float* x = a.in[I_XS] + (size_t)r * DM;
        const float* gtrow = (const float*)(a.ws + WS_MOD) + (size_t)(NB + r) * NMOD + 2 * DM;
        f32x4 v[8]; float ss = 0.f;
#pragma unroll
        for (int j = 0; j < 8; ++j) { const int k = 4 * lane + 256 * j; f32x4 mix = *(const f32x4*)(slab + k);
#pragma unroll
            for (int s2 = 1; s2 < 8; ++s2) mix += *(const f32x4*)(slab + (size_t)s2 * NSMP * DM + k);
            const f32x4 xv = *(const f32x4*)(x + k), gt = *(const f32x4*)(gtrow + k);
#pragma unroll
            for (int q = 0; q < 4; ++q) { v[j][q] = xv[q] + gt[q] * mix[q]; ss += v[j][q] * v[j][q]; } }
        const float rstd = rsqrtf(wave_sum(ss) * (1.0f / DM) + RMS_EPS);
#pragma unroll
        for (int j = 0; j < 8; ++j) { const int k = 4 * lane + 256 * j; const f32x4 gv = *(const f32x4*)(fg + k); f32x4 o;
#pragma unroll
            for (int q = 0; q < 4; ++q) o[q] = v[j][q] * rstd * gv[q];
            *(f32x4*)(y + k) = o; }
    }
}

__global__ void __launch_bounds__(512, 2) fwd_kernel(Args args) {
    extern __shared__ __attribute__((aligned(16))) unsigned char lds_raw[];
    LAS unsigned char* lds = (LAS unsigned char*)lds_raw;
    const int tid = threadIdx.x, lane = tid & 63, wave = __builtin_amdgcn_readfirstlane(tid >> 6);
    const int G = gridDim.x, bx = blockIdx.x;
    const int vcu = (G % 8 == 0) ? (bx % 8) * (G / 8) + bx / 8 : bx;
    volatile LAS unsigned* MISC = (volatile LAS unsigned*)(lds + MISC_OFF);
    for (int u = tid; u < (LDS_BYTES - LDSCTL_OFF) / 4; u += 512) ((LAS unsigned*)(lds + LDSCTL_OFF))[u] = 0u;
    __syncthreads();
    unsigned* ctl = (unsigned*)(args.ws + WS_CTL);
    XcdBarrier bar; bar.bar = ctl + CW_BAR + args.li * XCD_BAR_WORDS; bar.x = 0; bar.st = nullptr;
    const bool multi = (args.ph_hi - args.ph_lo) > 1;
    if (multi) bar = xcd_barrier_post(ctl + CW_BAR + args.li * XCD_BAR_WORDS, MISC + 8);
    const int lo = args.ph_lo, hi = args.ph_hi;
#define IN(k) (lo <= (k) && (k) < hi)
#define SEAM(k) do { if (IN(k) && IN((k) + 1)) xcd_barrier(bar); } while (0)
    const int gw = vcu * 8 + wave, NGW = G * 8;

    if (IN(0)) {
        if (vcu < 192) p0_mod(args, lds, vcu, wave, lane);
        else if (vcu - 192 < 64) p0_s5_tables(args, lds, vcu - 192, tid);
    }
    SEAM(0);
    if (IN(1)) {
        { LAS float* scr = (LAS float*)(lds + wave * 16384);
          bf16_t* WT = (bf16_t*)(args.ws + WS_WT);
          for (int it = gw; it < 328 * 32; it += NGW) { const int nb = it >> 5, kb = it & 31; const int p0 = 32 * nb;
              const int src = (p0 < 5120) ? p0 : ((p0 < 10240) ? p0 + 128 : p0 - 5120);
              transpose_item(args.in[I_WIN], NIN, 2048, src, WT, p0, 64 * kb, scr, lane, p0 >= NIN); } }
        for (int m = gw; m < MT; m += NGW) p1_row(args, m, lane);
    }
    SEAM(1);
    if (IN(2)) {
        pg8::Gemm g{(const bf16_t*)(args.ws + WS_XN), (const bf16_t*)(args.ws + WS_WT), 2048, 2048};
        pg8::StaticOrder S; S.init(MT, LDP, 2048, G, bx);
        EpiP E{(bf16_t*)(args.ws + WS_P)};
        pg8::gemm_phase<EpiP, pg8::StaticOrder>(lds, g, S, E);
    }
    SEAM(2);
    if (IN(3)) {
        p3_rwkv_chunks(args, lds, vcu >> 2, vcu & 3, tid, wave, lane);
        { LAS float* scr = (LAS float*)(lds + wave * 16384);
          for (int it = gw; it < 2048 + 512; it += NGW) {
              if (it < 2048) { const int nb = it >> 5, kb = it & 31; transpose_item(args.in[I_WOUT], 2048, 2048, 32 * nb, (bf16_t*)(args.ws + WS_WOUT_T), 32 * nb, 64 * kb, scr, lane, false); }
              else { const int i2 = it - 2048, nb = i2 >> 4, kb = i2 & 15; transpose_item(args.in[I_WGLU], 1024, 1024, 32 * nb, (bf16_t*)(args.ws + WS_WGLU_T), 32 * nb, 64 * kb, scr, lane, false); } } }
        __syncthreads();
        p3_s5_prompt(args, lds, vcu, tid, wave, lane);
        if (vcu < 64) p3_s5_sample(args, vcu, wave, lane);
        __syncthreads();
        if (vcu >= 128) p3_rwkv_sample(args, lds, vcu - 128, wave, lane);
    }
    SEAM(3);
    if (IN(4)) {
        pg8::StaticOrder S; S.init(MT, 1024, 1024, G, bx);
        pg8::Unit u0;
        if (S.next(0, u0)) {
            pg8::Gemm g{(const bf16_t*)(args.ws + WS_YG), (const bf16_t*)(args.ws + WS_WGLU_T), 1024, 1024};
            EpiGlu E{(const bf16_t*)(args.ws + WS_YG), (const bf16_t*)(args.ws + WS_P), args.in[I_BGLU], (bf16_t*)(args.ws + WS_XN)};
            pg8::gemm_phase<EpiGlu, pg8::StaticOrder>(lds, g, S, E);
        } else {
            const int nfree = G - 132, j = bx - 132, unit = wave * nfree + j;
            if (unit < 256) p3_rwkv_seq(args, unit, lane);
        }
    }
    SEAM(4);
    if (IN(5)) { for (int it = gw * 8; it < MP * 16; it += NGW * 8) p4_rwkv_post8(args, it, lane); }
    SEAM(5);
    if (IN(6)) {
        pg8::Gemm g{(const bf16_t*)(args.ws + WS_XN), (const bf16_t*)(args.ws + WS_WOUT_T), 2048, 1024};
        pg8::OutOrder S; S.init(MP, DM, 1024, G, bx);
        EpiOut E{(const bf16_t*)(args.ws + WS_P), args.in[I_XP], (const float*)(args.ws + WS_MOD), args.out, (float*)(args.ws + WS_ROWSS), (bf16_t*)(args.ws + WS_TMP), (float*)(args.ws + WS_SLAB)};
        pg8::gemm_phase<EpiOut, pg8::OutOrder>(lds, g, S, E);
    }
    SEAM(6);
    if (IN(7)) { for (int m = gw; m < MV; m += NGW) p6_row(args, m, lane); }
#undef IN
#undef SEAM
}

extern "C" void kernel_launch(void* const* d_in, const int* in_sizes, int n_in, void* d_out, int out_size, void* d_ws, size_t ws_size, hipStream_t stream) {
    static int grid = 0;
    if (grid == 0) {
        if (n_in != 34 || ws_size < WS_END) { fprintf(stderr, "kernel_launch: unexpected n_in %d / ws %zu\n", n_in, ws_size); grid = -1; return; }
        int dev = 0, cus = 0;
        if (hipGetDevice(&dev) != hipSuccess || hipDeviceGetAttribute(&cus, hipDeviceAttributeMultiprocessorCount, dev) != hipSuccess) { grid = -1; return; }
        if (hipFuncSetAttribute((const void*)fwd_kernel, hipFuncAttributeMaxDynamicSharedMemorySize, LDS_BYTES) != hipSuccess) { fprintf(stderr, "kernel_launch: hipFuncSetAttribute failed\n"); grid = -1; return; }
        int per_cu = 0;
        if (hipOccupancyMaxActiveBlocksPerMultiprocessor(&per_cu, (const void*)fwd_kernel, 512, LDS_BYTES) != hipSuccess || per_cu < 1) fprintf(stderr, "kernel_launch: occupancy query says %d\n", per_cu);
        (void)hipGetLastError();
        grid = cus;
        if (grid != 256) fprintf(stderr, "kernel_launch: note: %d CUs\n", grid);
    }
    if (grid < 0) return;
    (void)hipMemsetAsync((char*)d_ws + WS_CTL, 0, CTL_BYTES, stream);
    Args a{};
    for (int i = 0; i < 34; ++i) a.in[i] = (const float*)d_in[i];
    a.out = (float*)d_out; a.ws = (unsigned char*)d_ws;
    if (PROBE_PHASE >= 0) {
        a.ph_lo = 0; a.ph_hi = PROBE_PHASE + 1; a.li = 0; hipLaunchKernelGGL(fwd_kernel, dim3(grid), dim3(512), LDS_BYTES, stream, a);
        a.ph_lo = PROBE_PHASE; a.ph_hi = PROBE_PHASE + 1; a.li = 1; hipLaunchKernelGGL(fwd_kernel, dim3(grid), dim3(512), LDS_BYTES, stream, a);
        if (PROBE_PHASE + 1 < N_PHASES) { a.ph_lo = PROBE_PHASE + 1; a.ph_hi = N_PHASES; a.li = 2; hipLaunchKernelGGL(fwd_kernel, dim3(grid), dim3(512), LDS_BYTES, stream, a); }
    } else if (MK_N_LAUNCHES == 1) { a.ph_lo = 0; a.ph_hi = N_PHASES; a.li = 0; hipLaunchKernelGGL(fwd_kernel, dim3(grid), dim3(512), LDS_BYTES, stream, a); }
    else { for (int p = 0; p < N_PHASES; ++p) { a.ph_lo = p; a.ph_hi = p + 1; a.li = 0; hipLaunchKernelGGL(fwd_kernel, dim3(grid), dim3(512), LDS_BYTES, stream, a); } }
}
```

```cpp
#include <hip/hip_runtime.h>
#include <cstdio>
#include <cstdint>

#ifndef MK_N_LAUNCHES
#define MK_N_LAUNCHES 1
#endif
#ifndef PROBE_PHASE
#define PROBE_PHASE -1
#endif
constexpr int N_PHASES = 8;

#define GAS __attribute__((address_space(1)))
#define LAS __attribute__((address_space(3)))
typedef unsigned short bf16_t;
typedef short bf16x8 __attribute__((ext_vector_type(8)));
typedef float f32x2 __attribute__((ext_vector_type(2)));
typedef float f32x4 __attribute__((ext_vector_type(4)));
typedef float f32x16 __attribute__((ext_vector_type(16)));
typedef unsigned u32x2 __attribute__((ext_vector_type(2)));
typedef unsigned u32x4 __attribute__((ext_vector_type(4)));
typedef GAS unsigned gu32;

constexpr int DM = 2048, SEQ = 2048, NB = 4, NSMP = 128;
constexpr int MP = NB * SEQ;
constexpr int MV = MP + NSMP;
constexpr int MT = MV + NSMP;
constexpr int NIN = 10368, LDP = 10496;
constexpr int NMOD = 6144, NMODROWS = NB + NSMP;
constexpr float RMS_EPS = 1e-6f, GN_EPS = 64e-5f;
constexpr int PC_U = 0, PC_ZS = 1024, PC_R = 2048, PC_K = 3072, PC_V = 4096, PC_ZR = 5120, PC_GS = 6144, PC_GR = 8192, PC_WD = 10240, PC_AD = 10304;

constexpr size_t WS_CTL = 0, CTL_BYTES = 65536;
constexpr size_t WS_MOD = 65536;
constexpr size_t WS_WT = 3342336;
constexpr size_t WS_XN = WS_WT + (size_t)LDP * 2048 * 2;
constexpr size_t WS_P = WS_XN + (size_t)MT * 2048 * 2;
constexpr size_t WS_RWI = WS_P + (size_t)MT * LDP * 2;
constexpr int RWI_GF = 0, RWI_W2F = 8192, RWI_H1F = 16384, RWI_O1F = 32768, RWI_LAM = 49152, RWI_BYTES = 49408;
constexpr size_t WS_TMP = WS_RWI + (size_t)2048 * RWI_BYTES;
constexpr size_t WS_SLAB = WS_TMP + (size_t)MP * 2048 * 2;
constexpr size_t WS_YG = WS_SLAB + (size_t)8 * NSMP * DM * 4;
constexpr size_t WS_WOUT_T = WS_YG + (size_t)MT * 1024 * 2;
constexpr size_t WS_WGLU_T = WS_WOUT_T + (size_t)2048 * 2048 * 2;
constexpr size_t WS_ROWSS = WS_WGLU_T + (size_t)1024 * 1024 * 2;
constexpr size_t WS_END = WS_ROWSS + (size_t)MP * 8 * 4;
static_assert(WS_END <= ((size_t)412 << 20), "ws map");
constexpr size_t DO_ORAW = 0, DO_BV = (size_t)MP * 1024 * 2, DO_S5TAB = 2 * DO_BV;
constexpr int S5T_ME = 0, S5T_KT = 65536, S5T_CA = 81920, S5T_C0 = 147456, S5T_DF = 155648, S5T_HDR = 156672, S5T_BYTES = 157696;
static_assert(DO_S5TAB + (size_t)64 * S5T_BYTES <= (size_t)MV * DM * 4, "d_out scratch");
constexpr size_t OUT_Y = 0, OUT_S5RE_P = 17039360, OUT_S5IM_P = 17055744, OUT_WKV_P = 17072128, OUT_SHIFT_P = 17334272,
                 OUT_S5RE_S = 17342464, OUT_S5IM_S = 17866752, OUT_WKV_S = 18391040, OUT_SHIFT_S = 26779648;
constexpr int RING_BYTES = 131072, LDSCTL_OFF = RING_BYTES, MISC_OFF = LDSCTL_OFF + 320, LDS_BYTES = 147456;
constexpr int CW_BAR = 1024;
constexpr int CW_PANEL = 8192, CW_TILE = 12288;

#define LDS_WAIT() asm volatile("s_waitcnt lgkmcnt(0)" ::: "memory")
#define VM_WAIT() asm volatile("s_waitcnt vmcnt(0)" ::: "memory")
typedef __bf16 bf16x2_t __attribute__((ext_vector_type(2)));
__device__ __forceinline__ unsigned cvt_pk_bf16(float lo, float hi) { const f32x2 v = {lo, hi}; return __builtin_bit_cast(unsigned, __builtin_convertvector(v, bf16x2_t)); }
__device__ __forceinline__ u32x2 pack4(float a, float b, float c, float d) { u32x2 w; w.x = cvt_pk_bf16(a, b); w.y = cvt_pk_bf16(c, d); return w; }
__device__ __forceinline__ float bf_lo(unsigned w) { return __uint_as_float(w << 16); }
__device__ __forceinline__ float bf_hi(unsigned w) { return __uint_as_float(w & 0xffff0000u); }
__device__ __forceinline__ float bf2f(bf16_t b) { return __uint_as_float(((unsigned)b) << 16); }
__device__ __forceinline__ bf16_t f2bf(float f) { return (bf16_t)(cvt_pk_bf16(f, 0.f) & 0xffffu); }
__device__ __forceinline__ float rcpf_(float x) { return __builtin_amdgcn_rcpf(x); }
__device__ __forceinline__ float sigmoidf_(float x) { return rcpf_(1.0f + __expf(-x)); }
__device__ __forceinline__ float siluf_(float x) { return x * rcpf_(1.0f + __expf(-x)); }
__device__ __forceinline__ float tanhf_(float x) { const float e = __expf(2.0f * x); return 1.0f - 2.0f * rcpf_(e + 1.0f); }
__device__ __forceinline__ float geluf_(float y) { const float z = 0.7978845608028654f * (y + 0.044715f * y * y * y); return 0.5f * y * (1.0f + tanhf_(z)); }
__device__ __forceinline__ float wave_sum(float v) {
#pragma unroll
    for (int o = 1; o < 64; o <<= 1) v += __shfl_xor(v, o);
    return v;
}
template <int CTRL> __device__ __forceinline__ float dpp_f(float x) { return __builtin_bit_cast(float, __builtin_amdgcn_mov_dpp(__builtin_bit_cast(int, x), CTRL, 0xf, 0xf, true)); }
__device__ __forceinline__ float wave_sum_dpp(float v) {
    v += __builtin_bit_cast(float, __builtin_amdgcn_update_dpp(0, __builtin_bit_cast(int, v), 0x111, 0xf, 0xf, true));
    v += __builtin_bit_cast(float, __builtin_amdgcn_update_dpp(0, __builtin_bit_cast(int, v), 0x112, 0xf, 0xf, true));
    v += __builtin_bit_cast(float, __builtin_amdgcn_update_dpp(0, __builtin_bit_cast(int, v), 0x114, 0xf, 0xf, true));
    v += __builtin_bit_cast(float, __builtin_amdgcn_update_dpp(0, __builtin_bit_cast(int, v), 0x118, 0xf, 0xf, true));
    v += __builtin_bit_cast(float, __builtin_amdgcn_update_dpp(0, __builtin_bit_cast(int, v), 0x142, 0xa, 0xf, false));
    v += __builtin_bit_cast(float, __builtin_amdgcn_update_dpp(0, __builtin_bit_cast(int, v), 0x143, 0xc, 0xf, false));
    return __builtin_bit_cast(float, __builtin_amdgcn_readlane(__builtin_bit_cast(int, v), 63));
}
__device__ __forceinline__ float row16_sum(float v) {
    v += dpp_f<0xB1>(v);
    v += dpp_f<0x4E>(v);
    v += dpp_f<0x141>(v);
    v += dpp_f<0x140>(v);
    return v;
}

#define XB_TMO      128
#define XB_XCNT(j)  (256  + 64 * (j))
#define XB_XSUB(j)  (1280 + 64 * (j))
#define XB_XGEN(j)  (2304 + 64 * (j))
#define XB_TOP      3328
#define XB_TOPGEN   3392
#define XCD_BAR_WORDS 3456
#define XB_SPIN_CAP (1u << 20)
__device__ __forceinline__ unsigned xb_ld(unsigned* p)              { return __hip_atomic_load(p, __ATOMIC_RELAXED, __HIP_MEMORY_SCOPE_AGENT); }
__device__ __forceinline__ unsigned xb_add(unsigned* p, unsigned v) { return __hip_atomic_fetch_add(p, v, __ATOMIC_RELAXED, __HIP_MEMORY_SCOPE_AGENT); }
__device__ __forceinline__ unsigned xb_xcc_id() { return (unsigned)__builtin_amdgcn_s_getreg((3 << 11) | 20) & 0xFu; }
#define XB_SPIN(cond, bar) do { unsigned _sp = 0; while (cond) { __builtin_amdgcn_s_sleep(1); \
    if ((++_sp & 255u) == 0u) { if (xb_ld(&(bar)[XB_TMO])) break; if (_sp > XB_SPIN_CAP) { atomicAdd(&(bar)[XB_TMO], 1u); break; } } } } while (0)
struct XcdBarrier { unsigned* bar; unsigned x; volatile LAS unsigned* st; };
__device__ __forceinline__ XcdBarrier xcd_barrier_post(unsigned* bar, volatile LAS unsigned* st) {
    XcdBarrier b; b.bar = bar; b.x = xb_xcc_id(); b.st = st;
    if (threadIdx.x == 0) (void)xb_add(&bar[XB_XCNT(b.x)], 1u);
    return b;
}
__device__ __forceinline__ void xcd_barrier_complete(unsigned* bar, unsigned x, unsigned& nloc, unsigned& nx) {
    const unsigned G = gridDim.x * gridDim.y * gridDim.z;
    unsigned sum, cnt, mine, sp = 0u;
    for (;;) {
        sum = 0u; cnt = 0u; mine = 0u;
#pragma unroll
        for (unsigned j = 0; j < 16; ++j) { const unsigned c = xb_ld(&bar[XB_XCNT(j)]); sum += c; cnt += (c > 0u) ? 1u : 0u; mine = (j == x) ? c : mine; }
        if (sum == G) break;
        __builtin_amdgcn_s_sleep(1);
        if ((++sp & 255u) == 0u) { if (xb_ld(&bar[XB_TMO])) break; if (sp > XB_SPIN_CAP) { atomicAdd(&bar[XB_TMO], 1u); break; } }
    }
    nloc = mine > 0u ? mine : 1u; nx = cnt > 0u ? cnt : 1u;
}
__device__ __forceinline__ void xcd_barrier(const XcdBarrier& b) {
    asm volatile("s_waitcnt vmcnt(0)" ::: "memory");
    __syncthreads();
    if (threadIdx.x == 0) {
        unsigned* bar = b.bar;
        __builtin_amdgcn_s_waitcnt(0);
        unsigned nloc = b.st[0], nx = b.st[1];
        if (nloc == 0u) { xcd_barrier_complete(bar, b.x, nloc, nx); b.st[0] = nloc; b.st[1] = nx; }
        const unsigned old = xb_add(&bar[XB_XSUB(b.x)], 1u);
        const unsigned gen = old / nloc;
        if (old + 1u == (gen + 1u) * nloc) {
            __builtin_amdgcn_fence(__ATOMIC_RELEASE, "agent");
            asm volatile("s_waitcnt vmcnt(0)" ::: "memory");
            const unsigned og = xb_add(&bar[XB_TOP], 1u);
            const unsigned tg = og / nx;
            if (og + 1u == (tg + 1u) * nx) xb_add(&bar[XB_TOPGEN], 1u);
            else XB_SPIN(xb_ld(&bar[XB_TOPGEN]) == tg, bar);
            __builtin_amdgcn_fence(__ATOMIC_ACQUIRE, "agent");
            xb_add(&bar[XB_XGEN(b.x)], 1u);
            asm volatile("s_waitcnt vmcnt(0)" ::: "memory");
        } else {
            XB_SPIN(xb_ld(&bar[XB_XGEN(b.x)]) == gen, bar);
            __builtin_amdgcn_fence(__ATOMIC_ACQUIRE, "agent");
            asm volatile("s_waitcnt vmcnt(0)" ::: "memory");
        }
    }
    __syncthreads();
}

namespace pg8 {
constexpr int BM = 256, BK = 64, HALF = 128, HTB = HALF * BK * 2, STAGE_BYTES = 8 * HTB, NXCD = 8, WGM = 8;
__host__ __device__ __forceinline__ int lds_byte(int r, int c) { const int st = (r >> 4) * 2 + (c >> 5), rr = r & 15, cc = c & 31, ob = rr * 64 + cc * 2; return st * 1024 + (ob ^ (((ob >> 9) & 1) << 5)); }
__host__ __device__ __forceinline__ void stage_rc(int b, int& R, int& C) { const int st = b / 1024, sb = b % 1024, swz = sb ^ (((sb >> 9) & 1) << 5); R = (st >> 1) * 16 + swz / 64; C = (st & 1) * 32 + (swz % 64) / 2; }
__host__ __device__ __forceinline__ int perm32(int rho) { const int n = rho >> 4, i = rho & 15; return 8 * (i >> 2) + 4 * n + (i & 3); }
struct Unit { int pm, pn, koff, kt, mode; };
struct Gemm { const bf16_t* A; const bf16_t* Bt; int ld, K; };
struct StaticOrder {
    int nM, nN, nwg, G, c, kt;
    __device__ void init(int M, int N, int K, int G_, int c_) { nM = M / BM; nN = N / BM; nwg = nM * nN; G = G_; c = c_; kt = K / BK; }
    __device__ __forceinline__ void tile(int L, Unit& u) const {
        int wgid = L; { const int q = nwg / NXCD, r = nwg % NXCD, xcd = wgid % NXCD, off = wgid / NXCD; wgid = (xcd < r ? xcd * (q + 1) : r * (q + 1) + (xcd - r) * q) + off; }
        const int nig = WGM * nN, gid = wgid / nig, fm = gid * WGM, gsz = (nM - fm) < WGM ? (nM - fm) : WGM;
        u.pm = fm + ((wgid % nig) % gsz); u.pn = (wgid % nig) / gsz; u.koff = 0; u.kt = kt; u.mode = 0;
    }
    __device__ __forceinline__ bool next(int i, Unit& u) const { const long L = (long)i * G + c; if (L >= nwg) return false; tile((int)L, u); return true; }
    __device__ __forceinline__ void done(const Unit&, int) const {}
};
struct OutOrder : StaticOrder {
    __device__ __forceinline__ bool next(int i, Unit& u) const {
        const int i2 = (c < 64) ? i - 1 : i;
        if (i2 < 0) { u.pm = 32; u.pn = c >> 3; u.koff = (c & 7) * 256; u.kt = 4; u.mode = 2; return true; }
        if (i2 < 2 && c < nwg) { tile(c, u); u.koff = i2 * 1024; u.kt = 16; u.mode = i2; return true; }
        return false;
    }
};
struct TailOrder : StaticOrder {
    unsigned* cnt;
    __device__ void init2(int G_, int c_, unsigned* cnt_) { nM = 32; nN = 37; nwg = 32 * 37; G = G_; c = c_; kt = 32; cnt = cnt_; }
    __device__ __forceinline__ bool next(int i, Unit& u) const {
        const int L = i * G + c; if (L >= 169 + 1184) return false;
        if (L < 132) { const int x = L & 7, k = L >> 3; if (k < 16) { u.pm = 4 * x + (k >> 2); u.pn = k & 3; } else { u.pm = 32; u.pn = x; }
                       u.koff = 0; u.kt = 32; u.mode = 0; }
        else if (L < 169) { u.pm = 32; u.pn = 4 + (L - 132); u.koff = 0; u.kt = 32; u.mode = 0; }
        else { tile(L - 169, u); u.pn += 4; }
        return true;
    }
    __device__ __forceinline__ void done(const Unit& u, int lane) const {
        if (u.pm == 32 || u.pn < 4) {
            asm volatile("s_waitcnt vmcnt(0)" ::: "memory");
            const int idx = (u.pm == 32) ? 16 + u.pn : (u.pm >> 3) * 4 + u.pn;
            if (lane == 0) __hip_atomic_fetch_add(cnt + 64 * idx, 1u, __ATOMIC_RELAXED, __HIP_MEMORY_SCOPE_AGENT);
        }
    }
};
template <class Epi, class Sched>
__device__ __forceinline__ void gemm_phase(LAS unsigned char* lds, const Gemm g, const Sched& S, const Epi& E) {
    const int tid = threadIdx.x, wid = __builtin_amdgcn_readfirstlane(tid >> 6), lane = tid & 63, wr = wid >> 2, wc = wid & 3, fr = lane & 15, fq = lane >> 4;
    const int ld = g.ld;
    unsigned voffA[2], voffB[2];
#pragma unroll
    for (int i = 0; i < 2; ++i) { int R, C; stage_rc(tid * 16 + i * 8192, R, C); const int Rb = Epi::PERM ? ((R & ~31) + perm32(R & 31)) : R;
        voffA[i] = (unsigned)(R * ld + C) * 2u; voffB[i] = (unsigned)(Rb * ld + C) * 2u; }
    const size_t kstep = (size_t)(BK * 2);
    const size_t hstep = (size_t)HALF * ld * 2;
    const size_t tstep = 2 * hstep;
    const unsigned ldsw = (unsigned)wid * 1024u;
    const int aoff = lds_byte(wr * 64 + fr, fq * 8), boff = lds_byte(wc * 32 + fr, fq * 8);
#define PG8_SA(b, h) (((b) * 2 + (h)) * HTB)
#define PG8_SB(b, h) ((4 + (b) * 2 + (h)) * HTB)
#define PG8_STAGE(bufoff, gbase, voff) do { _Pragma("unroll") for (int _i = 0; _i < 2; ++_i) \
        __builtin_amdgcn_global_load_lds((const unsigned*)((const char*)(gbase) + (voff)[_i]), (LAS unsigned*)(lds + (bufoff) + ldsw + _i * 8192), 16, 0, 0); } while (0)
#define PG8_LDA(dst, b, h) do { _Pragma("unroll") for (int m = 0; m < 4; ++m) _Pragma("unroll") for (int k = 0; k < 2; ++k) dst[m][k] = *(const LAS bf16x8*)(lds + PG8_SA(b, h) + aoff + m * 2048 + k * 1024); } while (0)
#define PG8_LDB(dst, b, h) do { _Pragma("unroll") for (int n = 0; n < 2; ++n) _Pragma("unroll") for (int k = 0; k < 2; ++k) dst[n][k] = *(const LAS bf16x8*)(lds + PG8_SB(b, h) + boff + n * 2048 + k * 1024); } while (0)
#define PG8_MMA(ai, bj, At, Bt) do { __builtin_amdgcn_s_setprio(1); _Pragma("unroll") for (int m = 0; m < 4; ++m) _Pragma("unroll") for (int n = 0; n < 2; ++n) _Pragma("unroll") for (int k = 0; k < 2; ++k) \
        acc[ai][bj][m][n] = __builtin_amdgcn_mfma_f32_16x16x32_bf16(Bt[n][k], At[m][k], acc[ai][bj][m][n], 0, 0, 0); __builtin_amdgcn_s_setprio(0); } while (0)
#define PG8_WAIT_V(n) asm volatile("s_waitcnt vmcnt(" #n ")" ::: "memory")
#define PG8_WAIT_L(n) asm volatile("s_waitcnt lgkmcnt(" #n ")" ::: "memory")
#define PG8_BAR __builtin_amdgcn_s_barrier()
#define PG8_SCHED __builtin_amdgcn_sched_barrier(0)
    Unit cur, nxt; int ui = 0; bool deferred = false;
    if (!S.next(0, cur)) return;
    f32x4 acc[2][2][4][2];
#pragma unroll
    for (int a = 0; a < 2; ++a)
#pragma unroll
        for (int b = 0; b < 2; ++b)
#pragma unroll
            for (int m = 0; m < 4; ++m)
#pragma unroll
                for (int n = 0; n < 2; ++n) acc[a][b][m][n] = (f32x4){0.f, 0.f, 0.f, 0.f};
    bf16x8 At[4][2], B0[2][2], B1[2][2];
    const char* cA = (const char*)g.A + (size_t)cur.pm * tstep + (size_t)cur.koff * 2; const char* cB = (const char*)g.Bt + (size_t)cur.pn * tstep + (size_t)cur.koff * 2;
    PG8_STAGE(PG8_SB(0, 0), cB, voffB); PG8_STAGE(PG8_SA(0, 0), cA, voffA); PG8_STAGE(PG8_SB(0, 1), cB + hstep, voffB); PG8_STAGE(PG8_SA(0, 1), cA + hstep, voffA);
    if (wr == 1) PG8_BAR;
    PG8_WAIT_V(4); PG8_BAR;
    PG8_STAGE(PG8_SB(1, 0), cB + kstep, voffB); PG8_STAGE(PG8_SA(1, 0), cA + kstep, voffA); PG8_STAGE(PG8_SB(1, 1), cB + hstep + kstep, voffB);
    PG8_WAIT_V(6); PG8_BAR;
    for (;;) {
        const bool has_next = S.next(ui + 1, nxt);
        const char* nA = has_next ? (const char*)g.A + (size_t)nxt.pm * tstep + (size_t)nxt.koff * 2 : cA; const char* nB = has_next ? (const char*)g.Bt + (size_t)nxt.pn * tstep + (size_t)nxt.koff * 2 : cB;
        const int nt = cur.kt;
        for (int t = 0; t < nt; t += 2) {
            const bool last = (t == nt - 2);
            const char* a1 = cA + (size_t)(t + 1) * kstep;
            const char* a2 = last ? nA : cA + (size_t)(t + 2) * kstep; const char* b2 = last ? nB : cB + (size_t)(t + 2) * kstep;
            const char* a3 = a2 + kstep; const char* b3 = b2 + kstep;
            PG8_LDB(B0, 0, 0); PG8_SCHED; PG8_LDA(At, 0, 0); PG8_STAGE(PG8_SA(1, 1), a1 + hstep, voffA);
            PG8_WAIT_L(8); PG8_BAR; PG8_WAIT_L(0); PG8_MMA(0, 0, At, B0); PG8_BAR; PG8_SCHED;
            PG8_LDB(B1, 0, 1); PG8_STAGE(PG8_SB(0, 0), b2, voffB);
            PG8_BAR; PG8_WAIT_L(0); PG8_MMA(0, 1, At, B1); PG8_BAR;
            PG8_LDA(At, 0, 1); PG8_STAGE(PG8_SA(0, 0), a2, voffA);
            PG8_BAR; PG8_WAIT_L(0); PG8_MMA(1, 0, At, B0); PG8_BAR; PG8_SCHED;
            PG8_STAGE(PG8_SB(0, 1), b2 + hstep, voffB);
            PG8_WAIT_V(6); PG8_BAR; PG8_MMA(1, 1, At, B1); PG8_BAR;
            PG8_LDB(B0, 1, 0); PG8_SCHED; PG8_LDA(At, 1, 0); PG8_STAGE(PG8_SA(0, 1), a2 + hstep, voffA);
            PG8_WAIT_L(8); PG8_BAR; PG8_WAIT_L(0); PG8_MMA(0, 0, At, B0); PG8_BAR; PG8_SCHED;
            PG8_LDB(B1, 1, 1); PG8_STAGE(PG8_SB(1, 0), b3, voffB);
            PG8_BAR; PG8_WAIT_L(0); PG8_MMA(0, 1, At, B1); PG8_BAR;
            PG8_LDA(At, 1, 1); PG8_STAGE(PG8_SA(1, 0), a3, voffA);
            PG8_BAR; PG8_WAIT_L(0); PG8_MMA(1, 0, At, B0); PG8_BAR; PG8_SCHED;
            PG8_STAGE(PG8_SB(1, 1), b3 + hstep, voffB);
            PG8_WAIT_V(6); PG8_BAR; PG8_MMA(1, 1, At, B1); PG8_BAR;
        }
        if (Epi::FUSED_LAST && !has_next && cur.mode == 1) deferred = true; else { E(acc, cur, wr, wc, fr, fq); S.done(cur, lane); }
        if (!has_next) break;
#pragma unroll
        for (int a = 0; a < 2; ++a)
#pragma unroll
            for (int b = 0; b < 2; ++b)
#pragma unroll
                for (int m = 0; m < 4; ++m)
#pragma unroll
                    for (int n = 0; n < 2; ++n) acc[a][b][m][n] = (f32x4){0.f, 0.f, 0.f, 0.f};
        cur = nxt; cA = nA; cB = nB; ++ui;
    }
    PG8_WAIT_V(0);
    if (wr == 0) PG8_BAR;
    PG8_BAR;
    if constexpr (Epi::FUSED_LAST) { if (deferred) E.fused(acc, cur, wr, wc, fr, fq, lds, wid, lane); }
#undef PG8_SA
#undef PG8_SB
#undef PG8_STAGE
#undef PG8_LDA
#undef PG8_LDB
#undef PG8_MMA
#undef PG8_WAIT_V
#undef PG8_WAIT_L
#undef PG8_BAR
#undef PG8_SCHED
}
}

struct EpiP {
    static constexpr bool PERM = true, FUSED_LAST = false;
    bf16_t* P; bool tail;
    __device__ __forceinline__ void operator()(const f32x4 (&acc)[2][2][4][2], const pg8::Unit& u, int wr, int wc, int fr, int fq) const {
        const int row0 = u.pm * 256 + wr * 64 + fr, col0 = u.pn * 256 + wc * 32 + 8 * fq;
        const bool wt = tail && (u.pm == 32 || u.pn < 4);
        const int act = ((u.pn >= 4 && u.pn < 8) || (u.pn >= 20 && u.pn < 24)) ? 1 : ((u.pn >= 24 && u.pn < 40) ? 2 : 0);
#pragma unroll
        for (int ai = 0; ai < 2; ++ai)
#pragma unroll
            for (int m = 0; m < 4; ++m) { bf16_t* rowp = P + (size_t)(row0 + ai * 128 + m * 16) * LDP + col0;
#pragma unroll
                for (int bj = 0; bj < 2; ++bj) { f32x4 v0 = acc[ai][bj][m][0], v1 = acc[ai][bj][m][1];
                    if (act == 1) {
#pragma unroll
                        for (int j = 0; j < 4; ++j) { v0[j] = siluf_(v0[j]); v1[j] = siluf_(v1[j]); } }
                    else if (act == 2) {
#pragma unroll
                        for (int j = 0; j < 4; ++j) { v0[j] = sigmoidf_(v0[j]); v1[j] = sigmoidf_(v1[j]); } }
                    u32x4 w; w.x = cvt_pk_bf16(v0[0], v0[1]); w.y = cvt_pk_bf16(v0[2], v0[3]); w.z = cvt_pk_bf16(v1[0], v1[1]); w.w = cvt_pk_bf16(v1[2], v1[3]);
                    if (wt) { __hip_atomic_store((unsigned long long*)(rowp + bj * 128), ((unsigned long long)w.y << 32) | w.x, __ATOMIC_RELAXED, __HIP_MEMORY_SCOPE_AGENT);
                              __hip_atomic_store((unsigned long long*)(rowp + bj * 128 + 4), ((unsigned long long)w.w << 32) | w.z, __ATOMIC_RELAXED, __HIP_MEMORY_SCOPE_AGENT); }
                    else *(u32x4*)(rowp + bj * 128) = w; } }
    }
};
struct EpiGlu {
    static constexpr bool PERM = true, FUSED_LAST = false;
    const bf16_t* Yg; const bf16_t* P; const float* bglu; bf16_t* A2;
    __device__ __forceinline__ void operator()(const f32x4 (&acc)[2][2][4][2], const pg8::Unit& u, int wr, int wc, int fr, int fq) const {
        const int row0 = u.pm * 256 + wr * 64 + fr, col0 = u.pn * 256 + wc * 32 + 8 * fq;
        f32x4 bv[2][2];
#pragma unroll
        for (int bj = 0; bj < 2; ++bj)
#pragma unroll
            for (int n = 0; n < 2; ++n) bv[bj][n] = *(const f32x4*)(bglu + col0 + bj * 128 + 4 * n);
#pragma unroll
        for (int ai = 0; ai < 2; ++ai)
#pragma unroll
            for (int m = 0; m < 4; ++m) { const size_t row = (size_t)(row0 + ai * 128 + m * 16);
#pragma unroll
                for (int bj = 0; bj < 2; ++bj) { const int c = col0 + bj * 128;
                    const u32x4 yg = *(const u32x4*)(Yg + row * 1024 + c), sz = *(const u32x4*)(P + row * LDP + PC_ZS + c);
                    const f32x4 a0 = acc[ai][bj][m][0] + bv[bj][0], a1 = acc[ai][bj][m][1] + bv[bj][1];
                    float o[8];
                    o[0] = bf_lo(yg.x) * sigmoidf_(a0[0]) * bf_lo(sz.x); o[1] = bf_hi(yg.x) * sigmoidf_(a0[1]) * bf_hi(sz.x);
                    o[2] = bf_lo(yg.y) * sigmoidf_(a0[2]) * bf_lo(sz.y); o[3] = bf_hi(yg.y) * sigmoidf_(a0[3]) * bf_hi(sz.y);
                    o[4] = bf_lo(yg.z) * sigmoidf_(a1[0]) * bf_lo(sz.z); o[5] = bf_hi(yg.z) * sigmoidf_(a1[1]) * bf_hi(sz.z);
                    o[6] = bf_lo(yg.w) * sigmoidf_(a1[2]) * bf_lo(sz.w); o[7] = bf_hi(yg.w) * sigmoidf_(a1[3]) * bf_hi(sz.w);
                    u32x4 w; w.x = cvt_pk_bf16(o[0], o[1]); w.y = cvt_pk_bf16(o[2], o[3]); w.z = cvt_pk_bf16(o[4], o[5]); w.w = cvt_pk_bf16(o[6], o[7]);
                    *(u32x4*)(A2 + row * 2048 + c) = w; } }
    }
};
struct EpiOut {
    static constexpr bool PERM = false, FUSED_LAST = true;
    const bf16_t* P; const float* xp; const float* mod; float* out; float* xbuf; bf16_t* tmp; float* slab; unsigned* cnt; const float* fg;
    __device__ __forceinline__ void operator()(const f32x4 (&acc)[2][2][4][2], const pg8::Unit& u, int wr, int wc, int fr, int fq) const {
        const int row0 = u.pm * 256 + wr * 64 + fr, col0 = u.pn * 256 + wc * 32 + 4 * fq;
        if (u.mode == 0) {
#pragma unroll
            for (int ai = 0; ai < 2; ++ai)
#pragma unroll
                for (int m = 0; m < 4; ++m) { const size_t row = (size_t)(row0 + ai * 128 + m * 16); const bf16_t* prow = P + row * LDP + PC_GS + col0; bf16_t* trow = tmp + row * DM + col0;
#pragma unroll
                    for (int bj = 0; bj < 2; ++bj)
#pragma unroll
                        for (int n = 0; n < 2; ++n) { const int o = bj * 128 + n * 16; const u32x2 gg = *(const u32x2*)(prow + o); const f32x4 a = acc[ai][bj][m][n];
                            *(u32x2*)(trow + o) = pack4(bf_lo(gg.x) * a[0], bf_hi(gg.x) * a[1], bf_lo(gg.y) * a[2], bf_hi(gg.y) * a[3]); } }
        } else {
            const int gc = (u.koff < 1024) ? PC_GS : PC_GR; float* sl = slab + (size_t)(u.koff >> 8) * NSMP * DM;
#pragma unroll
            for (int m = 0; m < 4; ++m) { const size_t row = (size_t)(row0 + m * 16); const bf16_t* prow = P + row * LDP + gc + col0; float* srow = sl + (row - MP) * DM + col0;
#pragma unroll
                for (int bj = 0; bj < 2; ++bj)
#pragma unroll
                    for (int n = 0; n < 2; ++n) { const int o = bj * 128 + n * 16; const u32x2 gg = *(const u32x2*)(prow + o); const f32x4 a = acc[0][bj][m][n];
                        *(f32x4*)(srow + o) = (f32x4){bf_lo(gg.x) * a[0], bf_hi(gg.x) * a[1], bf_lo(gg.y) * a[2], bf_hi(gg.y) * a[3]}; } }
        }
    }
    __device__ __forceinline__ void fused(f32x4 (&acc)[2][2][4][2], const pg8::Unit& u, int wr, int wc, int fr, int fq, LAS unsigned char* lds, int wid, int lane) const {
        const int row0 = u.pm * 256 + wr * 64 + fr, col0 = u.pn * 256 + wc * 32 + 4 * fq;
        LAS float* PT = (LAS float*)lds; LAS float* ST = (LAS float*)(lds + 4096);
        f32x4 gt[2][2];
        { const float* gtrow = mod + (size_t)(u.pm >> 3) * NMOD + 2 * DM + col0;
#pragma unroll
          for (int bj = 0; bj < 2; ++bj)
#pragma unroll
              for (int n = 0; n < 2; ++n) gt[bj][n] = *(const f32x4*)(gtrow + bj * 128 + n * 16); }
#pragma unroll
        for (int ai = 0; ai < 2; ++ai)
#pragma unroll
            for (int m = 0; m < 4; ++m) { const size_t row = (size_t)(row0 + ai * 128 + m * 16);
                const bf16_t* prow = P + row * LDP + PC_GR + col0; const bf16_t* trow = tmp + row * DM + col0; const float* xrow = xp + row * DM + col0;
                u32x2 gg[4], tv[4]; f32x4 xv[4];
#pragma unroll
                for (int q = 0; q < 4; ++q) { const int o = (q >> 1) * 128 + (q & 1) * 16; gg[q] = *(const u32x2*)(prow + o); tv[q] = *(const u32x2*)(trow + o); xv[q] = *(const f32x4*)(xrow + o); }
                float ss = 0.f;
#pragma unroll
                for (int q = 0; q < 4; ++q) { const f32x4 a = acc[ai][q >> 1][m][q & 1]; const f32x4 g4 = gt[q >> 1][q & 1];
                    f32x4 r; r[0] = xv[q][0] + g4[0] * (bf_lo(tv[q].x) + bf_lo(gg[q].x) * a[0]); r[1] = xv[q][1] + g4[1] * (bf_hi(tv[q].x) + bf_hi(gg[q].x) * a[1]);
                    r[2] = xv[q][2] + g4[2] * (bf_lo(tv[q].y) + bf_lo(gg[q].y) * a[2]); r[3] = xv[q][3] + g4[3] * (bf_hi(tv[q].y) + bf_hi(gg[q].y) * a[3]);
                    ss += (r[0] * r[0] + r[1] * r[1]) + (r[2] * r[2] + r[3] * r[3]);
                    acc[ai][q >> 1][m][q & 1] = r; }
                ss += __shfl_xor(ss, 16); ss += __shfl_xor(ss, 32);
                if (fq == 0) PT[(ai * 128 + wr * 64 + m * 16 + fr) * 4 + wc] = ss; }
        asm volatile("s_waitcnt lgkmcnt(0)" ::: "memory"); __builtin_amdgcn_s_barrier(); asm volatile("" ::: "memory");
        const int row = wid * 32 + (lane & 31);
        if (lane < 32) { const f32x4 p4 = *(const LAS f32x4*)(PT + row * 4);
            __hip_atomic_store(xbuf + ((size_t)(u.pm * 256 + row) * 8 + u.pn), (p4[0] + p4[1]) + (p4[2] + p4[3]), __ATOMIC_RELAXED, __HIP_MEMORY_SCOPE_AGENT); }
        asm volatile("s_waitcnt vmcnt(0)" ::: "memory");
        if (lane == 0) __hip_atomic_fetch_add(cnt + 64 * u.pm, 1u, __ATOMIC_RELAXED, __HIP_MEMORY_SCOPE_AGENT);
        if (wid == 0) {
            unsigned sp = 0;
            while ((unsigned)__builtin_amdgcn_readfirstlane(__hip_atomic_load(cnt + 64 * u.pm, __ATOMIC_RELAXED, __HIP_MEMORY_SCOPE_AGENT)) < 64u) { __builtin_amdgcn_s_sleep(2); if (++sp > (1u << 22)) break; }
            __builtin_amdgcn_fence(__ATOMIC_ACQUIRE, "agent");
        }
        asm volatile("s_waitcnt vmcnt(0) lgkmcnt(0)" ::: "memory"); __builtin_amdgcn_s_barrier(); asm volatile("" ::: "memory");
        if (lane < 32) { const float* sl = xbuf + (size_t)(u.pm * 256 + row) * 8; float s8 = 0.f;
#pragma unroll
            for (int t = 0; t < 8; ++t) s8 += __hip_atomic_load(sl + t, __ATOMIC_RELAXED, __HIP_MEMORY_SCOPE_AGENT);
            ST[row] = rsqrtf(s8 * (1.0f / DM) + RMS_EPS); }
        asm volatile("s_waitcnt lgkmcnt(0)" ::: "memory"); __builtin_amdgcn_s_barrier(); asm volatile("" ::: "memory");
        f32x4 fgv[2][2];
#pragma unroll
        for (int bj = 0; bj < 2; ++bj)
#pragma unroll
            for (int n = 0; n < 2; ++n) fgv[bj][n] = *(const f32x4*)(fg + col0 + bj * 128 + n * 16);
#pragma unroll
        for (int ai = 0; ai < 2; ++ai)
#pragma unroll
            for (int m = 0; m < 4; ++m) { const int rl = ai * 128 + wr * 64 + m * 16 + fr; const float rstd = ST[rl]; float* orow = out + (size_t)(u.pm * 256 + rl) * DM + col0;
#pragma unroll
                for (int bj = 0; bj < 2; ++bj)
#pragma unroll
                    for (int n = 0; n < 2; ++n) *(f32x4*)(orow + bj * 128 + n * 16) = acc[ai][bj][m][n] * rstd * fgv[bj][n]; }
    }
};

struct Args { const float* in[34]; float* out; unsigned char* ws; int ph_lo, ph_hi, li, pad; };
enum { I_XP = 0, I_XS, I_CP, I_CS, I_S5RE, I_S5IM, I_WKV, I_SHIFT, I_NORMG, I_WADA, I_BADA, I_WIN, I_MU, I_ARE, I_AIM, I_LOGSTEP, I_BRE, I_BIM, I_CRE, I_CIM, I_DSKIP,
       I_WGLU, I_BGLU, I_W0, I_W2, I_A0, I_A2, I_KK, I_KA, I_RK, I_GNW, I_GNB, I_WOUT, I_FINALG };

__device__ __forceinline__ void transpose_item(const float* W, int ldw, int K, int csrc, bf16_t* WT, int rdst, int k0, LAS float* scr, int lane, bool zero) {
    if (zero) {
#pragma unroll
        for (int j = 0; j < 4; ++j) { const int n = (lane >> 3) + 8 * j; *(u32x4*)(WT + (size_t)(rdst + n) * K + k0 + 8 * (lane & 7)) = (u32x4){0u, 0u, 0u, 0u}; }
        return;
    }
#pragma unroll 8
    for (int i = 0; i < 32; ++i) { const int kk = 2 * i + (lane >> 5); scr[kk * 33 + (lane & 31)] = W[(size_t)(k0 + kk) * ldw + csrc + (lane & 31)]; }
    LDS_WAIT(); asm volatile("" ::: "memory");
    const int c = lane & 7;
#pragma unroll
    for (int j = 0; j < 4; ++j) { const int n = (lane >> 3) + 8 * j; const LAS float* s = scr + (8 * c) * 33 + n;
        u32x4 o; o.x = cvt_pk_bf16(s[0 * 33], s[1 * 33]); o.y = cvt_pk_bf16(s[2 * 33], s[3 * 33]); o.z = cvt_pk_bf16(s[4 * 33], s[5 * 33]); o.w = cvt_pk_bf16(s[6 * 33], s[7 * 33]);
        *(u32x4*)(WT + (size_t)(rdst + n) * K + k0 + 8 * c) = o; }
    LDS_WAIT(); asm volatile("" ::: "memory");
}

__device__ __forceinline__ void wait_count(unsigned* cnt, unsigned need, int wave) {
    if (wave == 0) { unsigned sp = 0;
        while ((unsigned)__builtin_amdgcn_readfirstlane(__hip_atomic_load(cnt, __ATOMIC_RELAXED, __HIP_MEMORY_SCOPE_AGENT)) < need) { __builtin_amdgcn_s_sleep(4); if (++sp > (1u << 22)) break; }
        __builtin_amdgcn_fence(__ATOMIC_ACQUIRE, "agent");
        asm volatile("s_waitcnt vmcnt(0)" ::: "memory"); }
    __syncthreads();
}
__device__ __forceinline__ void p0_mod(const Args& a, LAS unsigned char* lds, int s, int wave, int lane) {
    const float* cp = a.in[I_CP]; const float* cs = a.in[I_CS]; const float* W = a.in[I_WADA]; const float* bias = a.in[I_BADA];
    float* mod = (float*)(a.ws + WS_MOD);
    const int n0 = 32 * s, k0 = 256 * wave, r31 = lane & 31, h = lane >> 5;
    f32x16 acc[5];
#pragma unroll
    for (int t = 0; t < 5; ++t)
#pragma unroll
        for (int r = 0; r < 16; ++r) acc[t][r] = 0.f;
    float bw[8]; f32x4 c0[5], c1[5];
#define MOD_LOAD(ks_) do { const int kb_ = k0 + 16 * (ks_) + 8 * h; \
        _Pragma("unroll") for (int j = 0; j < 8; ++j) bw[j] = W[(size_t)(kb_ + j) * NMOD + n0 + r31]; \
        _Pragma("unroll") for (int t = 0; t < 5; ++t) { const int R = 32 * t + r31; c0[t] = (f32x4){0.f, 0.f, 0.f, 0.f}; c1[t] = c0[t]; \
            if (R < NMODROWS) { const float* src = (R < NB) ? cp + (size_t)R * DM + kb_ : cs + (size_t)(R - NB) * DM + kb_; c0[t] = *(const f32x4*)src; c1[t] = *(const f32x4*)(src + 4); } } } while (0)
    MOD_LOAD(0);
#pragma unroll 1
    for (int ks = 0; ks < 16; ++ks) {
        bf16x8 bfr; { u32x4 t; t.x = cvt_pk_bf16(bw[0], bw[1]); t.y = cvt_pk_bf16(bw[2], bw[3]); t.z = cvt_pk_bf16(bw[4], bw[5]); t.w = cvt_pk_bf16(bw[6], bw[7]); bfr = __builtin_bit_cast(bf16x8, t); }
        bf16x8 afr[5];
#pragma unroll
        for (int t = 0; t < 5; ++t) { u32x4 w; w.x = cvt_pk_bf16(siluf_(c0[t][0]), siluf_(c0[t][1])); w.y = cvt_pk_bf16(siluf_(c0[t][2]), siluf_(c0[t][3])); w.z = cvt_pk_bf16(siluf_(c1[t][0]), siluf_(c1[t][1])); w.w = cvt_pk_bf16(siluf_(c1[t][2]), siluf_(c1[t][3])); afr[t] = __builtin_bit_cast(bf16x8, w); }
        if (ks + 1 < 16) MOD_LOAD(ks + 1);
#pragma unroll
        for (int t = 0; t < 5; ++t) acc[t] = __builtin_amdgcn_mfma_f32_32x32x16_bf16(afr[t], bfr, acc[t], 0, 0, 0);
    }
#undef MOD_LOAD
    LAS float* red = (LAS float*)lds;
#pragma unroll
    for (int step = 4; step >= 1; step >>= 1) {
        if (wave >= step && wave < 2 * step) {
#pragma unroll
            for (int t = 0; t < 5; ++t)
#pragma unroll
                for (int r = 0; r < 16; ++r) red[(((wave - step) * 5 + t) * 16 + r) * 64 + lane] = acc[t][r];
        }
        __syncthreads();
        if (wave < step) {
#pragma unroll
            for (int t = 0; t < 5; ++t)
#pragma unroll
                for (int r = 0; r < 16; ++r) acc[t][r] += red[((wave * 5 + t) * 16 + r) * 64 + lane];
        }
        __syncthreads();
    }
    if (wave == 0) {
        const float bc = bias[n0 + r31];
#pragma unroll
        for (int t = 0; t < 5; ++t)
#pragma unroll
            for (int r = 0; r < 16; ++r) { const int R = 32 * t + (r & 3) + 8 * (r >> 2) + 4 * h; if (R < NMODROWS) mod[(size_t)R * NMOD + n0 + r31] = acc[t][r] + bc; }
    }
}

__device__ __forceinline__ void p0_s5_tables(const Args& a, LAS unsigned char* lds, int g, int tid) {
    LAS float* pw = (LAS float*)lds;
    LAS float* bbL = pw + 17 * 128;
    LAS float* ccL = bbL + 2048;
    LAS float* KF = ccL + 2048;
    LAS float* DL = KF + 4096;
    unsigned char* tab = (unsigned char*)a.out + DO_S5TAB + (size_t)g * S5T_BYTES;
    {
        const int p = tid & 63;
        const float step = expf(a.in[I_LOGSTEP][g]);
        const float lre = fminf(a.in[I_ARE][g * 64 + p], -1e-4f), lim = a.in[I_AIM][g * 64 + p];
        const float mag = expf(lre * step); float sn, cs; sincosf(lim * step, &sn, &cs);
        const float abr = mag * cs, abi = mag * sn, den = lre * lre + lim * lim;
        const float fr = ((abr - 1.0f) * lre + abi * lim) / den, fi = (abi * lre - (abr - 1.0f) * lim) / den;
        if (tid < 64) { float pr = 1.f, pi = 0.f;
            for (int e = 0; e <= 16; ++e) { pw[(e * 64 + p) * 2] = pr; pw[(e * 64 + p) * 2 + 1] = pi; const float nr = pr * abr - pi * abi, ni = pr * abi + pi * abr; pr = nr; pi = ni; } }
#pragma unroll
        for (int i = 0; i < 2; ++i) { const int c = (tid >> 6) + 8 * i; const float br = a.in[I_BRE][(g * 64 + p) * 16 + c], bi = a.in[I_BIM][(g * 64 + p) * 16 + c];
            bbL[(p * 16 + c) * 2] = fr * br - fi * bi; bbL[(p * 16 + c) * 2 + 1] = fr * bi + fi * br;
            ccL[(c * 64 + p) * 2] = a.in[I_CRE][(g * 16 + c) * 64 + p]; ccL[(c * 64 + p) * 2 + 1] = a.in[I_CIM][(g * 16 + c) * 64 + p]; }
        if (tid < 16) DL[tid] = a.in[I_DSKIP][g * 16 + tid];
    }
    __syncthreads();
    for (int idx = tid; idx < 4096; idx += 512) { const int e = idx >> 8, c = (idx >> 4) & 15, c2 = idx & 15; float s = 0.f;
        for (int p = 0; p < 64; ++p) { const float cr = ccL[(c * 64 + p) * 2], ci = ccL[(c * 64 + p) * 2 + 1], pr = pw[(e * 64 + p) * 2], pi = pw[(e * 64 + p) * 2 + 1];
            const float ar = cr * pr - ci * pi, ai = cr * pi + ci * pr; s += ar * bbL[(p * 16 + c2) * 2] - ai * bbL[(p * 16 + c2) * 2 + 1]; }
        if (e == 0 && c == c2) s += DL[c];
        KF[idx] = s; }
    __syncthreads();
    for (int it = tid; it < 4096; it += 512) { const int l = it & 63, s = (it >> 6) & 15, mtile = it >> 10; const int m = 32 * mtile + (l & 31), h = l >> 5, p = m & 63, im = m >> 6;
        const float pr = pw[((15 - s) * 64 + p) * 2], pi = pw[((15 - s) * 64 + p) * 2 + 1]; float v[8];
#pragma unroll
        for (int j = 0; j < 8; ++j) { const float br = bbL[(p * 16 + 8 * h + j) * 2], bi = bbL[(p * 16 + 8 * h + j) * 2 + 1]; v[j] = im ? (pr * bi + pi * br) : (pr * br - pi * bi); }
        u32x4 w; w.x = cvt_pk_bf16(v[0], v[1]); w.y = cvt_pk_bf16(v[2], v[3]); w.z = cvt_pk_bf16(v[4], v[5]); w.w = cvt_pk_bf16(v[6], v[7]);
        *(u32x4*)(tab + S5T_ME + (size_t)it * 16) = w; }
    for (int it = tid; it < 1024; it += 512) { const int l = it & 63, ti = it >> 6; const int rho = l & 31, dt = rho >> 4, c = rho & 15, h = l >> 5, e = ti - 1 + dt; float v[8];
#pragma unroll
        for (int j = 0; j < 8; ++j) v[j] = (e < 0) ? 0.f : KF[(e * 16 + c) * 16 + 8 * h + j];
        u32x4 w; w.x = cvt_pk_bf16(v[0], v[1]); w.y = cvt_pk_bf16(v[2], v[3]); w.z = cvt_pk_bf16(v[4], v[5]); w.w = cvt_pk_bf16(v[6], v[7]);
        *(u32x4*)(tab + S5T_KT + (size_t)it * 16) = w; }
    for (int it = tid; it < 4096; it += 512) { const int l = it & 63, ks = (it >> 6) & 7, mt = it >> 9; const int rho = l & 31, dt = rho >> 4, c = rho & 15, h = l >> 5, t = 2 * mt + dt; float v[8];
#pragma unroll
        for (int j = 0; j < 8; ++j) { const int m = 16 * ks + 8 * h + j, p = m & 63; const float cr = ccL[(c * 64 + p) * 2], ci = ccL[(c * 64 + p) * 2 + 1], pr = pw[((t + 1) * 64 + p) * 2], pi = pw[((t + 1) * 64 + p) * 2 + 1];
            v[j] = (m < 64) ? (cr * pr - ci * pi) : -(cr * pi + ci * pr); }
        u32x4 w; w.x = cvt_pk_bf16(v[0], v[1]); w.y = cvt_pk_bf16(v[2], v[3]); w.z = cvt_pk_bf16(v[4], v[5]); w.w = cvt_pk_bf16(v[6], v[7]);
        *(u32x4*)(tab + S5T_CA + (size_t)it * 16) = w; }
    { const int it = tid; const int l = it & 63, sp = (it >> 6) & 1, mtile = it >> 7; const int rho = l & 31, h = l >> 5; float v[8];
#pragma unroll
        for (int j = 0; j < 8; ++j) { const int m = 32 * mtile + 16 * sp + 8 * (j >> 2) + 4 * h + (j & 3), p = m & 63; v[j] = (rho < 16) ? ((m < 64) ? ccL[(rho * 64 + p) * 2] : -ccL[(rho * 64 + p) * 2 + 1]) : 0.f; }
        u32x4 w; w.x = cvt_pk_bf16(v[0], v[1]); w.y = cvt_pk_bf16(v[2], v[3]); w.z = cvt_pk_bf16(v[4], v[5]); w.w = cvt_pk_bf16(v[6], v[7]);
        *(u32x4*)(tab + S5T_C0 + (size_t)it * 16) = w; }
    if (tid < 64) { const int l = tid, rho = l & 31, h = l >> 5; float v[8];
#pragma unroll
        for (int j = 0; j < 8; ++j) v[j] = (rho < 16 && rho == 8 * h + j) ? DL[rho] : 0.f;
        u32x4 w; w.x = cvt_pk_bf16(v[0], v[1]); w.y = cvt_pk_bf16(v[2], v[3]); w.z = cvt_pk_bf16(v[4], v[5]); w.w = cvt_pk_bf16(v[6], v[7]);
        *(u32x4*)(tab + S5T_DF + (size_t)l * 16) = w;
        float* hdr = (float*)(tab + S5T_HDR);
        hdr[l] = pw[(16 * 64 + l) * 2]; hdr[64 + l] = pw[(16 * 64 + l) * 2 + 1]; hdr[128 + l] = pw[(64 + l) * 2]; hdr[192 + l] = pw[(64 + l) * 2 + 1]; }
    __syncthreads();
}

__device__ __forceinline__ void p1_row(const Args& a, int m, int lane) {
    bf16_t* XN = (bf16_t*)(a.ws + WS_XN) + (size_t)m * DM;
    if (m >= MV) {
        const float* src = a.in[I_SHIFT] + (size_t)(m - MV) * DM;
#pragma unroll
        for (int j = 0; j < 8; ++j) { const f32x4 v = *(const f32x4*)(src + 4 * lane + 256 * j); u32x2 w; w.x = cvt_pk_bf16(v[0], v[1]); w.y = cvt_pk_bf16(v[2], v[3]); *(u32x2*)(XN + 4 * lane + 256 * j) = w; }
        return;
    }
    const float* x = (m < MP) ? a.in[I_XP] + (size_t)m * DM : a.in[I_XS] + (size_t)(m - MP) * DM;
    const int mrow = (m < MP) ? (m >> 11) : (NB + m - MP);
    const float* mod = (const float*)(a.ws + WS_MOD) + (size_t)mrow * NMOD;
    const float* g = a.in[I_NORMG];
    f32x4 v[8]; float ss = 0.f;
#pragma unroll
    for (int j = 0; j < 8; ++j) { v[j] = *(const f32x4*)(x + 4 * lane + 256 * j); ss += (v[j][0] * v[j][0] + v[j][1] * v[j][1]) + (v[j][2] * v[j][2] + v[j][3] * v[j][3]); }
    const float rstd = rsqrtf(wave_sum(ss) * (1.0f / DM) + RMS_EPS);
    float* sh_out = nullptr;
    if (m >= MP) sh_out = a.out + OUT_SHIFT_S + (size_t)(m - MP) * DM;
    else if ((m & (SEQ - 1)) == SEQ - 1) sh_out = a.out + OUT_SHIFT_P + (size_t)(m >> 11) * DM;
#pragma unroll
    for (int j = 0; j < 8; ++j) { const int k = 4 * lane + 256 * j; const f32x4 gv = *(const f32x4*)(g + k), sh = *(const f32x4*)(mod + k), sc = *(const f32x4*)(mod + DM + k);
        f32x4 hv;
#pragma unroll
        for (int q = 0; q < 4; ++q) hv[q] = v[j][q] * rstd * gv[q] * (1.0f + sc[q]) + sh[q];
        u32x2 w; w.x = cvt_pk_bf16(hv[0], hv[1]); w.y = cvt_pk_bf16(hv[2], hv[3]); *(u32x2*)(XN + k) = w;
        if (sh_out) *(f32x4*)(sh_out + k) = hv; }
}

constexpr int RW_TB = 32;
constexpr int RW_KK = 0, RW_DR = 2048, RW_DD = 4096, RW_BB = 6144, RW_KP = 8192, RW_VV = 10240, RW_SC = 11264, RW_LW = 11392, RW_LA = 13440, RW_OB = 15488, RW_BVB = 16512, RW_END = 17536;
__device__ __forceinline__ void lerp8(const bf16_t* cur, const bf16_t* prev, bool has_prev, const float* mu, float (&o)[8]) {
    const u32x4 c = *(const u32x4*)cur; u32x4 p = (u32x4){0u, 0u, 0u, 0u}; if (has_prev) p = *(const u32x4*)prev;
    const f32x4 m0 = *(const f32x4*)mu, m1 = *(const f32x4*)(mu + 4);
    const float cf[8] = {bf_lo(c.x), bf_hi(c.x), bf_lo(c.y), bf_hi(c.y), bf_lo(c.z), bf_hi(c.z), bf_lo(c.w), bf_hi(c.w)};
    const float pf[8] = {bf_lo(p.x), bf_hi(p.x), bf_lo(p.y), bf_hi(p.y), bf_lo(p.z), bf_hi(p.z), bf_lo(p.w), bf_hi(p.w)};
    const float mf[8] = {m0[0], m0[1], m0[2], m0[3], m1[0], m1[1], m1[2], m1[3]};
#pragma unroll
    for (int j = 0; j < 8; ++j) o[j] = cf[j] + (pf[j] - cf[j]) * mf[j];
}
struct RwTok { float kk, dr, dd, bb, kp, v, br, kr, bonus; };
__device__ __forceinline__ RwTok rw_token(const Args& a, int hj, float r, float k, float v, float lw, float la) {
    RwTok o;
    const float wpre = a.in[I_W0][hj] + lw;
    const float nz = -wpre;
    const float sp = fmaxf(nz, 0.f) + log1pf(__expf(-fabsf(nz)));
    const float w = -sp - 0.5f;
    o.dd = __expf(-__expf(w));
    const float av = sigmoidf_(a.in[I_A0][hj] + la);
    const float kkv = k * a.in[I_KK][hj];
    const float nrm = sqrtf(wave_sum(kkv * kkv));
    o.kk = kkv / fmaxf(nrm, 1e-12f);
    o.kp = k * (1.0f + (av - 1.0f) * a.in[I_KA][hj]);
    o.bb = o.kk * av;
    o.dr = o.dd * r;
    o.v = v;
    o.br = wave_sum(o.bb * r);
    o.kr = wave_sum(o.kp * r);
    o.bonus = wave_sum(r * o.kp * a.in[I_RK][hj]);
    return o;
}
__device__ __forceinline__ void p3_rwkv_prompt(const Args& a, LAS unsigned char* lds, int unit, int tid, int wave, int lane) {
    const int b = unit >> 5, h = (unit >> 1) & 15, half = unit & 1;
    LAS float* L = (LAS float*)lds;
    const bf16_t* P = (const bf16_t*)(a.ws + WS_P);
    bf16_t* ORAW = (bf16_t*)((unsigned char*)a.out + DO_ORAW); bf16_t* BV = (bf16_t*)((unsigned char*)a.out + DO_BV);
    const float* mu = a.in[I_MU];
    const int r31 = lane & 31, hh = lane >> 5;
    bf16x8 bfr[4];
    if (wave < 4) { const float* W2 = (wave >> 1) ? a.in[I_A2] : a.in[I_W2]; const int col = h * 64 + 32 * (wave & 1) + r31;
#pragma unroll
        for (int ks = 0; ks < 4; ++ks) { float w[8];
#pragma unroll
            for (int j = 0; j < 8; ++j) w[j] = W2[(size_t)(16 * ks + 8 * hh + j) * 1024 + col];
            u32x4 t; t.x = cvt_pk_bf16(w[0], w[1]); t.y = cvt_pk_bf16(w[2], w[3]); t.z = cvt_pk_bf16(w[4], w[5]); t.w = cvt_pk_bf16(w[6], w[7]); bfr[ks] = __builtin_bit_cast(bf16x8, t); } }
    const int srow = 4 * wave + (lane >> 4), cq = lane & 15;
    f32x4 S = (f32x4){0.f, 0.f, 0.f, 0.f};
    for (int t0 = 0; t0 < SEQ; t0 += RW_TB) {
        const size_t rowbase = (size_t)b * SEQ + t0;
        if (wave < 4) { const int mat = wave >> 1, nt2 = wave & 1; const size_t row = rowbase + r31; const bool hp = (t0 + r31) > 0;
            f32x16 acc;
#pragma unroll
            for (int r = 0; r < 16; ++r) acc[r] = 0.f;
#pragma unroll
            for (int ks = 0; ks < 4; ++ks) { const int col = PC_WD + mat * 64 + 16 * ks + 8 * hh; float x8[8];
                lerp8(P + row * LDP + col, P + (row - 1) * LDP + col, hp, mu + 3072 + mat * 64 + 16 * ks + 8 * hh, x8);
                if (mat == 0) {
#pragma unroll
                    for (int j = 0; j < 8; ++j) x8[j] = tanhf_(x8[j]); }
                u32x4 t; t.x = cvt_pk_bf16(x8[0], x8[1]); t.y = cvt_pk_bf16(x8[2], x8[3]); t.z = cvt_pk_bf16(x8[4], x8[5]); t.w = cvt_pk_bf16(x8[6], x8[7]);
                acc = __builtin_amdgcn_mfma_f32_32x32x16_bf16(__builtin_bit_cast(bf16x8, t), bfr[ks], acc, 0, 0, 0); }
            LAS float* dst = L + (mat ? RW_LA : RW_LW);
#pragma unroll
            for (int r = 0; r < 16; ++r) { const int tl = (r & 3) + 8 * (r >> 2) + 4 * hh; dst[tl * 64 + 32 * nt2 + r31] = acc[r]; } }
        __syncthreads();
#pragma unroll
        for (int q = 0; q < 4; ++q) { const int tl = wave * 4 + q; const size_t row = rowbase + tl; const bool hp = (t0 + tl) > 0; const int hj = h * 64 + lane;
            const bf16_t* pc = P + row * LDP; const bf16_t* pp = pc - LDP;
            float r = bf2f(pc[PC_R + hj]), k = bf2f(pc[PC_K + hj]), v = bf2f(pc[PC_V + hj]);
            const float pr = hp ? bf2f(pp[PC_R + hj]) : 0.f, pk = hp ? bf2f(pp[PC_K + hj]) : 0.f, pv = hp ? bf2f(pp[PC_V + hj]) : 0.f;
            r += (pr - r) * mu[hj]; k += (pk - k) * mu[1024 + hj]; v += (pv - v) * mu[2048 + hj];
            const RwTok o = rw_token(a, hj, r, k, v, L[RW_LW + tl * 64 + lane], L[RW_LA + tl * 64 + lane]);
            L[RW_KK + tl * 64 + lane] = o.kk; L[RW_DR + tl * 64 + lane] = o.dr; L[RW_DD + tl * 64 + lane] = o.dd; L[RW_BB + tl * 64 + lane] = o.bb; L[RW_KP + tl * 64 + lane] = o.kp;
            if ((lane >> 5) == half) L[RW_VV + tl * 32 + (lane & 31)] = o.v;
            if (lane == 0) { L[RW_SC + tl * 4] = o.br; L[RW_SC + tl * 4 + 1] = o.kr; L[RW_SC + tl * 4 + 2] = o.bonus; } }
        __syncthreads();
#pragma unroll 4
        for (int tl = 0; tl < RW_TB; ++tl) {
            const f32x4 kk4 = *(const LAS f32x4*)(L + RW_KK + tl * 64 + 4 * cq), dr4 = *(const LAS f32x4*)(L + RW_DR + tl * 64 + 4 * cq), d4 = *(const LAS f32x4*)(L + RW_DD + tl * 64 + 4 * cq),
                        b4 = *(const LAS f32x4*)(L + RW_BB + tl * 64 + 4 * cq), k4 = *(const LAS f32x4*)(L + RW_KP + tl * 64 + 4 * cq);
            const float v = L[RW_VV + tl * 32 + srow]; const f32x4 sc = *(const LAS f32x4*)(L + RW_SC + tl * 4);
            float p1 = (S[0] * kk4[0] + S[1] * kk4[1]) + (S[2] * kk4[2] + S[3] * kk4[3]);
            float p2 = (S[0] * dr4[0] + S[1] * dr4[1]) + (S[2] * dr4[2] + S[3] * dr4[3]);
            p1 = row16_sum(p1); p2 = row16_sum(p2);
            const float sa = -p1;
            const float o = p2 + sa * sc[0] + v * sc[1];
#pragma unroll
            for (int j = 0; j < 4; ++j) S[j] = S[j] * d4[j] + sa * b4[j] + v * k4[j];
            if (cq == 0) { L[RW_OB + tl * 32 + srow] = o; L[RW_BVB + tl * 32 + srow] = sc[2] * v; }
        }
        __syncthreads();
        { const int tl = tid >> 4, r2 = 2 * (tid & 15); const size_t off = (rowbase + tl) * 1024 + h * 64 + 32 * half + r2;
          *(unsigned*)(ORAW + off) = cvt_pk_bf16(L[RW_OB + tl * 32 + r2], L[RW_OB + tl * 32 + r2 + 1]);
          *(unsigned*)(BV + off) = cvt_pk_bf16(L[RW_BVB + tl * 32 + r2], L[RW_BVB + tl * 32 + r2 + 1]); }
    }
    *(f32x4*)(a.out + OUT_WKV_P + (((size_t)(b * 16 + h) * 64 + 32 * half + srow) * 64 + 4 * cq)) = S;
    __syncthreads();
}


constexpr int RC_LD = 72, RC_MAT = 64 * RC_LD * 2;
constexpr int RC_QK = 0 * RC_MAT, RC_RT = 1 * RC_MAT, RC_KT = 2 * RC_MAT, RC_BT = 3 * RC_MAT, RC_QKT = 4 * RC_MAT, RC_BHT = 5 * RC_MAT, RC_KHT = 6 * RC_MAT, RC_VT = 7 * RC_MAT,
              RC_AKK = 8 * RC_MAT, RC_ARK = 9 * RC_MAT, RC_ARB = 10 * RC_MAT, RC_TB = 11 * RC_MAT, RC_AKB = 12 * RC_MAT, RC_W1T = 12 * RC_MAT, RC_U1T = 13 * RC_MAT,
              RC_AVT = RC_QK, RC_TF = RC_KT, RC_LWA = RC_AKK, RC_SEG = 14 * RC_MAT;
static_assert(RC_SEG + 2048 <= RING_BYTES, "rwkv chunk lds");
constexpr int RS_ROWB = 656, RS_BASE = 0;
static_assert(RS_BASE + 65 * RS_ROWB <= RC_AKK, "staging must stay inside R0..R7");
#define MFMA32(a, b, c) __builtin_amdgcn_mfma_f32_32x32x16_bf16((a), (b), (c), 0, 0, 0)
#define MFMA16(a, b, c) __builtin_amdgcn_mfma_f32_16x16x32_bf16((a), (b), (c), 0, 0, 0)
__device__ __forceinline__ bf16x8 lds_frag(LAS unsigned char* lds, int mat, int row, int k0) { return *(const LAS bf16x8*)(lds + mat + (row * RC_LD + k0) * 2); }

__device__ __forceinline__ void p3_rwkv_chunks(const Args& a, LAS unsigned char* lds, int bh, int seg, int tid, int wave, int lane) {
    const int b = bh >> 4, h = bh & 15, r31_ = lane & 31, hh_ = lane >> 5, hj = h * 64 + lane;
    const bf16_t* P = (const bf16_t*)(a.ws + WS_P);
    bf16_t* BV = (bf16_t*)((unsigned char*)a.out + DO_BV);
    const float* mu = a.in[I_MU];
    LAS float* SEG = (LAS float*)(lds + RC_SEG);
    bf16x8 bfr[4];
    { const float* W2 = (wave >> 2) ? a.in[I_A2] : a.in[I_W2]; const int col = h * 64 + 32 * (wave & 1) + r31_;
#pragma unroll
      for (int ks = 0; ks < 4; ++ks) { float w[8];
#pragma unroll
          for (int j = 0; j < 8; ++j) w[j] = W2[(size_t)(16 * ks + 8 * hh_ + j) * 1024 + col];
          u32x4 t; t.x = cvt_pk_bf16(w[0], w[1]); t.y = cvt_pk_bf16(w[2], w[3]); t.z = cvt_pk_bf16(w[4], w[5]); t.w = cvt_pk_bf16(w[6], w[7]); bfr[ks] = __builtin_bit_cast(bf16x8, t); } }
    const float w0j = a.in[I_W0][hj], a0j = a.in[I_A0][hj], kkj = a.in[I_KK][hj], kaj = a.in[I_KA][hj], rkj = a.in[I_RK][hj];
    const float mur = mu[hj], muk = mu[1024 + hj], muv = mu[2048 + hj];
    unsigned goff[6], loff[6]; u32x4 pf[6];
#pragma unroll
    for (int i = 0; i < 6; ++i) { const int idx = tid + 512 * i, row = idx / 40, c = idx - row * 40;
        const int col = (c < 8) ? PC_R + h * 64 + 8 * c : ((c < 16) ? PC_K + h * 64 + 8 * (c - 8) : ((c < 24) ? PC_V + h * 64 + 8 * (c - 16) : PC_WD + 8 * (c - 24)));
        goff[i] = (unsigned)(row * LDP + col) * 2u; loff[i] = (unsigned)(RS_BASE + row * RS_ROWB + c * 16); }
#define RWC_PREFETCH(chunk_) do { const unsigned char* pb_ = (const unsigned char*)(P + ((size_t)b * SEQ + (size_t)(chunk_) * 64 - 1) * LDP); \
        _Pragma("unroll") for (int i = 0; i < 6; ++i) { const bool ok_ = (tid + 512 * i < 2600) && ((chunk_) > 0 || tid + 512 * i >= 40); \
            pf[i] = (u32x4){0u, 0u, 0u, 0u}; if (ok_) pf[i] = *(const u32x4*)(pb_ + goff[i]); } } while (0)
    RWC_PREFETCH(seg * 8);
#pragma unroll 1
    for (int ci = 0; ci < 8; ++ci) {
        const int chunk = seg * 8 + ci; const size_t rowbase = (size_t)b * SEQ + chunk * 64;
#pragma unroll
        for (int i = 0; i < 6; ++i) if (tid + 512 * i < 2600) *(LAS u32x4*)(lds + loff[i]) = pf[i];
        if (ci + 1 < 8) RWC_PREFETCH(chunk + 1);
        __syncthreads();
        int r31 = r31_, hh = hh_; asm volatile("" : "+v"(r31), "+v"(hh));
        unsigned char* rwi = a.ws + WS_RWI + (size_t)((bh * 32) + chunk) * RWI_BYTES;
        { const int mat = wave >> 2, mtile = (wave >> 1) & 1, nt2 = wave & 1; const int tl = 32 * mtile + r31;
          f32x16 acc;
#pragma unroll
          for (int r = 0; r < 16; ++r) acc[r] = 0.f;
#pragma unroll
          for (int ks = 0; ks < 4; ++ks) { float x8[8];
              { const u32x4 c = *(const LAS u32x4*)(lds + RS_BASE + (tl + 1) * RS_ROWB + (24 + mat * 8 + 2 * ks + hh) * 16), p = *(const LAS u32x4*)(lds + RS_BASE + tl * RS_ROWB + (24 + mat * 8 + 2 * ks + hh) * 16);
                const float cf[8] = {bf_lo(c.x), bf_hi(c.x), bf_lo(c.y), bf_hi(c.y), bf_lo(c.z), bf_hi(c.z), bf_lo(c.w), bf_hi(c.w)};
                const float pf8[8] = {bf_lo(p.x), bf_hi(p.x), bf_lo(p.y), bf_hi(p.y), bf_lo(p.z), bf_hi(p.z), bf_lo(p.w), bf_hi(p.w)};
                const float* mp = mu + 3072 + mat * 64 + 16 * ks + 8 * hh; const f32x4 m0 = *(const f32x4*)mp, m1 = *(const f32x4*)(mp + 4);
                const float mf[8] = {m0[0], m0[1], m0[2], m0[3], m1[0], m1[1], m1[2], m1[3]};
#pragma unroll
                for (int j = 0; j < 8; ++j) x8[j] = cf[j] + (pf8[j] - cf[j]) * mf[j]; }
              if (mat == 0) {
#pragma unroll
                  for (int j = 0; j < 8; ++j) x8[j] = tanhf_(x8[j]); }
              u32x4 t; t.x = cvt_pk_bf16(x8[0], x8[1]); t.y = cvt_pk_bf16(x8[2], x8[3]); t.z = cvt_pk_bf16(x8[4], x8[5]); t.w = cvt_pk_bf16(x8[6], x8[7]);
              acc = MFMA32(__builtin_bit_cast(bf16x8, t), bfr[ks], acc); }
          LAS float* dst = (LAS float*)(lds + RC_LWA) + mat * 64 * 68;
#pragma unroll
          for (int r = 0; r < 16; ++r) { const int t2 = 32 * mtile + (r & 3) + 8 * (r >> 2) + 4 * hh; dst[t2 * 68 + 32 * nt2 + r31] = acc[r]; } }
        __syncthreads();
        float r8[8], kp8[8], kk8[8], bb8[8], v8[8], ld8[8], cs8[8];
        { const LAS float* LW = (const LAS float*)(lds + RC_LWA); const LAS float* LA = LW + 64 * 68;
#pragma unroll
          for (int q = 0; q < 8; ++q) { const int tl = 8 * wave + q; const size_t row = rowbase + tl;
              const LAS bf16_t* pc = (const LAS bf16_t*)(lds + RS_BASE + (tl + 1) * RS_ROWB); const LAS bf16_t* pp = (const LAS bf16_t*)(lds + RS_BASE + tl * RS_ROWB);
              float r = bf2f(pc[lane]), k = bf2f(pc[64 + lane]), v = bf2f(pc[128 + lane]);
              const float pr = bf2f(pp[lane]), pk = bf2f(pp[64 + lane]), pv = bf2f(pp[128 + lane]);
              r += (pr - r) * mur; k += (pk - k) * muk; v += (pv - v) * muv;
              ld8[q] = -0.6065306597126334f * sigmoidf_(w0j + LW[tl * 68 + lane]);
              const float av = sigmoidf_(a0j + LA[tl * 68 + lane]);
              const float kkv = k * kkj; const float rn = fminf(__builtin_amdgcn_rsqf(wave_sum_dpp(kkv * kkv)), 1e12f);
              kk8[q] = kkv * rn; kp8[q] = k * (1.0f + (av - 1.0f) * kaj); bb8[q] = kk8[q] * av; r8[q] = r; v8[q] = v;
              const float bonus = wave_sum_dpp(r * kp8[q] * rkj);
              BV[row * 1024 + hj] = f2bf(bonus * v); }
          cs8[0] = ld8[0];
#pragma unroll
          for (int q = 1; q < 8; ++q) cs8[q] = cs8[q - 1] + ld8[q];
          SEG[wave * 64 + lane] = cs8[7]; }
        __syncthreads();
        { float off = 0.f, cL = 0.f;
#pragma unroll
          for (int w2 = 0; w2 < 8; ++w2) { const float sg = SEG[w2 * 64 + lane]; cL += sg; if (w2 < wave) off += sg; }
          if (wave == 0) *(float*)(rwi + RWI_LAM + lane * 4) = __expf(cL);
          float qkT[8], bhT[8], khT[8];
          const float eLtot = __expf(cL); float ecprev = __expf(off);
#pragma unroll
          for (int q = 0; q < 8; ++q) { const int tl = 8 * wave + q; const float c = off + cs8[q];
              const float ec = __expf(c), ecp = ecprev, enc = rcpf_(ec), eL = eLtot * enc; ecprev = ec;
              const float qk = kk8[q] * ecp;
              ((LAS bf16_t*)(lds + RC_QK))[tl * RC_LD + lane] = f2bf(qk); ((LAS bf16_t*)(lds + RC_RT))[tl * RC_LD + lane] = f2bf(r8[q] * ec);
              ((LAS bf16_t*)(lds + RC_KT))[tl * RC_LD + lane] = f2bf(kp8[q] * enc); ((LAS bf16_t*)(lds + RC_BT))[tl * RC_LD + lane] = f2bf(bb8[q] * enc);
              qkT[q] = qk; bhT[q] = bb8[q] * eL; khT[q] = kp8[q] * eL; }
          u32x4 t;
          t.x = cvt_pk_bf16(qkT[0], qkT[1]); t.y = cvt_pk_bf16(qkT[2], qkT[3]); t.z = cvt_pk_bf16(qkT[4], qkT[5]); t.w = cvt_pk_bf16(qkT[6], qkT[7]); *(LAS u32x4*)(lds + RC_QKT + (lane * RC_LD + 8 * wave) * 2) = t;
          t.x = cvt_pk_bf16(bhT[0], bhT[1]); t.y = cvt_pk_bf16(bhT[2], bhT[3]); t.z = cvt_pk_bf16(bhT[4], bhT[5]); t.w = cvt_pk_bf16(bhT[6], bhT[7]); *(LAS u32x4*)(lds + RC_BHT + (lane * RC_LD + 8 * wave) * 2) = t;
          t.x = cvt_pk_bf16(khT[0], khT[1]); t.y = cvt_pk_bf16(khT[2], khT[3]); t.z = cvt_pk_bf16(khT[4], khT[5]); t.w = cvt_pk_bf16(khT[6], khT[7]); *(LAS u32x4*)(lds + RC_KHT + (lane * RC_LD + 8 * wave) * 2) = t;
          t.x = cvt_pk_bf16(v8[0], v8[1]); t.y = cvt_pk_bf16(v8[2], v8[3]); t.z = cvt_pk_bf16(v8[4], v8[5]); t.w = cvt_pk_bf16(v8[6], v8[7]); *(LAS u32x4*)(lds + RC_VT + (lane * RC_LD + 8 * wave) * 2) = t; }
        __syncthreads();
#pragma unroll
        for (int jr = 0; jr < 2; ++jr) { const int job = wave + 8 * jr; if (job < 12) {
            const int mat = job / 3, tt = job % 3, ms = (tt == 2) ? 1 : 0, nt2 = (tt == 0) ? 0 : 1;
            const int X = (mat & 1) ? RC_BT : RC_KT, Y = (mat & 2) ? RC_RT : RC_QK;
            f32x16 acc;
#pragma unroll
            for (int r = 0; r < 16; ++r) acc[r] = 0.f;
#pragma unroll
            for (int ks = 0; ks < 4; ++ks) acc = MFMA32(lds_frag(lds, X, 32 * ms + r31, 16 * ks + 8 * hh), lds_frag(lds, Y, 32 * nt2 + r31, 16 * ks + 8 * hh), acc);
            const int t = 32 * nt2 + r31; const bool incl = (mat & 2) != 0;
#pragma unroll
            for (int g4 = 0; g4 < 4; ++g4) { const int s0 = 32 * ms + 8 * g4 + 4 * hh; float v[4];
#pragma unroll
                for (int e = 0; e < 4; ++e) { const int sx = s0 + e; v[e] = (incl ? (sx <= t) : (sx < t)) ? acc[4 * g4 + e] : 0.f; }
                if (mat == 1) *(LAS f32x4*)(lds + RC_AKB + (t * 72 + s0) * 4) = (f32x4){v[0], v[1], v[2], v[3]};
                else { const int dstm = (mat == 0) ? RC_AKK : ((mat == 2) ? RC_ARK : RC_ARB); *(LAS u32x2*)(lds + dstm + (t * RC_LD + s0) * 2) = pack4(v[0], v[1], v[2], v[3]); } } } }
        __syncthreads();
        LAS float* TF = (LAS float*)(lds + RC_TF); const LAS float* AKB = (const LAS float*)(lds + RC_AKB); LAS float* YS = SEG;
        if (wave == 0) {
            const int I = lane >> 4, jj = lane & 15; float x[16];
#pragma unroll
            for (int r = 0; r < 16; ++r) { float sacc = (r == jj) ? 1.f : 0.f;
#pragma unroll
                for (int q = 0; q < r; ++q) sacc -= AKB[(16 * I + r) * 72 + 16 * I + q] * x[q];
                x[r] = sacc; TF[(16 * I + r) * 72 + 16 * I + jj] = sacc; }
        } else if (wave < 4) {
            const int t2 = tid - 64;
            for (int e = t2; e < 512; e += 192) { const int blk = e >> 8, rr = (e >> 4) & 15, cc = e & 15; TF[(32 * blk + rr) * 72 + 32 * blk + 16 + cc] = 0.f; }
        } else {
            const int mt = (wave >> 1) & 1, nt2 = wave & 1; f32x16 acc;
#pragma unroll
            for (int r = 0; r < 16; ++r) acc[r] = 0.f;
#pragma unroll
            for (int ks = 0; ks < 4; ++ks) if (ks < 2 || mt == 1) acc = MFMA32(lds_frag(lds, RC_AKK, 32 * mt + r31, 16 * ks + 8 * hh), lds_frag(lds, RC_VT, 32 * nt2 + r31, 16 * ks + 8 * hh), acc);
#pragma unroll
            for (int g4 = 0; g4 < 4; ++g4) *(LAS u32x2*)(lds + RC_AVT + ((32 * nt2 + r31) * RC_LD + 32 * mt + 8 * g4 + 4 * hh) * 2) = pack4(acc[4 * g4], acc[4 * g4 + 1], acc[4 * g4 + 2], acc[4 * g4 + 3]);
        }
        __syncthreads();
        { const int pr = tid >> 8, i = (tid >> 4) & 15, jj = tid & 15, ba = 2 * pr, bb = 2 * pr + 1;
          float y = 0.f;
#pragma unroll
          for (int q = 0; q < 16; ++q) y += AKB[(16 * bb + i) * 72 + 16 * ba + q] * TF[(16 * ba + q) * 72 + 16 * ba + jj];
          YS[tid] = y; }
        __syncthreads();
        { const int pr = tid >> 8, i = (tid >> 4) & 15, jj = tid & 15, ba = 2 * pr, bb = 2 * pr + 1; float tv = 0.f;
#pragma unroll
          for (int q = 0; q < 16; ++q) tv -= TF[(16 * bb + i) * 72 + 16 * bb + q] * YS[pr * 256 + q * 16 + jj];
          TF[(16 * bb + i) * 72 + 16 * ba + jj] = tv; }
        __syncthreads();
        { const int i = tid >> 4, j0 = (tid & 15) * 2; float z0 = 0.f, z1 = 0.f;
#pragma unroll 8
          for (int q = 0; q < 32; ++q) { const float av = AKB[(32 + i) * 72 + q]; z0 += av * TF[q * 72 + j0]; z1 += av * TF[q * 72 + j0 + 1]; }
          __syncthreads();
          TF[i * 72 + 32 + j0] = z0; TF[i * 72 + 32 + j0 + 1] = z1; }
        __syncthreads();
        { const int i = tid >> 4, j0 = (tid & 15) * 2; float t0 = 0.f, t1 = 0.f;
#pragma unroll 8
          for (int q = 0; q < 32; ++q) { const float tb = TF[(32 + i) * 72 + 32 + q]; t0 -= tb * TF[q * 72 + 32 + j0]; t1 -= tb * TF[q * 72 + 32 + j0 + 1]; }
          TF[(32 + i) * 72 + j0] = t0; TF[(32 + i) * 72 + j0 + 1] = t1; }
        __syncthreads();
        { const int t = tid >> 3, c0 = (tid & 7) * 8; const f32x4 x0 = *(const LAS f32x4*)(TF + t * 72 + c0), x1 = *(const LAS f32x4*)(TF + t * 72 + c0 + 4);
          u32x4 w; w.x = cvt_pk_bf16(x0[0], x0[1]); w.y = cvt_pk_bf16(x0[2], x0[3]); w.z = cvt_pk_bf16(x1[0], x1[1]); w.w = cvt_pk_bf16(x1[2], x1[3]);
          *(LAS u32x4*)(lds + RC_TB + (t * RC_LD + c0) * 2) = w; }
        __syncthreads();
        { const int which = wave >> 2, mt = (wave >> 1) & 1, nt2 = wave & 1; const int Bm = which ? RC_AVT : RC_QKT, Dm = which ? RC_U1T : RC_W1T; f32x16 acc;
#pragma unroll
          for (int r = 0; r < 16; ++r) acc[r] = 0.f;
#pragma unroll
          for (int ks = 0; ks < 4; ++ks) if (ks < 2 || mt == 1) acc = MFMA32(lds_frag(lds, RC_TB, 32 * mt + r31, 16 * ks + 8 * hh), lds_frag(lds, Bm, 32 * nt2 + r31, 16 * ks + 8 * hh), acc);
#pragma unroll
          for (int g4 = 0; g4 < 4; ++g4) *(LAS u32x2*)(lds + Dm + ((32 * nt2 + r31) * RC_LD + 32 * mt + 8 * g4 + 4 * hh) * 2) = pack4(acc[4 * g4], acc[4 * g4 + 1], acc[4 * g4 + 2], acc[4 * g4 + 3]); }
        __syncthreads();
        { const int kind = wave >> 2, mt = (wave >> 1) & 1, nt2 = wave & 1; const int cidx = 32 * nt2 + r31;
          f32x16 acc;
#pragma unroll
          for (int r = 0; r < 16; ++r) acc[r] = 0.f;
          if (kind == 0) {
#pragma unroll
              for (int ks = 0; ks < 4; ++ks) acc = MFMA32(lds_frag(lds, RC_W1T, 32 * mt + r31, 16 * ks + 8 * hh), lds_frag(lds, RC_BHT, cidx, 16 * ks + 8 * hh), acc);
#pragma unroll
              for (int g4 = 0; g4 < 4; ++g4) { const int jo = 8 * g4 + 4 * hh, half = jo >> 4, q2 = (jo & 15) >> 2; const int blk = (cidx >> 4) * 2 + mt, lane2 = (cidx & 15) + 16 * q2;
                  *(u32x2*)(rwi + RWI_GF + (blk * 64 + lane2) * 16 + half * 8) = pack4(-acc[4 * g4], -acc[4 * g4 + 1], -acc[4 * g4 + 2], -acc[4 * g4 + 3]); }
          } else {
#pragma unroll
              for (int ks = 0; ks < 4; ++ks) if (ks < 2 || nt2 == 1) acc = MFMA32(lds_frag(lds, RC_W1T, 32 * mt + r31, 16 * ks + 8 * hh), lds_frag(lds, RC_ARB, cidx, 16 * ks + 8 * hh), acc);
#pragma unroll
              for (int g4 = 0; g4 < 4; ++g4) { const int jo = 8 * g4 + 4 * hh, half = jo >> 4, q2 = (jo & 15) >> 2; const int blk = (cidx >> 4) * 2 + mt, lane2 = (cidx & 15) + 16 * q2;
                  const u32x2 rt = *(const LAS u32x2*)(lds + RC_RT + (cidx * RC_LD + 32 * mt + jo) * 2);
                  *(u32x2*)(rwi + RWI_W2F + (blk * 64 + lane2) * 16 + half * 8) = pack4(bf_lo(rt.x) - acc[4 * g4], bf_hi(rt.x) - acc[4 * g4 + 1], bf_lo(rt.y) - acc[4 * g4 + 2], bf_hi(rt.y) - acc[4 * g4 + 3]); }
          }
          f32x16 ac1, ac2;
#pragma unroll
          for (int r = 0; r < 16; ++r) { ac1[r] = 0.f; ac2[r] = 0.f; }
          if (kind == 0) {
#pragma unroll
              for (int ks = 0; ks < 4; ++ks) { ac1 = MFMA32(lds_frag(lds, RC_KHT, 32 * mt + r31, 16 * ks + 8 * hh), lds_frag(lds, RC_VT, cidx, 16 * ks + 8 * hh), ac1);
                                               ac2 = MFMA32(lds_frag(lds, RC_BHT, 32 * mt + r31, 16 * ks + 8 * hh), lds_frag(lds, RC_U1T, cidx, 16 * ks + 8 * hh), ac2); }
#pragma unroll
              for (int g4 = 0; g4 < 4; ++g4) { const int ro = 32 * mt + 8 * g4 + 4 * hh, mt2 = ro >> 4, q2 = (ro & 15) >> 2, cb = cidx >> 4, lane2 = (cidx & 15) + 16 * q2;
                  *(f32x4*)(rwi + RWI_H1F + ((cb * 4 + mt2) * 64 + lane2) * 16) = (f32x4){ac1[4 * g4] - ac2[4 * g4], ac1[4 * g4 + 1] - ac2[4 * g4 + 1], ac1[4 * g4 + 2] - ac2[4 * g4 + 2], ac1[4 * g4 + 3] - ac2[4 * g4 + 3]}; }
          } else {
#pragma unroll
              for (int ks = 0; ks < 4; ++ks) if (ks < 2 || nt2 == 1) { ac1 = MFMA32(lds_frag(lds, RC_VT, 32 * mt + r31, 16 * ks + 8 * hh), lds_frag(lds, RC_ARK, cidx, 16 * ks + 8 * hh), ac1);
                                                                        ac2 = MFMA32(lds_frag(lds, RC_U1T, 32 * mt + r31, 16 * ks + 8 * hh), lds_frag(lds, RC_ARB, cidx, 16 * ks + 8 * hh), ac2); }
#pragma unroll
              for (int g4 = 0; g4 < 4; ++g4) { const int ro = 32 * mt + 8 * g4 + 4 * hh, cb = ro >> 4, q2 = (ro & 15) >> 2, nt3 = cidx >> 4, lane2 = (cidx & 15) + 16 * q2;
                  *(f32x4*)(rwi + RWI_O1F + ((cb * 4 + nt3) * 64 + lane2) * 16) = (f32x4){ac1[4 * g4] - ac2[4 * g4], ac1[4 * g4 + 1] - ac2[4 * g4 + 1], ac1[4 * g4 + 2] - ac2[4 * g4 + 2], ac1[4 * g4 + 3] - ac2[4 * g4 + 3]}; }
          } }
        __syncthreads();
    }
}

__device__ __forceinline__ void p3_rwkv_seq(const Args& a, int unit, int lane) {
    const int bh = unit >> 2, cb = unit & 3, b = bh >> 4, h = bh & 15, l15 = lane & 15, q = lane >> 4;
    bf16_t* ORAW = (bf16_t*)((unsigned char*)a.out + DO_ORAW);
    f32x4 hacc[4];
#pragma unroll
    for (int m = 0; m < 4; ++m) hacc[m] = (f32x4){0.f, 0.f, 0.f, 0.f};
    const unsigned char* base = a.ws + WS_RWI + (size_t)(bh * 32) * RWI_BYTES;
    bf16x8 gf[8]; f32x4 h1[4], lam[4];
#define RW2_LOADG(src) do { _Pragma("unroll") for (int k2 = 0; k2 < 8; ++k2) gf[k2] = *(const bf16x8*)((src) + RWI_GF + (k2 * 64 + lane) * 16); \
        _Pragma("unroll") for (int m = 0; m < 4; ++m) { h1[m] = *(const f32x4*)((src) + RWI_H1F + ((cb * 4 + m) * 64 + lane) * 16); lam[m] = *(const f32x4*)((src) + RWI_LAM + (16 * m + 4 * q) * 4); } } while (0)
    RW2_LOADG(base);
#pragma unroll 1
    for (int c = 0; c < 32; ++c) {
        const unsigned char* cur = base + (size_t)c * RWI_BYTES;
        bf16x8 w2f[8]; f32x4 o1[4];
#pragma unroll
        for (int k2 = 0; k2 < 8; ++k2) w2f[k2] = *(const bf16x8*)(cur + RWI_W2F + (k2 * 64 + lane) * 16);
#pragma unroll
        for (int n = 0; n < 4; ++n) o1[n] = *(const f32x4*)(cur + RWI_O1F + ((cb * 4 + n) * 64 + lane) * 16);
        bf16x8 hb[2];
#pragma unroll
        for (int ks = 0; ks < 2; ++ks) { u32x4 t; t.x = cvt_pk_bf16(hacc[2 * ks][0], hacc[2 * ks][1]); t.y = cvt_pk_bf16(hacc[2 * ks][2], hacc[2 * ks][3]);
            t.z = cvt_pk_bf16(hacc[2 * ks + 1][0], hacc[2 * ks + 1][1]); t.w = cvt_pk_bf16(hacc[2 * ks + 1][2], hacc[2 * ks + 1][3]); hb[ks] = __builtin_bit_cast(bf16x8, t); }
        f32x4 nacc[4];
#pragma unroll
        for (int m = 0; m < 4; ++m) { nacc[m] = h1[m] + lam[m] * hacc[m];
#pragma unroll
            for (int ks = 0; ks < 2; ++ks) nacc[m] = MFMA16(gf[m * 2 + ks], hb[ks], nacc[m]); }
        if (c + 1 < 32) RW2_LOADG(cur + RWI_BYTES);
#pragma unroll
        for (int n = 0; n < 4; ++n) { f32x4 oacc = o1[n];
#pragma unroll
            for (int ks = 0; ks < 2; ++ks) oacc = MFMA16(hb[ks], w2f[n * 2 + ks], oacc);
            *(u32x2*)(ORAW + ((size_t)b * SEQ + c * 64 + 16 * n + l15) * 1024 + h * 64 + 16 * cb + 4 * q) = pack4(oacc[0], oacc[1], oacc[2], oacc[3]); }
#pragma unroll
        for (int m = 0; m < 4; ++m) hacc[m] = nacc[m];
    }
#undef RW2_LOADG
#pragma unroll
    for (int m = 0; m < 4; ++m) *(f32x4*)(a.out + OUT_WKV_P + (((size_t)bh * 64 + 16 * cb + l15) * 64 + 16 * m + 4 * q)) = hacc[m];
}

__device__ __forceinline__ void p3_rwkv_sample(const Args& a, LAS unsigned char* lds, int bs, int h, int wave, int lane) {
    LAS float* Lw = (LAS float*)lds + wave * 768;
    const bf16_t* P = (const bf16_t*)(a.ws + WS_P);
    const bf16_t* pc = P + (size_t)(MP + bs) * LDP; const bf16_t* pp = P + (size_t)(MV + bs) * LDP;
    bf16_t* A2 = (bf16_t*)(a.ws + WS_XN);
    const float* mu = a.in[I_MU];
    const int hj = h * 64 + lane, rg = lane >> 4, cq = lane & 15;
    const size_t sbase = ((size_t)(bs * 16 + h) * 64) * 64;
    const float* S0 = a.in[I_WKV] + sbase; float* S1 = a.out + OUT_WKV_S + sbase;
    f32x4 S[16];
#pragma unroll
    for (int it = 0; it < 16; ++it) S[it] = *(const f32x4*)(S0 + (size_t)(4 * it + rg) * 64 + 4 * cq);
    { float wd = bf2f(pc[PC_WD + lane]), ad = bf2f(pc[PC_AD + lane]); wd += (bf2f(pp[PC_WD + lane]) - wd) * mu[3072 + lane]; ad += (bf2f(pp[PC_AD + lane]) - ad) * mu[3136 + lane];
      Lw[lane] = tanhf_(wd); Lw[64 + lane] = ad; }
    LDS_WAIT();
    float lw = 0.f, la = 0.f;
#pragma unroll 16
    for (int m = 0; m < 64; ++m) { lw += Lw[m] * a.in[I_W2][(size_t)m * 1024 + hj]; la += Lw[64 + m] * a.in[I_A2][(size_t)m * 1024 + hj]; }
    float r = bf2f(pc[PC_R + hj]), k = bf2f(pc[PC_K + hj]), v = bf2f(pc[PC_V + hj]);
    r += (bf2f(pp[PC_R + hj]) - r) * mu[hj]; k += (bf2f(pp[PC_K + hj]) - k) * mu[1024 + hj]; v += (bf2f(pp[PC_V + hj]) - v) * mu[2048 + hj];
    const RwTok o = rw_token(a, hj, r, k, v, lw, la);
    Lw[128 + lane] = o.kk; Lw[192 + lane] = o.dr; Lw[256 + lane] = o.dd; Lw[320 + lane] = o.bb; Lw[384 + lane] = o.kp; Lw[448 + lane] = o.v;
    LDS_WAIT();
    const f32x4 kk4 = *(const LAS f32x4*)(Lw + 128 + 4 * cq), dr4 = *(const LAS f32x4*)(Lw + 192 + 4 * cq), d4 = *(const LAS f32x4*)(Lw + 256 + 4 * cq), b4 = *(const LAS f32x4*)(Lw + 320 + 4 * cq), k4 = *(const LAS f32x4*)(Lw + 384 + 4 * cq);
#pragma unroll
    for (int it = 0; it < 16; ++it) { const int i = 4 * it + rg; const float vi = Lw[448 + i];
        float p1 = (S[it][0] * kk4[0] + S[it][1] * kk4[1]) + (S[it][2] * kk4[2] + S[it][3] * kk4[3]);
        float p2 = (S[it][0] * dr4[0] + S[it][1] * dr4[1]) + (S[it][2] * dr4[2] + S[it][3] * dr4[3]);
        p1 = row16_sum(p1); p2 = row16_sum(p2);
        const float sa = -p1, ov = p2 + sa * o.br + vi * o.kr;
        f32x4 Sn;
#pragma unroll
        for (int j = 0; j < 4; ++j) Sn[j] = S[it][j] * d4[j] + sa * b4[j] + vi * k4[j];
        *(f32x4*)(S1 + (size_t)i * 64 + 4 * cq) = Sn;
        if (cq == 0) Lw[512 + i] = ov; }
    LDS_WAIT();
    const float ov = Lw[512 + lane];
    const float mean = wave_sum_dpp(ov) * (1.0f / 64.0f); const float dv = ov - mean; const float var = wave_sum_dpp(dv * dv) * (1.0f / 64.0f);
    float on = dv * rsqrtf(var + GN_EPS) * a.in[I_GNW][hj] + a.in[I_GNB][hj] + o.bonus * o.v;
    on *= bf2f(pc[PC_ZR + hj]);
    A2[(size_t)(MP + bs) * 2048 + 1024 + hj] = f2bf(on);
    LDS_WAIT();
}

constexpr int S5_ELD = 132, S5_XLD = 136;
constexpr int S5_E_OFF = 0, S5_X_OFF = 128 * S5_ELD * 4;
__device__ __forceinline__ bf16x8 ldfrag(const unsigned char* base, int block, int lane) { return *(const bf16x8*)(base + (size_t)block * 1024 + lane * 16); }
__device__ __forceinline__ void p3_s5_prompt(const Args& a, LAS unsigned char* lds, int unit, int tid, int wave, int lane) {
    const int b = unit >> 6, g = unit & 63;
    const unsigned char* tab = (const unsigned char*)a.out + DO_S5TAB + (size_t)g * S5T_BYTES;
    const bf16_t* P = (const bf16_t*)(a.ws + WS_P);
    bf16_t* Yg = (bf16_t*)(a.ws + WS_YG);
    LAS float* EL = (LAS float*)(lds + S5_E_OFF); LAS bf16_t* XL = (LAS bf16_t*)(lds + S5_X_OFF);
    const int nt = wave & 3, hm = wave >> 2, r31 = lane & 31, hh = lane >> 5;
    const int n = 32 * nt + r31;
    { u32x4 tv[10];
#pragma unroll
      for (int i = 0; i < 10; ++i) tv[i] = *(const u32x4*)(tab + S5T_ME + (size_t)(tid + 512 * i) * 16);
#pragma unroll
      for (int i = 0; i < 10; ++i) *(LAS u32x4*)(lds + (tid + 512 * i) * 16) = tv[i]; }
    const bf16_t* ubase = P + ((size_t)b * SEQ + 16 * n) * LDP + PC_U + g * 16 + 8 * hh;
    bf16x8 bu[16];
#pragma unroll
    for (int s2 = 0; s2 < 16; ++s2) bu[s2] = *(const bf16x8*)(ubase + (size_t)s2 * LDP);
    f32x16 accY[4], accE[2];
#pragma unroll
    for (int q = 0; q < 4; ++q)
#pragma unroll
        for (int r = 0; r < 16; ++r) accY[q][r] = 0.f;
#pragma unroll
    for (int q = 0; q < 2; ++q)
#pragma unroll
        for (int r = 0; r < 16; ++r) accE[q][r] = 0.f;
    const int mts[4] = {hm ? 1 : 0, hm ? 2 : 3, hm ? 5 : 4, hm ? 6 : 7};
    __syncthreads();
#pragma unroll
    for (int s2 = 0; s2 < 16; ++s2) {
#pragma unroll
        for (int e = 0; e < 2; ++e) accE[e] = __builtin_amdgcn_mfma_f32_32x32x16_bf16(*(const LAS bf16x8*)(lds + S5T_ME + (((2 * hm + e) * 16 + s2) * 64 + lane) * 16), bu[s2], accE[e], 0, 0, 0);
#pragma unroll
        for (int q = 0; q < 4; ++q) { const int mt = mts[q]; if (s2 <= 2 * mt + 1) accY[q] = __builtin_amdgcn_mfma_f32_32x32x16_bf16(*(const LAS bf16x8*)(lds + S5T_KT + ((2 * mt - s2 + 1) * 64 + lane) * 16), bu[s2], accY[q], 0, 0, 0); }
    }
    __syncthreads();
#pragma unroll
    for (int e = 0; e < 2; ++e)
#pragma unroll
        for (int q4 = 0; q4 < 4; ++q4) { f32x4 v; v[0] = accE[e][4 * q4]; v[1] = accE[e][4 * q4 + 1]; v[2] = accE[e][4 * q4 + 2]; v[3] = accE[e][4 * q4 + 3];
            *(LAS f32x4*)(EL + n * S5_ELD + 32 * (2 * hm + e) + 8 * q4 + 4 * hh) = v; }
    __syncthreads();
    if (wave == 0) { const float* hdr = (const float*)(tab + S5T_HDR); const float ar = hdr[lane], ai = hdr[64 + lane]; float xr = 0.f, xi = 0.f;
#pragma unroll 8
        for (int c = 0; c < 128; ++c) { XL[c * S5_XLD + lane] = f2bf(xr); XL[c * S5_XLD + 64 + lane] = f2bf(xi);
            const float er = EL[c * S5_ELD + lane], ei = EL[c * S5_ELD + 64 + lane];
            const float nr = ar * xr - ai * xi + er, ni = ar * xi + ai * xr + ei; xr = nr; xi = ni; }
        a.out[OUT_S5RE_P + (size_t)(b * 64 + g) * 64 + lane] = xr; a.out[OUT_S5IM_P + (size_t)(b * 64 + g) * 64 + lane] = xi; }
    __syncthreads();
#pragma unroll
    for (int ks = 0; ks < 8; ++ks) { const bf16x8 bx = *(const LAS bf16x8*)(XL + n * S5_XLD + 16 * ks + 8 * hh);
#pragma unroll
        for (int q = 0; q < 4; ++q) accY[q] = __builtin_amdgcn_mfma_f32_32x32x16_bf16(ldfrag(tab + S5T_CA, mts[q] * 8 + ks, lane), bx, accY[q], 0, 0, 0); }
#pragma unroll
    for (int q = 0; q < 4; ++q) { const int mt = mts[q];
#pragma unroll
        for (int q4 = 0; q4 < 4; ++q4) { const int dt = q4 >> 1, c0 = 8 * (q4 & 1) + 4 * hh; const size_t row = (size_t)b * SEQ + 16 * n + 2 * mt + dt;
            u32x2 w; w.x = cvt_pk_bf16(geluf_(accY[q][4 * q4]), geluf_(accY[q][4 * q4 + 1])); w.y = cvt_pk_bf16(geluf_(accY[q][4 * q4 + 2]), geluf_(accY[q][4 * q4 + 3]));
            *(u32x2*)(Yg + row * 1024 + g * 16 + c0) = w; } }
    __syncthreads();
}
__device__ __forceinline__ void p3_s5_sample(const Args& a, int g, int wave, int lane) {
    if (wave >= 4) return;
    const unsigned char* tab = (const unsigned char*)a.out + DO_S5TAB + (size_t)g * S5T_BYTES;
    const float* hdr = (const float*)(tab + S5T_HDR);
    const bf16_t* P = (const bf16_t*)(a.ws + WS_P);
    bf16_t* Yg = (bf16_t*)(a.ws + WS_YG);
    const int r31 = lane & 31, hh = lane >> 5, bs = 32 * wave + r31;
    const bf16x8 bu = *(const bf16x8*)(P + (size_t)(MP + bs) * LDP + PC_U + g * 16 + 8 * hh);
    f32x16 z;
#pragma unroll
    for (int r = 0; r < 16; ++r) z[r] = 0.f;
    f32x16 x[4];
#pragma unroll
    for (int mtile = 0; mtile < 4; ++mtile) x[mtile] = __builtin_amdgcn_mfma_f32_32x32x16_bf16(ldfrag(tab + S5T_ME, mtile * 16 + 15, lane), bu, z, 0, 0, 0);
    const size_t sb = (size_t)(bs * 64 + g) * 64;
#pragma unroll
    for (int pt = 0; pt < 2; ++pt)
#pragma unroll
        for (int q4 = 0; q4 < 4; ++q4) { const int p0 = 32 * pt + 8 * q4 + 4 * hh;
            const f32x4 x0r = *(const f32x4*)(a.in[I_S5RE] + sb + p0), x0i = *(const f32x4*)(a.in[I_S5IM] + sb + p0);
            const f32x4 ar = *(const f32x4*)(hdr + 128 + p0), ai = *(const f32x4*)(hdr + 192 + p0);
            f32x4 nr, ni;
#pragma unroll
            for (int j = 0; j < 4; ++j) { nr[j] = ar[j] * x0r[j] - ai[j] * x0i[j] + x[pt][4 * q4 + j]; ni[j] = ar[j] * x0i[j] + ai[j] * x0r[j] + x[2 + pt][4 * q4 + j]; x[pt][4 * q4 + j] = nr[j]; x[2 + pt][4 * q4 + j] = ni[j]; }
            *(f32x4*)(a.out + OUT_S5RE_S + sb + p0) = nr; *(f32x4*)(a.out + OUT_S5IM_S + sb + p0) = ni; }
    f32x16 y = __builtin_amdgcn_mfma_f32_32x32x16_bf16(ldfrag(tab + S5T_DF, 0, lane), bu, z, 0, 0, 0);
#pragma unroll
    for (int mtile = 0; mtile < 4; ++mtile)
#pragma unroll
        for (int sp = 0; sp < 2; ++sp) { u32x4 t; t.x = cvt_pk_bf16(x[mtile][8 * sp], x[mtile][8 * sp + 1]); t.y = cvt_pk_bf16(x[mtile][8 * sp + 2], x[mtile][8 * sp + 3]);
            t.z = cvt_pk_bf16(x[mtile][8 * sp + 4], x[mtile][8 * sp + 5]); t.w = cvt_pk_bf16(x[mtile][8 * sp + 6], x[mtile][8 * sp + 7]);
            y = __builtin_amdgcn_mfma_f32_32x32x16_bf16(ldfrag(tab + S5T_C0, mtile * 2 + sp, lane), __builtin_bit_cast(bf16x8, t), y, 0, 0, 0); }
#pragma unroll
    for (int q4 = 0; q4 < 2; ++q4) { const int c0 = 8 * q4 + 4 * hh;
        u32x2 w; w.x = cvt_pk_bf16(geluf_(y[4 * q4]), geluf_(y[4 * q4 + 1])); w.y = cvt_pk_bf16(geluf_(y[4 * q4 + 2]), geluf_(y[4 * q4 + 3]));
        *(u32x2*)(Yg + (size_t)(MP + bs) * 1024 + g * 16 + c0) = w; }
}

__device__ __forceinline__ void p4_rwkv_post8(const Args& a, int item0, int lane) {
    const int item = item0 + (lane >> 3), cg = lane & 7, row = item >> 4, h = item & 15, ch = h * 64 + 8 * cg;
    const bf16_t* ORAW = (const bf16_t*)((const unsigned char*)a.out + DO_ORAW); const bf16_t* BV = (const bf16_t*)((const unsigned char*)a.out + DO_BV);
    const bf16_t* P = (const bf16_t*)(a.ws + WS_P); bf16_t* A2 = (bf16_t*)(a.ws + WS_XN);
    const u32x4 ow = *(const u32x4*)(ORAW + (size_t)row * 1024 + ch), bw = *(const u32x4*)(BV + (size_t)row * 1024 + ch), zw = *(const u32x4*)(P + (size_t)row * LDP + PC_ZR + ch);
    const f32x4 w0 = *(const f32x4*)(a.in[I_GNW] + ch), w1 = *(const f32x4*)(a.in[I_GNW] + ch + 4), b0 = *(const f32x4*)(a.in[I_GNB] + ch), b1 = *(const f32x4*)(a.in[I_GNB] + ch + 4);
    const float o[8] = {bf_lo(ow.x), bf_hi(ow.x), bf_lo(ow.y), bf_hi(ow.y), bf_lo(ow.z), bf_hi(ow.z), bf_lo(ow.w), bf_hi(ow.w)};
    const float bv[8] = {bf_lo(bw.x), bf_hi(bw.x), bf_lo(bw.y), bf_hi(bw.y), bf_lo(bw.z), bf_hi(bw.z), bf_lo(bw.w), bf_hi(bw.w)};
    const float z[8] = {bf_lo(zw.x), bf_hi(zw.x), bf_lo(zw.y), bf_hi(zw.y), bf_lo(zw.z), bf_hi(zw.z), bf_lo(zw.w), bf_hi(zw.w)};
    const float gw[8] = {w0[0], w0[1], w0[2], w0[3], w1[0], w1[1], w1[2], w1[3]}, gb[8] = {b0[0], b0[1], b0[2], b0[3], b1[0], b1[1], b1[2], b1[3]};
    float sm = ((o[0] + o[1]) + (o[2] + o[3])) + ((o[4] + o[5]) + (o[6] + o[7]));
    sm += dpp_f<0xB1>(sm); sm += dpp_f<0x4E>(sm); sm += dpp_f<0x141>(sm);
    const float mean = sm * (1.0f / 64.0f); float d[8], sq = 0.f;
#pragma unroll
    for (int j = 0; j < 8; ++j) { d[j] = o[j] - mean; sq += d[j] * d[j]; }
    sq += dpp_f<0xB1>(sq); sq += dpp_f<0x4E>(sq); sq += dpp_f<0x141>(sq);
    const float rstd = rsqrtf(sq * (1.0f / 64.0f) + GN_EPS); float r[8];
#pragma unroll
    for (int j = 0; j < 8; ++j) r[j] = (d[j] * rstd * gw[j] + gb[j] + bv[j]) * z[j];
    u32x4 w; w.x = cvt_pk_bf16(r[0], r[1]); w.y = cvt_pk_bf16(r[2], r[3]); w.z = cvt_pk_bf16(r[4], r[5]); w.w = cvt_pk_bf16(r[6], r[7]);
    *(u32x4*)(A2 + (size_t)row * 2048 + 1024 + ch) = w;
}

__device__ __forceinline__ void p6_row(const Args& a, int m, int lane) {
    float* y = a.out + (size_t)m * DM; const float* fg = a.in[I_FINALG];
    if (m < MP) {
        const float* rs = (const float*)(a.ws + WS_ROWSS) + (size_t)m * 32;
        const float ss = wave_sum(rs[lane & 31]) * 0.5f;
        const float rstd = rsqrtf(ss * (1.0f / DM) + RMS_EPS);
#pragma unroll
        for (int j = 0; j < 8; ++j) { const int k = 4 * lane + 256 * j; f32x4 v = *(const f32x4*)(y + k); const f32x4 gv = *(const f32x4*)(fg + k);
#pragma unroll
            for (int q = 0; q < 4; ++q) v[q] = v[q] * rstd * gv[q];
            *(f32x4*)(y + k) = v; }
    } else {
        const int r = m - MP; const float* slab = (const float*)(a.ws + WS_SLAB) + (size_t)r * DM; const float* x = a.in[I_XS] + (size_t)r * DM;
        const float* gtrow = (const float*)(a.ws + WS_MOD) + (size_t)(NB + r) * NMOD + 2 * DM;
        f32x4 v[8]; float ss = 0.f;
#pragma unroll
        for (int j = 0; j < 8; ++j) { const int k = 4 * lane + 256 * j; f32x4 mix = *(const f32x4*)(slab + k);
#pragma unroll
            for (int s2 = 1; s2 < 8; ++s2) mix += *(const f32x4*)(slab + (size_t)s2 * NSMP * DM + k);
            const f32x4 xv = *(const f32x4*)(x + k), gt = *(const f32x4*)(gtrow + k);
#pragma unroll
            for (int q = 0; q < 4; ++q) { v[j][q] = xv[q] + gt[q] * mix[q]; ss += v[j][q] * v[j][q]; } }
        const float rstd = rsqrtf(wave_sum(ss) * (1.0f / DM) + RMS_EPS);
#pragma unroll
        for (int j = 0; j < 8; ++j) { const int k = 4 * lane + 256 * j; const f32x4 gv = *(const f32x4*)(fg + k); f32x4 o;
#pragma unroll
            for (int q = 0; q < 4; ++q) o[q] = v[j][q] * rstd * gv[q];
            *(f32x4*)(y + k) = o; }
    }
}

__global__ void __launch_bounds__(512, 2) fwd_kernel(Args args) {
    extern __shared__ __attribute__((aligned(16))) unsigned char lds_raw[];
    LAS unsigned char* lds = (LAS unsigned char*)lds_raw;
    const int tid = threadIdx.x, lane = tid & 63, wave = __builtin_amdgcn_readfirstlane(tid >> 6);
    const int G = gridDim.x, bx = blockIdx.x;
    const int vcu = (G % 8 == 0) ? (bx % 8) * (G / 8) + bx / 8 : bx;
    volatile LAS unsigned* MISC = (volatile LAS unsigned*)(lds + MISC_OFF);
    for (int u = tid; u < (LDS_BYTES - LDSCTL_OFF) / 4; u += 512) ((LAS unsigned*)(lds + LDSCTL_OFF))[u] = 0u;
    __syncthreads();
    unsigned* ctl = (unsigned*)(args.ws + WS_CTL);
    XcdBarrier bar; bar.bar = ctl + CW_BAR + args.li * XCD_BAR_WORDS; bar.x = 0; bar.st = nullptr;
    const bool multi = (args.ph_hi - args.ph_lo) > 1;
    if (multi) bar = xcd_barrier_post(ctl + CW_BAR + args.li * XCD_BAR_WORDS, MISC + 8);
    const int lo = args.ph_lo, hi = args.ph_hi;
#define IN(k) (lo <= (k) && (k) < hi)
#define SEAM(k) do { if (IN(k) && IN((k) + 1)) xcd_barrier(bar); } while (0)
    const int gw = vcu * 8 + wave, NGW = G * 8;

    if (IN(0)) {
        if (vcu < 192) p0_mod(args, lds, vcu, wave, lane);
        else if (vcu - 192 < 64) p0_s5_tables(args, lds, vcu - 192, tid);
    }
    SEAM(0);
    if (IN(1)) {
        { LAS float* scr = (LAS float*)(lds + wave * 16384);
          bf16_t* WT = (bf16_t*)(args.ws + WS_WT);
          for (int it = gw; it < 328 * 32; it += NGW) { const int nb = it >> 5, kb = it & 31; const int p0 = 32 * nb;
              const int src = (p0 < 5120) ? p0 : ((p0 < 10240) ? p0 + 128 : p0 - 5120);
              transpose_item(args.in[I_WIN], NIN, 2048, src, WT, p0, 64 * kb, scr, lane, p0 >= NIN); } }
        for (int m = gw; m < MT; m += NGW) p1_row(args, m, lane);
    }
    SEAM(1);
    const bool tail_mode = (G == 256);
    if (IN(2)) {
        pg8::Gemm g{(const bf16_t*)(args.ws + WS_XN), (const bf16_t*)(args.ws + WS_WT), 2048, 2048};
        EpiP E{(bf16_t*)(args.ws + WS_P), tail_mode};
        if (tail_mode) {
            pg8::TailOrder S; S.init2(G, bx, ctl + CW_TILE);
            pg8::gemm_phase<EpiP, pg8::TailOrder>(lds, g, S, E);
            if (bx >= 73) {
                const int t = bx - 73;
                for (int u = t; u < 256; u += 183) { wait_count(ctl + CW_TILE + 64 * ((u >> 6) * 4 + ((u & 63) >> 4)), 64u, wave); p3_s5_prompt(args, lds, u, tid, wave, lane); }
                if (t >= 73 && t < 137) { const int g2 = t - 73; wait_count(ctl + CW_TILE + 64 * (16 + (g2 >> 4)), 8u, wave); p3_s5_sample(args, g2, wave, lane); }
                __syncthreads();
                { LAS float* scr = (LAS float*)(lds + wave * 16384);
                  for (int it = t * 8 + wave; it < 2048 + 512; it += 183 * 8) {
                      if (it < 2048) { const int nb = it >> 5, kb = it & 31; transpose_item(args.in[I_WOUT], 2048, 2048, 32 * nb, (bf16_t*)(args.ws + WS_WOUT_T), 32 * nb, 64 * kb, scr, lane, false); }
                      else { const int i2 = it - 2048, nb = i2 >> 4, kb = i2 & 15; transpose_item(args.in[I_WGLU], 1024, 1024, 32 * nb, (bf16_t*)(args.ws + WS_WGLU_T), 32 * nb, 64 * kb, scr, lane, false); } } }
            }
        } else {
            pg8::StaticOrder S; S.init(MT, LDP, 2048, G, bx);
            pg8::gemm_phase<EpiP, pg8::StaticOrder>(lds, g, S, E);
        }
    }
    SEAM(2);
    if (IN(3)) {
        p3_rwkv_chunks(args, lds, vcu >> 2, vcu & 3, tid, wave, lane);
        if (!tail_mode) {
            { LAS float* scr = (LAS float*)(lds + wave * 16384);
              for (int it = gw; it < 2048 + 512; it += NGW) {
                  if (it < 2048) { const int nb = it >> 5, kb = it & 31; transpose_item(args.in[I_WOUT], 2048, 2048, 32 * nb, (bf16_t*)(args.ws + WS_WOUT_T), 32 * nb, 64 * kb, scr, lane, false); }
                  else { const int i2 = it - 2048, nb = i2 >> 4, kb = i2 & 15; transpose_item(args.in[I_WGLU], 1024, 1024, 32 * nb, (bf16_t*)(args.ws + WS_WGLU_T), 32 * nb, 64 * kb, scr, lane, false); } } }
            __syncthreads();
            for (int u = vcu; u < 256; u += G) p3_s5_prompt(args, lds, u, tid, wave, lane);
            for (int g2 = vcu; g2 < 64; g2 += G) p3_s5_sample(args, g2, wave, lane);
            __syncthreads();
        }
        for (int it = vcu; it < 256; it += G) p3_rwkv_sample(args, lds, it >> 1, (it & 1) * 8 + wave, wave, lane);
    }
    SEAM(3);
    if (IN(4)) {
        pg8::StaticOrder S; S.init(MT, 1024, 1024, G, bx);
        pg8::Unit u0;
        if (S.next(0, u0)) {
            pg8::Gemm g{(const bf16_t*)(args.ws + WS_YG), (const bf16_t*)(args.ws + WS_WGLU_T), 1024, 1024};
            EpiGlu E{(const bf16_t*)(args.ws + WS_YG), (const bf16_t*)(args.ws + WS_P), args.in[I_BGLU], (bf16_t*)(args.ws + WS_XN)};
            pg8::gemm_phase<EpiGlu, pg8::StaticOrder>(lds, g, S, E);
        } else {
            const int nfree = G - 132, j = bx - 132, unit = wave * nfree + j;
            if (unit < 256) p3_rwkv_seq(args, unit, lane);
        }
    }
    SEAM(4);
    if (IN(5)) { for (int it = gw * 8; it < MP * 16; it += NGW * 8) p4_rwkv_post8(args, it, lane); }
    SEAM(5);
    if (IN(6)) {
        pg8::Gemm g{(const bf16_t*)(args.ws + WS_XN), (const bf16_t*)(args.ws + WS_WOUT_T), 2048, 1024};
        pg8::OutOrder S; S.init(MP, DM, 1024, G, bx);
        EpiOut E{(const bf16_t*)(args.ws + WS_P), args.in[I_XP], (const float*)(args.ws + WS_MOD), args.out, (float*)(args.ws + WS_ROWSS), (bf16_t*)(args.ws + WS_TMP), (float*)(args.ws + WS_SLAB), ctl + CW_PANEL, args.in[I_FINALG]};
        pg8::gemm_phase<EpiOut, pg8::OutOrder>(lds, g, S, E);
    }
    SEAM(6);
    if (IN(7)) { for (int m = MP + gw; m < MV; m += NGW) p6_row(args, m, lane); }
#undef IN
#undef SEAM
}

extern "C" void kernel_launch(void* const* d_in, const int* in_sizes, int n_in, void* d_out, int out_size, void* d_ws, size_t ws_size, hipStream_t stream) {
    static int grid = 0;
    if (grid == 0) {
        if (n_in != 34 || ws_size < WS_END) { fprintf(stderr, "kernel_launch: unexpected n_in %d / ws %zu\n", n_in, ws_size); grid = -1; return; }
        int dev = 0, cus = 0;
        if (hipGetDevice(&dev) != hipSuccess || hipDeviceGetAttribute(&cus, hipDeviceAttributeMultiprocessorCount, dev) != hipSuccess) { grid = -1; return; }
        if (hipFuncSetAttribute((const void*)fwd_kernel, hipFuncAttributeMaxDynamicSharedMemorySize, LDS_BYTES) != hipSuccess) { fprintf(stderr, "kernel_launch: hipFuncSetAttribute failed\n"); grid = -1; return; }
        int per_cu = 0;
        if (hipOccupancyMaxActiveBlocksPerMultiprocessor(&per_cu, (const void*)fwd_kernel, 512, LDS_BYTES) != hipSuccess || per_cu < 1) fprintf(stderr, "kernel_launch: occupancy query says %d\n", per_cu);
        (void)hipGetLastError();
        grid = cus;
        if (grid != 256) fprintf(stderr, "kernel_launch: note: %d CUs\n", grid);
    }
    if (grid < 0) return;
    (void)hipMemsetAsync((char*)d_ws + WS_CTL, 0, CTL_BYTES, stream);
    Args a{};
    for (int i = 0; i < 34; ++i) a.in[i] = (const float*)d_in[i];
    a.out = (float*)d_out; a.ws = (unsigned char*)d_ws;
    if (PROBE_PHASE >= 0) {
        a.ph_lo = 0; a.ph_hi = PROBE_PHASE + 1; a.li = 0; hipLaunchKernelGGL(fwd_kernel, dim3(grid), dim3(512), LDS_BYTES, stream, a);
        a.ph_lo = PROBE_PHASE; a.ph_hi = PROBE_PHASE + 1; a.li = 1; hipLaunchKernelGGL(fwd_kernel, dim3(grid), dim3(512), LDS_BYTES, stream, a);
        if (PROBE_PHASE + 1 < N_PHASES) { a.ph_lo = PROBE_PHASE + 1; a.ph_hi = N_PHASES; a.li = 2; hipLaunchKernelGGL(fwd_kernel, dim3(grid), dim3(512), LDS_BYTES, stream, a); }
    } else if (MK_N_LAUNCHES == 1) { a.ph_lo = 0; a.ph_hi = N_PHASES; a.li = 0; hipLaunchKernelGGL(fwd_kernel, dim3(grid), dim3(512), LDS_BYTES, stream, a); }
    else { for (int p = 0; p < N_PHASES; ++p) { a.ph_lo = p; a.ph_hi = p + 1; a.li = 0; hipLaunchKernelGGL(fwd_kernel, dim3(grid), dim3(512), LDS_BYTES, stream, a); } }
}
```

```cpp
#include <hip/hip_runtime.h>
#include <cstdio>
#include <cstdint>

#ifndef MK_N_LAUNCHES
#define MK_N_LAUNCHES 1
#endif
#ifndef PROBE_PHASE
#define PROBE_PHASE -1
#endif
constexpr int N_PHASES = 8;

#define GAS __attribute__((address_space(1)))
#define LAS __attribute__((address_space(3)))
typedef unsigned short bf16_t;
typedef short bf16x8 __attribute__((ext_vector_type(8)));
typedef float f32x2 __attribute__((ext_vector_type(2)));
typedef float f32x4 __attribute__((ext_vector_type(4)));
typedef float f32x16 __attribute__((ext_vector_type(16)));
typedef unsigned u32x2 __attribute__((ext_vector_type(2)));
typedef unsigned u32x4 __attribute__((ext_vector_type(4)));
typedef GAS unsigned gu32;

constexpr int DM = 2048, SEQ = 2048, NB = 4, NSMP = 128;
constexpr int MP = NB * SEQ;
constexpr int MV = MP + NSMP;
constexpr int MT = MV + NSMP;
constexpr int NIN = 10368, LDP = 10496;
constexpr int NMOD = 6144, NMODROWS = NB + NSMP;
constexpr float RMS_EPS = 1e-6f, GN_EPS = 64e-5f;
constexpr int PC_U = 0, PC_ZS = 1024, PC_R = 2048, PC_K = 3072, PC_V = 4096, PC_ZR = 5120, PC_GS = 6144, PC_GR = 8192, PC_WD = 10240, PC_AD = 10304;

constexpr size_t WS_CTL = 0, CTL_BYTES = 131072;
constexpr size_t WS_MOD = CTL_BYTES;
constexpr size_t WS_WT = WS_MOD + 3276800;
constexpr size_t WS_XN = WS_WT + (size_t)LDP * 2048 * 2;
constexpr size_t WS_P = WS_XN + (size_t)MT * 2048 * 2;
constexpr size_t WS_RWI = WS_P + (size_t)MT * LDP * 2;
constexpr int RWI_GF = 0, RWI_W2F = 8192, RWI_H1F = 16384, RWI_O1F = 32768, RWI_LAM = 49152, RWI_BYTES = 49408;
constexpr size_t WS_TMP = WS_RWI;
constexpr size_t WS_SLAB = WS_TMP + (size_t)MP * 2048 * 2;
static_assert(WS_SLAB + (size_t)8 * NSMP * DM * 4 <= WS_RWI + (size_t)2048 * RWI_BYTES, "tmp/slab alias");
constexpr size_t WS_YG = WS_RWI + (size_t)2048 * RWI_BYTES;
constexpr size_t WS_WOUT_T = WS_YG + (size_t)MT * 1024 * 2;
constexpr size_t WS_WGLU_T = WS_WOUT_T + (size_t)2048 * 2048 * 2;
constexpr size_t WS_ROWSS = WS_WGLU_T + (size_t)1024 * 1024 * 2;
constexpr size_t WS_U2 = WS_ROWSS + (size_t)MP * 8 * 4;
constexpr size_t WS_U2S = WS_U2 + (size_t)MP * 1024 * 2;
constexpr size_t WS_END = WS_U2S + (size_t)NSMP * 1024 * 2;
static_assert(WS_END <= ((size_t)412 << 20), "ws map");
constexpr size_t DO_ORAW = 0, DO_BV = (size_t)MP * 1024 * 2, DO_S5TAB = 2 * DO_BV;
constexpr int S5T_ME = 0, S5T_KT = 65536, S5T_CA = 81920, S5T_C0 = 147456, S5T_DF = 155648, S5T_HDR = 156672, S5T_BYTES = 157696;
static_assert(DO_S5TAB + (size_t)64 * S5T_BYTES <= (size_t)MV * DM * 4, "d_out scratch");
constexpr size_t OUT_Y = 0, OUT_S5RE_P = 17039360, OUT_S5IM_P = 17055744, OUT_WKV_P = 17072128, OUT_SHIFT_P = 17334272,
                 OUT_S5RE_S = 17342464, OUT_S5IM_S = 17866752, OUT_WKV_S = 18391040, OUT_SHIFT_S = 26779648;
constexpr int RING_BYTES = 131072, LDSCTL_OFF = RING_BYTES, MISC_OFF = LDSCTL_OFF + 320, LDS_BYTES = 147456;
constexpr int CW_BAR = 1024;
constexpr int CW_PANEL = 12288, CW_TILE = 16384;

#define LDS_WAIT() asm volatile("s_waitcnt lgkmcnt(0)" ::: "memory")
#define VM_WAIT() asm volatile("s_waitcnt vmcnt(0)" ::: "memory")
typedef __bf16 bf16x2_t __attribute__((ext_vector_type(2)));
__device__ __forceinline__ unsigned cvt_pk_bf16(float lo, float hi) { const f32x2 v = {lo, hi}; return __builtin_bit_cast(unsigned, __builtin_convertvector(v, bf16x2_t)); }
__device__ __forceinline__ u32x2 pack4(float a, float b, float c, float d) { u32x2 w; w.x = cvt_pk_bf16(a, b); w.y = cvt_pk_bf16(c, d); return w; }
__device__ __forceinline__ float bf_lo(unsigned w) { return __uint_as_float(w << 16); }
__device__ __forceinline__ float bf_hi(unsigned w) { return __uint_as_float(w & 0xffff0000u); }
__device__ __forceinline__ float bf2f(bf16_t b) { return __uint_as_float(((unsigned)b) << 16); }
__device__ __forceinline__ bf16_t f2bf(float f) { return (bf16_t)(cvt_pk_bf16(f, 0.f) & 0xffffu); }
__device__ __forceinline__ float rcpf_(float x) { return __builtin_amdgcn_rcpf(x); }
__device__ __forceinline__ float sigmoidf_(float x) { return rcpf_(1.0f + __expf(-x)); }
__device__ __forceinline__ float siluf_(float x) { return x * rcpf_(1.0f + __expf(-x)); }
__device__ __forceinline__ float tanhf_(float x) { const float e = __expf(2.0f * x); return 1.0f - 2.0f * rcpf_(e + 1.0f); }
__device__ __forceinline__ float geluf_(float y) { const float z = 0.7978845608028654f * (y + 0.044715f * y * y * y); return 0.5f * y * (1.0f + tanhf_(z)); }
__device__ __forceinline__ float wave_sum(float v) {
#pragma unroll
    for (int o = 1; o < 64; o <<= 1) v += __shfl_xor(v, o);
    return v;
}
template <int CTRL> __device__ __forceinline__ float dpp_f(float x) { return __builtin_bit_cast(float, __builtin_amdgcn_mov_dpp(__builtin_bit_cast(int, x), CTRL, 0xf, 0xf, true)); }
__device__ __forceinline__ float wave_sum_dpp(float v) {
    v += __builtin_bit_cast(float, __builtin_amdgcn_update_dpp(0, __builtin_bit_cast(int, v), 0x111, 0xf, 0xf, true));
    v += __builtin_bit_cast(float, __builtin_amdgcn_update_dpp(0, __builtin_bit_cast(int, v), 0x112, 0xf, 0xf, true));
    v += __builtin_bit_cast(float, __builtin_amdgcn_update_dpp(0, __builtin_bit_cast(int, v), 0x114, 0xf, 0xf, true));
    v += __builtin_bit_cast(float, __builtin_amdgcn_update_dpp(0, __builtin_bit_cast(int, v), 0x118, 0xf, 0xf, true));
    v += __builtin_bit_cast(float, __builtin_amdgcn_update_dpp(0, __builtin_bit_cast(int, v), 0x142, 0xa, 0xf, false));
    v += __builtin_bit_cast(float, __builtin_amdgcn_update_dpp(0, __builtin_bit_cast(int, v), 0x143, 0xc, 0xf, false));
    return __builtin_bit_cast(float, __builtin_amdgcn_readlane(__builtin_bit_cast(int, v), 63));
}
__device__ __forceinline__ float row16_sum(float v) {
    v += dpp_f<0xB1>(v);
    v += dpp_f<0x4E>(v);
    v += dpp_f<0x141>(v);
    v += dpp_f<0x140>(v);
    return v;
}

#define XB_TMO      128
#define XB_XCNT(j)  (256  + 64 * (j))
#define XB_XSUB(j)  (1280 + 64 * (j))
#define XB_XGEN(j)  (2304 + 64 * (j))
#define XB_TOP      3328
#define XB_TOPGEN   3392
#define XCD_BAR_WORDS 3456
#define XB_SPIN_CAP (1u << 20)
__device__ __forceinline__ unsigned xb_ld(unsigned* p)              { return __hip_atomic_load(p, __ATOMIC_RELAXED, __HIP_MEMORY_SCOPE_AGENT); }
__device__ __forceinline__ unsigned xb_add(unsigned* p, unsigned v) { return __hip_atomic_fetch_add(p, v, __ATOMIC_RELAXED, __HIP_MEMORY_SCOPE_AGENT); }
__device__ __forceinline__ unsigned xb_xcc_id() { return (unsigned)__builtin_amdgcn_s_getreg((3 << 11) | 20) & 0xFu; }
#define XB_SPIN(cond, bar) do { unsigned _sp = 0; while (cond) { __builtin_amdgcn_s_sleep(1); \
    if ((++_sp & 255u) == 0u) { if (xb_ld(&(bar)[XB_TMO])) break; if (_sp > XB_SPIN_CAP) { atomicAdd(&(bar)[XB_TMO], 1u); break; } } } } while (0)
struct XcdBarrier { unsigned* bar; unsigned x; volatile LAS unsigned* st; };
__device__ __forceinline__ XcdBarrier xcd_barrier_post(unsigned* bar, volatile LAS unsigned* st) {
    XcdBarrier b; b.bar = bar; b.x = xb_xcc_id(); b.st = st;
    if (threadIdx.x == 0) (void)xb_add(&bar[XB_XCNT(b.x)], 1u);
    return b;
}
__device__ __forceinline__ void xcd_barrier_complete(unsigned* bar, unsigned x, unsigned& nloc, unsigned& nx) {
    const unsigned G = gridDim.x * gridDim.y * gridDim.z;
    unsigned sum, cnt, mine, sp = 0u;
    for (;;) {
        sum = 0u; cnt = 0u; mine = 0u;
#pragma unroll
        for (unsigned j = 0; j < 16; ++j) { const unsigned c = xb_ld(&bar[XB_XCNT(j)]); sum += c; cnt += (c > 0u) ? 1u : 0u; mine = (j == x) ? c : mine; }
        if (sum == G) break;
        __builtin_amdgcn_s_sleep(1);
        if ((++sp & 255u) == 0u) { if (xb_ld(&bar[XB_TMO])) break; if (sp > XB_SPIN_CAP) { atomicAdd(&bar[XB_TMO], 1u); break; } }
    }
    nloc = mine > 0u ? mine : 1u; nx = cnt > 0u ? cnt : 1u;
}
__device__ __forceinline__ void xcd_barrier(const XcdBarrier& b) {
    asm volatile("s_waitcnt vmcnt(0)" ::: "memory");
    __syncthreads();
    if (threadIdx.x == 0) {
        unsigned* bar = b.bar;
        __builtin_amdgcn_s_waitcnt(0);
        unsigned nloc = b.st[0], nx = b.st[1];
        if (nloc == 0u) { xcd_barrier_complete(bar, b.x, nloc, nx); b.st[0] = nloc; b.st[1] = nx; }
        const unsigned old = xb_add(&bar[XB_XSUB(b.x)], 1u);
        const unsigned gen = old / nloc;
        if (old + 1u == (gen + 1u) * nloc) {
            __builtin_amdgcn_fence(__ATOMIC_RELEASE, "agent");
            asm volatile("s_waitcnt vmcnt(0)" ::: "memory");
            const unsigned og = xb_add(&bar[XB_TOP], 1u);
            const unsigned tg = og / nx;
            if (og + 1u == (tg + 1u) * nx) xb_add(&bar[XB_TOPGEN], 1u);
            else XB_SPIN(xb_ld(&bar[XB_TOPGEN]) == tg, bar);
            __builtin_amdgcn_fence(__ATOMIC_ACQUIRE, "agent");
            xb_add(&bar[XB_XGEN(b.x)], 1u);
            asm volatile("s_waitcnt vmcnt(0)" ::: "memory");
        } else {
            XB_SPIN(xb_ld(&bar[XB_XGEN(b.x)]) == gen, bar);
            __builtin_amdgcn_fence(__ATOMIC_ACQUIRE, "agent");
            asm volatile("s_waitcnt vmcnt(0)" ::: "memory");
        }
    }
    __syncthreads();
}

namespace pg8 {
constexpr int BM = 256, BK = 64, HALF = 128, HTB = HALF * BK * 2, STAGE_BYTES = 8 * HTB, NXCD = 8, WGM = 8;
__host__ __device__ __forceinline__ int lds_byte(int r, int c) { const int st = (r >> 4) * 2 + (c >> 5), rr = r & 15, cc = c & 31, ob = rr * 64 + cc * 2; return st * 1024 + (ob ^ (((ob >> 9) & 1) << 5)); }
__host__ __device__ __forceinline__ void stage_rc(int b, int& R, int& C) { const int st = b / 1024, sb = b % 1024, swz = sb ^ (((sb >> 9) & 1) << 5); R = (st >> 1) * 16 + swz / 64; C = (st & 1) * 32 + (swz % 64) / 2; }
__host__ __device__ __forceinline__ int perm32(int rho) { const int n = rho >> 4, i = rho & 15; return 8 * (i >> 2) + 4 * n + (i & 3); }
struct Unit { int pm, pn, koff, kt, mode; };
struct Gemm { const bf16_t* A; const bf16_t* Bt; int ld, K; };
struct StaticOrder {
    int nM, nN, nwg, G, c, kt;
    __device__ void init(int M, int N, int K, int G_, int c_) { nM = M / BM; nN = N / BM; nwg = nM * nN; G = G_; c = c_; kt = K / BK; }
    __device__ __forceinline__ void tile(int L, Unit& u) const {
        int wgid = L; { const int q = nwg / NXCD, r = nwg % NXCD, xcd = wgid % NXCD, off = wgid / NXCD; wgid = (xcd < r ? xcd * (q + 1) : r * (q + 1) + (xcd - r) * q) + off; }
        const int nig = WGM * nN, gid = wgid / nig, fm = gid * WGM, gsz = (nM - fm) < WGM ? (nM - fm) : WGM;
        u.pm = fm + ((wgid % nig) % gsz); u.pn = (wgid % nig) / gsz; u.koff = 0; u.kt = kt; u.mode = 0;
    }
    __device__ __forceinline__ bool next(int i, Unit& u) const { const long L = (long)i * G + c; if (L >= nwg) return false; tile((int)L, u); return true; }
    __device__ __forceinline__ void done(const Unit&, int, int&) const {}
};
struct OutOrder : StaticOrder {
    __device__ __forceinline__ bool next(int i, Unit& u) const {
        const int i2 = (c < 64) ? i - 1 : i;
        if (i2 < 0) { u.pm = 32; u.pn = c >> 3; u.koff = (c & 7) * 256; u.kt = 4; u.mode = 2; return true; }
        if (i2 < 2 && c < nwg) { tile(c, u); u.koff = i2 * 1024; u.kt = 16; u.mode = i2; return true; }
        return false;
    }
};
struct TailOrder : StaticOrder {
    unsigned* cnt;
    __device__ void init2(int G_, int c_, unsigned* cnt_) { nM = 32; nN = 37; nwg = 32 * 37; G = G_; c = c_; kt = 32; cnt = cnt_; }
    __device__ __forceinline__ bool next(int i, Unit& u) const {
        const int L = i * G + c; if (L >= 169 + 1184) return false;
        if (L < 132) { const int x = L & 7, k = L >> 3; if (k < 16) { u.pm = 4 * x + (k >> 2); u.pn = k & 3; } else { u.pm = 32; u.pn = x; }
                       u.koff = 0; u.kt = 32; u.mode = 0; }
        else if (L < 169) { u.pm = 32; u.pn = 4 + (L - 132); u.koff = 0; u.kt = 32; u.mode = 0; }
        else { tile(L - 169, u); u.pn += 4; }
        return true;
    }
    __device__ __forceinline__ void done(const Unit& u, int lane, int& pend) const {
        if (pend >= 0) {
            asm volatile("s_waitcnt vmcnt(0)" ::: "memory");
            if (lane == 0) __hip_atomic_fetch_add(cnt + 64 * pend, 1u, __ATOMIC_RELAXED, __HIP_MEMORY_SCOPE_AGENT);
            pend = -1;
        }
        if (u.pm == 32 || u.pn < 4) pend = (u.pm == 32) ? 16 + u.pn : (u.pm >> 3) * 4 + u.pn;
    }
};
template <class Epi, class Sched>
__device__ __forceinline__ void gemm_phase(LAS unsigned char* lds, const Gemm g, const Sched& S, const Epi& E) {
    const int tid = threadIdx.x, wid = __builtin_amdgcn_readfirstlane(tid >> 6), lane = tid & 63, wr = wid >> 2, wc = wid & 3, fr = lane & 15, fq = lane >> 4;
    const int ld = g.ld;
    unsigned voffA[2], voffB[2];
#pragma unroll
    for (int i = 0; i < 2; ++i) { int R, C; stage_rc(tid * 16 + i * 8192, R, C); const int Rb = Epi::PERM ? ((R & ~31) + perm32(R & 31)) : R;
        voffA[i] = (unsigned)(R * ld + C) * 2u; voffB[i] = (unsigned)(Rb * ld + C) * 2u; }
    const size_t kstep = (size_t)(BK * 2);
    const size_t hstep = (size_t)HALF * ld * 2;
    const size_t tstep = 2 * hstep;
    const unsigned ldsw = (unsigned)wid * 1024u;
    const int aoff = lds_byte(wr * 64 + fr, fq * 8), boff = lds_byte(wc * 32 + fr, fq * 8);
#define PG8_SA(b, h) (((b) * 2 + (h)) * HTB)
#define PG8_SB(b, h) ((4 + (b) * 2 + (h)) * HTB)
#define PG8_STAGE(bufoff, gbase, voff) do { _Pragma("unroll") for (int _i = 0; _i < 2; ++_i) \
        __builtin_amdgcn_global_load_lds((const unsigned*)((const char*)(gbase) + (voff)[_i]), (LAS unsigned*)(lds + (bufoff) + ldsw + _i * 8192), 16, 0, 0); } while (0)
#define PG8_LDA(dst, b, h) do { _Pragma("unroll") for (int m = 0; m < 4; ++m) _Pragma("unroll") for (int k = 0; k < 2; ++k) dst[m][k] = *(const LAS bf16x8*)(lds + PG8_SA(b, h) + aoff + m * 2048 + k * 1024); } while (0)
#define PG8_LDB(dst, b, h) do { _Pragma("unroll") for (int n = 0; n < 2; ++n) _Pragma("unroll") for (int k = 0; k < 2; ++k) dst[n][k] = *(const LAS bf16x8*)(lds + PG8_SB(b, h) + boff + n * 2048 + k * 1024); } while (0)
#define PG8_MMA(ai, bj, At, Bt) do { __builtin_amdgcn_s_setprio(1); _Pragma("unroll") for (int m = 0; m < 4; ++m) _Pragma("unroll") for (int n = 0; n < 2; ++n) _Pragma("unroll") for (int k = 0; k < 2; ++k) \
        acc[ai][bj][m][n] = __builtin_amdgcn_mfma_f32_16x16x32_bf16(Bt[n][k], At[m][k], acc[ai][bj][m][n], 0, 0, 0); __builtin_amdgcn_s_setprio(0); } while (0)
#define PG8_WAIT_V(n) asm volatile("s_waitcnt vmcnt(" #n ")" ::: "memory")
#define PG8_WAIT_L(n) asm volatile("s_waitcnt lgkmcnt(" #n ")" ::: "memory")
#define PG8_BAR __builtin_amdgcn_s_barrier()
#define PG8_SCHED __builtin_amdgcn_sched_barrier(0)
    Unit cur, nxt; int ui = 0; bool deferred = false; int pend = -1;
    if (!S.next(0, cur)) return;
    f32x4 acc[2][2][4][2];
#pragma unroll
    for (int a = 0; a < 2; ++a)
#pragma unroll
        for (int b = 0; b < 2; ++b)
#pragma unroll
            for (int m = 0; m < 4; ++m)
#pragma unroll
                for (int n = 0; n < 2; ++n) acc[a][b][m][n] = (f32x4){0.f, 0.f, 0.f, 0.f};
    bf16x8 At[4][2], B0[2][2], B1[2][2];
    const char* cA = (const char*)g.A + (size_t)cur.pm * tstep + (size_t)cur.koff * 2; const char* cB = (const char*)g.Bt + (size_t)cur.pn * tstep + (size_t)cur.koff * 2;
    PG8_STAGE(PG8_SB(0, 0), cB, voffB); PG8_STAGE(PG8_SA(0, 0), cA, voffA); PG8_STAGE(PG8_SB(0, 1), cB + hstep, voffB); PG8_STAGE(PG8_SA(0, 1), cA + hstep, voffA);
    if (wr == 1) PG8_BAR;
    PG8_WAIT_V(4); PG8_BAR;
    PG8_STAGE(PG8_SB(1, 0), cB + kstep, voffB); PG8_STAGE(PG8_SA(1, 0), cA + kstep, voffA); PG8_STAGE(PG8_SB(1, 1), cB + hstep + kstep, voffB);
    PG8_WAIT_V(6); PG8_BAR;
    for (;;) {
        const bool has_next = S.next(ui + 1, nxt);
        const char* nA = has_next ? (const char*)g.A + (size_t)nxt.pm * tstep + (size_t)nxt.koff * 2 : cA; const char* nB = has_next ? (const char*)g.Bt + (size_t)nxt.pn * tstep + (size_t)nxt.koff * 2 : cB;
        const int nt = cur.kt;
        for (int t = 0; t < nt; t += 2) {
            const bool last = (t == nt - 2);
            const char* a1 = cA + (size_t)(t + 1) * kstep;
            const char* a2 = last ? nA : cA + (size_t)(t + 2) * kstep; const char* b2 = last ? nB : cB + (size_t)(t + 2) * kstep;
            const char* a3 = a2 + kstep; const char* b3 = b2 + kstep;
            PG8_LDB(B0, 0, 0); PG8_SCHED; PG8_LDA(At, 0, 0); PG8_STAGE(PG8_SA(1, 1), a1 + hstep, voffA);
            PG8_WAIT_L(8); PG8_BAR; PG8_WAIT_L(0); PG8_MMA(0, 0, At, B0); PG8_BAR; PG8_SCHED;
            PG8_LDB(B1, 0, 1); PG8_STAGE(PG8_SB(0, 0), b2, voffB);
            PG8_BAR; PG8_WAIT_L(0); PG8_MMA(0, 1, At, B1); PG8_BAR;
            PG8_LDA(At, 0, 1); PG8_STAGE(PG8_SA(0, 0), a2, voffA);
            PG8_BAR; PG8_WAIT_L(0); PG8_MMA(1, 0, At, B0); PG8_BAR; PG8_SCHED;
            PG8_STAGE(PG8_SB(0, 1), b2 + hstep, voffB);
            PG8_WAIT_V(6); PG8_BAR; PG8_MMA(1, 1, At, B1); PG8_BAR;
            PG8_LDB(B0, 1, 0); PG8_SCHED; PG8_LDA(At, 1, 0); PG8_STAGE(PG8_SA(0, 1), a2 + hstep, voffA);
            PG8_WAIT_L(8); PG8_BAR; PG8_WAIT_L(0); PG8_MMA(0, 0, At, B0); PG8_BAR; PG8_SCHED;
            PG8_LDB(B1, 1, 1); PG8_STAGE(PG8_SB(1, 0), b3, voffB);
            PG8_BAR; PG8_WAIT_L(0); PG8_MMA(0, 1, At, B1); PG8_BAR;
            PG8_LDA(At, 1, 1); PG8_STAGE(PG8_SA(1, 0), a3, voffA);
            PG8_BAR; PG8_WAIT_L(0); PG8_MMA(1, 0, At, B0); PG8_BAR; PG8_SCHED;
            PG8_STAGE(PG8_SB(1, 1), b3 + hstep, voffB);
            PG8_WAIT_V(6); PG8_BAR; PG8_MMA(1, 1, At, B1); PG8_BAR;
        }
        if (Epi::FUSED_LAST && !has_next && cur.mode == 1) deferred = true; else { E(acc, cur, wr, wc, fr, fq); S.done(cur, lane, pend); }
        if (!has_next) break;
#pragma unroll
        for (int a = 0; a < 2; ++a)
#pragma unroll
            for (int b = 0; b < 2; ++b)
#pragma unroll
                for (int m = 0; m < 4; ++m)
#pragma unroll
                    for (int n = 0; n < 2; ++n) acc[a][b][m][n] = (f32x4){0.f, 0.f, 0.f, 0.f};
        cur = nxt; cA = nA; cB = nB; ++ui;
    }
    PG8_WAIT_V(0);
    if (wr == 0) PG8_BAR;
    PG8_BAR;
    if constexpr (Epi::FUSED_LAST) { if (deferred) E.fused(acc, cur, wr, wc, fr, fq, lds, wid, lane); }
#undef PG8_SA
#undef PG8_SB
#undef PG8_STAGE
#undef PG8_LDA
#undef PG8_LDB
#undef PG8_MMA
#undef PG8_WAIT_V
#undef PG8_WAIT_L
#undef PG8_BAR
#undef PG8_SCHED
}
}

struct EpiP {
    static constexpr bool PERM = true, FUSED_LAST = false;
    bf16_t* P; bool tail; bf16_t* U2;
    __device__ __forceinline__ void operator()(const f32x4 (&acc)[2][2][4][2], const pg8::Unit& u, int wr, int wc, int fr, int fq) const {
        const int row0 = u.pm * 256 + wr * 64 + fr, col0 = u.pn * 256 + wc * 32 + 8 * fq;
        const bool wt = tail && (u.pm == 32 || u.pn < 4);
        const __amdgpu_buffer_rsrc_t rsrc = __builtin_amdgcn_make_buffer_rsrc(P, 0, (int)((size_t)MT * LDP * 2), 0x00020000);
        const __amdgpu_buffer_rsrc_t rsrc2 = __builtin_amdgcn_make_buffer_rsrc(U2, 0, (int)((size_t)MV * 1024 * 2), 0x00020000);
        const int act = ((u.pn >= 4 && u.pn < 8) || (u.pn >= 20 && u.pn < 24)) ? 1 : ((u.pn >= 24 && u.pn < 40) ? 2 : 0);
#pragma unroll
        for (int ai = 0; ai < 2; ++ai)
#pragma unroll
            for (int m = 0; m < 4; ++m) { bf16_t* rowp = P + (size_t)(row0 + ai * 128 + m * 16) * LDP + col0;
#pragma unroll
                for (int bj = 0; bj < 2; ++bj) { f32x4 v0 = acc[ai][bj][m][0], v1 = acc[ai][bj][m][1];
                    if (act == 1) {
#pragma unroll
                        for (int j = 0; j < 4; ++j) { v0[j] = siluf_(v0[j]); v1[j] = siluf_(v1[j]); } }
                    else if (act == 2) {
#pragma unroll
                        for (int j = 0; j < 4; ++j) { v0[j] = sigmoidf_(v0[j]); v1[j] = sigmoidf_(v1[j]); } }
                    u32x4 w; w.x = cvt_pk_bf16(v0[0], v0[1]); w.y = cvt_pk_bf16(v0[2], v0[3]); w.z = cvt_pk_bf16(v1[0], v1[1]); w.w = cvt_pk_bf16(v1[2], v1[3]);
                    if (u.pn < 4) {
                        const int row = row0 + ai * 128 + m * 16, col = col0 + bj * 128, g2 = col >> 4, hf = (col >> 3) & 1;
                        size_t eo; if (row < MP) eo = (((size_t)(row >> 11) * 64 + g2) * SEQ + (row & (SEQ - 1))) * 16 + hf * 8; else eo = (size_t)MP * 1024 + ((size_t)g2 * NSMP + ((row - MP) & (NSMP - 1))) * 16 + hf * 8;
                        if (row < MV) { if (wt) __builtin_amdgcn_raw_buffer_store_b128(w, rsrc2, (unsigned)(eo * 2), 0, 16); else *(u32x4*)(U2 + eo) = w; } }
                    else if (wt) __builtin_amdgcn_raw_buffer_store_b128(w, rsrc, (unsigned)((size_t)(row0 + ai * 128 + m * 16) * LDP + col0 + bj * 128) * 2u, 0, 16);
                    else *(u32x4*)(rowp + bj * 128) = w; } }
    }
};
struct EpiGlu {
    static constexpr bool PERM = true, FUSED_LAST = false;
    const bf16_t* Yg; const bf16_t* P; const float* bglu; bf16_t* A2;
    __device__ __forceinline__ void operator()(const f32x4 (&acc)[2][2][4][2], const pg8::Unit& u, int wr, int wc, int fr, int fq) const {
        const int row0 = u.pm * 256 + wr * 64 + fr, col0 = u.pn * 256 + wc * 32 + 8 * fq;
        f32x4 bv[2][2];
#pragma unroll
        for (int bj = 0; bj < 2; ++bj)
#pragma unroll
            for (int n = 0; n < 2; ++n) bv[bj][n] = *(const f32x4*)(bglu + col0 + bj * 128 + 4 * n);
#pragma unroll
        for (int ai = 0; ai < 2; ++ai)
#pragma unroll
            for (int m = 0; m < 4; ++m) { const size_t row = (size_t)(row0 + ai * 128 + m * 16);
#pragma unroll
                for (int bj = 0; bj < 2; ++bj) { const int c = col0 + bj * 128;
                    const u32x4 yg = *(const u32x4*)(Yg + row * 1024 + c), sz = *(const u32x4*)(P + row * LDP + PC_ZS + c);
                    const f32x4 a0 = acc[ai][bj][m][0] + bv[bj][0], a1 = acc[ai][bj][m][1] + bv[bj][1];
                    float o[8];
                    o[0] = bf_lo(yg.x) * sigmoidf_(a0[0]) * bf_lo(sz.x); o[1] = bf_hi(yg.x) * sigmoidf_(a0[1]) * bf_hi(sz.x);
                    o[2] = bf_lo(yg.y) * sigmoidf_(a0[2]) * bf_lo(sz.y); o[3] = bf_hi(yg.y) * sigmoidf_(a0[3]) * bf_hi(sz.y);
                    o[4] = bf_lo(yg.z) * sigmoidf_(a1[0]) * bf_lo(sz.z); o[5] = bf_hi(yg.z) * sigmoidf_(a1[1]) * bf_hi(sz.z);
                    o[6] = bf_lo(yg.w) * sigmoidf_(a1[2]) * bf_lo(sz.w); o[7] = bf_hi(yg.w) * sigmoidf_(a1[3]) * bf_hi(sz.w);
                    u32x4 w; w.x = cvt_pk_bf16(o[0], o[1]); w.y = cvt_pk_bf16(o[2], o[3]); w.z = cvt_pk_bf16(o[4], o[5]); w.w = cvt_pk_bf16(o[6], o[7]);
                    *(u32x4*)(A2 + row * 2048 + c) = w; } }
    }
};
struct EpiOut {
    static constexpr bool PERM = false, FUSED_LAST = true;
    const bf16_t* P; const float* xp; const float* mod; float* out; float* xbuf; bf16_t* tmp; float* slab; unsigned* cnt; const float* fg;
    __device__ __forceinline__ void operator()(const f32x4 (&acc)[2][2][4][2], const pg8::Unit& u, int wr, int wc, int fr, int fq) const {
        const int row0 = u.pm * 256 + wr * 64 + fr, col0 = u.pn * 256 + wc * 32 + 4 * fq;
        if (u.mode == 0) {
#pragma unroll
            for (int ai = 0; ai < 2; ++ai)
#pragma unroll
                for (int m = 0; m < 4; ++m) { const size_t row = (size_t)(row0 + ai * 128 + m * 16); const bf16_t* prow = P + row * LDP + PC_GS + col0; bf16_t* trow = tmp + row * DM + col0;
#pragma unroll
                    for (int bj = 0; bj < 2; ++bj)
#pragma unroll
                        for (int n = 0; n < 2; ++n) { const int o = bj * 128 + n * 16; const u32x2 gg = *(const u32x2*)(prow + o); const f32x4 a = acc[ai][bj][m][n];
                            *(u32x2*)(trow + o) = pack4(bf_lo(gg.x) * a[0], bf_hi(gg.x) * a[1], bf_lo(gg.y) * a[2], bf_hi(gg.y) * a[3]); } }
        } else {
            const int gc = (u.koff < 1024) ? PC_GS : PC_GR; float* sl = slab + (size_t)(u.koff >> 8) * NSMP * DM;
#pragma unroll
            for (int m = 0; m < 4; ++m) { const size_t row = (size_t)(row0 + m * 16); const bf16_t* prow = P + row * LDP + gc + col0; float* srow = sl + (row - MP) * DM + col0;
#pragma unroll
                for (int bj = 0; bj < 2; ++bj)
#pragma unroll
                    for (int n = 0; n < 2; ++n) { const int o = bj * 128 + n * 16; const u32x2 gg = *(const u32x2*)(prow + o); const f32x4 a = acc[0][bj][m][n];
                        *(f32x4*)(srow + o) = (f32x4){bf_lo(gg.x) * a[0], bf_hi(gg.x) * a[1], bf_lo(gg.y) * a[2], bf_hi(gg.y) * a[3]}; } }
        }
    }
    __device__ __forceinline__ void fused(f32x4 (&acc)[2][2][4][2], const pg8::Unit& u, int wr, int wc, int fr, int fq, LAS unsigned char* lds, int wid, int lane) const {
        const int row0 = u.pm * 256 + wr * 64 + fr, col0 = u.pn * 256 + wc * 32 + 4 * fq;
        LAS float* PT = (LAS float*)lds; LAS float* ST = (LAS float*)(lds + 4096);
        f32x4 gt[2][2];
        { const float* gtrow = mod + (size_t)(u.pm >> 3) * NMOD + 2 * DM + col0;
#pragma unroll
          for (int bj = 0; bj < 2; ++bj)
#pragma unroll
              for (int n = 0; n < 2; ++n) gt[bj][n] = *(const f32x4*)(gtrow + bj * 128 + n * 16); }
#pragma unroll
        for (int ai = 0; ai < 2; ++ai)
#pragma unroll
            for (int m = 0; m < 4; ++m) { const size_t row = (size_t)(row0 + ai * 128 + m * 16);
                const bf16_t* prow = P + row * LDP + PC_GR + col0; const bf16_t* trow = tmp + row * DM + col0; const float* xrow = xp + row * DM + col0;
                u32x2 gg[4], tv[4]; f32x4 xv[4];
#pragma unroll
                for (int q = 0; q < 4; ++q) { const int o = (q >> 1) * 128 + (q & 1) * 16; gg[q] = *(const u32x2*)(prow + o); tv[q] = *(const u32x2*)(trow + o); xv[q] = *(const f32x4*)(xrow + o); }
                float ss = 0.f;
#pragma unroll
                for (int q = 0; q < 4; ++q) { const f32x4 a = acc[ai][q >> 1][m][q & 1]; const f32x4 g4 = gt[q >> 1][q & 1];
                    f32x4 r; r[0] = xv[q][0] + g4[0] * (bf_lo(tv[q].x) + bf_lo(gg[q].x) * a[0]); r[1] = xv[q][1] + g4[1] * (bf_hi(tv[q].x) + bf_hi(gg[q].x) * a[1]);
                    r[2] = xv[q][2] + g4[2] * (bf_lo(tv[q].y) + bf_lo(gg[q].y) * a[2]); r[3] = xv[q][3] + g4[3] * (bf_hi(tv[q].y) + bf_hi(gg[q].y) * a[3]);
                    ss += (r[0] * r[0] + r[1] * r[1]) + (r[2] * r[2] + r[3] * r[3]);
                    acc[ai][q >> 1][m][q & 1] = r; }
                ss += __shfl_xor(ss, 16); ss += __shfl_xor(ss, 32);
                if (fq == 0) PT[(ai * 128 + wr * 64 + m * 16 + fr) * 4 + wc] = ss; }
        asm volatile("s_waitcnt lgkmcnt(0)" ::: "memory"); __builtin_amdgcn_s_barrier(); asm volatile("" ::: "memory");
        const int row = wid * 32 + (lane & 31);
        if (lane < 32) { const f32x4 p4 = *(const LAS f32x4*)(PT + row * 4);
            __hip_atomic_store(xbuf + ((size_t)(u.pm * 256 + row) * 8 + u.pn), (p4[0] + p4[1]) + (p4[2] + p4[3]), __ATOMIC_RELAXED, __HIP_MEMORY_SCOPE_AGENT); }
        asm volatile("s_waitcnt vmcnt(0)" ::: "memory");
        if (lane == 0) __hip_atomic_fetch_add(cnt + 64 * u.pm, 1u, __ATOMIC_RELAXED, __HIP_MEMORY_SCOPE_AGENT);
        if (wid == 0) {
            unsigned sp = 0;
            while ((unsigned)__builtin_amdgcn_readfirstlane(__hip_atomic_load(cnt + 64 * u.pm, __ATOMIC_RELAXED, __HIP_MEMORY_SCOPE_AGENT)) < 64u) { __builtin_amdgcn_s_sleep(2); if (++sp > (1u << 22)) break; }
            __builtin_amdgcn_fence(__ATOMIC_ACQUIRE, "agent");
        }
        asm volatile("s_waitcnt vmcnt(0) lgkmcnt(0)" ::: "memory"); __builtin_amdgcn_s_barrier(); asm volatile("" ::: "memory");
        if (lane < 32) { const float* sl = xbuf + (size_t)(u.pm * 256 + row) * 8; float s8 = 0.f;
#pragma unroll
            for (int t = 0; t < 8; ++t) s8 += __hip_atomic_load(sl + t, __ATOMIC_RELAXED, __HIP_MEMORY_SCOPE_AGENT);
            ST[row] = rsqrtf(s8 * (1.0f / DM) + RMS_EPS); }
        asm volatile("s_waitcnt lgkmcnt(0)" ::: "memory"); __builtin_amdgcn_s_barrier(); asm volatile("" ::: "memory");
        f32x4 fgv[2][2];
#pragma unroll
        for (int bj = 0; bj < 2; ++bj)
#pragma unroll
            for (int n = 0; n < 2; ++n) fgv[bj][n] = *(const f32x4*)(fg + col0 + bj * 128 + n * 16);
#pragma unroll
        for (int ai = 0; ai < 2; ++ai)
#pragma unroll
            for (int m = 0; m < 4; ++m) { const int rl = ai * 128 + wr * 64 + m * 16 + fr; const float rstd = ST[rl]; float* orow = out + (size_t)(u.pm * 256 + rl) * DM + col0;
#pragma unroll
                for (int bj = 0; bj < 2; ++bj)
#pragma unroll
                    for (int n = 0; n < 2; ++n) *(f32x4*)(orow + bj * 128 + n * 16) = acc[ai][bj][m][n] * rstd * fgv[bj][n]; }
    }
};

struct Args { const float* in[34]; float* out; unsigned char* ws; int ph_lo, ph_hi, li, pad; };
enum { I_XP = 0, I_XS, I_CP, I_CS, I_S5RE, I_S5IM, I_WKV, I_SHIFT, I_NORMG, I_WADA, I_BADA, I_WIN, I_MU, I_ARE, I_AIM, I_LOGSTEP, I_BRE, I_BIM, I_CRE, I_CIM, I_DSKIP,
       I_WGLU, I_BGLU, I_W0, I_W2, I_A0, I_A2, I_KK, I_KA, I_RK, I_GNW, I_GNB, I_WOUT, I_FINALG };

__device__ __forceinline__ void transpose_item(const float* W, int ldw, int K, int csrc, bf16_t* WT, int rdst, int k0, LAS float* scr, int lane, bool zero) {
    if (zero) {
#pragma unroll
        for (int j = 0; j < 4; ++j) { const int n = (lane >> 3) + 8 * j; *(u32x4*)(WT + (size_t)(rdst + n) * K + k0 + 8 * (lane & 7)) = (u32x4){0u, 0u, 0u, 0u}; }
        return;
    }
#pragma unroll 8
    for (int i = 0; i < 32; ++i) { const int kk = 2 * i + (lane >> 5); scr[kk * 33 + (lane & 31)] = W[(size_t)(k0 + kk) * ldw + csrc + (lane & 31)]; }
    LDS_WAIT(); asm volatile("" ::: "memory");
    const int c = lane & 7;
#pragma unroll
    for (int j = 0; j < 4; ++j) { const int n = (lane >> 3) + 8 * j; const LAS float* s = scr + (8 * c) * 33 + n;
        u32x4 o; o.x = cvt_pk_bf16(s[0 * 33], s[1 * 33]); o.y = cvt_pk_bf16(s[2 * 33], s[3 * 33]); o.z = cvt_pk_bf16(s[4 * 33], s[5 * 33]); o.w = cvt_pk_bf16(s[6 * 33], s[7 * 33]);
        *(u32x4*)(WT + (size_t)(rdst + n) * K + k0 + 8 * c) = o; }
    LDS_WAIT(); asm volatile("" ::: "memory");
}

__device__ __forceinline__ void wait_count(unsigned* cnt, unsigned need, int wave) {
    if (wave == 0) { unsigned sp = 0;
        while ((unsigned)__builtin_amdgcn_readfirstlane(__hip_atomic_load(cnt, __ATOMIC_RELAXED, __HIP_MEMORY_SCOPE_AGENT)) < need) { __builtin_amdgcn_s_sleep(4); if (++sp > (1u << 22)) break; }
        __builtin_amdgcn_fence(__ATOMIC_ACQUIRE, "agent");
        asm volatile("s_waitcnt vmcnt(0)" ::: "memory"); }
    __syncthreads();
}
__device__ __forceinline__ void p0_mod(const Args& a, LAS unsigned char* lds, int s, int wave, int lane) {
    const float* cp = a.in[I_CP]; const float* cs = a.in[I_CS]; const float* W = a.in[I_WADA]; const float* bias = a.in[I_BADA];
    float* mod = (float*)(a.ws + WS_MOD);
    const int n0 = 32 * s, k0 = 256 * wave, r31 = lane & 31, h = lane >> 5;
    f32x16 acc[5];
#pragma unroll
    for (int t = 0; t < 5; ++t)
#pragma unroll
        for (int r = 0; r < 16; ++r) acc[t][r] = 0.f;
    float bw[8]; f32x4 c0[5], c1[5];
#define MOD_LOAD(ks_) do { const int kb_ = k0 + 16 * (ks_) + 8 * h; \
        _Pragma("unroll") for (int j = 0; j < 8; ++j) bw[j] = W[(size_t)(kb_ + j) * NMOD + n0 + r31]; \
        _Pragma("unroll") for (int t = 0; t < 5; ++t) { const int R = 32 * t + r31; c0[t] = (f32x4){0.f, 0.f, 0.f, 0.f}; c1[t] = c0[t]; \
            if (R < NMODROWS) { const float* src = (R < NB) ? cp + (size_t)R * DM + kb_ : cs + (size_t)(R - NB) * DM + kb_; c0[t] = *(const f32x4*)src; c1[t] = *(const f32x4*)(src + 4); } } } while (0)
    MOD_LOAD(0);
#pragma unroll 1
    for (int ks = 0; ks < 16; ++ks) {
        bf16x8 bfr; { u32x4 t; t.x = cvt_pk_bf16(bw[0], bw[1]); t.y = cvt_pk_bf16(bw[2], bw[3]); t.z = cvt_pk_bf16(bw[4], bw[5]); t.w = cvt_pk_bf16(bw[6], bw[7]); bfr = __builtin_bit_cast(bf16x8, t); }
        bf16x8 afr[5];
#pragma unroll
        for (int t = 0; t < 5; ++t) { u32x4 w; w.x = cvt_pk_bf16(siluf_(c0[t][0]), siluf_(c0[t][1])); w.y = cvt_pk_bf16(siluf_(c0[t][2]), siluf_(c0[t][3])); w.z = cvt_pk_bf16(siluf_(c1[t][0]), siluf_(c1[t][1])); w.w = cvt_pk_bf16(siluf_(c1[t][2]), siluf_(c1[t][3])); afr[t] = __builtin_bit_cast(bf16x8, w); }
        if (ks + 1 < 16) MOD_LOAD(ks + 1);
#pragma unroll
        for (int t = 0; t < 5; ++t) acc[t] = __builtin_amdgcn_mfma_f32_32x32x16_bf16(afr[t], bfr, acc[t], 0, 0, 0);
    }
#undef MOD_LOAD
    LAS float* red = (LAS float*)lds;
#pragma unroll
    for (int step = 4; step >= 1; step >>= 1) {
        if (wave >= step && wave < 2 * step) {
#pragma unroll
            for (int t = 0; t < 5; ++t)
#pragma unroll
                for (int r = 0; r < 16; ++r) red[(((wave - step) * 5 + t) * 16 + r) * 64 + lane] = acc[t][r];
        }
        __syncthreads();
        if (wave < step) {
#pragma unroll
            for (int t = 0; t < 5; ++t)
#pragma unroll
                for (int r = 0; r < 16; ++r) acc[t][r] += red[((wave * 5 + t) * 16 + r) * 64 + lane];
        }
        __syncthreads();
    }
    if (wave == 0) {
        const float bc = bias[n0 + r31];
#pragma unroll
        for (int t = 0; t < 5; ++t)
#pragma unroll
            for (int r = 0; r < 16; ++r) { const int R = 32 * t + (r & 3) + 8 * (r >> 2) + 4 * h; if (R < NMODROWS) mod[(size_t)R * NMOD + n0 + r31] = acc[t][r] + bc; }
    }
}

__device__ __forceinline__ void p0_s5_tables(const Args& a, LAS unsigned char* lds, int g, int tid) {
    LAS float* pw = (LAS float*)lds;
    LAS float* bbL = pw + 17 * 128;
    LAS float* ccL = bbL + 2048;
    LAS float* KF = ccL + 2048;
    LAS float* DL = KF + 4096;
    unsigned char* tab = (unsigned char*)a.out + DO_S5TAB + (size_t)g * S5T_BYTES;
    {
        const int p = tid & 63;
        const float step = expf(a.in[I_LOGSTEP][g]);
        const float lre = fminf(a.in[I_ARE][g * 64 + p], -1e-4f), lim = a.in[I_AIM][g * 64 + p];
        const float mag = expf(lre * step); float sn, cs; sincosf(lim * step, &sn, &cs);
        const float abr = mag * cs, abi = mag * sn, den = lre * lre + lim * lim;
        const float fr = ((abr - 1.0f) * lre + abi * lim) / den, fi = (abi * lre - (abr - 1.0f) * lim) / den;
        if (tid < 64) { float pr = 1.f, pi = 0.f;
            for (int e = 0; e <= 16; ++e) { pw[(e * 64 + p) * 2] = pr; pw[(e * 64 + p) * 2 + 1] = pi; const float nr = pr * abr - pi * abi, ni = pr * abi + pi * abr; pr = nr; pi = ni; } }
#pragma unroll
        for (int i = 0; i < 2; ++i) { const int c = (tid >> 6) + 8 * i; const float br = a.in[I_BRE][(g * 64 + p) * 16 + c], bi = a.in[I_BIM][(g * 64 + p) * 16 + c];
            bbL[(p * 16 + c) * 2] = fr * br - fi * bi; bbL[(p * 16 + c) * 2 + 1] = fr * bi + fi * br;
            ccL[(c * 64 + p) * 2] = a.in[I_CRE][(g * 16 + c) * 64 + p]; ccL[(c * 64 + p) * 2 + 1] = a.in[I_CIM][(g * 16 + c) * 64 + p]; }
        if (tid < 16) DL[tid] = a.in[I_DSKIP][g * 16 + tid];
    }
    __syncthreads();
    for (int idx = tid; idx < 4096; idx += 512) { const int e = idx >> 8, c = (idx >> 4) & 15, c2 = idx & 15; float s = 0.f;
        for (int p = 0; p < 64; ++p) { const float cr = ccL[(c * 64 + p) * 2], ci = ccL[(c * 64 + p) * 2 + 1], pr = pw[(e * 64 + p) * 2], pi = pw[(e * 64 + p) * 2 + 1];
            const float ar = cr * pr - ci * pi, ai = cr * pi + ci * pr; s += ar * bbL[(p * 16 + c2) * 2] - ai * bbL[(p * 16 + c2) * 2 + 1]; }
        if (e == 0 && c == c2) s += DL[c];
        KF[idx] = s; }
    __syncthreads();
    for (int it = tid; it < 4096; it += 512) { const int l = it & 63, s = (it >> 6) & 15, mtile = it >> 10; const int m = 32 * mtile + (l & 31), h = l >> 5, p = m & 63, im = m >> 6;
        const float pr = pw[((15 - s) * 64 + p) * 2], pi = pw[((15 - s) * 64 + p) * 2 + 1]; float v[8];
#pragma unroll
        for (int j = 0; j < 8; ++j) { const float br = bbL[(p * 16 + 8 * h + j) * 2], bi = bbL[(p * 16 + 8 * h + j) * 2 + 1]; v[j] = im ? (pr * bi + pi * br) : (pr * br - pi * bi); }
        u32x4 w; w.x = cvt_pk_bf16(v[0], v[1]); w.y = cvt_pk_bf16(v[2], v[3]); w.z = cvt_pk_bf16(v[4], v[5]); w.w = cvt_pk_bf16(v[6], v[7]);
        *(u32x4*)(tab + S5T_ME + (size_t)it * 16) = w; }
    for (int it = tid; it < 1024; it += 512) { const int l = it & 63, ti = it >> 6; const int rho = l & 31, dt = rho >> 4, c = rho & 15, h = l >> 5, e = ti - 1 + dt; float v[8];
#pragma unroll
        for (int j = 0; j < 8; ++j) v[j] = (e < 0) ? 0.f : KF[(e * 16 + c) * 16 + 8 * h + j];
        u32x4 w; w.x = cvt_pk_bf16(v[0], v[1]); w.y = cvt_pk_bf16(v[2], v[3]); w.z = cvt_pk_bf16(v[4], v[5]); w.w = cvt_pk_bf16(v[6], v[7]);
        *(u32x4*)(tab + S5T_KT + (size_t)it * 16) = w; }
    for (int it = tid; it < 4096; it += 512) { const int l = it & 63, ks = (it >> 6) & 7, mt = it >> 9; const int rho = l & 31, dt = rho >> 4, c = rho & 15, h = l >> 5, t = 2 * mt + dt; float v[8];
#pragma unroll
        for (int j = 0; j < 8; ++j) { const int m = 16 * ks + 8 * h + j, p = m & 63; const float cr = ccL[(c * 64 + p) * 2], ci = ccL[(c * 64 + p) * 2 + 1], pr = pw[((t + 1) * 64 + p) * 2], pi = pw[((t + 1) * 64 + p) * 2 + 1];
            v[j] = (m < 64) ? (cr * pr - ci * pi) : -(cr * pi + ci * pr); }
        u32x4 w; w.x = cvt_pk_bf16(v[0], v[1]); w.y = cvt_pk_bf16(v[2], v[3]); w.z = cvt_pk_bf16(v[4], v[5]); w.w = cvt_pk_bf16(v[6], v[7]);
        *(u32x4*)(tab + S5T_CA + (size_t)it * 16) = w; }
    { const int it = tid; const int l = it & 63, sp = (it >> 6) & 1, mtile = it >> 7; const int rho = l & 31, h = l >> 5; float v[8];
#pragma unroll
        for (int j = 0; j < 8; ++j) { const int m = 32 * mtile + 16 * sp + 8 * (j >> 2) + 4 * h + (j & 3), p = m & 63; v[j] = (rho < 16) ? ((m < 64) ? ccL[(rho * 64 + p) * 2] : -ccL[(rho * 64 + p) * 2 + 1]) : 0.f; }
        u32x4 w; w.x = cvt_pk_bf16(v[0], v[1]); w.y = cvt_pk_bf16(v[2], v[3]); w.z = cvt_pk_bf16(v[4], v[5]); w.w = cvt_pk_bf16(v[6], v[7]);
        *(u32x4*)(tab + S5T_C0 + (size_t)it * 16) = w; }
    if (tid < 64) { const int l = tid, rho = l & 31, h = l >> 5; float v[8];
#pragma unroll
        for (int j = 0; j < 8; ++j) v[j] = (rho < 16 && rho == 8 * h + j) ? DL[rho] : 0.f;
        u32x4 w; w.x = cvt_pk_bf16(v[0], v[1]); w.y = cvt_pk_bf16(v[2], v[3]); w.z = cvt_pk_bf16(v[4], v[5]); w.w = cvt_pk_bf16(v[6], v[7]);
        *(u32x4*)(tab + S5T_DF + (size_t)l * 16) = w;
        float* hdr = (float*)(tab + S5T_HDR);
        hdr[l] = pw[(16 * 64 + l) * 2]; hdr[64 + l] = pw[(16 * 64 + l) * 2 + 1]; hdr[128 + l] = pw[(64 + l) * 2]; hdr[192 + l] = pw[(64 + l) * 2 + 1]; }
    __syncthreads();
}

__device__ __forceinline__ void p1_row(const Args& a, int m, int lane) {
    bf16_t* XN = (bf16_t*)(a.ws + WS_XN) + (size_t)m * DM;
    if (m >= MV) {
        const float* src = a.in[I_SHIFT] + (size_t)(m - MV) * DM;
#pragma unroll
        for (int j = 0; j < 8; ++j) { const f32x4 v = *(const f32x4*)(src + 4 * lane + 256 * j); u32x2 w; w.x = cvt_pk_bf16(v[0], v[1]); w.y = cvt_pk_bf16(v[2], v[3]); *(u32x2*)(XN + 4 * lane + 256 * j) = w; }
        return;
    }
    const float* x = (m < MP) ? a.in[I_XP] + (size_t)m * DM : a.in[I_XS] + (size_t)(m - MP) * DM;
    const int mrow = (m < MP) ? (m >> 11) : (NB + m - MP);
    const float* mod = (const float*)(a.ws + WS_MOD) + (size_t)mrow * NMOD;
    const float* g = a.in[I_NORMG];
    f32x4 v[8]; float ss = 0.f;
#pragma unroll
    for (int j = 0; j < 8; ++j) { v[j] = *(const f32x4*)(x + 4 * lane + 256 * j); ss += (v[j][0] * v[j][0] + v[j][1] * v[j][1]) + (v[j][2] * v[j][2] + v[j][3] * v[j][3]); }
    const float rstd = rsqrtf(wave_sum(ss) * (1.0f / DM) + RMS_EPS);
    float* sh_out = nullptr;
    if (m >= MP) sh_out = a.out + OUT_SHIFT_S + (size_t)(m - MP) * DM;
    else if ((m & (SEQ - 1)) == SEQ - 1) sh_out = a.out + OUT_SHIFT_P + (size_t)(m >> 11) * DM;
#pragma unroll
    for (int j = 0; j < 8; ++j) { const int k = 4 * lane + 256 * j; const f32x4 gv = *(const f32x4*)(g + k), sh = *(const f32x4*)(mod + k), sc = *(const f32x4*)(mod + DM + k);
        f32x4 hv;
#pragma unroll
        for (int q = 0; q < 4; ++q) hv[q] = v[j][q] * rstd * gv[q] * (1.0f + sc[q]) + sh[q];
        u32x2 w; w.x = cvt_pk_bf16(hv[0], hv[1]); w.y = cvt_pk_bf16(hv[2], hv[3]); *(u32x2*)(XN + k) = w;
        if (sh_out) *(f32x4*)(sh_out + k) = hv; }
}

constexpr int RW_TB = 32;
constexpr int RW_KK = 0, RW_DR = 2048, RW_DD = 4096, RW_BB = 6144, RW_KP = 8192, RW_VV = 10240, RW_SC = 11264, RW_LW = 11392, RW_LA = 13440, RW_OB = 15488, RW_BVB = 16512, RW_END = 17536;
__device__ __forceinline__ void lerp8(const bf16_t* cur, const bf16_t* prev, bool has_prev, const float* mu, float (&o)[8]) {
    const u32x4 c = *(const u32x4*)cur; u32x4 p = (u32x4){0u, 0u, 0u, 0u}; if (has_prev) p = *(const u32x4*)prev;
    const f32x4 m0 = *(const f32x4*)mu, m1 = *(const f32x4*)(mu + 4);
    const float cf[8] = {bf_lo(c.x), bf_hi(c.x), bf_lo(c.y), bf_hi(c.y), bf_lo(c.z), bf_hi(c.z), bf_lo(c.w), bf_hi(c.w)};
    const float pf[8] = {bf_lo(p.x), bf_hi(p.x), bf_lo(p.y), bf_hi(p.y), bf_lo(p.z), bf_hi(p.z), bf_lo(p.w), bf_hi(p.w)};
    const float mf[8] = {m0[0], m0[1], m0[2], m0[3], m1[0], m1[1], m1[2], m1[3]};
#pragma unroll
    for (int j = 0; j < 8; ++j) o[j] = cf[j] + (pf[j] - cf[j]) * mf[j];
}
struct RwTok { float kk, dr, dd, bb, kp, v, br, kr, bonus; };
__device__ __forceinline__ RwTok rw_token(const Args& a, int hj, float r, float k, float v, float lw, float la) {
    RwTok o;
    const float wpre = a.in[I_W0][hj] + lw;
    const float nz = -wpre;
    const float sp = fmaxf(nz, 0.f) + log1pf(__expf(-fabsf(nz)));
    const float w = -sp - 0.5f;
    o.dd = __expf(-__expf(w));
    const float av = sigmoidf_(a.in[I_A0][hj] + la);
    const float kkv = k * a.in[I_KK][hj];
    const float nrm = sqrtf(wave_sum(kkv * kkv));
    o.kk = kkv / fmaxf(nrm, 1e-12f);
    o.kp = k * (1.0f + (av - 1.0f) * a.in[I_KA][hj]);
    o.bb = o.kk * av;
    o.dr = o.dd * r;
    o.v = v;
    o.br = wave_sum(o.bb * r);
    o.kr = wave_sum(o.kp * r);
    o.bonus = wave_sum(r * o.kp * a.in[I_RK][hj]);
    return o;
}
__device__ __forceinline__ void p3_rwkv_prompt(const Args& a, LAS unsigned char* lds, int unit, int tid, int wave, int lane) {
    const int b = unit >> 5, h = (unit >> 1) & 15, half = unit & 1;
    LAS float* L = (LAS float*)lds;
    const bf16_t* P = (const bf16_t*)(a.ws + WS_P);
    bf16_t* ORAW = (bf16_t*)((unsigned char*)a.out + DO_ORAW); bf16_t* BV = (bf16_t*)((unsigned char*)a.out + DO_BV);
    const float* mu = a.in[I_MU];
    const int r31 = lane & 31, hh = lane >> 5;
    bf16x8 bfr[4];
    if (wave < 4) { const float* W2 = (wave >> 1) ? a.in[I_A2] : a.in[I_W2]; const int col = h * 64 + 32 * (wave & 1) + r31;
#pragma unroll
        for (int ks = 0; ks < 4; ++ks) { float w[8];
#pragma unroll
            for (int j = 0; j < 8; ++j) w[j] = W2[(size_t)(16 * ks + 8 * hh + j) * 1024 + col];
            u32x4 t; t.x = cvt_pk_bf16(w[0], w[1]); t.y = cvt_pk_bf16(w[2], w[3]); t.z = cvt_pk_bf16(w[4], w[5]); t.w = cvt_pk_bf16(w[6], w[7]); bfr[ks] = __builtin_bit_cast(bf16x8, t); } }
    const int srow = 4 * wave + (lane >> 4), cq = lane & 15;
    f32x4 S = (f32x4){0.f, 0.f, 0.f, 0.f};
    for (int t0 = 0; t0 < SEQ; t0 += RW_TB) {
        const size_t rowbase = (size_t)b * SEQ + t0;
        if (wave < 4) { const int mat = wave >> 1, nt2 = wave & 1; const size_t row = rowbase + r31; const bool hp = (t0 + r31) > 0;
            f32x16 acc;
#pragma unroll
            for (int r = 0; r < 16; ++r) acc[r] = 0.f;
#pragma unroll
            for (int ks = 0; ks < 4; ++ks) { const int col = PC_WD + mat * 64 + 16 * ks + 8 * hh; float x8[8];
                lerp8(P + row * LDP + col, P + (row - 1) * LDP + col, hp, mu + 3072 + mat * 64 + 16 * ks + 8 * hh, x8);
                if (mat == 0) {
#pragma unroll
                    for (int j = 0; j < 8; ++j) x8[j] = tanhf_(x8[j]); }
                u32x4 t; t.x = cvt_pk_bf16(x8[0], x8[1]); t.y = cvt_pk_bf16(x8[2], x8[3]); t.z = cvt_pk_bf16(x8[4], x8[5]); t.w = cvt_pk_bf16(x8[6], x8[7]);
                acc = __builtin_amdgcn_mfma_f32_32x32x16_bf16(__builtin_bit_cast(bf16x8, t), bfr[ks], acc, 0, 0, 0); }
            LAS float* dst = L + (mat ? RW_LA : RW_LW);
#pragma unroll
            for (int r = 0; r < 16; ++r) { const int tl = (r & 3) + 8 * (r >> 2) + 4 * hh; dst[tl * 64 + 32 * nt2 + r31] = acc[r]; } }
        __syncthreads();
#pragma unroll
        for (int q = 0; q < 4; ++q) { const int tl = wave * 4 + q; const size_t row = rowbase + tl; const bool hp = (t0 + tl) > 0; const int hj = h * 64 + lane;
            const bf16_t* pc = P + row * LDP; const bf16_t* pp = pc - LDP;
            float r = bf2f(pc[PC_R + hj]), k = bf2f(pc[PC_K + hj]), v = bf2f(pc[PC_V + hj]);
            const float pr = hp ? bf2f(pp[PC_R + hj]) : 0.f, pk = hp ? bf2f(pp[PC_K + hj]) : 0.f, pv = hp ? bf2f(pp[PC_V + hj]) : 0.f;
            r += (pr - r) * mu[hj]; k += (pk - k) * mu[1024 + hj]; v += (pv - v) * mu[2048 + hj];
            const RwTok o = rw_token(a, hj, r, k, v, L[RW_LW + tl * 64 + lane], L[RW_LA + tl * 64 + lane]);
            L[RW_KK + tl * 64 + lane] = o.kk; L[RW_DR + tl * 64 + lane] = o.dr; L[RW_DD + tl * 64 + lane] = o.dd; L[RW_BB + tl * 64 + lane] = o.bb; L[RW_KP + tl * 64 + lane] = o.kp;
            if ((lane >> 5) == half) L[RW_VV + tl * 32 + (lane & 31)] = o.v;
            if (lane == 0) { L[RW_SC + tl * 4] = o.br; L[RW_SC + tl * 4 + 1] = o.kr; L[RW_SC + tl * 4 + 2] = o.bonus; } }
        __syncthreads();
#pragma unroll 4
        for (int tl = 0; tl < RW_TB; ++tl) {
            const f32x4 kk4 = *(const LAS f32x4*)(L + RW_KK + tl * 64 + 4 * cq), dr4 = *(const LAS f32x4*)(L + RW_DR + tl * 64 + 4 * cq), d4 = *(const LAS f32x4*)(L + RW_DD + tl * 64 + 4 * cq),
                        b4 = *(const LAS f32x4*)(L + RW_BB + tl * 64 + 4 * cq), k4 = *(const LAS f32x4*)(L + RW_KP + tl * 64 + 4 * cq);
            const float v = L[RW_VV + tl * 32 + srow]; const f32x4 sc = *(const LAS f32x4*)(L + RW_SC + tl * 4);
            float p1 = (S[0] * kk4[0] + S[1] * kk4[1]) + (S[2] * kk4[2] + S[3] * kk4[3]);
            float p2 = (S[0] * dr4[0] + S[1] * dr4[1]) + (S[2] * dr4[2] + S[3] * dr4[3]);
            p1 = row16_sum(p1); p2 = row16_sum(p2);
            const float sa = -p1;
            const float o = p2 + sa * sc[0] + v * sc[1];
#pragma unroll
            for (int j = 0; j < 4; ++j) S[j] = S[j] * d4[j] + sa * b4[j] + v * k4[j];
            if (cq == 0) { L[RW_OB + tl * 32 + srow] = o; L[RW_BVB + tl * 32 + srow] = sc[2] * v; }
        }
        __syncthreads();
        { const int tl = tid >> 4, r2 = 2 * (tid & 15); const size_t off = (rowbase + tl) * 1024 + h * 64 + 32 * half + r2;
          *(unsigned*)(ORAW + off) = cvt_pk_bf16(L[RW_OB + tl * 32 + r2], L[RW_OB + tl * 32 + r2 + 1]);
          *(unsigned*)(BV + off) = cvt_pk_bf16(L[RW_BVB + tl * 32 + r2], L[RW_BVB + tl * 32 + r2 + 1]); }
    }
    *(f32x4*)(a.out + OUT_WKV_P + (((size_t)(b * 16 + h) * 64 + 32 * half + srow) * 64 + 4 * cq)) = S;
    __syncthreads();
}


constexpr int RC_LD = 72, RC_MAT = 64 * RC_LD * 2;
constexpr int RC_QK = 0 * RC_MAT, RC_RT = 1 * RC_MAT, RC_KT = 2 * RC_MAT, RC_BT = 3 * RC_MAT, RC_QKT = 4 * RC_MAT, RC_BHT = 5 * RC_MAT, RC_KHT = 6 * RC_MAT, RC_VT = 7 * RC_MAT,
              RC_AKK = 8 * RC_MAT, RC_ARK = 9 * RC_MAT, RC_ARB = 10 * RC_MAT, RC_TB = 11 * RC_MAT, RC_AKB = 12 * RC_MAT, RC_W1T = 12 * RC_MAT, RC_U1T = 13 * RC_MAT,
              RC_AVT = RC_QK, RC_TF = RC_KT, RC_LWA = RC_AKK, RC_SEG = 14 * RC_MAT;
static_assert(RC_SEG + 2048 <= RING_BYTES, "rwkv chunk lds");
constexpr int RS_ROWB = 656, RS_BASE = 0;
static_assert(RS_BASE + 65 * RS_ROWB <= RC_AKK, "staging must stay inside R0..R7");
#define MFMA32(a, b, c) __builtin_amdgcn_mfma_f32_32x32x16_bf16((a), (b), (c), 0, 0, 0)
#define MFMA16(a, b, c) __builtin_amdgcn_mfma_f32_16x16x32_bf16((a), (b), (c), 0, 0, 0)
__device__ __forceinline__ bf16x8 lds_frag(LAS unsigned char* lds, int mat, int row, int k0) { return *(const LAS bf16x8*)(lds + mat + (row * RC_LD + k0) * 2); }

__device__ __forceinline__ void p3_rwkv_chunks(const Args& a, LAS unsigned char* lds, int bh, int seg, int tid, int wave, int lane) {
    const int b = bh >> 4, h = bh & 15, r31_ = lane & 31, hh_ = lane >> 5, hj = h * 64 + lane;
    const bf16_t* P = (const bf16_t*)(a.ws + WS_P);
    bf16_t* BV = (bf16_t*)((unsigned char*)a.out + DO_BV);
    const float* mu = a.in[I_MU];
    LAS float* SEG = (LAS float*)(lds + RC_SEG);
    bf16x8 bfr[4];
    { const float* W2 = (wave >> 2) ? a.in[I_A2] : a.in[I_W2]; const int col = h * 64 + 32 * (wave & 1) + r31_;
#pragma unroll
      for (int ks = 0; ks < 4; ++ks) { float w[8];
#pragma unroll
          for (int j = 0; j < 8; ++j) w[j] = W2[(size_t)(16 * ks + 8 * hh_ + j) * 1024 + col];
          u32x4 t; t.x = cvt_pk_bf16(w[0], w[1]); t.y = cvt_pk_bf16(w[2], w[3]); t.z = cvt_pk_bf16(w[4], w[5]); t.w = cvt_pk_bf16(w[6], w[7]); bfr[ks] = __builtin_bit_cast(bf16x8, t); } }
    const float w0j = a.in[I_W0][hj], a0j = a.in[I_A0][hj], kkj = a.in[I_KK][hj], kaj = a.in[I_KA][hj], rkj = a.in[I_RK][hj];
    const float mur = mu[hj], muk = mu[1024 + hj], muv = mu[2048 + hj];
    unsigned goff[6], loff[6]; u32x4 pf[6];
#pragma unroll
    for (int i = 0; i < 6; ++i) { const int idx = tid + 512 * i, row = idx / 40, c = idx - row * 40;
        const int col = (c < 8) ? PC_R + h * 64 + 8 * c : ((c < 16) ? PC_K + h * 64 + 8 * (c - 8) : ((c < 24) ? PC_V + h * 64 + 8 * (c - 16) : PC_WD + 8 * (c - 24)));
        goff[i] = (unsigned)(row * LDP + col) * 2u; loff[i] = (unsigned)(RS_BASE + row * RS_ROWB + c * 16); }
#define RWC_PREFETCH(chunk_) do { const unsigned char* pb_ = (const unsigned char*)(P + ((size_t)b * SEQ + (size_t)(chunk_) * 64 - 1) * LDP); \
        _Pragma("unroll") for (int i = 0; i < 6; ++i) { const bool ok_ = (tid + 512 * i < 2600) && ((chunk_) > 0 || tid + 512 * i >= 40); \
            pf[i] = (u32x4){0u, 0u, 0u, 0u}; if (ok_) pf[i] = *(const u32x4*)(pb_ + goff[i]); } } while (0)
    RWC_PREFETCH(seg * 8);
#pragma unroll 1
    for (int ci = 0; ci < 8; ++ci) {
        const int chunk = seg * 8 + ci; const size_t rowbase = (size_t)b * SEQ + chunk * 64;
#pragma unroll
        for (int i = 0; i < 6; ++i) if (tid + 512 * i < 2600) *(LAS u32x4*)(lds + loff[i]) = pf[i];
        if (ci + 1 < 8) RWC_PREFETCH(chunk + 1);
        __syncthreads();
        int r31 = r31_, hh = hh_; asm volatile("" : "+v"(r31), "+v"(hh));
        unsigned char* rwi = a.ws + WS_RWI + (size_t)((bh * 32) + chunk) * RWI_BYTES;
        { const int mat = wave >> 2, mtile = (wave >> 1) & 1, nt2 = wave & 1; const int tl = 32 * mtile + r31;
          f32x16 acc;
#pragma unroll
          for (int r = 0; r < 16; ++r) acc[r] = 0.f;
#pragma unroll
          for (int ks = 0; ks < 4; ++ks) { float x8[8];
              { const u32x4 c = *(const LAS u32x4*)(lds + RS_BASE + (tl + 1) * RS_ROWB + (24 + mat * 8 + 2 * ks + hh) * 16), p = *(const LAS u32x4*)(lds + RS_BASE + tl * RS_ROWB + (24 + mat * 8 + 2 * ks + hh) * 16);
                const float cf[8] = {bf_lo(c.x), bf_hi(c.x), bf_lo(c.y), bf_hi(c.y), bf_lo(c.z), bf_hi(c.z), bf_lo(c.w), bf_hi(c.w)};
                const float pf8[8] = {bf_lo(p.x), bf_hi(p.x), bf_lo(p.y), bf_hi(p.y), bf_lo(p.z), bf_hi(p.z), bf_lo(p.w), bf_hi(p.w)};
                const float* mp = mu + 3072 + mat * 64 + 16 * ks + 8 * hh; const f32x4 m0 = *(const f32x4*)mp, m1 = *(const f32x4*)(mp + 4);
                const float mf[8] = {m0[0], m0[1], m0[2], m0[3], m1[0], m1[1], m1[2], m1[3]};
#pragma unroll
                for (int j = 0; j < 8; ++j) x8[j] = cf[j] + (pf8[j] - cf[j]) * mf[j]; }
              if (mat == 0) {
#pragma unroll
                  for (int j = 0; j < 8; ++j) x8[j] = tanhf_(x8[j]); }
              u32x4 t; t.x = cvt_pk_bf16(x8[0], x8[1]); t.y = cvt_pk_bf16(x8[2], x8[3]); t.z = cvt_pk_bf16(x8[4], x8[5]); t.w = cvt_pk_bf16(x8[6], x8[7]);
              acc = MFMA32(__builtin_bit_cast(bf16x8, t), bfr[ks], acc); }
          LAS float* dst = (LAS float*)(lds + RC_LWA) + mat * 64 * 68;
#pragma unroll
          for (int r = 0; r < 16; ++r) { const int t2 = 32 * mtile + (r & 3) + 8 * (r >> 2) + 4 * hh; dst[t2 * 68 + 32 * nt2 + r31] = acc[r]; } }
        __syncthreads();
        float r8[8], kp8[8], kk8[8], bb8[8], v8[8], ld8[8], cs8[8];
        { const LAS float* LW = (const LAS float*)(lds + RC_LWA); const LAS float* LA = LW + 64 * 68;
#pragma unroll
          for (int q = 0; q < 8; ++q) { const int tl = 8 * wave + q; const size_t row = rowbase + tl;
              const LAS bf16_t* pc = (const LAS bf16_t*)(lds + RS_BASE + (tl + 1) * RS_ROWB); const LAS bf16_t* pp = (const LAS bf16_t*)(lds + RS_BASE + tl * RS_ROWB);
              float r = bf2f(pc[lane]), k = bf2f(pc[64 + lane]), v = bf2f(pc[128 + lane]);
              const float pr = bf2f(pp[lane]), pk = bf2f(pp[64 + lane]), pv = bf2f(pp[128 + lane]);
              r += (pr - r) * mur; k += (pk - k) * muk; v += (pv - v) * muv;
              ld8[q] = -0.6065306597126334f * sigmoidf_(w0j + LW[tl * 68 + lane]);
              const float av = sigmoidf_(a0j + LA[tl * 68 + lane]);
              const float kkv = k * kkj; const float rn = fminf(__builtin_amdgcn_rsqf(wave_sum_dpp(kkv * kkv)), 1e12f);
              kk8[q] = kkv * rn; kp8[q] = k * (1.0f + (av - 1.0f) * kaj); bb8[q] = kk8[q] * av; r8[q] = r; v8[q] = v;
              const float bonus = wave_sum_dpp(r * kp8[q] * rkj);
              BV[row * 1024 + hj] = f2bf(bonus * v); }
          cs8[0] = ld8[0];
#pragma unroll
          for (int q = 1; q < 8; ++q) cs8[q] = cs8[q - 1] + ld8[q];
          SEG[wave * 64 + lane] = cs8[7]; }
        __syncthreads();
        { float off = 0.f, cL = 0.f;
#pragma unroll
          for (int w2 = 0; w2 < 8; ++w2) { const float sg = SEG[w2 * 64 + lane]; cL += sg; if (w2 < wave) off += sg; }
          if (wave == 0) *(float*)(rwi + RWI_LAM + lane * 4) = __expf(cL);
          float qkT[8], bhT[8], khT[8];
          const float eLtot = __expf(cL); float ecprev = __expf(off);
#pragma unroll
          for (int q = 0; q < 8; ++q) { const int tl = 8 * wave + q; const float c = off + cs8[q];
              const float ec = __expf(c), ecp = ecprev, enc = rcpf_(ec), eL = eLtot * enc; ecprev = ec;
              const float qk = kk8[q] * ecp;
              ((LAS bf16_t*)(lds + RC_QK))[tl * RC_LD + lane] = f2bf(qk); ((LAS bf16_t*)(lds + RC_RT))[tl * RC_LD + lane] = f2bf(r8[q] * ec);
              ((LAS bf16_t*)(lds + RC_KT))[tl * RC_LD + lane] = f2bf(kp8[q] * enc); ((LAS bf16_t*)(lds + RC_BT))[tl * RC_LD + lane] = f2bf(bb8[q] * enc);
              qkT[q] = qk; bhT[q] = bb8[q] * eL; khT[q] = kp8[q] * eL; }
          u32x4 t;
          t.x = cvt_pk_bf16(qkT[0], qkT[1]); t.y = cvt_pk_bf16(qkT[2], qkT[3]); t.z = cvt_pk_bf16(qkT[4], qkT[5]); t.w = cvt_pk_bf16(qkT[6], qkT[7]); *(LAS u32x4*)(lds + RC_QKT + (lane * RC_LD + 8 * wave) * 2) = t;
          t.x = cvt_pk_bf16(bhT[0], bhT[1]); t.y = cvt_pk_bf16(bhT[2], bhT[3]); t.z = cvt_pk_bf16(bhT[4], bhT[5]); t.w = cvt_pk_bf16(bhT[6], bhT[7]); *(LAS u32x4*)(lds + RC_BHT + (lane * RC_LD + 8 * wave) * 2) = t;
          t.x = cvt_pk_bf16(khT[0], khT[1]); t.y = cvt_pk_bf16(khT[2], khT[3]); t.z = cvt_pk_bf16(khT[4], khT[5]); t.w = cvt_pk_bf16(khT[6], khT[7]); *(LAS u32x4*)(lds + RC_KHT + (lane * RC_LD + 8 * wave) * 2) = t;
          t.x = cvt_pk_bf16(v8[0], v8[1]); t.y = cvt_pk_bf16(v8[2], v8[3]); t.z = cvt_pk_bf16(v8[4], v8[5]); t.w = cvt_pk_bf16(v8[6], v8[7]); *(LAS u32x4*)(lds + RC_VT + (lane * RC_LD + 8 * wave) * 2) = t; }
        __syncthreads();
#pragma unroll
        for (int jr = 0; jr < 2; ++jr) { const int job = wave + 8 * jr; if (job < 12) {
            const int mat = job / 3, tt = job % 3, ms = (tt == 2) ? 1 : 0, nt2 = (tt == 0) ? 0 : 1;
            const int X = (mat & 1) ? RC_BT : RC_KT, Y = (mat & 2) ? RC_RT : RC_QK;
            f32x16 acc;
#pragma unroll
            for (int r = 0; r < 16; ++r) acc[r] = 0.f;
#pragma unroll
            for (int ks = 0; ks < 4; ++ks) acc = MFMA32(lds_frag(lds, X, 32 * ms + r31, 16 * ks + 8 * hh), lds_frag(lds, Y, 32 * nt2 + r31, 16 * ks + 8 * hh), acc);
            const int t = 32 * nt2 + r31; const bool incl = (mat & 2) != 0;
#pragma unroll
            for (int g4 = 0; g4 < 4; ++g4) { const int s0 = 32 * ms + 8 * g4 + 4 * hh; float v[4];
#pragma unroll
                for (int e = 0; e < 4; ++e) { const int sx = s0 + e; v[e] = (incl ? (sx <= t) : (sx < t)) ? acc[4 * g4 + e] : 0.f; }
                if (mat == 1) *(LAS f32x4*)(lds + RC_AKB + (t * 72 + s0) * 4) = (f32x4){v[0], v[1], v[2], v[3]};
                else { const int dstm = (mat == 0) ? RC_AKK : ((mat == 2) ? RC_ARK : RC_ARB); *(LAS u32x2*)(lds + dstm + (t * RC_LD + s0) * 2) = pack4(v[0], v[1], v[2], v[3]); } } } }
        __syncthreads();
        LAS float* TF = (LAS float*)(lds + RC_TF); const LAS float* AKB = (const LAS float*)(lds + RC_AKB); LAS float* YS = SEG;
        if (wave == 0) {
            const int I = lane >> 4, jj = lane & 15; float x[16];
#pragma unroll
            for (int r = 0; r < 16; ++r) { float sacc = (r == jj) ? 1.f : 0.f;
#pragma unroll
                for (int q = 0; q < r; ++q) sacc -= AKB[(16 * I + r) * 72 + 16 * I + q] * x[q];
                x[r] = sacc; TF[(16 * I + r) * 72 + 16 * I + jj] = sacc; }
        } else if (wave < 4) {
            const int t2 = tid - 64;
            for (int e = t2; e < 512; e += 192) { const int blk = e >> 8, rr = (e >> 4) & 15, cc = e & 15; TF[(32 * blk + rr) * 72 + 32 * blk + 16 + cc] = 0.f; }
        } else {
            const int mt = (wave >> 1) & 1, nt2 = wave & 1; f32x16 acc;
#pragma unroll
            for (int r = 0; r < 16; ++r) acc[r] = 0.f;
#pragma unroll
            for (int ks = 0; ks < 4; ++ks) if (ks < 2 || mt == 1) acc = MFMA32(lds_frag(lds, RC_AKK, 32 * mt + r31, 16 * ks + 8 * hh), lds_frag(lds, RC_VT, 32 * nt2 + r31, 16 * ks + 8 * hh), acc);
#pragma unroll
            for (int g4 = 0; g4 < 4; ++g4) *(LAS u32x2*)(lds + RC_AVT + ((32 * nt2 + r31) * RC_LD + 32 * mt + 8 * g4 + 4 * hh) * 2) = pack4(acc[4 * g4], acc[4 * g4 + 1], acc[4 * g4 + 2], acc[4 * g4 + 3]);
        }
        __syncthreads();
        { const int pr = tid >> 8, i = (tid >> 4) & 15, jj = tid & 15, ba = 2 * pr, bb = 2 * pr + 1;
          float y = 0.f;
#pragma unroll
          for (int q = 0; q < 16; ++q) y += AKB[(16 * bb + i) * 72 + 16 * ba + q] * TF[(16 * ba + q) * 72 + 16 * ba + jj];
          YS[tid] = y; }
        __syncthreads();
        { const int pr = tid >> 8, i = (tid >> 4) & 15, jj = tid & 15, ba = 2 * pr, bb = 2 * pr + 1; float tv = 0.f;
#pragma unroll
          for (int q = 0; q < 16; ++q) tv -= TF[(16 * bb + i) * 72 + 16 * bb + q] * YS[pr * 256 + q * 16 + jj];
          TF[(16 * bb + i) * 72 + 16 * ba + jj] = tv; }
        __syncthreads();
        { const int i = tid >> 4, j0 = (tid & 15) * 2; float z0 = 0.f, z1 = 0.f;
#pragma unroll 8
          for (int q = 0; q < 32; ++q) { const float av = AKB[(32 + i) * 72 + q]; z0 += av * TF[q * 72 + j0]; z1 += av * TF[q * 72 + j0 + 1]; }
          __syncthreads();
          TF[i * 72 + 32 + j0] = z0; TF[i * 72 + 32 + j0 + 1] = z1; }
        __syncthreads();
        { const int i = tid >> 4, j0 = (tid & 15) * 2; float t0 = 0.f, t1 = 0.f;
#pragma unroll 8
          for (int q = 0; q < 32; ++q) { const float tb = TF[(32 + i) * 72 + 32 + q]; t0 -= tb * TF[q * 72 + 32 + j0]; t1 -= tb * TF[q * 72 + 32 + j0 + 1]; }
          TF[(32 + i) * 72 + j0] = t0; TF[(32 + i) * 72 + j0 + 1] = t1; }
        __syncthreads();
        { const int t = tid >> 3, c0 = (tid & 7) * 8; const f32x4 x0 = *(const LAS f32x4*)(TF + t * 72 + c0), x1 = *(const LAS f32x4*)(TF + t * 72 + c0 + 4);
          u32x4 w; w.x = cvt_pk_bf16(x0[0], x0[1]); w.y = cvt_pk_bf16(x0[2], x0[3]); w.z = cvt_pk_bf16(x1[0], x1[1]); w.w = cvt_pk_bf16(x1[2], x1[3]);
          *(LAS u32x4*)(lds + RC_TB + (t * RC_LD + c0) * 2) = w; }
        __syncthreads();
        { const int which = wave >> 2, mt = (wave >> 1) & 1, nt2 = wave & 1; const int Bm = which ? RC_AVT : RC_QKT, Dm = which ? RC_U1T : RC_W1T; f32x16 acc;
#pragma unroll
          for (int r = 0; r < 16; ++r) acc[r] = 0.f;
#pragma unroll
          for (int ks = 0; ks < 4; ++ks) if (ks < 2 || mt == 1) acc = MFMA32(lds_frag(lds, RC_TB, 32 * mt + r31, 16 * ks + 8 * hh), lds_frag(lds, Bm, 32 * nt2 + r31, 16 * ks + 8 * hh), acc);
#pragma unroll
          for (int g4 = 0; g4 < 4; ++g4) *(LAS u32x2*)(lds + Dm + ((32 * nt2 + r31) * RC_LD + 32 * mt + 8 * g4 + 4 * hh) * 2) = pack4(acc[4 * g4], acc[4 * g4 + 1], acc[4 * g4 + 2], acc[4 * g4 + 3]); }
        __syncthreads();
        { const int kind = wave >> 2, mt = (wave >> 1) & 1, nt2 = wave & 1; const int cidx = 32 * nt2 + r31;
          f32x16 acc;
#pragma unroll
          for (int r = 0; r < 16; ++r) acc[r] = 0.f;
          if (kind == 0) {
#pragma unroll
              for (int ks = 0; ks < 4; ++ks) acc = MFMA32(lds_frag(lds, RC_W1T, 32 * mt + r31, 16 * ks + 8 * hh), lds_frag(lds, RC_BHT, cidx, 16 * ks + 8 * hh), acc);
#pragma unroll
              for (int g4 = 0; g4 < 4; ++g4) { const int jo = 8 * g4 + 4 * hh, half = jo >> 4, q2 = (jo & 15) >> 2; const int blk = (cidx >> 4) * 2 + mt, lane2 = (cidx & 15) + 16 * q2;
                  *(u32x2*)(rwi + RWI_GF + (blk * 64 + lane2) * 16 + half * 8) = pack4(-acc[4 * g4], -acc[4 * g4 + 1], -acc[4 * g4 + 2], -acc[4 * g4 + 3]); }
          } else {
#pragma unroll
              for (int ks = 0; ks < 4; ++ks) if (ks < 2 || nt2 == 1) acc = MFMA32(lds_frag(lds, RC_W1T, 32 * mt + r31, 16 * ks + 8 * hh), lds_frag(lds, RC_ARB, cidx, 16 * ks + 8 * hh), acc);
#pragma unroll
              for (int g4 = 0; g4 < 4; ++g4) { const int jo = 8 * g4 + 4 * hh, half = jo >> 4, q2 = (jo & 15) >> 2; const int blk = (cidx >> 4) * 2 + mt, lane2 = (cidx & 15) + 16 * q2;
                  const u32x2 rt = *(const LAS u32x2*)(lds + RC_RT + (cidx * RC_LD + 32 * mt + jo) * 2);
                  *(u32x2*)(rwi + RWI_W2F + (blk * 64 + lane2) * 16 + half * 8) = pack4(bf_lo(rt.x) - acc[4 * g4], bf_hi(rt.x) - acc[4 * g4 + 1], bf_lo(rt.y) - acc[4 * g4 + 2], bf_hi(rt.y) - acc[4 * g4 + 3]); }
          }
          f32x16 ac1, ac2;
#pragma unroll
          for (int r = 0; r < 16; ++r) { ac1[r] = 0.f; ac2[r] = 0.f; }
          if (kind == 0) {
#pragma unroll
              for (int ks = 0; ks < 4; ++ks) { ac1 = MFMA32(lds_frag(lds, RC_KHT, 32 * mt + r31, 16 * ks + 8 * hh), lds_frag(lds, RC_VT, cidx, 16 * ks + 8 * hh), ac1);
                                               ac2 = MFMA32(lds_frag(lds, RC_BHT, 32 * mt + r31, 16 * ks + 8 * hh), lds_frag(lds, RC_U1T, cidx, 16 * ks + 8 * hh), ac2); }
#pragma unroll
              for (int g4 = 0; g4 < 4; ++g4) { const int ro = 32 * mt + 8 * g4 + 4 * hh, mt2 = ro >> 4, q2 = (ro & 15) >> 2, cb = cidx >> 4, lane2 = (cidx & 15) + 16 * q2;
                  *(f32x4*)(rwi + RWI_H1F + ((cb * 4 + mt2) * 64 + lane2) * 16) = (f32x4){ac1[4 * g4] - ac2[4 * g4], ac1[4 * g4 + 1] - ac2[4 * g4 + 1], ac1[4 * g4 + 2] - ac2[4 * g4 + 2], ac1[4 * g4 + 3] - ac2[4 * g4 + 3]}; }
          } else {
#pragma unroll
              for (int ks = 0; ks < 4; ++ks) if (ks < 2 || nt2 == 1) { ac1 = MFMA32(lds_frag(lds, RC_VT, 32 * mt + r31, 16 * ks + 8 * hh), lds_frag(lds, RC_ARK, cidx, 16 * ks + 8 * hh), ac1);
                                                                        ac2 = MFMA32(lds_frag(lds, RC_U1T, 32 * mt + r31, 16 * ks + 8 * hh), lds_frag(lds, RC_ARB, cidx, 16 * ks + 8 * hh), ac2); }
#pragma unroll
              for (int g4 = 0; g4 < 4; ++g4) { const int ro = 32 * mt + 8 * g4 + 4 * hh, cb = ro >> 4, q2 = (ro & 15) >> 2, nt3 = cidx >> 4, lane2 = (cidx & 15) + 16 * q2;
                  *(f32x4*)(rwi + RWI_O1F + ((cb * 4 + nt3) * 64 + lane2) * 16) = (f32x4){ac1[4 * g4] - ac2[4 * g4], ac1[4 * g4 + 1] - ac2[4 * g4 + 1], ac1[4 * g4 + 2] - ac2[4 * g4 + 2], ac1[4 * g4 + 3] - ac2[4 * g4 + 3]}; }
          } }
        __syncthreads();
    }
}

__device__ __forceinline__ void p3_rwkv_seq(const Args& a, int unit, int lane) {
    const int bh = unit >> 2, cb = unit & 3, b = bh >> 4, h = bh & 15, l15 = lane & 15, q = lane >> 4;
    bf16_t* ORAW = (bf16_t*)((unsigned char*)a.out + DO_ORAW);
    f32x4 hacc[4];
#pragma unroll
    for (int m = 0; m < 4; ++m) hacc[m] = (f32x4){0.f, 0.f, 0.f, 0.f};
    const unsigned char* base = a.ws + WS_RWI + (size_t)(bh * 32) * RWI_BYTES;
    bf16x8 gf[8]; f32x4 h1[4], lam[4];
#define RW2_LOADG(src) do { _Pragma("unroll") for (int k2 = 0; k2 < 8; ++k2) gf[k2] = *(const bf16x8*)((src) + RWI_GF + (k2 * 64 + lane) * 16); \
        _Pragma("unroll") for (int m = 0; m < 4; ++m) { h1[m] = *(const f32x4*)((src) + RWI_H1F + ((cb * 4 + m) * 64 + lane) * 16); lam[m] = *(const f32x4*)((src) + RWI_LAM + (16 * m + 4 * q) * 4); } } while (0)
    RW2_LOADG(base);
#pragma unroll 1
    for (int c = 0; c < 32; ++c) {
        const unsigned char* cur = base + (size_t)c * RWI_BYTES;
        bf16x8 w2f[8]; f32x4 o1[4];
#pragma unroll
        for (int k2 = 0; k2 < 8; ++k2) w2f[k2] = *(const bf16x8*)(cur + RWI_W2F + (k2 * 64 + lane) * 16);
#pragma unroll
        for (int n = 0; n < 4; ++n) o1[n] = *(const f32x4*)(cur + RWI_O1F + ((cb * 4 + n) * 64 + lane) * 16);
        bf16x8 hb[2];
#pragma unroll
        for (int ks = 0; ks < 2; ++ks) { u32x4 t; t.x = cvt_pk_bf16(hacc[2 * ks][0], hacc[2 * ks][1]); t.y = cvt_pk_bf16(hacc[2 * ks][2], hacc[2 * ks][3]);
            t.z = cvt_pk_bf16(hacc[2 * ks + 1][0], hacc[2 * ks + 1][1]); t.w = cvt_pk_bf16(hacc[2 * ks + 1][2], hacc[2 * ks + 1][3]); hb[ks] = __builtin_bit_cast(bf16x8, t); }
        f32x4 nacc[4];
#pragma unroll
        for (int m = 0; m < 4; ++m) { nacc[m] = h1[m] + lam[m] * hacc[m];
#pragma unroll
            for (int ks = 0; ks < 2; ++ks) nacc[m] = MFMA16(gf[m * 2 + ks], hb[ks], nacc[m]); }
        if (c + 1 < 32) RW2_LOADG(cur + RWI_BYTES);
#pragma unroll
        for (int n = 0; n < 4; ++n) { f32x4 oacc = o1[n];
#pragma unroll
            for (int ks = 0; ks < 2; ++ks) oacc = MFMA16(hb[ks], w2f[n * 2 + ks], oacc);
            *(u32x2*)(ORAW + ((size_t)b * SEQ + c * 64 + 16 * n + l15) * 1024 + h * 64 + 16 * cb + 4 * q) = pack4(oacc[0], oacc[1], oacc[2], oacc[3]); }
#pragma unroll
        for (int m = 0; m < 4; ++m) hacc[m] = nacc[m];
    }
#undef RW2_LOADG
#pragma unroll
    for (int m = 0; m < 4; ++m) *(f32x4*)(a.out + OUT_WKV_P + (((size_t)bh * 64 + 16 * cb + l15) * 64 + 16 * m + 4 * q)) = hacc[m];
}

__device__ __forceinline__ void p3_rwkv_sample(const Args& a, LAS unsigned char* lds, int bs, int h, int wave, int lane) {
    LAS float* Lw = (LAS float*)lds + wave * 768;
    const bf16_t* P = (const bf16_t*)(a.ws + WS_P);
    const bf16_t* pc = P + (size_t)(MP + bs) * LDP; const bf16_t* pp = P + (size_t)(MV + bs) * LDP;
    bf16_t* A2 = (bf16_t*)(a.ws + WS_XN);
    const float* mu = a.in[I_MU];
    const int hj = h * 64 + lane, rg = lane >> 4, cq = lane & 15;
    const size_t sbase = ((size_t)(bs * 16 + h) * 64) * 64;
    const float* S0 = a.in[I_WKV] + sbase; float* S1 = a.out + OUT_WKV_S + sbase;
    f32x4 S[16];
#pragma unroll
    for (int it = 0; it < 16; ++it) S[it] = *(const f32x4*)(S0 + (size_t)(4 * it + rg) * 64 + 4 * cq);
    { float wd = bf2f(pc[PC_WD + lane]), ad = bf2f(pc[PC_AD + lane]); wd += (bf2f(pp[PC_WD + lane]) - wd) * mu[3072 + lane]; ad += (bf2f(pp[PC_AD + lane]) - ad) * mu[3136 + lane];
      Lw[lane] = tanhf_(wd); Lw[64 + lane] = ad; }
    LDS_WAIT();
    float lw = 0.f, la = 0.f;
#pragma unroll 16
    for (int m = 0; m < 64; ++m) { lw += Lw[m] * a.in[I_W2][(size_t)m * 1024 + hj]; la += Lw[64 + m] * a.in[I_A2][(size_t)m * 1024 + hj]; }
    float r = bf2f(pc[PC_R + hj]), k = bf2f(pc[PC_K + hj]), v = bf2f(pc[PC_V + hj]);
    r += (bf2f(pp[PC_R + hj]) - r) * mu[hj]; k += (bf2f(pp[PC_K + hj]) - k) * mu[1024 + hj]; v += (bf2f(pp[PC_V + hj]) - v) * mu[2048 + hj];
    const RwTok o = rw_token(a, hj, r, k, v, lw, la);
    Lw[128 + lane] = o.kk; Lw[192 + lane] = o.dr; Lw[256 + lane] = o.dd; Lw[320 + lane] = o.bb; Lw[384 + lane] = o.kp; Lw[448 + lane] = o.v;
    LDS_WAIT();
    const f32x4 kk4 = *(const LAS f32x4*)(Lw + 128 + 4 * cq), dr4 = *(const LAS f32x4*)(Lw + 192 + 4 * cq), d4 = *(const LAS f32x4*)(Lw + 256 + 4 * cq), b4 = *(const LAS f32x4*)(Lw + 320 + 4 * cq), k4 = *(const LAS f32x4*)(Lw + 384 + 4 * cq);
#pragma unroll
    for (int it = 0; it < 16; ++it) { const int i = 4 * it + rg; const float vi = Lw[448 + i];
        float p1 = (S[it][0] * kk4[0] + S[it][1] * kk4[1]) + (S[it][2] * kk4[2] + S[it][3] * kk4[3]);
        float p2 = (S[it][0] * dr4[0] + S[it][1] * dr4[1]) + (S[it][2] * dr4[2] + S[it][3] * dr4[3]);
        p1 = row16_sum(p1); p2 = row16_sum(p2);
        const float sa = -p1, ov = p2 + sa * o.br + vi * o.kr;
        f32x4 Sn;
#pragma unroll
        for (int j = 0; j < 4; ++j) Sn[j] = S[it][j] * d4[j] + sa * b4[j] + vi * k4[j];
        *(f32x4*)(S1 + (size_t)i * 64 + 4 * cq) = Sn;
        if (cq == 0) Lw[512 + i] = ov; }
    LDS_WAIT();
    const float ov = Lw[512 + lane];
    const float mean = wave_sum_dpp(ov) * (1.0f / 64.0f); const float dv = ov - mean; const float var = wave_sum_dpp(dv * dv) * (1.0f / 64.0f);
    float on = dv * rsqrtf(var + GN_EPS) * a.in[I_GNW][hj] + a.in[I_GNB][hj] + o.bonus * o.v;
    on *= bf2f(pc[PC_ZR + hj]);
    A2[(size_t)(MP + bs) * 2048 + 1024 + hj] = f2bf(on);
    LDS_WAIT();
}

constexpr int S5_ELD = 132, S5_XLD = 136;
constexpr int S5_E_OFF = 0, S5_X_OFF = 128 * S5_ELD * 4;
__device__ __forceinline__ bf16x8 ldfrag(const unsigned char* base, int block, int lane) { return *(const bf16x8*)(base + (size_t)block * 1024 + lane * 16); }
__device__ __forceinline__ void p3_s5_prompt(const Args& a, LAS unsigned char* lds, int unit, int tid, int wave, int lane) {
    const int b = unit >> 6, g = unit & 63;
    const unsigned char* tab = (const unsigned char*)a.out + DO_S5TAB + (size_t)g * S5T_BYTES;
    const bf16_t* P = (const bf16_t*)(a.ws + WS_P);
    bf16_t* Yg = (bf16_t*)(a.ws + WS_YG);
    LAS float* EL = (LAS float*)(lds + S5_E_OFF); LAS bf16_t* XL = (LAS bf16_t*)(lds + S5_X_OFF);
    const int nt = wave & 3, hm = wave >> 2, r31 = lane & 31, hh = lane >> 5;
    const int n = 32 * nt + r31;
    { u32x4 tv[10];
#pragma unroll
      for (int i = 0; i < 10; ++i) tv[i] = *(const u32x4*)(tab + S5T_ME + (size_t)(tid + 512 * i) * 16);
#pragma unroll
      for (int i = 0; i < 10; ++i) *(LAS u32x4*)(lds + (tid + 512 * i) * 16) = tv[i]; }
    const bf16_t* ubase = (const bf16_t*)(a.ws + WS_U2) + (((size_t)b * 64 + g) * SEQ + 16 * n) * 16 + 8 * hh;
    bf16x8 bu[16];
#pragma unroll
    for (int s2 = 0; s2 < 16; ++s2) bu[s2] = *(const bf16x8*)(ubase + (size_t)s2 * 16);
    f32x16 accY[4], accE[2];
#pragma unroll
    for (int q = 0; q < 4; ++q)
#pragma unroll
        for (int r = 0; r < 16; ++r) accY[q][r] = 0.f;
#pragma unroll
    for (int q = 0; q < 2; ++q)
#pragma unroll
        for (int r = 0; r < 16; ++r) accE[q][r] = 0.f;
    const int mts[4] = {hm ? 1 : 0, hm ? 2 : 3, hm ? 5 : 4, hm ? 6 : 7};
    __syncthreads();
#pragma unroll
    for (int s2 = 0; s2 < 16; ++s2) {
#pragma unroll
        for (int e = 0; e < 2; ++e) accE[e] = __builtin_amdgcn_mfma_f32_32x32x16_bf16(*(const LAS bf16x8*)(lds + S5T_ME + (((2 * hm + e) * 16 + s2) * 64 + lane) * 16), bu[s2], accE[e], 0, 0, 0);
#pragma unroll
        for (int q = 0; q < 4; ++q) { const int mt = mts[q]; if (s2 <= 2 * mt + 1) accY[q] = __builtin_amdgcn_mfma_f32_32x32x16_bf16(*(const LAS bf16x8*)(lds + S5T_KT + ((2 * mt - s2 + 1) * 64 + lane) * 16), bu[s2], accY[q], 0, 0, 0); }
    }
    __syncthreads();
#pragma unroll
    for (int e = 0; e < 2; ++e)
#pragma unroll
        for (int q4 = 0; q4 < 4; ++q4) { f32x4 v; v[0] = accE[e][4 * q4]; v[1] = accE[e][4 * q4 + 1]; v[2] = accE[e][4 * q4 + 2]; v[3] = accE[e][4 * q4 + 3];
            *(LAS f32x4*)(EL + n * S5_ELD + 32 * (2 * hm + e) + 8 * q4 + 4 * hh) = v; }
    __syncthreads();
    if (wave == 0) { const float* hdr = (const float*)(tab + S5T_HDR); const float ar = hdr[lane], ai = hdr[64 + lane]; float xr = 0.f, xi = 0.f;
#pragma unroll 1
        for (int c0 = 0; c0 < 128; c0 += 16) { float er[16], ei[16];
#pragma unroll
            for (int j = 0; j < 16; ++j) { er[j] = EL[(c0 + j) * S5_ELD + lane]; ei[j] = EL[(c0 + j) * S5_ELD + 64 + lane]; }
#pragma unroll
            for (int j = 0; j < 16; ++j) { XL[(c0 + j) * S5_XLD + lane] = f2bf(xr); XL[(c0 + j) * S5_XLD + 64 + lane] = f2bf(xi);
                const float nr = ar * xr - ai * xi + er[j], ni = ar * xi + ai * xr + ei[j]; xr = nr; xi = ni; } }
        a.out[OUT_S5RE_P + (size_t)(b * 64 + g) * 64 + lane] = xr; a.out[OUT_S5IM_P + (size_t)(b * 64 + g) * 64 + lane] = xi; }
    __syncthreads();
#pragma unroll
    for (int ks = 0; ks < 8; ++ks) { const bf16x8 bx = *(const LAS bf16x8*)(XL + n * S5_XLD + 16 * ks + 8 * hh);
#pragma unroll
        for (int q = 0; q < 4; ++q) accY[q] = __builtin_amdgcn_mfma_f32_32x32x16_bf16(ldfrag(tab + S5T_CA, mts[q] * 8 + ks, lane), bx, accY[q], 0, 0, 0); }
#pragma unroll
    for (int q = 0; q < 4; ++q) { const int mt = mts[q];
#pragma unroll
        for (int q4 = 0; q4 < 4; ++q4) { const int dt = q4 >> 1, c0 = 8 * (q4 & 1) + 4 * hh; const size_t row = (size_t)b * SEQ + 16 * n + 2 * mt + dt;
            u32x2 w; w.x = cvt_pk_bf16(geluf_(accY[q][4 * q4]), geluf_(accY[q][4 * q4 + 1])); w.y = cvt_pk_bf16(geluf_(accY[q][4 * q4 + 2]), geluf_(accY[q][4 * q4 + 3]));
            *(u32x2*)(Yg + row * 1024 + g * 16 + c0) = w; } }
    __syncthreads();
}
__device__ __forceinline__ void p3_s5_sample(const Args& a, int g, int wave, int lane) {
    if (wave >= 4) return;
    const unsigned char* tab = (const unsigned char*)a.out + DO_S5TAB + (size_t)g * S5T_BYTES;
    const float* hdr = (const float*)(tab + S5T_HDR);
    const bf16_t* P = (const bf16_t*)(a.ws + WS_P);
    bf16_t* Yg = (bf16_t*)(a.ws + WS_YG);
    const int r31 = lane & 31, hh = lane >> 5, bs = 32 * wave + r31;
    const bf16x8 bu = *(const bf16x8*)((const bf16_t*)(a.ws + WS_U2S) + ((size_t)g * NSMP + bs) * 16 + 8 * hh);
    f32x16 z;
#pragma unroll
    for (int r = 0; r < 16; ++r) z[r] = 0.f;
    f32x16 x[4];
#pragma unroll
    for (int mtile = 0; mtile < 4; ++mtile) x[mtile] = __builtin_amdgcn_mfma_f32_32x32x16_bf16(ldfrag(tab + S5T_ME, mtile * 16 + 15, lane), bu, z, 0, 0, 0);
    const size_t sb = (size_t)(bs * 64 + g) * 64;
#pragma unroll
    for (int pt = 0; pt < 2; ++pt)
#pragma unroll
        for (int q4 = 0; q4 < 4; ++q4) { const int p0 = 32 * pt + 8 * q4 + 4 * hh;
            const f32x4 x0r = *(const f32x4*)(a.in[I_S5RE] + sb + p0), x0i = *(const f32x4*)(a.in[I_S5IM] + sb + p0);
            const f32x4 ar = *(const f32x4*)(hdr + 128 + p0), ai = *(const f32x4*)(hdr + 192 + p0);
            f32x4 nr, ni;
#pragma unroll
            for (int j = 0; j < 4; ++j) { nr[j] = ar[j] * x0r[j] - ai[j] * x0i[j] + x[pt][4 * q4 + j]; ni[j] = ar[j] * x0i[j] + ai[j] * x0r[j] + x[2 + pt][4 * q4 + j]; x[pt][4 * q4 + j] = nr[j]; x[2 + pt][4 * q4 + j] = ni[j]; }
            *(f32x4*)(a.out + OUT_S5RE_S + sb + p0) = nr; *(f32x4*)(a.out + OUT_S5IM_S + sb + p0) = ni; }
    f32x16 y = __builtin_amdgcn_mfma_f32_32x32x16_bf16(ldfrag(tab + S5T_DF, 0, lane), bu, z, 0, 0, 0);
#pragma unroll
    for (int mtile = 0; mtile < 4; ++mtile)
#pragma unroll
        for (int sp = 0; sp < 2; ++sp) { u32x4 t; t.x = cvt_pk_bf16(x[mtile][8 * sp], x[mtile][8 * sp + 1]); t.y = cvt_pk_bf16(x[mtile][8 * sp + 2], x[mtile][8 * sp + 3]);
            t.z = cvt_pk_bf16(x[mtile][8 * sp + 4], x[mtile][8 * sp + 5]); t.w = cvt_pk_bf16(x[mtile][8 * sp + 6], x[mtile][8 * sp + 7]);
            y = __builtin_amdgcn_mfma_f32_32x32x16_bf16(ldfrag(tab + S5T_C0, mtile * 2 + sp, lane), __builtin_bit_cast(bf16x8, t), y, 0, 0, 0); }
#pragma unroll
    for (int q4 = 0; q4 < 2; ++q4) { const int c0 = 8 * q4 + 4 * hh;
        u32x2 w; w.x = cvt_pk_bf16(geluf_(y[4 * q4]), geluf_(y[4 * q4 + 1])); w.y = cvt_pk_bf16(geluf_(y[4 * q4 + 2]), geluf_(y[4 * q4 + 3]));
        *(u32x2*)(Yg + (size_t)(MP + bs) * 1024 + g * 16 + c0) = w; }
}

__device__ __forceinline__ void p4_rwkv_post8(const Args& a, int item0, int lane) {
    const int item = item0 + (lane >> 3), cg = lane & 7, row = item >> 4, h = item & 15, ch = h * 64 + 8 * cg;
    const bf16_t* ORAW = (const bf16_t*)((const unsigned char*)a.out + DO_ORAW); const bf16_t* BV = (const bf16_t*)((const unsigned char*)a.out + DO_BV);
    const bf16_t* P = (const bf16_t*)(a.ws + WS_P); bf16_t* A2 = (bf16_t*)(a.ws + WS_XN);
    const u32x4 ow = *(const u32x4*)(ORAW + (size_t)row * 1024 + ch), bw = *(const u32x4*)(BV + (size_t)row * 1024 + ch), zw = *(const u32x4*)(P + (size_t)row * LDP + PC_ZR + ch);
    const f32x4 w0 = *(const f32x4*)(a.in[I_GNW] + ch), w1 = *(const f32x4*)(a.in[I_GNW] + ch + 4), b0 = *(const f32x4*)(a.in[I_GNB] + ch), b1 = *(const f32x4*)(a.in[I_GNB] + ch + 4);
    const float o[8] = {bf_lo(ow.x), bf_hi(ow.x), bf_lo(ow.y), bf_hi(ow.y), bf_lo(ow.z), bf_hi(ow.z), bf_lo(ow.w), bf_hi(ow.w)};
    const float bv[8] = {bf_lo(bw.x), bf_hi(bw.x), bf_lo(bw.y), bf_hi(bw.y), bf_lo(bw.z), bf_hi(bw.z), bf_lo(bw.w), bf_hi(bw.w)};
    const float z[8] = {bf_lo(zw.x), bf_hi(zw.x), bf_lo(zw.y), bf_hi(zw.y), bf_lo(zw.z), bf_hi(zw.z), bf_lo(zw.w), bf_hi(zw.w)};
    const float gw[8] = {w0[0], w0[1], w0[2], w0[3], w1[0], w1[1], w1[2], w1[3]}, gb[8] = {b0[0], b0[1], b0[2], b0[3], b1[0], b1[1], b1[2], b1[3]};
    float sm = ((o[0] + o[1]) + (o[2] + o[3])) + ((o[4] + o[5]) + (o[6] + o[7]));
    sm += dpp_f<0xB1>(sm); sm += dpp_f<0x4E>(sm); sm += dpp_f<0x141>(sm);
    const float mean = sm * (1.0f / 64.0f); float d[8], sq = 0.f;
#pragma unroll
    for (int j = 0; j < 8; ++j) { d[j] = o[j] - mean; sq += d[j] * d[j]; }
    sq += dpp_f<0xB1>(sq); sq += dpp_f<0x4E>(sq); sq += dpp_f<0x141>(sq);
    const float rstd = rsqrtf(sq * (1.0f / 64.0f) + GN_EPS); float r[8];
#pragma unroll
    for (int j = 0; j < 8; ++j) r[j] = (d[j] * rstd * gw[j] + gb[j] + bv[j]) * z[j];
    u32x4 w; w.x = cvt_pk_bf16(r[0], r[1]); w.y = cvt_pk_bf16(r[2], r[3]); w.z = cvt_pk_bf16(r[4], r[5]); w.w = cvt_pk_bf16(r[6], r[7]);
    *(u32x4*)(A2 + (size_t)row * 2048 + 1024 + ch) = w;
}

__device__ __forceinline__ void p6_row(const Args& a, int m, int lane) {
    float* y = a.out + (size_t)m * DM; const float* fg = a.in[I_FINALG];
    if (m < MP) {
        const float* rs = (const float*)(a.ws + WS_ROWSS) + (size_t)m * 32;
        const float ss = wave_sum(rs[lane & 31]) * 0.5f;
        const float rstd = rsqrtf(ss * (1.0f / DM) + RMS_EPS);
#pragma unroll
        for (int j = 0; j < 8; ++j) { const int k = 4 * lane + 256 * j; f32x4 v = *(const f32x4*)(y + k); const f32x4 gv = *(const f32x4*)(fg + k);
#pragma unroll
            for (int q = 0; q < 4; ++q) v[q] = v[q] * rstd * gv[q];
            *(f32x4*)(y + k) = v; }
    } else {
        const int r = m - MP; const float* slab = (const float*)(a.ws + WS_SLAB) + (size_t)r * DM; const float* x = a.in[I_XS] + (size_t)r * DM;
        const float* gtrow = (const float*)(a.ws + WS_MOD) + (size_t)(NB + r) * NMOD + 2 * DM;
        f32x4 v[8]; float ss = 0.f;
#pragma unroll
        for (int j = 0; j < 8; ++j) { const int k = 4 * lane + 256 * j; f32x4 mix = *(const f32x4*)(slab + k);
#pragma unroll
            for (int s2 = 1; s2 < 8; ++s2) mix += *(const f32x4*)(slab + (size_t)s2 * NSMP * DM + k);
            const f32x4 xv = *(const f32x4*)(x + k), gt = *(const f32x4*)(gtrow + k);
#pragma unroll
            for (int q = 0; q < 4; ++q) { v[j][q] = xv[q] + gt[q] * mix[q]; ss += v[j][q] * v[j][q]; } }
        const float rstd = rsqrtf(wave_sum(ss) * (1.0f / DM) + RMS_EPS);
#pragma unroll
        for (int j = 0; j < 8; ++j) { const int k = 4 * lane + 256 * j; const f32x4 gv = *(const f32x4*)(fg + k); f32x4 o;
#pragma unroll
            for (int q = 0; q < 4; ++q) o[q] = v[j][q] * rstd * gv[q];
            *(f32x4*)(y + k) = o; }
    }
}

__global__ void __launch_bounds__(512, 2) fwd_kernel(Args args) {
    extern __shared__ __attribute__((aligned(16))) unsigned char lds_raw[];
    LAS unsigned char* lds = (LAS unsigned char*)lds_raw;
    const int tid = threadIdx.x, lane = tid & 63, wave = __builtin_amdgcn_readfirstlane(tid >> 6);
    const int G = gridDim.x, bx = blockIdx.x;
    const int vcu = (G % 8 == 0) ? (bx % 8) * (G / 8) + bx / 8 : bx;
    volatile LAS unsigned* MISC = (volatile LAS unsigned*)(lds + MISC_OFF);
    for (int u = tid; u < (LDS_BYTES - LDSCTL_OFF) / 4; u += 512) ((LAS unsigned*)(lds + LDSCTL_OFF))[u] = 0u;
    __syncthreads();
    unsigned* ctl = (unsigned*)(args.ws + WS_CTL);
    XcdBarrier bar; bar.bar = ctl + CW_BAR + args.li * XCD_BAR_WORDS; bar.x = 0; bar.st = nullptr;
    const bool multi = (args.ph_hi - args.ph_lo) > 1;
    if (multi) bar = xcd_barrier_post(ctl + CW_BAR + args.li * XCD_BAR_WORDS, MISC + 8);
    const int lo = args.ph_lo, hi = args.ph_hi;
#define IN(k) (lo <= (k) && (k) < hi)
#define SEAM(k) do { if (IN(k) && IN((k) + 1)) xcd_barrier(bar); } while (0)
    const int gw = vcu * 8 + wave, NGW = G * 8;

    if (IN(0)) {
        if (vcu < 192) p0_mod(args, lds, vcu, wave, lane);
        else if (vcu - 192 < 64) p0_s5_tables(args, lds, vcu - 192, tid);
    }
    SEAM(0);
    if (IN(1)) {
        { LAS float* scr = (LAS float*)(lds + wave * 16384);
          bf16_t* WT = (bf16_t*)(args.ws + WS_WT);
          for (int it = gw; it < 328 * 32; it += NGW) { const int nb = it >> 5, kb = it & 31; const int p0 = 32 * nb;
              const int src = (p0 < 5120) ? p0 : ((p0 < 10240) ? p0 + 128 : p0 - 5120);
              transpose_item(args.in[I_WIN], NIN, 2048, src, WT, p0, 64 * kb, scr, lane, p0 >= NIN); } }
        for (int m = gw; m < MT; m += NGW) p1_row(args, m, lane);
    }
    SEAM(1);
    const bool tail_mode = (G == 256);
    if (IN(2)) {
        pg8::Gemm g{(const bf16_t*)(args.ws + WS_XN), (const bf16_t*)(args.ws + WS_WT), 2048, 2048};
        EpiP E{(bf16_t*)(args.ws + WS_P), tail_mode, (bf16_t*)(args.ws + WS_U2)};
        if (tail_mode) {
            pg8::TailOrder S; S.init2(G, bx, ctl + CW_TILE);
            pg8::gemm_phase<EpiP, pg8::TailOrder>(lds, g, S, E);
            if (bx >= 73) {
                const int t = bx - 73;
                for (int u = t; u < 256; u += 183) { wait_count(ctl + CW_TILE + 64 * ((u >> 6) * 4 + ((u & 63) >> 4)), 64u, wave); p3_s5_prompt(args, lds, u, tid, wave, lane); }
                if (t >= 73 && t < 137) { const int g2 = t - 73; wait_count(ctl + CW_TILE + 64 * (16 + (g2 >> 4)), 8u, wave); p3_s5_sample(args, g2, wave, lane); }
                __syncthreads();
                { LAS float* scr = (LAS float*)(lds + wave * 16384);
                  for (int it = t * 8 + wave; it < 2048 + 512; it += 183 * 8) {
                      if (it < 2048) { const int nb = it >> 5, kb = it & 31; transpose_item(args.in[I_WOUT], 2048, 2048, 32 * nb, (bf16_t*)(args.ws + WS_WOUT_T), 32 * nb, 64 * kb, scr, lane, false); }
                      else { const int i2 = it - 2048, nb = i2 >> 4, kb = i2 & 15; transpose_item(args.in[I_WGLU], 1024, 1024, 32 * nb, (bf16_t*)(args.ws + WS_WGLU_T), 32 * nb, 64 * kb, scr, lane, false); } } }
            }
        } else {
            pg8::StaticOrder S; S.init(MT, LDP, 2048, G, bx);
            pg8::gemm_phase<EpiP, pg8::StaticOrder>(lds, g, S, E);
        }
    }
    SEAM(2);
    if (IN(3)) {
        p3_rwkv_chunks(args, lds, vcu >> 2, vcu & 3, tid, wave, lane);
        if (!tail_mode) {
            { LAS float* scr = (LAS float*)(lds + wave * 16384);
              for (int it = gw; it < 2048 + 512; it += NGW) {
                  if (it < 2048) { const int nb = it >> 5, kb = it & 31; transpose_item(args.in[I_WOUT], 2048, 2048, 32 * nb, (bf16_t*)(args.ws + WS_WOUT_T), 32 * nb, 64 * kb, scr, lane, false); }
                  else { const int i2 = it - 2048, nb = i2 >> 4, kb = i2 & 15; transpose_item(args.in[I_WGLU], 1024, 1024, 32 * nb, (bf16_t*)(args.ws + WS_WGLU_T), 32 * nb, 64 * kb, scr, lane, false); } } }
            __syncthreads();
            for (int u = vcu; u < 256; u += G) p3_s5_prompt(args, lds, u, tid, wave, lane);
            for (int g2 = vcu; g2 < 64; g2 += G) p3_s5_sample(args, g2, wave, lane);
            __syncthreads();
        }
        for (int it = vcu; it < 256; it += G) p3_rwkv_sample(args, lds, it >> 1, (it & 1) * 8 + wave, wave, lane);
    }
    SEAM(3);
    if (IN(4)) {
        pg8::StaticOrder S; S.init(MT, 1024, 1024, G, bx);
        pg8::Unit u0;
        if (S.next(0, u0)) {
            pg8::Gemm g{(const bf16_t*)(args.ws + WS_YG), (const bf16_t*)(args.ws + WS_WGLU_T), 1024, 1024};
            EpiGlu E{(const bf16_t*)(args.ws + WS_YG), (const bf16_t*)(args.ws + WS_P), args.in[I_BGLU], (bf16_t*)(args.ws + WS_XN)};
            pg8::gemm_phase<EpiGlu, pg8::StaticOrder>(lds, g, S, E);
        } else {
            const int nfree = G - 132, j = bx - 132, unit = wave * nfree + j;
            if (unit < 256) p3_rwkv_seq(args, unit, lane);
        }
    }
    SEAM(4);
    if (IN(5)) { for (int it = gw * 8; it < MP * 16; it += NGW * 8) p4_rwkv_post8(args, it, lane); }
    SEAM(5);
    if (IN(6)) {
        pg8::Gemm g{(const bf16_t*)(args.ws + WS_XN), (const bf16_t*)(args.ws + WS_WOUT_T), 2048, 1024};
        pg8::OutOrder S; S.init(MP, DM, 1024, G, bx);
        EpiOut E{(const bf16_t*)(args.ws + WS_P), args.in[I_XP], (const float*)(args.ws + WS_MOD), args.out, (float*)(args.ws + WS_ROWSS), (bf16_t*)(args.ws + WS_TMP), (float*)(args.ws + WS_SLAB), ctl + CW_PANEL, args.in[I_FINALG]};
        pg8::gemm_phase<EpiOut, pg8::OutOrder>(lds, g, S, E);
    }
    SEAM(6);
    if (IN(7)) { for (int m = MP + gw; m < MV; m += NGW) p6_row(args, m, lane); }
#undef IN
#undef SEAM
}

extern "C" void kernel_launch(void* const* d_in, const int* in_sizes, int n_in, void* d_out, int out_size, void* d_ws, size_t ws_size, hipStream_t stream) {
    static int grid = 0;
    if (grid == 0) {
        if (n_in != 34 || ws_size < WS_END) { fprintf(stderr, "kernel_launch: unexpected n_in %d / ws %zu\n", n_in, ws_size); grid = -1; return; }
        int dev = 0, cus = 0;
        if (hipGetDevice(&dev) != hipSuccess || hipDeviceGetAttribute(&cus, hipDeviceAttributeMultiprocessorCount, dev) != hipSuccess) { grid = -1; return; }
        if (hipFuncSetAttribute((const void*)fwd_kernel, hipFuncAttributeMaxDynamicSharedMemorySize, LDS_BYTES) != hipSuccess) { fprintf(stderr, "kernel_launch: hipFuncSetAttribute failed\n"); grid = -1; return; }
        int per_cu = 0;
        if (hipOccupancyMaxActiveBlocksPerMultiprocessor(&per_cu, (const void*)fwd_kernel, 512, LDS_BYTES) != hipSuccess || per_cu < 1) fprintf(stderr, "kernel_launch: occupancy query says %d\n", per_cu);
        (void)hipGetLastError();
        grid = cus;
        if (grid != 256) fprintf(stderr, "kernel_launch: note: %d CUs\n", grid);
    }
    if (grid < 0) return;
    (void)hipMemsetAsync((char*)d_ws + WS_CTL, 0, CTL_BYTES, stream);
    Args a{};
    for (int i = 0; i < 34; ++i) a.in[i] = (const float*)d_in[i];
    a.out = (float*)d_out; a.ws = (unsigned char*)d_ws;
    if (PROBE_PHASE >= 0) {
        a.ph_lo = 0; a.ph_hi = PROBE_PHASE + 1; a.li = 0; hipLaunchKernelGGL(fwd_kernel, dim3(grid), dim3(512), LDS_BYTES, stream, a);
        a.ph_lo = PROBE_PHASE; a.ph_hi = PROBE_PHASE + 1; a.li = 1; hipLaunchKernelGGL(fwd_kernel, dim3(grid), dim3(512), LDS_BYTES, stream, a);
        if (PROBE_PHASE + 1 < N_PHASES) { a.ph_lo = PROBE_PHASE + 1; a.ph_hi = N_PHASES; a.li = 2; hipLaunchKernelGGL(fwd_kernel, dim3(grid), dim3(512), LDS_BYTES, stream, a); }
    } else if (MK_N_LAUNCHES == 1) { a.ph_lo = 0; a.ph_hi = N_PHASES; a.li = 0; hipLaunchKernelGGL(fwd_kernel, dim3(grid), dim3(512), LDS_BYTES, stream, a); }
    else { for (int p = 0; p < N_PHASES; ++p) { a.ph_lo = p; a.ph_hi = p + 1; a.li = 0; hipLaunchKernelGGL(fwd_kernel, dim3(grid), dim3(512), LDS_BYTES, stream, a); } }
}
```

```cpp
#include <hip/hip_runtime.h>
#include <cstdio>
#include <cstdint>

#ifndef MK_N_LAUNCHES
#define MK_N_LAUNCHES 1
#endif
#ifndef PROBE_PHASE
#define PROBE_PHASE -1
#endif
constexpr int N_PHASES = 8;
#ifndef GEMM_SP2
#define GEMM_SP2 true
#endif
#ifndef GEMM_ALIGN
#define GEMM_ALIGN true
#endif

#define GAS __attribute__((address_space(1)))
#define LAS __attribute__((address_space(3)))
typedef unsigned short bf16_t;
typedef short bf16x8 __attribute__((ext_vector_type(8)));
typedef float f32x2 __attribute__((ext_vector_type(2)));
typedef float f32x4 __attribute__((ext_vector_type(4)));
typedef float f32x16 __attribute__((ext_vector_type(16)));
typedef unsigned u32x2 __attribute__((ext_vector_type(2)));
typedef unsigned u32x4 __attribute__((ext_vector_type(4)));
typedef GAS unsigned gu32;

constexpr int DM = 2048, SEQ = 2048, NB = 4, NSMP = 128;
constexpr int MP = NB * SEQ;
constexpr int MV = MP + NSMP;
constexpr int MT = MV + NSMP;
constexpr int NIN = 10368, LDP = 10496;
constexpr int NMOD = 6144, NMODROWS = NB + NSMP;
constexpr float RMS_EPS = 1e-6f, GN_EPS = 64e-5f;
constexpr int PC_U = 0, PC_ZS = 1024, PC_R = 2048, PC_K = 3072, PC_V = 4096, PC_ZR = 5120, PC_GS = 6144, PC_GR = 8192, PC_WD = 10240, PC_AD = 10304;

constexpr size_t WS_CTL = 0, CTL_BYTES = 131072;
constexpr size_t WS_MOD = CTL_BYTES;
constexpr size_t WS_WT = WS_MOD + 3276800;
constexpr size_t WS_XN = WS_WT + (size_t)LDP * 2048 * 2;
constexpr size_t WS_P = WS_XN + (size_t)MT * 2048 * 2;
constexpr size_t WS_RWI = WS_P + (size_t)MT * LDP * 2;
constexpr int RWI_GF = 0, RWI_W2F = 8192, RWI_H1F = 16384, RWI_O1F = 32768, RWI_LAM = 49152, RWI_BYTES = 49408;
constexpr size_t WS_TMP = WS_RWI;
constexpr size_t WS_SLAB = WS_TMP + (size_t)MP * 2048 * 2;
static_assert(WS_SLAB + (size_t)8 * NSMP * DM * 4 <= WS_RWI + (size_t)2048 * RWI_BYTES, "tmp/slab alias");
constexpr size_t WS_YG = WS_RWI + (size_t)2048 * RWI_BYTES;
constexpr size_t WS_WOUT_T = WS_YG + (size_t)MT * 1024 * 2;
constexpr size_t WS_WGLU_T = WS_WOUT_T + (size_t)2048 * 2048 * 2;
constexpr size_t WS_ROWSS = WS_WGLU_T + (size_t)1024 * 1024 * 2;
constexpr size_t WS_U2 = WS_ROWSS + (size_t)MP * 8 * 4;
constexpr size_t WS_U2S = WS_U2 + (size_t)MP * 1024 * 2;
constexpr size_t WS_END = WS_U2S + (size_t)NSMP * 1024 * 2;
static_assert(WS_END <= ((size_t)412 << 20), "ws map");
constexpr size_t DO_ORAW = 0, DO_BV = (size_t)MP * 1024 * 2, DO_S5TAB = 2 * DO_BV;
constexpr int S5T_ME = 0, S5T_KT = 65536, S5T_CA = 81920, S5T_C0 = 147456, S5T_DF = 155648, S5T_HDR = 156672, S5T_BYTES = 157696;
static_assert(DO_S5TAB + (size_t)64 * S5T_BYTES <= (size_t)MV * DM * 4, "d_out scratch");
constexpr size_t OUT_Y = 0, OUT_S5RE_P = 17039360, OUT_S5IM_P = 17055744, OUT_WKV_P = 17072128, OUT_SHIFT_P = 17334272,
                 OUT_S5RE_S = 17342464, OUT_S5IM_S = 17866752, OUT_WKV_S = 18391040, OUT_SHIFT_S = 26779648;
constexpr int RING_BYTES = 131072, LDSCTL_OFF = RING_BYTES, MISC_OFF = LDSCTL_OFF + 320, LDS_BYTES = 147456;
constexpr int CW_BAR = 1024;
constexpr int CW_PANEL = 12288, CW_TILE = 16384;

#define LDS_WAIT() asm volatile("s_waitcnt lgkmcnt(0)" ::: "memory")
#define VM_WAIT() asm volatile("s_waitcnt vmcnt(0)" ::: "memory")
typedef __bf16 bf16x2_t __attribute__((ext_vector_type(2)));
__device__ __forceinline__ unsigned cvt_pk_bf16(float lo, float hi) { const f32x2 v = {lo, hi}; return __builtin_bit_cast(unsigned, __builtin_convertvector(v, bf16x2_t)); }
__device__ __forceinline__ u32x2 pack4(float a, float b, float c, float d) { u32x2 w; w.x = cvt_pk_bf16(a, b); w.y = cvt_pk_bf16(c, d); return w; }
__device__ __forceinline__ float bf_lo(unsigned w) { return __uint_as_float(w << 16); }
__device__ __forceinline__ float bf_hi(unsigned w) { return __uint_as_float(w & 0xffff0000u); }
__device__ __forceinline__ float bf2f(bf16_t b) { return __uint_as_float(((unsigned)b) << 16); }
__device__ __forceinline__ bf16_t f2bf(float f) { return (bf16_t)(cvt_pk_bf16(f, 0.f) & 0xffffu); }
__device__ __forceinline__ float rcpf_(float x) { return __builtin_amdgcn_rcpf(x); }
__device__ __forceinline__ float sigmoidf_(float x) { return rcpf_(1.0f + __expf(-x)); }
__device__ __forceinline__ float siluf_(float x) { return x * rcpf_(1.0f + __expf(-x)); }
__device__ __forceinline__ float tanhf_(float x) { const float e = __expf(2.0f * x); return 1.0f - 2.0f * rcpf_(e + 1.0f); }
__device__ __forceinline__ float geluf_(float y) { const float z = 0.7978845608028654f * (y + 0.044715f * y * y * y); return 0.5f * y * (1.0f + tanhf_(z)); }
__device__ __forceinline__ float wave_sum(float v) {
#pragma unroll
    for (int o = 1; o < 64; o <<= 1) v += __shfl_xor(v, o);
    return v;
}
template <int CTRL> __device__ __forceinline__ float dpp_f(float x) { return __builtin_bit_cast(float, __builtin_amdgcn_mov_dpp(__builtin_bit_cast(int, x), CTRL, 0xf, 0xf, true)); }
__device__ __forceinline__ float wave_sum_dpp(float v) {
    v += __builtin_bit_cast(float, __builtin_amdgcn_update_dpp(0, __builtin_bit_cast(int, v), 0x111, 0xf, 0xf, true));
    v += __builtin_bit_cast(float, __builtin_amdgcn_update_dpp(0, __builtin_bit_cast(int, v), 0x112, 0xf, 0xf, true));
    v += __builtin_bit_cast(float, __builtin_amdgcn_update_dpp(0, __builtin_bit_cast(int, v), 0x114, 0xf, 0xf, true));
    v += __builtin_bit_cast(float, __builtin_amdgcn_update_dpp(0, __builtin_bit_cast(int, v), 0x118, 0xf, 0xf, true));
    v += __builtin_bit_cast(float, __builtin_amdgcn_update_dpp(0, __builtin_bit_cast(int, v), 0x142, 0xa, 0xf, false));
    v += __builtin_bit_cast(float, __builtin_amdgcn_update_dpp(0, __builtin_bit_cast(int, v), 0x143, 0xc, 0xf, false));
    return __builtin_bit_cast(float, __builtin_amdgcn_readlane(__builtin_bit_cast(int, v), 63));
}
__device__ __forceinline__ float row16_sum(float v) {
    v += dpp_f<0xB1>(v);
    v += dpp_f<0x4E>(v);
    v += dpp_f<0x141>(v);
    v += dpp_f<0x140>(v);
    return v;
}

#define XB_TMO      128
#define XB_XCNT(j)  (256  + 64 * (j))
#define XB_XSUB(j)  (1280 + 64 * (j))
#define XB_XGEN(j)  (2304 + 64 * (j))
#define XB_TOP      3328
#define XB_TOPGEN   3392
#define XCD_BAR_WORDS 3456
#define XB_SPIN_CAP (1u << 20)
__device__ __forceinline__ unsigned xb_ld(unsigned* p)              { return __hip_atomic_load(p, __ATOMIC_RELAXED, __HIP_MEMORY_SCOPE_AGENT); }
__device__ __forceinline__ unsigned xb_add(unsigned* p, unsigned v) { return __hip_atomic_fetch_add(p, v, __ATOMIC_RELAXED, __HIP_MEMORY_SCOPE_AGENT); }
__device__ __forceinline__ unsigned xb_xcc_id() { return (unsigned)__builtin_amdgcn_s_getreg((3 << 11) | 20) & 0xFu; }
#define XB_SPIN(cond, bar) do { unsigned _sp = 0; while (cond) { __builtin_amdgcn_s_sleep(1); \
    if ((++_sp & 255u) == 0u) { if (xb_ld(&(bar)[XB_TMO])) break; if (_sp > XB_SPIN_CAP) { atomicAdd(&(bar)[XB_TMO], 1u); break; } } } } while (0)
struct XcdBarrier { unsigned* bar; unsigned x; volatile LAS unsigned* st; };
__device__ __forceinline__ XcdBarrier xcd_barrier_post(unsigned* bar, volatile LAS unsigned* st) {
    XcdBarrier b; b.bar = bar; b.x = xb_xcc_id(); b.st = st;
    if (threadIdx.x == 0) (void)xb_add(&bar[XB_XCNT(b.x)], 1u);
    return b;
}
__device__ __forceinline__ void xcd_barrier_complete(unsigned* bar, unsigned x, unsigned& nloc, unsigned& nx) {
    const unsigned G = gridDim.x * gridDim.y * gridDim.z;
    unsigned sum, cnt, mine, sp = 0u;
    for (;;) {
        sum = 0u; cnt = 0u; mine = 0u;
#pragma unroll
        for (unsigned j = 0; j < 16; ++j) { const unsigned c = xb_ld(&bar[XB_XCNT(j)]); sum += c; cnt += (c > 0u) ? 1u : 0u; mine = (j == x) ? c : mine; }
        if (sum == G) break;
        __builtin_amdgcn_s_sleep(1);
        if ((++sp & 255u) == 0u) { if (xb_ld(&bar[XB_TMO])) break; if (sp > XB_SPIN_CAP) { atomicAdd(&bar[XB_TMO], 1u); break; } }
    }
    nloc = mine > 0u ? mine : 1u; nx = cnt > 0u ? cnt : 1u;
}
__device__ __forceinline__ void xcd_barrier(const XcdBarrier& b) {
    asm volatile("s_waitcnt vmcnt(0)" ::: "memory");
    __syncthreads();
    if (threadIdx.x == 0) {
        unsigned* bar = b.bar;
        __builtin_amdgcn_s_waitcnt(0);
        unsigned nloc = b.st[0], nx = b.st[1];
        if (nloc == 0u) { xcd_barrier_complete(bar, b.x, nloc, nx); b.st[0] = nloc; b.st[1] = nx; }
        const unsigned old = xb_add(&bar[XB_XSUB(b.x)], 1u);
        const unsigned gen = old / nloc;
        if (old + 1u == (gen + 1u) * nloc) {
            __builtin_amdgcn_fence(__ATOMIC_RELEASE, "agent");
            asm volatile("s_waitcnt vmcnt(0)" ::: "memory");
            const unsigned og = xb_add(&bar[XB_TOP], 1u);
            const unsigned tg = og / nx;
            if (og + 1u == (tg + 1u) * nx) xb_add(&bar[XB_TOPGEN], 1u);
            else XB_SPIN(xb_ld(&bar[XB_TOPGEN]) == tg, bar);
            __builtin_amdgcn_fence(__ATOMIC_ACQUIRE, "agent");
            xb_add(&bar[XB_XGEN(b.x)], 1u);
            asm volatile("s_waitcnt vmcnt(0)" ::: "memory");
        } else {
            XB_SPIN(xb_ld(&bar[XB_XGEN(b.x)]) == gen, bar);
            __builtin_amdgcn_fence(__ATOMIC_ACQUIRE, "agent");
            asm volatile("s_waitcnt vmcnt(0)" ::: "memory");
        }
    }
    __syncthreads();
}

namespace pg8 {
constexpr int BM = 256, BK = 64, HALF = 128, HTB = HALF * BK * 2, STAGE_BYTES = 8 * HTB, NXCD = 8, WGM = 8;
__host__ __device__ __forceinline__ int lds_byte(int r, int c) { const int st = (r >> 4) * 2 + (c >> 5), rr = r & 15, cc = c & 31, ob = rr * 64 + cc * 2; return st * 1024 + (ob ^ (((ob >> 9) & 1) << 5)); }
__host__ __device__ __forceinline__ void stage_rc(int b, int& R, int& C) { const int st = b / 1024, sb = b % 1024, swz = sb ^ (((sb >> 9) & 1) << 5); R = (st >> 1) * 16 + swz / 64; C = (st & 1) * 32 + (swz % 64) / 2; }
__host__ __device__ __forceinline__ int perm32(int rho) { const int n = rho >> 4, i = rho & 15; return 8 * (i >> 2) + 4 * n + (i & 3); }
struct Unit { int pm, pn, koff, kt, mode; };
struct Gemm { const bf16_t* A; const bf16_t* Bt; int ld, K; };
struct StaticOrder {
    int nM, nN, nwg, G, c, kt;
    __device__ void init(int M, int N, int K, int G_, int c_) { nM = M / BM; nN = N / BM; nwg = nM * nN; G = G_; c = c_; kt = K / BK; }
    __device__ __forceinline__ void tile(int L, Unit& u) const {
        int wgid = L; { const int q = nwg / NXCD, r = nwg % NXCD, xcd = wgid % NXCD, off = wgid / NXCD; wgid = (xcd < r ? xcd * (q + 1) : r * (q + 1) + (xcd - r) * q) + off; }
        const int nig = WGM * nN, gid = wgid / nig, fm = gid * WGM, gsz = (nM - fm) < WGM ? (nM - fm) : WGM;
        u.pm = fm + ((wgid % nig) % gsz); u.pn = (wgid % nig) / gsz; u.koff = 0; u.kt = kt; u.mode = 0;
    }
    __device__ __forceinline__ bool next(int i, Unit& u) const { const long L = (long)i * G + c; if (L >= nwg) return false; tile((int)L, u); return true; }
    __device__ __forceinline__ void done(const Unit&, int, int&) const {}
};
struct OutOrder : StaticOrder {
    __device__ __forceinline__ bool next(int i, Unit& u) const {
        const int i2 = (c < 64) ? i - 1 : i;
        if (i2 < 0) { u.pm = 32; u.pn = c >> 3; u.koff = (c & 7) * 256; u.kt = 4; u.mode = 2; return true; }
        if (i2 < 2 && c < nwg) { tile(c, u); u.koff = i2 * 1024; u.kt = 16; u.mode = i2; return true; }
        return false;
    }
};
struct TailOrder : StaticOrder {
    unsigned* cnt;
    __device__ void init2(int G_, int c_, unsigned* cnt_) { nM = 32; nN = 37; nwg = 32 * 37; G = G_; c = c_; kt = 32; cnt = cnt_; }
    __device__ __forceinline__ bool next(int i, Unit& u) const {
        const int L = i * G + c; if (L >= 169 + 1184) return false;
        if (L < 132) { const int x = L & 7, k = L >> 3; if (k < 16) { u.pm = 4 * x + (k >> 2); u.pn = k & 3; } else { u.pm = 32; u.pn = x; }
                       u.koff = 0; u.kt = 32; u.mode = 0; }
        else if (L < 169) { u.pm = 32; u.pn = 4 + (L - 132); u.koff = 0; u.kt = 32; u.mode = 0; }
        else { tile(L - 169, u); u.pn += 4; }
        return true;
    }
    __device__ __forceinline__ void done(const Unit& u, int lane, int& pend) const {
        if (pend >= 0) {
            asm volatile("s_waitcnt vmcnt(0)" ::: "memory");
            if (lane == 0) __hip_atomic_fetch_add(cnt + 64 * pend, 1u, __ATOMIC_RELAXED, __HIP_MEMORY_SCOPE_AGENT);
            pend = -1;
        }
        if (u.pm == 32 || u.pn < 4) pend = (u.pm == 32) ? 16 + u.pn : (u.pm >> 3) * 4 + u.pn;
    }
};
template <class Epi, class Sched, bool ALIGN_EPI = false, bool SP2 = false>
__device__ __forceinline__ void gemm_phase(LAS unsigned char* lds, const Gemm g, const Sched& S, const Epi& E) {
    const int tid = threadIdx.x, wid = __builtin_amdgcn_readfirstlane(tid >> 6), lane = tid & 63, wr = wid >> 2, wc = wid & 3, fr = lane & 15, fq = lane >> 4;
    const int ld = g.ld;
    unsigned voffA[2], voffB[2];
#pragma unroll
    for (int i = 0; i < 2; ++i) { int R, C; stage_rc(tid * 16 + i * 8192, R, C); const int Rb = Epi::PERM ? ((R & ~31) + perm32(R & 31)) : R;
        voffA[i] = (unsigned)(R * ld + C) * 2u; voffB[i] = (unsigned)(Rb * ld + C) * 2u; }
    const size_t kstep = (size_t)(BK * 2);
    const size_t hstep = (size_t)HALF * ld * 2;
    const size_t tstep = 2 * hstep;
    const unsigned ldsw = (unsigned)wid * 1024u;
    const int aoff = lds_byte(wr * 64 + fr, fq * 8), boff = lds_byte(wc * 32 + fr, fq * 8);
#define PG8_SA(b, h) (((b) * 2 + (h)) * HTB)
#define PG8_SB(b, h) ((4 + (b) * 2 + (h)) * HTB)
#define PG8_STAGE(bufoff, gbase, voff) do { _Pragma("unroll") for (int _i = 0; _i < 2; ++_i) \
        __builtin_amdgcn_global_load_lds((const unsigned*)((const char*)(gbase) + (voff)[_i]), (LAS unsigned*)(lds + (bufoff) + ldsw + _i * 8192), 16, 0, 0); } while (0)
#define PG8_LDA(dst, b, h) do { _Pragma("unroll") for (int m = 0; m < 4; ++m) _Pragma("unroll") for (int k = 0; k < 2; ++k) dst[m][k] = *(const LAS bf16x8*)(lds + PG8_SA(b, h) + aoff + m * 2048 + k * 1024); } while (0)
#define PG8_LDB(dst, b, h) do { _Pragma("unroll") for (int n = 0; n < 2; ++n) _Pragma("unroll") for (int k = 0; k < 2; ++k) dst[n][k] = *(const LAS bf16x8*)(lds + PG8_SB(b, h) + boff + n * 2048 + k * 1024); } while (0)
#define PG8_MMA(ai, bj, At, Bt) do { __builtin_amdgcn_s_setprio(1); _Pragma("unroll") for (int m = 0; m < 4; ++m) _Pragma("unroll") for (int n = 0; n < 2; ++n) _Pragma("unroll") for (int k = 0; k < 2; ++k) \
        acc[ai][bj][m][n] = __builtin_amdgcn_mfma_f32_16x16x32_bf16(Bt[n][k], At[m][k], acc[ai][bj][m][n], 0, 0, 0); __builtin_amdgcn_s_setprio(0); } while (0)
#define PG8_WAIT_V(n) asm volatile("s_waitcnt vmcnt(" #n ")" ::: "memory")
#define PG8_WAIT_L(n) asm volatile("s_waitcnt lgkmcnt(" #n ")" ::: "memory")
#define PG8_BAR __builtin_amdgcn_s_barrier()
#define PG8_SCHED __builtin_amdgcn_sched_barrier(0)
    Unit cur, nxt; int ui = 0; bool deferred = false; int pend = -1;
    if (!S.next(0, cur)) return;
    f32x4 acc[2][2][4][2];
#pragma unroll
    for (int a = 0; a < 2; ++a)
#pragma unroll
        for (int b = 0; b < 2; ++b)
#pragma unroll
            for (int m = 0; m < 4; ++m)
#pragma unroll
                for (int n = 0; n < 2; ++n) acc[a][b][m][n] = (f32x4){0.f, 0.f, 0.f, 0.f};
    bf16x8 At[4][2], B0[2][2], B1[2][2];
    const char* cA = (const char*)g.A + (size_t)cur.pm * tstep + (size_t)cur.koff * 2; const char* cB = (const char*)g.Bt + (size_t)cur.pn * tstep + (size_t)cur.koff * 2;
    if constexpr (SP2) {
        PG8_STAGE(PG8_SB(0, 0), cB, voffB); PG8_STAGE(PG8_SB(0, 1), cB + hstep, voffB); PG8_STAGE(PG8_SA(0, 0), cA, voffA); PG8_STAGE(PG8_SA(0, 1), cA + hstep, voffA);
        if (wr == 1) PG8_BAR;
        PG8_WAIT_V(2); PG8_BAR;
        PG8_STAGE(PG8_SB(1, 0), cB + kstep, voffB); PG8_STAGE(PG8_SA(1, 0), cA + kstep, voffA); PG8_STAGE(PG8_SB(1, 1), cB + hstep + kstep, voffB);
        PG8_WAIT_V(6); PG8_BAR;
    } else {
    PG8_STAGE(PG8_SB(0, 0), cB, voffB); PG8_STAGE(PG8_SA(0, 0), cA, voffA); PG8_STAGE(PG8_SB(0, 1), cB + hstep, voffB); PG8_STAGE(PG8_SA(0, 1), cA + hstep, voffA);
    if (wr == 1) PG8_BAR;
    PG8_WAIT_V(4); PG8_BAR;
    PG8_STAGE(PG8_SB(1, 0), cB + kstep, voffB); PG8_STAGE(PG8_SA(1, 0), cA + kstep, voffA); PG8_STAGE(PG8_SB(1, 1), cB + hstep + kstep, voffB);
    PG8_WAIT_V(6); PG8_BAR;
    }
    for (;;) {
        const bool has_next = S.next(ui + 1, nxt);
        const char* nA = has_next ? (const char*)g.A + (size_t)nxt.pm * tstep + (size_t)nxt.koff * 2 : cA; const char* nB = has_next ? (const char*)g.Bt + (size_t)nxt.pn * tstep + (size_t)nxt.koff * 2 : cB;
        const int nt = cur.kt;
        for (int t = 0; t < nt; t += 2) {
            const bool last = (t == nt - 2);
            const char* a1 = cA + (size_t)(t + 1) * kstep;
            const char* a2 = last ? nA : cA + (size_t)(t + 2) * kstep; const char* b2 = last ? nB : cB + (size_t)(t + 2) * kstep;
            const char* a3 = a2 + kstep; const char* b3 = b2 + kstep;
            if constexpr (SP2) {
            PG8_LDB(B0, 0, 0); PG8_LDB(B1, 0, 1); PG8_SCHED; PG8_LDA(At, 0, 0); PG8_STAGE(PG8_SA(1, 1), a1 + hstep, voffA);
            PG8_WAIT_V(8); PG8_WAIT_L(0); PG8_BAR; PG8_MMA(0, 0, At, B0); PG8_MMA(0, 1, At, B1); PG8_BAR; PG8_SCHED;
            PG8_LDA(At, 0, 1); PG8_STAGE(PG8_SB(0, 0), b2, voffB); PG8_STAGE(PG8_SB(0, 1), b2 + hstep, voffB); PG8_STAGE(PG8_SA(0, 0), a2, voffA);
            PG8_WAIT_V(8); PG8_WAIT_L(0); PG8_BAR; PG8_MMA(1, 0, At, B0); PG8_MMA(1, 1, At, B1); PG8_BAR; PG8_SCHED;
            PG8_LDB(B0, 1, 0); PG8_LDB(B1, 1, 1); PG8_SCHED; PG8_LDA(At, 1, 0); PG8_STAGE(PG8_SA(0, 1), a2 + hstep, voffA);
            PG8_WAIT_V(8); PG8_WAIT_L(0); PG8_BAR; PG8_MMA(0, 0, At, B0); PG8_MMA(0, 1, At, B1); PG8_BAR; PG8_SCHED;
            PG8_LDA(At, 1, 1); PG8_STAGE(PG8_SB(1, 0), b3, voffB); PG8_STAGE(PG8_SB(1, 1), b3 + hstep, voffB); PG8_STAGE(PG8_SA(1, 0), a3, voffA);
            PG8_WAIT_V(8); PG8_WAIT_L(0); PG8_BAR; PG8_MMA(1, 0, At, B0); PG8_MMA(1, 1, At, B1); PG8_BAR; PG8_SCHED;
            } else {
            PG8_LDB(B0, 0, 0); PG8_SCHED; PG8_LDA(At, 0, 0); PG8_STAGE(PG8_SA(1, 1), a1 + hstep, voffA);
            PG8_WAIT_L(8); PG8_BAR; PG8_WAIT_L(0); PG8_MMA(0, 0, At, B0); PG8_BAR; PG8_SCHED;
            PG8_LDB(B1, 0, 1); PG8_STAGE(PG8_SB(0, 0), b2, voffB);
            PG8_BAR; PG8_WAIT_L(0); PG8_MMA(0, 1, At, B1); PG8_BAR;
            PG8_LDA(At, 0, 1); PG8_STAGE(PG8_SA(0, 0), a2, voffA);
            PG8_BAR; PG8_WAIT_L(0); PG8_MMA(1, 0, At, B0); PG8_BAR; PG8_SCHED;
            PG8_STAGE(PG8_SB(0, 1), b2 + hstep, voffB);
            PG8_WAIT_V(6); PG8_BAR; PG8_MMA(1, 1, At, B1); PG8_BAR;
            PG8_LDB(B0, 1, 0); PG8_SCHED; PG8_LDA(At, 1, 0); PG8_STAGE(PG8_SA(0, 1), a2 + hstep, voffA);
            PG8_WAIT_L(8); PG8_BAR; PG8_WAIT_L(0); PG8_MMA(0, 0, At, B0); PG8_BAR; PG8_SCHED;
            PG8_LDB(B1, 1, 1); PG8_STAGE(PG8_SB(1, 0), b3, voffB);
            PG8_BAR; PG8_WAIT_L(0); PG8_MMA(0, 1, At, B1); PG8_BAR;
            PG8_LDA(At, 1, 1); PG8_STAGE(PG8_SA(1, 0), a3, voffA);
            PG8_BAR; PG8_WAIT_L(0); PG8_MMA(1, 0, At, B0); PG8_BAR; PG8_SCHED;
            PG8_STAGE(PG8_SB(1, 1), b3 + hstep, voffB);
            PG8_WAIT_V(6); PG8_BAR; PG8_MMA(1, 1, At, B1); PG8_BAR;
            }
        }
        if constexpr (ALIGN_EPI) { if (wr == 0) PG8_BAR; }
        if (Epi::FUSED_LAST && !has_next && cur.mode == 1) deferred = true; else { E(acc, cur, wr, wc, fr, fq); S.done(cur, lane, pend); }
        if (!has_next) break;
#pragma unroll
        for (int a = 0; a < 2; ++a)
#pragma unroll
            for (int b = 0; b < 2; ++b)
#pragma unroll
                for (int m = 0; m < 4; ++m)
#pragma unroll
                    for (int n = 0; n < 2; ++n) acc[a][b][m][n] = (f32x4){0.f, 0.f, 0.f, 0.f};
        cur = nxt; cA = nA; cB = nB; ++ui;
        if constexpr (ALIGN_EPI) { if (wr == 1) PG8_BAR; }
    }
    PG8_WAIT_V(0);
    if constexpr (!ALIGN_EPI) { if (wr == 0) PG8_BAR; }
    PG8_BAR;
    if constexpr (Epi::FUSED_LAST) { if (deferred) E.fused(acc, cur, wr, wc, fr, fq, lds, wid, lane); }
#undef PG8_SA
#undef PG8_SB
#undef PG8_STAGE
#undef PG8_LDA
#undef PG8_LDB
#undef PG8_MMA
#undef PG8_WAIT_V
#undef PG8_WAIT_L
#undef PG8_BAR
#undef PG8_SCHED
}
}

struct EpiP {
    static constexpr bool PERM = true, FUSED_LAST = false;
    bf16_t* P; bool tail; bf16_t* U2;
    __device__ __forceinline__ void operator()(const f32x4 (&acc)[2][2][4][2], const pg8::Unit& u, int wr, int wc, int fr, int fq) const {
        const int row0 = u.pm * 256 + wr * 64 + fr, col0 = u.pn * 256 + wc * 32 + 8 * fq;
        const bool wt = tail && (u.pm == 32 || u.pn < 4);
        const __amdgpu_buffer_rsrc_t rsrc = __builtin_amdgcn_make_buffer_rsrc(P, 0, (int)((size_t)MT * LDP * 2), 0x00020000);
        const __amdgpu_buffer_rsrc_t rsrc2 = __builtin_amdgcn_make_buffer_rsrc(U2, 0, (int)((size_t)MV * 1024 * 2), 0x00020000);
        const int act = ((u.pn >= 4 && u.pn < 8) || (u.pn >= 20 && u.pn < 24)) ? 1 : ((u.pn >= 24 && u.pn < 40) ? 2 : 0);
#pragma unroll
        for (int ai = 0; ai < 2; ++ai)
#pragma unroll
            for (int m = 0; m < 4; ++m) { bf16_t* rowp = P + (size_t)(row0 + ai * 128 + m * 16) * LDP + col0;
#pragma unroll
                for (int bj = 0; bj < 2; ++bj) { f32x4 v0 = acc[ai][bj][m][0], v1 = acc[ai][bj][m][1];
                    if (act == 1) {
#pragma unroll
                        for (int j = 0; j < 4; ++j) { v0[j] = siluf_(v0[j]); v1[j] = siluf_(v1[j]); } }
                    else if (act == 2) {
#pragma unroll
                        for (int j = 0; j < 4; ++j) { v0[j] = sigmoidf_(v0[j]); v1[j] = sigmoidf_(v1[j]); } }
                    u32x4 w; w.x = cvt_pk_bf16(v0[0], v0[1]); w.y = cvt_pk_bf16(v0[2], v0[3]); w.z = cvt_pk_bf16(v1[0], v1[1]); w.w = cvt_pk_bf16(v1[2], v1[3]);
                    if (u.pn < 4) {
                        const int row = row0 + ai * 128 + m * 16, col = col0 + bj * 128, g2 = col >> 4, hf = (col >> 3) & 1;
                        size_t eo; if (row < MP) eo = (((size_t)(row >> 11) * 64 + g2) * SEQ + (row & (SEQ - 1))) * 16 + hf * 8; else eo = (size_t)MP * 1024 + ((size_t)g2 * NSMP + ((row - MP) & (NSMP - 1))) * 16 + hf * 8;
                        if (row < MV) { if (wt) __builtin_amdgcn_raw_buffer_store_b128(w, rsrc2, (unsigned)(eo * 2), 0, 16); else *(u32x4*)(U2 + eo) = w; } }
                    else if (wt) __builtin_amdgcn_raw_buffer_store_b128(w, rsrc, (unsigned)((size_t)(row0 + ai * 128 + m * 16) * LDP + col0 + bj * 128) * 2u, 0, 16);
                    else *(u32x4*)(rowp + bj * 128) = w; } }
    }
};
struct EpiGlu {
    static constexpr bool PERM = true, FUSED_LAST = false;
    const bf16_t* Yg; const bf16_t* P; const float* bglu; bf16_t* A2;
    __device__ __forceinline__ void operator()(const f32x4 (&acc)[2][2][4][2], const pg8::Unit& u, int wr, int wc, int fr, int fq) const {
        const int row0 = u.pm * 256 + wr * 64 + fr, col0 = u.pn * 256 + wc * 32 + 8 * fq;
        f32x4 bv[2][2];
#pragma unroll
        for (int bj = 0; bj < 2; ++bj)
#pragma unroll
            for (int n = 0; n < 2; ++n) bv[bj][n] = *(const f32x4*)(bglu + col0 + bj * 128 + 4 * n);
#pragma unroll
        for (int ai = 0; ai < 2; ++ai)
#pragma unroll
            for (int m = 0; m < 4; ++m) { const size_t row = (size_t)(row0 + ai * 128 + m * 16);
#pragma unroll
                for (int bj = 0; bj < 2; ++bj) { const int c = col0 + bj * 128;
                    const u32x4 yg = *(const u32x4*)(Yg + row * 1024 + c), sz = *(const u32x4*)(P + row * LDP + PC_ZS + c);
                    const f32x4 a0 = acc[ai][bj][m][0] + bv[bj][0], a1 = acc[ai][bj][m][1] + bv[bj][1];
                    float o[8];
                    o[0] = bf_lo(yg.x) * sigmoidf_(a0[0]) * bf_lo(sz.x); o[1] = bf_hi(yg.x) * sigmoidf_(a0[1]) * bf_hi(sz.x);
                    o[2] = bf_lo(yg.y) * sigmoidf_(a0[2]) * bf_lo(sz.y); o[3] = bf_hi(yg.y) * sigmoidf_(a0[3]) * bf_hi(sz.y);
                    o[4] = bf_lo(yg.z) * sigmoidf_(a1[0]) * bf_lo(sz.z); o[5] = bf_hi(yg.z) * sigmoidf_(a1[1]) * bf_hi(sz.z);
                    o[6] = bf_lo(yg.w) * sigmoidf_(a1[2]) * bf_lo(sz.w); o[7] = bf_hi(yg.w) * sigmoidf_(a1[3]) * bf_hi(sz.w);
                    u32x4 w; w.x = cvt_pk_bf16(o[0], o[1]); w.y = cvt_pk_bf16(o[2], o[3]); w.z = cvt_pk_bf16(o[4], o[5]); w.w = cvt_pk_bf16(o[6], o[7]);
                    *(u32x4*)(A2 + row * 2048 + c) = w; } }
    }
};
struct EpiOut {
    static constexpr bool PERM = false, FUSED_LAST = true;
    const bf16_t* P; const float* xp; const float* mod; float* out; float* xbuf; bf16_t* tmp; float* slab; unsigned* cnt; const float* fg;
    __device__ __forceinline__ void operator()(const f32x4 (&acc)[2][2][4][2], const pg8::Unit& u, int wr, int wc, int fr, int fq) const {
        const int row0 = u.pm * 256 + wr * 64 + fr, col0 = u.pn * 256 + wc * 32 + 4 * fq;
        if (u.mode == 0) {
#pragma unroll
            for (int ai = 0; ai < 2; ++ai)
#pragma unroll
                for (int m = 0; m < 4; ++m) { const size_t row = (size_t)(row0 + ai * 128 + m * 16); const bf16_t* prow = P + row * LDP + PC_GS + col0; bf16_t* trow = tmp + row * DM + col0;
#pragma unroll
                    for (int bj = 0; bj < 2; ++bj)
#pragma unroll
                        for (int n = 0; n < 2; ++n) { const int o = bj * 128 + n * 16; const u32x2 gg = *(const u32x2*)(prow + o); const f32x4 a = acc[ai][bj][m][n];
                            *(u32x2*)(trow + o) = pack4(bf_lo(gg.x) * a[0], bf_hi(gg.x) * a[1], bf_lo(gg.y) * a[2], bf_hi(gg.y) * a[3]); } }
        } else {
            const int gc = (u.koff < 1024) ? PC_GS : PC_GR; float* sl = slab + (size_t)(u.koff >> 8) * NSMP * DM;
#pragma unroll
            for (int m = 0; m < 4; ++m) { const size_t row = (size_t)(row0 + m * 16); const bf16_t* prow = P + row * LDP + gc + col0; float* srow = sl + (row - MP) * DM + col0;
#pragma unroll
                for (int bj = 0; bj < 2; ++bj)
#pragma unroll
                    for (int n = 0; n < 2; ++n) { const int o = bj * 128 + n * 16; const u32x2 gg = *(const u32x2*)(prow + o); const f32x4 a = acc[0][bj][m][n];
                        *(f32x4*)(srow + o) = (f32x4){bf_lo(gg.x) * a[0], bf_hi(gg.x) * a[1], bf_lo(gg.y) * a[2], bf_hi(gg.y) * a[3]}; } }
        }
    }
    __device__ __forceinline__ void fused(f32x4 (&acc)[2][2][4][2], const pg8::Unit& u, int wr, int wc, int fr, int fq, LAS unsigned char* lds, int wid, int lane) const {
        const int row0 = u.pm * 256 + wr * 64 + fr, col0 = u.pn * 256 + wc * 32 + 4 * fq;
        LAS float* PT = (LAS float*)lds; LAS float* ST = (LAS float*)(lds + 4096);
        f32x4 gt[2][2];
        { const float* gtrow = mod + (size_t)(u.pm >> 3) * NMOD + 2 * DM + col0;
#pragma unroll
          for (int bj = 0; bj < 2; ++bj)
#pragma unroll
              for (int n = 0; n < 2; ++n) gt[bj][n] = *(const f32x4*)(gtrow + bj * 128 + n * 16); }
#pragma unroll
        for (int ai = 0; ai < 2; ++ai)
#pragma unroll
            for (int m = 0; m < 4; ++m) { const size_t row = (size_t)(row0 + ai * 128 + m * 16);
                const bf16_t* prow = P + row * LDP + PC_GR + col0; const bf16_t* trow = tmp + row * DM + col0; const float* xrow = xp + row * DM + col0;
                u32x2 gg[4], tv[4]; f32x4 xv[4];
#pragma unroll
                for (int q = 0; q < 4; ++q) { const int o = (q >> 1) * 128 + (q & 1) * 16; gg[q] = *(const u32x2*)(prow + o); tv[q] = *(const u32x2*)(trow + o); xv[q] = *(const f32x4*)(xrow + o); }
                float ss = 0.f;
#pragma unroll
                for (int q = 0; q < 4; ++q) { const f32x4 a = acc[ai][q >> 1][m][q & 1]; const f32x4 g4 = gt[q >> 1][q & 1];
                    f32x4 r; r[0] = xv[q][0] + g4[0] * (bf_lo(tv[q].x) + bf_lo(gg[q].x) * a[0]); r[1] = xv[q][1] + g4[1] * (bf_hi(tv[q].x) + bf_hi(gg[q].x) * a[1]);
                    r[2] = xv[q][2] + g4[2] * (bf_lo(tv[q].y) + bf_lo(gg[q].y) * a[2]); r[3] = xv[q][3] + g4[3] * (bf_hi(tv[q].y) + bf_hi(gg[q].y) * a[3]);
                    ss += (r[0] * r[0] + r[1] * r[1]) + (r[2] * r[2] + r[3] * r[3]);
                    acc[ai][q >> 1][m][q & 1] = r; }
                ss += __shfl_xor(ss, 16); ss += __shfl_xor(ss, 32);
                if (fq == 0) PT[(ai * 128 + wr * 64 + m * 16 + fr) * 4 + wc] = ss; }
        asm volatile("s_waitcnt lgkmcnt(0)" ::: "memory"); __builtin_amdgcn_s_barrier(); asm volatile("" ::: "memory");
        const int row = wid * 32 + (lane & 31);
        if (lane < 32) { const f32x4 p4 = *(const LAS f32x4*)(PT + row * 4);
            __hip_atomic_store(xbuf + ((size_t)(u.pm * 256 + row) * 8 + u.pn), (p4[0] + p4[1]) + (p4[2] + p4[3]), __ATOMIC_RELAXED, __HIP_MEMORY_SCOPE_AGENT); }
        asm volatile("s_waitcnt vmcnt(0)" ::: "memory");
        if (lane == 0) __hip_atomic_fetch_add(cnt + 64 * u.pm, 1u, __ATOMIC_RELAXED, __HIP_MEMORY_SCOPE_AGENT);
        if (wid == 0) {
            unsigned sp = 0;
            while ((unsigned)__builtin_amdgcn_readfirstlane(__hip_atomic_load(cnt + 64 * u.pm, __ATOMIC_RELAXED, __HIP_MEMORY_SCOPE_AGENT)) < 64u) { __builtin_amdgcn_s_sleep(2); if (++sp > (1u << 22)) break; }
            __builtin_amdgcn_fence(__ATOMIC_ACQUIRE, "agent");
        }
        asm volatile("s_waitcnt vmcnt(0) lgkmcnt(0)" ::: "memory"); __builtin_amdgcn_s_barrier(); asm volatile("" ::: "memory");
        if (lane < 32) { const float* sl = xbuf + (size_t)(u.pm * 256 + row) * 8; float s8 = 0.f;
#pragma unroll
            for (int t = 0; t < 8; ++t) s8 += __hip_atomic_load(sl + t, __ATOMIC_RELAXED, __HIP_MEMORY_SCOPE_AGENT);
            ST[row] = rsqrtf(s8 * (1.0f / DM) + RMS_EPS); }
        asm volatile("s_waitcnt lgkmcnt(0)" ::: "memory"); __builtin_amdgcn_s_barrier(); asm volatile("" ::: "memory");
        f32x4 fgv[2][2];
#pragma unroll
        for (int bj = 0; bj < 2; ++bj)
#pragma unroll
            for (int n = 0; n < 2; ++n) fgv[bj][n] = *(const f32x4*)(fg + col0 + bj * 128 + n * 16);
#pragma unroll
        for (int ai = 0; ai < 2; ++ai)
#pragma unroll
            for (int m = 0; m < 4; ++m) { const int rl = ai * 128 + wr * 64 + m * 16 + fr; const float rstd = ST[rl]; float* orow = out + (size_t)(u.pm * 256 + rl) * DM + col0;
#pragma unroll
                for (int bj = 0; bj < 2; ++bj)
#pragma unroll
                    for (int n = 0; n < 2; ++n) *(f32x4*)(orow + bj * 128 + n * 16) = acc[ai][bj][m][n] * rstd * fgv[bj][n]; }
    }
};

struct Args { const float* in[34]; float* out; unsigned char* ws; int ph_lo, ph_hi, li, pad; };
enum { I_XP = 0, I_XS, I_CP, I_CS, I_S5RE, I_S5IM, I_WKV, I_SHIFT, I_NORMG, I_WADA, I_BADA, I_WIN, I_MU, I_ARE, I_AIM, I_LOGSTEP, I_BRE, I_BIM, I_CRE, I_CIM, I_DSKIP,
       I_WGLU, I_BGLU, I_W0, I_W2, I_A0, I_A2, I_KK, I_KA, I_RK, I_GNW, I_GNB, I_WOUT, I_FINALG };

__device__ __forceinline__ void transpose_item(const float* W, int ldw, int K, int csrc, bf16_t* WT, int rdst, int k0, LAS float* scr, int lane, bool zero) {
    if (zero) {
#pragma unroll
        for (int j = 0; j < 4; ++j) { const int n = (lane >> 3) + 8 * j; *(u32x4*)(WT + (size_t)(rdst + n) * K + k0 + 8 * (lane & 7)) = (u32x4){0u, 0u, 0u, 0u}; }
        return;
    }
#pragma unroll 8
    for (int i = 0; i < 32; ++i) { const int kk = 2 * i + (lane >> 5); scr[kk * 33 + (lane & 31)] = W[(size_t)(k0 + kk) * ldw + csrc + (lane & 31)]; }
    LDS_WAIT(); asm volatile("" ::: "memory");
    const int c = lane & 7;
#pragma unroll
    for (int j = 0; j < 4; ++j) { const int n = (lane >> 3) + 8 * j; const LAS float* s = scr + (8 * c) * 33 + n;
        u32x4 o; o.x = cvt_pk_bf16(s[0 * 33], s[1 * 33]); o.y = cvt_pk_bf16(s[2 * 33], s[3 * 33]); o.z = cvt_pk_bf16(s[4 * 33], s[5 * 33]); o.w = cvt_pk_bf16(s[6 * 33], s[7 * 33]);
        *(u32x4*)(WT + (size_t)(rdst + n) * K + k0 + 8 * c) = o; }
    LDS_WAIT(); asm volatile("" ::: "memory");
}

__device__ __forceinline__ void wait_count(unsigned* cnt, unsigned need, int wave) {
    if (wave == 0) { unsigned sp = 0;
        while ((unsigned)__builtin_amdgcn_readfirstlane(__hip_atomic_load(cnt, __ATOMIC_RELAXED, __HIP_MEMORY_SCOPE_AGENT)) < need) { __builtin_amdgcn_s_sleep(4); if (++sp > (1u << 22)) break; }
        __builtin_amdgcn_fence(__ATOMIC_ACQUIRE, "agent");
        asm volatile("s_waitcnt vmcnt(0)" ::: "memory"); }
    __syncthreads();
}
__device__ __forceinline__ void p0_mod(const Args& a, LAS unsigned char* lds, int s, int wave, int lane) {
    const float* cp = a.in[I_CP]; const float* cs = a.in[I_CS]; const float* W = a.in[I_WADA]; const float* bias = a.in[I_BADA];
    float* mod = (float*)(a.ws + WS_MOD);
    const int n0 = 32 * s, k0 = 256 * wave, r31 = lane & 31, h = lane >> 5;
    f32x16 acc[5];
#pragma unroll
    for (int t = 0; t < 5; ++t)
#pragma unroll
        for (int r = 0; r < 16; ++r) acc[t][r] = 0.f;
    float bw[8]; f32x4 c0[5], c1[5];
#define MOD_LOAD(ks_) do { const int kb_ = k0 + 16 * (ks_) + 8 * h; \
        _Pragma("unroll") for (int j = 0; j < 8; ++j) bw[j] = W[(size_t)(kb_ + j) * NMOD + n0 + r31]; \
        _Pragma("unroll") for (int t = 0; t < 5; ++t) { const int R = 32 * t + r31; c0[t] = (f32x4){0.f, 0.f, 0.f, 0.f}; c1[t] = c0[t]; \
            if (R < NMODROWS) { const float* src = (R < NB) ? cp + (size_t)R * DM + kb_ : cs + (size_t)(R - NB) * DM + kb_; c0[t] = *(const f32x4*)src; c1[t] = *(const f32x4*)(src + 4); } } } while (0)
    MOD_LOAD(0);
#pragma unroll 1
    for (int ks = 0; ks < 16; ++ks) {
        bf16x8 bfr; { u32x4 t; t.x = cvt_pk_bf16(bw[0], bw[1]); t.y = cvt_pk_bf16(bw[2], bw[3]); t.z = cvt_pk_bf16(bw[4], bw[5]); t.w = cvt_pk_bf16(bw[6], bw[7]); bfr = __builtin_bit_cast(bf16x8, t); }
        bf16x8 afr[5];
#pragma unroll
        for (int t = 0; t < 5; ++t) { u32x4 w; w.x = cvt_pk_bf16(siluf_(c0[t][0]), siluf_(c0[t][1])); w.y = cvt_pk_bf16(siluf_(c0[t][2]), siluf_(c0[t][3])); w.z = cvt_pk_bf16(siluf_(c1[t][0]), siluf_(c1[t][1])); w.w = cvt_pk_bf16(siluf_(c1[t][2]), siluf_(c1[t][3])); afr[t] = __builtin_bit_cast(bf16x8, w); }
        if (ks + 1 < 16) MOD_LOAD(ks + 1);
#pragma unroll
        for (int t = 0; t < 5; ++t) acc[t] = __builtin_amdgcn_mfma_f32_32x32x16_bf16(afr[t], bfr, acc[t], 0, 0, 0);
    }
#undef MOD_LOAD
    LAS float* red = (LAS float*)lds;
#pragma unroll
    for (int step = 4; step >= 1; step >>= 1) {
        if (wave >= step && wave < 2 * step) {
#pragma unroll
            for (int t = 0; t < 5; ++t)
#pragma unroll
                for (int r = 0; r < 16; ++r) red[(((wave - step) * 5 + t) * 16 + r) * 64 + lane] = acc[t][r];
        }
        __syncthreads();
        if (wave < step) {
#pragma unroll
            for (int t = 0; t < 5; ++t)
#pragma unroll
                for (int r = 0; r < 16; ++r) acc[t][r] += red[((wave * 5 + t) * 16 + r) * 64 + lane];
        }
        __syncthreads();
    }
    if (wave == 0) {
        const float bc = bias[n0 + r31];
#pragma unroll
        for (int t = 0; t < 5; ++t)
#pragma unroll
            for (int r = 0; r < 16; ++r) { const int R = 32 * t + (r & 3) + 8 * (r >> 2) + 4 * h; if (R < NMODROWS) mod[(size_t)R * NMOD + n0 + r31] = acc[t][r] + bc; }
    }
}

__device__ __forceinline__ void p0_s5_tables(const Args& a, LAS unsigned char* lds, int g, int tid) {
    LAS float* pw = (LAS float*)lds;
    LAS float* bbL = pw + 17 * 128;
    LAS float* ccL = bbL + 2048;
    LAS float* KF = ccL + 2048;
    LAS float* DL = KF + 4096;
    unsigned char* tab = (unsigned char*)a.out + DO_S5TAB + (size_t)g * S5T_BYTES;
    {
        const int p = tid & 63;
        const float step = expf(a.in[I_LOGSTEP][g]);
        const float lre = fminf(a.in[I_ARE][g * 64 + p], -1e-4f), lim = a.in[I_AIM][g * 64 + p];
        const float mag = expf(lre * step); float sn, cs; sincosf(lim * step, &sn, &cs);
        const float abr = mag * cs, abi = mag * sn, den = lre * lre + lim * lim;
        const float fr = ((abr - 1.0f) * lre + abi * lim) / den, fi = (abi * lre - (abr - 1.0f) * lim) / den;
        if (tid < 64) { float pr = 1.f, pi = 0.f;
            for (int e = 0; e <= 16; ++e) { pw[(e * 64 + p) * 2] = pr; pw[(e * 64 + p) * 2 + 1] = pi; const float nr = pr * abr - pi * abi, ni = pr * abi + pi * abr; pr = nr; pi = ni; } }
#pragma unroll
        for (int i = 0; i < 2; ++i) { const int c = (tid >> 6) + 8 * i; const float br = a.in[I_BRE][(g * 64 + p) * 16 + c], bi = a.in[I_BIM][(g * 64 + p) * 16 + c];
            bbL[(p * 16 + c) * 2] = fr * br - fi * bi; bbL[(p * 16 + c) * 2 + 1] = fr * bi + fi * br;
            ccL[(c * 64 + p) * 2] = a.in[I_CRE][(g * 16 + c) * 64 + p]; ccL[(c * 64 + p) * 2 + 1] = a.in[I_CIM][(g * 16 + c) * 64 + p]; }
        if (tid < 16) DL[tid] = a.in[I_DSKIP][g * 16 + tid];
    }
    __syncthreads();
    for (int idx = tid; idx < 4096; idx += 512) { const int e = idx >> 8, c = (idx >> 4) & 15, c2 = idx & 15; float s = 0.f;
        for (int p = 0; p < 64; ++p) { const float cr = ccL[(c * 64 + p) * 2], ci = ccL[(c * 64 + p) * 2 + 1], pr = pw[(e * 64 + p) * 2], pi = pw[(e * 64 + p) * 2 + 1];
            const float ar = cr * pr - ci * pi, ai = cr * pi + ci * pr; s += ar * bbL[(p * 16 + c2) * 2] - ai * bbL[(p * 16 + c2) * 2 + 1]; }
        if (e == 0 && c == c2) s += DL[c];
        KF[idx] = s; }
    __syncthreads();
    for (int it = tid; it < 4096; it += 512) { const int l = it & 63, s = (it >> 6) & 15, mtile = it >> 10; const int m = 32 * mtile + (l & 31), h = l >> 5, p = m & 63, im = m >> 6;
        const float pr = pw[((15 - s) * 64 + p) * 2], pi = pw[((15 - s) * 64 + p) * 2 + 1]; float v[8];
#pragma unroll
        for (int j = 0; j < 8; ++j) { const float br = bbL[(p * 16 + 8 * h + j) * 2], bi = bbL[(p * 16 + 8 * h + j) * 2 + 1]; v[j] = im ? (pr * bi + pi * br) : (pr * br - pi * bi); }
        u32x4 w; w.x = cvt_pk_bf16(v[0], v[1]); w.y = cvt_pk_bf16(v[2], v[3]); w.z = cvt_pk_bf16(v[4], v[5]); w.w = cvt_pk_bf16(v[6], v[7]);
        *(u32x4*)(tab + S5T_ME + (size_t)it * 16) = w; }
    for (int it = tid; it < 1024; it += 512) { const int l = it & 63, ti = it >> 6; const int rho = l & 31, dt = rho >> 4, c = rho & 15, h = l >> 5, e = ti - 1 + dt; float v[8];
#pragma unroll
        for (int j = 0; j < 8; ++j) v[j] = (e < 0) ? 0.f : KF[(e * 16 + c) * 16 + 8 * h + j];
        u32x4 w; w.x = cvt_pk_bf16(v[0], v[1]); w.y = cvt_pk_bf16(v[2], v[3]); w.z = cvt_pk_bf16(v[4], v[5]); w.w = cvt_pk_bf16(v[6], v[7]);
        *(u32x4*)(tab + S5T_KT + (size_t)it * 16) = w; }
    for (int it = tid; it < 4096; it += 512) { const int l = it & 63, ks = (it >> 6) & 7, mt = it >> 9; const int rho = l & 31, dt = rho >> 4, c = rho & 15, h = l >> 5, t = 2 * mt + dt; float v[8];
#pragma unroll
        for (int j = 0; j < 8; ++j) { const int m = 16 * ks + 8 * h + j, p = m & 63; const float cr = ccL[(c * 64 + p) * 2], ci = ccL[(c * 64 + p) * 2 + 1], pr = pw[((t + 1) * 64 + p) * 2], pi = pw[((t + 1) * 64 + p) * 2 + 1];
            v[j] = (m < 64) ? (cr * pr - ci * pi) : -(cr * pi + ci * pr); }
        u32x4 w; w.x = cvt_pk_bf16(v[0], v[1]); w.y = cvt_pk_bf16(v[2], v[3]); w.z = cvt_pk_bf16(v[4], v[5]); w.w = cvt_pk_bf16(v[6], v[7]);
        *(u32x4*)(tab + S5T_CA + (size_t)it * 16) = w; }
    { const int it = tid; const int l = it & 63, sp = (it >> 6) & 1, mtile = it >> 7; const int rho = l & 31, h = l >> 5; float v[8];
#pragma unroll
        for (int j = 0; j < 8; ++j) { const int m = 32 * mtile + 16 * sp + 8 * (j >> 2) + 4 * h + (j & 3), p = m & 63; v[j] = (rho < 16) ? ((m < 64) ? ccL[(rho * 64 + p) * 2] : -ccL[(rho * 64 + p) * 2 + 1]) : 0.f; }
        u32x4 w; w.x = cvt_pk_bf16(v[0], v[1]); w.y = cvt_pk_bf16(v[2], v[3]); w.z = cvt_pk_bf16(v[4], v[5]); w.w = cvt_pk_bf16(v[6], v[7]);
        *(u32x4*)(tab + S5T_C0 + (size_t)it * 16) = w; }
    if (tid < 64) { const int l = tid, rho = l & 31, h = l >> 5; float v[8];
#pragma unroll
        for (int j = 0; j < 8; ++j) v[j] = (rho < 16 && rho == 8 * h + j) ? DL[rho] : 0.f;
        u32x4 w; w.x = cvt_pk_bf16(v[0], v[1]); w.y = cvt_pk_bf16(v[2], v[3]); w.z = cvt_pk_bf16(v[4], v[5]); w.w = cvt_pk_bf16(v[6], v[7]);
        *(u32x4*)(tab + S5T_DF + (size_t)l * 16) = w;
        float* hdr = (float*)(tab + S5T_HDR);
        hdr[l] = pw[(16 * 64 + l) * 2]; hdr[64 + l] = pw[(16 * 64 + l) * 2 + 1]; hdr[128 + l] = pw[(64 + l) * 2]; hdr[192 + l] = pw[(64 + l) * 2 + 1]; }
    __syncthreads();
}

__device__ __forceinline__ void p1_row(const Args& a, int m, int lane) {
    bf16_t* XN = (bf16_t*)(a.ws + WS_XN) + (size_t)m * DM;
    if (m >= MV) {
        const float* src = a.in[I_SHIFT] + (size_t)(m - MV) * DM;
#pragma unroll
        for (int j = 0; j < 8; ++j) { const f32x4 v = *(const f32x4*)(src + 4 * lane + 256 * j); u32x2 w; w.x = cvt_pk_bf16(v[0], v[1]); w.y = cvt_pk_bf16(v[2], v[3]); *(u32x2*)(XN + 4 * lane + 256 * j) = w; }
        return;
    }
    const float* x = (m < MP) ? a.in[I_XP] + (size_t)m * DM : a.in[I_XS] + (size_t)(m - MP) * DM;
    const int mrow = (m < MP) ? (m >> 11) : (NB + m - MP);
    const float* mod = (const float*)(a.ws + WS_MOD) + (size_t)mrow * NMOD;
    const float* g = a.in[I_NORMG];
    f32x4 v[8]; float ss = 0.f;
#pragma unroll
    for (int j = 0; j < 8; ++j) { v[j] = *(const f32x4*)(x + 4 * lane + 256 * j); ss += (v[j][0] * v[j][0] + v[j][1] * v[j][1]) + (v[j][2] * v[j][2] + v[j][3] * v[j][3]); }
    const float rstd = rsqrtf(wave_sum(ss) * (1.0f / DM) + RMS_EPS);
    float* sh_out = nullptr;
    if (m >= MP) sh_out = a.out + OUT_SHIFT_S + (size_t)(m - MP) * DM;
    else if ((m & (SEQ - 1)) == SEQ - 1) sh_out = a.out + OUT_SHIFT_P + (size_t)(m >> 11) * DM;
#pragma unroll
    for (int j = 0; j < 8; ++j) { const int k = 4 * lane + 256 * j; const f32x4 gv = *(const f32x4*)(g + k), sh = *(const f32x4*)(mod + k), sc = *(const f32x4*)(mod + DM + k);
        f32x4 hv;
#pragma unroll
        for (int q = 0; q < 4; ++q) hv[q] = v[j][q] * rstd * gv[q] * (1.0f + sc[q]) + sh[q];
        u32x2 w; w.x = cvt_pk_bf16(hv[0], hv[1]); w.y = cvt_pk_bf16(hv[2], hv[3]); *(u32x2*)(XN + k) = w;
        if (sh_out) *(f32x4*)(sh_out + k) = hv; }
}

constexpr int RW_TB = 32;
constexpr int RW_KK = 0, RW_DR = 2048, RW_DD = 4096, RW_BB = 6144, RW_KP = 8192, RW_VV = 10240, RW_SC = 11264, RW_LW = 11392, RW_LA = 13440, RW_OB = 15488, RW_BVB = 16512, RW_END = 17536;
__device__ __forceinline__ void lerp8(const bf16_t* cur, const bf16_t* prev, bool has_prev, const float* mu, float (&o)[8]) {
    const u32x4 c = *(const u32x4*)cur; u32x4 p = (u32x4){0u, 0u, 0u, 0u}; if (has_prev) p = *(const u32x4*)prev;
    const f32x4 m0 = *(const f32x4*)mu, m1 = *(const f32x4*)(mu + 4);
    const float cf[8] = {bf_lo(c.x), bf_hi(c.x), bf_lo(c.y), bf_hi(c.y), bf_lo(c.z), bf_hi(c.z), bf_lo(c.w), bf_hi(c.w)};
    const float pf[8] = {bf_lo(p.x), bf_hi(p.x), bf_lo(p.y), bf_hi(p.y), bf_lo(p.z), bf_hi(p.z), bf_lo(p.w), bf_hi(p.w)};
    const float mf[8] = {m0[0], m0[1], m0[2], m0[3], m1[0], m1[1], m1[2], m1[3]};
#pragma unroll
    for (int j = 0; j < 8; ++j) o[j] = cf[j] + (pf[j] - cf[j]) * mf[j];
}
struct RwTok { float kk, dr, dd, bb, kp, v, br, kr, bonus; };
__device__ __forceinline__ RwTok rw_token(const Args& a, int hj, float r, float k, float v, float lw, float la) {
    RwTok o;
    const float wpre = a.in[I_W0][hj] + lw;
    const float nz = -wpre;
    const float sp = fmaxf(nz, 0.f) + log1pf(__expf(-fabsf(nz)));
    const float w = -sp - 0.5f;
    o.dd = __expf(-__expf(w));
    const float av = sigmoidf_(a.in[I_A0][hj] + la);
    const float kkv = k * a.in[I_KK][hj];
    const float nrm = sqrtf(wave_sum(kkv * kkv));
    o.kk = kkv / fmaxf(nrm, 1e-12f);
    o.kp = k * (1.0f + (av - 1.0f) * a.in[I_KA][hj]);
    o.bb = o.kk * av;
    o.dr = o.dd * r;
    o.v = v;
    o.br = wave_sum(o.bb * r);
    o.kr = wave_sum(o.kp * r);
    o.bonus = wave_sum(r * o.kp * a.in[I_RK][hj]);
    return o;
}
__device__ __forceinline__ void p3_rwkv_prompt(const Args& a, LAS unsigned char* lds, int unit, int tid, int wave, int lane) {
    const int b = unit >> 5, h = (unit >> 1) & 15, half = unit & 1;
    LAS float* L = (LAS float*)lds;
    const bf16_t* P = (const bf16_t*)(a.ws + WS_P);
    bf16_t* ORAW = (bf16_t*)((unsigned char*)a.out + DO_ORAW); bf16_t* BV = (bf16_t*)((unsigned char*)a.out + DO_BV);
    const float* mu = a.in[I_MU];
    const int r31 = lane & 31, hh = lane >> 5;
    bf16x8 bfr[4];
    if (wave < 4) { const float* W2 = (wave >> 1) ? a.in[I_A2] : a.in[I_W2]; const int col = h * 64 + 32 * (wave & 1) + r31;
#pragma unroll
        for (int ks = 0; ks < 4; ++ks) { float w[8];
#pragma unroll
            for (int j = 0; j < 8; ++j) w[j] = W2[(size_t)(16 * ks + 8 * hh + j) * 1024 + col];
            u32x4 t; t.x = cvt_pk_bf16(w[0], w[1]); t.y = cvt_pk_bf16(w[2], w[3]); t.z = cvt_pk_bf16(w[4], w[5]); t.w = cvt_pk_bf16(w[6], w[7]); bfr[ks] = __builtin_bit_cast(bf16x8, t); } }
    const int srow = 4 * wave + (lane >> 4), cq = lane & 15;
    f32x4 S = (f32x4){0.f, 0.f, 0.f, 0.f};
    for (int t0 = 0; t0 < SEQ; t0 += RW_TB) {
        const size_t rowbase = (size_t)b * SEQ + t0;
        if (wave < 4) { const int mat = wave >> 1, nt2 = wave & 1; const size_t row = rowbase + r31; const bool hp = (t0 + r31) > 0;
            f32x16 acc;
#pragma unroll
            for (int r = 0; r < 16; ++r) acc[r] = 0.f;
#pragma unroll
            for (int ks = 0; ks < 4; ++ks) { const int col = PC_WD + mat * 64 + 16 * ks + 8 * hh; float x8[8];
                lerp8(P + row * LDP + col, P + (row - 1) * LDP + col, hp, mu + 3072 + mat * 64 + 16 * ks + 8 * hh, x8);
                if (mat == 0) {
#pragma unroll
                    for (int j = 0; j < 8; ++j) x8[j] = tanhf_(x8[j]); }
                u32x4 t; t.x = cvt_pk_bf16(x8[0], x8[1]); t.y = cvt_pk_bf16(x8[2], x8[3]); t.z = cvt_pk_bf16(x8[4], x8[5]); t.w = cvt_pk_bf16(x8[6], x8[7]);
                acc = __builtin_amdgcn_mfma_f32_32x32x16_bf16(__builtin_bit_cast(bf16x8, t), bfr[ks], acc, 0, 0, 0); }
            LAS float* dst = L + (mat ? RW_LA : RW_LW);
#pragma unroll
            for (int r = 0; r < 16; ++r) { const int tl = (r & 3) + 8 * (r >> 2) + 4 * hh; dst[tl * 64 + 32 * nt2 + r31] = acc[r]; } }
        __syncthreads();
#pragma unroll
        for (int q = 0; q < 4; ++q) { const int tl = wave * 4 + q; const size_t row = rowbase + tl; const bool hp = (t0 + tl) > 0; const int hj = h * 64 + lane;
            const bf16_t* pc = P + row * LDP; const bf16_t* pp = pc - LDP;
            float r = bf2f(pc[PC_R + hj]), k = bf2f(pc[PC_K + hj]), v = bf2f(pc[PC_V + hj]);
            const float pr = hp ? bf2f(pp[PC_R + hj]) : 0.f, pk = hp ? bf2f(pp[PC_K + hj]) : 0.f, pv = hp ? bf2f(pp[PC_V + hj]) : 0.f;
            r += (pr - r) * mu[hj]; k += (pk - k) * mu[1024 + hj]; v += (pv - v) * mu[2048 + hj];
            const RwTok o = rw_token(a, hj, r, k, v, L[RW_LW + tl * 64 + lane], L[RW_LA + tl * 64 + lane]);
            L[RW_KK + tl * 64 + lane] = o.kk; L[RW_DR + tl * 64 + lane] = o.dr; L[RW_DD + tl * 64 + lane] = o.dd; L[RW_BB + tl * 64 + lane] = o.bb; L[RW_KP + tl * 64 + lane] = o.kp;
            if ((lane >> 5) == half) L[RW_VV + tl * 32 + (lane & 31)] = o.v;
            if (lane == 0) { L[RW_SC + tl * 4] = o.br; L[RW_SC + tl * 4 + 1] = o.kr; L[RW_SC + tl * 4 + 2] = o.bonus; } }
        __syncthreads();
#pragma unroll 4
        for (int tl = 0; tl < RW_TB; ++tl) {
            const f32x4 kk4 = *(const LAS f32x4*)(L + RW_KK + tl * 64 + 4 * cq), dr4 = *(const LAS f32x4*)(L + RW_DR + tl * 64 + 4 * cq), d4 = *(const LAS f32x4*)(L + RW_DD + tl * 64 + 4 * cq),
                        b4 = *(const LAS f32x4*)(L + RW_BB + tl * 64 + 4 * cq), k4 = *(const LAS f32x4*)(L + RW_KP + tl * 64 + 4 * cq);
            const float v = L[RW_VV + tl * 32 + srow]; const f32x4 sc = *(const LAS f32x4*)(L + RW_SC + tl * 4);
            float p1 = (S[0] * kk4[0] + S[1] * kk4[1]) + (S[2] * kk4[2] + S[3] * kk4[3]);
            float p2 = (S[0] * dr4[0] + S[1] * dr4[1]) + (S[2] * dr4[2] + S[3] * dr4[3]);
            p1 = row16_sum(p1); p2 = row16_sum(p2);
            const float sa = -p1;
            const float o = p2 + sa * sc[0] + v * sc[1];
#pragma unroll
            for (int j = 0; j < 4; ++j) S[j] = S[j] * d4[j] + sa * b4[j] + v * k4[j];
            if (cq == 0) { L[RW_OB + tl * 32 + srow] = o; L[RW_BVB + tl * 32 + srow] = sc[2] * v; }
        }
        __syncthreads();
        { const int tl = tid >> 4, r2 = 2 * (tid & 15); const size_t off = (rowbase + tl) * 1024 + h * 64 + 32 * half + r2;
          *(unsigned*)(ORAW + off) = cvt_pk_bf16(L[RW_OB + tl * 32 + r2], L[RW_OB + tl * 32 + r2 + 1]);
          *(unsigned*)(BV + off) = cvt_pk_bf16(L[RW_BVB + tl * 32 + r2], L[RW_BVB + tl * 32 + r2 + 1]); }
    }
    *(f32x4*)(a.out + OUT_WKV_P + (((size_t)(b * 16 + h) * 64 + 32 * half + srow) * 64 + 4 * cq)) = S;
    __syncthreads();
}


constexpr int RC_LD = 72, RC_MAT = 64 * RC_LD * 2;
constexpr int RC_QK = 0 * RC_MAT, RC_RT = 1 * RC_MAT, RC_KT = 2 * RC_MAT, RC_BT = 3 * RC_MAT, RC_QKT = 4 * RC_MAT, RC_BHT = 5 * RC_MAT, RC_KHT = 6 * RC_MAT, RC_VT = 7 * RC_MAT,
              RC_AKK = 8 * RC_MAT, RC_ARK = 9 * RC_MAT, RC_ARB = 10 * RC_MAT, RC_TB = 11 * RC_MAT, RC_AKB = 12 * RC_MAT, RC_W1T = 12 * RC_MAT, RC_U1T = 13 * RC_MAT,
              RC_AVT = RC_QK, RC_TF = RC_KT, RC_LWA = RC_AKK, RC_SEG = 14 * RC_MAT;
static_assert(RC_SEG + 2048 <= RING_BYTES, "rwkv chunk lds");
constexpr int RS_ROWB = 656, RS_BASE = 0;
static_assert(RS_BASE + 65 * RS_ROWB <= RC_AKK, "staging must stay inside R0..R7");
#define MFMA32(a, b, c) __builtin_amdgcn_mfma_f32_32x32x16_bf16((a), (b), (c), 0, 0, 0)
#define MFMA16(a, b, c) __builtin_amdgcn_mfma_f32_16x16x32_bf16((a), (b), (c), 0, 0, 0)
__device__ __forceinline__ bf16x8 lds_frag(LAS unsigned char* lds, int mat, int row, int k0) { return *(const LAS bf16x8*)(lds + mat + (row * RC_LD + k0) * 2); }

__device__ __forceinline__ void p3_rwkv_chunks(const Args& a, LAS unsigned char* lds, int bh, int seg, int tid, int wave, int lane) {
    const int b = bh >> 4, h = bh & 15, r31_ = lane & 31, hh_ = lane >> 5, hj = h * 64 + lane;
    const bf16_t* P = (const bf16_t*)(a.ws + WS_P);
    bf16_t* BV = (bf16_t*)((unsigned char*)a.out + DO_BV);
    const float* mu = a.in[I_MU];
    LAS float* SEG = (LAS float*)(lds + RC_SEG);
    bf16x8 bfr[4];
    { const float* W2 = (wave >> 2) ? a.in[I_A2] : a.in[I_W2]; const int col = h * 64 + 32 * (wave & 1) + r31_;
#pragma unroll
      for (int ks = 0; ks < 4; ++ks) { float w[8];
#pragma unroll
          for (int j = 0; j < 8; ++j) w[j] = W2[(size_t)(16 * ks + 8 * hh_ + j) * 1024 + col];
          u32x4 t; t.x = cvt_pk_bf16(w[0], w[1]); t.y = cvt_pk_bf16(w[2], w[3]); t.z = cvt_pk_bf16(w[4], w[5]); t.w = cvt_pk_bf16(w[6], w[7]); bfr[ks] = __builtin_bit_cast(bf16x8, t); } }
    const float w0j = a.in[I_W0][hj], a0j = a.in[I_A0][hj], kkj = a.in[I_KK][hj], kaj = a.in[I_KA][hj], rkj = a.in[I_RK][hj];
    const float mur = mu[hj], muk = mu[1024 + hj], muv = mu[2048 + hj];
    unsigned goff[6], loff[6]; u32x4 pf[6];
#pragma unroll
    for (int i = 0; i < 6; ++i) { const int idx = tid + 512 * i, row = idx / 40, c = idx - row * 40;
        const int col = (c < 8) ? PC_R + h * 64 + 8 * c : ((c < 16) ? PC_K + h * 64 + 8 * (c - 8) : ((c < 24) ? PC_V + h * 64 + 8 * (c - 16) : PC_WD + 8 * (c - 24)));
        goff[i] = (unsigned)(row * LDP + col) * 2u; loff[i] = (unsigned)(RS_BASE + row * RS_ROWB + c * 16); }
#define RWC_PREFETCH(chunk_) do { const unsigned char* pb_ = (const unsigned char*)(P + ((size_t)b * SEQ + (size_t)(chunk_) * 64 - 1) * LDP); \
        _Pragma("unroll") for (int i = 0; i < 6; ++i) { const bool ok_ = (tid + 512 * i < 2600) && ((chunk_) > 0 || tid + 512 * i >= 40); \
            pf[i] = (u32x4){0u, 0u, 0u, 0u}; if (ok_) pf[i] = *(const u32x4*)(pb_ + goff[i]); } } while (0)
    RWC_PREFETCH(seg * 8);
#pragma unroll 1
    for (int ci = 0; ci < 8; ++ci) {
        const int chunk = seg * 8 + ci; const size_t rowbase = (size_t)b * SEQ + chunk * 64;
#pragma unroll
        for (int i = 0; i < 6; ++i) if (tid + 512 * i < 2600) *(LAS u32x4*)(lds + loff[i]) = pf[i];
        if (ci + 1 < 8) RWC_PREFETCH(chunk + 1);
        __syncthreads();
        int r31 = r31_, hh = hh_; asm volatile("" : "+v"(r31), "+v"(hh));
        unsigned char* rwi = a.ws + WS_RWI + (size_t)((bh * 32) + chunk) * RWI_BYTES;
        { const int mat = wave >> 2, mtile = (wave >> 1) & 1, nt2 = wave & 1; const int tl = 32 * mtile + r31;
          f32x16 acc;
#pragma unroll
          for (int r = 0; r < 16; ++r) acc[r] = 0.f;
#pragma unroll
          for (int ks = 0; ks < 4; ++ks) { float x8[8];
              { const u32x4 c = *(const LAS u32x4*)(lds + RS_BASE + (tl + 1) * RS_ROWB + (24 + mat * 8 + 2 * ks + hh) * 16), p = *(const LAS u32x4*)(lds + RS_BASE + tl * RS_ROWB + (24 + mat * 8 + 2 * ks + hh) * 16);
                const float cf[8] = {bf_lo(c.x), bf_hi(c.x), bf_lo(c.y), bf_hi(c.y), bf_lo(c.z), bf_hi(c.z), bf_lo(c.w), bf_hi(c.w)};
                const float pf8[8] = {bf_lo(p.x), bf_hi(p.x), bf_lo(p.y), bf_hi(p.y), bf_lo(p.z), bf_hi(p.z), bf_lo(p.w), bf_hi(p.w)};
                const float* mp = mu + 3072 + mat * 64 + 16 * ks + 8 * hh; const f32x4 m0 = *(const f32x4*)mp, m1 = *(const f32x4*)(mp + 4);
                const float mf[8] = {m0[0], m0[1], m0[2], m0[3], m1[0], m1[1], m1[2], m1[3]};
#pragma unroll
                for (int j = 0; j < 8; ++j) x8[j] = cf[j] + (pf8[j] - cf[j]) * mf[j]; }
              if (mat == 0) {
#pragma unroll
                  for (int j = 0; j < 8; ++j) x8[j] = tanhf_(x8[j]); }
              u32x4 t; t.x = cvt_pk_bf16(x8[0], x8[1]); t.y = cvt_pk_bf16(x8[2], x8[3]); t.z = cvt_pk_bf16(x8[4], x8[5]); t.w = cvt_pk_bf16(x8[6], x8[7]);
              acc = MFMA32(__builtin_bit_cast(bf16x8, t), bfr[ks], acc); }
          LAS float* dst = (LAS float*)(lds + RC_LWA) + mat * 64 * 68;
#pragma unroll
          for (int r = 0; r < 16; ++r) { const int t2 = 32 * mtile + (r & 3) + 8 * (r >> 2) + 4 * hh; dst[t2 * 68 + 32 * nt2 + r31] = acc[r]; } }
        __syncthreads();
        float r8[8], kp8[8], kk8[8], bb8[8], v8[8], ld8[8], cs8[8];
        { const LAS float* LW = (const LAS float*)(lds + RC_LWA); const LAS float* LA = LW + 64 * 68;
#pragma unroll
          for (int q = 0; q < 8; ++q) { const int tl = 8 * wave + q; const size_t row = rowbase + tl;
              const LAS bf16_t* pc = (const LAS bf16_t*)(lds + RS_BASE + (tl + 1) * RS_ROWB); const LAS bf16_t* pp = (const LAS bf16_t*)(lds + RS_BASE + tl * RS_ROWB);
              float r = bf2f(pc[lane]), k = bf2f(pc[64 + lane]), v = bf2f(pc[128 + lane]);
              const float pr = bf2f(pp[lane]), pk = bf2f(pp[64 + lane]), pv = bf2f(pp[128 + lane]);
              r += (pr - r) * mur; k += (pk - k) * muk; v += (pv - v) * muv;
              ld8[q] = -0.6065306597126334f * sigmoidf_(w0j + LW[tl * 68 + lane]);
              const float av = sigmoidf_(a0j + LA[tl * 68 + lane]);
              const float kkv = k * kkj; const float rn = fminf(__builtin_amdgcn_rsqf(wave_sum_dpp(kkv * kkv)), 1e12f);
              kk8[q] = kkv * rn; kp8[q] = k * (1.0f + (av - 1.0f) * kaj); bb8[q] = kk8[q] * av; r8[q] = r; v8[q] = v;
              const float bonus = wave_sum_dpp(r * kp8[q] * rkj);
              BV[row * 1024 + hj] = f2bf(bonus * v); }
          cs8[0] = ld8[0];
#pragma unroll
          for (int q = 1; q < 8; ++q) cs8[q] = cs8[q - 1] + ld8[q];
          SEG[wave * 64 + lane] = cs8[7]; }
        __syncthreads();
        { float off = 0.f, cL = 0.f;
#pragma unroll
          for (int w2 = 0; w2 < 8; ++w2) { const float sg = SEG[w2 * 64 + lane]; cL += sg; if (w2 < wave) off += sg; }
          if (wave == 0) *(float*)(rwi + RWI_LAM + lane * 4) = __expf(cL);
          float qkT[8], bhT[8], khT[8];
          const float eLtot = __expf(cL); float ecprev = __expf(off);
#pragma unroll
          for (int q = 0; q < 8; ++q) { const int tl = 8 * wave + q; const float c = off + cs8[q];
              const float ec = __expf(c), ecp = ecprev, enc = rcpf_(ec), eL = eLtot * enc; ecprev = ec;
              const float qk = kk8[q] * ecp;
              ((LAS bf16_t*)(lds + RC_QK))[tl * RC_LD + lane] = f2bf(qk); ((LAS bf16_t*)(lds + RC_RT))[tl * RC_LD + lane] = f2bf(r8[q] * ec);
              ((LAS bf16_t*)(lds + RC_KT))[tl * RC_LD + lane] = f2bf(kp8[q] * enc); ((LAS bf16_t*)(lds + RC_BT))[tl * RC_LD + lane] = f2bf(bb8[q] * enc);
              qkT[q] = qk; bhT[q] = bb8[q] * eL; khT[q] = kp8[q] * eL; }
          u32x4 t;
          t.x = cvt_pk_bf16(qkT[0], qkT[1]); t.y = cvt_pk_bf16(qkT[2], qkT[3]); t.z = cvt_pk_bf16(qkT[4], qkT[5]); t.w = cvt_pk_bf16(qkT[6], qkT[7]); *(LAS u32x4*)(lds + RC_QKT + (lane * RC_LD + 8 * wave) * 2) = t;
          t.x = cvt_pk_bf16(bhT[0], bhT[1]); t.y = cvt_pk_bf16(bhT[2], bhT[3]); t.z = cvt_pk_bf16(bhT[4], bhT[5]); t.w = cvt_pk_bf16(bhT[6], bhT[7]); *(LAS u32x4*)(lds + RC_BHT + (lane * RC_LD + 8 * wave) * 2) = t;
          t.x = cvt_pk_bf16(khT[0], khT[1]); t.y = cvt_pk_bf16(khT[2], khT[3]); t.z = cvt_pk_bf16(khT[4], khT[5]); t.w = cvt_pk_bf16(khT[6], khT[7]); *(LAS u32x4*)(lds + RC_KHT + (lane * RC_LD + 8 * wave) * 2) = t;
          t.x = cvt_pk_bf16(v8[0], v8[1]); t.y = cvt_pk_bf16(v8[2], v8[3]); t.z = cvt_pk_bf16(v8[4], v8[5]); t.w = cvt_pk_bf16(v8[6], v8[7]); *(LAS u32x4*)(lds + RC_VT + (lane * RC_LD + 8 * wave) * 2) = t; }
        __syncthreads();
#pragma unroll
        for (int jr = 0; jr < 2; ++jr) { const int job = wave + 8 * jr; if (job < 12) {
            const int mat = job / 3, tt = job % 3, ms = (tt == 2) ? 1 : 0, nt2 = (tt == 0) ? 0 : 1;
            const int X = (mat & 1) ? RC_BT : RC_KT, Y = (mat & 2) ? RC_RT : RC_QK;
            f32x16 acc;
#pragma unroll
            for (int r = 0; r < 16; ++r) acc[r] = 0.f;
#pragma unroll
            for (int ks = 0; ks < 4; ++ks) acc = MFMA32(lds_frag(lds, X, 32 * ms + r31, 16 * ks + 8 * hh), lds_frag(lds, Y, 32 * nt2 + r31, 16 * ks + 8 * hh), acc);
            const int t = 32 * nt2 + r31; const bool incl = (mat & 2) != 0;
#pragma unroll
            for (int g4 = 0; g4 < 4; ++g4) { const int s0 = 32 * ms + 8 * g4 + 4 * hh; float v[4];
#pragma unroll
                for (int e = 0; e < 4; ++e) { const int sx = s0 + e; v[e] = (incl ? (sx <= t) : (sx < t)) ? acc[4 * g4 + e] : 0.f; }
                if (mat == 1) *(LAS f32x4*)(lds + RC_AKB + (t * 72 + s0) * 4) = (f32x4){v[0], v[1], v[2], v[3]};
                else { const int dstm = (mat == 0) ? RC_AKK : ((mat == 2) ? RC_ARK : RC_ARB); *(LAS u32x2*)(lds + dstm + (t * RC_LD + s0) * 2) = pack4(v[0], v[1], v[2], v[3]); } } } }
        __syncthreads();
        LAS float* TF = (LAS float*)(lds + RC_TF); const LAS float* AKB = (const LAS float*)(lds + RC_AKB); LAS float* YS = SEG;
        if (wave == 0) {
            const int I = lane >> 4, jj = lane & 15; float x[16];
#pragma unroll
            for (int r = 0; r < 16; ++r) { float sacc = (r == jj) ? 1.f : 0.f;
#pragma unroll
                for (int q = 0; q < r; ++q) sacc -= AKB[(16 * I + r) * 72 + 16 * I + q] * x[q];
                x[r] = sacc; TF[(16 * I + r) * 72 + 16 * I + jj] = sacc; }
        } else if (wave < 4) {
            const int t2 = tid - 64;
            for (int e = t2; e < 512; e += 192) { const int blk = e >> 8, rr = (e >> 4) & 15, cc = e & 15; TF[(32 * blk + rr) * 72 + 32 * blk + 16 + cc] = 0.f; }
        } else {
            const int mt = (wave >> 1) & 1, nt2 = wave & 1; f32x16 acc;
#pragma unroll
            for (int r = 0; r < 16; ++r) acc[r] = 0.f;
#pragma unroll
            for (int ks = 0; ks < 4; ++ks) if (ks < 2 || mt == 1) acc = MFMA32(lds_frag(lds, RC_AKK, 32 * mt + r31, 16 * ks + 8 * hh), lds_frag(lds, RC_VT, 32 * nt2 + r31, 16 * ks + 8 * hh), acc);
#pragma unroll
            for (int g4 = 0; g4 < 4; ++g4) *(LAS u32x2*)(lds + RC_AVT + ((32 * nt2 + r31) * RC_LD + 32 * mt + 8 * g4 + 4 * hh) * 2) = pack4(acc[4 * g4], acc[4 * g4 + 1], acc[4 * g4 + 2], acc[4 * g4 + 3]);
        }
        __syncthreads();
        { const int pr = tid >> 8, i = (tid >> 4) & 15, jj = tid & 15, ba = 2 * pr, bb = 2 * pr + 1;
          float y = 0.f;
#pragma unroll
          for (int q = 0; q < 16; ++q) y += AKB[(16 * bb + i) * 72 + 16 * ba + q] * TF[(16 * ba + q) * 72 + 16 * ba + jj];
          YS[tid] = y; }
        __syncthreads();
        { const int pr = tid >> 8, i = (tid >> 4) & 15, jj = tid & 15, ba = 2 * pr, bb = 2 * pr + 1; float tv = 0.f;
#pragma unroll
          for (int q = 0; q < 16; ++q) tv -= TF[(16 * bb + i) * 72 + 16 * bb + q] * YS[pr * 256 + q * 16 + jj];
          TF[(16 * bb + i) * 72 + 16 * ba + jj] = tv; }
        __syncthreads();
        { const int i = tid >> 4, j0 = (tid & 15) * 2; float z0 = 0.f, z1 = 0.f;
#pragma unroll 8
          for (int q = 0; q < 32; ++q) { const float av = AKB[(32 + i) * 72 + q]; z0 += av * TF[q * 72 + j0]; z1 += av * TF[q * 72 + j0 + 1]; }
          __syncthreads();
          TF[i * 72 + 32 + j0] = z0; TF[i * 72 + 32 + j0 + 1] = z1; }
        __syncthreads();
        { const int i = tid >> 4, j0 = (tid & 15) * 2; float t0 = 0.f, t1 = 0.f;
#pragma unroll 8
          for (int q = 0; q < 32; ++q) { const float tb = TF[(32 + i) * 72 + 32 + q]; t0 -= tb * TF[q * 72 + 32 + j0]; t1 -= tb * TF[q * 72 + 32 + j0 + 1]; }
          TF[(32 + i) * 72 + j0] = t0; TF[(32 + i) * 72 + j0 + 1] = t1; }
        __syncthreads();
        { const int t = tid >> 3, c0 = (tid & 7) * 8; const f32x4 x0 = *(const LAS f32x4*)(TF + t * 72 + c0), x1 = *(const LAS f32x4*)(TF + t * 72 + c0 + 4);
          u32x4 w; w.x = cvt_pk_bf16(x0[0], x0[1]); w.y = cvt_pk_bf16(x0[2], x0[3]); w.z = cvt_pk_bf16(x1[0], x1[1]); w.w = cvt_pk_bf16(x1[2], x1[3]);
          *(LAS u32x4*)(lds + RC_TB + (t * RC_LD + c0) * 2) = w; }
        __syncthreads();
        { const int which = wave >> 2, mt = (wave >> 1) & 1, nt2 = wave & 1; const int Bm = which ? RC_AVT : RC_QKT, Dm = which ? RC_U1T : RC_W1T; f32x16 acc;
#pragma unroll
          for (int r = 0; r < 16; ++r) acc[r] = 0.f;
#pragma unroll
          for (int ks = 0; ks < 4; ++ks) if (ks < 2 || mt == 1) acc = MFMA32(lds_frag(lds, RC_TB, 32 * mt + r31, 16 * ks + 8 * hh), lds_frag(lds, Bm, 32 * nt2 + r31, 16 * ks + 8 * hh), acc);
#pragma unroll
          for (int g4 = 0; g4 < 4; ++g4) *(LAS u32x2*)(lds + Dm + ((32 * nt2 + r31) * RC_LD + 32 * mt + 8 * g4 + 4 * hh) * 2) = pack4(acc[4 * g4], acc[4 * g4 + 1], acc[4 * g4 + 2], acc[4 * g4 + 3]); }
        __syncthreads();
        { const int kind = wave >> 2, mt = (wave >> 1) & 1, nt2 = wave & 1; const int cidx = 32 * nt2 + r31;
          f32x16 acc;
#pragma unroll
          for (int r = 0; r < 16; ++r) acc[r] = 0.f;
          if (kind == 0) {
#pragma unroll
              for (int ks = 0; ks < 4; ++ks) acc = MFMA32(lds_frag(lds, RC_W1T, 32 * mt + r31, 16 * ks + 8 * hh), lds_frag(lds, RC_BHT, cidx, 16 * ks + 8 * hh), acc);
#pragma unroll
              for (int g4 = 0; g4 < 4; ++g4) { const int jo = 8 * g4 + 4 * hh, half = jo >> 4, q2 = (jo & 15) >> 2; const int blk = (cidx >> 4) * 2 + mt, lane2 = (cidx & 15) + 16 * q2;
                  *(u32x2*)(rwi + RWI_GF + (blk * 64 + lane2) * 16 + half * 8) = pack4(-acc[4 * g4], -acc[4 * g4 + 1], -acc[4 * g4 + 2], -acc[4 * g4 + 3]); }
          } else {
#pragma unroll
              for (int ks = 0; ks < 4; ++ks) if (ks < 2 || nt2 == 1) acc = MFMA32(lds_frag(lds, RC_W1T, 32 * mt + r31, 16 * ks + 8 * hh), lds_frag(lds, RC_ARB, cidx, 16 * ks + 8 * hh), acc);
#pragma unroll
              for (int g4 = 0; g4 < 4; ++g4) { const int jo = 8 * g4 + 4 * hh, half = jo >> 4, q2 = (jo & 15) >> 2; const int blk = (cidx >> 4) * 2 + mt, lane2 = (cidx & 15) + 16 * q2;
                  const u32x2 rt = *(const LAS u32x2*)(lds + RC_RT + (cidx * RC_LD + 32 * mt + jo) * 2);
                  *(u32x2*)(rwi + RWI_W2F + (blk * 64 + lane2) * 16 + half * 8) = pack4(bf_lo(rt.x) - acc[4 * g4], bf_hi(rt.x) - acc[4 * g4 + 1], bf_lo(rt.y) - acc[4 * g4 + 2], bf_hi(rt.y) - acc[4 * g4 + 3]); }
          }
          f32x16 ac1, ac2;
#pragma unroll
          for (int r = 0; r < 16; ++r) { ac1[r] = 0.f; ac2[r] = 0.f; }
          if (kind == 0) {
#pragma unroll
              for (int ks = 0; ks < 4; ++ks) { ac1 = MFMA32(lds_frag(lds, RC_KHT, 32 * mt + r31, 16 * ks + 8 * hh), lds_frag(lds, RC_VT, cidx, 16 * ks + 8 * hh), ac1);
                                               ac2 = MFMA32(lds_frag(lds, RC_BHT, 32 * mt + r31, 16 * ks + 8 * hh), lds_frag(lds, RC_U1T, cidx, 16 * ks + 8 * hh), ac2); }
#pragma unroll
              for (int g4 = 0; g4 < 4; ++g4) { const int ro = 32 * mt + 8 * g4 + 4 * hh, mt2 = ro >> 4, q2 = (ro & 15) >> 2, cb = cidx >> 4, lane2 = (cidx & 15) + 16 * q2;
                  *(f32x4*)(rwi + RWI_H1F + ((cb * 4 + mt2) * 64 + lane2) * 16) = (f32x4){ac1[4 * g4] - ac2[4 * g4], ac1[4 * g4 + 1] - ac2[4 * g4 + 1], ac1[4 * g4 + 2] - ac2[4 * g4 + 2], ac1[4 * g4 + 3] - ac2[4 * g4 + 3]}; }
          } else {
#pragma unroll
              for (int ks = 0; ks < 4; ++ks) if (ks < 2 || nt2 == 1) { ac1 = MFMA32(lds_frag(lds, RC_VT, 32 * mt + r31, 16 * ks + 8 * hh), lds_frag(lds, RC_ARK, cidx, 16 * ks + 8 * hh), ac1);
                                                                        ac2 = MFMA32(lds_frag(lds, RC_U1T, 32 * mt + r31, 16 * ks + 8 * hh), lds_frag(lds, RC_ARB, cidx, 16 * ks + 8 * hh), ac2); }
#pragma unroll
              for (int g4 = 0; g4 < 4; ++g4) { const int ro = 32 * mt + 8 * g4 + 4 * hh, cb = ro >> 4, q2 = (ro & 15) >> 2, nt3 = cidx >> 4, lane2 = (cidx & 15) + 16 * q2;
                  *(f32x4*)(rwi + RWI_O1F + ((cb * 4 + nt3) * 64 + lane2) * 16) = (f32x4){ac1[4 * g4] - ac2[4 * g4], ac1[4 * g4 + 1] - ac2[4 * g4 + 1], ac1[4 * g4 + 2] - ac2[4 * g4 + 2], ac1[4 * g4 + 3] - ac2[4 * g4 + 3]}; }
          } }
        __syncthreads();
    }
}

__device__ __forceinline__ void p3_rwkv_seq(const Args& a, int unit, int lane) {
    const int bh = unit >> 2, cb = unit & 3, b = bh >> 4, h = bh & 15, l15 = lane & 15, q = lane >> 4;
    bf16_t* ORAW = (bf16_t*)((unsigned char*)a.out + DO_ORAW);
    f32x4 hacc[4];
#pragma unroll
    for (int m = 0; m < 4; ++m) hacc[m] = (f32x4){0.f, 0.f, 0.f, 0.f};
    const unsigned char* base = a.ws + WS_RWI + (size_t)(bh * 32) * RWI_BYTES;
    bf16x8 gf[8]; f32x4 h1[4], lam[4];
#define RW2_LOADG(src) do { _Pragma("unroll") for (int k2 = 0; k2 < 8; ++k2) gf[k2] = *(const bf16x8*)((src) + RWI_GF + (k2 * 64 + lane) * 16); \
        _Pragma("unroll") for (int m = 0; m < 4; ++m) { h1[m] = *(const f32x4*)((src) + RWI_H1F + ((cb * 4 + m) * 64 + lane) * 16); lam[m] = *(const f32x4*)((src) + RWI_LAM + (16 * m + 4 * q) * 4); } } while (0)
    RW2_LOADG(base);
#pragma unroll 1
    for (int c = 0; c < 32; ++c) {
        const unsigned char* cur = base + (size_t)c * RWI_BYTES;
        bf16x8 w2f[8]; f32x4 o1[4];
#pragma unroll
        for (int k2 = 0; k2 < 8; ++k2) w2f[k2] = *(const bf16x8*)(cur + RWI_W2F + (k2 * 64 + lane) * 16);
#pragma unroll
        for (int n = 0; n < 4; ++n) o1[n] = *(const f32x4*)(cur + RWI_O1F + ((cb * 4 + n) * 64 + lane) * 16);
        bf16x8 hb[2];
#pragma unroll
        for (int ks = 0; ks < 2; ++ks) { u32x4 t; t.x = cvt_pk_bf16(hacc[2 * ks][0], hacc[2 * ks][1]); t.y = cvt_pk_bf16(hacc[2 * ks][2], hacc[2 * ks][3]);
            t.z = cvt_pk_bf16(hacc[2 * ks + 1][0], hacc[2 * ks + 1][1]); t.w = cvt_pk_bf16(hacc[2 * ks + 1][2], hacc[2 * ks + 1][3]); hb[ks] = __builtin_bit_cast(bf16x8, t); }
        f32x4 nacc[4];
#pragma unroll
        for (int m = 0; m < 4; ++m) { nacc[m] = h1[m] + lam[m] * hacc[m];
#pragma unroll
            for (int ks = 0; ks < 2; ++ks) nacc[m] = MFMA16(gf[m * 2 + ks], hb[ks], nacc[m]); }
        if (c + 1 < 32) RW2_LOADG(cur + RWI_BYTES);
#pragma unroll
        for (int n = 0; n < 4; ++n) { f32x4 oacc = o1[n];
#pragma unroll
            for (int ks = 0; ks < 2; ++ks) oacc = MFMA16(hb[ks], w2f[n * 2 + ks], oacc);
            *(u32x2*)(ORAW + ((size_t)b * SEQ + c * 64 + 16 * n + l15) * 1024 + h * 64 + 16 * cb + 4 * q) = pack4(oacc[0], oacc[1], oacc[2], oacc[3]); }
#pragma unroll
        for (int m = 0; m < 4; ++m) hacc[m] = nacc[m];
    }
#undef RW2_LOADG
#pragma unroll
    for (int m = 0; m < 4; ++m) *(f32x4*)(a.out + OUT_WKV_P + (((size_t)bh * 64 + 16 * cb + l15) * 64 + 16 * m + 4 * q)) = hacc[m];
}

__device__ __forceinline__ void p3_rwkv_sample(const Args& a, LAS unsigned char* lds, int bs, int h, int wave, int lane) {
    LAS float* Lw = (LAS float*)lds + wave * 768;
    const bf16_t* P = (const bf16_t*)(a.ws + WS_P);
    const bf16_t* pc = P + (size_t)(MP + bs) * LDP; const bf16_t* pp = P + (size_t)(MV + bs) * LDP;
    bf16_t* A2 = (bf16_t*)(a.ws + WS_XN);
    const float* mu = a.in[I_MU];
    const int hj = h * 64 + lane, rg = lane >> 4, cq = lane & 15;
    const size_t sbase = ((size_t)(bs * 16 + h) * 64) * 64;
    const float* S0 = a.in[I_WKV] + sbase; float* S1 = a.out + OUT_WKV_S + sbase;
    f32x4 S[16];
#pragma unroll
    for (int it = 0; it < 16; ++it) S[it] = *(const f32x4*)(S0 + (size_t)(4 * it + rg) * 64 + 4 * cq);
    { float wd = bf2f(pc[PC_WD + lane]), ad = bf2f(pc[PC_AD + lane]); wd += (bf2f(pp[PC_WD + lane]) - wd) * mu[3072 + lane]; ad += (bf2f(pp[PC_AD + lane]) - ad) * mu[3136 + lane];
      Lw[lane] = tanhf_(wd); Lw[64 + lane] = ad; }
    LDS_WAIT();
    float lw = 0.f, la = 0.f;
#pragma unroll 16
    for (int m = 0; m < 64; ++m) { lw += Lw[m] * a.in[I_W2][(size_t)m * 1024 + hj]; la += Lw[64 + m] * a.in[I_A2][(size_t)m * 1024 + hj]; }
    float r = bf2f(pc[PC_R + hj]), k = bf2f(pc[PC_K + hj]), v = bf2f(pc[PC_V + hj]);
    r += (bf2f(pp[PC_R + hj]) - r) * mu[hj]; k += (bf2f(pp[PC_K + hj]) - k) * mu[1024 + hj]; v += (bf2f(pp[PC_V + hj]) - v) * mu[2048 + hj];
    const RwTok o = rw_token(a, hj, r, k, v, lw, la);
    Lw[128 + lane] = o.kk; Lw[192 + lane] = o.dr; Lw[256 + lane] = o.dd; Lw[320 + lane] = o.bb; Lw[384 + lane] = o.kp; Lw[448 + lane] = o.v;
    LDS_WAIT();
    const f32x4 kk4 = *(const LAS f32x4*)(Lw + 128 + 4 * cq), dr4 = *(const LAS f32x4*)(Lw + 192 + 4 * cq), d4 = *(const LAS f32x4*)(Lw + 256 + 4 * cq), b4 = *(const LAS f32x4*)(Lw + 320 + 4 * cq), k4 = *(const LAS f32x4*)(Lw + 384 + 4 * cq);
#pragma unroll
    for (int it = 0; it < 16; ++it) { const int i = 4 * it + rg; const float vi = Lw[448 + i];
        float p1 = (S[it][0] * kk4[0] + S[it][1] * kk4[1]) + (S[it][2] * kk4[2] + S[it][3] * kk4[3]);
        float p2 = (S[it][0] * dr4[0] + S[it][1] * dr4[1]) + (S[it][2] * dr4[2] + S[it][3] * dr4[3]);
        p1 = row16_sum(p1); p2 = row16_sum(p2);
        const float sa = -p1, ov = p2 + sa * o.br + vi * o.kr;
        f32x4 Sn;
#pragma unroll
        for (int j = 0; j < 4; ++j) Sn[j] = S[it][j] * d4[j] + sa * b4[j] + vi * k4[j];
        *(f32x4*)(S1 + (size_t)i * 64 + 4 * cq) = Sn;
        if (cq == 0) Lw[512 + i] = ov; }
    LDS_WAIT();
    const float ov = Lw[512 + lane];
    const float mean = wave_sum_dpp(ov) * (1.0f / 64.0f); const float dv = ov - mean; const float var = wave_sum_dpp(dv * dv) * (1.0f / 64.0f);
    float on = dv * rsqrtf(var + GN_EPS) * a.in[I_GNW][hj] + a.in[I_GNB][hj] + o.bonus * o.v;
    on *= bf2f(pc[PC_ZR + hj]);
    A2[(size_t)(MP + bs) * 2048 + 1024 + hj] = f2bf(on);
    LDS_WAIT();
}

constexpr int S5_ELD = 132, S5_XLD = 136;
constexpr int S5_E_OFF = 0, S5_X_OFF = 128 * S5_ELD * 4;
__device__ __forceinline__ bf16x8 ldfrag(const unsigned char* base, int block, int lane) { return *(const bf16x8*)(base + (size_t)block * 1024 + lane * 16); }
__device__ __forceinline__ void p3_s5_prompt(const Args& a, LAS unsigned char* lds, int unit, int tid, int wave, int lane) {
    const int b = unit >> 6, g = unit & 63;
    const unsigned char* tab = (const unsigned char*)a.out + DO_S5TAB + (size_t)g * S5T_BYTES;
    const bf16_t* P = (const bf16_t*)(a.ws + WS_P);
    bf16_t* Yg = (bf16_t*)(a.ws + WS_YG);
    LAS float* EL = (LAS float*)(lds + S5_E_OFF); LAS bf16_t* XL = (LAS bf16_t*)(lds + S5_X_OFF);
    const int nt = wave & 3, hm = wave >> 2, r31 = lane & 31, hh = lane >> 5;
    const int n = 32 * nt + r31;
    { u32x4 tv[10];
#pragma unroll
      for (int i = 0; i < 10; ++i) tv[i] = *(const u32x4*)(tab + S5T_ME + (size_t)(tid + 512 * i) * 16);
#pragma unroll
      for (int i = 0; i < 10; ++i) *(LAS u32x4*)(lds + (tid + 512 * i) * 16) = tv[i]; }
    const bf16_t* ubase = (const bf16_t*)(a.ws + WS_U2) + (((size_t)b * 64 + g) * SEQ + 16 * n) * 16 + 8 * hh;
    bf16x8 bu[16];
#pragma unroll
    for (int s2 = 0; s2 < 16; ++s2) bu[s2] = *(const bf16x8*)(ubase + (size_t)s2 * 16);
    f32x16 accY[4], accE[2];
#pragma unroll
    for (int q = 0; q < 4; ++q)
#pragma unroll
        for (int r = 0; r < 16; ++r) accY[q][r] = 0.f;
#pragma unroll
    for (int q = 0; q < 2; ++q)
#pragma unroll
        for (int r = 0; r < 16; ++r) accE[q][r] = 0.f;
    const int mts[4] = {hm ? 1 : 0, hm ? 2 : 3, hm ? 5 : 4, hm ? 6 : 7};
    __syncthreads();
#pragma unroll
    for (int s2 = 0; s2 < 16; ++s2) {
#pragma unroll
        for (int e = 0; e < 2; ++e) accE[e] = __builtin_amdgcn_mfma_f32_32x32x16_bf16(*(const LAS bf16x8*)(lds + S5T_ME + (((2 * hm + e) * 16 + s2) * 64 + lane) * 16), bu[s2], accE[e], 0, 0, 0);
#pragma unroll
        for (int q = 0; q < 4; ++q) { const int mt = mts[q]; if (s2 <= 2 * mt + 1) accY[q] = __builtin_amdgcn_mfma_f32_32x32x16_bf16(*(const LAS bf16x8*)(lds + S5T_KT + ((2 * mt - s2 + 1) * 64 + lane) * 16), bu[s2], accY[q], 0, 0, 0); }
    }
    __syncthreads();
#pragma unroll
    for (int e = 0; e < 2; ++e)
#pragma unroll
        for (int q4 = 0; q4 < 4; ++q4) { f32x4 v; v[0] = accE[e][4 * q4]; v[1] = accE[e][4 * q4 + 1]; v[2] = accE[e][4 * q4 + 2]; v[3] = accE[e][4 * q4 + 3];
            *(LAS f32x4*)(EL + n * S5_ELD + 32 * (2 * hm + e) + 8 * q4 + 4 * hh) = v; }
    __syncthreads();
    if (wave == 0) { const float* hdr = (const float*)(tab + S5T_HDR); const float ar = hdr[lane], ai = hdr[64 + lane]; float xr = 0.f, xi = 0.f;
#pragma unroll 1
        for (int c0 = 0; c0 < 128; c0 += 16) { float er[16], ei[16];
#pragma unroll
            for (int j = 0; j < 16; ++j) { er[j] = EL[(c0 + j) * S5_ELD + lane]; ei[j] = EL[(c0 + j) * S5_ELD + 64 + lane]; }
#pragma unroll
            for (int j = 0; j < 16; ++j) { XL[(c0 + j) * S5_XLD + lane] = f2bf(xr); XL[(c0 + j) * S5_XLD + 64 + lane] = f2bf(xi);
                const float nr = ar * xr - ai * xi + er[j], ni = ar * xi + ai * xr + ei[j]; xr = nr; xi = ni; } }
        a.out[OUT_S5RE_P + (size_t)(b * 64 + g) * 64 + lane] = xr; a.out[OUT_S5IM_P + (size_t)(b * 64 + g) * 64 + lane] = xi; }
    __syncthreads();
#pragma unroll
    for (int ks = 0; ks < 8; ++ks) { const bf16x8 bx = *(const LAS bf16x8*)(XL + n * S5_XLD + 16 * ks + 8 * hh);
#pragma unroll
        for (int q = 0; q < 4; ++q) accY[q] = __builtin_amdgcn_mfma_f32_32x32x16_bf16(ldfrag(tab + S5T_CA, mts[q] * 8 + ks, lane), bx, accY[q], 0, 0, 0); }
#pragma unroll
    for (int q = 0; q < 4; ++q) { const int mt = mts[q];
#pragma unroll
        for (int q4 = 0; q4 < 4; ++q4) { const int dt = q4 >> 1, c0 = 8 * (q4 & 1) + 4 * hh; const size_t row = (size_t)b * SEQ + 16 * n + 2 * mt + dt;
            u32x2 w; w.x = cvt_pk_bf16(geluf_(accY[q][4 * q4]), geluf_(accY[q][4 * q4 + 1])); w.y = cvt_pk_bf16(geluf_(accY[q][4 * q4 + 2]), geluf_(accY[q][4 * q4 + 3]));
            *(u32x2*)(Yg + row * 1024 + g * 16 + c0) = w; } }
    __syncthreads();
}
__device__ __forceinline__ void p3_s5_sample(const Args& a, int g, int wave, int lane) {
    if (wave >= 4) return;
    const unsigned char* tab = (const unsigned char*)a.out + DO_S5TAB + (size_t)g * S5T_BYTES;
    const float* hdr = (const float*)(tab + S5T_HDR);
    const bf16_t* P = (const bf16_t*)(a.ws + WS_P);
    bf16_t* Yg = (bf16_t*)(a.ws + WS_YG);
    const int r31 = lane & 31, hh = lane >> 5, bs = 32 * wave + r31;
    const bf16x8 bu = *(const bf16x8*)((const bf16_t*)(a.ws + WS_U2S) + ((size_t)g * NSMP + bs) * 16 + 8 * hh);
    f32x16 z;
#pragma unroll
    for (int r = 0; r < 16; ++r) z[r] = 0.f;
    f32x16 x[4];
#pragma unroll
    for (int mtile = 0; mtile < 4; ++mtile) x[mtile] = __builtin_amdgcn_mfma_f32_32x32x16_bf16(ldfrag(tab + S5T_ME, mtile * 16 + 15, lane), bu, z, 0, 0, 0);
    const size_t sb = (size_t)(bs * 64 + g) * 64;
#pragma unroll
    for (int pt = 0; pt < 2; ++pt)
#pragma unroll
        for (int q4 = 0; q4 < 4; ++q4) { const int p0 = 32 * pt + 8 * q4 + 4 * hh;
            const f32x4 x0r = *(const f32x4*)(a.in[I_S5RE] + sb + p0), x0i = *(const f32x4*)(a.in[I_S5IM] + sb + p0);
            const f32x4 ar = *(const f32x4*)(hdr + 128 + p0), ai = *(const f32x4*)(hdr + 192 + p0);
            f32x4 nr, ni;
#pragma unroll
            for (int j = 0; j < 4; ++j) { nr[j] = ar[j] * x0r[j] - ai[j] * x0i[j] + x[pt][4 * q4 + j]; ni[j] = ar[j] * x0i[j] + ai[j] * x0r[j] + x[2 + pt][4 * q4 + j]; x[pt][4 * q4 + j] = nr[j]; x[2 + pt][4 * q4 + j] = ni[j]; }
            *(f32x4*)(a.out + OUT_S5RE_S + sb + p0) = nr; *(f32x4*)(a.out + OUT_S5IM_S + sb + p0) = ni; }
    f32x16 y = __builtin_amdgcn_mfma_f32_32x32x16_bf16(ldfrag(tab + S5T_DF, 0, lane), bu, z, 0, 0, 0);
#pragma unroll
    for (int mtile = 0; mtile < 4; ++mtile)
#pragma unroll
        for (int sp = 0; sp < 2; ++sp) { u32x4 t; t.x = cvt_pk_bf16(x[mtile][8 * sp], x[mtile][8 * sp + 1]); t.y = cvt_pk_bf16(x[mtile][8 * sp + 2], x[mtile][8 * sp + 3]);
            t.z = cvt_pk_bf16(x[mtile][8 * sp + 4], x[mtile][8 * sp + 5]); t.w = cvt_pk_bf16(x[mtile][8 * sp + 6], x[mtile][8 * sp + 7]);
            y = __builtin_amdgcn_mfma_f32_32x32x16_bf16(ldfrag(tab + S5T_C0, mtile * 2 + sp, lane), __builtin_bit_cast(bf16x8, t), y, 0, 0, 0); }
#pragma unroll
    for (int q4 = 0; q4 < 2; ++q4) { const int c0 = 8 * q4 + 4 * hh;
        u32x2 w; w.x = cvt_pk_bf16(geluf_(y[4 * q4]), geluf_(y[4 * q4 + 1])); w.y = cvt_pk_bf16(geluf_(y[4 * q4 + 2]), geluf_(y[4 * q4 + 3]));
        *(u32x2*)(Yg + (size_t)(MP + bs) * 1024 + g * 16 + c0) = w; }
}

__device__ __forceinline__ void p4_rwkv_post8(const Args& a, int item0, int lane) {
    const int item = item0 + (lane >> 3), cg = lane & 7, row = item >> 4, h = item & 15, ch = h * 64 + 8 * cg;
    const bf16_t* ORAW = (const bf16_t*)((const unsigned char*)a.out + DO_ORAW); const bf16_t* BV = (const bf16_t*)((const unsigned char*)a.out + DO_BV);
    const bf16_t* P = (const bf16_t*)(a.ws + WS_P); bf16_t* A2 = (bf16_t*)(a.ws + WS_XN);
    const u32x4 ow = *(const u32x4*)(ORAW + (size_t)row * 1024 + ch), bw = *(const u32x4*)(BV + (size_t)row * 1024 + ch), zw = *(const u32x4*)(P + (size_t)row * LDP + PC_ZR + ch);
    const f32x4 w0 = *(const f32x4*)(a.in[I_GNW] + ch), w1 = *(const f32x4*)(a.in[I_GNW] + ch + 4), b0 = *(const f32x4*)(a.in[I_GNB] + ch), b1 = *(const f32x4*)(a.in[I_GNB] + ch + 4);
    const float o[8] = {bf_lo(ow.x), bf_hi(ow.x), bf_lo(ow.y), bf_hi(ow.y), bf_lo(ow.z), bf_hi(ow.z), bf_lo(ow.w), bf_hi(ow.w)};
    const float bv[8] = {bf_lo(bw.x), bf_hi(bw.x), bf_lo(bw.y), bf_hi(bw.y), bf_lo(bw.z), bf_hi(bw.z), bf_lo(bw.w), bf_hi(bw.w)};
    const float z[8] = {bf_lo(zw.x), bf_hi(zw.x), bf_lo(zw.y), bf_hi(zw.y), bf_lo(zw.z), bf_hi(zw.z), bf_lo(zw.w), bf_hi(zw.w)};
    const float gw[8] = {w0[0], w0[1], w0[2], w0[3], w1[0], w1[1], w1[2], w1[3]}, gb[8] = {b0[0], b0[1], b0[2], b0[3], b1[0], b1[1], b1[2], b1[3]};
    float sm = ((o[0] + o[1]) + (o[2] + o[3])) + ((o[4] + o[5]) + (o[6] + o[7]));
    sm += dpp_f<0xB1>(sm); sm += dpp_f<0x4E>(sm); sm += dpp_f<0x141>(sm);
    const float mean = sm * (1.0f / 64.0f); float d[8], sq = 0.f;
#pragma unroll
    for (int j = 0; j < 8; ++j) { d[j] = o[j] - mean; sq += d[j] * d[j]; }
    sq += dpp_f<0xB1>(sq); sq += dpp_f<0x4E>(sq); sq += dpp_f<0x141>(sq);
    const float rstd = rsqrtf(sq * (1.0f / 64.0f) + GN_EPS); float r[8];
#pragma unroll
    for (int j = 0; j < 8; ++j) r[j] = (d[j] * rstd * gw[j] + gb[j] + bv[j]) * z[j];
    u32x4 w; w.x = cvt_pk_bf16(r[0], r[1]); w.y = cvt_pk_bf16(r[2], r[3]); w.z = cvt_pk_bf16(r[4], r[5]); w.w = cvt_pk_bf16(r[6], r[7]);
    *(u32x4*)(A2 + (size_t)row * 2048 + 1024 + ch) = w;
}

__device__ __forceinline__ void p6_row(const Args& a, int m, int lane) {
    float* y = a.out + (size_t)m * DM; const float* fg = a.in[I_FINALG];
    if (m < MP) {
        const float* rs = (const float*)(a.ws + WS_ROWSS) + (size_t)m * 32;
        const float ss = wave_sum(rs[lane & 31]) * 0.5f;
        const float rstd = rsqrtf(ss * (1.0f / DM) + RMS_EPS);
#pragma unroll
        for (int j = 0; j < 8; ++j) { const int k = 4 * lane + 256 * j; f32x4 v = *(const f32x4*)(y + k); const f32x4 gv = *(const f32x4*)(fg + k);
#pragma unroll
            for (int q = 0; q < 4; ++q) v[q] = v[q] * rstd * gv[q];
            *(f32x4*)(y + k) = v; }
    } else {
        const int r = m - MP; const float* slab = (const float*)(a.ws + WS_SLAB) + (size_t)r * DM; const float* x = a.in[I_XS] + (size_t)r * DM;
        const float* gtrow = (const float*)(a.ws + WS_MOD) + (size_t)(NB + r) * NMOD + 2 * DM;
        f32x4 v[8]; float ss = 0.f;
#pragma unroll
        for (int j = 0; j < 8; ++j) { const int k = 4 * lane + 256 * j; f32x4 mix = *(const f32x4*)(slab + k);
#pragma unroll
            for (int s2 = 1; s2 < 8; ++s2) mix += *(const f32x4*)(slab + (size_t)s2 * NSMP * DM + k);
            const f32x4 xv = *(const f32x4*)(x + k), gt = *(const f32x4*)(gtrow + k);
#pragma unroll
            for (int q = 0; q < 4; ++q) { v[j][q] = xv[q] + gt[q] * mix[q]; ss += v[j][q] * v[j][q]; } }
        const float rstd = rsqrtf(wave_sum(ss) * (1.0f / DM) + RMS_EPS);
#pragma unroll
        for (int j = 0; j < 8; ++j) { const int k = 4 * lane + 256 * j; const f32x4 gv = *(const f32x4*)(fg + k); f32x4 o;
#pragma unroll
            for (int q = 0; q < 4; ++q) o[q] = v[j][q] * rstd * gv[q];
            *(f32x4*)(y + k) = o; }
    }
}

__global__ void __launch_bounds__(512, 2) fwd_kernel(Args args) {
    extern __shared__ __attribute__((aligned(16))) unsigned char lds_raw[];
    LAS unsigned char* lds = (LAS unsigned char*)lds_raw;
    const int tid = threadIdx.x, lane = tid & 63, wave = __builtin_amdgcn_readfirstlane(tid >> 6);
    const int G = gridDim.x, bx = blockIdx.x;
    const int vcu = (G % 8 == 0) ? (bx % 8) * (G / 8) + bx / 8 : bx;
    volatile LAS unsigned* MISC = (volatile LAS unsigned*)(lds + MISC_OFF);
    for (int u = tid; u < (LDS_BYTES - LDSCTL_OFF) / 4; u += 512) ((LAS unsigned*)(lds + LDSCTL_OFF))[u] = 0u;
    __syncthreads();
    unsigned* ctl = (unsigned*)(args.ws + WS_CTL);
    XcdBarrier bar; bar.bar = ctl + CW_BAR + args.li * XCD_BAR_WORDS; bar.x = 0; bar.st = nullptr;
    const bool multi = (args.ph_hi - args.ph_lo) > 1;
    if (multi) bar = xcd_barrier_post(ctl + CW_BAR + args.li * XCD_BAR_WORDS, MISC + 8);
    const int lo = args.ph_lo, hi = args.ph_hi;
#define IN(k) (lo <= (k) && (k) < hi)
#define SEAM(k) do { if (IN(k) && IN((k) + 1)) xcd_barrier(bar); } while (0)
    const int gw = vcu * 8 + wave, NGW = G * 8;

    if (IN(0)) {
        if (vcu < 192) p0_mod(args, lds, vcu, wave, lane);
        else if (vcu - 192 < 64) p0_s5_tables(args, lds, vcu - 192, tid);
    }
    SEAM(0);
    if (IN(1)) {
        { LAS float* scr = (LAS float*)(lds + wave * 16384);
          bf16_t* WT = (bf16_t*)(args.ws + WS_WT);
          for (int it = gw; it < 328 * 32; it += NGW) { const int nb = it >> 5, kb = it & 31; const int p0 = 32 * nb;
              const int src = (p0 < 5120) ? p0 : ((p0 < 10240) ? p0 + 128 : p0 - 5120);
              transpose_item(args.in[I_WIN], NIN, 2048, src, WT, p0, 64 * kb, scr, lane, p0 >= NIN); } }
        for (int m = gw; m < MT; m += NGW) p1_row(args, m, lane);
    }
    SEAM(1);
    const bool tail_mode = (G == 256);
    if (IN(2)) {
        pg8::Gemm g{(const bf16_t*)(args.ws + WS_XN), (const bf16_t*)(args.ws + WS_WT), 2048, 2048};
        EpiP E{(bf16_t*)(args.ws + WS_P), tail_mode, (bf16_t*)(args.ws + WS_U2)};
        if (tail_mode) {
            pg8::TailOrder S; S.init2(G, bx, ctl + CW_TILE);
            pg8::gemm_phase<EpiP, pg8::TailOrder, GEMM_ALIGN, GEMM_SP2>(lds, g, S, E);
            if (bx >= 73) {
                const int t = bx - 73;
                for (int u = t; u < 256; u += 183) { wait_count(ctl + CW_TILE + 64 * ((u >> 6) * 4 + ((u & 63) >> 4)), 64u, wave); p3_s5_prompt(args, lds, u, tid, wave, lane); }
                if (t >= 73 && t < 137) { const int g2 = t - 73; wait_count(ctl + CW_TILE + 64 * (16 + (g2 >> 4)), 8u, wave); p3_s5_sample(args, g2, wave, lane); }
                __syncthreads();
                { LAS float* scr = (LAS float*)(lds + wave * 16384);
                  for (int it = t * 8 + wave; it < 2048 + 512; it += 183 * 8) {
                      if (it < 2048) { const int nb = it >> 5, kb = it & 31; transpose_item(args.in[I_WOUT], 2048, 2048, 32 * nb, (bf16_t*)(args.ws + WS_WOUT_T), 32 * nb, 64 * kb, scr, lane, false); }
                      else { const int i2 = it - 2048, nb = i2 >> 4, kb = i2 & 15; transpose_item(args.in[I_WGLU], 1024, 1024, 32 * nb, (bf16_t*)(args.ws + WS_WGLU_T), 32 * nb, 64 * kb, scr, lane, false); } } }
            }
        } else {
            pg8::StaticOrder S; S.init(MT, LDP, 2048, G, bx);
            pg8::gemm_phase<EpiP, pg8::StaticOrder, GEMM_ALIGN, GEMM_SP2>(lds, g, S, E);
        }
    }
    SEAM(2);
    if (IN(3)) {
        p3_rwkv_chunks(args, lds, vcu >> 2, vcu & 3, tid, wave, lane);
        if (!tail_mode) {
            { LAS float* scr = (LAS float*)(lds + wave * 16384);
              for (int it = gw; it < 2048 + 512; it += NGW) {
                  if (it < 2048) { const int nb = it >> 5, kb = it & 31; transpose_item(args.in[I_WOUT], 2048, 2048, 32 * nb, (bf16_t*)(args.ws + WS_WOUT_T), 32 * nb, 64 * kb, scr, lane, false); }
                  else { const int i2 = it - 2048, nb = i2 >> 4, kb = i2 & 15; transpose_item(args.in[I_WGLU], 1024, 1024, 32 * nb, (bf16_t*)(args.ws + WS_WGLU_T), 32 * nb, 64 * kb, scr, lane, false); } } }
            __syncthreads();
            for (int u = vcu; u < 256; u += G) p3_s5_prompt(args, lds, u, tid, wave, lane);
            for (int g2 = vcu; g2 < 64; g2 += G) p3_s5_sample(args, g2, wave, lane);
            __syncthreads();
        }
        for (int it = vcu; it < 256; it += G) p3_rwkv_sample(args, lds, it >> 1, (it & 1) * 8 + wave, wave, lane);
    }
    SEAM(3);
    if (IN(4)) {
        pg8::StaticOrder S; S.init(MT, 1024, 1024, G, bx);
        pg8::Unit u0;
        if (S.next(0, u0)) {
            pg8::Gemm g{(const bf16_t*)(args.ws + WS_YG), (const bf16_t*)(args.ws + WS_WGLU_T), 1024, 1024};
            EpiGlu E{(const bf16_t*)(args.ws + WS_YG), (const bf16_t*)(args.ws + WS_P), args.in[I_BGLU], (bf16_t*)(args.ws + WS_XN)};
            pg8::gemm_phase<EpiGlu, pg8::StaticOrder, GEMM_ALIGN, GEMM_SP2>(lds, g, S, E);
        } else {
            const int nfree = G - 132, j = bx - 132, unit = wave * nfree + j;
            if (unit < 256) p3_rwkv_seq(args, unit, lane);
        }
    }
    SEAM(4);
    if (IN(5)) { for (int it = gw * 8; it < MP * 16; it += NGW * 8) p4_rwkv_post8(args, it, lane); }
    SEAM(5);
    if (IN(6)) {
        pg8::Gemm g{(const bf16_t*)(args.ws + WS_XN), (const bf16_t*)(args.ws + WS_WOUT_T), 2048, 1024};
        pg8::OutOrder S; S.init(MP, DM, 1024, G, bx);
        EpiOut E{(const bf16_t*)(args.ws + WS_P), args.in[I_XP], (const float*)(args.ws + WS_MOD), args.out, (float*)(args.ws + WS_ROWSS), (bf16_t*)(args.ws + WS_TMP), (float*)(args.ws + WS_SLAB), ctl + CW_PANEL, args.in[I_FINALG]};
        pg8::gemm_phase<EpiOut, pg8::OutOrder, false, GEMM_SP2>(lds, g, S, E);
    }
    SEAM(6);
    if (IN(7)) { for (int m = MP + gw; m < MV; m += NGW) p6_row(args, m, lane); }
#undef IN
#undef SEAM
}

extern "C" void kernel_launch(void* const* d_in, const int* in_sizes, int n_in, void* d_out, int out_size, void* d_ws, size_t ws_size, hipStream_t stream) {
    static int grid = 0;
    if (grid == 0) {
        if (n_in != 34 || ws_size < WS_END) { fprintf(stderr, "kernel_launch: unexpected n_in %d / ws %zu\n", n_in, ws_size); grid = -1; return; }
        int dev = 0, cus = 0;
        if (hipGetDevice(&dev) != hipSuccess || hipDeviceGetAttribute(&cus, hipDeviceAttributeMultiprocessorCount, dev) != hipSuccess) { grid = -1; return; }
        if (hipFuncSetAttribute((const void*)fwd_kernel, hipFuncAttributeMaxDynamicSharedMemorySize, LDS_BYTES) != hipSuccess) { fprintf(stderr, "kernel_launch: hipFuncSetAttribute failed\n"); grid = -1; return; }
        int per_cu = 0;
        if (hipOccupancyMaxActiveBlocksPerMultiprocessor(&per_cu, (const void*)fwd_kernel, 512, LDS_BYTES) != hipSuccess || per_cu < 1) fprintf(stderr, "kernel_launch: occupancy query says %d\n", per_cu);
        (void)hipGetLastError();
        grid = cus;
        if (grid != 256) fprintf(stderr, "kernel_launch: note: %d CUs\n", grid);
    }
    if (grid < 0) return;
    (void)hipMemsetAsync((char*)d_ws + WS_CTL, 0, CTL_BYTES, stream);
    Args a{};
    for (int i = 0; i < 34; ++i) a.in[i] = (const float*)d_in[i];
    a.out = (float*)d_out; a.ws = (unsigned char*)d_ws;
    if (PROBE_PHASE >= 0) {
        a.ph_lo = 0; a.ph_hi = PROBE_PHASE + 1; a.li = 0; hipLaunchKernelGGL(fwd_kernel, dim3(grid), dim3(512), LDS_BYTES, stream, a);
        a.ph_lo = PROBE_PHASE; a.ph_hi = PROBE_PHASE + 1; a.li = 1; hipLaunchKernelGGL(fwd_kernel, dim3(grid), dim3(512), LDS_BYTES, stream, a);
        if (PROBE_PHASE + 1 < N_PHASES) { a.ph_lo = PROBE_PHASE + 1; a.ph_hi = N_PHASES; a.li = 2; hipLaunchKernelGGL(fwd_kernel, dim3(grid), dim3(512), LDS_BYTES, stream, a); }
    } else if (MK_N_LAUNCHES == 1) { a.ph_lo = 0; a.ph_hi = N_PHASES; a.li = 0; hipLaunchKernelGGL(fwd_kernel, dim3(grid), dim3(512), LDS_BYTES, stream, a); }
    else { for (int p = 0; p < N_PHASES; ++p) { a.ph_lo = p; a.ph_hi = p + 1; a.li = 0; hipLaunchKernelGGL(fwd_kernel, dim3(grid), dim3(512), LDS_BYTES, stream, a); } }
}
```

```cpp
#include <hip/hip_runtime.h>
#include <cstdio>
#include <cstdint>

#ifndef MK_N_LAUNCHES
#define MK_N_LAUNCHES 1
#endif
#ifndef PROBE_PHASE
#define PROBE_PHASE -1
#endif
constexpr int N_PHASES = 8;
#ifndef GEMM_SP2
#define GEMM_SP2 true
#endif
#ifndef GEMM_ALIGN
#define GEMM_ALIGN true
#endif

#define GAS __attribute__((address_space(1)))
#define LAS __attribute__((address_space(3)))
typedef unsigned short bf16_t;
typedef short bf16x8 __attribute__((ext_vector_type(8)));
typedef float f32x2 __attribute__((ext_vector_type(2)));
typedef float f32x4 __attribute__((ext_vector_type(4)));
typedef float f32x16 __attribute__((ext_vector_type(16)));
typedef unsigned u32x2 __attribute__((ext_vector_type(2)));
typedef unsigned u32x4 __attribute__((ext_vector_type(4)));
typedef GAS unsigned gu32;

constexpr int DM = 2048, SEQ = 2048, NB = 4, NSMP = 128;
constexpr int MP = NB * SEQ;
constexpr int MV = MP + NSMP;
constexpr int MT = MV + NSMP;
constexpr int NIN = 10368, LDP = 10496;
constexpr int NMOD = 6144, NMODROWS = NB + NSMP;
constexpr float RMS_EPS = 1e-6f, GN_EPS = 64e-5f;
constexpr int PC_U = 0, PC_ZS = 1024, PC_R = 2048, PC_K = 3072, PC_V = 4096, PC_ZR = 5120, PC_GS = 6144, PC_GR = 8192, PC_WD = 10240, PC_AD = 10304;

constexpr size_t WS_CTL = 0, CTL_BYTES = 131072;
constexpr size_t WS_MOD = CTL_BYTES;
constexpr size_t WS_WT = WS_MOD + 3276800;
constexpr size_t WS_XN = WS_WT + (size_t)LDP * 2048 * 2;
constexpr size_t WS_P = WS_XN + (size_t)MT * 2048 * 2;
constexpr size_t WS_RWI = WS_P + (size_t)MT * LDP * 2;
constexpr int RWI_GF = 0, RWI_W2F = 8192, RWI_H1F = 16384, RWI_O1F = 32768, RWI_LAM = 49152, RWI_BYTES = 49408;
constexpr size_t WS_TMP = WS_RWI;
constexpr size_t WS_SLAB = WS_TMP + (size_t)MP * 2048 * 2;
static_assert(WS_SLAB + (size_t)8 * NSMP * DM * 4 <= WS_RWI + (size_t)2048 * RWI_BYTES, "tmp/slab alias");
constexpr size_t WS_YG = WS_RWI + (size_t)2048 * RWI_BYTES;
constexpr size_t WS_WOUT_T = WS_YG + (size_t)MT * 1024 * 2;
constexpr size_t WS_WGLU_T = WS_WOUT_T + (size_t)2048 * 2048 * 2;
constexpr size_t WS_ROWSS = WS_WGLU_T + (size_t)1024 * 1024 * 2;
constexpr size_t WS_U2 = WS_ROWSS + (size_t)MP * 8 * 4;
constexpr size_t WS_U2S = WS_U2 + (size_t)MP * 1024 * 2;
constexpr size_t WS_HB = WS_U2S + (size_t)NSMP * 1024 * 2;
constexpr size_t WS_END = WS_HB + (size_t)256 * 32 * 2048;
static_assert(WS_END <= ((size_t)412 << 20), "ws map");
constexpr size_t DO_ORAW = 0, DO_BV = (size_t)MP * 1024 * 2, DO_S5TAB = 2 * DO_BV;
constexpr int S5T_ME = 0, S5T_KT = 65536, S5T_CA = 81920, S5T_C0 = 147456, S5T_DF = 155648, S5T_HDR = 156672, S5T_BYTES = 157696;
static_assert(DO_S5TAB + (size_t)64 * S5T_BYTES <= (size_t)MV * DM * 4, "d_out scratch");
constexpr size_t OUT_Y = 0, OUT_S5RE_P = 17039360, OUT_S5IM_P = 17055744, OUT_WKV_P = 17072128, OUT_SHIFT_P = 17334272,
                 OUT_S5RE_S = 17342464, OUT_S5IM_S = 17866752, OUT_WKV_S = 18391040, OUT_SHIFT_S = 26779648;
constexpr int RING_BYTES = 131072, LDSCTL_OFF = RING_BYTES, MISC_OFF = LDSCTL_OFF + 320, LDS_BYTES = 147456;
constexpr int CW_BAR = 1024;
constexpr int CW_PANEL = 12288, CW_TILE = 16384;

#define LDS_WAIT() asm volatile("s_waitcnt lgkmcnt(0)" ::: "memory")
#define VM_WAIT() asm volatile("s_waitcnt vmcnt(0)" ::: "memory")
typedef __bf16 bf16x2_t __attribute__((ext_vector_type(2)));
__device__ __forceinline__ unsigned cvt_pk_bf16(float lo, float hi) { const f32x2 v = {lo, hi}; return __builtin_bit_cast(unsigned, __builtin_convertvector(v, bf16x2_t)); }
__device__ __forceinline__ u32x2 pack4(float a, float b, float c, float d) { u32x2 w; w.x = cvt_pk_bf16(a, b); w.y = cvt_pk_bf16(c, d); return w; }
__device__ __forceinline__ float bf_lo(unsigned w) { return __uint_as_float(w << 16); }
__device__ __forceinline__ float bf_hi(unsigned w) { return __uint_as_float(w & 0xffff0000u); }
__device__ __forceinline__ float bf2f(bf16_t b) { return __uint_as_float(((unsigned)b) << 16); }
__device__ __forceinline__ bf16_t f2bf(float f) { return (bf16_t)(cvt_pk_bf16(f, 0.f) & 0xffffu); }
__device__ __forceinline__ float rcpf_(float x) { return __builtin_amdgcn_rcpf(x); }
__device__ __forceinline__ float sigmoidf_(float x) { return rcpf_(1.0f + __expf(-x)); }
__device__ __forceinline__ float siluf_(float x) { return x * rcpf_(1.0f + __expf(-x)); }
__device__ __forceinline__ float tanhf_(float x) { const float e = __expf(2.0f * x); return 1.0f - 2.0f * rcpf_(e + 1.0f); }
__device__ __forceinline__ float geluf_(float y) { const float z = 0.7978845608028654f * (y + 0.044715f * y * y * y); return 0.5f * y * (1.0f + tanhf_(z)); }
__device__ __forceinline__ float wave_sum(float v) {
#pragma unroll
    for (int o = 1; o < 64; o <<= 1) v += __shfl_xor(v, o);
    return v;
}
template <int CTRL> __device__ __forceinline__ float dpp_f(float x) { return __builtin_bit_cast(float, __builtin_amdgcn_mov_dpp(__builtin_bit_cast(int, x), CTRL, 0xf, 0xf, true)); }
__device__ __forceinline__ float wave_sum_dpp(float v) {
    v += __builtin_bit_cast(float, __builtin_amdgcn_update_dpp(0, __builtin_bit_cast(int, v), 0x111, 0xf, 0xf, true));
    v += __builtin_bit_cast(float, __builtin_amdgcn_update_dpp(0, __builtin_bit_cast(int, v), 0x112, 0xf, 0xf, true));
    v += __builtin_bit_cast(float, __builtin_amdgcn_update_dpp(0, __builtin_bit_cast(int, v), 0x114, 0xf, 0xf, true));
    v += __builtin_bit_cast(float, __builtin_amdgcn_update_dpp(0, __builtin_bit_cast(int, v), 0x118, 0xf, 0xf, true));
    v += __builtin_bit_cast(float, __builtin_amdgcn_update_dpp(0, __builtin_bit_cast(int, v), 0x142, 0xa, 0xf, false));
    v += __builtin_bit_cast(float, __builtin_amdgcn_update_dpp(0, __builtin_bit_cast(int, v), 0x143, 0xc, 0xf, false));
    return __builtin_bit_cast(float, __builtin_amdgcn_readlane(__builtin_bit_cast(int, v), 63));
}
__device__ __forceinline__ float row16_sum(float v) {
    v += dpp_f<0xB1>(v);
    v += dpp_f<0x4E>(v);
    v += dpp_f<0x141>(v);
    v += dpp_f<0x140>(v);
    return v;
}

#define XB_TMO      128
#define XB_XCNT(j)  (256  + 64 * (j))
#define XB_XSUB(j)  (1280 + 64 * (j))
#define XB_XGEN(j)  (2304 + 64 * (j))
#define XB_TOP      3328
#define XB_TOPGEN   3392
#define XCD_BAR_WORDS 3456
#define XB_SPIN_CAP (1u << 20)
__device__ __forceinline__ unsigned xb_ld(unsigned* p)              { return __hip_atomic_load(p, __ATOMIC_RELAXED, __HIP_MEMORY_SCOPE_AGENT); }
__device__ __forceinline__ unsigned xb_add(unsigned* p, unsigned v) { return __hip_atomic_fetch_add(p, v, __ATOMIC_RELAXED, __HIP_MEMORY_SCOPE_AGENT); }
__device__ __forceinline__ unsigned xb_xcc_id() { return (unsigned)__builtin_amdgcn_s_getreg((3 << 11) | 20) & 0xFu; }
#define XB_SPIN(cond, bar) do { unsigned _sp = 0; while (cond) { __builtin_amdgcn_s_sleep(1); \
    if ((++_sp & 255u) == 0u) { if (xb_ld(&(bar)[XB_TMO])) break; if (_sp > XB_SPIN_CAP) { atomicAdd(&(bar)[XB_TMO], 1u); break; } } } } while (0)
struct XcdBarrier { unsigned* bar; unsigned x; volatile LAS unsigned* st; };
__device__ __forceinline__ XcdBarrier xcd_barrier_post(unsigned* bar, volatile LAS unsigned* st) {
    XcdBarrier b; b.bar = bar; b.x = xb_xcc_id(); b.st = st;
    if (threadIdx.x == 0) (void)xb_add(&bar[XB_XCNT(b.x)], 1u);
    return b;
}
__device__ __forceinline__ void xcd_barrier_complete(unsigned* bar, unsigned x, unsigned& nloc, unsigned& nx) {
    const unsigned G = gridDim.x * gridDim.y * gridDim.z;
    unsigned sum, cnt, mine, sp = 0u;
    for (;;) {
        sum = 0u; cnt = 0u; mine = 0u;
#pragma unroll
        for (unsigned j = 0; j < 16; ++j) { const unsigned c = xb_ld(&bar[XB_XCNT(j)]); sum += c; cnt += (c > 0u) ? 1u : 0u; mine = (j == x) ? c : mine; }
        if (sum == G) break;
        __builtin_amdgcn_s_sleep(1);
        if ((++sp & 255u) == 0u) { if (xb_ld(&bar[XB_TMO])) break; if (sp > XB_SPIN_CAP) { atomicAdd(&bar[XB_TMO], 1u); break; } }
    }
    nloc = mine > 0u ? mine : 1u; nx = cnt > 0u ? cnt : 1u;
}
__device__ __forceinline__ void xcd_barrier(const XcdBarrier& b) {
    asm volatile("s_waitcnt vmcnt(0)" ::: "memory");
    __syncthreads();
    if (threadIdx.x == 0) {
        unsigned* bar = b.bar;
        __builtin_amdgcn_s_waitcnt(0);
        unsigned nloc = b.st[0], nx = b.st[1];
        if (nloc == 0u) { xcd_barrier_complete(bar, b.x, nloc, nx); b.st[0] = nloc; b.st[1] = nx; }
        const unsigned old = xb_add(&bar[XB_XSUB(b.x)], 1u);
        const unsigned gen = old / nloc;
        if (old + 1u == (gen + 1u) * nloc) {
            __builtin_amdgcn_fence(__ATOMIC_RELEASE, "agent");
            asm volatile("s_waitcnt vmcnt(0)" ::: "memory");
            const unsigned og = xb_add(&bar[XB_TOP], 1u);
            const unsigned tg = og / nx;
            if (og + 1u == (tg + 1u) * nx) xb_add(&bar[XB_TOPGEN], 1u);
            else XB_SPIN(xb_ld(&bar[XB_TOPGEN]) == tg, bar);
            __builtin_amdgcn_fence(__ATOMIC_ACQUIRE, "agent");
            xb_add(&bar[XB_XGEN(b.x)], 1u);
            asm volatile("s_waitcnt vmcnt(0)" ::: "memory");
        } else {
            XB_SPIN(xb_ld(&bar[XB_XGEN(b.x)]) == gen, bar);
            __builtin_amdgcn_fence(__ATOMIC_ACQUIRE, "agent");
            asm volatile("s_waitcnt vmcnt(0)" ::: "memory");
        }
    }
    __syncthreads();
}

namespace pg8 {
constexpr int BM = 256, BK = 64, HALF = 128, HTB = HALF * BK * 2, STAGE_BYTES = 8 * HTB, NXCD = 8, WGM = 8;
__host__ __device__ __forceinline__ int lds_byte(int r, int c) { const int st = (r >> 4) * 2 + (c >> 5), rr = r & 15, cc = c & 31, ob = rr * 64 + cc * 2; return st * 1024 + (ob ^ (((ob >> 9) & 1) << 5)); }
__host__ __device__ __forceinline__ void stage_rc(int b, int& R, int& C) { const int st = b / 1024, sb = b % 1024, swz = sb ^ (((sb >> 9) & 1) << 5); R = (st >> 1) * 16 + swz / 64; C = (st & 1) * 32 + (swz % 64) / 2; }
__host__ __device__ __forceinline__ int perm32(int rho) { const int n = rho >> 4, i = rho & 15; return 8 * (i >> 2) + 4 * n + (i & 3); }
struct Unit { int pm, pn, koff, kt, mode; };
struct Gemm { const bf16_t* A; const bf16_t* Bt; int ld, K; };
struct StaticOrder {
    int nM, nN, nwg, G, c, kt;
    __device__ void init(int M, int N, int K, int G_, int c_) { nM = M / BM; nN = N / BM; nwg = nM * nN; G = G_; c = c_; kt = K / BK; }
    __device__ __forceinline__ void tile(int L, Unit& u) const {
        int wgid = L; { const int q = nwg / NXCD, r = nwg % NXCD, xcd = wgid % NXCD, off = wgid / NXCD; wgid = (xcd < r ? xcd * (q + 1) : r * (q + 1) + (xcd - r) * q) + off; }
        const int nig = WGM * nN, gid = wgid / nig, fm = gid * WGM, gsz = (nM - fm) < WGM ? (nM - fm) : WGM;
        u.pm = fm + ((wgid % nig) % gsz); u.pn = (wgid % nig) / gsz; u.koff = 0; u.kt = kt; u.mode = 0;
    }
    __device__ __forceinline__ bool next(int i, Unit& u) const { const long L = (long)i * G + c; if (L >= nwg) return false; tile((int)L, u); return true; }
    __device__ __forceinline__ void done(const Unit&, int, int&) const {}
};
struct OutOrder : StaticOrder {
    __device__ __forceinline__ bool next(int i, Unit& u) const {
        const int i2 = (c < 64) ? i - 1 : i;
        if (i2 < 0) { u.pm = 32; u.pn = c >> 3; u.koff = (c & 7) * 256; u.kt = 4; u.mode = 2; return true; }
        if (i2 < 2 && c < nwg) { tile(c, u); u.koff = i2 * 1024; u.kt = 16; u.mode = i2; return true; }
        return false;
    }
};
struct TailOrder : StaticOrder {
    unsigned* cnt;
    __device__ void init2(int G_, int c_, unsigned* cnt_) { nM = 32; nN = 37; nwg = 32 * 37; G = G_; c = c_; kt = 32; cnt = cnt_; }
    __device__ __forceinline__ bool next(int i, Unit& u) const {
        const int L = i * G + c; if (L >= 169 + 1184) return false;
        if (L < 132) { const int x = L & 7, k = L >> 3; if (k < 16) { u.pm = 4 * x + (k >> 2); u.pn = k & 3; } else { u.pm = 32; u.pn = x; }
                       u.koff = 0; u.kt = 32; u.mode = 0; }
        else if (L < 169) { u.pm = 32; u.pn = 4 + (L - 132); u.koff = 0; u.kt = 32; u.mode = 0; }
        else { tile(L - 169, u); u.pn += 4; }
        return true;
    }
    __device__ __forceinline__ void done(const Unit& u, int lane, int& pend) const {
        if (pend >= 0) {
            asm volatile("s_waitcnt vmcnt(0)" ::: "memory");
            if (lane == 0) __hip_atomic_fetch_add(cnt + 64 * pend, 1u, __ATOMIC_RELAXED, __HIP_MEMORY_SCOPE_AGENT);
            pend = -1;
        }
        if (u.pm == 32 || u.pn < 4) pend = (u.pm == 32) ? 16 + u.pn : (u.pm >> 3) * 4 + u.pn;
    }
};
template <class Epi, class Sched, bool ALIGN_EPI = false, bool SP2 = false>
__device__ __forceinline__ void gemm_phase(LAS unsigned char* lds, const Gemm g, const Sched& S, const Epi& E) {
    const int tid = threadIdx.x, wid = __builtin_amdgcn_readfirstlane(tid >> 6), lane = tid & 63, wr = wid >> 2, wc = wid & 3, fr = lane & 15, fq = lane >> 4;
    const int ld = g.ld;
    unsigned voffA[2], voffB[2];
#pragma unroll
    for (int i = 0; i < 2; ++i) { int R, C; stage_rc(tid * 16 + i * 8192, R, C); const int Rb = Epi::PERM ? ((R & ~31) + perm32(R & 31)) : R;
        voffA[i] = (unsigned)(R * ld + C) * 2u; voffB[i] = (unsigned)(Rb * ld + C) * 2u; }
    const size_t kstep = (size_t)(BK * 2);
    const size_t hstep = (size_t)HALF * ld * 2;
    const size_t tstep = 2 * hstep;
    const unsigned ldsw = (unsigned)wid * 1024u;
    const int aoff = lds_byte(wr * 64 + fr, fq * 8), boff = lds_byte(wc * 32 + fr, fq * 8);
#define PG8_SA(b, h) (((b) * 2 + (h)) * HTB)
#define PG8_SB(b, h) ((4 + (b) * 2 + (h)) * HTB)
#define PG8_STAGE(bufoff, gbase, voff) do { _Pragma("unroll") for (int _i = 0; _i < 2; ++_i) \
        __builtin_amdgcn_global_load_lds((const unsigned*)((const char*)(gbase) + (voff)[_i]), (LAS unsigned*)(lds + (bufoff) + ldsw + _i * 8192), 16, 0, 0); } while (0)
#define PG8_LDA(dst, b, h) do { _Pragma("unroll") for (int m = 0; m < 4; ++m) _Pragma("unroll") for (int k = 0; k < 2; ++k) dst[m][k] = *(const LAS bf16x8*)(lds + PG8_SA(b, h) + aoff + m * 2048 + k * 1024); } while (0)
#define PG8_LDB(dst, b, h) do { _Pragma("unroll") for (int n = 0; n < 2; ++n) _Pragma("unroll") for (int k = 0; k < 2; ++k) dst[n][k] = *(const LAS bf16x8*)(lds + PG8_SB(b, h) + boff + n * 2048 + k * 1024); } while (0)
#define PG8_MMA(ai, bj, At, Bt) do { __builtin_amdgcn_s_setprio(1); _Pragma("unroll") for (int m = 0; m < 4; ++m) _Pragma("unroll") for (int n = 0; n < 2; ++n) _Pragma("unroll") for (int k = 0; k < 2; ++k) \
        acc[ai][bj][m][n] = __builtin_amdgcn_mfma_f32_16x16x32_bf16(Bt[n][k], At[m][k], acc[ai][bj][m][n], 0, 0, 0); __builtin_amdgcn_s_setprio(0); } while (0)
#define PG8_WAIT_V(n) asm volatile("s_waitcnt vmcnt(" #n ")" ::: "memory")
#define PG8_WAIT_L(n) asm volatile("s_waitcnt lgkmcnt(" #n ")" ::: "memory")
#define PG8_BAR __builtin_amdgcn_s_barrier()
#define PG8_SCHED __builtin_amdgcn_sched_barrier(0)
    Unit cur, nxt; int ui = 0; bool deferred = false; int pend = -1;
    if (!S.next(0, cur)) return;
    f32x4 acc[2][2][4][2];
#pragma unroll
    for (int a = 0; a < 2; ++a)
#pragma unroll
        for (int b = 0; b < 2; ++b)
#pragma unroll
            for (int m = 0; m < 4; ++m)
#pragma unroll
                for (int n = 0; n < 2; ++n) acc[a][b][m][n] = (f32x4){0.f, 0.f, 0.f, 0.f};
    bf16x8 At[4][2], B0[2][2], B1[2][2];
    const char* cA = (const char*)g.A + (size_t)cur.pm * tstep + (size_t)cur.koff * 2; const char* cB = (const char*)g.Bt + (size_t)cur.pn * tstep + (size_t)cur.koff * 2;
    if constexpr (SP2) {
        PG8_STAGE(PG8_SB(0, 0), cB, voffB); PG8_STAGE(PG8_SB(0, 1), cB + hstep, voffB); PG8_STAGE(PG8_SA(0, 0), cA, voffA); PG8_STAGE(PG8_SA(0, 1), cA + hstep, voffA);
        if (wr == 1) PG8_BAR;
        PG8_WAIT_V(2); PG8_BAR;
        PG8_STAGE(PG8_SB(1, 0), cB + kstep, voffB); PG8_STAGE(PG8_SA(1, 0), cA + kstep, voffA); PG8_STAGE(PG8_SB(1, 1), cB + hstep + kstep, voffB);
        PG8_WAIT_V(6); PG8_BAR;
    } else {
    PG8_STAGE(PG8_SB(0, 0), cB, voffB); PG8_STAGE(PG8_SA(0, 0), cA, voffA); PG8_STAGE(PG8_SB(0, 1), cB + hstep, voffB); PG8_STAGE(PG8_SA(0, 1), cA + hstep, voffA);
    if (wr == 1) PG8_BAR;
    PG8_WAIT_V(4); PG8_BAR;
    PG8_STAGE(PG8_SB(1, 0), cB + kstep, voffB); PG8_STAGE(PG8_SA(1, 0), cA + kstep, voffA); PG8_STAGE(PG8_SB(1, 1), cB + hstep + kstep, voffB);
    PG8_WAIT_V(6); PG8_BAR;
    }
    for (;;) {
        const bool has_next = S.next(ui + 1, nxt);
        const char* nA = has_next ? (const char*)g.A + (size_t)nxt.pm * tstep + (size_t)nxt.koff * 2 : cA; const char* nB = has_next ? (const char*)g.Bt + (size_t)nxt.pn * tstep + (size_t)nxt.koff * 2 : cB;
        const int nt = cur.kt;
        for (int t = 0; t < nt; t += 2) {
            const bool last = (t == nt - 2);
            const char* a1 = cA + (size_t)(t + 1) * kstep;
            const char* a2 = last ? nA : cA + (size_t)(t + 2) * kstep; const char* b2 = last ? nB : cB + (size_t)(t + 2) * kstep;
            const char* a3 = a2 + kstep; const char* b3 = b2 + kstep;
            if constexpr (SP2) {
            PG8_LDB(B0, 0, 0); PG8_LDB(B1, 0, 1); PG8_SCHED; PG8_LDA(At, 0, 0); PG8_STAGE(PG8_SA(1, 1), a1 + hstep, voffA);
            PG8_WAIT_V(8); PG8_WAIT_L(0); PG8_BAR; PG8_MMA(0, 0, At, B0); PG8_MMA(0, 1, At, B1); PG8_BAR; PG8_SCHED;
            PG8_LDA(At, 0, 1); PG8_STAGE(PG8_SB(0, 0), b2, voffB); PG8_STAGE(PG8_SB(0, 1), b2 + hstep, voffB); PG8_STAGE(PG8_SA(0, 0), a2, voffA);
            PG8_WAIT_V(8); PG8_WAIT_L(0); PG8_BAR; PG8_MMA(1, 0, At, B0); PG8_MMA(1, 1, At, B1); PG8_BAR; PG8_SCHED;
            PG8_LDB(B0, 1, 0); PG8_LDB(B1, 1, 1); PG8_SCHED; PG8_LDA(At, 1, 0); PG8_STAGE(PG8_SA(0, 1), a2 + hstep, voffA);
            PG8_WAIT_V(8); PG8_WAIT_L(0); PG8_BAR; PG8_MMA(0, 0, At, B0); PG8_MMA(0, 1, At, B1); PG8_BAR; PG8_SCHED;
            PG8_LDA(At, 1, 1); PG8_STAGE(PG8_SB(1, 0), b3, voffB); PG8_STAGE(PG8_SB(1, 1), b3 + hstep, voffB); PG8_STAGE(PG8_SA(1, 0), a3, voffA);
            PG8_WAIT_V(8); PG8_WAIT_L(0); PG8_BAR; PG8_MMA(1, 0, At, B0); PG8_MMA(1, 1, At, B1); PG8_BAR; PG8_SCHED;
            } else {
            PG8_LDB(B0, 0, 0); PG8_SCHED; PG8_LDA(At, 0, 0); PG8_STAGE(PG8_SA(1, 1), a1 + hstep, voffA);
            PG8_WAIT_L(8); PG8_BAR; PG8_WAIT_L(0); PG8_MMA(0, 0, At, B0); PG8_BAR; PG8_SCHED;
            PG8_LDB(B1, 0, 1); PG8_STAGE(PG8_SB(0, 0), b2, voffB);
            PG8_BAR; PG8_WAIT_L(0); PG8_MMA(0, 1, At, B1); PG8_BAR;
            PG8_LDA(At, 0, 1); PG8_STAGE(PG8_SA(0, 0), a2, voffA);
            PG8_BAR; PG8_WAIT_L(0); PG8_MMA(1, 0, At, B0); PG8_BAR; PG8_SCHED;
            PG8_STAGE(PG8_SB(0, 1), b2 + hstep, voffB);
            PG8_WAIT_V(6); PG8_BAR; PG8_MMA(1, 1, At, B1); PG8_BAR;
            PG8_LDB(B0, 1, 0); PG8_SCHED; PG8_LDA(At, 1, 0); PG8_STAGE(PG8_SA(0, 1), a2 + hstep, voffA);
            PG8_WAIT_L(8); PG8_BAR; PG8_WAIT_L(0); PG8_MMA(0, 0, At, B0); PG8_BAR; PG8_SCHED;
            PG8_LDB(B1, 1, 1); PG8_STAGE(PG8_SB(1, 0), b3, voffB);
            PG8_BAR; PG8_WAIT_L(0); PG8_MMA(0, 1, At, B1); PG8_BAR;
            PG8_LDA(At, 1, 1); PG8_STAGE(PG8_SA(1, 0), a3, voffA);
            PG8_BAR; PG8_WAIT_L(0); PG8_MMA(1, 0, At, B0); PG8_BAR; PG8_SCHED;
            PG8_STAGE(PG8_SB(1, 1), b3 + hstep, voffB);
            PG8_WAIT_V(6); PG8_BAR; PG8_MMA(1, 1, At, B1); PG8_BAR;
            }
        }
        if constexpr (ALIGN_EPI) { if (wr == 0) PG8_BAR; }
        if (Epi::FUSED_LAST && !has_next && cur.mode == 1) deferred = true; else { E(acc, cur, wr, wc, fr, fq); S.done(cur, lane, pend); }
        if (!has_next) break;
#pragma unroll
        for (int a = 0; a < 2; ++a)
#pragma unroll
            for (int b = 0; b < 2; ++b)
#pragma unroll
                for (int m = 0; m < 4; ++m)
#pragma unroll
                    for (int n = 0; n < 2; ++n) acc[a][b][m][n] = (f32x4){0.f, 0.f, 0.f, 0.f};
        cur = nxt; cA = nA; cB = nB; ++ui;
        if constexpr (ALIGN_EPI) { if (wr == 1) PG8_BAR; }
    }
    PG8_WAIT_V(0);
    if constexpr (!ALIGN_EPI) { if (wr == 0) PG8_BAR; }
    PG8_BAR;
    if constexpr (Epi::FUSED_LAST) { if (deferred) E.fused(acc, cur, wr, wc, fr, fq, lds, wid, lane); }
#undef PG8_SA
#undef PG8_SB
#undef PG8_STAGE
#undef PG8_LDA
#undef PG8_LDB
#undef PG8_MMA
#undef PG8_WAIT_V
#undef PG8_WAIT_L
#undef PG8_BAR
#undef PG8_SCHED
}
}

struct EpiP {
    static constexpr bool PERM = true, FUSED_LAST = false;
    bf16_t* P; bool tail; bf16_t* U2;
    __device__ __forceinline__ void operator()(const f32x4 (&acc)[2][2][4][2], const pg8::Unit& u, int wr, int wc, int fr, int fq) const {
        const int row0 = u.pm * 256 + wr * 64 + fr, col0 = u.pn * 256 + wc * 32 + 8 * fq;
        const bool wt = tail && (u.pm == 32 || u.pn < 4);
        const __amdgpu_buffer_rsrc_t rsrc = __builtin_amdgcn_make_buffer_rsrc(P, 0, (int)((size_t)MT * LDP * 2), 0x00020000);
        const __amdgpu_buffer_rsrc_t rsrc2 = __builtin_amdgcn_make_buffer_rsrc(U2, 0, (int)((size_t)MV * 1024 * 2), 0x00020000);
        const int act = ((u.pn >= 4 && u.pn < 8) || (u.pn >= 20 && u.pn < 24)) ? 1 : ((u.pn >= 24 && u.pn < 40) ? 2 : 0);
#pragma unroll
        for (int ai = 0; ai < 2; ++ai)
#pragma unroll
            for (int m = 0; m < 4; ++m) { bf16_t* rowp = P + (size_t)(row0 + ai * 128 + m * 16) * LDP + col0;
#pragma unroll
                for (int bj = 0; bj < 2; ++bj) { f32x4 v0 = acc[ai][bj][m][0], v1 = acc[ai][bj][m][1];
                    if (act == 1) {
#pragma unroll
                        for (int j = 0; j < 4; ++j) { v0[j] = siluf_(v0[j]); v1[j] = siluf_(v1[j]); } }
                    else if (act == 2) {
#pragma unroll
                        for (int j = 0; j < 4; ++j) { v0[j] = sigmoidf_(v0[j]); v1[j] = sigmoidf_(v1[j]); } }
                    u32x4 w; w.x = cvt_pk_bf16(v0[0], v0[1]); w.y = cvt_pk_bf16(v0[2], v0[3]); w.z = cvt_pk_bf16(v1[0], v1[1]); w.w = cvt_pk_bf16(v1[2], v1[3]);
                    if (u.pn < 4) {
                        const int row = row0 + ai * 128 + m * 16, col = col0 + bj * 128, g2 = col >> 4, hf = (col >> 3) & 1;
                        size_t eo; if (row < MP) eo = (((size_t)(row >> 11) * 64 + g2) * SEQ + (row & (SEQ - 1))) * 16 + hf * 8; else eo = (size_t)MP * 1024 + ((size_t)g2 * NSMP + ((row - MP) & (NSMP - 1))) * 16 + hf * 8;
                        if (row < MV) { if (wt) __builtin_amdgcn_raw_buffer_store_b128(w, rsrc2, (unsigned)(eo * 2), 0, 16); else *(u32x4*)(U2 + eo) = w; } }
                    else if (wt) __builtin_amdgcn_raw_buffer_store_b128(w, rsrc, (unsigned)((size_t)(row0 + ai * 128 + m * 16) * LDP + col0 + bj * 128) * 2u, 0, 16);
                    else *(u32x4*)(rowp + bj * 128) = w; } }
    }
};
struct EpiGlu {
    static constexpr bool PERM = true, FUSED_LAST = false;
    const bf16_t* Yg; const bf16_t* P; const float* bglu; bf16_t* A2;
    __device__ __forceinline__ void operator()(const f32x4 (&acc)[2][2][4][2], const pg8::Unit& u, int wr, int wc, int fr, int fq) const {
        const int row0 = u.pm * 256 + wr * 64 + fr, col0 = u.pn * 256 + wc * 32 + 8 * fq;
        f32x4 bv[2][2];
#pragma unroll
        for (int bj = 0; bj < 2; ++bj)
#pragma unroll
            for (int n = 0; n < 2; ++n) bv[bj][n] = *(const f32x4*)(bglu + col0 + bj * 128 + 4 * n);
#pragma unroll
        for (int ai = 0; ai < 2; ++ai)
#pragma unroll
            for (int m = 0; m < 4; ++m) { const size_t row = (size_t)(row0 + ai * 128 + m * 16);
#pragma unroll
                for (int bj = 0; bj < 2; ++bj) { const int c = col0 + bj * 128;
                    const u32x4 yg = *(const u32x4*)(Yg + row * 1024 + c), sz = *(const u32x4*)(P + row * LDP + PC_ZS + c);
                    const f32x4 a0 = acc[ai][bj][m][0] + bv[bj][0], a1 = acc[ai][bj][m][1] + bv[bj][1];
                    float o[8];
                    o[0] = bf_lo(yg.x) * sigmoidf_(a0[0]) * bf_lo(sz.x); o[1] = bf_hi(yg.x) * sigmoidf_(a0[1]) * bf_hi(sz.x);
                    o[2] = bf_lo(yg.y) * sigmoidf_(a0[2]) * bf_lo(sz.y); o[3] = bf_hi(yg.y) * sigmoidf_(a0[3]) * bf_hi(sz.y);
                    o[4] = bf_lo(yg.z) * sigmoidf_(a1[0]) * bf_lo(sz.z); o[5] = bf_hi(yg.z) * sigmoidf_(a1[1]) * bf_hi(sz.z);
                    o[6] = bf_lo(yg.w) * sigmoidf_(a1[2]) * bf_lo(sz.w); o[7] = bf_hi(yg.w) * sigmoidf_(a1[3]) * bf_hi(sz.w);
                    u32x4 w; w.x = cvt_pk_bf16(o[0], o[1]); w.y = cvt_pk_bf16(o[2], o[3]); w.z = cvt_pk_bf16(o[4], o[5]); w.w = cvt_pk_bf16(o[6], o[7]);
                    *(u32x4*)(A2 + row * 2048 + c) = w; } }
    }
};
struct EpiOut {
    static constexpr bool PERM = false, FUSED_LAST = true;
    const bf16_t* P; const float* xp; const float* mod; float* out; float* xbuf; bf16_t* tmp; float* slab; unsigned* cnt; const float* fg;
    __device__ __forceinline__ void operator()(const f32x4 (&acc)[2][2][4][2], const pg8::Unit& u, int wr, int wc, int fr, int fq) const {
        const int row0 = u.pm * 256 + wr * 64 + fr, col0 = u.pn * 256 + wc * 32 + 4 * fq;
        if (u.mode == 0) {
#pragma unroll
            for (int ai = 0; ai < 2; ++ai)
#pragma unroll
                for (int m = 0; m < 4; ++m) { const size_t row = (size_t)(row0 + ai * 128 + m * 16); const bf16_t* prow = P + row * LDP + PC_GS + col0; bf16_t* trow = tmp + row * DM + col0;
#pragma unroll
                    for (int bj = 0; bj < 2; ++bj)
#pragma unroll
                        for (int n = 0; n < 2; ++n) { const int o = bj * 128 + n * 16; const u32x2 gg = *(const u32x2*)(prow + o); const f32x4 a = acc[ai][bj][m][n];
                            *(u32x2*)(trow + o) = pack4(bf_lo(gg.x) * a[0], bf_hi(gg.x) * a[1], bf_lo(gg.y) * a[2], bf_hi(gg.y) * a[3]); } }
        } else {
            const int gc = (u.koff < 1024) ? PC_GS : PC_GR; float* sl = slab + (size_t)(u.koff >> 8) * NSMP * DM;
#pragma unroll
            for (int m = 0; m < 4; ++m) { const size_t row = (size_t)(row0 + m * 16); const bf16_t* prow = P + row * LDP + gc + col0; float* srow = sl + (row - MP) * DM + col0;
#pragma unroll
                for (int bj = 0; bj < 2; ++bj)
#pragma unroll
                    for (int n = 0; n < 2; ++n) { const int o = bj * 128 + n * 16; const u32x2 gg = *(const u32x2*)(prow + o); const f32x4 a = acc[0][bj][m][n];
                        *(f32x4*)(srow + o) = (f32x4){bf_lo(gg.x) * a[0], bf_hi(gg.x) * a[1], bf_lo(gg.y) * a[2], bf_hi(gg.y) * a[3]}; } }
        }
    }
    __device__ __forceinline__ void fused(f32x4 (&acc)[2][2][4][2], const pg8::Unit& u, int wr, int wc, int fr, int fq, LAS unsigned char* lds, int wid, int lane) const {
        const int row0 = u.pm * 256 + wr * 64 + fr, col0 = u.pn * 256 + wc * 32 + 4 * fq;
        LAS float* PT = (LAS float*)lds; LAS float* ST = (LAS float*)(lds + 4096);
        f32x4 gt[2][2];
        { const float* gtrow = mod + (size_t)(u.pm >> 3) * NMOD + 2 * DM + col0;
#pragma unroll
          for (int bj = 0; bj < 2; ++bj)
#pragma unroll
              for (int n = 0; n < 2; ++n) gt[bj][n] = *(const f32x4*)(gtrow + bj * 128 + n * 16); }
#pragma unroll
        for (int ai = 0; ai < 2; ++ai)
#pragma unroll
            for (int m = 0; m < 4; ++m) { const size_t row = (size_t)(row0 + ai * 128 + m * 16);
                const bf16_t* prow = P + row * LDP + PC_GR + col0; const bf16_t* trow = tmp + row * DM + col0; const float* xrow = xp + row * DM + col0;
                u32x2 gg[4], tv[4]; f32x4 xv[4];
#pragma unroll
                for (int q = 0; q < 4; ++q) { const int o = (q >> 1) * 128 + (q & 1) * 16; gg[q] = *(const u32x2*)(prow + o); tv[q] = *(const u32x2*)(trow + o); xv[q] = *(const f32x4*)(xrow + o); }
                float ss = 0.f;
#pragma unroll
                for (int q = 0; q < 4; ++q) { const f32x4 a = acc[ai][q >> 1][m][q & 1]; const f32x4 g4 = gt[q >> 1][q & 1];
                    f32x4 r; r[0] = xv[q][0] + g4[0] * (bf_lo(tv[q].x) + bf_lo(gg[q].x) * a[0]); r[1] = xv[q][1] + g4[1] * (bf_hi(tv[q].x) + bf_hi(gg[q].x) * a[1]);
                    r[2] = xv[q][2] + g4[2] * (bf_lo(tv[q].y) + bf_lo(gg[q].y) * a[2]); r[3] = xv[q][3] + g4[3] * (bf_hi(tv[q].y) + bf_hi(gg[q].y) * a[3]);
                    ss += (r[0] * r[0] + r[1] * r[1]) + (r[2] * r[2] + r[3] * r[3]);
                    acc[ai][q >> 1][m][q & 1] = r; }
                ss += __shfl_xor(ss, 16); ss += __shfl_xor(ss, 32);
                if (fq == 0) PT[(ai * 128 + wr * 64 + m * 16 + fr) * 4 + wc] = ss; }
        asm volatile("s_waitcnt lgkmcnt(0)" ::: "memory"); __builtin_amdgcn_s_barrier(); asm volatile("" ::: "memory");
        const int row = wid * 32 + (lane & 31);
        if (lane < 32) { const f32x4 p4 = *(const LAS f32x4*)(PT + row * 4);
            __hip_atomic_store(xbuf + ((size_t)(u.pm * 256 + row) * 8 + u.pn), (p4[0] + p4[1]) + (p4[2] + p4[3]), __ATOMIC_RELAXED, __HIP_MEMORY_SCOPE_AGENT); }
        asm volatile("s_waitcnt vmcnt(0)" ::: "memory");
        if (lane == 0) __hip_atomic_fetch_add(cnt + 64 * u.pm, 1u, __ATOMIC_RELAXED, __HIP_MEMORY_SCOPE_AGENT);
        if (wid == 0) {
            unsigned sp = 0;
            while ((unsigned)__builtin_amdgcn_readfirstlane(__hip_atomic_load(cnt + 64 * u.pm, __ATOMIC_RELAXED, __HIP_MEMORY_SCOPE_AGENT)) < 64u) { __builtin_amdgcn_s_sleep(2); if (++sp > (1u << 22)) break; }
            __builtin_amdgcn_fence(__ATOMIC_ACQUIRE, "agent");
        }
        asm volatile("s_waitcnt vmcnt(0) lgkmcnt(0)" ::: "memory"); __builtin_amdgcn_s_barrier(); asm volatile("" ::: "memory");
        if (lane < 32) { const float* sl = xbuf + (size_t)(u.pm * 256 + row) * 8; float s8 = 0.f;
#pragma unroll
            for (int t = 0; t < 8; ++t) s8 += __hip_atomic_load(sl + t, __ATOMIC_RELAXED, __HIP_MEMORY_SCOPE_AGENT);
            ST[row] = rsqrtf(s8 * (1.0f / DM) + RMS_EPS); }
        asm volatile("s_waitcnt lgkmcnt(0)" ::: "memory"); __builtin_amdgcn_s_barrier(); asm volatile("" ::: "memory");
        f32x4 fgv[2][2];
#pragma unroll
        for (int bj = 0; bj < 2; ++bj)
#pragma unroll
            for (int n = 0; n < 2; ++n) fgv[bj][n] = *(const f32x4*)(fg + col0 + bj * 128 + n * 16);
#pragma unroll
        for (int ai = 0; ai < 2; ++ai)
#pragma unroll
            for (int m = 0; m < 4; ++m) { const int rl = ai * 128 + wr * 64 + m * 16 + fr; const float rstd = ST[rl]; float* orow = out + (size_t)(u.pm * 256 + rl) * DM + col0;
#pragma unroll
                for (int bj = 0; bj < 2; ++bj)
#pragma unroll
                    for (int n = 0; n < 2; ++n) *(f32x4*)(orow + bj * 128 + n * 16) = acc[ai][bj][m][n] * rstd * fgv[bj][n]; }
    }
};

struct Args { const float* in[34]; float* out; unsigned char* ws; int ph_lo, ph_hi, li, pad; };
enum { I_XP = 0, I_XS, I_CP, I_CS, I_S5RE, I_S5IM, I_WKV, I_SHIFT, I_NORMG, I_WADA, I_BADA, I_WIN, I_MU, I_ARE, I_AIM, I_LOGSTEP, I_BRE, I_BIM, I_CRE, I_CIM, I_DSKIP,
       I_WGLU, I_BGLU, I_W0, I_W2, I_A0, I_A2, I_KK, I_KA, I_RK, I_GNW, I_GNB, I_WOUT, I_FINALG };

__device__ __forceinline__ void transpose_item(const float* W, int ldw, int K, int csrc, bf16_t* WT, int rdst, int k0, LAS float* scr, int lane, bool zero) {
    if (zero) {
#pragma unroll
        for (int j = 0; j < 4; ++j) { const int n = (lane >> 3) + 8 * j; *(u32x4*)(WT + (size_t)(rdst + n) * K + k0 + 8 * (lane & 7)) = (u32x4){0u, 0u, 0u, 0u}; }
        return;
    }
#pragma unroll 8
    for (int i = 0; i < 32; ++i) { const int kk = 2 * i + (lane >> 5); scr[kk * 33 + (lane & 31)] = W[(size_t)(k0 + kk) * ldw + csrc + (lane & 31)]; }
    LDS_WAIT(); asm volatile("" ::: "memory");
    const int c = lane & 7;
#pragma unroll
    for (int j = 0; j < 4; ++j) { const int n = (lane >> 3) + 8 * j; const LAS float* s = scr + (8 * c) * 33 + n;
        u32x4 o; o.x = cvt_pk_bf16(s[0 * 33], s[1 * 33]); o.y = cvt_pk_bf16(s[2 * 33], s[3 * 33]); o.z = cvt_pk_bf16(s[4 * 33], s[5 * 33]); o.w = cvt_pk_bf16(s[6 * 33], s[7 * 33]);
        *(u32x4*)(WT + (size_t)(rdst + n) * K + k0 + 8 * c) = o; }
    LDS_WAIT(); asm volatile("" ::: "memory");
}

__device__ __forceinline__ void wait_count(unsigned* cnt, unsigned need, int wave) {
    if (wave == 0) { unsigned sp = 0;
        while ((unsigned)__builtin_amdgcn_readfirstlane(__hip_atomic_load(cnt, __ATOMIC_RELAXED, __HIP_MEMORY_SCOPE_AGENT)) < need) { __builtin_amdgcn_s_sleep(4); if (++sp > (1u << 22)) break; }
        __builtin_amdgcn_fence(__ATOMIC_ACQUIRE, "agent");
        asm volatile("s_waitcnt vmcnt(0)" ::: "memory"); }
    __syncthreads();
}
__device__ __forceinline__ void p0_mod(const Args& a, LAS unsigned char* lds, int s, int wave, int lane) {
    const float* cp = a.in[I_CP]; const float* cs = a.in[I_CS]; const float* W = a.in[I_WADA]; const float* bias = a.in[I_BADA];
    float* mod = (float*)(a.ws + WS_MOD);
    const int n0 = 32 * s, k0 = 256 * wave, r31 = lane & 31, h = lane >> 5;
    f32x16 acc[5];
#pragma unroll
    for (int t = 0; t < 5; ++t)
#pragma unroll
        for (int r = 0; r < 16; ++r) acc[t][r] = 0.f;
    float bw[8]; f32x4 c0[5], c1[5];
#define MOD_LOAD(ks_) do { const int kb_ = k0 + 16 * (ks_) + 8 * h; \
        _Pragma("unroll") for (int j = 0; j < 8; ++j) bw[j] = W[(size_t)(kb_ + j) * NMOD + n0 + r31]; \
        _Pragma("unroll") for (int t = 0; t < 5; ++t) { const int R = 32 * t + r31; c0[t] = (f32x4){0.f, 0.f, 0.f, 0.f}; c1[t] = c0[t]; \
            if (R < NMODROWS) { const float* src = (R < NB) ? cp + (size_t)R * DM + kb_ : cs + (size_t)(R - NB) * DM + kb_; c0[t] = *(const f32x4*)src; c1[t] = *(const f32x4*)(src + 4); } } } while (0)
    MOD_LOAD(0);
#pragma unroll 1
    for (int ks = 0; ks < 16; ++ks) {
        bf16x8 bfr; { u32x4 t; t.x = cvt_pk_bf16(bw[0], bw[1]); t.y = cvt_pk_bf16(bw[2], bw[3]); t.z = cvt_pk_bf16(bw[4], bw[5]); t.w = cvt_pk_bf16(bw[6], bw[7]); bfr = __builtin_bit_cast(bf16x8, t); }
        bf16x8 afr[5];
#pragma unroll
        for (int t = 0; t < 5; ++t) { u32x4 w; w.x = cvt_pk_bf16(siluf_(c0[t][0]), siluf_(c0[t][1])); w.y = cvt_pk_bf16(siluf_(c0[t][2]), siluf_(c0[t][3])); w.z = cvt_pk_bf16(siluf_(c1[t][0]), siluf_(c1[t][1])); w.w = cvt_pk_bf16(siluf_(c1[t][2]), siluf_(c1[t][3])); afr[t] = __builtin_bit_cast(bf16x8, w); }
        if (ks + 1 < 16) MOD_LOAD(ks + 1);
#pragma unroll
        for (int t = 0; t < 5; ++t) acc[t] = __builtin_amdgcn_mfma_f32_32x32x16_bf16(afr[t], bfr, acc[t], 0, 0, 0);
    }
#undef MOD_LOAD
    LAS float* red = (LAS float*)lds;
#pragma unroll
    for (int step = 4; step >= 1; step >>= 1) {
        if (wave >= step && wave < 2 * step) {
#pragma unroll
            for (int t = 0; t < 5; ++t)
#pragma unroll
                for (int r = 0; r < 16; ++r) red[(((wave - step) * 5 + t) * 16 + r) * 64 + lane] = acc[t][r];
        }
        __syncthreads();
        if (wave < step) {
#pragma unroll
            for (int t = 0; t < 5; ++t)
#pragma unroll
                for (int r = 0; r < 16; ++r) acc[t][r] += red[((wave * 5 + t) * 16 + r) * 64 + lane];
        }
        __syncthreads();
    }
    if (wave == 0) {
        const float bc = bias[n0 + r31];
#pragma unroll
        for (int t = 0; t < 5; ++t)
#pragma unroll
            for (int r = 0; r < 16; ++r) { const int R = 32 * t + (r & 3) + 8 * (r >> 2) + 4 * h; if (R < NMODROWS) mod[(size_t)R * NMOD + n0 + r31] = acc[t][r] + bc; }
    }
}

__device__ __forceinline__ void p0_s5_tables(const Args& a, LAS unsigned char* lds, int g, int tid) {
    LAS float* pw = (LAS float*)lds;
    LAS float* bbL = pw + 17 * 128;
    LAS float* ccL = bbL + 2048;
    LAS float* KF = ccL + 2048;
    LAS float* DL = KF + 4096;
    unsigned char* tab = (unsigned char*)a.out + DO_S5TAB + (size_t)g * S5T_BYTES;
    {
        const int p = tid & 63;
        const float step = expf(a.in[I_LOGSTEP][g]);
        const float lre = fminf(a.in[I_ARE][g * 64 + p], -1e-4f), lim = a.in[I_AIM][g * 64 + p];
        const float mag = expf(lre * step); float sn, cs; sincosf(lim * step, &sn, &cs);
        const float abr = mag * cs, abi = mag * sn, den = lre * lre + lim * lim;
        const float fr = ((abr - 1.0f) * lre + abi * lim) / den, fi = (abi * lre - (abr - 1.0f) * lim) / den;
        if (tid < 64) { float pr = 1.f, pi = 0.f;
            for (int e = 0; e <= 16; ++e) { pw[(e * 64 + p) * 2] = pr; pw[(e * 64 + p) * 2 + 1] = pi; const float nr = pr * abr - pi * abi, ni = pr * abi + pi * abr; pr = nr; pi = ni; } }
#pragma unroll
        for (int i = 0; i < 2; ++i) { const int c = (tid >> 6) + 8 * i; const float br = a.in[I_BRE][(g * 64 + p) * 16 + c], bi = a.in[I_BIM][(g * 64 + p) * 16 + c];
            bbL[(p * 16 + c) * 2] = fr * br - fi * bi; bbL[(p * 16 + c) * 2 + 1] = fr * bi + fi * br;
            ccL[(c * 64 + p) * 2] = a.in[I_CRE][(g * 16 + c) * 64 + p]; ccL[(c * 64 + p) * 2 + 1] = a.in[I_CIM][(g * 16 + c) * 64 + p]; }
        if (tid < 16) DL[tid] = a.in[I_DSKIP][g * 16 + tid];
    }
    __syncthreads();
    for (int idx = tid; idx < 4096; idx += 512) { const int e = idx >> 8, c = (idx >> 4) & 15, c2 = idx & 15; float s = 0.f;
        for (int p = 0; p < 64; ++p) { const float cr = ccL[(c * 64 + p) * 2], ci = ccL[(c * 64 + p) * 2 + 1], pr = pw[(e * 64 + p) * 2], pi = pw[(e * 64 + p) * 2 + 1];
            const float ar = cr * pr - ci * pi, ai = cr * pi + ci * pr; s += ar * bbL[(p * 16 + c2) * 2] - ai * bbL[(p * 16 + c2) * 2 + 1]; }
        if (e == 0 && c == c2) s += DL[c];
        KF[idx] = s; }
    __syncthreads();
    for (int it = tid; it < 4096; it += 512) { const int l = it & 63, s = (it >> 6) & 15, mtile = it >> 10; const int m = 32 * mtile + (l & 31), h = l >> 5, p = m & 63, im = m >> 6;
        const float pr = pw[((15 - s) * 64 + p) * 2], pi = pw[((15 - s) * 64 + p) * 2 + 1]; float v[8];
#pragma unroll
        for (int j = 0; j < 8; ++j) { const float br = bbL[(p * 16 + 8 * h + j) * 2], bi = bbL[(p * 16 + 8 * h + j) * 2 + 1]; v[j] = im ? (pr * bi + pi * br) : (pr * br - pi * bi); }
        u32x4 w; w.x = cvt_pk_bf16(v[0], v[1]); w.y = cvt_pk_bf16(v[2], v[3]); w.z = cvt_pk_bf16(v[4], v[5]); w.w = cvt_pk_bf16(v[6], v[7]);
        *(u32x4*)(tab + S5T_ME + (size_t)it * 16) = w; }
    for (int it = tid; it < 1024; it += 512) { const int l = it & 63, ti = it >> 6; const int rho = l & 31, dt = rho >> 4, c = rho & 15, h = l >> 5, e = ti - 1 + dt; float v[8];
#pragma unroll
        for (int j = 0; j < 8; ++j) v[j] = (e < 0) ? 0.f : KF[(e * 16 + c) * 16 + 8 * h + j];
        u32x4 w; w.x = cvt_pk_bf16(v[0], v[1]); w.y = cvt_pk_bf16(v[2], v[3]); w.z = cvt_pk_bf16(v[4], v[5]); w.w = cvt_pk_bf16(v[6], v[7]);
        *(u32x4*)(tab + S5T_KT + (size_t)it * 16) = w; }
    for (int it = tid; it < 4096; it += 512) { const int l = it & 63, ks = (it >> 6) & 7, mt = it >> 9; const int rho = l & 31, dt = rho >> 4, c = rho & 15, h = l >> 5, t = 2 * mt + dt; float v[8];
#pragma unroll
        for (int j = 0; j < 8; ++j) { const int m = 16 * ks + 8 * h + j, p = m & 63; const float cr = ccL[(c * 64 + p) * 2], ci = ccL[(c * 64 + p) * 2 + 1], pr = pw[((t + 1) * 64 + p) * 2], pi = pw[((t + 1) * 64 + p) * 2 + 1];
            v[j] = (m < 64) ? (cr * pr - ci * pi) : -(cr * pi + ci * pr); }
        u32x4 w; w.x = cvt_pk_bf16(v[0], v[1]); w.y = cvt_pk_bf16(v[2], v[3]); w.z = cvt_pk_bf16(v[4], v[5]); w.w = cvt_pk_bf16(v[6], v[7]);
        *(u32x4*)(tab + S5T_CA + (size_t)it * 16) = w; }
    { const int it = tid; const int l = it & 63, sp = (it >> 6) & 1, mtile = it >> 7; const int rho = l & 31, h = l >> 5; float v[8];
#pragma unroll
        for (int j = 0; j < 8; ++j) { const int m = 32 * mtile + 16 * sp + 8 * (j >> 2) + 4 * h + (j & 3), p = m & 63; v[j] = (rho < 16) ? ((m < 64) ? ccL[(rho * 64 + p) * 2] : -ccL[(rho * 64 + p) * 2 + 1]) : 0.f; }
        u32x4 w; w.x = cvt_pk_bf16(v[0], v[1]); w.y = cvt_pk_bf16(v[2], v[3]); w.z = cvt_pk_bf16(v[4], v[5]); w.w = cvt_pk_bf16(v[6], v[7]);
        *(u32x4*)(tab + S5T_C0 + (size_t)it * 16) = w; }
    if (tid < 64) { const int l = tid, rho = l & 31, h = l >> 5; float v[8];
#pragma unroll
        for (int j = 0; j < 8; ++j) v[j] = (rho < 16 && rho == 8 * h + j) ? DL[rho] : 0.f;
        u32x4 w; w.x = cvt_pk_bf16(v[0], v[1]); w.y = cvt_pk_bf16(v[2], v[3]); w.z = cvt_pk_bf16(v[4], v[5]); w.w = cvt_pk_bf16(v[6], v[7]);
        *(u32x4*)(tab + S5T_DF + (size_t)l * 16) = w;
        float* hdr = (float*)(tab + S5T_HDR);
        hdr[l] = pw[(16 * 64 + l) * 2]; hdr[64 + l] = pw[(16 * 64 + l) * 2 + 1]; hdr[128 + l] = pw[(64 + l) * 2]; hdr[192 + l] = pw[(64 + l) * 2 + 1]; }
    __syncthreads();
}

__device__ __forceinline__ void p1_row(const Args& a, int m, int lane) {
    bf16_t* XN = (bf16_t*)(a.ws + WS_XN) + (size_t)m * DM;
    if (m >= MV) {
        const float* src = a.in[I_SHIFT] + (size_t)(m - MV) * DM;
#pragma unroll
        for (int j = 0; j < 8; ++j) { const f32x4 v = *(const f32x4*)(src + 4 * lane + 256 * j); u32x2 w; w.x = cvt_pk_bf16(v[0], v[1]); w.y = cvt_pk_bf16(v[2], v[3]); *(u32x2*)(XN + 4 * lane + 256 * j) = w; }
        return;
    }
    const float* x = (m < MP) ? a.in[I_XP] + (size_t)m * DM : a.in[I_XS] + (size_t)(m - MP) * DM;
    const int mrow = (m < MP) ? (m >> 11) : (NB + m - MP);
    const float* mod = (const float*)(a.ws + WS_MOD) + (size_t)mrow * NMOD;
    const float* g = a.in[I_NORMG];
    f32x4 v[8]; float ss = 0.f;
#pragma unroll
    for (int j = 0; j < 8; ++j) { v[j] = *(const f32x4*)(x + 4 * lane + 256 * j); ss += (v[j][0] * v[j][0] + v[j][1] * v[j][1]) + (v[j][2] * v[j][2] + v[j][3] * v[j][3]); }
    const float rstd = rsqrtf(wave_sum(ss) * (1.0f / DM) + RMS_EPS);
    float* sh_out = nullptr;
    if (m >= MP) sh_out = a.out + OUT_SHIFT_S + (size_t)(m - MP) * DM;
    else if ((m & (SEQ - 1)) == SEQ - 1) sh_out = a.out + OUT_SHIFT_P + (size_t)(m >> 11) * DM;
#pragma unroll
    for (int j = 0; j < 8; ++j) { const int k = 4 * lane + 256 * j; const f32x4 gv = *(const f32x4*)(g + k), sh = *(const f32x4*)(mod + k), sc = *(const f32x4*)(mod + DM + k);
        f32x4 hv;
#pragma unroll
        for (int q = 0; q < 4; ++q) hv[q] = v[j][q] * rstd * gv[q] * (1.0f + sc[q]) + sh[q];
        u32x2 w; w.x = cvt_pk_bf16(hv[0], hv[1]); w.y = cvt_pk_bf16(hv[2], hv[3]); *(u32x2*)(XN + k) = w;
        if (sh_out) *(f32x4*)(sh_out + k) = hv; }
}

constexpr int RW_TB = 32;
constexpr int RW_KK = 0, RW_DR = 2048, RW_DD = 4096, RW_BB = 6144, RW_KP = 8192, RW_VV = 10240, RW_SC = 11264, RW_LW = 11392, RW_LA = 13440, RW_OB = 15488, RW_BVB = 16512, RW_END = 17536;
__device__ __forceinline__ void lerp8(const bf16_t* cur, const bf16_t* prev, bool has_prev, const float* mu, float (&o)[8]) {
    const u32x4 c = *(const u32x4*)cur; u32x4 p = (u32x4){0u, 0u, 0u, 0u}; if (has_prev) p = *(const u32x4*)prev;
    const f32x4 m0 = *(const f32x4*)mu, m1 = *(const f32x4*)(mu + 4);
    const float cf[8] = {bf_lo(c.x), bf_hi(c.x), bf_lo(c.y), bf_hi(c.y), bf_lo(c.z), bf_hi(c.z), bf_lo(c.w), bf_hi(c.w)};
    const float pf[8] = {bf_lo(p.x), bf_hi(p.x), bf_lo(p.y), bf_hi(p.y), bf_lo(p.z), bf_hi(p.z), bf_lo(p.w), bf_hi(p.w)};
    const float mf[8] = {m0[0], m0[1], m0[2], m0[3], m1[0], m1[1], m1[2], m1[3]};
#pragma unroll
    for (int j = 0; j < 8; ++j) o[j] = cf[j] + (pf[j] - cf[j]) * mf[j];
}
struct RwTok { float kk, dr, dd, bb, kp, v, br, kr, bonus; };
__device__ __forceinline__ RwTok rw_token(const Args& a, int hj, float r, float k, float v, float lw, float la) {
    RwTok o;
    const float wpre = a.in[I_W0][hj] + lw;
    const float nz = -wpre;
    const float sp = fmaxf(nz, 0.f) + log1pf(__expf(-fabsf(nz)));
    const float w = -sp - 0.5f;
    o.dd = __expf(-__expf(w));
    const float av = sigmoidf_(a.in[I_A0][hj] + la);
    const float kkv = k * a.in[I_KK][hj];
    const float nrm = sqrtf(wave_sum(kkv * kkv));
    o.kk = kkv / fmaxf(nrm, 1e-12f);
    o.kp = k * (1.0f + (av - 1.0f) * a.in[I_KA][hj]);
    o.bb = o.kk * av;
    o.dr = o.dd * r;
    o.v = v;
    o.br = wave_sum(o.bb * r);
    o.kr = wave_sum(o.kp * r);
    o.bonus = wave_sum(r * o.kp * a.in[I_RK][hj]);
    return o;
}
__device__ __forceinline__ void p3_rwkv_prompt(const Args& a, LAS unsigned char* lds, int unit, int tid, int wave, int lane) {
    const int b = unit >> 5, h = (unit >> 1) & 15, half = unit & 1;
    LAS float* L = (LAS float*)lds;
    const bf16_t* P = (const bf16_t*)(a.ws + WS_P);
    bf16_t* ORAW = (bf16_t*)((unsigned char*)a.out + DO_ORAW); bf16_t* BV = (bf16_t*)((unsigned char*)a.out + DO_BV);
    const float* mu = a.in[I_MU];
    const int r31 = lane & 31, hh = lane >> 5;
    bf16x8 bfr[4];
    if (wave < 4) { const float* W2 = (wave >> 1) ? a.in[I_A2] : a.in[I_W2]; const int col = h * 64 + 32 * (wave & 1) + r31;
#pragma unroll
        for (int ks = 0; ks < 4; ++ks) { float w[8];
#pragma unroll
            for (int j = 0; j < 8; ++j) w[j] = W2[(size_t)(16 * ks + 8 * hh + j) * 1024 + col];
            u32x4 t; t.x = cvt_pk_bf16(w[0], w[1]); t.y = cvt_pk_bf16(w[2], w[3]); t.z = cvt_pk_bf16(w[4], w[5]); t.w = cvt_pk_bf16(w[6], w[7]); bfr[ks] = __builtin_bit_cast(bf16x8, t); } }
    const int srow = 4 * wave + (lane >> 4), cq = lane & 15;
    f32x4 S = (f32x4){0.f, 0.f, 0.f, 0.f};
    for (int t0 = 0; t0 < SEQ; t0 += RW_TB) {
        const size_t rowbase = (size_t)b * SEQ + t0;
        if (wave < 4) { const int mat = wave >> 1, nt2 = wave & 1; const size_t row = rowbase + r31; const bool hp = (t0 + r31) > 0;
            f32x16 acc;
#pragma unroll
            for (int r = 0; r < 16; ++r) acc[r] = 0.f;
#pragma unroll
            for (int ks = 0; ks < 4; ++ks) { const int col = PC_WD + mat * 64 + 16 * ks + 8 * hh; float x8[8];
                lerp8(P + row * LDP + col, P + (row - 1) * LDP + col, hp, mu + 3072 + mat * 64 + 16 * ks + 8 * hh, x8);
                if (mat == 0) {
#pragma unroll
                    for (int j = 0; j < 8; ++j) x8[j] = tanhf_(x8[j]); }
                u32x4 t; t.x = cvt_pk_bf16(x8[0], x8[1]); t.y = cvt_pk_bf16(x8[2], x8[3]); t.z = cvt_pk_bf16(x8[4], x8[5]); t.w = cvt_pk_bf16(x8[6], x8[7]);
                acc = __builtin_amdgcn_mfma_f32_32x32x16_bf16(__builtin_bit_cast(bf16x8, t), bfr[ks], acc, 0, 0, 0); }
            LAS float* dst = L + (mat ? RW_LA : RW_LW);
#pragma unroll
            for (int r = 0; r < 16; ++r) { const int tl = (r & 3) + 8 * (r >> 2) + 4 * hh; dst[tl * 64 + 32 * nt2 + r31] = acc[r]; } }
        __syncthreads();
#pragma unroll
        for (int q = 0; q < 4; ++q) { const int tl = wave * 4 + q; const size_t row = rowbase + tl; const bool hp = (t0 + tl) > 0; const int hj = h * 64 + lane;
            const bf16_t* pc = P + row * LDP; const bf16_t* pp = pc - LDP;
            float r = bf2f(pc[PC_R + hj]), k = bf2f(pc[PC_K + hj]), v = bf2f(pc[PC_V + hj]);
            const float pr = hp ? bf2f(pp[PC_R + hj]) : 0.f, pk = hp ? bf2f(pp[PC_K + hj]) : 0.f, pv = hp ? bf2f(pp[PC_V + hj]) : 0.f;
            r += (pr - r) * mu[hj]; k += (pk - k) * mu[1024 + hj]; v += (pv - v) * mu[2048 + hj];
            const RwTok o = rw_token(a, hj, r, k, v, L[RW_LW + tl * 64 + lane], L[RW_LA + tl * 64 + lane]);
            L[RW_KK + tl * 64 + lane] = o.kk; L[RW_DR + tl * 64 + lane] = o.dr; L[RW_DD + tl * 64 + lane] = o.dd; L[RW_BB + tl * 64 + lane] = o.bb; L[RW_KP + tl * 64 + lane] = o.kp;
            if ((lane >> 5) == half) L[RW_VV + tl * 32 + (lane & 31)] = o.v;
            if (lane == 0) { L[RW_SC + tl * 4] = o.br; L[RW_SC + tl * 4 + 1] = o.kr; L[RW_SC + tl * 4 + 2] = o.bonus; } }
        __syncthreads();
#pragma unroll 4
        for (int tl = 0; tl < RW_TB; ++tl) {
            const f32x4 kk4 = *(const LAS f32x4*)(L + RW_KK + tl * 64 + 4 * cq), dr4 = *(const LAS f32x4*)(L + RW_DR + tl * 64 + 4 * cq), d4 = *(const LAS f32x4*)(L + RW_DD + tl * 64 + 4 * cq),
                        b4 = *(const LAS f32x4*)(L + RW_BB + tl * 64 + 4 * cq), k4 = *(const LAS f32x4*)(L + RW_KP + tl * 64 + 4 * cq);
            const float v = L[RW_VV + tl * 32 + srow]; const f32x4 sc = *(const LAS f32x4*)(L + RW_SC + tl * 4);
            float p1 = (S[0] * kk4[0] + S[1] * kk4[1]) + (S[2] * kk4[2] + S[3] * kk4[3]);
            float p2 = (S[0] * dr4[0] + S[1] * dr4[1]) + (S[2] * dr4[2] + S[3] * dr4[3]);
            p1 = row16_sum(p1); p2 = row16_sum(p2);
            const float sa = -p1;
            const float o = p2 + sa * sc[0] + v * sc[1];
#pragma unroll
            for (int j = 0; j < 4; ++j) S[j] = S[j] * d4[j] + sa * b4[j] + v * k4[j];
            if (cq == 0) { L[RW_OB + tl * 32 + srow] = o; L[RW_BVB + tl * 32 + srow] = sc[2] * v; }
        }
        __syncthreads();
        { const int tl = tid >> 4, r2 = 2 * (tid & 15); const size_t off = (rowbase + tl) * 1024 + h * 64 + 32 * half + r2;
          *(unsigned*)(ORAW + off) = cvt_pk_bf16(L[RW_OB + tl * 32 + r2], L[RW_OB + tl * 32 + r2 + 1]);
          *(unsigned*)(BV + off) = cvt_pk_bf16(L[RW_BVB + tl * 32 + r2], L[RW_BVB + tl * 32 + r2 + 1]); }
    }
    *(f32x4*)(a.out + OUT_WKV_P + (((size_t)(b * 16 + h) * 64 + 32 * half + srow) * 64 + 4 * cq)) = S;
    __syncthreads();
}


constexpr int RC_LD = 72, RC_MAT = 64 * RC_LD * 2;
constexpr int RC_QK = 0 * RC_MAT, RC_RT = 1 * RC_MAT, RC_KT = 2 * RC_MAT, RC_BT = 3 * RC_MAT, RC_QKT = 4 * RC_MAT, RC_BHT = 5 * RC_MAT, RC_KHT = 6 * RC_MAT, RC_VT = 7 * RC_MAT,
              RC_AKK = 8 * RC_MAT, RC_ARK = 9 * RC_MAT, RC_ARB = 10 * RC_MAT, RC_TB = 11 * RC_MAT, RC_AKB = 12 * RC_MAT, RC_W1T = 12 * RC_MAT, RC_U1T = 13 * RC_MAT,
              RC_AVT = RC_QK, RC_TF = RC_KT, RC_LWA = RC_AKK, RC_SEG = 14 * RC_MAT;
static_assert(RC_SEG + 2048 <= RING_BYTES, "rwkv chunk lds");
constexpr int RS_ROWB = 656, RS_BASE = 0;
static_assert(RS_BASE + 65 * RS_ROWB <= RC_AKK, "staging must stay inside R0..R7");
#define MFMA32(a, b, c) __builtin_amdgcn_mfma_f32_32x32x16_bf16((a), (b), (c), 0, 0, 0)
#define MFMA16(a, b, c) __builtin_amdgcn_mfma_f32_16x16x32_bf16((a), (b), (c), 0, 0, 0)
__device__ __forceinline__ bf16x8 lds_frag(LAS unsigned char* lds, int mat, int row, int k0) { return *(const LAS bf16x8*)(lds + mat + (row * RC_LD + k0) * 2); }

__device__ __forceinline__ void p3_rwkv_chunks(const Args& a, LAS unsigned char* lds, int bh, int seg, int tid, int wave, int lane) {
    const int b = bh >> 4, h = bh & 15, r31_ = lane & 31, hh_ = lane >> 5, hj = h * 64 + lane;
    const bf16_t* P = (const bf16_t*)(a.ws + WS_P);
    bf16_t* BV = (bf16_t*)((unsigned char*)a.out + DO_BV);
    const float* mu = a.in[I_MU];
    LAS float* SEG = (LAS float*)(lds + RC_SEG);
    bf16x8 bfr[4];
    { const float* W2 = (wave >> 2) ? a.in[I_A2] : a.in[I_W2]; const int col = h * 64 + 32 * (wave & 1) + r31_;
#pragma unroll
      for (int ks = 0; ks < 4; ++ks) { float w[8];
#pragma unroll
          for (int j = 0; j < 8; ++j) w[j] = W2[(size_t)(16 * ks + 8 * hh_ + j) * 1024 + col];
          u32x4 t; t.x = cvt_pk_bf16(w[0], w[1]); t.y = cvt_pk_bf16(w[2], w[3]); t.z = cvt_pk_bf16(w[4], w[5]); t.w = cvt_pk_bf16(w[6], w[7]); bfr[ks] = __builtin_bit_cast(bf16x8, t); } }
    const float w0j = a.in[I_W0][hj], a0j = a.in[I_A0][hj], kkj = a.in[I_KK][hj], kaj = a.in[I_KA][hj], rkj = a.in[I_RK][hj];
    const float mur = mu[hj], muk = mu[1024 + hj], muv = mu[2048 + hj];
    unsigned goff[6], loff[6]; u32x4 pf[6];
#pragma unroll
    for (int i = 0; i < 6; ++i) { const int idx = tid + 512 * i, row = idx / 40, c = idx - row * 40;
        const int col = (c < 8) ? PC_R + h * 64 + 8 * c : ((c < 16) ? PC_K + h * 64 + 8 * (c - 8) : ((c < 24) ? PC_V + h * 64 + 8 * (c - 16) : PC_WD + 8 * (c - 24)));
        goff[i] = (unsigned)(row * LDP + col) * 2u; loff[i] = (unsigned)(RS_BASE + row * RS_ROWB + c * 16); }
#define RWC_PREFETCH(chunk_) do { const unsigned char* pb_ = (const unsigned char*)(P + ((size_t)b * SEQ + (size_t)(chunk_) * 64 - 1) * LDP); \
        _Pragma("unroll") for (int i = 0; i < 6; ++i) { const bool ok_ = (tid + 512 * i < 2600) && ((chunk_) > 0 || tid + 512 * i >= 40); \
            pf[i] = (u32x4){0u, 0u, 0u, 0u}; if (ok_) pf[i] = *(const u32x4*)(pb_ + goff[i]); } } while (0)
    RWC_PREFETCH(seg * 8);
#pragma unroll 1
    for (int ci = 0; ci < 8; ++ci) {
        const int chunk = seg * 8 + ci; const size_t rowbase = (size_t)b * SEQ + chunk * 64;
#pragma unroll
        for (int i = 0; i < 6; ++i) if (tid + 512 * i < 2600) *(LAS u32x4*)(lds + loff[i]) = pf[i];
        if (ci + 1 < 8) RWC_PREFETCH(chunk + 1);
        __syncthreads();
        int r31 = r31_, hh = hh_; asm volatile("" : "+v"(r31), "+v"(hh));
        unsigned char* rwi = a.ws + WS_RWI + (size_t)((bh * 32) + chunk) * RWI_BYTES;
        { const int mat = wave >> 2, mtile = (wave >> 1) & 1, nt2 = wave & 1; const int tl = 32 * mtile + r31;
          f32x16 acc;
#pragma unroll
          for (int r = 0; r < 16; ++r) acc[r] = 0.f;
#pragma unroll
          for (int ks = 0; ks < 4; ++ks) { float x8[8];
              { const u32x4 c = *(const LAS u32x4*)(lds + RS_BASE + (tl + 1) * RS_ROWB + (24 + mat * 8 + 2 * ks + hh) * 16), p = *(const LAS u32x4*)(lds + RS_BASE + tl * RS_ROWB + (24 + mat * 8 + 2 * ks + hh) * 16);
                const float cf[8] = {bf_lo(c.x), bf_hi(c.x), bf_lo(c.y), bf_hi(c.y), bf_lo(c.z), bf_hi(c.z), bf_lo(c.w), bf_hi(c.w)};
                const float pf8[8] = {bf_lo(p.x), bf_hi(p.x), bf_lo(p.y), bf_hi(p.y), bf_lo(p.z), bf_hi(p.z), bf_lo(p.w), bf_hi(p.w)};
                const float* mp = mu + 3072 + mat * 64 + 16 * ks + 8 * hh; const f32x4 m0 = *(const f32x4*)mp, m1 = *(const f32x4*)(mp + 4);
                const float mf[8] = {m0[0], m0[1], m0[2], m0[3], m1[0], m1[1], m1[2], m1[3]};
#pragma unroll
                for (int j = 0; j < 8; ++j) x8[j] = cf[j] + (pf8[j] - cf[j]) * mf[j]; }
              if (mat == 0) {
#pragma unroll
                  for (int j = 0; j < 8; ++j) x8[j] = tanhf_(x8[j]); }
              u32x4 t; t.x = cvt_pk_bf16(x8[0], x8[1]); t.y = cvt_pk_bf16(x8[2], x8[3]); t.z = cvt_pk_bf16(x8[4], x8[5]); t.w = cvt_pk_bf16(x8[6], x8[7]);
              acc = MFMA32(__builtin_bit_cast(bf16x8, t), bfr[ks], acc); }
          LAS float* dst = (LAS float*)(lds + RC_LWA) + mat * 64 * 68;
#pragma unroll
          for (int r = 0; r < 16; ++r) { const int t2 = 32 * mtile + (r & 3) + 8 * (r >> 2) + 4 * hh; dst[t2 * 68 + 32 * nt2 + r31] = acc[r]; } }
        __syncthreads();
        float r8[8], kp8[8], kk8[8], bb8[8], v8[8], ld8[8], cs8[8];
        { const LAS float* LW = (const LAS float*)(lds + RC_LWA); const LAS float* LA = LW + 64 * 68;
#pragma unroll
          for (int q = 0; q < 8; ++q) { const int tl = 8 * wave + q; const size_t row = rowbase + tl;
              const LAS bf16_t* pc = (const LAS bf16_t*)(lds + RS_BASE + (tl + 1) * RS_ROWB); const LAS bf16_t* pp = (const LAS bf16_t*)(lds + RS_BASE + tl * RS_ROWB);
              float r = bf2f(pc[lane]), k = bf2f(pc[64 + lane]), v = bf2f(pc[128 + lane]);
              const float pr = bf2f(pp[lane]), pk = bf2f(pp[64 + lane]), pv = bf2f(pp[128 + lane]);
              r += (pr - r) * mur; k += (pk - k) * muk; v += (pv - v) * muv;
              ld8[q] = -0.6065306597126334f * sigmoidf_(w0j + LW[tl * 68 + lane]);
              const float av = sigmoidf_(a0j + LA[tl * 68 + lane]);
              const float kkv = k * kkj; const float rn = fminf(__builtin_amdgcn_rsqf(wave_sum_dpp(kkv * kkv)), 1e12f);
              kk8[q] = kkv * rn; kp8[q] = k * (1.0f + (av - 1.0f) * kaj); bb8[q] = kk8[q] * av; r8[q] = r; v8[q] = v;
              const float bonus = wave_sum_dpp(r * kp8[q] * rkj);
              BV[row * 1024 + hj] = f2bf(bonus * v); }
          cs8[0] = ld8[0];
#pragma unroll
          for (int q = 1; q < 8; ++q) cs8[q] = cs8[q - 1] + ld8[q];
          SEG[wave * 64 + lane] = cs8[7]; }
        __syncthreads();
        { float off = 0.f, cL = 0.f;
#pragma unroll
          for (int w2 = 0; w2 < 8; ++w2) { const float sg = SEG[w2 * 64 + lane]; cL += sg; if (w2 < wave) off += sg; }
          if (wave == 0) *(float*)(rwi + RWI_LAM + lane * 4) = __expf(cL);
          float qkT[8], bhT[8], khT[8];
          const float eLtot = __expf(cL); float ecprev = __expf(off);
#pragma unroll
          for (int q = 0; q < 8; ++q) { const int tl = 8 * wave + q; const float c = off + cs8[q];
              const float ec = __expf(c), ecp = ecprev, enc = rcpf_(ec), eL = eLtot * enc; ecprev = ec;
              const float qk = kk8[q] * ecp;
              ((LAS bf16_t*)(lds + RC_QK))[tl * RC_LD + lane] = f2bf(qk); ((LAS bf16_t*)(lds + RC_RT))[tl * RC_LD + lane] = f2bf(r8[q] * ec);
              ((LAS bf16_t*)(lds + RC_KT))[tl * RC_LD + lane] = f2bf(kp8[q] * enc); ((LAS bf16_t*)(lds + RC_BT))[tl * RC_LD + lane] = f2bf(bb8[q] * enc);
              qkT[q] = qk; bhT[q] = bb8[q] * eL; khT[q] = kp8[q] * eL; }
          u32x4 t;
          t.x = cvt_pk_bf16(qkT[0], qkT[1]); t.y = cvt_pk_bf16(qkT[2], qkT[3]); t.z = cvt_pk_bf16(qkT[4], qkT[5]); t.w = cvt_pk_bf16(qkT[6], qkT[7]); *(LAS u32x4*)(lds + RC_QKT + (lane * RC_LD + 8 * wave) * 2) = t;
          t.x = cvt_pk_bf16(bhT[0], bhT[1]); t.y = cvt_pk_bf16(bhT[2], bhT[3]); t.z = cvt_pk_bf16(bhT[4], bhT[5]); t.w = cvt_pk_bf16(bhT[6], bhT[7]); *(LAS u32x4*)(lds + RC_BHT + (lane * RC_LD + 8 * wave) * 2) = t;
          t.x = cvt_pk_bf16(khT[0], khT[1]); t.y = cvt_pk_bf16(khT[2], khT[3]); t.z = cvt_pk_bf16(khT[4], khT[5]); t.w = cvt_pk_bf16(khT[6], khT[7]); *(LAS u32x4*)(lds + RC_KHT + (lane * RC_LD + 8 * wave) * 2) = t;
          t.x = cvt_pk_bf16(v8[0], v8[1]); t.y = cvt_pk_bf16(v8[2], v8[3]); t.z = cvt_pk_bf16(v8[4], v8[5]); t.w = cvt_pk_bf16(v8[6], v8[7]); *(LAS u32x4*)(lds + RC_VT + (lane * RC_LD + 8 * wave) * 2) = t; }
        __syncthreads();
#pragma unroll
        for (int jr = 0; jr < 2; ++jr) { const int job = wave + 8 * jr; if (job < 12) {
            const int mat = job / 3, tt = job % 3, ms = (tt == 2) ? 1 : 0, nt2 = (tt == 0) ? 0 : 1;
            const int X = (mat & 1) ? RC_BT : RC_KT, Y = (mat & 2) ? RC_RT : RC_QK;
            f32x16 acc;
#pragma unroll
            for (int r = 0; r < 16; ++r) acc[r] = 0.f;
#pragma unroll
            for (int ks = 0; ks < 4; ++ks) acc = MFMA32(lds_frag(lds, X, 32 * ms + r31, 16 * ks + 8 * hh), lds_frag(lds, Y, 32 * nt2 + r31, 16 * ks + 8 * hh), acc);
            const int t = 32 * nt2 + r31; const bool incl = (mat & 2) != 0;
#pragma unroll
            for (int g4 = 0; g4 < 4; ++g4) { const int s0 = 32 * ms + 8 * g4 + 4 * hh; float v[4];
#pragma unroll
                for (int e = 0; e < 4; ++e) { const int sx = s0 + e; v[e] = (incl ? (sx <= t) : (sx < t)) ? acc[4 * g4 + e] : 0.f; }
                if (mat == 1) *(LAS f32x4*)(lds + RC_AKB + (t * 72 + s0) * 4) = (f32x4){v[0], v[1], v[2], v[3]};
                else { const int dstm = (mat == 0) ? RC_AKK : ((mat == 2) ? RC_ARK : RC_ARB); *(LAS u32x2*)(lds + dstm + (t * RC_LD + s0) * 2) = pack4(v[0], v[1], v[2], v[3]); } } } }
        __syncthreads();
        LAS float* TF = (LAS float*)(lds + RC_TF); const LAS float* AKB = (const LAS float*)(lds + RC_AKB); LAS float* YS = SEG;
        if (wave == 0) {
            const int I = lane >> 4, jj = lane & 15; float x[16];
#pragma unroll
            for (int r = 0; r < 16; ++r) { float sacc = (r == jj) ? 1.f : 0.f;
#pragma unroll
                for (int q = 0; q < r; ++q) sacc -= AKB[(16 * I + r) * 72 + 16 * I + q] * x[q];
                x[r] = sacc; TF[(16 * I + r) * 72 + 16 * I + jj] = sacc; }
        } else if (wave < 4) {
            const int t2 = tid - 64;
            for (int e = t2; e < 512; e += 192) { const int blk = e >> 8, rr = (e >> 4) & 15, cc = e & 15; TF[(32 * blk + rr) * 72 + 32 * blk + 16 + cc] = 0.f; }
        } else {
            const int mt = (wave >> 1) & 1, nt2 = wave & 1; f32x16 acc;
#pragma unroll
            for (int r = 0; r < 16; ++r) acc[r] = 0.f;
#pragma unroll
            for (int ks = 0; ks < 4; ++ks) if (ks < 2 || mt == 1) acc = MFMA32(lds_frag(lds, RC_AKK, 32 * mt + r31, 16 * ks + 8 * hh), lds_frag(lds, RC_VT, 32 * nt2 + r31, 16 * ks + 8 * hh), acc);
#pragma unroll
            for (int g4 = 0; g4 < 4; ++g4) *(LAS u32x2*)(lds + RC_AVT + ((32 * nt2 + r31) * RC_LD + 32 * mt + 8 * g4 + 4 * hh) * 2) = pack4(acc[4 * g4], acc[4 * g4 + 1], acc[4 * g4 + 2], acc[4 * g4 + 3]);
        }
        __syncthreads();
        { const int pr = tid >> 8, i = (tid >> 4) & 15, jj = tid & 15, ba = 2 * pr, bb = 2 * pr + 1;
          float y = 0.f;
#pragma unroll
          for (int q = 0; q < 16; ++q) y += AKB[(16 * bb + i) * 72 + 16 * ba + q] * TF[(16 * ba + q) * 72 + 16 * ba + jj];
          YS[tid] = y; }
        __syncthreads();
        { const int pr = tid >> 8, i = (tid >> 4) & 15, jj = tid & 15, ba = 2 * pr, bb = 2 * pr + 1; float tv = 0.f;
#pragma unroll
          for (int q = 0; q < 16; ++q) tv -= TF[(16 * bb + i) * 72 + 16 * bb + q] * YS[pr * 256 + q * 16 + jj];
          TF[(16 * bb + i) * 72 + 16 * ba + jj] = tv; }
        __syncthreads();
        { const int i = tid >> 4, j0 = (tid & 15) * 2; float z0 = 0.f, z1 = 0.f;
#pragma unroll 8
          for (int q = 0; q < 32; ++q) { const float av = AKB[(32 + i) * 72 + q]; z0 += av * TF[q * 72 + j0]; z1 += av * TF[q * 72 + j0 + 1]; }
          __syncthreads();
          TF[i * 72 + 32 + j0] = z0; TF[i * 72 + 32 + j0 + 1] = z1; }
        __syncthreads();
        { const int i = tid >> 4, j0 = (tid & 15) * 2; float t0 = 0.f, t1 = 0.f;
#pragma unroll 8
          for (int q = 0; q < 32; ++q) { const float tb = TF[(32 + i) * 72 + 32 + q]; t0 -= tb * TF[q * 72 + 32 + j0]; t1 -= tb * TF[q * 72 + 32 + j0 + 1]; }
          TF[(32 + i) * 72 + j0] = t0; TF[(32 + i) * 72 + j0 + 1] = t1; }
        __syncthreads();
        { const int t = tid >> 3, c0 = (tid & 7) * 8; const f32x4 x0 = *(const LAS f32x4*)(TF + t * 72 + c0), x1 = *(const LAS f32x4*)(TF + t * 72 + c0 + 4);
          u32x4 w; w.x = cvt_pk_bf16(x0[0], x0[1]); w.y = cvt_pk_bf16(x0[2], x0[3]); w.z = cvt_pk_bf16(x1[0], x1[1]); w.w = cvt_pk_bf16(x1[2], x1[3]);
          *(LAS u32x4*)(lds + RC_TB + (t * RC_LD + c0) * 2) = w; }
        __syncthreads();
        { const int which = wave >> 2, mt = (wave >> 1) & 1, nt2 = wave & 1; const int Bm = which ? RC_AVT : RC_QKT, Dm = which ? RC_U1T : RC_W1T; f32x16 acc;
#pragma unroll
          for (int r = 0; r < 16; ++r) acc[r] = 0.f;
#pragma unroll
          for (int ks = 0; ks < 4; ++ks) if (ks < 2 || mt == 1) acc = MFMA32(lds_frag(lds, RC_TB, 32 * mt + r31, 16 * ks + 8 * hh), lds_frag(lds, Bm, 32 * nt2 + r31, 16 * ks + 8 * hh), acc);
#pragma unroll
          for (int g4 = 0; g4 < 4; ++g4) *(LAS u32x2*)(lds + Dm + ((32 * nt2 + r31) * RC_LD + 32 * mt + 8 * g4 + 4 * hh) * 2) = pack4(acc[4 * g4], acc[4 * g4 + 1], acc[4 * g4 + 2], acc[4 * g4 + 3]); }
        __syncthreads();
        { const int kind = wave >> 2, mt = (wave >> 1) & 1, nt2 = wave & 1; const int cidx = 32 * nt2 + r31;
          f32x16 acc;
#pragma unroll
          for (int r = 0; r < 16; ++r) acc[r] = 0.f;
          if (kind == 0) {
#pragma unroll
              for (int ks = 0; ks < 4; ++ks) acc = MFMA32(lds_frag(lds, RC_W1T, 32 * mt + r31, 16 * ks + 8 * hh), lds_frag(lds, RC_BHT, cidx, 16 * ks + 8 * hh), acc);
#pragma unroll
              for (int g4 = 0; g4 < 4; ++g4) { const int jo = 8 * g4 + 4 * hh, half = jo >> 4, q2 = (jo & 15) >> 2; const int blk = (cidx >> 4) * 2 + mt, lane2 = (cidx & 15) + 16 * q2;
                  *(u32x2*)(rwi + RWI_GF + (blk * 64 + lane2) * 16 + half * 8) = pack4(-acc[4 * g4], -acc[4 * g4 + 1], -acc[4 * g4 + 2], -acc[4 * g4 + 3]); }
          } else {
#pragma unroll
              for (int ks = 0; ks < 4; ++ks) if (ks < 2 || nt2 == 1) acc = MFMA32(lds_frag(lds, RC_W1T, 32 * mt + r31, 16 * ks + 8 * hh), lds_frag(lds, RC_ARB, cidx, 16 * ks + 8 * hh), acc);
#pragma unroll
              for (int g4 = 0; g4 < 4; ++g4) { const int jo = 8 * g4 + 4 * hh, half = jo >> 4, q2 = (jo & 15) >> 2; const int blk = (cidx >> 4) * 2 + mt, lane2 = (cidx & 15) + 16 * q2;
                  const u32x2 rt = *(const LAS u32x2*)(lds + RC_RT + (cidx * RC_LD + 32 * mt + jo) * 2);
                  *(u32x2*)(rwi + RWI_W2F + (blk * 64 + lane2) * 16 + half * 8) = pack4(bf_lo(rt.x) - acc[4 * g4], bf_hi(rt.x) - acc[4 * g4 + 1], bf_lo(rt.y) - acc[4 * g4 + 2], bf_hi(rt.y) - acc[4 * g4 + 3]); }
          }
          f32x16 ac1, ac2;
#pragma unroll
          for (int r = 0; r < 16; ++r) { ac1[r] = 0.f; ac2[r] = 0.f; }
          if (kind == 0) {
#pragma unroll
              for (int ks = 0; ks < 4; ++ks) { ac1 = MFMA32(lds_frag(lds, RC_KHT, 32 * mt + r31, 16 * ks + 8 * hh), lds_frag(lds, RC_VT, cidx, 16 * ks + 8 * hh), ac1);
                                               ac2 = MFMA32(lds_frag(lds, RC_BHT, 32 * mt + r31, 16 * ks + 8 * hh), lds_frag(lds, RC_U1T, cidx, 16 * ks + 8 * hh), ac2); }
#pragma unroll
              for (int g4 = 0; g4 < 4; ++g4) { const int ro = 32 * mt + 8 * g4 + 4 * hh, mt2 = ro >> 4, q2 = (ro & 15) >> 2, cb = cidx >> 4, lane2 = (cidx & 15) + 16 * q2;
                  *(f32x4*)(rwi + RWI_H1F + ((cb * 4 + mt2) * 64 + lane2) * 16) = (f32x4){ac1[4 * g4] - ac2[4 * g4], ac1[4 * g4 + 1] - ac2[4 * g4 + 1], ac1[4 * g4 + 2] - ac2[4 * g4 + 2], ac1[4 * g4 + 3] - ac2[4 * g4 + 3]}; }
          } else {
#pragma unroll
              for (int ks = 0; ks < 4; ++ks) if (ks < 2 || nt2 == 1) { ac1 = MFMA32(lds_frag(lds, RC_VT, 32 * mt + r31, 16 * ks + 8 * hh), lds_frag(lds, RC_ARK, cidx, 16 * ks + 8 * hh), ac1);
                                                                        ac2 = MFMA32(lds_frag(lds, RC_U1T, 32 * mt + r31, 16 * ks + 8 * hh), lds_frag(lds, RC_ARB, cidx, 16 * ks + 8 * hh), ac2); }
#pragma unroll
              for (int g4 = 0; g4 < 4; ++g4) { const int ro = 32 * mt + 8 * g4 + 4 * hh, cb = ro >> 4, q2 = (ro & 15) >> 2, nt3 = cidx >> 4, lane2 = (cidx & 15) + 16 * q2;
                  *(f32x4*)(rwi + RWI_O1F + ((cb * 4 + nt3) * 64 + lane2) * 16) = (f32x4){ac1[4 * g4] - ac2[4 * g4], ac1[4 * g4 + 1] - ac2[4 * g4 + 1], ac1[4 * g4 + 2] - ac2[4 * g4 + 2], ac1[4 * g4 + 3] - ac2[4 * g4 + 3]}; }
          } }
        __syncthreads();
    }
}

__device__ __forceinline__ void p3_rwkv_seq(const Args& a, int unit, int lane) {
    const int bh = unit >> 2, cb = unit & 3, l15 = lane & 15, q = lane >> 4;
    f32x4 hacc[4];
#pragma unroll
    for (int m = 0; m < 4; ++m) hacc[m] = (f32x4){0.f, 0.f, 0.f, 0.f};
    const unsigned char* base = a.ws + WS_RWI + (size_t)(bh * 32) * RWI_BYTES;
    unsigned char* hbo = a.ws + WS_HB + (size_t)unit * 32 * 2048;
    bf16x8 gfA[8], gfB[8]; f32x4 h1A[4], h1B[4], lamA[4], lamB[4];
#define RW2_LOADG(gf, h1, lam, src) do { _Pragma("unroll") for (int k2 = 0; k2 < 8; ++k2) gf[k2] = *(const bf16x8*)((src) + RWI_GF + (k2 * 64 + lane) * 16); \
        _Pragma("unroll") for (int m = 0; m < 4; ++m) { h1[m] = *(const f32x4*)((src) + RWI_H1F + ((cb * 4 + m) * 64 + lane) * 16); lam[m] = *(const f32x4*)((src) + RWI_LAM + (16 * m + 4 * q) * 4); } } while (0)
#define RW2_STEP(c_, gf, h1, lam) do { const int c = (c_); \
        bf16x8 hb[2]; \
        _Pragma("unroll") for (int ks = 0; ks < 2; ++ks) { u32x4 t; t.x = cvt_pk_bf16(hacc[2 * ks][0], hacc[2 * ks][1]); t.y = cvt_pk_bf16(hacc[2 * ks][2], hacc[2 * ks][3]); \
            t.z = cvt_pk_bf16(hacc[2 * ks + 1][0], hacc[2 * ks + 1][1]); t.w = cvt_pk_bf16(hacc[2 * ks + 1][2], hacc[2 * ks + 1][3]); hb[ks] = __builtin_bit_cast(bf16x8, t); \
            *(bf16x8*)(hbo + (size_t)c * 2048 + (ks * 64 + lane) * 16) = hb[ks]; } \
        _Pragma("unroll") for (int m = 0; m < 4; ++m) { f32x4 nacc = h1[m] + lam[m] * hacc[m]; \
            _Pragma("unroll") for (int ks = 0; ks < 2; ++ks) nacc = MFMA16(gf[m * 2 + ks], hb[ks], nacc); hacc[m] = nacc; } \
        if (c + 2 < 32) RW2_LOADG(gf, h1, lam, base + (size_t)(c + 2) * RWI_BYTES); } while (0)
    RW2_LOADG(gfA, h1A, lamA, base); RW2_LOADG(gfB, h1B, lamB, base + RWI_BYTES);
#pragma unroll 1
    for (int c2 = 0; c2 < 32; c2 += 2) { RW2_STEP(c2, gfA, h1A, lamA); RW2_STEP(c2 + 1, gfB, h1B, lamB); }
#undef RW2_STEP
#undef RW2_LOADG
#pragma unroll
    for (int m = 0; m < 4; ++m) *(f32x4*)(a.out + OUT_WKV_P + (((size_t)bh * 64 + 16 * cb + l15) * 64 + 16 * m + 4 * q)) = hacc[m];
}
__device__ __forceinline__ void p5_rwkv_out(const Args& a, int item, int lane) {
    const int bh = item >> 5, c = item & 31, b = bh >> 4, h = bh & 15, l15 = lane & 15, q = lane >> 4;
    const unsigned char* cur = a.ws + WS_RWI + (size_t)item * RWI_BYTES;
    const bf16_t* BV = (const bf16_t*)((const unsigned char*)a.out + DO_BV);
    const bf16_t* P = (const bf16_t*)(a.ws + WS_P); bf16_t* A2 = (bf16_t*)(a.ws + WS_XN);
    bf16x8 hb[4][2], w2f[8];
#pragma unroll
    for (int cb = 0; cb < 4; ++cb)
#pragma unroll
        for (int ks = 0; ks < 2; ++ks) hb[cb][ks] = *(const bf16x8*)(a.ws + WS_HB + ((size_t)(bh * 4 + cb) * 32 + c) * 2048 + (ks * 64 + lane) * 16);
#pragma unroll
    for (int k2 = 0; k2 < 8; ++k2) w2f[k2] = *(const bf16x8*)(cur + RWI_W2F + (k2 * 64 + lane) * 16);
    f32x4 gw[4], gb[4];
#pragma unroll
    for (int cb = 0; cb < 4; ++cb) { gw[cb] = *(const f32x4*)(a.in[I_GNW] + h * 64 + 16 * cb + 4 * q); gb[cb] = *(const f32x4*)(a.in[I_GNB] + h * 64 + 16 * cb + 4 * q); }
#pragma unroll
    for (int n = 0; n < 4; ++n) {
        const size_t row = (size_t)b * SEQ + c * 64 + 16 * n + l15;
        f32x4 o[4]; u32x2 bvw[4], zw[4];
#pragma unroll
        for (int cb = 0; cb < 4; ++cb) { o[cb] = *(const f32x4*)(cur + RWI_O1F + ((cb * 4 + n) * 64 + lane) * 16);
            bvw[cb] = *(const u32x2*)(BV + row * 1024 + h * 64 + 16 * cb + 4 * q); zw[cb] = *(const u32x2*)(P + row * LDP + PC_ZR + h * 64 + 16 * cb + 4 * q); }
#pragma unroll
        for (int cb = 0; cb < 4; ++cb)
#pragma unroll
            for (int ks = 0; ks < 2; ++ks) o[cb] = MFMA16(hb[cb][ks], w2f[n * 2 + ks], o[cb]);
        float sm = 0.f;
#pragma unroll
        for (int cb = 0; cb < 4; ++cb) sm += (o[cb][0] + o[cb][1]) + (o[cb][2] + o[cb][3]);
        sm += __shfl_xor(sm, 16); sm += __shfl_xor(sm, 32);
        const float mean = sm * (1.0f / 64.0f); float sq = 0.f;
#pragma unroll
        for (int cb = 0; cb < 4; ++cb) { o[cb] = o[cb] - mean; sq += (o[cb][0] * o[cb][0] + o[cb][1] * o[cb][1]) + (o[cb][2] * o[cb][2] + o[cb][3] * o[cb][3]); }
        sq += __shfl_xor(sq, 16); sq += __shfl_xor(sq, 32);
        const float rstd = rsqrtf(sq * (1.0f / 64.0f) + GN_EPS);
#pragma unroll
        for (int cb = 0; cb < 4; ++cb) {
            const float r0 = (o[cb][0] * rstd * gw[cb][0] + gb[cb][0] + bf_lo(bvw[cb].x)) * bf_lo(zw[cb].x), r1 = (o[cb][1] * rstd * gw[cb][1] + gb[cb][1] + bf_hi(bvw[cb].x)) * bf_hi(zw[cb].x);
            const float r2 = (o[cb][2] * rstd * gw[cb][2] + gb[cb][2] + bf_lo(bvw[cb].y)) * bf_lo(zw[cb].y), r3 = (o[cb][3] * rstd * gw[cb][3] + gb[cb][3] + bf_hi(bvw[cb].y)) * bf_hi(zw[cb].y);
            *(u32x2*)(A2 + row * 2048 + 1024 + h * 64 + 16 * cb + 4 * q) = pack4(r0, r1, r2, r3); }
    }
}

__device__ __forceinline__ void p3_rwkv_sample(const Args& a, LAS unsigned char* lds, int bs, int h, int wave, int lane) {
    LAS float* Lw = (LAS float*)lds + wave * 768;
    const bf16_t* P = (const bf16_t*)(a.ws + WS_P);
    const bf16_t* pc = P + (size_t)(MP + bs) * LDP; const bf16_t* pp = P + (size_t)(MV + bs) * LDP;
    bf16_t* A2 = (bf16_t*)(a.ws + WS_XN);
    const float* mu = a.in[I_MU];
    const int hj = h * 64 + lane, rg = lane >> 4, cq = lane & 15;
    const size_t sbase = ((size_t)(bs * 16 + h) * 64) * 64;
    const float* S0 = a.in[I_WKV] + sbase; float* S1 = a.out + OUT_WKV_S + sbase;
    f32x4 S[16];
#pragma unroll
    for (int it = 0; it < 16; ++it) S[it] = *(const f32x4*)(S0 + (size_t)(4 * it + rg) * 64 + 4 * cq);
    { float wd = bf2f(pc[PC_WD + lane]), ad = bf2f(pc[PC_AD + lane]); wd += (bf2f(pp[PC_WD + lane]) - wd) * mu[3072 + lane]; ad += (bf2f(pp[PC_AD + lane]) - ad) * mu[3136 + lane];
      Lw[lane] = tanhf_(wd); Lw[64 + lane] = ad; }
    LDS_WAIT();
    float lw = 0.f, la = 0.f;
#pragma unroll 16
    for (int m = 0; m < 64; ++m) { lw += Lw[m] * a.in[I_W2][(size_t)m * 1024 + hj]; la += Lw[64 + m] * a.in[I_A2][(size_t)m * 1024 + hj]; }
    float r = bf2f(pc[PC_R + hj]), k = bf2f(pc[PC_K + hj]), v = bf2f(pc[PC_V + hj]);
    r += (bf2f(pp[PC_R + hj]) - r) * mu[hj]; k += (bf2f(pp[PC_K + hj]) - k) * mu[1024 + hj]; v += (bf2f(pp[PC_V + hj]) - v) * mu[2048 + hj];
    const RwTok o = rw_token(a, hj, r, k, v, lw, la);
    Lw[128 + lane] = o.kk; Lw[192 + lane] = o.dr; Lw[256 + lane] = o.dd; Lw[320 + lane] = o.bb; Lw[384 + lane] = o.kp; Lw[448 + lane] = o.v;
    LDS_WAIT();
    const f32x4 kk4 = *(const LAS f32x4*)(Lw + 128 + 4 * cq), dr4 = *(const LAS f32x4*)(Lw + 192 + 4 * cq), d4 = *(const LAS f32x4*)(Lw + 256 + 4 * cq), b4 = *(const LAS f32x4*)(Lw + 320 + 4 * cq), k4 = *(const LAS f32x4*)(Lw + 384 + 4 * cq);
#pragma unroll
    for (int it = 0; it < 16; ++it) { const int i = 4 * it + rg; const float vi = Lw[448 + i];
        float p1 = (S[it][0] * kk4[0] + S[it][1] * kk4[1]) + (S[it][2] * kk4[2] + S[it][3] * kk4[3]);
        float p2 = (S[it][0] * dr4[0] + S[it][1] * dr4[1]) + (S[it][2] * dr4[2] + S[it][3] * dr4[3]);
        p1 = row16_sum(p1); p2 = row16_sum(p2);
        const float sa = -p1, ov = p2 + sa * o.br + vi * o.kr;
        f32x4 Sn;
#pragma unroll
        for (int j = 0; j < 4; ++j) Sn[j] = S[it][j] * d4[j] + sa * b4[j] + vi * k4[j];
        *(f32x4*)(S1 + (size_t)i * 64 + 4 * cq) = Sn;
        if (cq == 0) Lw[512 + i] = ov; }
    LDS_WAIT();
    const float ov = Lw[512 + lane];
    const float mean = wave_sum_dpp(ov) * (1.0f / 64.0f); const float dv = ov - mean; const float var = wave_sum_dpp(dv * dv) * (1.0f / 64.0f);
    float on = dv * rsqrtf(var + GN_EPS) * a.in[I_GNW][hj] + a.in[I_GNB][hj] + o.bonus * o.v;
    on *= bf2f(pc[PC_ZR + hj]);
    A2[(size_t)(MP + bs) * 2048 + 1024 + hj] = f2bf(on);
    LDS_WAIT();
}

constexpr int S5_ELD = 132, S5_XLD = 136;
constexpr int S5_E_OFF = 0, S5_X_OFF = 128 * S5_ELD * 4;
__device__ __forceinline__ bf16x8 ldfrag(const unsigned char* base, int block, int lane) { return *(const bf16x8*)(base + (size_t)block * 1024 + lane * 16); }
__device__ __forceinline__ void p3_s5_prompt(const Args& a, LAS unsigned char* lds, int unit, int tid, int wave, int lane) {
    const int b = unit >> 6, g = unit & 63;
    const unsigned char* tab = (const unsigned char*)a.out + DO_S5TAB + (size_t)g * S5T_BYTES;
    const bf16_t* P = (const bf16_t*)(a.ws + WS_P);
    bf16_t* Yg = (bf16_t*)(a.ws + WS_YG);
    LAS float* EL = (LAS float*)(lds + S5_E_OFF); LAS bf16_t* XL = (LAS bf16_t*)(lds + S5_X_OFF);
    const int nt = wave & 3, hm = wave >> 2, r31 = lane & 31, hh = lane >> 5;
    const int n = 32 * nt + r31;
    { u32x4 tv[10];
#pragma unroll
      for (int i = 0; i < 10; ++i) tv[i] = *(const u32x4*)(tab + S5T_ME + (size_t)(tid + 512 * i) * 16);
#pragma unroll
      for (int i = 0; i < 10; ++i) *(LAS u32x4*)(lds + (tid + 512 * i) * 16) = tv[i]; }
    const bf16_t* ubase = (const bf16_t*)(a.ws + WS_U2) + (((size_t)b * 64 + g) * SEQ + 16 * n) * 16 + 8 * hh;
    bf16x8 bu[16];
#pragma unroll
    for (int s2 = 0; s2 < 16; ++s2) bu[s2] = *(const bf16x8*)(ubase + (size_t)s2 * 16);
    f32x16 accY[4], accE[2];
#pragma unroll
    for (int q = 0; q < 4; ++q)
#pragma unroll
        for (int r = 0; r < 16; ++r) accY[q][r] = 0.f;
#pragma unroll
    for (int q = 0; q < 2; ++q)
#pragma unroll
        for (int r = 0; r < 16; ++r) accE[q][r] = 0.f;
    const int mts[4] = {hm ? 1 : 0, hm ? 2 : 3, hm ? 5 : 4, hm ? 6 : 7};
    __syncthreads();
#pragma unroll
    for (int s2 = 0; s2 < 16; ++s2) {
#pragma unroll
        for (int e = 0; e < 2; ++e) accE[e] = __builtin_amdgcn_mfma_f32_32x32x16_bf16(*(const LAS bf16x8*)(lds + S5T_ME + (((2 * hm + e) * 16 + s2) * 64 + lane) * 16), bu[s2], accE[e], 0, 0, 0);
#pragma unroll
        for (int q = 0; q < 4; ++q) { const int mt = mts[q]; if (s2 <= 2 * mt + 1) accY[q] = __builtin_amdgcn_mfma_f32_32x32x16_bf16(*(const LAS bf16x8*)(lds + S5T_KT + ((2 * mt - s2 + 1) * 64 + lane) * 16), bu[s2], accY[q], 0, 0, 0); }
    }
    __syncthreads();
#pragma unroll
    for (int e = 0; e < 2; ++e)
#pragma unroll
        for (int q4 = 0; q4 < 4; ++q4) { f32x4 v; v[0] = accE[e][4 * q4]; v[1] = accE[e][4 * q4 + 1]; v[2] = accE[e][4 * q4 + 2]; v[3] = accE[e][4 * q4 + 3];
            *(LAS f32x4*)(EL + n * S5_ELD + 32 * (2 * hm + e) + 8 * q4 + 4 * hh) = v; }
    __syncthreads();
    if (wave == 0) { const float* hdr = (const float*)(tab + S5T_HDR); const float ar = hdr[lane], ai = hdr[64 + lane]; float xr = 0.f, xi = 0.f;
#pragma unroll 1
        for (int c0 = 0; c0 < 128; c0 += 16) { float er[16], ei[16];
#pragma unroll
            for (int j = 0; j < 16; ++j) { er[j] = EL[(c0 + j) * S5_ELD + lane]; ei[j] = EL[(c0 + j) * S5_ELD + 64 + lane]; }
#pragma unroll
            for (int j = 0; j < 16; ++j) { XL[(c0 + j) * S5_XLD + lane] = f2bf(xr); XL[(c0 + j) * S5_XLD + 64 + lane] = f2bf(xi);
                const float nr = ar * xr - ai * xi + er[j], ni = ar * xi + ai * xr + ei[j]; xr = nr; xi = ni; } }
        a.out[OUT_S5RE_P + (size_t)(b * 64 + g) * 64 + lane] = xr; a.out[OUT_S5IM_P + (size_t)(b * 64 + g) * 64 + lane] = xi; }
    __syncthreads();
#pragma unroll
    for (int ks = 0; ks < 8; ++ks) { const bf16x8 bx = *(const LAS bf16x8*)(XL + n * S5_XLD + 16 * ks + 8 * hh);
#pragma unroll
        for (int q = 0; q < 4; ++q) accY[q] = __builtin_amdgcn_mfma_f32_32x32x16_bf16(ldfrag(tab + S5T_CA, mts[q] * 8 + ks, lane), bx, accY[q], 0, 0, 0); }
#pragma unroll
    for (int q = 0; q < 4; ++q) { const int mt = mts[q];
#pragma unroll
        for (int q4 = 0; q4 < 4; ++q4) { const int dt = q4 >> 1, c0 = 8 * (q4 & 1) + 4 * hh; const size_t row = (size_t)b * SEQ + 16 * n + 2 * mt + dt;
            u32x2 w; w.x = cvt_pk_bf16(geluf_(accY[q][4 * q4]), geluf_(accY[q][4 * q4 + 1])); w.y = cvt_pk_bf16(geluf_(accY[q][4 * q4 + 2]), geluf_(accY[q][4 * q4 + 3]));
            *(u32x2*)(Yg + row * 1024 + g * 16 + c0) = w; } }
    __syncthreads();
}
__device__ __forceinline__ void p3_s5_sample(const Args& a, int g, int wave, int lane) {
    if (wave >= 4) return;
    const unsigned char* tab = (const unsigned char*)a.out + DO_S5TAB + (size_t)g * S5T_BYTES;
    const float* hdr = (const float*)(tab + S5T_HDR);
    const bf16_t* P = (const bf16_t*)(a.ws + WS_P);
    bf16_t* Yg = (bf16_t*)(a.ws + WS_YG);
    const int r31 = lane & 31, hh = lane >> 5, bs = 32 * wave + r31;
    const bf16x8 bu = *(const bf16x8*)((const bf16_t*)(a.ws + WS_U2S) + ((size_t)g * NSMP + bs) * 16 + 8 * hh);
    f32x16 z;
#pragma unroll
    for (int r = 0; r < 16; ++r) z[r] = 0.f;
    f32x16 x[4];
#pragma unroll
    for (int mtile = 0; mtile < 4; ++mtile) x[mtile] = __builtin_amdgcn_mfma_f32_32x32x16_bf16(ldfrag(tab + S5T_ME, mtile * 16 + 15, lane), bu, z, 0, 0, 0);
    const size_t sb = (size_t)(bs * 64 + g) * 64;
#pragma unroll
    for (int pt = 0; pt < 2; ++pt)
#pragma unroll
        for (int q4 = 0; q4 < 4; ++q4) { const int p0 = 32 * pt + 8 * q4 + 4 * hh;
            const f32x4 x0r = *(const f32x4*)(a.in[I_S5RE] + sb + p0), x0i = *(const f32x4*)(a.in[I_S5IM] + sb + p0);
            const f32x4 ar = *(const f32x4*)(hdr + 128 + p0), ai = *(const f32x4*)(hdr + 192 + p0);
            f32x4 nr, ni;
#pragma unroll
            for (int j = 0; j < 4; ++j) { nr[j] = ar[j] * x0r[j] - ai[j] * x0i[j] + x[pt][4 * q4 + j]; ni[j] = ar[j] * x0i[j] + ai[j] * x0r[j] + x[2 + pt][4 * q4 + j]; x[pt][4 * q4 + j] = nr[j]; x[2 + pt][4 * q4 + j] = ni[j]; }
            *(f32x4*)(a.out + OUT_S5RE_S + sb + p0) = nr; *(f32x4*)(a.out + OUT_S5IM_S + sb + p0) = ni; }
    f32x16 y = __builtin_amdgcn_mfma_f32_32x32x16_bf16(ldfrag(tab + S5T_DF, 0, lane), bu, z, 0, 0, 0);
#pragma unroll
    for (int mtile = 0; mtile < 4; ++mtile)
#pragma unroll
        for (int sp = 0; sp < 2; ++sp) { u32x4 t; t.x = cvt_pk_bf16(x[mtile][8 * sp], x[mtile][8 * sp + 1]); t.y = cvt_pk_bf16(x[mtile][8 * sp + 2], x[mtile][8 * sp + 3]);
            t.z = cvt_pk_bf16(x[mtile][8 * sp + 4], x[mtile][8 * sp + 5]); t.w = cvt_pk_bf16(x[mtile][8 * sp + 6], x[mtile][8 * sp + 7]);
            y = __builtin_amdgcn_mfma_f32_32x32x16_bf16(ldfrag(tab + S5T_C0, mtile * 2 + sp, lane), __builtin_bit_cast(bf16x8, t), y, 0, 0, 0); }
#pragma unroll
    for (int q4 = 0; q4 < 2; ++q4) { const int c0 = 8 * q4 + 4 * hh;
        u32x2 w; w.x = cvt_pk_bf16(geluf_(y[4 * q4]), geluf_(y[4 * q4 + 1])); w.y = cvt_pk_bf16(geluf_(y[4 * q4 + 2]), geluf_(y[4 * q4 + 3]));
        *(u32x2*)(Yg + (size_t)(MP + bs) * 1024 + g * 16 + c0) = w; }
}

__device__ __forceinline__ void p4_rwkv_post8(const Args& a, int item0, int lane) {
    const int item = item0 + (lane >> 3), cg = lane & 7, row = item >> 4, h = item & 15, ch = h * 64 + 8 * cg;
    const bf16_t* ORAW = (const bf16_t*)((const unsigned char*)a.out + DO_ORAW); const bf16_t* BV = (const bf16_t*)((const unsigned char*)a.out + DO_BV);
    const bf16_t* P = (const bf16_t*)(a.ws + WS_P); bf16_t* A2 = (bf16_t*)(a.ws + WS_XN);
    const u32x4 ow = *(const u32x4*)(ORAW + (size_t)row * 1024 + ch), bw = *(const u32x4*)(BV + (size_t)row * 1024 + ch), zw = *(const u32x4*)(P + (size_t)row * LDP + PC_ZR + ch);
    const f32x4 w0 = *(const f32x4*)(a.in[I_GNW] + ch), w1 = *(const f32x4*)(a.in[I_GNW] + ch + 4), b0 = *(const f32x4*)(a.in[I_GNB] + ch), b1 = *(const f32x4*)(a.in[I_GNB] + ch + 4);
    const float o[8] = {bf_lo(ow.x), bf_hi(ow.x), bf_lo(ow.y), bf_hi(ow.y), bf_lo(ow.z), bf_hi(ow.z), bf_lo(ow.w), bf_hi(ow.w)};
    const float bv[8] = {bf_lo(bw.x), bf_hi(bw.x), bf_lo(bw.y), bf_hi(bw.y), bf_lo(bw.z), bf_hi(bw.z), bf_lo(bw.w), bf_hi(bw.w)};
    const float z[8] = {bf_lo(zw.x), bf_hi(zw.x), bf_lo(zw.y), bf_hi(zw.y), bf_lo(zw.z), bf_hi(zw.z), bf_lo(zw.w), bf_hi(zw.w)};
    const float gw[8] = {w0[0], w0[1], w0[2], w0[3], w1[0], w1[1], w1[2], w1[3]}, gb[8] = {b0[0], b0[1], b0[2], b0[3], b1[0], b1[1], b1[2], b1[3]};
    float sm = ((o[0] + o[1]) + (o[2] + o[3])) + ((o[4] + o[5]) + (o[6] + o[7]));
    sm += dpp_f<0xB1>(sm); sm += dpp_f<0x4E>(sm); sm += dpp_f<0x141>(sm);
    const float mean = sm * (1.0f / 64.0f); float d[8], sq = 0.f;
#pragma unroll
    for (int j = 0; j < 8; ++j) { d[j] = o[j] - mean; sq += d[j] * d[j]; }
    sq += dpp_f<0xB1>(sq); sq += dpp_f<0x4E>(sq); sq += dpp_f<0x141>(sq);
    const float rstd = rsqrtf(sq * (1.0f / 64.0f) + GN_EPS); float r[8];
#pragma unroll
    for (int j = 0; j < 8; ++j) r[j] = (d[j] * rstd * gw[j] + gb[j] + bv[j]) * z[j];
    u32x4 w; w.x = cvt_pk_bf16(r[0], r[1]); w.y = cvt_pk_bf16(r[2], r[3]); w.z = cvt_pk_bf16(r[4], r[5]); w.w = cvt_pk_bf16(r[6], r[7]);
    *(u32x4*)(A2 + (size_t)row * 2048 + 1024 + ch) = w;
}

__device__ __forceinline__ void p6_row(const Args& a, int m, int lane) {
    float* y = a.out + (size_t)m * DM; const float* fg = a.in[I_FINALG];
    if (m < MP) {
        const float* rs = (const float*)(a.ws + WS_ROWSS) + (size_t)m * 32;
        const float ss = wave_sum(rs[lane & 31]) * 0.5f;
        const float rstd = rsqrtf(ss * (1.0f / DM) + RMS_EPS);
#pragma unroll
        for (int j = 0; j < 8; ++j) { const int k = 4 * lane + 256 * j; f32x4 v = *(const f32x4*)(y + k); const f32x4 gv = *(const f32x4*)(fg + k);
#pragma unroll
            for (int q = 0; q < 4; ++q) v[q] = v[q] * rstd * gv[q];
            *(f32x4*)(y + k) = v; }
    } else {
        const int r = m - MP; const float* slab = (const float*)(a.ws + WS_SLAB) + (size_t)r * DM; const float* x = a.in[I_XS] + (size_t)r * DM;
        const float* gtrow = (const float*)(a.ws + WS_MOD) + (size_t)(NB + r) * NMOD + 2 * DM;
        f32x4 v[8]; float ss = 0.f;
#pragma unroll
        for (int j = 0; j < 8; ++j) { const int k = 4 * lane + 256 * j; f32x4 mix = *(const f32x4*)(slab + k);
#pragma unroll
            for (int s2 = 1; s2 < 8; ++s2) mix += *(const f32x4*)(slab + (size_t)s2 * NSMP * DM + k);
            const f32x4 xv = *(const f32x4*)(x + k), gt = *(const f32x4*)(gtrow + k);
#pragma unroll
            for (int q = 0; q < 4; ++q) { v[j][q] = xv[q] + gt[q] * mix[q]; ss += v[j][q] * v[j][q]; } }
        const float rstd = rsqrtf(wave_sum(ss) * (1.0f / DM) + RMS_EPS);
#pragma unroll
        for (int j = 0; j < 8; ++j) { const int k = 4 * lane + 256 * j; const f32x4 gv = *(const f32x4*)(fg + k); f32x4 o;
#pragma unroll
            for (int q = 0; q < 4; ++q) o[q] = v[j][q] * rstd * gv[q];
            *(f32x4*)(y + k) = o; }
    }
}

__global__ void __launch_bounds__(512, 2) fwd_kernel(Args args) {
    extern __shared__ __attribute__((aligned(16))) unsigned char lds_raw[];
    LAS unsigned char* lds = (LAS unsigned char*)lds_raw;
    const int tid = threadIdx.x, lane = tid & 63, wave = __builtin_amdgcn_readfirstlane(tid >> 6);
    const int G = gridDim.x, bx = blockIdx.x;
    const int vcu = (G % 8 == 0) ? (bx % 8) * (G / 8) + bx / 8 : bx;
    volatile LAS unsigned* MISC = (volatile LAS unsigned*)(lds + MISC_OFF);
    for (int u = tid; u < (LDS_BYTES - LDSCTL_OFF) / 4; u += 512) ((LAS unsigned*)(lds + LDSCTL_OFF))[u] = 0u;
    __syncthreads();
    unsigned* ctl = (unsigned*)(args.ws + WS_CTL);
    XcdBarrier bar; bar.bar = ctl + CW_BAR + args.li * XCD_BAR_WORDS; bar.x = 0; bar.st = nullptr;
    const bool multi = (args.ph_hi - args.ph_lo) > 1;
    if (multi) bar = xcd_barrier_post(ctl + CW_BAR + args.li * XCD_BAR_WORDS, MISC + 8);
    const int lo = args.ph_lo, hi = args.ph_hi;
#define IN(k) (lo <= (k) && (k) < hi)
#define SEAM(k) do { if (IN(k) && IN((k) + 1)) xcd_barrier(bar); } while (0)
    const int gw = vcu * 8 + wave, NGW = G * 8;

    if (IN(0)) {
        if (vcu < 192) p0_mod(args, lds, vcu, wave, lane);
        else if (vcu - 192 < 64) { p0_s5_tables(args, lds, vcu - 192, tid);
            LAS float* scr = (LAS float*)(lds + wave * 16384);
            for (int it = (vcu - 192) * 8 + wave; it < 2048 + 512; it += 64 * 8) {
                if (it < 2048) { const int nb = it >> 5, kb = it & 31; transpose_item(args.in[I_WOUT], 2048, 2048, 32 * nb, (bf16_t*)(args.ws + WS_WOUT_T), 32 * nb, 64 * kb, scr, lane, false); }
                else { const int i2 = it - 2048, nb = i2 >> 4, kb = i2 & 15; transpose_item(args.in[I_WGLU], 1024, 1024, 32 * nb, (bf16_t*)(args.ws + WS_WGLU_T), 32 * nb, 64 * kb, scr, lane, false); } } }
    }
    SEAM(0);
    if (IN(1)) {
        { LAS float* scr = (LAS float*)(lds + wave * 16384);
          bf16_t* WT = (bf16_t*)(args.ws + WS_WT);
          for (int it = gw; it < 328 * 32; it += NGW) { const int nb = it >> 5, kb = it & 31; const int p0 = 32 * nb;
              const int src = (p0 < 5120) ? p0 : ((p0 < 10240) ? p0 + 128 : p0 - 5120);
              transpose_item(args.in[I_WIN], NIN, 2048, src, WT, p0, 64 * kb, scr, lane, p0 >= NIN); } }
        for (int m = gw; m < MT; m += NGW) p1_row(args, m, lane);
    }
    SEAM(1);
    const bool tail_mode = (G == 256);
    if (IN(2)) {
        pg8::Gemm g{(const bf16_t*)(args.ws + WS_XN), (const bf16_t*)(args.ws + WS_WT), 2048, 2048};
        EpiP E{(bf16_t*)(args.ws + WS_P), tail_mode, (bf16_t*)(args.ws + WS_U2)};
        if (tail_mode) {
            pg8::TailOrder S; S.init2(G, bx, ctl + CW_TILE);
            pg8::gemm_phase<EpiP, pg8::TailOrder, GEMM_ALIGN, GEMM_SP2>(lds, g, S, E);
            if (bx >= 73) {
                const int t = bx - 73;
                for (int u = t; u < 256; u += 183) { wait_count(ctl + CW_TILE + 64 * ((u >> 6) * 4 + ((u & 63) >> 4)), 64u, wave); p3_s5_prompt(args, lds, u, tid, wave, lane); }
                if (t >= 73 && t < 137) { const int g2 = t - 73; wait_count(ctl + CW_TILE + 64 * (16 + (g2 >> 4)), 8u, wave); p3_s5_sample(args, g2, wave, lane); }
            }
        } else {
            pg8::StaticOrder S; S.init(MT, LDP, 2048, G, bx);
            pg8::gemm_phase<EpiP, pg8::StaticOrder, GEMM_ALIGN, GEMM_SP2>(lds, g, S, E);
        }
    }
    SEAM(2);
    if (IN(3)) {
        p3_rwkv_chunks(args, lds, vcu >> 2, vcu & 3, tid, wave, lane);
        if (!tail_mode) {
            if (false) { LAS float* scr = (LAS float*)(lds + wave * 16384);
              for (int it = gw; it < 2048 + 512; it += NGW) {
                  if (it < 2048) { const int nb = it >> 5, kb = it & 31; transpose_item(args.in[I_WOUT], 2048, 2048, 32 * nb, (bf16_t*)(args.ws + WS_WOUT_T), 32 * nb, 64 * kb, scr, lane, false); }
                  else { const int i2 = it - 2048, nb = i2 >> 4, kb = i2 & 15; transpose_item(args.in[I_WGLU], 1024, 1024, 32 * nb, (bf16_t*)(args.ws + WS_WGLU_T), 32 * nb, 64 * kb, scr, lane, false); } } }
            __syncthreads();
            for (int u = vcu; u < 256; u += G) p3_s5_prompt(args, lds, u, tid, wave, lane);
            for (int g2 = vcu; g2 < 64; g2 += G) p3_s5_sample(args, g2, wave, lane);
            __syncthreads();
        }
        for (int it = vcu; it < 256; it += G) p3_rwkv_sample(args, lds, it >> 1, (it & 1) * 8 + wave, wave, lane);
    }
    SEAM(3);
    if (IN(4)) {
        pg8::StaticOrder S; S.init(MT, 1024, 1024, G, bx);
        pg8::Unit u0;
        if (S.next(0, u0)) {
            pg8::Gemm g{(const bf16_t*)(args.ws + WS_YG), (const bf16_t*)(args.ws + WS_WGLU_T), 1024, 1024};
            EpiGlu E{(const bf16_t*)(args.ws + WS_YG), (const bf16_t*)(args.ws + WS_P), args.in[I_BGLU], (bf16_t*)(args.ws + WS_XN)};
            pg8::gemm_phase<EpiGlu, pg8::StaticOrder, GEMM_ALIGN, GEMM_SP2>(lds, g, S, E);
        } else {
            const int nfree = G - 132, j = bx - 132, unit = wave * nfree + j;
            if (unit < 256) p3_rwkv_seq(args, unit, lane);
        }
    }
    SEAM(4);
    if (IN(5)) { for (int it = gw; it < 2048; it += NGW) p5_rwkv_out(args, it, lane); }
    SEAM(5);
    if (IN(6)) {
        pg8::Gemm g{(const bf16_t*)(args.ws + WS_XN), (const bf16_t*)(args.ws + WS_WOUT_T), 2048, 1024};
        pg8::OutOrder S; S.init(MP, DM, 1024, G, bx);
        EpiOut E{(const bf16_t*)(args.ws + WS_P), args.in[I_XP], (const float*)(args.ws + WS_MOD), args.out, (float*)(args.ws + WS_ROWSS), (bf16_t*)(args.ws + WS_TMP), (float*)(args.ws + WS_SLAB), ctl + CW_PANEL, args.in[I_FINALG]};
        pg8::gemm_phase<EpiOut, pg8::OutOrder, false, GEMM_SP2>(lds, g, S, E);
    }
    SEAM(6);
    if (IN(7)) { for (int m = MP + gw; m < MV; m += NGW) p6_row(args, m, lane); }
#undef IN
#undef SEAM
}

extern "C" void kernel_launch(void* const* d_in, const int* in_sizes, int n_in, void* d_out, int out_size, void* d_ws, size_t ws_size, hipStream_t stream) {
    static int grid = 0;
    if (grid == 0) {
        if (n_in != 34 || ws_size < WS_END) { fprintf(stderr, "kernel_launch: unexpected n_in %d / ws %zu\n", n_in, ws_size); grid = -1; return; }
        int dev = 0, cus = 0;
        if (hipGetDevice(&dev) != hipSuccess || hipDeviceGetAttribute(&cus, hipDeviceAttributeMultiprocessorCount, dev) != hipSuccess) { grid = -1; return; }
        if (hipFuncSetAttribute((const void*)fwd_kernel, hipFuncAttributeMaxDynamicSharedMemorySize, LDS_BYTES) != hipSuccess) { fprintf(stderr, "kernel_launch: hipFuncSetAttribute failed\n"); grid = -1; return; }
        int per_cu = 0;
        if (hipOccupancyMaxActiveBlocksPerMultiprocessor(&per_cu, (const void*)fwd_kernel, 512, LDS_BYTES) != hipSuccess || per_cu < 1) fprintf(stderr, "kernel_launch: occupancy query says %d\n", per_cu);
        (void)hipGetLastError();
        grid = cus;
        if (grid != 256) fprintf(stderr, "kernel_launch: note: %d CUs\n", grid);
    }
    if (grid < 0) return;
    (void)hipMemsetAsync((char*)d_ws + WS_CTL, 0, CTL_BYTES, stream);
    Args a{};
    for (int i = 0; i < 34; ++i) a.in[i] = (const float*)d_in[i];
    a.out = (float*)d_out; a.ws = (unsigned char*)d_ws;
    if (PROBE_PHASE >= 0) {
        a.ph_lo = 0; a.ph_hi = PROBE_PHASE + 1; a.li = 0; hipLaunchKernelGGL(fwd_kernel, dim3(grid), dim3(512), LDS_BYTES, stream, a);
        a.ph_lo = PROBE_PHASE; a.ph_hi = PROBE_PHASE + 1; a.li = 1; hipLaunchKernelGGL(fwd_kernel, dim3(grid), dim3(512), LDS_BYTES, stream, a);
        if (PROBE_PHASE + 1 < N_PHASES) { a.ph_lo = PROBE_PHASE + 1; a.ph_hi = N_PHASES; a.li = 2; hipLaunchKernelGGL(fwd_kernel, dim3(grid), dim3(512), LDS_BYTES, stream, a); }
    } else if (MK_N_LAUNCHES == 1) { a.ph_lo = 0; a.ph_hi = N_PHASES; a.li = 0; hipLaunchKernelGGL(fwd_kernel, dim3(grid), dim3(512), LDS_BYTES, stream, a); }
    else { for (int p = 0; p < N_PHASES; ++p) { a.ph_lo = p; a.ph_hi = p + 1; a.li = 0; hipLaunchKernelGGL(fwd_kernel, dim3(grid), dim3(512), LDS_BYTES, stream, a); } }
}
```

```cpp
#include <hip/hip_runtime.h>
#include <cstdio>
#include <cstdint>

#ifndef MK_N_LAUNCHES
#define MK_N_LAUNCHES 1
#endif
#ifndef PROBE_PHASE
#define PROBE_PHASE -1
#endif
constexpr int N_PHASES = 8;
#ifndef GEMM_SP2
#define GEMM_SP2 true
#endif
#ifndef GEMM_ALIGN
#define GEMM_ALIGN true
#endif

#define GAS __attribute__((address_space(1)))
#define LAS __attribute__((address_space(3)))
typedef unsigned short bf16_t;
typedef short bf16x8 __attribute__((ext_vector_type(8)));
typedef float f32x2 __attribute__((ext_vector_type(2)));
typedef float f32x4 __attribute__((ext_vector_type(4)));
typedef float f32x16 __attribute__((ext_vector_type(16)));
typedef unsigned u32x2 __attribute__((ext_vector_type(2)));
typedef unsigned u32x4 __attribute__((ext_vector_type(4)));
typedef GAS unsigned gu32;

constexpr int DM = 2048, SEQ = 2048, NB = 4, NSMP = 128;
constexpr int MP = NB * SEQ;
constexpr int MV = MP + NSMP;
constexpr int MT = MV + NSMP;
constexpr int NIN = 10368, LDP = 10496;
constexpr int NMOD = 6144, NMODROWS = NB + NSMP;
constexpr float RMS_EPS = 1e-6f, GN_EPS = 64e-5f;
constexpr int PC_U = 0, PC_ZS = 1024, PC_R = 2048, PC_K = 3072, PC_V = 4096, PC_ZR = 5120, PC_GS = 6144, PC_GR = 8192, PC_WD = 10240, PC_AD = 10304;

constexpr size_t WS_CTL = 0, CTL_BYTES = 131072;
constexpr size_t WS_MOD = CTL_BYTES;
constexpr size_t WS_WT = WS_MOD + 3276800;
constexpr size_t WS_XN = WS_WT + (size_t)LDP * 2048 * 2;
constexpr size_t WS_P = WS_XN + (size_t)MT * 2048 * 2;
constexpr size_t WS_RWI = WS_P + (size_t)MT * LDP * 2;
constexpr int RWI_GF = 0, RWI_W2F = 8192, RWI_H1F = 16384, RWI_O1F = 32768, RWI_LAM = 49152, RWI_BYTES = 49408;
constexpr size_t WS_TMP = WS_RWI;
constexpr size_t WS_SLAB = WS_TMP + (size_t)MP * 2048 * 2;
static_assert(WS_SLAB + (size_t)8 * NSMP * DM * 4 <= WS_RWI + (size_t)2048 * RWI_BYTES, "tmp/slab alias");
constexpr size_t WS_YG = WS_RWI + (size_t)2048 * RWI_BYTES;
constexpr size_t WS_WOUT_T = WS_YG + (size_t)MT * 1024 * 2;
constexpr size_t WS_WGLU_T = WS_WOUT_T + (size_t)2048 * 2048 * 2;
constexpr size_t WS_ROWSS = WS_WGLU_T + (size_t)1024 * 1024 * 2;
constexpr size_t WS_U2 = WS_ROWSS + (size_t)MP * 8 * 4;
constexpr size_t WS_U2S = WS_U2 + (size_t)MP * 1024 * 2;
constexpr size_t WS_HB = WS_U2S + (size_t)NSMP * 1024 * 2;
constexpr size_t WS_XW = WS_HB + (size_t)256 * 32 * 2048;
constexpr size_t WS_END = WS_XW + (size_t)MP * 128 * 2;
static_assert(WS_END <= ((size_t)412 << 20), "ws map");
constexpr size_t DO_ORAW = 0, DO_BV = (size_t)MP * 1024 * 2, DO_S5TAB = 2 * DO_BV;
constexpr int S5T_ME = 0, S5T_KT = 65536, S5T_CA = 81920, S5T_C0 = 147456, S5T_DF = 155648, S5T_HDR = 156672, S5T_BYTES = 157696;
static_assert(DO_S5TAB + (size_t)64 * S5T_BYTES <= (size_t)MV * DM * 4, "d_out scratch");
constexpr size_t OUT_Y = 0, OUT_S5RE_P = 17039360, OUT_S5IM_P = 17055744, OUT_WKV_P = 17072128, OUT_SHIFT_P = 17334272,
                 OUT_S5RE_S = 17342464, OUT_S5IM_S = 17866752, OUT_WKV_S = 18391040, OUT_SHIFT_S = 26779648;
constexpr int RING_BYTES = 131072, LDSCTL_OFF = RING_BYTES, MISC_OFF = LDSCTL_OFF + 320, LDS_BYTES = 147456;
constexpr int CW_BAR = 1024;
constexpr int CW_PANEL = 12288, CW_TILE = 16384;

#define LDS_WAIT() asm volatile("s_waitcnt lgkmcnt(0)" ::: "memory")
#define VM_WAIT() asm volatile("s_waitcnt vmcnt(0)" ::: "memory")
typedef __bf16 bf16x2_t __attribute__((ext_vector_type(2)));
__device__ __forceinline__ unsigned cvt_pk_bf16(float lo, float hi) { const f32x2 v = {lo, hi}; return __builtin_bit_cast(unsigned, __builtin_convertvector(v, bf16x2_t)); }
__device__ __forceinline__ u32x2 pack4(float a, float b, float c, float d) { u32x2 w; w.x = cvt_pk_bf16(a, b); w.y = cvt_pk_bf16(c, d); return w; }
__device__ __forceinline__ float bf_lo(unsigned w) { return __uint_as_float(w << 16); }
__device__ __forceinline__ float bf_hi(unsigned w) { return __uint_as_float(w & 0xffff0000u); }
__device__ __forceinline__ float bf2f(bf16_t b) { return __uint_as_float(((unsigned)b) << 16); }
__device__ __forceinline__ bf16_t f2bf(float f) { return (bf16_t)(cvt_pk_bf16(f, 0.f) & 0xffffu); }
__device__ __forceinline__ float rcpf_(float x) { return __builtin_amdgcn_rcpf(x); }
__device__ __forceinline__ float sigmoidf_(float x) { return rcpf_(1.0f + __expf(-x)); }
__device__ __forceinline__ float siluf_(float x) { return x * rcpf_(1.0f + __expf(-x)); }
__device__ __forceinline__ float tanhf_(float x) { const float e = __expf(2.0f * x); return 1.0f - 2.0f * rcpf_(e + 1.0f); }
__device__ __forceinline__ float geluf_(float y) { const float z = 0.7978845608028654f * (y + 0.044715f * y * y * y); return 0.5f * y * (1.0f + tanhf_(z)); }
__device__ __forceinline__ float wave_sum(float v) {
#pragma unroll
    for (int o = 1; o < 64; o <<= 1) v += __shfl_xor(v, o);
    return v;
}
template <int CTRL> __device__ __forceinline__ float dpp_f(float x) { return __builtin_bit_cast(float, __builtin_amdgcn_mov_dpp(__builtin_bit_cast(int, x), CTRL, 0xf, 0xf, true)); }
__device__ __forceinline__ float wave_sum_dpp(float v) {
    v += __builtin_bit_cast(float, __builtin_amdgcn_update_dpp(0, __builtin_bit_cast(int, v), 0x111, 0xf, 0xf, true));
    v += __builtin_bit_cast(float, __builtin_amdgcn_update_dpp(0, __builtin_bit_cast(int, v), 0x112, 0xf, 0xf, true));
    v += __builtin_bit_cast(float, __builtin_amdgcn_update_dpp(0, __builtin_bit_cast(int, v), 0x114, 0xf, 0xf, true));
    v += __builtin_bit_cast(float, __builtin_amdgcn_update_dpp(0, __builtin_bit_cast(int, v), 0x118, 0xf, 0xf, true));
    v += __builtin_bit_cast(float, __builtin_amdgcn_update_dpp(0, __builtin_bit_cast(int, v), 0x142, 0xa, 0xf, false));
    v += __builtin_bit_cast(float, __builtin_amdgcn_update_dpp(0, __builtin_bit_cast(int, v), 0x143, 0xc, 0xf, false));
    return __builtin_bit_cast(float, __builtin_amdgcn_readlane(__builtin_bit_cast(int, v), 63));
}
__device__ __forceinline__ float row16_sum(float v) {
    v += dpp_f<0xB1>(v);
    v += dpp_f<0x4E>(v);
    v += dpp_f<0x141>(v);
    v += dpp_f<0x140>(v);
    return v;
}

#define XB_TMO      128
#define XB_XCNT(j)  (256  + 64 * (j))
#define XB_XSUB(j)  (1280 + 64 * (j))
#define XB_XGEN(j)  (2304 + 64 * (j))
#define XB_TOP      3328
#define XB_TOPGEN   3392
#define XCD_BAR_WORDS 3456
#define XB_SPIN_CAP (1u << 20)
__device__ __forceinline__ unsigned xb_ld(unsigned* p)              { return __hip_atomic_load(p, __ATOMIC_RELAXED, __HIP_MEMORY_SCOPE_AGENT); }
__device__ __forceinline__ unsigned xb_add(unsigned* p, unsigned v) { return __hip_atomic_fetch_add(p, v, __ATOMIC_RELAXED, __HIP_MEMORY_SCOPE_AGENT); }
__device__ __forceinline__ unsigned xb_xcc_id() { return (unsigned)__builtin_amdgcn_s_getreg((3 << 11) | 20) & 0xFu; }
#define XB_SPIN(cond, bar) do { unsigned _sp = 0; while (cond) { __builtin_amdgcn_s_sleep(1); \
    if ((++_sp & 255u) == 0u) { if (xb_ld(&(bar)[XB_TMO])) break; if (_sp > XB_SPIN_CAP) { atomicAdd(&(bar)[XB_TMO], 1u); break; } } } } while (0)
struct XcdBarrier { unsigned* bar; unsigned x; volatile LAS unsigned* st; };
__device__ __forceinline__ XcdBarrier xcd_barrier_post(unsigned* bar, volatile LAS unsigned* st) {
    XcdBarrier b; b.bar = bar; b.x = xb_xcc_id(); b.st = st;
    if (threadIdx.x == 0) (void)xb_add(&bar[XB_XCNT(b.x)], 1u);
    return b;
}
__device__ __forceinline__ void xcd_barrier_complete(unsigned* bar, unsigned x, unsigned& nloc, unsigned& nx) {
    const unsigned G = gridDim.x * gridDim.y * gridDim.z;
    unsigned sum, cnt, mine, sp = 0u;
    for (;;) {
        sum = 0u; cnt = 0u; mine = 0u;
#pragma unroll
        for (unsigned j = 0; j < 16; ++j) { const unsigned c = xb_ld(&bar[XB_XCNT(j)]); sum += c; cnt += (c > 0u) ? 1u : 0u; mine = (j == x) ? c : mine; }
        if (sum == G) break;
        __builtin_amdgcn_s_sleep(1);
        if ((++sp & 255u) == 0u) { if (xb_ld(&bar[XB_TMO])) break; if (sp > XB_SPIN_CAP) { atomicAdd(&bar[XB_TMO], 1u); break; } }
    }
    nloc = mine > 0u ? mine : 1u; nx = cnt > 0u ? cnt : 1u;
}
__device__ __forceinline__ void xcd_barrier(const XcdBarrier& b) {
    asm volatile("s_waitcnt vmcnt(0)" ::: "memory");
    __syncthreads();
    if (threadIdx.x == 0) {
        unsigned* bar = b.bar;
        __builtin_amdgcn_s_waitcnt(0);
        unsigned nloc = b.st[0], nx = b.st[1];
        if (nloc == 0u) { xcd_barrier_complete(bar, b.x, nloc, nx); b.st[0] = nloc; b.st[1] = nx; }
        const unsigned old = xb_add(&bar[XB_XSUB(b.x)], 1u);
        const unsigned gen = old / nloc;
        if (old + 1u == (gen + 1u) * nloc) {
            __builtin_amdgcn_fence(__ATOMIC_RELEASE, "agent");
            asm volatile("s_waitcnt vmcnt(0)" ::: "memory");
            const unsigned og = xb_add(&bar[XB_TOP], 1u);
            const unsigned tg = og / nx;
            if (og + 1u == (tg + 1u) * nx) xb_add(&bar[XB_TOPGEN], 1u);
            else XB_SPIN(xb_ld(&bar[XB_TOPGEN]) == tg, bar);
            __builtin_amdgcn_fence(__ATOMIC_ACQUIRE, "agent");
            xb_add(&bar[XB_XGEN(b.x)], 1u);
            asm volatile("s_waitcnt vmcnt(0)" ::: "memory");
        } else {
            XB_SPIN(xb_ld(&bar[XB_XGEN(b.x)]) == gen, bar);
            __builtin_amdgcn_fence(__ATOMIC_ACQUIRE, "agent");
            asm volatile("s_waitcnt vmcnt(0)" ::: "memory");
        }
    }
    __syncthreads();
}

namespace pg8 {
constexpr int BM = 256, BK = 64, HALF = 128, HTB = HALF * BK * 2, STAGE_BYTES = 8 * HTB, NXCD = 8, WGM = 8;
__host__ __device__ __forceinline__ int lds_byte(int r, int c) { const int st = (r >> 4) * 2 + (c >> 5), rr = r & 15, cc = c & 31, ob = rr * 64 + cc * 2; return st * 1024 + (ob ^ (((ob >> 9) & 1) << 5)); }
__host__ __device__ __forceinline__ void stage_rc(int b, int& R, int& C) { const int st = b / 1024, sb = b % 1024, swz = sb ^ (((sb >> 9) & 1) << 5); R = (st >> 1) * 16 + swz / 64; C = (st & 1) * 32 + (swz % 64) / 2; }
__host__ __device__ __forceinline__ int perm32(int rho) { const int n = rho >> 4, i = rho & 15; return 8 * (i >> 2) + 4 * n + (i & 3); }
struct Unit { int pm, pn, koff, kt, mode; };
struct Gemm { const bf16_t* A; const bf16_t* Bt; int ld, K; };
struct StaticOrder {
    int nM, nN, nwg, G, c, kt;
    __device__ void init(int M, int N, int K, int G_, int c_) { nM = M / BM; nN = N / BM; nwg = nM * nN; G = G_; c = c_; kt = K / BK; }
    __device__ __forceinline__ void tile(int L, Unit& u) const {
        int wgid = L; { const int q = nwg / NXCD, r = nwg % NXCD, xcd = wgid % NXCD, off = wgid / NXCD; wgid = (xcd < r ? xcd * (q + 1) : r * (q + 1) + (xcd - r) * q) + off; }
        const int nig = WGM * nN, gid = wgid / nig, fm = gid * WGM, gsz = (nM - fm) < WGM ? (nM - fm) : WGM;
        u.pm = fm + ((wgid % nig) % gsz); u.pn = (wgid % nig) / gsz; u.koff = 0; u.kt = kt; u.mode = 0;
    }
    __device__ __forceinline__ bool next(int i, Unit& u) const { const long L = (long)i * G + c; if (L >= nwg) return false; tile((int)L, u); return true; }
    __device__ __forceinline__ void done(const Unit&, int, int&) const {}
};
struct OutOrder : StaticOrder {
    __device__ __forceinline__ bool next(int i, Unit& u) const {
        const int i2 = (c < 64) ? i - 1 : i;
        if (i2 < 0) { u.pm = 32; u.pn = c >> 3; u.koff = (c & 7) * 256; u.kt = 4; u.mode = 2; return true; }
        if (i2 < 2 && c < nwg) { tile(c, u); u.koff = i2 * 1024; u.kt = 16; u.mode = i2; return true; }
        return false;
    }
};
struct TailOrder : StaticOrder {
    unsigned* cnt;
    __device__ void init2(int G_, int c_, unsigned* cnt_) { nM = 32; nN = 36; nwg = 32 * 36; G = G_; c = c_; kt = 32; cnt = cnt_; }
    __device__ __forceinline__ static bool flagged(const Unit& u) { return u.pm == 32 || u.pn < 4 || u.pn == 40; }
    __device__ __forceinline__ bool next(int i, Unit& u) const {
        const int L = i * G + c; if (L >= 201 + 1152) return false;
        if (L < 132) { const int x = L & 7, k = L >> 3; if (k < 16) { u.pm = 4 * x + (k >> 2); u.pn = k & 3; } else { u.pm = 32; u.pn = x; }
                       u.koff = 0; u.kt = 32; u.mode = 0; }
        else if (L < 169) { u.pm = 32; u.pn = 4 + (L - 132); u.koff = 0; u.kt = 32; u.mode = 0; }
        else if (L < 201) { u.pm = L - 169; u.pn = 40; u.koff = 0; u.kt = 32; u.mode = 0; }
        else { tile(L - 201, u); u.pn += 4; }
        return true;
    }
    __device__ __forceinline__ void done(const Unit& u, int lane, int& pend) const {
        if (pend >= 0) {
            asm volatile("s_waitcnt vmcnt(0)" ::: "memory");
            if (lane == 0) __hip_atomic_fetch_add(cnt + 64 * pend, 1u, __ATOMIC_RELAXED, __HIP_MEMORY_SCOPE_AGENT);
            pend = -1;
        }
        if (flagged(u)) pend = (u.pm == 32) ? 16 + u.pn : ((u.pn < 4) ? (u.pm >> 3) * 4 + u.pn : 57 + u.pm);
    }
};
template <class Epi, class Sched, bool ALIGN_EPI = false, bool SP2 = false>
__device__ __forceinline__ void gemm_phase(LAS unsigned char* lds, const Gemm g, const Sched& S, const Epi& E) {
    const int tid = threadIdx.x, wid = __builtin_amdgcn_readfirstlane(tid >> 6), lane = tid & 63, wr = wid >> 2, wc = wid & 3, fr = lane & 15, fq = lane >> 4;
    const int ld = g.ld;
    unsigned voffA[2], voffB[2];
#pragma unroll
    for (int i = 0; i < 2; ++i) { int R, C; stage_rc(tid * 16 + i * 8192, R, C); const int Rb = Epi::PERM ? ((R & ~31) + perm32(R & 31)) : R;
        voffA[i] = (unsigned)(R * ld + C) * 2u; voffB[i] = (unsigned)(Rb * ld + C) * 2u; }
    const size_t kstep = (size_t)(BK * 2);
    const size_t hstep = (size_t)HALF * ld * 2;
    const size_t tstep = 2 * hstep;
    const unsigned ldsw = (unsigned)wid * 1024u;
    const int aoff = lds_byte(wr * 64 + fr, fq * 8), boff = lds_byte(wc * 32 + fr, fq * 8);
#define PG8_SA(b, h) (((b) * 2 + (h)) * HTB)
#define PG8_SB(b, h) ((4 + (b) * 2 + (h)) * HTB)
#define PG8_STAGE(bufoff, gbase, voff) do { _Pragma("unroll") for (int _i = 0; _i < 2; ++_i) \
        __builtin_amdgcn_global_load_lds((const unsigned*)((const char*)(gbase) + (voff)[_i]), (LAS unsigned*)(lds + (bufoff) + ldsw + _i * 8192), 16, 0, 0); } while (0)
#define PG8_LDA(dst, b, h) do { _Pragma("unroll") for (int m = 0; m < 4; ++m) _Pragma("unroll") for (int k = 0; k < 2; ++k) dst[m][k] = *(const LAS bf16x8*)(lds + PG8_SA(b, h) + aoff + m * 2048 + k * 1024); } while (0)
#define PG8_LDB(dst, b, h) do { _Pragma("unroll") for (int n = 0; n < 2; ++n) _Pragma("unroll") for (int k = 0; k < 2; ++k) dst[n][k] = *(const LAS bf16x8*)(lds + PG8_SB(b, h) + boff + n * 2048 + k * 1024); } while (0)
#define PG8_MMA(ai, bj, At, Bt) do { __builtin_amdgcn_s_setprio(1); _Pragma("unroll") for (int m = 0; m < 4; ++m) _Pragma("unroll") for (int n = 0; n < 2; ++n) _Pragma("unroll") for (int k = 0; k < 2; ++k) \
        acc[ai][bj][m][n] = __builtin_amdgcn_mfma_f32_16x16x32_bf16(Bt[n][k], At[m][k], acc[ai][bj][m][n], 0, 0, 0); __builtin_amdgcn_s_setprio(0); } while (0)
#define PG8_WAIT_V(n) asm volatile("s_waitcnt vmcnt(" #n ")" ::: "memory")
#define PG8_WAIT_L(n) asm volatile("s_waitcnt lgkmcnt(" #n ")" ::: "memory")
#define PG8_BAR __builtin_amdgcn_s_barrier()
#define PG8_SCHED __builtin_amdgcn_sched_barrier(0)
    Unit cur, nxt; int ui = 0; bool deferred = false; int pend = -1;
    if (!S.next(0, cur)) return;
    f32x4 acc[2][2][4][2];
#pragma unroll
    for (int a = 0; a < 2; ++a)
#pragma unroll
        for (int b = 0; b < 2; ++b)
#pragma unroll
            for (int m = 0; m < 4; ++m)
#pragma unroll
                for (int n = 0; n < 2; ++n) acc[a][b][m][n] = (f32x4){0.f, 0.f, 0.f, 0.f};
    bf16x8 At[4][2], B0[2][2], B1[2][2];
    const char* cA = (const char*)g.A + (size_t)cur.pm * tstep + (size_t)cur.koff * 2; const char* cB = (const char*)g.Bt + (size_t)cur.pn * tstep + (size_t)cur.koff * 2;
    if constexpr (SP2) {
        PG8_STAGE(PG8_SB(0, 0), cB, voffB); PG8_STAGE(PG8_SB(0, 1), cB + hstep, voffB); PG8_STAGE(PG8_SA(0, 0), cA, voffA); PG8_STAGE(PG8_SA(0, 1), cA + hstep, voffA);
        if (wr == 1) PG8_BAR;
        PG8_WAIT_V(2); PG8_BAR;
        PG8_STAGE(PG8_SB(1, 0), cB + kstep, voffB); PG8_STAGE(PG8_SA(1, 0), cA + kstep, voffA); PG8_STAGE(PG8_SB(1, 1), cB + hstep + kstep, voffB);
        PG8_WAIT_V(6); PG8_BAR;
    } else {
    PG8_STAGE(PG8_SB(0, 0), cB, voffB); PG8_STAGE(PG8_SA(0, 0), cA, voffA); PG8_STAGE(PG8_SB(0, 1), cB + hstep, voffB); PG8_STAGE(PG8_SA(0, 1), cA + hstep, voffA);
    if (wr == 1) PG8_BAR;
    PG8_WAIT_V(4); PG8_BAR;
    PG8_STAGE(PG8_SB(1, 0), cB + kstep, voffB); PG8_STAGE(PG8_SA(1, 0), cA + kstep, voffA); PG8_STAGE(PG8_SB(1, 1), cB + hstep + kstep, voffB);
    PG8_WAIT_V(6); PG8_BAR;
    }
    for (;;) {
        const bool has_next = S.next(ui + 1, nxt);
        const char* nA = has_next ? (const char*)g.A + (size_t)nxt.pm * tstep + (size_t)nxt.koff * 2 : cA; const char* nB = has_next ? (const char*)g.Bt + (size_t)nxt.pn * tstep + (size_t)nxt.koff * 2 : cB;
        const int nt = cur.kt;
        for (int t = 0; t < nt; t += 2) {
            const bool last = (t == nt - 2);
            const char* a1 = cA + (size_t)(t + 1) * kstep;
            const char* a2 = last ? nA : cA + (size_t)(t + 2) * kstep; const char* b2 = last ? nB : cB + (size_t)(t + 2) * kstep;
            const char* a3 = a2 + kstep; const char* b3 = b2 + kstep;
            if constexpr (SP2) {
            PG8_LDB(B0, 0, 0); PG8_LDB(B1, 0, 1); PG8_SCHED; PG8_LDA(At, 0, 0); PG8_STAGE(PG8_SA(1, 1), a1 + hstep, voffA);
            PG8_WAIT_V(8); PG8_WAIT_L(0); PG8_BAR; PG8_MMA(0, 0, At, B0); PG8_MMA(0, 1, At, B1); PG8_BAR; PG8_SCHED;
            PG8_LDA(At, 0, 1); PG8_STAGE(PG8_SB(0, 0), b2, voffB); PG8_STAGE(PG8_SB(0, 1), b2 + hstep, voffB); PG8_STAGE(PG8_SA(0, 0), a2, voffA);
            PG8_WAIT_V(8); PG8_WAIT_L(0); PG8_BAR; PG8_MMA(1, 0, At, B0); PG8_MMA(1, 1, At, B1); PG8_BAR; PG8_SCHED;
            PG8_LDB(B0, 1, 0); PG8_LDB(B1, 1, 1); PG8_SCHED; PG8_LDA(At, 1, 0); PG8_STAGE(PG8_SA(0, 1), a2 + hstep, voffA);
            PG8_WAIT_V(8); PG8_WAIT_L(0); PG8_BAR; PG8_MMA(0, 0, At, B0); PG8_MMA(0, 1, At, B1); PG8_BAR; PG8_SCHED;
            PG8_LDA(At, 1, 1); PG8_STAGE(PG8_SB(1, 0), b3, voffB); PG8_STAGE(PG8_SB(1, 1), b3 + hstep, voffB); PG8_STAGE(PG8_SA(1, 0), a3, voffA);
            PG8_WAIT_V(8); PG8_WAIT_L(0); PG8_BAR; PG8_MMA(1, 0, At, B0); PG8_MMA(1, 1, At, B1); PG8_BAR; PG8_SCHED;
            } else {
            PG8_LDB(B0, 0, 0); PG8_SCHED; PG8_LDA(At, 0, 0); PG8_STAGE(PG8_SA(1, 1), a1 + hstep, voffA);
            PG8_WAIT_L(8); PG8_BAR; PG8_WAIT_L(0); PG8_MMA(0, 0, At, B0); PG8_BAR; PG8_SCHED;
            PG8_LDB(B1, 0, 1); PG8_STAGE(PG8_SB(0, 0), b2, voffB);
            PG8_BAR; PG8_WAIT_L(0); PG8_MMA(0, 1, At, B1); PG8_BAR;
            PG8_LDA(At, 0, 1); PG8_STAGE(PG8_SA(0, 0), a2, voffA);
            PG8_BAR; PG8_WAIT_L(0); PG8_MMA(1, 0, At, B0); PG8_BAR; PG8_SCHED;
            PG8_STAGE(PG8_SB(0, 1), b2 + hstep, voffB);
            PG8_WAIT_V(6); PG8_BAR; PG8_MMA(1, 1, At, B1); PG8_BAR;
            PG8_LDB(B0, 1, 0); PG8_SCHED; PG8_LDA(At, 1, 0); PG8_STAGE(PG8_SA(0, 1), a2 + hstep, voffA);
            PG8_WAIT_L(8); PG8_BAR; PG8_WAIT_L(0); PG8_MMA(0, 0, At, B0); PG8_BAR; PG8_SCHED;
            PG8_LDB(B1, 1, 1); PG8_STAGE(PG8_SB(1, 0), b3, voffB);
            PG8_BAR; PG8_WAIT_L(0); PG8_MMA(0, 1, At, B1); PG8_BAR;
            PG8_LDA(At, 1, 1); PG8_STAGE(PG8_SA(1, 0), a3, voffA);
            PG8_BAR; PG8_WAIT_L(0); PG8_MMA(1, 0, At, B0); PG8_BAR; PG8_SCHED;
            PG8_STAGE(PG8_SB(1, 1), b3 + hstep, voffB);
            PG8_WAIT_V(6); PG8_BAR; PG8_MMA(1, 1, At, B1); PG8_BAR;
            }
        }
        if constexpr (ALIGN_EPI) { if (wr == 0) PG8_BAR; }
        if (Epi::FUSED_LAST && !has_next && cur.mode == 1) deferred = true; else { E(acc, cur, wr, wc, fr, fq); S.done(cur, lane, pend); }
        if (!has_next) break;
#pragma unroll
        for (int a = 0; a < 2; ++a)
#pragma unroll
            for (int b = 0; b < 2; ++b)
#pragma unroll
                for (int m = 0; m < 4; ++m)
#pragma unroll
                    for (int n = 0; n < 2; ++n) acc[a][b][m][n] = (f32x4){0.f, 0.f, 0.f, 0.f};
        cur = nxt; cA = nA; cB = nB; ++ui;
        if constexpr (ALIGN_EPI) { if (wr == 1) PG8_BAR; }
    }
    PG8_WAIT_V(0);
    if constexpr (!ALIGN_EPI) { if (wr == 0) PG8_BAR; }
    PG8_BAR;
    if constexpr (Epi::FUSED_LAST) { if (deferred) E.fused(acc, cur, wr, wc, fr, fq, lds, wid, lane); }
#undef PG8_SA
#undef PG8_SB
#undef PG8_STAGE
#undef PG8_LDA
#undef PG8_LDB
#undef PG8_MMA
#undef PG8_WAIT_V
#undef PG8_WAIT_L
#undef PG8_BAR
#undef PG8_SCHED
}
}

struct EpiP {
    static constexpr bool PERM = true, FUSED_LAST = false;
    bf16_t* P; bool tail; bf16_t* U2;
    __device__ __forceinline__ void operator()(const f32x4 (&acc)[2][2][4][2], const pg8::Unit& u, int wr, int wc, int fr, int fq) const {
        const int row0 = u.pm * 256 + wr * 64 + fr, col0 = u.pn * 256 + wc * 32 + 8 * fq;
        const bool wt = tail && (u.pm == 32 || u.pn < 4 || u.pn == 40);
        const __amdgpu_buffer_rsrc_t rsrc = __builtin_amdgcn_make_buffer_rsrc(P, 0, (int)((size_t)MT * LDP * 2), 0x00020000);
        const __amdgpu_buffer_rsrc_t rsrc2 = __builtin_amdgcn_make_buffer_rsrc(U2, 0, (int)((size_t)MV * 1024 * 2), 0x00020000);
        const int act = ((u.pn >= 4 && u.pn < 8) || (u.pn >= 20 && u.pn < 24)) ? 1 : ((u.pn >= 24 && u.pn < 40) ? 2 : 0);
#pragma unroll
        for (int ai = 0; ai < 2; ++ai)
#pragma unroll
            for (int m = 0; m < 4; ++m) { bf16_t* rowp = P + (size_t)(row0 + ai * 128 + m * 16) * LDP + col0;
#pragma unroll
                for (int bj = 0; bj < 2; ++bj) { f32x4 v0 = acc[ai][bj][m][0], v1 = acc[ai][bj][m][1];
                    if (act == 1) {
#pragma unroll
                        for (int j = 0; j < 4; ++j) { v0[j] = siluf_(v0[j]); v1[j] = siluf_(v1[j]); } }
                    else if (act == 2) {
#pragma unroll
                        for (int j = 0; j < 4; ++j) { v0[j] = sigmoidf_(v0[j]); v1[j] = sigmoidf_(v1[j]); } }
                    u32x4 w; w.x = cvt_pk_bf16(v0[0], v0[1]); w.y = cvt_pk_bf16(v0[2], v0[3]); w.z = cvt_pk_bf16(v1[0], v1[1]); w.w = cvt_pk_bf16(v1[2], v1[3]);
                    if (u.pn < 4) {
                        const int row = row0 + ai * 128 + m * 16, col = col0 + bj * 128, g2 = col >> 4, hf = (col >> 3) & 1;
                        size_t eo; if (row < MP) eo = (((size_t)(row >> 11) * 64 + g2) * SEQ + (row & (SEQ - 1))) * 16 + hf * 8; else eo = (size_t)MP * 1024 + ((size_t)g2 * NSMP + ((row - MP) & (NSMP - 1))) * 16 + hf * 8;
                        if (row < MV) { if (wt) __builtin_amdgcn_raw_buffer_store_b128(w, rsrc2, (unsigned)(eo * 2), 0, 16); else *(u32x4*)(U2 + eo) = w; } }
                    else if (wt) __builtin_amdgcn_raw_buffer_store_b128(w, rsrc, (unsigned)((size_t)(row0 + ai * 128 + m * 16) * LDP + col0 + bj * 128) * 2u, 0, 16);
                    else *(u32x4*)(rowp + bj * 128) = w; } }
    }
};
struct EpiGlu {
    static constexpr bool PERM = true, FUSED_LAST = false;
    const bf16_t* Yg; const bf16_t* P; const float* bglu; bf16_t* A2;
    __device__ __forceinline__ void operator()(const f32x4 (&acc)[2][2][4][2], const pg8::Unit& u, int wr, int wc, int fr, int fq) const {
        const int row0 = u.pm * 256 + wr * 64 + fr, col0 = u.pn * 256 + wc * 32 + 8 * fq;
        f32x4 bv[2][2];
#pragma unroll
        for (int bj = 0; bj < 2; ++bj)
#pragma unroll
            for (int n = 0; n < 2; ++n) bv[bj][n] = *(const f32x4*)(bglu + col0 + bj * 128 + 4 * n);
#pragma unroll
        for (int ai = 0; ai < 2; ++ai)
#pragma unroll
            for (int m = 0; m < 4; ++m) { const size_t row = (size_t)(row0 + ai * 128 + m * 16);
#pragma unroll
                for (int bj = 0; bj < 2; ++bj) { const int c = col0 + bj * 128;
                    const u32x4 yg = *(const u32x4*)(Yg + row * 1024 + c), sz = *(const u32x4*)(P + row * LDP + PC_ZS + c);
                    const f32x4 a0 = acc[ai][bj][m][0] + bv[bj][0], a1 = acc[ai][bj][m][1] + bv[bj][1];
                    float o[8];
                    o[0] = bf_lo(yg.x) * sigmoidf_(a0[0]) * bf_lo(sz.x); o[1] = bf_hi(yg.x) * sigmoidf_(a0[1]) * bf_hi(sz.x);
                    o[2] = bf_lo(yg.y) * sigmoidf_(a0[2]) * bf_lo(sz.y); o[3] = bf_hi(yg.y) * sigmoidf_(a0[3]) * bf_hi(sz.y);
                    o[4] = bf_lo(yg.z) * sigmoidf_(a1[0]) * bf_lo(sz.z); o[5] = bf_hi(yg.z) * sigmoidf_(a1[1]) * bf_hi(sz.z);
                    o[6] = bf_lo(yg.w) * sigmoidf_(a1[2]) * bf_lo(sz.w); o[7] = bf_hi(yg.w) * sigmoidf_(a1[3]) * bf_hi(sz.w);
                    u32x4 w; w.x = cvt_pk_bf16(o[0], o[1]); w.y = cvt_pk_bf16(o[2], o[3]); w.z = cvt_pk_bf16(o[4], o[5]); w.w = cvt_pk_bf16(o[6], o[7]);
                    *(u32x4*)(A2 + row * 2048 + c) = w; } }
    }
};
struct EpiOut {
    static constexpr bool PERM = false, FUSED_LAST = true;
    const bf16_t* P; const float* xp; const float* mod; float* out; float* xbuf; bf16_t* tmp; float* slab; unsigned* cnt; const float* fg;
    __device__ __forceinline__ void operator()(const f32x4 (&acc)[2][2][4][2], const pg8::Unit& u, int wr, int wc, int fr, int fq) const {
        const int row0 = u.pm * 256 + wr * 64 + fr, col0 = u.pn * 256 + wc * 32 + 4 * fq;
        if (u.mode == 0) {
#pragma unroll
            for (int ai = 0; ai < 2; ++ai)
#pragma unroll
                for (int m = 0; m < 4; ++m) { const size_t row = (size_t)(row0 + ai * 128 + m * 16); const bf16_t* prow = P + row * LDP + PC_GS + col0; bf16_t* trow = tmp + row * DM + col0;
#pragma unroll
                    for (int bj = 0; bj < 2; ++bj)
#pragma unroll
                        for (int n = 0; n < 2; ++n) { const int o = bj * 128 + n * 16; const u32x2 gg = *(const u32x2*)(prow + o); const f32x4 a = acc[ai][bj][m][n];
                            *(u32x2*)(trow + o) = pack4(bf_lo(gg.x) * a[0], bf_hi(gg.x) * a[1], bf_lo(gg.y) * a[2], bf_hi(gg.y) * a[3]); } }
        } else {
            const int gc = (u.koff < 1024) ? PC_GS : PC_GR; float* sl = slab + (size_t)(u.koff >> 8) * NSMP * DM;
#pragma unroll
            for (int m = 0; m < 4; ++m) { const size_t row = (size_t)(row0 + m * 16); const bf16_t* prow = P + row * LDP + gc + col0; float* srow = sl + (row - MP) * DM + col0;
#pragma unroll
                for (int bj = 0; bj < 2; ++bj)
#pragma unroll
                    for (int n = 0; n < 2; ++n) { const int o = bj * 128 + n * 16; const u32x2 gg = *(const u32x2*)(prow + o); const f32x4 a = acc[0][bj][m][n];
                        *(f32x4*)(srow + o) = (f32x4){bf_lo(gg.x) * a[0], bf_hi(gg.x) * a[1], bf_lo(gg.y) * a[2], bf_hi(gg.y) * a[3]}; } }
        }
    }
    __device__ __forceinline__ void fused(f32x4 (&acc)[2][2][4][2], const pg8::Unit& u, int wr, int wc, int fr, int fq, LAS unsigned char* lds, int wid, int lane) const {
        const int row0 = u.pm * 256 + wr * 64 + fr, col0 = u.pn * 256 + wc * 32 + 4 * fq;
        LAS float* PT = (LAS float*)lds; LAS float* ST = (LAS float*)(lds + 4096);
        f32x4 gt[2][2];
        { const float* gtrow = mod + (size_t)(u.pm >> 3) * NMOD + 2 * DM + col0;
#pragma unroll
          for (int bj = 0; bj < 2; ++bj)
#pragma unroll
              for (int n = 0; n < 2; ++n) gt[bj][n] = *(const f32x4*)(gtrow + bj * 128 + n * 16); }
#pragma unroll
        for (int ai = 0; ai < 2; ++ai)
#pragma unroll
            for (int m = 0; m < 4; ++m) { const size_t row = (size_t)(row0 + ai * 128 + m * 16);
                const bf16_t* prow = P + row * LDP + PC_GR + col0; const bf16_t* trow = tmp + row * DM + col0; const float* xrow = xp + row * DM + col0;
                u32x2 gg[4], tv[4]; f32x4 xv[4];
#pragma unroll
                for (int q = 0; q < 4; ++q) { const int o = (q >> 1) * 128 + (q & 1) * 16; gg[q] = *(const u32x2*)(prow + o); tv[q] = *(const u32x2*)(trow + o); xv[q] = *(const f32x4*)(xrow + o); }
                float ss = 0.f;
#pragma unroll
                for (int q = 0; q < 4; ++q) { const f32x4 a = acc[ai][q >> 1][m][q & 1]; const f32x4 g4 = gt[q >> 1][q & 1];
                    f32x4 r; r[0] = xv[q][0] + g4[0] * (bf_lo(tv[q].x) + bf_lo(gg[q].x) * a[0]); r[1] = xv[q][1] + g4[1] * (bf_hi(tv[q].x) + bf_hi(gg[q].x) * a[1]);
                    r[2] = xv[q][2] + g4[2] * (bf_lo(tv[q].y) + bf_lo(gg[q].y) * a[2]); r[3] = xv[q][3] + g4[3] * (bf_hi(tv[q].y) + bf_hi(gg[q].y) * a[3]);
                    ss += (r[0] * r[0] + r[1] * r[1]) + (r[2] * r[2] + r[3] * r[3]);
                    acc[ai][q >> 1][m][q & 1] = r; }
                ss += __shfl_xor(ss, 16); ss += __shfl_xor(ss, 32);
                if (fq == 0) PT[(ai * 128 + wr * 64 + m * 16 + fr) * 4 + wc] = ss; }
        asm volatile("s_waitcnt lgkmcnt(0)" ::: "memory"); __builtin_amdgcn_s_barrier(); asm volatile("" ::: "memory");
        const int row = wid * 32 + (lane & 31);
        if (lane < 32) { const f32x4 p4 = *(const LAS f32x4*)(PT + row * 4);
            __hip_atomic_store(xbuf + ((size_t)(u.pm * 256 + row) * 8 + u.pn), (p4[0] + p4[1]) + (p4[2] + p4[3]), __ATOMIC_RELAXED, __HIP_MEMORY_SCOPE_AGENT); }
        asm volatile("s_waitcnt vmcnt(0)" ::: "memory");
        if (lane == 0) __hip_atomic_fetch_add(cnt + 64 * u.pm, 1u, __ATOMIC_RELAXED, __HIP_MEMORY_SCOPE_AGENT);
        if (wid == 0) {
            unsigned sp = 0;
            while ((unsigned)__builtin_amdgcn_readfirstlane(__hip_atomic_load(cnt + 64 * u.pm, __ATOMIC_RELAXED, __HIP_MEMORY_SCOPE_AGENT)) < 64u) { __builtin_amdgcn_s_sleep(2); if (++sp > (1u << 22)) break; }
            __builtin_amdgcn_fence(__ATOMIC_ACQUIRE, "agent");
        }
        asm volatile("s_waitcnt vmcnt(0) lgkmcnt(0)" ::: "memory"); __builtin_amdgcn_s_barrier(); asm volatile("" ::: "memory");
        if (lane < 32) { const float* sl = xbuf + (size_t)(u.pm * 256 + row) * 8; float s8 = 0.f;
#pragma unroll
            for (int t = 0; t < 8; ++t) s8 += __hip_atomic_load(sl + t, __ATOMIC_RELAXED, __HIP_MEMORY_SCOPE_AGENT);
            ST[row] = rsqrtf(s8 * (1.0f / DM) + RMS_EPS); }
        asm volatile("s_waitcnt lgkmcnt(0)" ::: "memory"); __builtin_amdgcn_s_barrier(); asm volatile("" ::: "memory");
        f32x4 fgv[2][2];
#pragma unroll
        for (int bj = 0; bj < 2; ++bj)
#pragma unroll
            for (int n = 0; n < 2; ++n) fgv[bj][n] = *(const f32x4*)(fg + col0 + bj * 128 + n * 16);
#pragma unroll
        for (int ai = 0; ai < 2; ++ai)
#pragma unroll
            for (int m = 0; m < 4; ++m) { const int rl = ai * 128 + wr * 64 + m * 16 + fr; const float rstd = ST[rl]; float* orow = out + (size_t)(u.pm * 256 + rl) * DM + col0;
#pragma unroll
                for (int bj = 0; bj < 2; ++bj)
#pragma unroll
                    for (int n = 0; n < 2; ++n) *(f32x4*)(orow + bj * 128 + n * 16) = acc[ai][bj][m][n] * rstd * fgv[bj][n]; }
    }
};

struct Args { const float* in[34]; float* out; unsigned char* ws; int ph_lo, ph_hi, li, pad; };
enum { I_XP = 0, I_XS, I_CP, I_CS, I_S5RE, I_S5IM, I_WKV, I_SHIFT, I_NORMG, I_WADA, I_BADA, I_WIN, I_MU, I_ARE, I_AIM, I_LOGSTEP, I_BRE, I_BIM, I_CRE, I_CIM, I_DSKIP,
       I_WGLU, I_BGLU, I_W0, I_W2, I_A0, I_A2, I_KK, I_KA, I_RK, I_GNW, I_GNB, I_WOUT, I_FINALG };

__device__ __forceinline__ void transpose_item(const float* W, int ldw, int K, int csrc, bf16_t* WT, int rdst, int k0, LAS float* scr, int lane, bool zero) {
    if (zero) {
#pragma unroll
        for (int j = 0; j < 4; ++j) { const int n = (lane >> 3) + 8 * j; *(u32x4*)(WT + (size_t)(rdst + n) * K + k0 + 8 * (lane & 7)) = (u32x4){0u, 0u, 0u, 0u}; }
        return;
    }
#pragma unroll 8
    for (int i = 0; i < 32; ++i) { const int kk = 2 * i + (lane >> 5); scr[kk * 33 + (lane & 31)] = W[(size_t)(k0 + kk) * ldw + csrc + (lane & 31)]; }
    LDS_WAIT(); asm volatile("" ::: "memory");
    const int c = lane & 7;
#pragma unroll
    for (int j = 0; j < 4; ++j) { const int n = (lane >> 3) + 8 * j; const LAS float* s = scr + (8 * c) * 33 + n;
        u32x4 o; o.x = cvt_pk_bf16(s[0 * 33], s[1 * 33]); o.y = cvt_pk_bf16(s[2 * 33], s[3 * 33]); o.z = cvt_pk_bf16(s[4 * 33], s[5 * 33]); o.w = cvt_pk_bf16(s[6 * 33], s[7 * 33]);
        *(u32x4*)(WT + (size_t)(rdst + n) * K + k0 + 8 * c) = o; }
    LDS_WAIT(); asm volatile("" ::: "memory");
}

__device__ __forceinline__ void lerp8(const bf16_t* cur, const bf16_t* prev, bool has_prev, const float* mu, float (&o)[8]) {
    const u32x4 c = *(const u32x4*)cur; u32x4 p = (u32x4){0u, 0u, 0u, 0u}; if (has_prev) p = *(const u32x4*)prev;
    const f32x4 m0 = *(const f32x4*)mu, m1 = *(const f32x4*)(mu + 4);
    const float cf[8] = {bf_lo(c.x), bf_hi(c.x), bf_lo(c.y), bf_hi(c.y), bf_lo(c.z), bf_hi(c.z), bf_lo(c.w), bf_hi(c.w)};
    const float pf[8] = {bf_lo(p.x), bf_hi(p.x), bf_lo(p.y), bf_hi(p.y), bf_lo(p.z), bf_hi(p.z), bf_lo(p.w), bf_hi(p.w)};
    const float mf[8] = {m0[0], m0[1], m0[2], m0[3], m1[0], m1[1], m1[2], m1[3]};
#pragma unroll
    for (int j = 0; j < 8; ++j) o[j] = cf[j] + (pf[j] - cf[j]) * mf[j];
}
__device__ __forceinline__ void p2_xw_panel(const Args& a, int pm, int tid) {
    const bf16_t* P = (const bf16_t*)(a.ws + WS_P); bf16_t* XW = (bf16_t*)(a.ws + WS_XW); const float* mu = a.in[I_MU];
    const int row = pm * 256 + (tid >> 1), hf = tid & 1; const bool hp = (row & (SEQ - 1)) != 0;
#pragma unroll
    for (int k8 = 0; k8 < 8; ++k8) { const int col = 64 * hf + 8 * k8; float x8[8];
        lerp8(P + (size_t)row * LDP + PC_WD + col, P + (size_t)(row - 1) * LDP + PC_WD + col, hp, mu + 3072 + col, x8);
        if (hf == 0) {
#pragma unroll
            for (int j = 0; j < 8; ++j) x8[j] = tanhf_(x8[j]); }
        u32x4 t; t.x = cvt_pk_bf16(x8[0], x8[1]); t.y = cvt_pk_bf16(x8[2], x8[3]); t.z = cvt_pk_bf16(x8[4], x8[5]); t.w = cvt_pk_bf16(x8[6], x8[7]);
        *(u32x4*)(XW + (size_t)row * 128 + col) = t; }
}
__device__ __forceinline__ void wait_count(unsigned* cnt, unsigned need, int wave) {
    if (wave == 0) { unsigned sp = 0;
        while ((unsigned)__builtin_amdgcn_readfirstlane(__hip_atomic_load(cnt, __ATOMIC_RELAXED, __HIP_MEMORY_SCOPE_AGENT)) < need) { __builtin_amdgcn_s_sleep(4); if (++sp > (1u << 22)) break; }
        __builtin_amdgcn_fence(__ATOMIC_ACQUIRE, "agent");
        asm volatile("s_waitcnt vmcnt(0)" ::: "memory"); }
    __syncthreads();
}
__device__ __forceinline__ void p0_mod(const Args& a, LAS unsigned char* lds, int s, int wave, int lane) {
    const float* cp = a.in[I_CP]; const float* cs = a.in[I_CS]; const float* W = a.in[I_WADA]; const float* bias = a.in[I_BADA];
    float* mod = (float*)(a.ws + WS_MOD);
    const int n0 = 32 * s, k0 = 256 * wave, r31 = lane & 31, h = lane >> 5;
    f32x16 acc[5];
#pragma unroll
    for (int t = 0; t < 5; ++t)
#pragma unroll
        for (int r = 0; r < 16; ++r) acc[t][r] = 0.f;
    float bw[8]; f32x4 c0[5], c1[5];
#define MOD_LOAD(ks_) do { const int kb_ = k0 + 16 * (ks_) + 8 * h; \
        _Pragma("unroll") for (int j = 0; j < 8; ++j) bw[j] = W[(size_t)(kb_ + j) * NMOD + n0 + r31]; \
        _Pragma("unroll") for (int t = 0; t < 5; ++t) { const int R = 32 * t + r31; c0[t] = (f32x4){0.f, 0.f, 0.f, 0.f}; c1[t] = c0[t]; \
            if (R < NMODROWS) { const float* src = (R < NB) ? cp + (size_t)R * DM + kb_ : cs + (size_t)(R - NB) * DM + kb_; c0[t] = *(const f32x4*)src; c1[t] = *(const f32x4*)(src + 4); } } } while (0)
    MOD_LOAD(0);
#pragma unroll 1
    for (int ks = 0; ks < 16; ++ks) {
        bf16x8 bfr; { u32x4 t; t.x = cvt_pk_bf16(bw[0], bw[1]); t.y = cvt_pk_bf16(bw[2], bw[3]); t.z = cvt_pk_bf16(bw[4], bw[5]); t.w = cvt_pk_bf16(bw[6], bw[7]); bfr = __builtin_bit_cast(bf16x8, t); }
        bf16x8 afr[5];
#pragma unroll
        for (int t = 0; t < 5; ++t) { u32x4 w; w.x = cvt_pk_bf16(siluf_(c0[t][0]), siluf_(c0[t][1])); w.y = cvt_pk_bf16(siluf_(c0[t][2]), siluf_(c0[t][3])); w.z = cvt_pk_bf16(siluf_(c1[t][0]), siluf_(c1[t][1])); w.w = cvt_pk_bf16(siluf_(c1[t][2]), siluf_(c1[t][3])); afr[t] = __builtin_bit_cast(bf16x8, w); }
        if (ks + 1 < 16) MOD_LOAD(ks + 1);
#pragma unroll
        for (int t = 0; t < 5; ++t) acc[t] = __builtin_amdgcn_mfma_f32_32x32x16_bf16(afr[t], bfr, acc[t], 0, 0, 0);
    }
#undef MOD_LOAD
    LAS float* red = (LAS float*)lds;
#pragma unroll
    for (int step = 4; step >= 1; step >>= 1) {
        if (wave >= step && wave < 2 * step) {
#pragma unroll
            for (int t = 0; t < 5; ++t)
#pragma unroll
                for (int r = 0; r < 16; ++r) red[(((wave - step) * 5 + t) * 16 + r) * 64 + lane] = acc[t][r];
        }
        __syncthreads();
        if (wave < step) {
#pragma unroll
            for (int t = 0; t < 5; ++t)
#pragma unroll
                for (int r = 0; r < 16; ++r) acc[t][r] += red[((wave * 5 + t) * 16 + r) * 64 + lane];
        }
        __syncthreads();
    }
    if (wave == 0) {
        const float bc = bias[n0 + r31];
#pragma unroll
        for (int t = 0; t < 5; ++t)
#pragma unroll
            for (int r = 0; r < 16; ++r) { const int R = 32 * t + (r & 3) + 8 * (r >> 2) + 4 * h; if (R < NMODROWS) mod[(size_t)R * NMOD + n0 + r31] = acc[t][r] + bc; }
    }
}

__device__ __forceinline__ void p0_s5_tables(const Args& a, LAS unsigned char* lds, int g, int tid) {
    LAS float* pw = (LAS float*)lds;
    LAS float* bbL = pw + 17 * 128;
    LAS float* ccL = bbL + 2048;
    LAS float* KF = ccL + 2048;
    LAS float* DL = KF + 4096;
    unsigned char* tab = (unsigned char*)a.out + DO_S5TAB + (size_t)g * S5T_BYTES;
    {
        const int p = tid & 63;
        const float step = expf(a.in[I_LOGSTEP][g]);
        const float lre = fminf(a.in[I_ARE][g * 64 + p], -1e-4f), lim = a.in[I_AIM][g * 64 + p];
        const float mag = expf(lre * step); float sn, cs; sincosf(lim * step, &sn, &cs);
        const float abr = mag * cs, abi = mag * sn, den = lre * lre + lim * lim;
        const float fr = ((abr - 1.0f) * lre + abi * lim) / den, fi = (abi * lre - (abr - 1.0f) * lim) / den;
        if (tid < 64) { float pr = 1.f, pi = 0.f;
            for (int e = 0; e <= 16; ++e) { pw[(e * 64 + p) * 2] = pr; pw[(e * 64 + p) * 2 + 1] = pi; const float nr = pr * abr - pi * abi, ni = pr * abi + pi * abr; pr = nr; pi = ni; } }
#pragma unroll
        for (int i = 0; i < 2; ++i) { const int c = (tid >> 6) + 8 * i; const float br = a.in[I_BRE][(g * 64 + p) * 16 + c], bi = a.in[I_BIM][(g * 64 + p) * 16 + c];
            bbL[(p * 16 + c) * 2] = fr * br - fi * bi; bbL[(p * 16 + c) * 2 + 1] = fr * bi + fi * br;
            ccL[(c * 64 + p) * 2] = a.in[I_CRE][(g * 16 + c) * 64 + p]; ccL[(c * 64 + p) * 2 + 1] = a.in[I_CIM][(g * 16 + c) * 64 + p]; }
        if (tid < 16) DL[tid] = a.in[I_DSKIP][g * 16 + tid];
    }
    __syncthreads();
    for (int idx = tid; idx < 4096; idx += 512) { const int e = idx >> 8, c = (idx >> 4) & 15, c2 = idx & 15; float s = 0.f;
        for (int p = 0; p < 64; ++p) { const float cr = ccL[(c * 64 + p) * 2], ci = ccL[(c * 64 + p) * 2 + 1], pr = pw[(e * 64 + p) * 2], pi = pw[(e * 64 + p) * 2 + 1];
            const float ar = cr * pr - ci * pi, ai = cr * pi + ci * pr; s += ar * bbL[(p * 16 + c2) * 2] - ai * bbL[(p * 16 + c2) * 2 + 1]; }
        if (e == 0 && c == c2) s += DL[c];
        KF[idx] = s; }
    __syncthreads();
    for (int it = tid; it < 4096; it += 512) { const int l = it & 63, s = (it >> 6) & 15, mtile = it >> 10; const int m = 32 * mtile + (l & 31), h = l >> 5, p = m & 63, im = m >> 6;
        const float pr = pw[((15 - s) * 64 + p) * 2], pi = pw[((15 - s) * 64 + p) * 2 + 1]; float v[8];
#pragma unroll
        for (int j = 0; j < 8; ++j) { const float br = bbL[(p * 16 + 8 * h + j) * 2], bi = bbL[(p * 16 + 8 * h + j) * 2 + 1]; v[j] = im ? (pr * bi + pi * br) : (pr * br - pi * bi); }
        u32x4 w; w.x = cvt_pk_bf16(v[0], v[1]); w.y = cvt_pk_bf16(v[2], v[3]); w.z = cvt_pk_bf16(v[4], v[5]); w.w = cvt_pk_bf16(v[6], v[7]);
        *(u32x4*)(tab + S5T_ME + (size_t)it * 16) = w; }
    for (int it = tid; it < 1024; it += 512) { const int l = it & 63, ti = it >> 6; const int rho = l & 31, dt = rho >> 4, c = rho & 15, h = l >> 5, e = ti - 1 + dt; float v[8];
#pragma unroll
        for (int j = 0; j < 8; ++j) v[j] = (e < 0) ? 0.f : KF[(e * 16 + c) * 16 + 8 * h + j];
        u32x4 w; w.x = cvt_pk_bf16(v[0], v[1]); w.y = cvt_pk_bf16(v[2], v[3]); w.z = cvt_pk_bf16(v[4], v[5]); w.w = cvt_pk_bf16(v[6], v[7]);
        *(u32x4*)(tab + S5T_KT + (size_t)it * 16) = w; }
    for (int it = tid; it < 4096; it += 512) { const int l = it & 63, ks = (it >> 6) & 7, mt = it >> 9; const int rho = l & 31, dt = rho >> 4, c = rho & 15, h = l >> 5, t = 2 * mt + dt; float v[8];
#pragma unroll
        for (int j = 0; j < 8; ++j) { const int m = 16 * ks + 8 * h + j, p = m & 63; const float cr = ccL[(c * 64 + p) * 2], ci = ccL[(c * 64 + p) * 2 + 1], pr = pw[((t + 1) * 64 + p) * 2], pi = pw[((t + 1) * 64 + p) * 2 + 1];
            v[j] = (m < 64) ? (cr * pr - ci * pi) : -(cr * pi + ci * pr); }
        u32x4 w; w.x = cvt_pk_bf16(v[0], v[1]); w.y = cvt_pk_bf16(v[2], v[3]); w.z = cvt_pk_bf16(v[4], v[5]); w.w = cvt_pk_bf16(v[6], v[7]);
        *(u32x4*)(tab + S5T_CA + (size_t)it * 16) = w; }
    { const int it = tid; const int l = it & 63, sp = (it >> 6) & 1, mtile = it >> 7; const int rho = l & 31, h = l >> 5; float v[8];
#pragma unroll
        for (int j = 0; j < 8; ++j) { const int m = 32 * mtile + 16 * sp + 8 * (j >> 2) + 4 * h + (j & 3), p = m & 63; v[j] = (rho < 16) ? ((m < 64) ? ccL[(rho * 64 + p) * 2] : -ccL[(rho * 64 + p) * 2 + 1]) : 0.f; }
        u32x4 w; w.x = cvt_pk_bf16(v[0], v[1]); w.y = cvt_pk_bf16(v[2], v[3]); w.z = cvt_pk_bf16(v[4], v[5]); w.w = cvt_pk_bf16(v[6], v[7]);
        *(u32x4*)(tab + S5T_C0 + (size_t)it * 16) = w; }
    if (tid < 64) { const int l = tid, rho = l & 31, h = l >> 5; float v[8];
#pragma unroll
        for (int j = 0; j < 8; ++j) v[j] = (rho < 16 && rho == 8 * h + j) ? DL[rho] : 0.f;
        u32x4 w; w.x = cvt_pk_bf16(v[0], v[1]); w.y = cvt_pk_bf16(v[2], v[3]); w.z = cvt_pk_bf16(v[4], v[5]); w.w = cvt_pk_bf16(v[6], v[7]);
        *(u32x4*)(tab + S5T_DF + (size_t)l * 16) = w;
        float* hdr = (float*)(tab + S5T_HDR);
        hdr[l] = pw[(16 * 64 + l) * 2]; hdr[64 + l] = pw[(16 * 64 + l) * 2 + 1]; hdr[128 + l] = pw[(64 + l) * 2]; hdr[192 + l] = pw[(64 + l) * 2 + 1]; }
    __syncthreads();
}

__device__ __forceinline__ void p1_row(const Args& a, int m, int lane) {
    bf16_t* XN = (bf16_t*)(a.ws + WS_XN) + (size_t)m * DM;
    if (m >= MV) {
        const float* src = a.in[I_SHIFT] + (size_t)(m - MV) * DM;
#pragma unroll
        for (int j = 0; j < 8; ++j) { const f32x4 v = *(const f32x4*)(src + 4 * lane + 256 * j); u32x2 w; w.x = cvt_pk_bf16(v[0], v[1]); w.y = cvt_pk_bf16(v[2], v[3]); *(u32x2*)(XN + 4 * lane + 256 * j) = w; }
        return;
    }
    const float* x = (m < MP) ? a.in[I_XP] + (size_t)m * DM : a.in[I_XS] + (size_t)(m - MP) * DM;
    const int mrow = (m < MP) ? (m >> 11) : (NB + m - MP);
    const float* mod = (const float*)(a.ws + WS_MOD) + (size_t)mrow * NMOD;
    const float* g = a.in[I_NORMG];
    f32x4 v[8]; float ss = 0.f;
#pragma unroll
    for (int j = 0; j < 8; ++j) { v[j] = *(const f32x4*)(x + 4 * lane + 256 * j); ss += (v[j][0] * v[j][0] + v[j][1] * v[j][1]) + (v[j][2] * v[j][2] + v[j][3] * v[j][3]); }
    const float rstd = rsqrtf(wave_sum(ss) * (1.0f / DM) + RMS_EPS);
    float* sh_out = nullptr;
    if (m >= MP) sh_out = a.out + OUT_SHIFT_S + (size_t)(m - MP) * DM;
    else if ((m & (SEQ - 1)) == SEQ - 1) sh_out = a.out + OUT_SHIFT_P + (size_t)(m >> 11) * DM;
#pragma unroll
    for (int j = 0; j < 8; ++j) { const int k = 4 * lane + 256 * j; const f32x4 gv = *(const f32x4*)(g + k), sh = *(const f32x4*)(mod + k), sc = *(const f32x4*)(mod + DM + k);
        f32x4 hv;
#pragma unroll
        for (int q = 0; q < 4; ++q) hv[q] = v[j][q] * rstd * gv[q] * (1.0f + sc[q]) + sh[q];
        u32x2 w; w.x = cvt_pk_bf16(hv[0], hv[1]); w.y = cvt_pk_bf16(hv[2], hv[3]); *(u32x2*)(XN + k) = w;
        if (sh_out) *(f32x4*)(sh_out + k) = hv; }
}

constexpr int RW_TB = 32;
constexpr int RW_KK = 0, RW_DR = 2048, RW_DD = 4096, RW_BB = 6144, RW_KP = 8192, RW_VV = 10240, RW_SC = 11264, RW_LW = 11392, RW_LA = 13440, RW_OB = 15488, RW_BVB = 16512, RW_END = 17536;
struct RwTok { float kk, dr, dd, bb, kp, v, br, kr, bonus; };
__device__ __forceinline__ RwTok rw_token(const Args& a, int hj, float r, float k, float v, float lw, float la) {
    RwTok o;
    const float wpre = a.in[I_W0][hj] + lw;
    const float nz = -wpre;
    const float sp = fmaxf(nz, 0.f) + log1pf(__expf(-fabsf(nz)));
    const float w = -sp - 0.5f;
    o.dd = __expf(-__expf(w));
    const float av = sigmoidf_(a.in[I_A0][hj] + la);
    const float kkv = k * a.in[I_KK][hj];
    const float nrm = sqrtf(wave_sum(kkv * kkv));
    o.kk = kkv / fmaxf(nrm, 1e-12f);
    o.kp = k * (1.0f + (av - 1.0f) * a.in[I_KA][hj]);
    o.bb = o.kk * av;
    o.dr = o.dd * r;
    o.v = v;
    o.br = wave_sum(o.bb * r);
    o.kr = wave_sum(o.kp * r);
    o.bonus = wave_sum(r * o.kp * a.in[I_RK][hj]);
    return o;
}
__device__ __forceinline__ void p3_rwkv_prompt(const Args& a, LAS unsigned char* lds, int unit, int tid, int wave, int lane) {
    const int b = unit >> 5, h = (unit >> 1) & 15, half = unit & 1;
    LAS float* L = (LAS float*)lds;
    const bf16_t* P = (const bf16_t*)(a.ws + WS_P);
    bf16_t* ORAW = (bf16_t*)((unsigned char*)a.out + DO_ORAW); bf16_t* BV = (bf16_t*)((unsigned char*)a.out + DO_BV);
    const float* mu = a.in[I_MU];
    const int r31 = lane & 31, hh = lane >> 5;
    bf16x8 bfr[4];
    if (wave < 4) { const float* W2 = (wave >> 1) ? a.in[I_A2] : a.in[I_W2]; const int col = h * 64 + 32 * (wave & 1) + r31;
#pragma unroll
        for (int ks = 0; ks < 4; ++ks) { float w[8];
#pragma unroll
            for (int j = 0; j < 8; ++j) w[j] = W2[(size_t)(16 * ks + 8 * hh + j) * 1024 + col];
            u32x4 t; t.x = cvt_pk_bf16(w[0], w[1]); t.y = cvt_pk_bf16(w[2], w[3]); t.z = cvt_pk_bf16(w[4], w[5]); t.w = cvt_pk_bf16(w[6], w[7]); bfr[ks] = __builtin_bit_cast(bf16x8, t); } }
    const int srow = 4 * wave + (lane >> 4), cq = lane & 15;
    f32x4 S = (f32x4){0.f, 0.f, 0.f, 0.f};
    for (int t0 = 0; t0 < SEQ; t0 += RW_TB) {
        const size_t rowbase = (size_t)b * SEQ + t0;
        if (wave < 4) { const int mat = wave >> 1, nt2 = wave & 1; const size_t row = rowbase + r31; const bool hp = (t0 + r31) > 0;
            f32x16 acc;
#pragma unroll
            for (int r = 0; r < 16; ++r) acc[r] = 0.f;
#pragma unroll
            for (int ks = 0; ks < 4; ++ks) { const int col = PC_WD + mat * 64 + 16 * ks + 8 * hh; float x8[8];
                lerp8(P + row * LDP + col, P + (row - 1) * LDP + col, hp, mu + 3072 + mat * 64 + 16 * ks + 8 * hh, x8);
                if (mat == 0) {
#pragma unroll
                    for (int j = 0; j < 8; ++j) x8[j] = tanhf_(x8[j]); }
                u32x4 t; t.x = cvt_pk_bf16(x8[0], x8[1]); t.y = cvt_pk_bf16(x8[2], x8[3]); t.z = cvt_pk_bf16(x8[4], x8[5]); t.w = cvt_pk_bf16(x8[6], x8[7]);
                acc = __builtin_amdgcn_mfma_f32_32x32x16_bf16(__builtin_bit_cast(bf16x8, t), bfr[ks], acc, 0, 0, 0); }
            LAS float* dst = L + (mat ? RW_LA : RW_LW);
#pragma unroll
            for (int r = 0; r < 16; ++r) { const int tl = (r & 3) + 8 * (r >> 2) + 4 * hh; dst[tl * 64 + 32 * nt2 + r31] = acc[r]; } }
        __syncthreads();
#pragma unroll
        for (int q = 0; q < 4; ++q) { const int tl = wave * 4 + q; const size_t row = rowbase + tl; const bool hp = (t0 + tl) > 0; const int hj = h * 64 + lane;
            const bf16_t* pc = P + row * LDP; const bf16_t* pp = pc - LDP;
            float r = bf2f(pc[PC_R + hj]), k = bf2f(pc[PC_K + hj]), v = bf2f(pc[PC_V + hj]);
            const float pr = hp ? bf2f(pp[PC_R + hj]) : 0.f, pk = hp ? bf2f(pp[PC_K + hj]) : 0.f, pv = hp ? bf2f(pp[PC_V + hj]) : 0.f;
            r += (pr - r) * mu[hj]; k += (pk - k) * mu[1024 + hj]; v += (pv - v) * mu[2048 + hj];
            const RwTok o = rw_token(a, hj, r, k, v, L[RW_LW + tl * 64 + lane], L[RW_LA + tl * 64 + lane]);
            L[RW_KK + tl * 64 + lane] = o.kk; L[RW_DR + tl * 64 + lane] = o.dr; L[RW_DD + tl * 64 + lane] = o.dd; L[RW_BB + tl * 64 + lane] = o.bb; L[RW_KP + tl * 64 + lane] = o.kp;
            if ((lane >> 5) == half) L[RW_VV + tl * 32 + (lane & 31)] = o.v;
            if (lane == 0) { L[RW_SC + tl * 4] = o.br; L[RW_SC + tl * 4 + 1] = o.kr; L[RW_SC + tl * 4 + 2] = o.bonus; } }
        __syncthreads();
#pragma unroll 4
        for (int tl = 0; tl < RW_TB; ++tl) {
            const f32x4 kk4 = *(const LAS f32x4*)(L + RW_KK + tl * 64 + 4 * cq), dr4 = *(const LAS f32x4*)(L + RW_DR + tl * 64 + 4 * cq), d4 = *(const LAS f32x4*)(L + RW_DD + tl * 64 + 4 * cq),
                        b4 = *(const LAS f32x4*)(L + RW_BB + tl * 64 + 4 * cq), k4 = *(const LAS f32x4*)(L + RW_KP + tl * 64 + 4 * cq);
            const float v = L[RW_VV + tl * 32 + srow]; const f32x4 sc = *(const LAS f32x4*)(L + RW_SC + tl * 4);
            float p1 = (S[0] * kk4[0] + S[1] * kk4[1]) + (S[2] * kk4[2] + S[3] * kk4[3]);
            float p2 = (S[0] * dr4[0] + S[1] * dr4[1]) + (S[2] * dr4[2] + S[3] * dr4[3]);
            p1 = row16_sum(p1); p2 = row16_sum(p2);
            const float sa = -p1;
            const float o = p2 + sa * sc[0] + v * sc[1];
#pragma unroll
            for (int j = 0; j < 4; ++j) S[j] = S[j] * d4[j] + sa * b4[j] + v * k4[j];
            if (cq == 0) { L[RW_OB + tl * 32 + srow] = o; L[RW_BVB + tl * 32 + srow] = sc[2] * v; }
        }
        __syncthreads();
        { const int tl = tid >> 4, r2 = 2 * (tid & 15); const size_t off = (rowbase + tl) * 1024 + h * 64 + 32 * half + r2;
          *(unsigned*)(ORAW + off) = cvt_pk_bf16(L[RW_OB + tl * 32 + r2], L[RW_OB + tl * 32 + r2 + 1]);
          *(unsigned*)(BV + off) = cvt_pk_bf16(L[RW_BVB + tl * 32 + r2], L[RW_BVB + tl * 32 + r2 + 1]); }
    }
    *(f32x4*)(a.out + OUT_WKV_P + (((size_t)(b * 16 + h) * 64 + 32 * half + srow) * 64 + 4 * cq)) = S;
    __syncthreads();
}


constexpr int RC_LD = 72, RC_MAT = 64 * RC_LD * 2;
constexpr int RC_QK = 0 * RC_MAT, RC_RT = 1 * RC_MAT, RC_KT = 2 * RC_MAT, RC_BT = 3 * RC_MAT, RC_QKT = 4 * RC_MAT, RC_BHT = 5 * RC_MAT, RC_KHT = 6 * RC_MAT, RC_VT = 7 * RC_MAT,
              RC_AKK = 8 * RC_MAT, RC_ARK = 9 * RC_MAT, RC_ARB = 10 * RC_MAT, RC_TB = 11 * RC_MAT, RC_AKB = 12 * RC_MAT, RC_W1T = 12 * RC_MAT, RC_U1T = 13 * RC_MAT,
              RC_AVT = RC_QK, RC_TF = RC_KT, RC_LWA = RC_AKK, RC_SEG = 14 * RC_MAT;
static_assert(RC_SEG + 2048 <= RING_BYTES, "rwkv chunk lds");
constexpr int RS_ROWB = 656, RS_BASE = 0;
static_assert(RS_BASE + 65 * RS_ROWB <= RC_AKK, "staging must stay inside R0..R7");
#define MFMA32(a, b, c) __builtin_amdgcn_mfma_f32_32x32x16_bf16((a), (b), (c), 0, 0, 0)
#define MFMA16(a, b, c) __builtin_amdgcn_mfma_f32_16x16x32_bf16((a), (b), (c), 0, 0, 0)
__device__ __forceinline__ bf16x8 lds_frag(LAS unsigned char* lds, int mat, int row, int k0) { return *(const LAS bf16x8*)(lds + mat + (row * RC_LD + k0) * 2); }

__device__ __forceinline__ void p3_rwkv_chunks(const Args& a, LAS unsigned char* lds, int bh, int seg, int tid, int wave, int lane) {
    const int b = bh >> 4, h = bh & 15, r31_ = lane & 31, hh_ = lane >> 5, hj = h * 64 + lane;
    const bf16_t* P = (const bf16_t*)(a.ws + WS_P);
    bf16_t* BV = (bf16_t*)((unsigned char*)a.out + DO_BV);
    const float* mu = a.in[I_MU];
    LAS float* SEG = (LAS float*)(lds + RC_SEG);
    bf16x8 bfr[4];
    { const float* W2 = (wave >> 2) ? a.in[I_A2] : a.in[I_W2]; const int col = h * 64 + 32 * (wave & 1) + r31_;
#pragma unroll
      for (int ks = 0; ks < 4; ++ks) { float w[8];
#pragma unroll
          for (int j = 0; j < 8; ++j) w[j] = W2[(size_t)(16 * ks + 8 * hh_ + j) * 1024 + col];
          u32x4 t; t.x = cvt_pk_bf16(w[0], w[1]); t.y = cvt_pk_bf16(w[2], w[3]); t.z = cvt_pk_bf16(w[4], w[5]); t.w = cvt_pk_bf16(w[6], w[7]); bfr[ks] = __builtin_bit_cast(bf16x8, t); } }
    const float w0j = a.in[I_W0][hj], a0j = a.in[I_A0][hj], kkj = a.in[I_KK][hj], kaj = a.in[I_KA][hj], rkj = a.in[I_RK][hj];
    const float mur = mu[hj], muk = mu[1024 + hj], muv = mu[2048 + hj];
    unsigned goff[6], loff[6]; u32x4 pf[6];
#pragma unroll
    for (int i = 0; i < 6; ++i) { const int idx = tid + 512 * i, row = idx / 40, c = idx - row * 40;
        const int col = (c < 8) ? PC_R + h * 64 + 8 * c : ((c < 16) ? PC_K + h * 64 + 8 * (c - 8) : PC_V + h * 64 + 8 * (c - 16));
        goff[i] = (c < 24) ? (unsigned)(row * LDP + col) * 2u : (0x80000000u | (unsigned)(row * 128 + 8 * (c - 24)) * 2u);   loff[i] = (unsigned)(RS_BASE + row * RS_ROWB + c * 16); }
#define RWC_PREFETCH(chunk_) do { const unsigned char* pb_ = (const unsigned char*)(P + ((size_t)b * SEQ + (size_t)(chunk_) * 64 - 1) * LDP); \
        const unsigned char* xb_ = a.ws + WS_XW + ((size_t)b * SEQ + (size_t)(chunk_) * 64) * 256 - 256; \
        _Pragma("unroll") for (int i = 0; i < 6; ++i) { const bool ok_ = (tid + 512 * i < 2600) && ((chunk_) > 0 || tid + 512 * i >= 40); \
            pf[i] = (u32x4){0u, 0u, 0u, 0u}; if (ok_) pf[i] = (goff[i] & 0x80000000u) ? *(const u32x4*)(xb_ + (goff[i] & 0x7fffffffu)) : *(const u32x4*)(pb_ + goff[i]); } } while (0)
    RWC_PREFETCH(seg * 8);
#pragma unroll 1
    for (int ci = 0; ci < 8; ++ci) {
        const int chunk = seg * 8 + ci; const size_t rowbase = (size_t)b * SEQ + chunk * 64;
#pragma unroll
        for (int i = 0; i < 6; ++i) if (tid + 512 * i < 2600) *(LAS u32x4*)(lds + loff[i]) = pf[i];
        if (ci + 1 < 8) RWC_PREFETCH(chunk + 1);
        __syncthreads();
        int r31 = r31_, hh = hh_; asm volatile("" : "+v"(r31), "+v"(hh));
        unsigned char* rwi = a.ws + WS_RWI + (size_t)((bh * 32) + chunk) * RWI_BYTES;
        { const int mat = wave >> 2, mtile = (wave >> 1) & 1, nt2 = wave & 1; const int tl = 32 * mtile + r31;
          f32x16 acc;
#pragma unroll
          for (int r = 0; r < 16; ++r) acc[r] = 0.f;
#pragma unroll
          for (int ks = 0; ks < 4; ++ks) acc = MFMA32(*(const LAS bf16x8*)(lds + RS_BASE + (tl + 1) * RS_ROWB + (24 + mat * 8 + 2 * ks + hh) * 16), bfr[ks], acc);
          LAS float* dst = (LAS float*)(lds + RC_LWA) + mat * 64 * 68;
#pragma unroll
          for (int r = 0; r < 16; ++r) { const int t2 = 32 * mtile + (r & 3) + 8 * (r >> 2) + 4 * hh; dst[t2 * 68 + 32 * nt2 + r31] = acc[r]; } }
        __syncthreads();
        float r8[8], kp8[8], kk8[8], bb8[8], v8[8], ld8[8], cs8[8];
        { const LAS float* LW = (const LAS float*)(lds + RC_LWA); const LAS float* LA = LW + 64 * 68;
#pragma unroll
          for (int q = 0; q < 8; ++q) { const int tl = 8 * wave + q; const size_t row = rowbase + tl;
              const LAS bf16_t* pc = (const LAS bf16_t*)(lds + RS_BASE + (tl + 1) * RS_ROWB); const LAS bf16_t* pp = (const LAS bf16_t*)(lds + RS_BASE + tl * RS_ROWB);
              float r = bf2f(pc[lane]), k = bf2f(pc[64 + lane]), v = bf2f(pc[128 + lane]);
              const float pr = bf2f(pp[lane]), pk = bf2f(pp[64 + lane]), pv = bf2f(pp[128 + lane]);
              r += (pr - r) * mur; k += (pk - k) * muk; v += (pv - v) * muv;
              ld8[q] = -0.6065306597126334f * sigmoidf_(w0j + LW[tl * 68 + lane]);
              const float av = sigmoidf_(a0j + LA[tl * 68 + lane]);
              const float kkv = k * kkj; const float rn = fminf(__builtin_amdgcn_rsqf(wave_sum_dpp(kkv * kkv)), 1e12f);
              kk8[q] = kkv * rn; kp8[q] = k * (1.0f + (av - 1.0f) * kaj); bb8[q] = kk8[q] * av; r8[q] = r; v8[q] = v;
              const float bonus = wave_sum_dpp(r * kp8[q] * rkj);
              BV[row * 1024 + hj] = f2bf(bonus * v); }
          cs8[0] = ld8[0];
#pragma unroll
          for (int q = 1; q < 8; ++q) cs8[q] = cs8[q - 1] + ld8[q];
          SEG[wave * 64 + lane] = cs8[7]; }
        __syncthreads();
        { float off = 0.f, cL = 0.f;
#pragma unroll
          for (int w2 = 0; w2 < 8; ++w2) { const float sg = SEG[w2 * 64 + lane]; cL += sg; if (w2 < wave) off += sg; }
          if (wave == 0) *(float*)(rwi + RWI_LAM + lane * 4) = __expf(cL);
          float qkT[8], bhT[8], khT[8];
          const float eLtot = __expf(cL); float ecprev = __expf(off);
#pragma unroll
          for (int q = 0; q < 8; ++q) { const int tl = 8 * wave + q; const float c = off + cs8[q];
              const float ec = __expf(c), ecp = ecprev, enc = rcpf_(ec), eL = eLtot * enc; ecprev = ec;
              const float qk = kk8[q] * ecp;
              ((LAS bf16_t*)(lds + RC_QK))[tl * RC_LD + lane] = f2bf(qk); ((LAS bf16_t*)(lds + RC_RT))[tl * RC_LD + lane] = f2bf(r8[q] * ec);
              ((LAS bf16_t*)(lds + RC_KT))[tl * RC_LD + lane] = f2bf(kp8[q] * enc); ((LAS bf16_t*)(lds + RC_BT))[tl * RC_LD + lane] = f2bf(bb8[q] * enc);
              qkT[q] = qk; bhT[q] = bb8[q] * eL; khT[q] = kp8[q] * eL; }
          u32x4 t;
          t.x = cvt_pk_bf16(qkT[0], qkT[1]); t.y = cvt_pk_bf16(qkT[2], qkT[3]); t.z = cvt_pk_bf16(qkT[4], qkT[5]); t.w = cvt_pk_bf16(qkT[6], qkT[7]); *(LAS u32x4*)(lds + RC_QKT + (lane * RC_LD + 8 * wave) * 2) = t;
          t.x = cvt_pk_bf16(bhT[0], bhT[1]); t.y = cvt_pk_bf16(bhT[2], bhT[3]); t.z = cvt_pk_bf16(bhT[4], bhT[5]); t.w = cvt_pk_bf16(bhT[6], bhT[7]); *(LAS u32x4*)(lds + RC_BHT + (lane * RC_LD + 8 * wave) * 2) = t;
          t.x = cvt_pk_bf16(khT[0], khT[1]); t.y = cvt_pk_bf16(khT[2], khT[3]); t.z = cvt_pk_bf16(khT[4], khT[5]); t.w = cvt_pk_bf16(khT[6], khT[7]); *(LAS u32x4*)(lds + RC_KHT + (lane * RC_LD + 8 * wave) * 2) = t;
          t.x = cvt_pk_bf16(v8[0], v8[1]); t.y = cvt_pk_bf16(v8[2], v8[3]); t.z = cvt_pk_bf16(v8[4], v8[5]); t.w = cvt_pk_bf16(v8[6], v8[7]); *(LAS u32x4*)(lds + RC_VT + (lane * RC_LD + 8 * wave) * 2) = t; }
        __syncthreads();
#pragma unroll
        for (int jr = 0; jr < 2; ++jr) { const int job = wave + 8 * jr; if (job < 12) {
            const int mat = job / 3, tt = job % 3, ms = (tt == 2) ? 1 : 0, nt2 = (tt == 0) ? 0 : 1;
            const int X = (mat & 1) ? RC_BT : RC_KT, Y = (mat & 2) ? RC_RT : RC_QK;
            f32x16 acc;
#pragma unroll
            for (int r = 0; r < 16; ++r) acc[r] = 0.f;
#pragma unroll
            for (int ks = 0; ks < 4; ++ks) acc = MFMA32(lds_frag(lds, X, 32 * ms + r31, 16 * ks + 8 * hh), lds_frag(lds, Y, 32 * nt2 + r31, 16 * ks + 8 * hh), acc);
            const int t = 32 * nt2 + r31; const bool incl = (mat & 2) != 0;
#pragma unroll
            for (int g4 = 0; g4 < 4; ++g4) { const int s0 = 32 * ms + 8 * g4 + 4 * hh; float v[4];
#pragma unroll
                for (int e = 0; e < 4; ++e) { const int sx = s0 + e; v[e] = (incl ? (sx <= t) : (sx < t)) ? acc[4 * g4 + e] : 0.f; }
                if (mat == 1) *(LAS f32x4*)(lds + RC_AKB + (t * 72 + s0) * 4) = (f32x4){v[0], v[1], v[2], v[3]};
                else { const int dstm = (mat == 0) ? RC_AKK : ((mat == 2) ? RC_ARK : RC_ARB); *(LAS u32x2*)(lds + dstm + (t * RC_LD + s0) * 2) = pack4(v[0], v[1], v[2], v[3]); } } } }
        __syncthreads();
        LAS float* TF = (LAS float*)(lds + RC_TF); const LAS float* AKB = (const LAS float*)(lds + RC_AKB); LAS float* YS = SEG;
        if (wave == 0) {
            const int I = lane >> 4, jj = lane & 15; float x[16];
#pragma unroll
            for (int r = 0; r < 16; ++r) { float sacc = (r == jj) ? 1.f : 0.f;
#pragma unroll
                for (int q = 0; q < r; ++q) sacc -= AKB[(16 * I + r) * 72 + 16 * I + q] * x[q];
                x[r] = sacc; TF[(16 * I + r) * 72 + 16 * I + jj] = sacc; }
        } else if (wave < 4) {
            const int t2 = tid - 64;
            for (int e = t2; e < 512; e += 192) { const int blk = e >> 8, rr = (e >> 4) & 15, cc = e & 15; TF[(32 * blk + rr) * 72 + 32 * blk + 16 + cc] = 0.f; }
        } else {
            const int mt = (wave >> 1) & 1, nt2 = wave & 1; f32x16 acc;
#pragma unroll
            for (int r = 0; r < 16; ++r) acc[r] = 0.f;
#pragma unroll
            for (int ks = 0; ks < 4; ++ks) if (ks < 2 || mt == 1) acc = MFMA32(lds_frag(lds, RC_AKK, 32 * mt + r31, 16 * ks + 8 * hh), lds_frag(lds, RC_VT, 32 * nt2 + r31, 16 * ks + 8 * hh), acc);
#pragma unroll
            for (int g4 = 0; g4 < 4; ++g4) *(LAS u32x2*)(lds + RC_AVT + ((32 * nt2 + r31) * RC_LD + 32 * mt + 8 * g4 + 4 * hh) * 2) = pack4(acc[4 * g4], acc[4 * g4 + 1], acc[4 * g4 + 2], acc[4 * g4 + 3]);
        }
        __syncthreads();
        { const int pr = tid >> 8, i = (tid >> 4) & 15, jj = tid & 15, ba = 2 * pr, bb = 2 * pr + 1;
          float y = 0.f;
#pragma unroll
          for (int q = 0; q < 16; ++q) y += AKB[(16 * bb + i) * 72 + 16 * ba + q] * TF[(16 * ba + q) * 72 + 16 * ba + jj];
          YS[tid] = y; }
        __syncthreads();
        { const int pr = tid >> 8, i = (tid >> 4) & 15, jj = tid & 15, ba = 2 * pr, bb = 2 * pr + 1; float tv = 0.f;
#pragma unroll
          for (int q = 0; q < 16; ++q) tv -= TF[(16 * bb + i) * 72 + 16 * bb + q] * YS[pr * 256 + q * 16 + jj];
          TF[(16 * bb + i) * 72 + 16 * ba + jj] = tv; }
        __syncthreads();
        { const int i = tid >> 4, j0 = (tid & 15) * 2; float z0 = 0.f, z1 = 0.f;
#pragma unroll 8
          for (int q = 0; q < 32; ++q) { const float av = AKB[(32 + i) * 72 + q]; z0 += av * TF[q * 72 + j0]; z1 += av * TF[q * 72 + j0 + 1]; }
          __syncthreads();
          TF[i * 72 + 32 + j0] = z0; TF[i * 72 + 32 + j0 + 1] = z1; }
        __syncthreads();
        { const int i = tid >> 4, j0 = (tid & 15) * 2; float t0 = 0.f, t1 = 0.f;
#pragma unroll 8
          for (int q = 0; q < 32; ++q) { const float tb = TF[(32 + i) * 72 + 32 + q]; t0 -= tb * TF[q * 72 + 32 + j0]; t1 -= tb * TF[q * 72 + 32 + j0 + 1]; }
          TF[(32 + i) * 72 + j0] = t0; TF[(32 + i) * 72 + j0 + 1] = t1; }
        __syncthreads();
        { const int t = tid >> 3, c0 = (tid & 7) * 8; const f32x4 x0 = *(const LAS f32x4*)(TF + t * 72 + c0), x1 = *(const LAS f32x4*)(TF + t * 72 + c0 + 4);
          u32x4 w; w.x = cvt_pk_bf16(x0[0], x0[1]); w.y = cvt_pk_bf16(x0[2], x0[3]); w.z = cvt_pk_bf16(x1[0], x1[1]); w.w = cvt_pk_bf16(x1[2], x1[3]);
          *(LAS u32x4*)(lds + RC_TB + (t * RC_LD + c0) * 2) = w; }
        __syncthreads();
        { const int which = wave >> 2, mt = (wave >> 1) & 1, nt2 = wave & 1; const int Bm = which ? RC_AVT : RC_QKT, Dm = which ? RC_U1T : RC_W1T; f32x16 acc;
#pragma unroll
          for (int r = 0; r < 16; ++r) acc[r] = 0.f;
#pragma unroll
          for (int ks = 0; ks < 4; ++ks) if (ks < 2 || mt == 1) acc = MFMA32(lds_frag(lds, RC_TB, 32 * mt + r31, 16 * ks + 8 * hh), lds_frag(lds, Bm, 32 * nt2 + r31, 16 * ks + 8 * hh), acc);
#pragma unroll
          for (int g4 = 0; g4 < 4; ++g4) *(LAS u32x2*)(lds + Dm + ((32 * nt2 + r31) * RC_LD + 32 * mt + 8 * g4 + 4 * hh) * 2) = pack4(acc[4 * g4], acc[4 * g4 + 1], acc[4 * g4 + 2], acc[4 * g4 + 3]); }
        __syncthreads();
        { const int kind = wave >> 2, mt = (wave >> 1) & 1, nt2 = wave & 1; const int cidx = 32 * nt2 + r31;
          f32x16 acc;
#pragma unroll
          for (int r = 0; r < 16; ++r) acc[r] = 0.f;
          if (kind == 0) {
#pragma unroll
              for (int ks = 0; ks < 4; ++ks) acc = MFMA32(lds_frag(lds, RC_W1T, 32 * mt + r31, 16 * ks + 8 * hh), lds_frag(lds, RC_BHT, cidx, 16 * ks + 8 * hh), acc);
#pragma unroll
              for (int g4 = 0; g4 < 4; ++g4) { const int jo = 8 * g4 + 4 * hh, half = jo >> 4, q2 = (jo & 15) >> 2; const int blk = (cidx >> 4) * 2 + mt, lane2 = (cidx & 15) + 16 * q2;
                  *(u32x2*)(rwi + RWI_GF + (blk * 64 + lane2) * 16 + half * 8) = pack4(-acc[4 * g4], -acc[4 * g4 + 1], -acc[4 * g4 + 2], -acc[4 * g4 + 3]); }
          } else {
#pragma unroll
              for (int ks = 0; ks < 4; ++ks) if (ks < 2 || nt2 == 1) acc = MFMA32(lds_frag(lds, RC_W1T, 32 * mt + r31, 16 * ks + 8 * hh), lds_frag(lds, RC_ARB, cidx, 16 * ks + 8 * hh), acc);
#pragma unroll
              for (int g4 = 0; g4 < 4; ++g4) { const int jo = 8 * g4 + 4 * hh, half = jo >> 4, q2 = (jo & 15) >> 2; const int blk = (cidx >> 4) * 2 + mt, lane2 = (cidx & 15) + 16 * q2;
                  const u32x2 rt = *(const LAS u32x2*)(lds + RC_RT + (cidx * RC_LD + 32 * mt + jo) * 2);
                  *(u32x2*)(rwi + RWI_W2F + (blk * 64 + lane2) * 16 + half * 8) = pack4(bf_lo(rt.x) - acc[4 * g4], bf_hi(rt.x) - acc[4 * g4 + 1], bf_lo(rt.y) - acc[4 * g4 + 2], bf_hi(rt.y) - acc[4 * g4 + 3]); }
          }
          f32x16 ac1, ac2;
#pragma unroll
          for (int r = 0; r < 16; ++r) { ac1[r] = 0.f; ac2[r] = 0.f; }
          if (kind == 0) {
#pragma unroll
              for (int ks = 0; ks < 4; ++ks) { ac1 = MFMA32(lds_frag(lds, RC_KHT, 32 * mt + r31, 16 * ks + 8 * hh), lds_frag(lds, RC_VT, cidx, 16 * ks + 8 * hh), ac1);
                                               ac2 = MFMA32(lds_frag(lds, RC_BHT, 32 * mt + r31, 16 * ks + 8 * hh), lds_frag(lds, RC_U1T, cidx, 16 * ks + 8 * hh), ac2); }
#pragma unroll
              for (int g4 = 0; g4 < 4; ++g4) { const int ro = 32 * mt + 8 * g4 + 4 * hh, mt2 = ro >> 4, q2 = (ro & 15) >> 2, cb = cidx >> 4, lane2 = (cidx & 15) + 16 * q2;
                  *(f32x4*)(rwi + RWI_H1F + ((cb * 4 + mt2) * 64 + lane2) * 16) = (f32x4){ac1[4 * g4] - ac2[4 * g4], ac1[4 * g4 + 1] - ac2[4 * g4 + 1], ac1[4 * g4 + 2] - ac2[4 * g4 + 2], ac1[4 * g4 + 3] - ac2[4 * g4 + 3]}; }
          } else {
#pragma unroll
              for (int ks = 0; ks < 4; ++ks) if (ks < 2 || nt2 == 1) { ac1 = MFMA32(lds_frag(lds, RC_VT, 32 * mt + r31, 16 * ks + 8 * hh), lds_frag(lds, RC_ARK, cidx, 16 * ks + 8 * hh), ac1);
                                                                        ac2 = MFMA32(lds_frag(lds, RC_U1T, 32 * mt + r31, 16 * ks + 8 * hh), lds_frag(lds, RC_ARB, cidx, 16 * ks + 8 * hh), ac2); }
#pragma unroll
              for (int g4 = 0; g4 < 4; ++g4) { const int ro = 32 * mt + 8 * g4 + 4 * hh, cb = ro >> 4, q2 = (ro & 15) >> 2, nt3 = cidx >> 4, lane2 = (cidx & 15) + 16 * q2;
                  *(f32x4*)(rwi + RWI_O1F + ((cb * 4 + nt3) * 64 + lane2) * 16) = (f32x4){ac1[4 * g4] - ac2[4 * g4], ac1[4 * g4 + 1] - ac2[4 * g4 + 1], ac1[4 * g4 + 2] - ac2[4 * g4 + 2], ac1[4 * g4 + 3] - ac2[4 * g4 + 3]}; }
          } }
        __syncthreads();
    }
}

__device__ __forceinline__ void p3_rwkv_seq(const Args& a, int unit, int lane) {
    const int bh = unit >> 2, cb = unit & 3, l15 = lane & 15, q = lane >> 4;
    f32x4 hacc[4];
#pragma unroll
    for (int m = 0; m < 4; ++m) hacc[m] = (f32x4){0.f, 0.f, 0.f, 0.f};
    const unsigned char* base = a.ws + WS_RWI + (size_t)(bh * 32) * RWI_BYTES;
    unsigned char* hbo = a.ws + WS_HB + (size_t)unit * 32 * 2048;
    bf16x8 gfA[8], gfB[8]; f32x4 h1A[4], h1B[4], lamA[4], lamB[4];
#define RW2_LOADG(gf, h1, lam, src) do { _Pragma("unroll") for (int k2 = 0; k2 < 8; ++k2) gf[k2] = *(const bf16x8*)((src) + RWI_GF + (k2 * 64 + lane) * 16); \
        _Pragma("unroll") for (int m = 0; m < 4; ++m) { h1[m] = *(const f32x4*)((src) + RWI_H1F + ((cb * 4 + m) * 64 + lane) * 16); lam[m] = *(const f32x4*)((src) + RWI_LAM + (16 * m + 4 * q) * 4); } } while (0)
#define RW2_STEP(c_, gf, h1, lam) do { const int c = (c_); \
        bf16x8 hb[2]; \
        _Pragma("unroll") for (int ks = 0; ks < 2; ++ks) { u32x4 t; t.x = cvt_pk_bf16(hacc[2 * ks][0], hacc[2 * ks][1]); t.y = cvt_pk_bf16(hacc[2 * ks][2], hacc[2 * ks][3]); \
            t.z = cvt_pk_bf16(hacc[2 * ks + 1][0], hacc[2 * ks + 1][1]); t.w = cvt_pk_bf16(hacc[2 * ks + 1][2], hacc[2 * ks + 1][3]); hb[ks] = __builtin_bit_cast(bf16x8, t); \
            *(bf16x8*)(hbo + (size_t)c * 2048 + (ks * 64 + lane) * 16) = hb[ks]; } \
        _Pragma("unroll") for (int m = 0; m < 4; ++m) { f32x4 nacc = h1[m] + lam[m] * hacc[m]; \
            _Pragma("unroll") for (int ks = 0; ks < 2; ++ks) nacc = MFMA16(gf[m * 2 + ks], hb[ks], nacc); hacc[m] = nacc; } \
        if (c + 2 < 32) RW2_LOADG(gf, h1, lam, base + (size_t)(c + 2) * RWI_BYTES); } while (0)
    RW2_LOADG(gfA, h1A, lamA, base); RW2_LOADG(gfB, h1B, lamB, base + RWI_BYTES);
#pragma unroll 1
    for (int c2 = 0; c2 < 32; c2 += 2) { RW2_STEP(c2, gfA, h1A, lamA); RW2_STEP(c2 + 1, gfB, h1B, lamB); }
#undef RW2_STEP
#undef RW2_LOADG
#pragma unroll
    for (int m = 0; m < 4; ++m) *(f32x4*)(a.out + OUT_WKV_P + (((size_t)bh * 64 + 16 * cb + l15) * 64 + 16 * m + 4 * q)) = hacc[m];
}
__device__ __forceinline__ void p5_rwkv_out(const Args& a, int item, int lane) {
    const int bh = item >> 5, c = item & 31, b = bh >> 4, h = bh & 15, l15 = lane & 15, q = lane >> 4;
    const unsigned char* cur = a.ws + WS_RWI + (size_t)item * RWI_BYTES;
    const bf16_t* BV = (const bf16_t*)((const unsigned char*)a.out + DO_BV);
    const bf16_t* P = (const bf16_t*)(a.ws + WS_P); bf16_t* A2 = (bf16_t*)(a.ws + WS_XN);
    bf16x8 hb[4][2], w2f[8];
#pragma unroll
    for (int cb = 0; cb < 4; ++cb)
#pragma unroll
        for (int ks = 0; ks < 2; ++ks) hb[cb][ks] = *(const bf16x8*)(a.ws + WS_HB + ((size_t)(bh * 4 + cb) * 32 + c) * 2048 + (ks * 64 + lane) * 16);
#pragma unroll
    for (int k2 = 0; k2 < 8; ++k2) w2f[k2] = *(const bf16x8*)(cur + RWI_W2F + (k2 * 64 + lane) * 16);
    f32x4 gw[4], gb[4];
#pragma unroll
    for (int cb = 0; cb < 4; ++cb) { gw[cb] = *(const f32x4*)(a.in[I_GNW] + h * 64 + 16 * cb + 4 * q); gb[cb] = *(const f32x4*)(a.in[I_GNB] + h * 64 + 16 * cb + 4 * q); }
#pragma unroll
    for (int n = 0; n < 4; ++n) {
        const size_t row = (size_t)b * SEQ + c * 64 + 16 * n + l15;
        f32x4 o[4]; u32x2 bvw[4], zw[4];
#pragma unroll
        for (int cb = 0; cb < 4; ++cb) { o[cb] = *(const f32x4*)(cur + RWI_O1F + ((cb * 4 + n) * 64 + lane) * 16);
            bvw[cb] = *(const u32x2*)(BV + row * 1024 + h * 64 + 16 * cb + 4 * q); zw[cb] = *(const u32x2*)(P + row * LDP + PC_ZR + h * 64 + 16 * cb + 4 * q); }
#pragma unroll
        for (int cb = 0; cb < 4; ++cb)
#pragma unroll
            for (int ks = 0; ks < 2; ++ks) o[cb] = MFMA16(hb[cb][ks], w2f[n * 2 + ks], o[cb]);
        float sm = 0.f;
#pragma unroll
        for (int cb = 0; cb < 4; ++cb) sm += (o[cb][0] + o[cb][1]) + (o[cb][2] + o[cb][3]);
        sm += __shfl_xor(sm, 16); sm += __shfl_xor(sm, 32);
        const float mean = sm * (1.0f / 64.0f); float sq = 0.f;
#pragma unroll
        for (int cb = 0; cb < 4; ++cb) { o[cb] = o[cb] - mean; sq += (o[cb][0] * o[cb][0] + o[cb][1] * o[cb][1]) + (o[cb][2] * o[cb][2] + o[cb][3] * o[cb][3]); }
        sq += __shfl_xor(sq, 16); sq += __shfl_xor(sq, 32);
        const float rstd = rsqrtf(sq * (1.0f / 64.0f) + GN_EPS);
#pragma unroll
        for (int cb = 0; cb < 4; ++cb) {
            const float r0 = (o[cb][0] * rstd * gw[cb][0] + gb[cb][0] + bf_lo(bvw[cb].x)) * bf_lo(zw[cb].x), r1 = (o[cb][1] * rstd * gw[cb][1] + gb[cb][1] + bf_hi(bvw[cb].x)) * bf_hi(zw[cb].x);
            const float r2 = (o[cb][2] * rstd * gw[cb][2] + gb[cb][2] + bf_lo(bvw[cb].y)) * bf_lo(zw[cb].y), r3 = (o[cb][3] * rstd * gw[cb][3] + gb[cb][3] + bf_hi(bvw[cb].y)) * bf_hi(zw[cb].y);
            *(u32x2*)(A2 + row * 2048 + 1024 + h * 64 + 16 * cb + 4 * q) = pack4(r0, r1, r2, r3); }
    }
}

__device__ __forceinline__ void p3_rwkv_sample(const Args& a, LAS unsigned char* lds, int bs, int h, int wave, int lane) {
    LAS float* Lw = (LAS float*)lds + wave * 768;
    const bf16_t* P = (const bf16_t*)(a.ws + WS_P);
    const bf16_t* pc = P + (size_t)(MP + bs) * LDP; const bf16_t* pp = P + (size_t)(MV + bs) * LDP;
    bf16_t* A2 = (bf16_t*)(a.ws + WS_XN);
    const float* mu = a.in[I_MU];
    const int hj = h * 64 + lane, rg = lane >> 4, cq = lane & 15;
    const size_t sbase = ((size_t)(bs * 16 + h) * 64) * 64;
    const float* S0 = a.in[I_WKV] + sbase; float* S1 = a.out + OUT_WKV_S + sbase;
    f32x4 S[16];
#pragma unroll
    for (int it = 0; it < 16; ++it) S[it] = *(const f32x4*)(S0 + (size_t)(4 * it + rg) * 64 + 4 * cq);
    { float wd = bf2f(pc[PC_WD + lane]), ad = bf2f(pc[PC_AD + lane]); wd += (bf2f(pp[PC_WD + lane]) - wd) * mu[3072 + lane]; ad += (bf2f(pp[PC_AD + lane]) - ad) * mu[3136 + lane];
      Lw[lane] = tanhf_(wd); Lw[64 + lane] = ad; }
    LDS_WAIT();
    float lw = 0.f, la = 0.f;
#pragma unroll 16
    for (int m = 0; m < 64; ++m) { lw += Lw[m] * a.in[I_W2][(size_t)m * 1024 + hj]; la += Lw[64 + m] * a.in[I_A2][(size_t)m * 1024 + hj]; }
    float r = bf2f(pc[PC_R + hj]), k = bf2f(pc[PC_K + hj]), v = bf2f(pc[PC_V + hj]);
    r += (bf2f(pp[PC_R + hj]) - r) * mu[hj]; k += (bf2f(pp[PC_K + hj]) - k) * mu[1024 + hj]; v += (bf2f(pp[PC_V + hj]) - v) * mu[2048 + hj];
    const RwTok o = rw_token(a, hj, r, k, v, lw, la);
    Lw[128 + lane] = o.kk; Lw[192 + lane] = o.dr; Lw[256 + lane] = o.dd; Lw[320 + lane] = o.bb; Lw[384 + lane] = o.kp; Lw[448 + lane] = o.v;
    LDS_WAIT();
    const f32x4 kk4 = *(const LAS f32x4*)(Lw + 128 + 4 * cq), dr4 = *(const LAS f32x4*)(Lw + 192 + 4 * cq), d4 = *(const LAS f32x4*)(Lw + 256 + 4 * cq), b4 = *(const LAS f32x4*)(Lw + 320 + 4 * cq), k4 = *(const LAS f32x4*)(Lw + 384 + 4 * cq);
#pragma unroll
    for (int it = 0; it < 16; ++it) { const int i = 4 * it + rg; const float vi = Lw[448 + i];
        float p1 = (S[it][0] * kk4[0] + S[it][1] * kk4[1]) + (S[it][2] * kk4[2] + S[it][3] * kk4[3]);
        float p2 = (S[it][0] * dr4[0] + S[it][1] * dr4[1]) + (S[it][2] * dr4[2] + S[it][3] * dr4[3]);
        p1 = row16_sum(p1); p2 = row16_sum(p2);
        const float sa = -p1, ov = p2 + sa * o.br + vi * o.kr;
        f32x4 Sn;
#pragma unroll
        for (int j = 0; j < 4; ++j) Sn[j] = S[it][j] * d4[j] + sa * b4[j] + vi * k4[j];
        *(f32x4*)(S1 + (size_t)i * 64 + 4 * cq) = Sn;
        if (cq == 0) Lw[512 + i] = ov; }
    LDS_WAIT();
    const float ov = Lw[512 + lane];
    const float mean = wave_sum_dpp(ov) * (1.0f / 64.0f); const float dv = ov - mean; const float var = wave_sum_dpp(dv * dv) * (1.0f / 64.0f);
    float on = dv * rsqrtf(var + GN_EPS) * a.in[I_GNW][hj] + a.in[I_GNB][hj] + o.bonus * o.v;
    on *= bf2f(pc[PC_ZR + hj]);
    A2[(size_t)(MP + bs) * 2048 + 1024 + hj] = f2bf(on);
    LDS_WAIT();
}

constexpr int S5_ELD = 132, S5_XLD = 136;
constexpr int S5_E_OFF = 0, S5_X_OFF = 128 * S5_ELD * 4;
__device__ __forceinline__ bf16x8 ldfrag(const unsigned char* base, int block, int lane) { return *(const bf16x8*)(base + (size_t)block * 1024 + lane * 16); }
__device__ __forceinline__ void p3_s5_prompt(const Args& a, LAS unsigned char* lds, int unit, int tid, int wave, int lane) {
    const int b = unit >> 6, g = unit & 63;
    const unsigned char* tab = (const unsigned char*)a.out + DO_S5TAB + (size_t)g * S5T_BYTES;
    const bf16_t* P = (const bf16_t*)(a.ws + WS_P);
    bf16_t* Yg = (bf16_t*)(a.ws + WS_YG);
    LAS float* EL = (LAS float*)(lds + S5_E_OFF); LAS bf16_t* XL = (LAS bf16_t*)(lds + S5_X_OFF);
    const int nt = wave & 3, hm = wave >> 2, r31 = lane & 31, hh = lane >> 5;
    const int n = 32 * nt + r31;
    { u32x4 tv[10];
#pragma unroll
      for (int i = 0; i < 10; ++i) tv[i] = *(const u32x4*)(tab + S5T_ME + (size_t)(tid + 512 * i) * 16);
#pragma unroll
      for (int i = 0; i < 10; ++i) *(LAS u32x4*)(lds + (tid + 512 * i) * 16) = tv[i]; }
    const bf16_t* ubase = (const bf16_t*)(a.ws + WS_U2) + (((size_t)b * 64 + g) * SEQ + 16 * n) * 16 + 8 * hh;
    bf16x8 bu[16];
#pragma unroll
    for (int s2 = 0; s2 < 16; ++s2) bu[s2] = *(const bf16x8*)(ubase + (size_t)s2 * 16);
    f32x16 accY[4], accE[2];
#pragma unroll
    for (int q = 0; q < 4; ++q)
#pragma unroll
        for (int r = 0; r < 16; ++r) accY[q][r] = 0.f;
#pragma unroll
    for (int q = 0; q < 2; ++q)
#pragma unroll
        for (int r = 0; r < 16; ++r) accE[q][r] = 0.f;
    const int mts[4] = {hm ? 1 : 0, hm ? 2 : 3, hm ? 5 : 4, hm ? 6 : 7};
    __syncthreads();
#pragma unroll
    for (int s2 = 0; s2 < 16; ++s2) {
#pragma unroll
        for (int e = 0; e < 2; ++e) accE[e] = __builtin_amdgcn_mfma_f32_32x32x16_bf16(*(const LAS bf16x8*)(lds + S5T_ME + (((2 * hm + e) * 16 + s2) * 64 + lane) * 16), bu[s2], accE[e], 0, 0, 0);
#pragma unroll
        for (int q = 0; q < 4; ++q) { const int mt = mts[q]; if (s2 <= 2 * mt + 1) accY[q] = __builtin_amdgcn_mfma_f32_32x32x16_bf16(*(const LAS bf16x8*)(lds + S5T_KT + ((2 * mt - s2 + 1) * 64 + lane) * 16), bu[s2], accY[q], 0, 0, 0); }
    }
    __syncthreads();
#pragma unroll
    for (int e = 0; e < 2; ++e)
#pragma unroll
        for (int q4 = 0; q4 < 4; ++q4) { f32x4 v; v[0] = accE[e][4 * q4]; v[1] = accE[e][4 * q4 + 1]; v[2] = accE[e][4 * q4 + 2]; v[3] = accE[e][4 * q4 + 3];
            *(LAS f32x4*)(EL + n * S5_ELD + 32 * (2 * hm + e) + 8 * q4 + 4 * hh) = v; }
    __syncthreads();
    if (wave == 0) { const float* hdr = (const float*)(tab + S5T_HDR); const float ar = hdr[lane], ai = hdr[64 + lane]; float xr = 0.f, xi = 0.f;
#pragma unroll 1
        for (int c0 = 0; c0 < 128; c0 += 16) { float er[16], ei[16];
#pragma unroll
            for (int j = 0; j < 16; ++j) { er[j] = EL[(c0 + j) * S5_ELD + lane]; ei[j] = EL[(c0 + j) * S5_ELD + 64 + lane]; }
#pragma unroll
            for (int j = 0; j < 16; ++j) { XL[(c0 + j) * S5_XLD + lane] = f2bf(xr); XL[(c0 + j) * S5_XLD + 64 + lane] = f2bf(xi);
                const float nr = ar * xr - ai * xi + er[j], ni = ar * xi + ai * xr + ei[j]; xr = nr; xi = ni; } }
        a.out[OUT_S5RE_P + (size_t)(b * 64 + g) * 64 + lane] = xr; a.out[OUT_S5IM_P + (size_t)(b * 64 + g) * 64 + lane] = xi; }
    __syncthreads();
#pragma unroll
    for (int ks = 0; ks < 8; ++ks) { const bf16x8 bx = *(const LAS bf16x8*)(XL + n * S5_XLD + 16 * ks + 8 * hh);
#pragma unroll
        for (int q = 0; q < 4; ++q) accY[q] = __builtin_amdgcn_mfma_f32_32x32x16_bf16(ldfrag(tab + S5T_CA, mts[q] * 8 + ks, lane), bx, accY[q], 0, 0, 0); }
#pragma unroll
    for (int q = 0; q < 4; ++q) { const int mt = mts[q];
#pragma unroll
        for (int q4 = 0; q4 < 4; ++q4) { const int dt = q4 >> 1, c0 = 8 * (q4 & 1) + 4 * hh; const size_t row = (size_t)b * SEQ + 16 * n + 2 * mt + dt;
            u32x2 w; w.x = cvt_pk_bf16(geluf_(accY[q][4 * q4]), geluf_(accY[q][4 * q4 + 1])); w.y = cvt_pk_bf16(geluf_(accY[q][4 * q4 + 2]), geluf_(accY[q][4 * q4 + 3]));
            *(u32x2*)(Yg + row * 1024 + g * 16 + c0) = w; } }
    __syncthreads();
}
__device__ __forceinline__ void p3_s5_sample(const Args& a, int g, int wave, int lane) {
    if (wave >= 4) return;
    const unsigned char* tab = (const unsigned char*)a.out + DO_S5TAB + (size_t)g * S5T_BYTES;
    const float* hdr = (const float*)(tab + S5T_HDR);
    const bf16_t* P = (const bf16_t*)(a.ws + WS_P);
    bf16_t* Yg = (bf16_t*)(a.ws + WS_YG);
    const int r31 = lane & 31, hh = lane >> 5, bs = 32 * wave + r31;
    const bf16x8 bu = *(const bf16x8*)((const bf16_t*)(a.ws + WS_U2S) + ((size_t)g * NSMP + bs) * 16 + 8 * hh);
    f32x16 z;
#pragma unroll
    for (int r = 0; r < 16; ++r) z[r] = 0.f;
    f32x16 x[4];
#pragma unroll
    for (int mtile = 0; mtile < 4; ++mtile) x[mtile] = __builtin_amdgcn_mfma_f32_32x32x16_bf16(ldfrag(tab + S5T_ME, mtile * 16 + 15, lane), bu, z, 0, 0, 0);
    const size_t sb = (size_t)(bs * 64 + g) * 64;
#pragma unroll
    for (int pt = 0; pt < 2; ++pt)
#pragma unroll
        for (int q4 = 0; q4 < 4; ++q4) { const int p0 = 32 * pt + 8 * q4 + 4 * hh;
            const f32x4 x0r = *(const f32x4*)(a.in[I_S5RE] + sb + p0), x0i = *(const f32x4*)(a.in[I_S5IM] + sb + p0);
            const f32x4 ar = *(const f32x4*)(hdr + 128 + p0), ai = *(const f32x4*)(hdr + 192 + p0);
            f32x4 nr, ni;
#pragma unroll
            for (int j = 0; j < 4; ++j) { nr[j] = ar[j] * x0r[j] - ai[j] * x0i[j] + x[pt][4 * q4 + j]; ni[j] = ar[j] * x0i[j] + ai[j] * x0r[j] + x[2 + pt][4 * q4 + j]; x[pt][4 * q4 + j] = nr[j]; x[2 + pt][4 * q4 + j] = ni[j]; }
            *(f32x4*)(a.out + OUT_S5RE_S + sb + p0) = nr; *(f32x4*)(a.out + OUT_S5IM_S + sb + p0) = ni; }
    f32x16 y = __builtin_amdgcn_mfma_f32_32x32x16_bf16(ldfrag(tab + S5T_DF, 0, lane), bu, z, 0, 0, 0);
#pragma unroll
    for (int mtile = 0; mtile < 4; ++mtile)
#pragma unroll
        for (int sp = 0; sp < 2; ++sp) { u32x4 t; t.x = cvt_pk_bf16(x[mtile][8 * sp], x[mtile][8 * sp + 1]); t.y = cvt_pk_bf16(x[mtile][8 * sp + 2], x[mtile][8 * sp + 3]);
            t.z = cvt_pk_bf16(x[mtile][8 * sp + 4], x[mtile][8 * sp + 5]); t.w = cvt_pk_bf16(x[mtile][8 * sp + 6], x[mtile][8 * sp + 7]);
            y = __builtin_amdgcn_mfma_f32_32x32x16_bf16(ldfrag(tab + S5T_C0, mtile * 2 + sp, lane), __builtin_bit_cast(bf16x8, t), y, 0, 0, 0); }
#pragma unroll
    for (int q4 = 0; q4 < 2; ++q4) { const int c0 = 8 * q4 + 4 * hh;
        u32x2 w; w.x = cvt_pk_bf16(geluf_(y[4 * q4]), geluf_(y[4 * q4 + 1])); w.y = cvt_pk_bf16(geluf_(y[4 * q4 + 2]), geluf_(y[4 * q4 + 3]));
        *(u32x2*)(Yg + (size_t)(MP + bs) * 1024 + g * 16 + c0) = w; }
}

__device__ __forceinline__ void p4_rwkv_post8(const Args& a, int item0, int lane) {
    const int item = item0 + (lane >> 3), cg = lane & 7, row = item >> 4, h = item & 15, ch = h * 64 + 8 * cg;
    const bf16_t* ORAW = (const bf16_t*)((const unsigned char*)a.out + DO_ORAW); const bf16_t* BV = (const bf16_t*)((const unsigned char*)a.out + DO_BV);
    const bf16_t* P = (const bf16_t*)(a.ws + WS_P); bf16_t* A2 = (bf16_t*)(a.ws + WS_XN);
    const u32x4 ow = *(const u32x4*)(ORAW + (size_t)row * 1024 + ch), bw = *(const u32x4*)(BV + (size_t)row * 1024 + ch), zw = *(const u32x4*)(P + (size_t)row * LDP + PC_ZR + ch);
    const f32x4 w0 = *(const f32x4*)(a.in[I_GNW] + ch), w1 = *(const f32x4*)(a.in[I_GNW] + ch + 4), b0 = *(const f32x4*)(a.in[I_GNB] + ch), b1 = *(const f32x4*)(a.in[I_GNB] + ch + 4);
    const float o[8] = {bf_lo(ow.x), bf_hi(ow.x), bf_lo(ow.y), bf_hi(ow.y), bf_lo(ow.z), bf_hi(ow.z), bf_lo(ow.w), bf_hi(ow.w)};
    const float bv[8] = {bf_lo(bw.x), bf_hi(bw.x), bf_lo(bw.y), bf_hi(bw.y), bf_lo(bw.z), bf_hi(bw.z), bf_lo(bw.w), bf_hi(bw.w)};
    const float z[8] = {bf_lo(zw.x), bf_hi(zw.x), bf_lo(zw.y), bf_hi(zw.y), bf_lo(zw.z), bf_hi(zw.z), bf_lo(zw.w), bf_hi(zw.w)};
    const float gw[8] = {w0[0], w0[1], w0[2], w0[3], w1[0], w1[1], w1[2], w1[3]}, gb[8] = {b0[0], b0[1], b0[2], b0[3], b1[0], b1[1], b1[2], b1[3]};
    float sm = ((o[0] + o[1]) + (o[2] + o[3])) + ((o[4] + o[5]) + (o[6] + o[7]));
    sm += dpp_f<0xB1>(sm); sm += dpp_f<0x4E>(sm); sm += dpp_f<0x141>(sm);
    const float mean = sm * (1.0f / 64.0f); float d[8], sq = 0.f;
#pragma unroll
    for (int j = 0; j < 8; ++j) { d[j] = o[j] - mean; sq += d[j] * d[j]; }
    sq += dpp_f<0xB1>(sq); sq += dpp_f<0x4E>(sq); sq += dpp_f<0x141>(sq);
    const float rstd = rsqrtf(sq * (1.0f / 64.0f) + GN_EPS); float r[8];
#pragma unroll
    for (int j = 0; j < 8; ++j) r[j] = (d[j] * rstd * gw[j] + gb[j] + bv[j]) * z[j];
    u32x4 w; w.x = cvt_pk_bf16(r[0], r[1]); w.y = cvt_pk_bf16(r[2], r[3]); w.z = cvt_pk_bf16(r[4], r[5]); w.w = cvt_pk_bf16(r[6], r[7]);
    *(u32x4*)(A2 + (size_t)row * 2048 + 1024 + ch) = w;
}

__device__ __forceinline__ void p6_row(const Args& a, int m, int lane) {
    float* y = a.out + (size_t)m * DM; const float* fg = a.in[I_FINALG];
    if (m < MP) {
        const float* rs = (const float*)(a.ws + WS_ROWSS) + (size_t)m * 32;
        const float ss = wave_sum(rs[lane & 31]) * 0.5f;
        const float rstd = rsqrtf(ss * (1.0f / DM) + RMS_EPS);
#pragma unroll
        for (int j = 0; j < 8; ++j) { const int k = 4 * lane + 256 * j; f32x4 v = *(const f32x4*)(y + k); const f32x4 gv = *(const f32x4*)(fg + k);
#pragma unroll
            for (int q = 0; q < 4; ++q) v[q] = v[q] * rstd * gv[q];
            *(f32x4*)(y + k) = v; }
    } else {
        const int r = m - MP; const float* slab = (const float*)(a.ws + WS_SLAB) + (size_t)r * DM; const float* x = a.in[I_XS] + (size_t)r * DM;
        const float* gtrow = (const float*)(a.ws + WS_MOD) + (size_t)(NB + r) * NMOD + 2 * DM;
        f32x4 v[8]; float ss = 0.f;
#pragma unroll
        for (int j = 0; j < 8; ++j) { const int k = 4 * lane + 256 * j; f32x4 mix = *(const f32x4*)(slab + k);
#pragma unroll
            for (int s2 = 1; s2 < 8; ++s2) mix += *(const f32x4*)(slab + (size_t)s2 * NSMP * DM + k);
            const f32x4 xv = *(const f32x4*)(x + k), gt = *(const f32x4*)(gtrow + k);
#pragma unroll
            for (int q = 0; q < 4; ++q) { v[j][q] = xv[q] + gt[q] * mix[q]; ss += v[j][q] * v[j][q]; } }
        const float rstd = rsqrtf(wave_sum(ss) * (1.0f / DM) + RMS_EPS);
#pragma unroll
        for (int j = 0; j < 8; ++j) { const int k = 4 * lane + 256 * j; const f32x4 gv = *(const f32x4*)(fg + k); f32x4 o;
#pragma unroll
            for (int q = 0; q < 4; ++q) o[q] = v[j][q] * rstd * gv[q];
            *(f32x4*)(y + k) = o; }
    }
}

__global__ void __launch_bounds__(512, 2) fwd_kernel(Args args) {
    extern __shared__ __attribute__((aligned(16))) unsigned char lds_raw[];
    LAS unsigned char* lds = (LAS unsigned char*)lds_raw;
    const int tid = threadIdx.x, lane = tid & 63, wave = __builtin_amdgcn_readfirstlane(tid >> 6);
    const int G = gridDim.x, bx = blockIdx.x;
    const int vcu = (G % 8 == 0) ? (bx % 8) * (G / 8) + bx / 8 : bx;
    volatile LAS unsigned* MISC = (volatile LAS unsigned*)(lds + MISC_OFF);
    for (int u = tid; u < (LDS_BYTES - LDSCTL_OFF) / 4; u += 512) ((LAS unsigned*)(lds + LDSCTL_OFF))[u] = 0u;
    __syncthreads();
    unsigned* ctl = (unsigned*)(args.ws + WS_CTL);
    XcdBarrier bar; bar.bar = ctl + CW_BAR + args.li * XCD_BAR_WORDS; bar.x = 0; bar.st = nullptr;
    const bool multi = (args.ph_hi - args.ph_lo) > 1;
    if (multi) bar = xcd_barrier_post(ctl + CW_BAR + args.li * XCD_BAR_WORDS, MISC + 8);
    const int lo = args.ph_lo, hi = args.ph_hi;
#define IN(k) (lo <= (k) && (k) < hi)
#define SEAM(k) do { if (IN(k) && IN((k) + 1)) xcd_barrier(bar); } while (0)
    const int gw = vcu * 8 + wave, NGW = G * 8;

    if (IN(0)) {
        if (vcu < 192) p0_mod(args, lds, vcu, wave, lane);
        else if (vcu - 192 < 64) { p0_s5_tables(args, lds, vcu - 192, tid);
            LAS float* scr = (LAS float*)(lds + wave * 16384);
            for (int it = (vcu - 192) * 8 + wave; it < 2048 + 512; it += 64 * 8) {
                if (it < 2048) { const int nb = it >> 5, kb = it & 31; transpose_item(args.in[I_WOUT], 2048, 2048, 32 * nb, (bf16_t*)(args.ws + WS_WOUT_T), 32 * nb, 64 * kb, scr, lane, false); }
                else { const int i2 = it - 2048, nb = i2 >> 4, kb = i2 & 15; transpose_item(args.in[I_WGLU], 1024, 1024, 32 * nb, (bf16_t*)(args.ws + WS_WGLU_T), 32 * nb, 64 * kb, scr, lane, false); } } }
    }
    SEAM(0);
    if (IN(1)) {
        { LAS float* scr = (LAS float*)(lds + wave * 16384);
          bf16_t* WT = (bf16_t*)(args.ws + WS_WT);
          for (int it = gw; it < 328 * 32; it += NGW) { const int nb = it >> 5, kb = it & 31; const int p0 = 32 * nb;
              const int src = (p0 < 5120) ? p0 : ((p0 < 10240) ? p0 + 128 : p0 - 5120);
              transpose_item(args.in[I_WIN], NIN, 2048, src, WT, p0, 64 * kb, scr, lane, p0 >= NIN); } }
        for (int m = gw; m < MT; m += NGW) p1_row(args, m, lane);
    }
    SEAM(1);
    const bool tail_mode = (G == 256);
    if (IN(2)) {
        pg8::Gemm g{(const bf16_t*)(args.ws + WS_XN), (const bf16_t*)(args.ws + WS_WT), 2048, 2048};
        EpiP E{(bf16_t*)(args.ws + WS_P), tail_mode, (bf16_t*)(args.ws + WS_U2)};
        if (tail_mode) {
            pg8::TailOrder S; S.init2(G, bx, ctl + CW_TILE);
            pg8::gemm_phase<EpiP, pg8::TailOrder, GEMM_ALIGN, GEMM_SP2>(lds, g, S, E);
            if (bx >= 73) {
                const int t = bx - 73;
                for (int u = t; u < 256; u += 183) { wait_count(ctl + CW_TILE + 64 * ((u >> 6) * 4 + ((u & 63) >> 4)), 64u, wave); p3_s5_prompt(args, lds, u, tid, wave, lane); }
                if (t >= 146 && t < 178) { const int pm2 = t - 146;
                    wait_count(ctl + CW_TILE + 64 * (57 + pm2), 8u, wave); if (pm2 & 7) wait_count(ctl + CW_TILE + 64 * (57 + pm2 - 1), 8u, wave);
                    p2_xw_panel(args, pm2, tid); }
                if (t >= 73 && t < 137) { const int g2 = t - 73; wait_count(ctl + CW_TILE + 64 * (16 + (g2 >> 4)), 8u, wave); p3_s5_sample(args, g2, wave, lane); }
            }
        } else {
            pg8::StaticOrder S; S.init(MT, LDP, 2048, G, bx);
            pg8::gemm_phase<EpiP, pg8::StaticOrder, GEMM_ALIGN, GEMM_SP2>(lds, g, S, E);
        }
    }
    SEAM(2);
    if (IN(3)) {
        p3_rwkv_chunks(args, lds, vcu >> 2, vcu & 3, tid, wave, lane);
        if (!tail_mode) {
            if (false) { LAS float* scr = (LAS float*)(lds + wave * 16384);
              for (int it = gw; it < 2048 + 512; it += NGW) {
                  if (it < 2048) { const int nb = it >> 5, kb = it & 31; transpose_item(args.in[I_WOUT], 2048, 2048, 32 * nb, (bf16_t*)(args.ws + WS_WOUT_T), 32 * nb, 64 * kb, scr, lane, false); }
                  else { const int i2 = it - 2048, nb = i2 >> 4, kb = i2 & 15; transpose_item(args.in[I_WGLU], 1024, 1024, 32 * nb, (bf16_t*)(args.ws + WS_WGLU_T), 32 * nb, 64 * kb, scr, lane, false); } } }
            __syncthreads();
            for (int u = vcu; u < 256; u += G) p3_s5_prompt(args, lds, u, tid, wave, lane);
            for (int g2 = vcu; g2 < 64; g2 += G) p3_s5_sample(args, g2, wave, lane);
            __syncthreads();
        }
        for (int it = vcu; it < 256; it += G) p3_rwkv_sample(args, lds, it >> 1, (it & 1) * 8 + wave, wave, lane);
    }
    SEAM(3);
    if (IN(4)) {
        pg8::StaticOrder S; S.init(MT, 1024, 1024, G, bx);
        pg8::Unit u0;
        if (S.next(0, u0)) {
            pg8::Gemm g{(const bf16_t*)(args.ws + WS_YG), (const bf16_t*)(args.ws + WS_WGLU_T), 1024, 1024};
            EpiGlu E{(const bf16_t*)(args.ws + WS_YG), (const bf16_t*)(args.ws + WS_P), args.in[I_BGLU], (bf16_t*)(args.ws + WS_XN)};
            pg8::gemm_phase<EpiGlu, pg8::StaticOrder, GEMM_ALIGN, GEMM_SP2>(lds, g, S, E);
        } else {
            const int nfree = G - 132, j = bx - 132, unit = wave * nfree + j;
            if (unit < 256) p3_rwkv_seq(args, unit, lane);
        }
    }
    SEAM(4);
    if (IN(5)) { for (int it = gw; it < 2048; it += NGW) p5_rwkv_out(args, it, lane); }
    SEAM(5);
    if (IN(6)) {
        pg8::Gemm g{(const bf16_t*)(args.ws + WS_XN), (const bf16_t*)(args.ws + WS_WOUT_T), 2048, 1024};
        pg8::OutOrder S; S.init(MP, DM, 1024, G, bx);
        EpiOut E{(const bf16_t*)(args.ws + WS_P), args.in[I_XP], (const float*)(args.ws + WS_MOD), args.out, (float*)(args.ws + WS_ROWSS), (bf16_t*)(args.ws + WS_TMP), (float*)(args.ws + WS_SLAB), ctl + CW_PANEL, args.in[I_FINALG]};
        pg8::gemm_phase<EpiOut, pg8::OutOrder, false, GEMM_SP2>(lds, g, S, E);
    }
    SEAM(6);
    if (IN(7)) { for (int m = MP + gw; m < MV; m += NGW) p6_row(args, m, lane); }
#undef IN
#undef SEAM
}

extern "C" void kernel_launch(void* const* d_in, const int* in_sizes, int n_in, void* d_out, int out_size, void* d_ws, size_t ws_size, hipStream_t stream) {
    static int grid = 0;
    if (grid == 0) {
        if (n_in != 34 || ws_size < WS_END) { fprintf(stderr, "kernel_launch: unexpected n_in %d / ws %zu\n", n_in, ws_size); grid = -1; return; }
        int dev = 0, cus = 0;
        if (hipGetDevice(&dev) != hipSuccess || hipDeviceGetAttribute(&cus, hipDeviceAttributeMultiprocessorCount, dev) != hipSuccess) { grid = -1; return; }
        if (hipFuncSetAttribute((const void*)fwd_kernel, hipFuncAttributeMaxDynamicSharedMemorySize, LDS_BYTES) != hipSuccess) { fprintf(stderr, "kernel_launch: hipFuncSetAttribute failed\n"); grid = -1; return; }
        int per_cu = 0;
        if (hipOccupancyMaxActiveBlocksPerMultiprocessor(&per_cu, (const void*)fwd_kernel, 512, LDS_BYTES) != hipSuccess || per_cu < 1) fprintf(stderr, "kernel_launch: occupancy query says %d\n", per_cu);
        (void)hipGetLastError();
        grid = cus;
        if (grid != 256) fprintf(stderr, "kernel_launch: note: %d CUs\n", grid);
    }
    if (grid < 0) return;
    (void)hipMemsetAsync((char*)d_ws + WS_CTL, 0, CTL_BYTES, stream);
    Args a{};
    for (int i = 0; i < 34; ++i) a.in[i] = (const float*)d_in[i];
    a.out = (float*)d_out; a.ws = (unsigned char*)d_ws;
    if (PROBE_PHASE >= 0) {
        a.ph_lo = 0; a.ph_hi = PROBE_PHASE + 1; a.li = 0; hipLaunchKernelGGL(fwd_kernel, dim3(grid), dim3(512), LDS_BYTES, stream, a);
        a.ph_lo = PROBE_PHASE; a.ph_hi = PROBE_PHASE + 1; a.li = 1; hipLaunchKernelGGL(fwd_kernel, dim3(grid), dim3(512), LDS_BYTES, stream, a);
        if (PROBE_PHASE + 1 < N_PHASES) { a.ph_lo = PROBE_PHASE + 1; a.ph_hi = N_PHASES; a.li = 2; hipLaunchKernelGGL(fwd_kernel, dim3(grid), dim3(512), LDS_BYTES, stream, a); }
    } else if (MK_N_LAUNCHES == 1) { a.ph_lo = 0; a.ph_hi = N_PHASES; a.li = 0; hipLaunchKernelGGL(fwd_kernel, dim3(grid), dim3(512), LDS_BYTES, stream, a); }
    else { for (int p = 0; p < N_PHASES; ++p) { a.ph_lo = p; a.ph_hi = p + 1; a.li = 0; hipLaunchKernelGGL(fwd_kernel, dim3(grid), dim3(512), LDS_BYTES, stream, a); } }
}
```

```cpp
#include <hip/hip_runtime.h>
#include <cstdio>
#include <cstdint>

#ifndef MK_N_LAUNCHES
#define MK_N_LAUNCHES 1
#endif
#ifndef PROBE_PHASE
#define PROBE_PHASE -1
#endif
constexpr int N_PHASES = 8;
#ifndef GEMM_SP2
#define GEMM_SP2 true
#endif
#ifndef GEMM_ALIGN
#define GEMM_ALIGN true
#endif

#define GAS __attribute__((address_space(1)))
#define LAS __attribute__((address_space(3)))
typedef unsigned short bf16_t;
typedef short bf16x8 __attribute__((ext_vector_type(8)));
typedef float f32x2 __attribute__((ext_vector_type(2)));
typedef float f32x4 __attribute__((ext_vector_type(4)));
typedef float f32x16 __attribute__((ext_vector_type(16)));
typedef unsigned u32x2 __attribute__((ext_vector_type(2)));
typedef unsigned u32x4 __attribute__((ext_vector_type(4)));
typedef GAS unsigned gu32;

constexpr int DM = 2048, SEQ = 2048, NB = 4, NSMP = 128;
constexpr int MP = NB * SEQ;
constexpr int MV = MP + NSMP;
constexpr int MT = MV + NSMP;
constexpr int NIN = 10368, LDP = 10496;
constexpr int NMOD = 6144, NMODROWS = NB + NSMP;
constexpr float RMS_EPS = 1e-6f, GN_EPS = 64e-5f;
constexpr int PC_U = 0, PC_ZS = 1024, PC_R = 2048, PC_K = 3072, PC_V = 4096, PC_ZR = 5120, PC_GS = 6144, PC_GR = 8192, PC_WD = 10240, PC_AD = 10304;

constexpr size_t WS_CTL = 0, CTL_BYTES = 131072;
constexpr size_t WS_MOD = CTL_BYTES;
constexpr size_t WS_WT = WS_MOD + 3276800;
constexpr size_t WS_XN = WS_WT + (size_t)LDP * 2048 * 2;
constexpr size_t WS_P = WS_XN + (size_t)MT * 2048 * 2;
constexpr size_t WS_RWI = WS_P + (size_t)MT * LDP * 2;
constexpr int RWI_GF = 0, RWI_W2F = 8192, RWI_H1F = 16384, RWI_O1F = 32768, RWI_LAM = 49152, RWI_BYTES = 49408;
constexpr size_t WS_TMP = WS_RWI;
constexpr size_t WS_SLAB = WS_TMP + (size_t)MP * 2048 * 2;
static_assert(WS_SLAB + (size_t)8 * NSMP * DM * 4 <= WS_RWI + (size_t)2048 * RWI_BYTES, "tmp/slab alias");
constexpr size_t WS_YG = WS_RWI + (size_t)2048 * RWI_BYTES;
constexpr size_t WS_WOUT_T = WS_YG + (size_t)MT * 1024 * 2;
constexpr size_t WS_WGLU_T = WS_WOUT_T + (size_t)2048 * 2048 * 2;
constexpr size_t WS_ROWSS = WS_WGLU_T + (size_t)1024 * 1024 * 2;
constexpr size_t WS_U2 = WS_ROWSS + (size_t)MP * 8 * 4;
constexpr size_t WS_U2S = WS_U2 + (size_t)MP * 1024 * 2;
constexpr size_t WS_HB = WS_U2S + (size_t)NSMP * 1024 * 2;
constexpr size_t WS_XW = WS_HB + (size_t)256 * 32 * 2048;
constexpr size_t WS_END = WS_XW + (size_t)MP * 128 * 2;
static_assert(WS_END <= ((size_t)412 << 20), "ws map");
constexpr size_t DO_ORAW = 0, DO_BV = (size_t)MP * 1024 * 2, DO_S5TAB = 2 * DO_BV;
constexpr int S5T_ME = 0, S5T_KT = 65536, S5T_CA = 81920, S5T_C0 = 147456, S5T_DF = 155648, S5T_HDR = 156672, S5T_BYTES = 157696;
static_assert(DO_S5TAB + (size_t)64 * S5T_BYTES <= (size_t)MV * DM * 4, "d_out scratch");
constexpr size_t OUT_Y = 0, OUT_S5RE_P = 17039360, OUT_S5IM_P = 17055744, OUT_WKV_P = 17072128, OUT_SHIFT_P = 17334272,
                 OUT_S5RE_S = 17342464, OUT_S5IM_S = 17866752, OUT_WKV_S = 18391040, OUT_SHIFT_S = 26779648;
constexpr int RING_BYTES = 131072, LDSCTL_OFF = RING_BYTES, MISC_OFF = LDSCTL_OFF + 320, LDS_BYTES = 147456;
constexpr int CW_BAR = 1024;
constexpr int CW_PANEL = 12288, CW_TILE = 16384;

#define LDS_WAIT() asm volatile("s_waitcnt lgkmcnt(0)" ::: "memory")
#define VM_WAIT() asm volatile("s_waitcnt vmcnt(0)" ::: "memory")
typedef __bf16 bf16x2_t __attribute__((ext_vector_type(2)));
__device__ __forceinline__ unsigned cvt_pk_bf16(float lo, float hi) { const f32x2 v = {lo, hi}; return __builtin_bit_cast(unsigned, __builtin_convertvector(v, bf16x2_t)); }
__device__ __forceinline__ u32x2 pack4(float a, float b, float c, float d) { u32x2 w; w.x = cvt_pk_bf16(a, b); w.y = cvt_pk_bf16(c, d); return w; }
__device__ __forceinline__ float bf_lo(unsigned w) { return __uint_as_float(w << 16); }
__device__ __forceinline__ float bf_hi(unsigned w) { return __uint_as_float(w & 0xffff0000u); }
__device__ __forceinline__ float bf2f(bf16_t b) { return __uint_as_float(((unsigned)b) << 16); }
__device__ __forceinline__ bf16_t f2bf(float f) { return (bf16_t)(cvt_pk_bf16(f, 0.f) & 0xffffu); }
__device__ __forceinline__ float rcpf_(float x) { return __builtin_amdgcn_rcpf(x); }
__device__ __forceinline__ float sigmoidf_(float x) { return rcpf_(1.0f + __expf(-x)); }
__device__ __forceinline__ float siluf_(float x) { return x * rcpf_(1.0f + __expf(-x)); }
__device__ __forceinline__ float tanhf_(float x) { const float e = __expf(2.0f * x); return 1.0f - 2.0f * rcpf_(e + 1.0f); }
__device__ __forceinline__ float geluf_(float y) { const float z = 0.7978845608028654f * (y + 0.044715f * y * y * y); return 0.5f * y * (1.0f + tanhf_(z)); }
__device__ __forceinline__ float wave_sum(float v) {
#pragma unroll
    for (int o = 1; o < 64; o <<= 1) v += __shfl_xor(v, o);
    return v;
}
template <int CTRL> __device__ __forceinline__ float dpp_f(float x) { return __builtin_bit_cast(float, __builtin_amdgcn_mov_dpp(__builtin_bit_cast(int, x), CTRL, 0xf, 0xf, true)); }
__device__ __forceinline__ float wave_sum_dpp(float v) {
    v += __builtin_bit_cast(float, __builtin_amdgcn_update_dpp(0, __builtin_bit_cast(int, v), 0x111, 0xf, 0xf, true));
    v += __builtin_bit_cast(float, __builtin_amdgcn_update_dpp(0, __builtin_bit_cast(int, v), 0x112, 0xf, 0xf, true));
    v += __builtin_bit_cast(float, __builtin_amdgcn_update_dpp(0, __builtin_bit_cast(int, v), 0x114, 0xf, 0xf, true));
    v += __builtin_bit_cast(float, __builtin_amdgcn_update_dpp(0, __builtin_bit_cast(int, v), 0x118, 0xf, 0xf, true));
    v += __builtin_bit_cast(float, __builtin_amdgcn_update_dpp(0, __builtin_bit_cast(int, v), 0x142, 0xa, 0xf, false));
    v += __builtin_bit_cast(float, __builtin_amdgcn_update_dpp(0, __builtin_bit_cast(int, v), 0x143, 0xc, 0xf, false));
    return __builtin_bit_cast(float, __builtin_amdgcn_readlane(__builtin_bit_cast(int, v), 63));
}
__device__ __forceinline__ float half_sum32(float v, bool upper) {
    v += __builtin_bit_cast(float, __builtin_amdgcn_update_dpp(0, __builtin_bit_cast(int, v), 0x111, 0xf, 0xf, true));
    v += __builtin_bit_cast(float, __builtin_amdgcn_update_dpp(0, __builtin_bit_cast(int, v), 0x112, 0xf, 0xf, true));
    v += __builtin_bit_cast(float, __builtin_amdgcn_update_dpp(0, __builtin_bit_cast(int, v), 0x114, 0xf, 0xf, true));
    v += __builtin_bit_cast(float, __builtin_amdgcn_update_dpp(0, __builtin_bit_cast(int, v), 0x118, 0xf, 0xf, true));
    v += __builtin_bit_cast(float, __builtin_amdgcn_update_dpp(0, __builtin_bit_cast(int, v), 0x142, 0xa, 0xf, false));
    const float s0 = __builtin_bit_cast(float, __builtin_amdgcn_readlane(__builtin_bit_cast(int, v), 31)), s1 = __builtin_bit_cast(float, __builtin_amdgcn_readlane(__builtin_bit_cast(int, v), 63));
    return upper ? s1 : s0;
}
__device__ __forceinline__ float row16_sum(float v) {
    v += dpp_f<0xB1>(v);
    v += dpp_f<0x4E>(v);
    v += dpp_f<0x141>(v);
    v += dpp_f<0x140>(v);
    return v;
}

#define XB_TMO      128
#define XB_XCNT(j)  (256  + 64 * (j))
#define XB_XSUB(j)  (1280 + 64 * (j))
#define XB_XGEN(j)  (2304 + 64 * (j))
#define XB_TOP      3328
#define XB_TOPGEN   3392
#define XCD_BAR_WORDS 3456
#define XB_SPIN_CAP (1u << 20)
__device__ __forceinline__ unsigned xb_ld(unsigned* p)              { return __hip_atomic_load(p, __ATOMIC_RELAXED, __HIP_MEMORY_SCOPE_AGENT); }
__device__ __forceinline__ unsigned xb_add(unsigned* p, unsigned v) { return __hip_atomic_fetch_add(p, v, __ATOMIC_RELAXED, __HIP_MEMORY_SCOPE_AGENT); }
__device__ __forceinline__ unsigned xb_xcc_id() { return (unsigned)__builtin_amdgcn_s_getreg((3 << 11) | 20) & 0xFu; }
#define XB_SPIN(cond, bar) do { unsigned _sp = 0; while (cond) { __builtin_amdgcn_s_sleep(1); \
    if ((++_sp & 255u) == 0u) { if (xb_ld(&(bar)[XB_TMO])) break; if (_sp > XB_SPIN_CAP) { atomicAdd(&(bar)[XB_TMO], 1u); break; } } } } while (0)
struct XcdBarrier { unsigned* bar; unsigned x; volatile LAS unsigned* st; };
__device__ __forceinline__ XcdBarrier xcd_barrier_post(unsigned* bar, volatile LAS unsigned* st) {
    XcdBarrier b; b.bar = bar; b.x = xb_xcc_id(); b.st = st;
    if (threadIdx.x == 0) (void)xb_add(&bar[XB_XCNT(b.x)], 1u);
    return b;
}
__device__ __forceinline__ void xcd_barrier_complete(unsigned* bar, unsigned x, unsigned& nloc, unsigned& nx) {
    const unsigned G = gridDim.x * gridDim.y * gridDim.z;
    unsigned sum, cnt, mine, sp = 0u;
    for (;;) {
        sum = 0u; cnt = 0u; mine = 0u;
#pragma unroll
        for (unsigned j = 0; j < 16; ++j) { const unsigned c = xb_ld(&bar[XB_XCNT(j)]); sum += c; cnt += (c > 0u) ? 1u : 0u; mine = (j == x) ? c : mine; }
        if (sum == G) break;
        __builtin_amdgcn_s_sleep(1);
        if ((++sp & 255u) == 0u) { if (xb_ld(&bar[XB_TMO])) break; if (sp > XB_SPIN_CAP) { atomicAdd(&bar[XB_TMO], 1u); break; } }
    }
    nloc = mine > 0u ? mine : 1u; nx = cnt > 0u ? cnt : 1u;
}
__device__ __forceinline__ void xcd_barrier(const XcdBarrier& b) {
    asm volatile("s_waitcnt vmcnt(0)" ::: "memory");
    __syncthreads();
    if (threadIdx.x == 0) {
        unsigned* bar = b.bar;
        __builtin_amdgcn_s_waitcnt(0);
        unsigned nloc = b.st[0], nx = b.st[1];
        if (nloc == 0u) { xcd_barrier_complete(bar, b.x, nloc, nx); b.st[0] = nloc; b.st[1] = nx; }
        const unsigned old = xb_add(&bar[XB_XSUB(b.x)], 1u);
        const unsigned gen = old / nloc;
        if (old + 1u == (gen + 1u) * nloc) {
            __builtin_amdgcn_fence(__ATOMIC_RELEASE, "agent");
            asm volatile("s_waitcnt vmcnt(0)" ::: "memory");
            const unsigned og = xb_add(&bar[XB_TOP], 1u);
            const unsigned tg = og / nx;
            if (og + 1u == (tg + 1u) * nx) xb_add(&bar[XB_TOPGEN], 1u);
            else XB_SPIN(xb_ld(&bar[XB_TOPGEN]) == tg, bar);
            __builtin_amdgcn_fence(__ATOMIC_ACQUIRE, "agent");
            xb_add(&bar[XB_XGEN(b.x)], 1u);
            asm volatile("s_waitcnt vmcnt(0)" ::: "memory");
        } else {
            XB_SPIN(xb_ld(&bar[XB_XGEN(b.x)]) == gen, bar);
            __builtin_amdgcn_fence(__ATOMIC_ACQUIRE, "agent");
            asm volatile("s_waitcnt vmcnt(0)" ::: "memory");
        }
    }
    __syncthreads();
}

namespace pg8 {
constexpr int BM = 256, BK = 64, HALF = 128, HTB = HALF * BK * 2, STAGE_BYTES = 8 * HTB, NXCD = 8, WGM = 8;
__host__ __device__ __forceinline__ int lds_byte(int r, int c) { const int st = (r >> 4) * 2 + (c >> 5), rr = r & 15, cc = c & 31, ob = rr * 64 + cc * 2; return st * 1024 + (ob ^ (((ob >> 9) & 1) << 5)); }
__host__ __device__ __forceinline__ void stage_rc(int b, int& R, int& C) { const int st = b / 1024, sb = b % 1024, swz = sb ^ (((sb >> 9) & 1) << 5); R = (st >> 1) * 16 + swz / 64; C = (st & 1) * 32 + (swz % 64) / 2; }
__host__ __device__ __forceinline__ int perm32(int rho) { const int n = rho >> 4, i = rho & 15; return 8 * (i >> 2) + 4 * n + (i & 3); }
struct Unit { int pm, pn, koff, kt, mode; };
struct Gemm { const bf16_t* A; const bf16_t* Bt; int ld, K; };
struct StaticOrder {
    int nM, nN, nwg, G, c, kt;
    __device__ void init(int M, int N, int K, int G_, int c_) { nM = M / BM; nN = N / BM; nwg = nM * nN; G = G_; c = c_; kt = K / BK; }
    __device__ __forceinline__ void tile(int L, Unit& u) const {
        int wgid = L; { const int q = nwg / NXCD, r = nwg % NXCD, xcd = wgid % NXCD, off = wgid / NXCD; wgid = (xcd < r ? xcd * (q + 1) : r * (q + 1) + (xcd - r) * q) + off; }
        const int nig = WGM * nN, gid = wgid / nig, fm = gid * WGM, gsz = (nM - fm) < WGM ? (nM - fm) : WGM;
        u.pm = fm + ((wgid % nig) % gsz); u.pn = (wgid % nig) / gsz; u.koff = 0; u.kt = kt; u.mode = 0;
    }
    __device__ __forceinline__ bool next(int i, Unit& u) const { const long L = (long)i * G + c; if (L >= nwg) return false; tile((int)L, u); return true; }
    __device__ __forceinline__ void done(const Unit&, int, int&) const {}
};
struct OutOrder : StaticOrder {
    __device__ __forceinline__ bool next(int i, Unit& u) const {
        const int i2 = (c < 64) ? i - 1 : i;
        if (i2 < 0) { u.pm = 32; u.pn = c >> 3; u.koff = (c & 7) * 256; u.kt = 4; u.mode = 2; return true; }
        if (i2 < 2 && c < nwg) { tile(c, u); u.koff = i2 * 1024; u.kt = 16; u.mode = i2; return true; }
        return false;
    }
};
struct TailOrder : StaticOrder {
    unsigned* cnt;
    __device__ void init2(int G_, int c_, unsigned* cnt_) { nM = 32; nN = 36; nwg = 32 * 36; G = G_; c = c_; kt = 32; cnt = cnt_; }
    __device__ __forceinline__ static bool flagged(const Unit& u) { return u.pm == 32 || u.pn < 4 || u.pn == 40; }
    __device__ __forceinline__ bool next(int i, Unit& u) const {
        const int L = i * G + c; if (L >= 201 + 1152) return false;
        if (L < 132) { const int x = L & 7, k = L >> 3; if (k < 16) { u.pm = 4 * x + (k >> 2); u.pn = k & 3; } else { u.pm = 32; u.pn = x; }
                       u.koff = 0; u.kt = 32; u.mode = 0; }
        else if (L < 169) { u.pm = 32; u.pn = 4 + (L - 132); u.koff = 0; u.kt = 32; u.mode = 0; }
        else if (L < 201) { u.pm = L - 169; u.pn = 40; u.koff = 0; u.kt = 32; u.mode = 0; }
        else { tile(L - 201, u); u.pn += 4; }
        return true;
    }
    __device__ __forceinline__ void done(const Unit& u, int lane, int& pend) const {
        if (pend >= 0) {
            asm volatile("s_waitcnt vmcnt(0)" ::: "memory");
            if (lane == 0) __hip_atomic_fetch_add(cnt + 64 * pend, 1u, __ATOMIC_RELAXED, __HIP_MEMORY_SCOPE_AGENT);
            pend = -1;
        }
        if (flagged(u)) pend = (u.pm == 32) ? 16 + u.pn : ((u.pn < 4) ? (u.pm >> 3) * 4 + u.pn : 57 + u.pm);
    }
};
template <class Epi, class Sched, bool ALIGN_EPI = false, bool SP2 = false>
__device__ __forceinline__ void gemm_phase(LAS unsigned char* lds, const Gemm g, const Sched& S, const Epi& E) {
    const int tid = threadIdx.x, wid = __builtin_amdgcn_readfirstlane(tid >> 6), lane = tid & 63, wr = wid >> 2, wc = wid & 3, fr = lane & 15, fq = lane >> 4;
    const int ld = g.ld;
    unsigned voffA[2], voffB[2];
#pragma unroll
    for (int i = 0; i < 2; ++i) { int R, C; stage_rc(tid * 16 + i * 8192, R, C); const int Rb = Epi::PERM ? ((R & ~31) + perm32(R & 31)) : R;
        voffA[i] = (unsigned)(R * ld + C) * 2u; voffB[i] = (unsigned)(Rb * ld + C) * 2u; }
    const size_t kstep = (size_t)(BK * 2);
    const size_t hstep = (size_t)HALF * ld * 2;
    const size_t tstep = 2 * hstep;
    const unsigned ldsw = (unsigned)wid * 1024u;
    const int aoff = lds_byte(wr * 64 + fr, fq * 8), boff = lds_byte(wc * 32 + fr, fq * 8);
#define PG8_SA(b, h) (((b) * 2 + (h)) * HTB)
#define PG8_SB(b, h) ((4 + (b) * 2 + (h)) * HTB)
#define PG8_STAGE(bufoff, gbase, voff) do { _Pragma("unroll") for (int _i = 0; _i < 2; ++_i) \
        __builtin_amdgcn_global_load_lds((const unsigned*)((const char*)(gbase) + (voff)[_i]), (LAS unsigned*)(lds + (bufoff) + ldsw + _i * 8192), 16, 0, 0); } while (0)
#define PG8_LDA(dst, b, h) do { _Pragma("unroll") for (int m = 0; m < 4; ++m) _Pragma("unroll") for (int k = 0; k < 2; ++k) dst[m][k] = *(const LAS bf16x8*)(lds + PG8_SA(b, h) + aoff + m * 2048 + k * 1024); } while (0)
#define PG8_LDB(dst, b, h) do { _Pragma("unroll") for (int n = 0; n < 2; ++n) _Pragma("unroll") for (int k = 0; k < 2; ++k) dst[n][k] = *(const LAS bf16x8*)(lds + PG8_SB(b, h) + boff + n * 2048 + k * 1024); } while (0)
#define PG8_MMA(ai, bj, At, Bt) do { __builtin_amdgcn_s_setprio(1); _Pragma("unroll") for (int m = 0; m < 4; ++m) _Pragma("unroll") for (int n = 0; n < 2; ++n) _Pragma("unroll") for (int k = 0; k < 2; ++k) \
        acc[ai][bj][m][n] = __builtin_amdgcn_mfma_f32_16x16x32_bf16(Bt[n][k], At[m][k], acc[ai][bj][m][n], 0, 0, 0); __builtin_amdgcn_s_setprio(0); } while (0)
#define PG8_WAIT_V(n) asm volatile("s_waitcnt vmcnt(" #n ")" ::: "memory")
#define PG8_WAIT_L(n) asm volatile("s_waitcnt lgkmcnt(" #n ")" ::: "memory")
#define PG8_BAR __builtin_amdgcn_s_barrier()
#define PG8_SCHED __builtin_amdgcn_sched_barrier(0)
    Unit cur, nxt; int ui = 0; bool deferred = false; int pend = -1;
    if (!S.next(0, cur)) return;
    f32x4 acc[2][2][4][2];
#pragma unroll
    for (int a = 0; a < 2; ++a)
#pragma unroll
        for (int b = 0; b < 2; ++b)
#pragma unroll
            for (int m = 0; m < 4; ++m)
#pragma unroll
                for (int n = 0; n < 2; ++n) acc[a][b][m][n] = (f32x4){0.f, 0.f, 0.f, 0.f};
    bf16x8 At[4][2], B0[2][2], B1[2][2];
    const char* cA = (const char*)g.A + (size_t)cur.pm * tstep + (size_t)cur.koff * 2; const char* cB = (const char*)g.Bt + (size_t)cur.pn * tstep + (size_t)cur.koff * 2;
    if constexpr (SP2) {
        PG8_STAGE(PG8_SB(0, 0), cB, voffB); PG8_STAGE(PG8_SB(0, 1), cB + hstep, voffB); PG8_STAGE(PG8_SA(0, 0), cA, voffA); PG8_STAGE(PG8_SA(0, 1), cA + hstep, voffA);
        if (wr == 1) PG8_BAR;
        PG8_WAIT_V(2); PG8_BAR;
        PG8_STAGE(PG8_SB(1, 0), cB + kstep, voffB); PG8_STAGE(PG8_SA(1, 0), cA + kstep, voffA); PG8_STAGE(PG8_SB(1, 1), cB + hstep + kstep, voffB);
        PG8_WAIT_V(6); PG8_BAR;
    } else {
    PG8_STAGE(PG8_SB(0, 0), cB, voffB); PG8_STAGE(PG8_SA(0, 0), cA, voffA); PG8_STAGE(PG8_SB(0, 1), cB + hstep, voffB); PG8_STAGE(PG8_SA(0, 1), cA + hstep, voffA);
    if (wr == 1) PG8_BAR;
    PG8_WAIT_V(4); PG8_BAR;
    PG8_STAGE(PG8_SB(1, 0), cB + kstep, voffB); PG8_STAGE(PG8_SA(1, 0), cA + kstep, voffA); PG8_STAGE(PG8_SB(1, 1), cB + hstep + kstep, voffB);
    PG8_WAIT_V(6); PG8_BAR;
    }
    for (;;) {
        const bool has_next = S.next(ui + 1, nxt);
        const char* nA = has_next ? (const char*)g.A + (size_t)nxt.pm * tstep + (size_t)nxt.koff * 2 : cA; const char* nB = has_next ? (const char*)g.Bt + (size_t)nxt.pn * tstep + (size_t)nxt.koff * 2 : cB;
        const int nt = cur.kt;
        for (int t = 0; t < nt; t += 2) {
            const bool last = (t == nt - 2);
            const char* a1 = cA + (size_t)(t + 1) * kstep;
            const char* a2 = last ? nA : cA + (size_t)(t + 2) * kstep; const char* b2 = last ? nB : cB + (size_t)(t + 2) * kstep;
            const char* a3 = a2 + kstep; const char* b3 = b2 + kstep;
            if constexpr (SP2) {
            PG8_LDB(B0, 0, 0); PG8_LDB(B1, 0, 1); PG8_SCHED; PG8_LDA(At, 0, 0); PG8_STAGE(PG8_SA(1, 1), a1 + hstep, voffA);
            PG8_WAIT_V(8); PG8_WAIT_L(0); PG8_BAR; PG8_MMA(0, 0, At, B0); PG8_MMA(0, 1, At, B1); PG8_BAR; PG8_SCHED;
            PG8_LDA(At, 0, 1); PG8_STAGE(PG8_SB(0, 0), b2, voffB); PG8_STAGE(PG8_SB(0, 1), b2 + hstep, voffB); PG8_STAGE(PG8_SA(0, 0), a2, voffA);
            PG8_WAIT_V(8); PG8_WAIT_L(0); PG8_BAR; PG8_MMA(1, 0, At, B0); PG8_MMA(1, 1, At, B1); PG8_BAR; PG8_SCHED;
            PG8_LDB(B0, 1, 0); PG8_LDB(B1, 1, 1); PG8_SCHED; PG8_LDA(At, 1, 0); PG8_STAGE(PG8_SA(0, 1), a2 + hstep, voffA);
            PG8_WAIT_V(8); PG8_WAIT_L(0); PG8_BAR; PG8_MMA(0, 0, At, B0); PG8_MMA(0, 1, At, B1); PG8_BAR; PG8_SCHED;
            PG8_LDA(At, 1, 1); PG8_STAGE(PG8_SB(1, 0), b3, voffB); PG8_STAGE(PG8_SB(1, 1), b3 + hstep, voffB); PG8_STAGE(PG8_SA(1, 0), a3, voffA);
            PG8_WAIT_V(8); PG8_WAIT_L(0); PG8_BAR; PG8_MMA(1, 0, At, B0); PG8_MMA(1, 1, At, B1); PG8_BAR; PG8_SCHED;
            } else {
            PG8_LDB(B0, 0, 0); PG8_SCHED; PG8_LDA(At, 0, 0); PG8_STAGE(PG8_SA(1, 1), a1 + hstep, voffA);
            PG8_WAIT_L(8); PG8_BAR; PG8_WAIT_L(0); PG8_MMA(0, 0, At, B0); PG8_BAR; PG8_SCHED;
            PG8_LDB(B1, 0, 1); PG8_STAGE(PG8_SB(0, 0), b2, voffB);
            PG8_BAR; PG8_WAIT_L(0); PG8_MMA(0, 1, At, B1); PG8_BAR;
            PG8_LDA(At, 0, 1); PG8_STAGE(PG8_SA(0, 0), a2, voffA);
            PG8_BAR; PG8_WAIT_L(0); PG8_MMA(1, 0, At, B0); PG8_BAR; PG8_SCHED;
            PG8_STAGE(PG8_SB(0, 1), b2 + hstep, voffB);
            PG8_WAIT_V(6); PG8_BAR; PG8_MMA(1, 1, At, B1); PG8_BAR;
            PG8_LDB(B0, 1, 0); PG8_SCHED; PG8_LDA(At, 1, 0); PG8_STAGE(PG8_SA(0, 1), a2 + hstep, voffA);
            PG8_WAIT_L(8); PG8_BAR; PG8_WAIT_L(0); PG8_MMA(0, 0, At, B0); PG8_BAR; PG8_SCHED;
            PG8_LDB(B1, 1, 1); PG8_STAGE(PG8_SB(1, 0), b3, voffB);
            PG8_BAR; PG8_WAIT_L(0); PG8_MMA(0, 1, At, B1); PG8_BAR;
            PG8_LDA(At, 1, 1); PG8_STAGE(PG8_SA(1, 0), a3, voffA);
            PG8_BAR; PG8_WAIT_L(0); PG8_MMA(1, 0, At, B0); PG8_BAR; PG8_SCHED;
            PG8_STAGE(PG8_SB(1, 1), b3 + hstep, voffB);
            PG8_WAIT_V(6); PG8_BAR; PG8_MMA(1, 1, At, B1); PG8_BAR;
            }
        }
        if constexpr (ALIGN_EPI) { if (wr == 0) PG8_BAR; }
        if (Epi::FUSED_LAST && !has_next && cur.mode == 1) deferred = true; else { E(acc, cur, wr, wc, fr, fq); S.done(cur, lane, pend); }
        if (!has_next) break;
#pragma unroll
        for (int a = 0; a < 2; ++a)
#pragma unroll
            for (int b = 0; b < 2; ++b)
#pragma unroll
                for (int m = 0; m < 4; ++m)
#pragma unroll
                    for (int n = 0; n < 2; ++n) acc[a][b][m][n] = (f32x4){0.f, 0.f, 0.f, 0.f};
        cur = nxt; cA = nA; cB = nB; ++ui;
        if constexpr (ALIGN_EPI) { if (wr == 1) PG8_BAR; }
    }
    PG8_WAIT_V(0);
    if constexpr (!ALIGN_EPI) { if (wr == 0) PG8_BAR; }
    PG8_BAR;
    if constexpr (Epi::FUSED_LAST) { if (deferred) E.fused(acc, cur, wr, wc, fr, fq, lds, wid, lane); }
#undef PG8_SA
#undef PG8_SB
#undef PG8_STAGE
#undef PG8_LDA
#undef PG8_LDB
#undef PG8_MMA
#undef PG8_WAIT_V
#undef PG8_WAIT_L
#undef PG8_BAR
#undef PG8_SCHED
}
}

struct EpiP {
    static constexpr bool PERM = true, FUSED_LAST = false;
    bf16_t* P; bool tail; bf16_t* U2;
    __device__ __forceinline__ void operator()(const f32x4 (&acc)[2][2][4][2], const pg8::Unit& u, int wr, int wc, int fr, int fq) const {
        const int row0 = u.pm * 256 + wr * 64 + fr, col0 = u.pn * 256 + wc * 32 + 8 * fq;
        const bool wt = tail && (u.pm == 32 || u.pn < 4 || u.pn == 40);
        const __amdgpu_buffer_rsrc_t rsrc = __builtin_amdgcn_make_buffer_rsrc(P, 0, (int)((size_t)MT * LDP * 2), 0x00020000);
        const __amdgpu_buffer_rsrc_t rsrc2 = __builtin_amdgcn_make_buffer_rsrc(U2, 0, (int)((size_t)MV * 1024 * 2), 0x00020000);
        const int act = ((u.pn >= 4 && u.pn < 8) || (u.pn >= 20 && u.pn < 24)) ? 1 : ((u.pn >= 24 && u.pn < 40) ? 2 : 0);
#pragma unroll
        for (int ai = 0; ai < 2; ++ai)
#pragma unroll
            for (int m = 0; m < 4; ++m) { bf16_t* rowp = P + (size_t)(row0 + ai * 128 + m * 16) * LDP + col0;
#pragma unroll
                for (int bj = 0; bj < 2; ++bj) { f32x4 v0 = acc[ai][bj][m][0], v1 = acc[ai][bj][m][1];
                    if (act == 1) {
#pragma unroll
                        for (int j = 0; j < 4; ++j) { v0[j] = siluf_(v0[j]); v1[j] = siluf_(v1[j]); } }
                    else if (act == 2) {
#pragma unroll
                        for (int j = 0; j < 4; ++j) { v0[j] = sigmoidf_(v0[j]); v1[j] = sigmoidf_(v1[j]); } }
                    u32x4 w; w.x = cvt_pk_bf16(v0[0], v0[1]); w.y = cvt_pk_bf16(v0[2], v0[3]); w.z = cvt_pk_bf16(v1[0], v1[1]); w.w = cvt_pk_bf16(v1[2], v1[3]);
                    if (u.pn < 4) {
                        const int row = row0 + ai * 128 + m * 16, col = col0 + bj * 128, g2 = col >> 4, hf = (col >> 3) & 1;
                        size_t eo; if (row < MP) eo = (((size_t)(row >> 11) * 64 + g2) * SEQ + (row & (SEQ - 1))) * 16 + hf * 8; else eo = (size_t)MP * 1024 + ((size_t)g2 * NSMP + ((row - MP) & (NSMP - 1))) * 16 + hf * 8;
                        if (row < MV) { if (wt) __builtin_amdgcn_raw_buffer_store_b128(w, rsrc2, (unsigned)(eo * 2), 0, 16); else *(u32x4*)(U2 + eo) = w; } }
                    else if (wt) __builtin_amdgcn_raw_buffer_store_b128(w, rsrc, (unsigned)((size_t)(row0 + ai * 128 + m * 16) * LDP + col0 + bj * 128) * 2u, 0, 16);
                    else *(u32x4*)(rowp + bj * 128) = w; } }
    }
};
struct EpiGlu {
    static constexpr bool PERM = true, FUSED_LAST = false;
    const bf16_t* Yg; const bf16_t* P; const float* bglu; bf16_t* A2;
    __device__ __forceinline__ void operator()(const f32x4 (&acc)[2][2][4][2], const pg8::Unit& u, int wr, int wc, int fr, int fq) const {
        const int row0 = u.pm * 256 + wr * 64 + fr, col0 = u.pn * 256 + wc * 32 + 8 * fq;
        f32x4 bv[2][2];
#pragma unroll
        for (int bj = 0; bj < 2; ++bj)
#pragma unroll
            for (int n = 0; n < 2; ++n) bv[bj][n] = *(const f32x4*)(bglu + col0 + bj * 128 + 4 * n);
#pragma unroll
        for (int ai = 0; ai < 2; ++ai)
#pragma unroll
            for (int m = 0; m < 4; ++m) { const size_t row = (size_t)(row0 + ai * 128 + m * 16);
#pragma unroll
                for (int bj = 0; bj < 2; ++bj) { const int c = col0 + bj * 128;
                    const u32x4 yg = *(const u32x4*)(Yg + row * 1024 + c), sz = *(const u32x4*)(P + row * LDP + PC_ZS + c);
                    const f32x4 a0 = acc[ai][bj][m][0] + bv[bj][0], a1 = acc[ai][bj][m][1] + bv[bj][1];
                    float o[8];
                    o[0] = bf_lo(yg.x) * sigmoidf_(a0[0]) * bf_lo(sz.x); o[1] = bf_hi(yg.x) * sigmoidf_(a0[1]) * bf_hi(sz.x);
                    o[2] = bf_lo(yg.y) * sigmoidf_(a0[2]) * bf_lo(sz.y); o[3] = bf_hi(yg.y) * sigmoidf_(a0[3]) * bf_hi(sz.y);
                    o[4] = bf_lo(yg.z) * sigmoidf_(a1[0]) * bf_lo(sz.z); o[5] = bf_hi(yg.z) * sigmoidf_(a1[1]) * bf_hi(sz.z);
                    o[6] = bf_lo(yg.w) * sigmoidf_(a1[2]) * bf_lo(sz.w); o[7] = bf_hi(yg.w) * sigmoidf_(a1[3]) * bf_hi(sz.w);
                    u32x4 w; w.x = cvt_pk_bf16(o[0], o[1]); w.y = cvt_pk_bf16(o[2], o[3]); w.z = cvt_pk_bf16(o[4], o[5]); w.w = cvt_pk_bf16(o[6], o[7]);
                    *(u32x4*)(A2 + row * 2048 + c) = w; } }
    }
};
struct EpiOut {
    static constexpr bool PERM = false, FUSED_LAST = true;
    const bf16_t* P; const float* xp; const float* mod; float* out; float* xbuf; bf16_t* tmp; float* slab; unsigned* cnt; const float* fg;
    __device__ __forceinline__ void operator()(const f32x4 (&acc)[2][2][4][2], const pg8::Unit& u, int wr, int wc, int fr, int fq) const {
        const int row0 = u.pm * 256 + wr * 64 + fr, col0 = u.pn * 256 + wc * 32 + 4 * fq;
        if (u.mode == 0) {
#pragma unroll
            for (int ai = 0; ai < 2; ++ai)
#pragma unroll
                for (int m = 0; m < 4; ++m) { const size_t row = (size_t)(row0 + ai * 128 + m * 16); const bf16_t* prow = P + row * LDP + PC_GS + col0; bf16_t* trow = tmp + row * DM + col0;
#pragma unroll
                    for (int bj = 0; bj < 2; ++bj)
#pragma unroll
                        for (int n = 0; n < 2; ++n) { const int o = bj * 128 + n * 16; const u32x2 gg = *(const u32x2*)(prow + o); const f32x4 a = acc[ai][bj][m][n];
                            *(u32x2*)(trow + o) = pack4(bf_lo(gg.x) * a[0], bf_hi(gg.x) * a[1], bf_lo(gg.y) * a[2], bf_hi(gg.y) * a[3]); } }
        } else {
            const int gc = (u.koff < 1024) ? PC_GS : PC_GR; float* sl = slab + (size_t)(u.koff >> 8) * NSMP * DM;
#pragma unroll
            for (int m = 0; m < 4; ++m) { const size_t row = (size_t)(row0 + m * 16); const bf16_t* prow = P + row * LDP + gc + col0; float* srow = sl + (row - MP) * DM + col0;
#pragma unroll
                for (int bj = 0; bj < 2; ++bj)
#pragma unroll
                    for (int n = 0; n < 2; ++n) { const int o = bj * 128 + n * 16; const u32x2 gg = *(const u32x2*)(prow + o); const f32x4 a = acc[0][bj][m][n];
                        *(f32x4*)(srow + o) = (f32x4){bf_lo(gg.x) * a[0], bf_hi(gg.x) * a[1], bf_lo(gg.y) * a[2], bf_hi(gg.y) * a[3]}; } }
        }
    }
    __device__ __forceinline__ void fused(f32x4 (&acc)[2][2][4][2], const pg8::Unit& u, int wr, int wc, int fr, int fq, LAS unsigned char* lds, int wid, int lane) const {
        const int row0 = u.pm * 256 + wr * 64 + fr, col0 = u.pn * 256 + wc * 32 + 4 * fq;
        LAS float* PT = (LAS float*)lds; LAS float* ST = (LAS float*)(lds + 4096);
        f32x4 gt[2][2];
        { const float* gtrow = mod + (size_t)(u.pm >> 3) * NMOD + 2 * DM + col0;
#pragma unroll
          for (int bj = 0; bj < 2; ++bj)
#pragma unroll
              for (int n = 0; n < 2; ++n) gt[bj][n] = *(const f32x4*)(gtrow + bj * 128 + n * 16); }
#pragma unroll
        for (int ai = 0; ai < 2; ++ai)
#pragma unroll
            for (int m = 0; m < 4; ++m) { const size_t row = (size_t)(row0 + ai * 128 + m * 16);
                const bf16_t* prow = P + row * LDP + PC_GR + col0; const bf16_t* trow = tmp + row * DM + col0; const float* xrow = xp + row * DM + col0;
                u32x2 gg[4], tv[4]; f32x4 xv[4];
#pragma unroll
                for (int q = 0; q < 4; ++q) { const int o = (q >> 1) * 128 + (q & 1) * 16; gg[q] = *(const u32x2*)(prow + o); tv[q] = *(const u32x2*)(trow + o); xv[q] = *(const f32x4*)(xrow + o); }
                float ss = 0.f;
#pragma unroll
                for (int q = 0; q < 4; ++q) { const f32x4 a = acc[ai][q >> 1][m][q & 1]; const f32x4 g4 = gt[q >> 1][q & 1];
                    f32x4 r; r[0] = xv[q][0] + g4[0] * (bf_lo(tv[q].x) + bf_lo(gg[q].x) * a[0]); r[1] = xv[q][1] + g4[1] * (bf_hi(tv[q].x) + bf_hi(gg[q].x) * a[1]);
                    r[2] = xv[q][2] + g4[2] * (bf_lo(tv[q].y) + bf_lo(gg[q].y) * a[2]); r[3] = xv[q][3] + g4[3] * (bf_hi(tv[q].y) + bf_hi(gg[q].y) * a[3]);
                    ss += (r[0] * r[0] + r[1] * r[1]) + (r[2] * r[2] + r[3] * r[3]);
                    acc[ai][q >> 1][m][q & 1] = r; }
                ss += __shfl_xor(ss, 16); ss += __shfl_xor(ss, 32);
                if (fq == 0) PT[(ai * 128 + wr * 64 + m * 16 + fr) * 4 + wc] = ss; }
        asm volatile("s_waitcnt lgkmcnt(0)" ::: "memory"); __builtin_amdgcn_s_barrier(); asm volatile("" ::: "memory");
        const int row = wid * 32 + (lane & 31);
        if (lane < 32) { const f32x4 p4 = *(const LAS f32x4*)(PT + row * 4);
            __hip_atomic_store(xbuf + ((size_t)(u.pm * 256 + row) * 8 + u.pn), (p4[0] + p4[1]) + (p4[2] + p4[3]), __ATOMIC_RELAXED, __HIP_MEMORY_SCOPE_AGENT); }
        asm volatile("s_waitcnt vmcnt(0)" ::: "memory");
        if (lane == 0) __hip_atomic_fetch_add(cnt + 64 * u.pm, 1u, __ATOMIC_RELAXED, __HIP_MEMORY_SCOPE_AGENT);
        if (wid == 0) {
            unsigned sp = 0;
            while ((unsigned)__builtin_amdgcn_readfirstlane(__hip_atomic_load(cnt + 64 * u.pm, __ATOMIC_RELAXED, __HIP_MEMORY_SCOPE_AGENT)) < 64u) { __builtin_amdgcn_s_sleep(2); if (++sp > (1u << 22)) break; }
            __builtin_amdgcn_fence(__ATOMIC_ACQUIRE, "agent");
        }
        asm volatile("s_waitcnt vmcnt(0) lgkmcnt(0)" ::: "memory"); __builtin_amdgcn_s_barrier(); asm volatile("" ::: "memory");
        if (lane < 32) { const float* sl = xbuf + (size_t)(u.pm * 256 + row) * 8; float s8 = 0.f;
#pragma unroll
            for (int t = 0; t < 8; ++t) s8 += __hip_atomic_load(sl + t, __ATOMIC_RELAXED, __HIP_MEMORY_SCOPE_AGENT);
            ST[row] = rsqrtf(s8 * (1.0f / DM) + RMS_EPS); }
        asm volatile("s_waitcnt lgkmcnt(0)" ::: "memory"); __builtin_amdgcn_s_barrier(); asm volatile("" ::: "memory");
        f32x4 fgv[2][2];
#pragma unroll
        for (int bj = 0; bj < 2; ++bj)
#pragma unroll
            for (int n = 0; n < 2; ++n) fgv[bj][n] = *(const f32x4*)(fg + col0 + bj * 128 + n * 16);
#pragma unroll
        for (int ai = 0; ai < 2; ++ai)
#pragma unroll
            for (int m = 0; m < 4; ++m) { const int rl = ai * 128 + wr * 64 + m * 16 + fr; const float rstd = ST[rl]; float* orow = out + (size_t)(u.pm * 256 + rl) * DM + col0;
#pragma unroll
                for (int bj = 0; bj < 2; ++bj)
#pragma unroll
                    for (int n = 0; n < 2; ++n) *(f32x4*)(orow + bj * 128 + n * 16) = acc[ai][bj][m][n] * rstd * fgv[bj][n]; }
    }
};

struct Args { const float* in[34]; float* out; unsigned char* ws; int ph_lo, ph_hi, li, pad; };
enum { I_XP = 0, I_XS, I_CP, I_CS, I_S5RE, I_S5IM, I_WKV, I_SHIFT, I_NORMG, I_WADA, I_BADA, I_WIN, I_MU, I_ARE, I_AIM, I_LOGSTEP, I_BRE, I_BIM, I_CRE, I_CIM, I_DSKIP,
       I_WGLU, I_BGLU, I_W0, I_W2, I_A0, I_A2, I_KK, I_KA, I_RK, I_GNW, I_GNB, I_WOUT, I_FINALG };

__device__ __forceinline__ void transpose_item(const float* W, int ldw, int K, int csrc, bf16_t* WT, int rdst, int k0, LAS float* scr, int lane, bool zero) {
    if (zero) {
#pragma unroll
        for (int j = 0; j < 4; ++j) { const int n = (lane >> 3) + 8 * j; *(u32x4*)(WT + (size_t)(rdst + n) * K + k0 + 8 * (lane & 7)) = (u32x4){0u, 0u, 0u, 0u}; }
        return;
    }
#pragma unroll 8
    for (int i = 0; i < 32; ++i) { const int kk = 2 * i + (lane >> 5); scr[kk * 33 + (lane & 31)] = W[(size_t)(k0 + kk) * ldw + csrc + (lane & 31)]; }
    LDS_WAIT(); asm volatile("" ::: "memory");
    const int c = lane & 7;
#pragma unroll
    for (int j = 0; j < 4; ++j) { const int n = (lane >> 3) + 8 * j; const LAS float* s = scr + (8 * c) * 33 + n;
        u32x4 o; o.x = cvt_pk_bf16(s[0 * 33], s[1 * 33]); o.y = cvt_pk_bf16(s[2 * 33], s[3 * 33]); o.z = cvt_pk_bf16(s[4 * 33], s[5 * 33]); o.w = cvt_pk_bf16(s[6 * 33], s[7 * 33]);
        *(u32x4*)(WT + (size_t)(rdst + n) * K + k0 + 8 * c) = o; }
    LDS_WAIT(); asm volatile("" ::: "memory");
}

__device__ __forceinline__ void lerp8(const bf16_t* cur, const bf16_t* prev, bool has_prev, const float* mu, float (&o)[8]) {
    const u32x4 c = *(const u32x4*)cur; u32x4 p = (u32x4){0u, 0u, 0u, 0u}; if (has_prev) p = *(const u32x4*)prev;
    const f32x4 m0 = *(const f32x4*)mu, m1 = *(const f32x4*)(mu + 4);
    const float cf[8] = {bf_lo(c.x), bf_hi(c.x), bf_lo(c.y), bf_hi(c.y), bf_lo(c.z), bf_hi(c.z), bf_lo(c.w), bf_hi(c.w)};
    const float pf[8] = {bf_lo(p.x), bf_hi(p.x), bf_lo(p.y), bf_hi(p.y), bf_lo(p.z), bf_hi(p.z), bf_lo(p.w), bf_hi(p.w)};
    const float mf[8] = {m0[0], m0[1], m0[2], m0[3], m1[0], m1[1], m1[2], m1[3]};
#pragma unroll
    for (int j = 0; j < 8; ++j) o[j] = cf[j] + (pf[j] - cf[j]) * mf[j];
}
__device__ __forceinline__ void p2_xw_panel(const Args& a, int pm, int tid) {
    const bf16_t* P = (const bf16_t*)(a.ws + WS_P); bf16_t* XW = (bf16_t*)(a.ws + WS_XW); const float* mu = a.in[I_MU];
    const int row = pm * 256 + (tid >> 1), hf = tid & 1; const bool hp = (row & (SEQ - 1)) != 0;
#pragma unroll
    for (int k8 = 0; k8 < 8; ++k8) { const int col = 64 * hf + 8 * k8; float x8[8];
        lerp8(P + (size_t)row * LDP + PC_WD + col, P + (size_t)(row - 1) * LDP + PC_WD + col, hp, mu + 3072 + col, x8);
        if (hf == 0) {
#pragma unroll
            for (int j = 0; j < 8; ++j) x8[j] = tanhf_(x8[j]); }
        u32x4 t; t.x = cvt_pk_bf16(x8[0], x8[1]); t.y = cvt_pk_bf16(x8[2], x8[3]); t.z = cvt_pk_bf16(x8[4], x8[5]); t.w = cvt_pk_bf16(x8[6], x8[7]);
        *(u32x4*)(XW + (size_t)row * 128 + col) = t; }
}
__device__ __forceinline__ void wait_count(unsigned* cnt, unsigned need, int wave) {
    if (wave == 0) { unsigned sp = 0;
        while ((unsigned)__builtin_amdgcn_readfirstlane(__hip_atomic_load(cnt, __ATOMIC_RELAXED, __HIP_MEMORY_SCOPE_AGENT)) < need) { __builtin_amdgcn_s_sleep(4); if (++sp > (1u << 22)) break; }
        __builtin_amdgcn_fence(__ATOMIC_ACQUIRE, "agent");
        asm volatile("s_waitcnt vmcnt(0)" ::: "memory"); }
    __syncthreads();
}
__device__ __forceinline__ void p0_mod(const Args& a, LAS unsigned char* lds, int s, int wave, int lane) {
    const float* cp = a.in[I_CP]; const float* cs = a.in[I_CS]; const float* W = a.in[I_WADA]; const float* bias = a.in[I_BADA];
    float* mod = (float*)(a.ws + WS_MOD);
    const int n0 = 32 * s, k0 = 256 * wave, r31 = lane & 31, h = lane >> 5;
    f32x16 acc[5];
#pragma unroll
    for (int t = 0; t < 5; ++t)
#pragma unroll
        for (int r = 0; r < 16; ++r) acc[t][r] = 0.f;
    float bw[8]; f32x4 c0[5], c1[5];
#define MOD_LOAD(ks_) do { const int kb_ = k0 + 16 * (ks_) + 8 * h; \
        _Pragma("unroll") for (int j = 0; j < 8; ++j) bw[j] = W[(size_t)(kb_ + j) * NMOD + n0 + r31]; \
        _Pragma("unroll") for (int t = 0; t < 5; ++t) { const int R = 32 * t + r31; c0[t] = (f32x4){0.f, 0.f, 0.f, 0.f}; c1[t] = c0[t]; \
            if (R < NMODROWS) { const float* src = (R < NB) ? cp + (size_t)R * DM + kb_ : cs + (size_t)(R - NB) * DM + kb_; c0[t] = *(const f32x4*)src; c1[t] = *(const f32x4*)(src + 4); } } } while (0)
    MOD_LOAD(0);
#pragma unroll 1
    for (int ks = 0; ks < 16; ++ks) {
        bf16x8 bfr; { u32x4 t; t.x = cvt_pk_bf16(bw[0], bw[1]); t.y = cvt_pk_bf16(bw[2], bw[3]); t.z = cvt_pk_bf16(bw[4], bw[5]); t.w = cvt_pk_bf16(bw[6], bw[7]); bfr = __builtin_bit_cast(bf16x8, t); }
        bf16x8 afr[5];
#pragma unroll
        for (int t = 0; t < 5; ++t) { u32x4 w; w.x = cvt_pk_bf16(siluf_(c0[t][0]), siluf_(c0[t][1])); w.y = cvt_pk_bf16(siluf_(c0[t][2]), siluf_(c0[t][3])); w.z = cvt_pk_bf16(siluf_(c1[t][0]), siluf_(c1[t][1])); w.w = cvt_pk_bf16(siluf_(c1[t][2]), siluf_(c1[t][3])); afr[t] = __builtin_bit_cast(bf16x8, w); }
        if (ks + 1 < 16) MOD_LOAD(ks + 1);
#pragma unroll
        for (int t = 0; t < 5; ++t) acc[t] = __builtin_amdgcn_mfma_f32_32x32x16_bf16(afr[t], bfr, acc[t], 0, 0, 0);
    }
#undef MOD_LOAD
    LAS float* red = (LAS float*)lds;
#pragma unroll
    for (int step = 4; step >= 1; step >>= 1) {
        if (wave >= step && wave < 2 * step) {
#pragma unroll
            for (int t = 0; t < 5; ++t)
#pragma unroll
                for (int r = 0; r < 16; ++r) red[(((wave - step) * 5 + t) * 16 + r) * 64 + lane] = acc[t][r];
        }
        __syncthreads();
        if (wave < step) {
#pragma unroll
            for (int t = 0; t < 5; ++t)
#pragma unroll
                for (int r = 0; r < 16; ++r) acc[t][r] += red[((wave * 5 + t) * 16 + r) * 64 + lane];
        }
        __syncthreads();
    }
    if (wave == 0) {
        const float bc = bias[n0 + r31];
#pragma unroll
        for (int t = 0; t < 5; ++t)
#pragma unroll
            for (int r = 0; r < 16; ++r) { const int R = 32 * t + (r & 3) + 8 * (r >> 2) + 4 * h; if (R < NMODROWS) mod[(size_t)R * NMOD + n0 + r31] = acc[t][r] + bc; }
    }
}

__device__ __forceinline__ void p0_s5_tables(const Args& a, LAS unsigned char* lds, int g, int tid) {
    LAS float* pw = (LAS float*)lds;
    LAS float* bbL = pw + 17 * 128;
    LAS float* ccL = bbL + 2048;
    LAS float* KF = ccL + 2048;
    LAS float* DL = KF + 4096;
    unsigned char* tab = (unsigned char*)a.out + DO_S5TAB + (size_t)g * S5T_BYTES;
    {
        const int p = tid & 63;
        const float step = expf(a.in[I_LOGSTEP][g]);
        const float lre = fminf(a.in[I_ARE][g * 64 + p], -1e-4f), lim = a.in[I_AIM][g * 64 + p];
        const float mag = expf(lre * step); float sn, cs; sincosf(lim * step, &sn, &cs);
        const float abr = mag * cs, abi = mag * sn, den = lre * lre + lim * lim;
        const float fr = ((abr - 1.0f) * lre + abi * lim) / den, fi = (abi * lre - (abr - 1.0f) * lim) / den;
        if (tid < 64) { float pr = 1.f, pi = 0.f;
            for (int e = 0; e <= 16; ++e) { pw[(e * 64 + p) * 2] = pr; pw[(e * 64 + p) * 2 + 1] = pi; const float nr = pr * abr - pi * abi, ni = pr * abi + pi * abr; pr = nr; pi = ni; } }
#pragma unroll
        for (int i = 0; i < 2; ++i) { const int c = (tid >> 6) + 8 * i; const float br = a.in[I_BRE][(g * 64 + p) * 16 + c], bi = a.in[I_BIM][(g * 64 + p) * 16 + c];
            bbL[(p * 16 + c) * 2] = fr * br - fi * bi; bbL[(p * 16 + c) * 2 + 1] = fr * bi + fi * br;
            ccL[(c * 64 + p) * 2] = a.in[I_CRE][(g * 16 + c) * 64 + p]; ccL[(c * 64 + p) * 2 + 1] = a.in[I_CIM][(g * 16 + c) * 64 + p]; }
        if (tid < 16) DL[tid] = a.in[I_DSKIP][g * 16 + tid];
    }
    __syncthreads();
    for (int idx = tid; idx < 4096; idx += 512) { const int e = idx >> 8, c = (idx >> 4) & 15, c2 = idx & 15; float s = 0.f;
        for (int p = 0; p < 64; ++p) { const float cr = ccL[(c * 64 + p) * 2], ci = ccL[(c * 64 + p) * 2 + 1], pr = pw[(e * 64 + p) * 2], pi = pw[(e * 64 + p) * 2 + 1];
            const float ar = cr * pr - ci * pi, ai = cr * pi + ci * pr; s += ar * bbL[(p * 16 + c2) * 2] - ai * bbL[(p * 16 + c2) * 2 + 1]; }
        if (e == 0 && c == c2) s += DL[c];
        KF[idx] = s; }
    __syncthreads();
    for (int it = tid; it < 4096; it += 512) { const int l = it & 63, s = (it >> 6) & 15, mtile = it >> 10; const int m = 32 * mtile + (l & 31), h = l >> 5, p = m & 63, im = m >> 6;
        const float pr = pw[((15 - s) * 64 + p) * 2], pi = pw[((15 - s) * 64 + p) * 2 + 1]; float v[8];
#pragma unroll
        for (int j = 0; j < 8; ++j) { const float br = bbL[(p * 16 + 8 * h + j) * 2], bi = bbL[(p * 16 + 8 * h + j) * 2 + 1]; v[j] = im ? (pr * bi + pi * br) : (pr * br - pi * bi); }
        u32x4 w; w.x = cvt_pk_bf16(v[0], v[1]); w.y = cvt_pk_bf16(v[2], v[3]); w.z = cvt_pk_bf16(v[4], v[5]); w.w = cvt_pk_bf16(v[6], v[7]);
        *(u32x4*)(tab + S5T_ME + (size_t)it * 16) = w; }
    for (int it = tid; it < 1024; it += 512) { const int l = it & 63, ti = it >> 6; const int rho = l & 31, dt = rho >> 4, c = rho & 15, h = l >> 5, e = ti - 1 + dt; float v[8];
#pragma unroll
        for (int j = 0; j < 8; ++j) v[j] = (e < 0) ? 0.f : KF[(e * 16 + c) * 16 + 8 * h + j];
        u32x4 w; w.x = cvt_pk_bf16(v[0], v[1]); w.y = cvt_pk_bf16(v[2], v[3]); w.z = cvt_pk_bf16(v[4], v[5]); w.w = cvt_pk_bf16(v[6], v[7]);
        *(u32x4*)(tab + S5T_KT + (size_t)it * 16) = w; }
    for (int it = tid; it < 4096; it += 512) { const int l = it & 63, ks = (it >> 6) & 7, mt = it >> 9; const int rho = l & 31, dt = rho >> 4, c = rho & 15, h = l >> 5, t = 2 * mt + dt; float v[8];
#pragma unroll
        for (int j = 0; j < 8; ++j) { const int m = 16 * ks + 8 * h + j, p = m & 63; const float cr = ccL[(c * 64 + p) * 2], ci = ccL[(c * 64 + p) * 2 + 1], pr = pw[((t + 1) * 64 + p) * 2], pi = pw[((t + 1) * 64 + p) * 2 + 1];
            v[j] = (m < 64) ? (cr * pr - ci * pi) : -(cr * pi + ci * pr); }
        u32x4 w; w.x = cvt_pk_bf16(v[0], v[1]); w.y = cvt_pk_bf16(v[2], v[3]); w.z = cvt_pk_bf16(v[4], v[5]); w.w = cvt_pk_bf16(v[6], v[7]);
        *(u32x4*)(tab + S5T_CA + (size_t)it * 16) = w; }
    { const int it = tid; const int l = it & 63, sp = (it >> 6) & 1, mtile = it >> 7; const int rho = l & 31, h = l >> 5; float v[8];
#pragma unroll
        for (int j = 0; j < 8; ++j) { const int m = 32 * mtile + 16 * sp + 8 * (j >> 2) + 4 * h + (j & 3), p = m & 63; v[j] = (rho < 16) ? ((m < 64) ? ccL[(rho * 64 + p) * 2] : -ccL[(rho * 64 + p) * 2 + 1]) : 0.f; }
        u32x4 w; w.x = cvt_pk_bf16(v[0], v[1]); w.y = cvt_pk_bf16(v[2], v[3]); w.z = cvt_pk_bf16(v[4], v[5]); w.w = cvt_pk_bf16(v[6], v[7]);
        *(u32x4*)(tab + S5T_C0 + (size_t)it * 16) = w; }
    if (tid < 64) { const int l = tid, rho = l & 31, h = l >> 5; float v[8];
#pragma unroll
        for (int j = 0; j < 8; ++j) v[j] = (rho < 16 && rho == 8 * h + j) ? DL[rho] : 0.f;
        u32x4 w; w.x = cvt_pk_bf16(v[0], v[1]); w.y = cvt_pk_bf16(v[2], v[3]); w.z = cvt_pk_bf16(v[4], v[5]); w.w = cvt_pk_bf16(v[6], v[7]);
        *(u32x4*)(tab + S5T_DF + (size_t)l * 16) = w;
        float* hdr = (float*)(tab + S5T_HDR);
        hdr[l] = pw[(16 * 64 + l) * 2]; hdr[64 + l] = pw[(16 * 64 + l) * 2 + 1]; hdr[128 + l] = pw[(64 + l) * 2]; hdr[192 + l] = pw[(64 + l) * 2 + 1]; }
    __syncthreads();
}

__device__ __forceinline__ void p1_row(const Args& a, int m, int lane) {
    bf16_t* XN = (bf16_t*)(a.ws + WS_XN) + (size_t)m * DM;
    if (m >= MV) {
        const float* src = a.in[I_SHIFT] + (size_t)(m - MV) * DM;
#pragma unroll
        for (int j = 0; j < 8; ++j) { const f32x4 v = *(const f32x4*)(src + 4 * lane + 256 * j); u32x2 w; w.x = cvt_pk_bf16(v[0], v[1]); w.y = cvt_pk_bf16(v[2], v[3]); *(u32x2*)(XN + 4 * lane + 256 * j) = w; }
        return;
    }
    const float* x = (m < MP) ? a.in[I_XP] + (size_t)m * DM : a.in[I_XS] + (size_t)(m - MP) * DM;
    const int mrow = (m < MP) ? (m >> 11) : (NB + m - MP);
    const float* mod = (const float*)(a.ws + WS_MOD) + (size_t)mrow * NMOD;
    const float* g = a.in[I_NORMG];
    f32x4 v[8]; float ss = 0.f;
#pragma unroll
    for (int j = 0; j < 8; ++j) { v[j] = *(const f32x4*)(x + 4 * lane + 256 * j); ss += (v[j][0] * v[j][0] + v[j][1] * v[j][1]) + (v[j][2] * v[j][2] + v[j][3] * v[j][3]); }
    const float rstd = rsqrtf(wave_sum(ss) * (1.0f / DM) + RMS_EPS);
    float* sh_out = nullptr;
    if (m >= MP) sh_out = a.out + OUT_SHIFT_S + (size_t)(m - MP) * DM;
    else if ((m & (SEQ - 1)) == SEQ - 1) sh_out = a.out + OUT_SHIFT_P + (size_t)(m >> 11) * DM;
#pragma unroll
    for (int j = 0; j < 8; ++j) { const int k = 4 * lane + 256 * j; const f32x4 gv = *(const f32x4*)(g + k), sh = *(const f32x4*)(mod + k), sc = *(const f32x4*)(mod + DM + k);
        f32x4 hv;
#pragma unroll
        for (int q = 0; q < 4; ++q) hv[q] = v[j][q] * rstd * gv[q] * (1.0f + sc[q]) + sh[q];
        u32x2 w; w.x = cvt_pk_bf16(hv[0], hv[1]); w.y = cvt_pk_bf16(hv[2], hv[3]); *(u32x2*)(XN + k) = w;
        if (sh_out) *(f32x4*)(sh_out + k) = hv; }
}

constexpr int RW_TB = 32;
constexpr int RW_KK = 0, RW_DR = 2048, RW_DD = 4096, RW_BB = 6144, RW_KP = 8192, RW_VV = 10240, RW_SC = 11264, RW_LW = 11392, RW_LA = 13440, RW_OB = 15488, RW_BVB = 16512, RW_END = 17536;
struct RwTok { float kk, dr, dd, bb, kp, v, br, kr, bonus; };
__device__ __forceinline__ RwTok rw_token(const Args& a, int hj, float r, float k, float v, float lw, float la) {
    RwTok o;
    const float wpre = a.in[I_W0][hj] + lw;
    const float nz = -wpre;
    const float sp = fmaxf(nz, 0.f) + log1pf(__expf(-fabsf(nz)));
    const float w = -sp - 0.5f;
    o.dd = __expf(-__expf(w));
    const float av = sigmoidf_(a.in[I_A0][hj] + la);
    const float kkv = k * a.in[I_KK][hj];
    const float nrm = sqrtf(wave_sum(kkv * kkv));
    o.kk = kkv / fmaxf(nrm, 1e-12f);
    o.kp = k * (1.0f + (av - 1.0f) * a.in[I_KA][hj]);
    o.bb = o.kk * av;
    o.dr = o.dd * r;
    o.v = v;
    o.br = wave_sum(o.bb * r);
    o.kr = wave_sum(o.kp * r);
    o.bonus = wave_sum(r * o.kp * a.in[I_RK][hj]);
    return o;
}
__device__ __forceinline__ void p3_rwkv_prompt(const Args& a, LAS unsigned char* lds, int unit, int tid, int wave, int lane) {
    const int b = unit >> 5, h = (unit >> 1) & 15, half = unit & 1;
    LAS float* L = (LAS float*)lds;
    const bf16_t* P = (const bf16_t*)(a.ws + WS_P);
    bf16_t* ORAW = (bf16_t*)((unsigned char*)a.out + DO_ORAW); bf16_t* BV = (bf16_t*)((unsigned char*)a.out + DO_BV);
    const float* mu = a.in[I_MU];
    const int r31 = lane & 31, hh = lane >> 5;
    bf16x8 bfr[4];
    if (wave < 4) { const float* W2 = (wave >> 1) ? a.in[I_A2] : a.in[I_W2]; const int col = h * 64 + 32 * (wave & 1) + r31;
#pragma unroll
        for (int ks = 0; ks < 4; ++ks) { float w[8];
#pragma unroll
            for (int j = 0; j < 8; ++j) w[j] = W2[(size_t)(16 * ks + 8 * hh + j) * 1024 + col];
            u32x4 t; t.x = cvt_pk_bf16(w[0], w[1]); t.y = cvt_pk_bf16(w[2], w[3]); t.z = cvt_pk_bf16(w[4], w[5]); t.w = cvt_pk_bf16(w[6], w[7]); bfr[ks] = __builtin_bit_cast(bf16x8, t); } }
    const int srow = 4 * wave + (lane >> 4), cq = lane & 15;
    f32x4 S = (f32x4){0.f, 0.f, 0.f, 0.f};
    for (int t0 = 0; t0 < SEQ; t0 += RW_TB) {
        const size_t rowbase = (size_t)b * SEQ + t0;
        if (wave < 4) { const int mat = wave >> 1, nt2 = wave & 1; const size_t row = rowbase + r31; const bool hp = (t0 + r31) > 0;
            f32x16 acc;
#pragma unroll
            for (int r = 0; r < 16; ++r) acc[r] = 0.f;
#pragma unroll
            for (int ks = 0; ks < 4; ++ks) { const int col = PC_WD + mat * 64 + 16 * ks + 8 * hh; float x8[8];
                lerp8(P + row * LDP + col, P + (row - 1) * LDP + col, hp, mu + 3072 + mat * 64 + 16 * ks + 8 * hh, x8);
                if (mat == 0) {
#pragma unroll
                    for (int j = 0; j < 8; ++j) x8[j] = tanhf_(x8[j]); }
                u32x4 t; t.x = cvt_pk_bf16(x8[0], x8[1]); t.y = cvt_pk_bf16(x8[2], x8[3]); t.z = cvt_pk_bf16(x8[4], x8[5]); t.w = cvt_pk_bf16(x8[6], x8[7]);
                acc = __builtin_amdgcn_mfma_f32_32x32x16_bf16(__builtin_bit_cast(bf16x8, t), bfr[ks], acc, 0, 0, 0); }
            LAS float* dst = L + (mat ? RW_LA : RW_LW);
#pragma unroll
            for (int r = 0; r < 16; ++r) { const int tl = (r & 3) + 8 * (r >> 2) + 4 * hh; dst[tl * 64 + 32 * nt2 + r31] = acc[r]; } }
        __syncthreads();
#pragma unroll
        for (int q = 0; q < 4; ++q) { const int tl = wave * 4 + q; const size_t row = rowbase + tl; const bool hp = (t0 + tl) > 0; const int hj = h * 64 + lane;
            const bf16_t* pc = P + row * LDP; const bf16_t* pp = pc - LDP;
            float r = bf2f(pc[PC_R + hj]), k = bf2f(pc[PC_K + hj]), v = bf2f(pc[PC_V + hj]);
            const float pr = hp ? bf2f(pp[PC_R + hj]) : 0.f, pk = hp ? bf2f(pp[PC_K + hj]) : 0.f, pv = hp ? bf2f(pp[PC_V + hj]) : 0.f;
            r += (pr - r) * mu[hj]; k += (pk - k) * mu[1024 + hj]; v += (pv - v) * mu[2048 + hj];
            const RwTok o = rw_token(a, hj, r, k, v, L[RW_LW + tl * 64 + lane], L[RW_LA + tl * 64 + lane]);
            L[RW_KK + tl * 64 + lane] = o.kk; L[RW_DR + tl * 64 + lane] = o.dr; L[RW_DD + tl * 64 + lane] = o.dd; L[RW_BB + tl * 64 + lane] = o.bb; L[RW_KP + tl * 64 + lane] = o.kp;
            if ((lane >> 5) == half) L[RW_VV + tl * 32 + (lane & 31)] = o.v;
            if (lane == 0) { L[RW_SC + tl * 4] = o.br; L[RW_SC + tl * 4 + 1] = o.kr; L[RW_SC + tl * 4 + 2] = o.bonus; } }
        __syncthreads();
#pragma unroll 4
        for (int tl = 0; tl < RW_TB; ++tl) {
            const f32x4 kk4 = *(const LAS f32x4*)(L + RW_KK + tl * 64 + 4 * cq), dr4 = *(const LAS f32x4*)(L + RW_DR + tl * 64 + 4 * cq), d4 = *(const LAS f32x4*)(L + RW_DD + tl * 64 + 4 * cq),
                        b4 = *(const LAS f32x4*)(L + RW_BB + tl * 64 + 4 * cq), k4 = *(const LAS f32x4*)(L + RW_KP + tl * 64 + 4 * cq);
            const float v = L[RW_VV + tl * 32 + srow]; const f32x4 sc = *(const LAS f32x4*)(L + RW_SC + tl * 4);
            float p1 = (S[0] * kk4[0] + S[1] * kk4[1]) + (S[2] * kk4[2] + S[3] * kk4[3]);
            float p2 = (S[0] * dr4[0] + S[1] * dr4[1]) + (S[2] * dr4[2] + S[3] * dr4[3]);
            p1 = row16_sum(p1); p2 = row16_sum(p2);
            const float sa = -p1;
            const float o = p2 + sa * sc[0] + v * sc[1];
#pragma unroll
            for (int j = 0; j < 4; ++j) S[j] = S[j] * d4[j] + sa * b4[j] + v * k4[j];
            if (cq == 0) { L[RW_OB + tl * 32 + srow] = o; L[RW_BVB + tl * 32 + srow] = sc[2] * v; }
        }
        __syncthreads();
        { const int tl = tid >> 4, r2 = 2 * (tid & 15); const size_t off = (rowbase + tl) * 1024 + h * 64 + 32 * half + r2;
          *(unsigned*)(ORAW + off) = cvt_pk_bf16(L[RW_OB + tl * 32 + r2], L[RW_OB + tl * 32 + r2 + 1]);
          *(unsigned*)(BV + off) = cvt_pk_bf16(L[RW_BVB + tl * 32 + r2], L[RW_BVB + tl * 32 + r2 + 1]); }
    }
    *(f32x4*)(a.out + OUT_WKV_P + (((size_t)(b * 16 + h) * 64 + 32 * half + srow) * 64 + 4 * cq)) = S;
    __syncthreads();
}


constexpr int RC_LD = 72, RC_MAT = 64 * RC_LD * 2;
constexpr int RC_QK = 0 * RC_MAT, RC_RT = 1 * RC_MAT, RC_KT = 2 * RC_MAT, RC_BT = 3 * RC_MAT, RC_QKT = 4 * RC_MAT, RC_BHT = 5 * RC_MAT, RC_KHT = 6 * RC_MAT, RC_VT = 7 * RC_MAT,
              RC_AKK = 8 * RC_MAT, RC_ARK = 9 * RC_MAT, RC_ARB = 10 * RC_MAT, RC_TB = 11 * RC_MAT, RC_AKB = 12 * RC_MAT, RC_W1T = 12 * RC_MAT, RC_U1T = 13 * RC_MAT,
              RC_AVT = RC_QK, RC_TF = RC_KT, RC_LWA = RC_AKK, RC_SEG = 14 * RC_MAT;
static_assert(RC_SEG + 2048 <= RING_BYTES, "rwkv chunk lds");
constexpr int RS_ROWB = 656, RS_BASE = 0;
static_assert(RS_BASE + 65 * RS_ROWB <= RC_AKK, "staging must stay inside R0..R7");
#define MFMA32(a, b, c) __builtin_amdgcn_mfma_f32_32x32x16_bf16((a), (b), (c), 0, 0, 0)
#define MFMA16(a, b, c) __builtin_amdgcn_mfma_f32_16x16x32_bf16((a), (b), (c), 0, 0, 0)
__device__ __forceinline__ bf16x8 lds_frag(LAS unsigned char* lds, int mat, int row, int k0) { return *(const LAS bf16x8*)(lds + mat + (row * RC_LD + k0) * 2); }

template <int MAT, int MS, int NT>
__device__ __forceinline__ void rwc_stage1_job(LAS unsigned char* lds, int r31, int hh) {
    constexpr int X = (MAT & 1) ? RC_BT : RC_KT, Y = (MAT & 2) ? RC_RT : RC_QK;
    constexpr bool incl = (MAT & 2) != 0, diag = (MS == NT);
    f32x16 acc;
#pragma unroll
    for (int r = 0; r < 16; ++r) acc[r] = 0.f;
#pragma unroll
    for (int ks = 0; ks < 4; ++ks) acc = MFMA32(lds_frag(lds, X, 32 * MS + r31, 16 * ks + 8 * hh), lds_frag(lds, Y, 32 * NT + r31, 16 * ks + 8 * hh), acc);
    const int t = 32 * NT + r31, d0 = r31 - 4 * hh;
#pragma unroll
    for (int g4 = 0; g4 < 4; ++g4) { const int s0 = 32 * MS + 8 * g4 + 4 * hh; float v[4];
#pragma unroll
        for (int e = 0; e < 4; ++e) v[e] = (!diag || (incl ? (8 * g4 + e <= d0) : (8 * g4 + e < d0))) ? acc[4 * g4 + e] : 0.f;
        if (MAT == 1) *(LAS f32x4*)(lds + RC_AKB + (t * 72 + s0) * 4) = (f32x4){v[0], v[1], v[2], v[3]};
        else { constexpr int dstm = (MAT == 0) ? RC_AKK : ((MAT == 2) ? RC_ARK : RC_ARB); *(LAS u32x2*)(lds + dstm + (t * RC_LD + s0) * 2) = pack4(v[0], v[1], v[2], v[3]); } }
}
__device__ __forceinline__ void p3_rwkv_chunks(const Args& a, LAS unsigned char* lds, int bh, int seg, int tid, int wave, int lane) {
    const int b = bh >> 4, h = bh & 15, r31_ = lane & 31, hh_ = lane >> 5, hj = h * 64 + lane;
    const bf16_t* P = (const bf16_t*)(a.ws + WS_P);
    bf16_t* BV = (bf16_t*)((unsigned char*)a.out + DO_BV);
    const float* mu = a.in[I_MU];
    LAS float* SEG = (LAS float*)(lds + RC_SEG);
    bf16x8 bfr[4];
    { const float* W2 = (wave >> 2) ? a.in[I_A2] : a.in[I_W2]; const int col = h * 64 + 32 * (wave & 1) + r31_;
#pragma unroll
      for (int ks = 0; ks < 4; ++ks) { float w[8];
#pragma unroll
          for (int j = 0; j < 8; ++j) w[j] = W2[(size_t)(16 * ks + 8 * hh_ + j) * 1024 + col];
          u32x4 t; t.x = cvt_pk_bf16(w[0], w[1]); t.y = cvt_pk_bf16(w[2], w[3]); t.z = cvt_pk_bf16(w[4], w[5]); t.w = cvt_pk_bf16(w[6], w[7]); bfr[ks] = __builtin_bit_cast(bf16x8, t); } }
    const int hj2 = h * 64 + 2 * r31_;
    const f32x2 w02 = *(const f32x2*)(a.in[I_W0] + hj2), a02 = *(const f32x2*)(a.in[I_A0] + hj2), kk2 = *(const f32x2*)(a.in[I_KK] + hj2), ka2 = *(const f32x2*)(a.in[I_KA] + hj2), rk2 = *(const f32x2*)(a.in[I_RK] + hj2);
    const f32x2 mur2 = *(const f32x2*)(mu + hj2), muk2 = *(const f32x2*)(mu + 1024 + hj2), muv2 = *(const f32x2*)(mu + 2048 + hj2);
    unsigned goff[6], loff[6]; u32x4 pf[6];
#pragma unroll
    for (int i = 0; i < 6; ++i) { const int idx = tid + 512 * i, row = idx / 40, c = idx - row * 40;
        const int col = (c < 8) ? PC_R + h * 64 + 8 * c : ((c < 16) ? PC_K + h * 64 + 8 * (c - 8) : PC_V + h * 64 + 8 * (c - 16));
        goff[i] = (c < 24) ? (unsigned)(row * LDP + col) * 2u : (0x80000000u | (unsigned)(row * 128 + 8 * (c - 24)) * 2u);   loff[i] = (unsigned)(RS_BASE + row * RS_ROWB + c * 16); }
#define RWC_PREFETCH(chunk_) do { const unsigned char* pb_ = (const unsigned char*)(P + ((size_t)b * SEQ + (size_t)(chunk_) * 64 - 1) * LDP); \
        const unsigned char* xb_ = a.ws + WS_XW + ((size_t)b * SEQ + (size_t)(chunk_) * 64) * 256 - 256; \
        _Pragma("unroll") for (int i = 0; i < 6; ++i) { const bool ok_ = (tid + 512 * i < 2600) && ((chunk_) > 0 || tid + 512 * i >= 40); \
            pf[i] = (u32x4){0u, 0u, 0u, 0u}; if (ok_) pf[i] = (goff[i] & 0x80000000u) ? *(const u32x4*)(xb_ + (goff[i] & 0x7fffffffu)) : *(const u32x4*)(pb_ + goff[i]); } } while (0)
    RWC_PREFETCH(seg * 8);
#pragma unroll 1
    for (int ci = 0; ci < 8; ++ci) {
        const int chunk = seg * 8 + ci; const size_t rowbase = (size_t)b * SEQ + chunk * 64;
#pragma unroll
        for (int i = 0; i < 6; ++i) if (tid + 512 * i < 2600) *(LAS u32x4*)(lds + loff[i]) = pf[i];
        if (ci + 1 < 8) RWC_PREFETCH(chunk + 1);
        __syncthreads();
        int r31 = r31_, hh = hh_; asm volatile("" : "+v"(r31), "+v"(hh));
        unsigned char* rwi = a.ws + WS_RWI + (size_t)((bh * 32) + chunk) * RWI_BYTES;
        { const int mat = wave >> 2, mtile = (wave >> 1) & 1, nt2 = wave & 1; const int tl = 32 * mtile + r31;
          f32x16 acc;
#pragma unroll
          for (int r = 0; r < 16; ++r) acc[r] = 0.f;
#pragma unroll
          for (int ks = 0; ks < 4; ++ks) acc = MFMA32(*(const LAS bf16x8*)(lds + RS_BASE + (tl + 1) * RS_ROWB + (24 + mat * 8 + 2 * ks + hh) * 16), bfr[ks], acc);
          LAS float* dst = (LAS float*)(lds + RC_LWA) + mat * 64 * 68;
#pragma unroll
          for (int r = 0; r < 16; ++r) { const int t2 = 32 * mtile + (r & 3) + 8 * (r >> 2) + 4 * hh; dst[t2 * 68 + 32 * nt2 + r31] = acc[r]; } }
        __syncthreads();
        f32x2 r4[4], kp4[4], kk4v[4], bb4[4], v4[4], cs4[4];
        LAS float* SEG2 = (LAS float*)(lds + RC_AKB);
        const int half = hh, j2 = 2 * r31, tq0 = 8 * wave + 4 * half;
        { const LAS float* LW = (const LAS float*)(lds + RC_LWA); const LAS float* LA = LW + 64 * 68;
#pragma unroll
          for (int q = 0; q < 4; ++q) { const int tl = tq0 + q; const size_t row = rowbase + tl;
              const LAS unsigned char* pc = lds + RS_BASE + (tl + 1) * RS_ROWB + j2 * 2; const LAS unsigned char* pp = lds + RS_BASE + tl * RS_ROWB + j2 * 2;
              const unsigned cr = *(const LAS unsigned*)pc, ck = *(const LAS unsigned*)(pc + 128), cv = *(const LAS unsigned*)(pc + 256);
              const unsigned qr = *(const LAS unsigned*)pp, qk_ = *(const LAS unsigned*)(pp + 128), qv = *(const LAS unsigned*)(pp + 256);
              f32x2 r = {bf_lo(cr), bf_hi(cr)}, k = {bf_lo(ck), bf_hi(ck)}, v = {bf_lo(cv), bf_hi(cv)};
              const f32x2 pr = {bf_lo(qr), bf_hi(qr)}, pk = {bf_lo(qk_), bf_hi(qk_)}, pv = {bf_lo(qv), bf_hi(qv)};
              r += (pr - r) * mur2; k += (pk - k) * muk2; v += (pv - v) * muv2;
              const f32x2 lw = *(const LAS f32x2*)(LW + tl * 68 + j2), la = *(const LAS f32x2*)(LA + tl * 68 + j2);
              const f32x2 xw = w02 + lw, xa = a02 + la;
              const f32x2 ld = {-0.6065306597126334f * sigmoidf_(xw[0]), -0.6065306597126334f * sigmoidf_(xw[1])};
              const f32x2 av = {sigmoidf_(xa[0]), sigmoidf_(xa[1])};
              const f32x2 kkv = k * kk2;
              const float rn = fminf(__builtin_amdgcn_rsqf(half_sum32(kkv[0] * kkv[0] + kkv[1] * kkv[1], half != 0)), 1e12f);
              kk4v[q] = kkv * rn; kp4[q] = k * (1.0f + (av - 1.0f) * ka2); bb4[q] = kk4v[q] * av; r4[q] = r; v4[q] = v;
              const f32x2 rk_ = r * kp4[q] * rk2;
              const float bonus = half_sum32(rk_[0] + rk_[1], half != 0);
              *(unsigned*)(BV + row * 1024 + h * 64 + j2) = cvt_pk_bf16(bonus * v[0], bonus * v[1]);
              cs4[q] = (q == 0) ? ld : cs4[q > 0 ? q - 1 : 0] + ld; }
          *(LAS f32x2*)(SEG2 + (2 * wave + half) * 64 + j2) = cs4[3]; }
        __syncthreads();
        { f32x2 off = {0.f, 0.f}, cL = {0.f, 0.f};
#pragma unroll
          for (int sg = 0; sg < 16; ++sg) { const f32x2 x = *(const LAS f32x2*)(SEG2 + sg * 64 + j2); cL += x; if (sg < 2 * wave + half) off += x; }
          const f32x2 eLtot = {__expf(cL[0]), __expf(cL[1])};
          if (wave == 0 && half == 0) *(f32x2*)(rwi + RWI_LAM + j2 * 4) = eLtot;
          f32x2 ecprev = {__expf(off[0]), __expf(off[1])};
          f32x2 qkT[4], bhT[4], khT[4];
#pragma unroll
          for (int q = 0; q < 4; ++q) { const int tl = tq0 + q; const f32x2 c = off + cs4[q];
              const f32x2 ec = {__expf(c[0]), __expf(c[1])}, ecp = ecprev, enc = {rcpf_(ec[0]), rcpf_(ec[1])}, eL = eLtot * enc; ecprev = ec;
              const f32x2 qk = kk4v[q] * ecp, rt = r4[q] * ec, kt = kp4[q] * enc, bt = bb4[q] * enc;
              *(LAS unsigned*)(lds + RC_QK + (tl * RC_LD + j2) * 2) = cvt_pk_bf16(qk[0], qk[1]); *(LAS unsigned*)(lds + RC_RT + (tl * RC_LD + j2) * 2) = cvt_pk_bf16(rt[0], rt[1]);
              *(LAS unsigned*)(lds + RC_KT + (tl * RC_LD + j2) * 2) = cvt_pk_bf16(kt[0], kt[1]); *(LAS unsigned*)(lds + RC_BT + (tl * RC_LD + j2) * 2) = cvt_pk_bf16(bt[0], bt[1]);
              qkT[q] = qk; bhT[q] = bb4[q] * eL; khT[q] = kp4[q] * eL; }
#pragma unroll
          for (int ch = 0; ch < 2; ++ch) { const int ro = ((j2 + ch) * RC_LD + tq0) * 2;
              *(LAS u32x2*)(lds + RC_QKT + ro) = pack4(qkT[0][ch], qkT[1][ch], qkT[2][ch], qkT[3][ch]); *(LAS u32x2*)(lds + RC_BHT + ro) = pack4(bhT[0][ch], bhT[1][ch], bhT[2][ch], bhT[3][ch]);
              *(LAS u32x2*)(lds + RC_KHT + ro) = pack4(khT[0][ch], khT[1][ch], khT[2][ch], khT[3][ch]); *(LAS u32x2*)(lds + RC_VT + ro) = pack4(v4[0][ch], v4[1][ch], v4[2][ch], v4[3][ch]); } }
        __syncthreads();
        switch (wave) {
            case 0: rwc_stage1_job<0, 0, 0>(lds, r31, hh); rwc_stage1_job<2, 1, 1>(lds, r31, hh); break;
            case 1: rwc_stage1_job<0, 0, 1>(lds, r31, hh); rwc_stage1_job<3, 0, 0>(lds, r31, hh); break;
            case 2: rwc_stage1_job<0, 1, 1>(lds, r31, hh); rwc_stage1_job<3, 0, 1>(lds, r31, hh); break;
            case 3: rwc_stage1_job<1, 0, 0>(lds, r31, hh); rwc_stage1_job<3, 1, 1>(lds, r31, hh); break;
            case 4: rwc_stage1_job<1, 0, 1>(lds, r31, hh); break;
            case 5: rwc_stage1_job<1, 1, 1>(lds, r31, hh); break;
            case 6: rwc_stage1_job<2, 0, 0>(lds, r31, hh); break;
            default: rwc_stage1_job<2, 0, 1>(lds, r31, hh); break;
        }
        __syncthreads();
        LAS float* TF = (LAS float*)(lds + RC_TF); const LAS float* AKB = (const LAS float*)(lds + RC_AKB); LAS float* YS = SEG;
        if (wave == 0) {
            const int I = lane >> 4, jj = lane & 15; float x[16];
#pragma unroll
            for (int r = 0; r < 16; ++r) { float sacc = (r == jj) ? 1.f : 0.f;
#pragma unroll
                for (int q = 0; q < r; ++q) sacc -= AKB[(16 * I + r) * 72 + 16 * I + q] * x[q];
                x[r] = sacc; TF[(16 * I + r) * 72 + 16 * I + jj] = sacc; }
        } else if (wave < 4) {
            const int t2 = tid - 64;
            for (int e = t2; e < 512; e += 192) { const int blk = e >> 8, rr = (e >> 4) & 15, cc = e & 15; TF[(32 * blk + rr) * 72 + 32 * blk + 16 + cc] = 0.f; }
        } else {
            const int mt = (wave >> 1) & 1, nt2 = wave & 1; f32x16 acc;
#pragma unroll
            for (int r = 0; r < 16; ++r) acc[r] = 0.f;
#pragma unroll
            for (int ks = 0; ks < 4; ++ks) if (ks < 2 || mt == 1) acc = MFMA32(lds_frag(lds, RC_AKK, 32 * mt + r31, 16 * ks + 8 * hh), lds_frag(lds, RC_VT, 32 * nt2 + r31, 16 * ks + 8 * hh), acc);
#pragma unroll
            for (int g4 = 0; g4 < 4; ++g4) *(LAS u32x2*)(lds + RC_AVT + ((32 * nt2 + r31) * RC_LD + 32 * mt + 8 * g4 + 4 * hh) * 2) = pack4(acc[4 * g4], acc[4 * g4 + 1], acc[4 * g4 + 2], acc[4 * g4 + 3]);
        }
        __syncthreads();
        { const int pr = tid >> 8, i = (tid >> 4) & 15, jj = tid & 15, ba = 2 * pr, bb = 2 * pr + 1;
          float y = 0.f;
#pragma unroll
          for (int q = 0; q < 16; ++q) y += AKB[(16 * bb + i) * 72 + 16 * ba + q] * TF[(16 * ba + q) * 72 + 16 * ba + jj];
          YS[tid] = y; }
        __syncthreads();
        { const int pr = tid >> 8, i = (tid >> 4) & 15, jj = tid & 15, ba = 2 * pr, bb = 2 * pr + 1; float tv = 0.f;
#pragma unroll
          for (int q = 0; q < 16; ++q) tv -= TF[(16 * bb + i) * 72 + 16 * bb + q] * YS[pr * 256 + q * 16 + jj];
          TF[(16 * bb + i) * 72 + 16 * ba + jj] = tv; }
        __syncthreads();
        { const int i = tid >> 4, j0 = (tid & 15) * 2; float z0 = 0.f, z1 = 0.f;
#pragma unroll 8
          for (int q = 0; q < 32; ++q) { const float av = AKB[(32 + i) * 72 + q]; z0 += av * TF[q * 72 + j0]; z1 += av * TF[q * 72 + j0 + 1]; }
          __syncthreads();
          TF[i * 72 + 32 + j0] = z0; TF[i * 72 + 32 + j0 + 1] = z1; }
        __syncthreads();
        { const int i = tid >> 4, j0 = (tid & 15) * 2; float t0 = 0.f, t1 = 0.f;
#pragma unroll 8
          for (int q = 0; q < 32; ++q) { const float tb = TF[(32 + i) * 72 + 32 + q]; t0 -= tb * TF[q * 72 + 32 + j0]; t1 -= tb * TF[q * 72 + 32 + j0 + 1]; }
          TF[(32 + i) * 72 + j0] = t0; TF[(32 + i) * 72 + j0 + 1] = t1; }
        __syncthreads();
        { const int t = tid >> 3, c0 = (tid & 7) * 8; const f32x4 x0 = *(const LAS f32x4*)(TF + t * 72 + c0), x1 = *(const LAS f32x4*)(TF + t * 72 + c0 + 4);
          u32x4 w; w.x = cvt_pk_bf16(x0[0], x0[1]); w.y = cvt_pk_bf16(x0[2], x0[3]); w.z = cvt_pk_bf16(x1[0], x1[1]); w.w = cvt_pk_bf16(x1[2], x1[3]);
          *(LAS u32x4*)(lds + RC_TB + (t * RC_LD + c0) * 2) = w; }
        __syncthreads();
        { const int which = wave >> 2, mt = (wave >> 1) & 1, nt2 = wave & 1; const int Bm = which ? RC_AVT : RC_QKT, Dm = which ? RC_U1T : RC_W1T; f32x16 acc;
#pragma unroll
          for (int r = 0; r < 16; ++r) acc[r] = 0.f;
#pragma unroll
          for (int ks = 0; ks < 4; ++ks) if (ks < 2 || mt == 1) acc = MFMA32(lds_frag(lds, RC_TB, 32 * mt + r31, 16 * ks + 8 * hh), lds_frag(lds, Bm, 32 * nt2 + r31, 16 * ks + 8 * hh), acc);
#pragma unroll
          for (int g4 = 0; g4 < 4; ++g4) *(LAS u32x2*)(lds + Dm + ((32 * nt2 + r31) * RC_LD + 32 * mt + 8 * g4 + 4 * hh) * 2) = pack4(acc[4 * g4], acc[4 * g4 + 1], acc[4 * g4 + 2], acc[4 * g4 + 3]); }
        __syncthreads();
        { const int kind = wave >> 2, mt = (wave >> 1) & 1, nt2 = wave & 1; const int cidx = 32 * nt2 + r31;
          f32x16 acc;
#pragma unroll
          for (int r = 0; r < 16; ++r) acc[r] = 0.f;
          if (kind == 0) {
#pragma unroll
              for (int ks = 0; ks < 4; ++ks) acc = MFMA32(lds_frag(lds, RC_W1T, 32 * mt + r31, 16 * ks + 8 * hh), lds_frag(lds, RC_BHT, cidx, 16 * ks + 8 * hh), acc);
#pragma unroll
              for (int g4 = 0; g4 < 4; ++g4) { const int jo = 8 * g4 + 4 * hh, half = jo >> 4, q2 = (jo & 15) >> 2; const int blk = (cidx >> 4) * 2 + mt, lane2 = (cidx & 15) + 16 * q2;
                  *(u32x2*)(rwi + RWI_GF + (blk * 64 + lane2) * 16 + half * 8) = pack4(-acc[4 * g4], -acc[4 * g4 + 1], -acc[4 * g4 + 2], -acc[4 * g4 + 3]); }
          } else {
#pragma unroll
              for (int ks = 0; ks < 4; ++ks) if (ks < 2 || nt2 == 1) acc = MFMA32(lds_frag(lds, RC_W1T, 32 * mt + r31, 16 * ks + 8 * hh), lds_frag(lds, RC_ARB, cidx, 16 * ks + 8 * hh), acc);
#pragma unroll
              for (int g4 = 0; g4 < 4; ++g4) { const int jo = 8 * g4 + 4 * hh, half = jo >> 4, q2 = (jo & 15) >> 2; const int blk = (cidx >> 4) * 2 + mt, lane2 = (cidx & 15) + 16 * q2;
                  const u32x2 rt = *(const LAS u32x2*)(lds + RC_RT + (cidx * RC_LD + 32 * mt + jo) * 2);
                  *(u32x2*)(rwi + RWI_W2F + (blk * 64 + lane2) * 16 + half * 8) = pack4(bf_lo(rt.x) - acc[4 * g4], bf_hi(rt.x) - acc[4 * g4 + 1], bf_lo(rt.y) - acc[4 * g4 + 2], bf_hi(rt.y) - acc[4 * g4 + 3]); }
          }
          f32x16 ac1, ac2;
#pragma unroll
          for (int r = 0; r < 16; ++r) { ac1[r] = 0.f; ac2[r] = 0.f; }
          if (kind == 0) {
#pragma unroll
              for (int ks = 0; ks < 4; ++ks) { ac1 = MFMA32(lds_frag(lds, RC_KHT, 32 * mt + r31, 16 * ks + 8 * hh), lds_frag(lds, RC_VT, cidx, 16 * ks + 8 * hh), ac1);
                                               ac2 = MFMA32(lds_frag(lds, RC_BHT, 32 * mt + r31, 16 * ks + 8 * hh), lds_frag(lds, RC_U1T, cidx, 16 * ks + 8 * hh), ac2); }
#pragma unroll
              for (int g4 = 0; g4 < 4; ++g4) { const int ro = 32 * mt + 8 * g4 + 4 * hh, mt2 = ro >> 4, q2 = (ro & 15) >> 2, cb = cidx >> 4, lane2 = (cidx & 15) + 16 * q2;
                  *(f32x4*)(rwi + RWI_H1F + ((cb * 4 + mt2) * 64 + lane2) * 16) = (f32x4){ac1[4 * g4] - ac2[4 * g4], ac1[4 * g4 + 1] - ac2[4 * g4 + 1], ac1[4 * g4 + 2] - ac2[4 * g4 + 2], ac1[4 * g4 + 3] - ac2[4 * g4 + 3]}; }
          } else {
#pragma unroll
              for (int ks = 0; ks < 4; ++ks) if (ks < 2 || nt2 == 1) { ac1 = MFMA32(lds_frag(lds, RC_VT, 32 * mt + r31, 16 * ks + 8 * hh), lds_frag(lds, RC_ARK, cidx, 16 * ks + 8 * hh), ac1);
                                                                        ac2 = MFMA32(lds_frag(lds, RC_U1T, 32 * mt + r31, 16 * ks + 8 * hh), lds_frag(lds, RC_ARB, cidx, 16 * ks + 8 * hh), ac2); }
#pragma unroll
              for (int g4 = 0; g4 < 4; ++g4) { const int ro = 32 * mt + 8 * g4 + 4 * hh, cb = ro >> 4, q2 = (ro & 15) >> 2, nt3 = cidx >> 4, lane2 = (cidx & 15) + 16 * q2;
                  *(f32x4*)(rwi + RWI_O1F + ((cb * 4 + nt3) * 64 + lane2) * 16) = (f32x4){ac1[4 * g4] - ac2[4 * g4], ac1[4 * g4 + 1] - ac2[4 * g4 + 1], ac1[4 * g4 + 2] - ac2[4 * g4 + 2], ac1[4 * g4 + 3] - ac2[4 * g4 + 3]}; }
          } }
        __syncthreads();
    }
}

__device__ __forceinline__ void p3_rwkv_seq(const Args& a, int unit, int lane) {
    const int bh = unit >> 2, cb = unit & 3, l15 = lane & 15, q = lane >> 4;
    f32x4 hacc[4];
#pragma unroll
    for (int m = 0; m < 4; ++m) hacc[m] = (f32x4){0.f, 0.f, 0.f, 0.f};
    const unsigned char* base = a.ws + WS_RWI + (size_t)(bh * 32) * RWI_BYTES;
    unsigned char* hbo = a.ws + WS_HB + (size_t)unit * 32 * 2048;
    bf16x8 gfA[8], gfB[8]; f32x4 h1A[4], h1B[4], lamA[4], lamB[4];
#define RW2_LOADG(gf, h1, lam, src) do { _Pragma("unroll") for (int k2 = 0; k2 < 8; ++k2) gf[k2] = *(const bf16x8*)((src) + RWI_GF + (k2 * 64 + lane) * 16); \
        _Pragma("unroll") for (int m = 0; m < 4; ++m) { h1[m] = *(const f32x4*)((src) + RWI_H1F + ((cb * 4 + m) * 64 + lane) * 16); lam[m] = *(const f32x4*)((src) + RWI_LAM + (16 * m + 4 * q) * 4); } } while (0)
#define RW2_STEP(c_, gf, h1, lam) do { const int c = (c_); \
        bf16x8 hb[2]; \
        _Pragma("unroll") for (int ks = 0; ks < 2; ++ks) { u32x4 t; t.x = cvt_pk_bf16(hacc[2 * ks][0], hacc[2 * ks][1]); t.y = cvt_pk_bf16(hacc[2 * ks][2], hacc[2 * ks][3]); \
            t.z = cvt_pk_bf16(hacc[2 * ks + 1][0], hacc[2 * ks + 1][1]); t.w = cvt_pk_bf16(hacc[2 * ks + 1][2], hacc[2 * ks + 1][3]); hb[ks] = __builtin_bit_cast(bf16x8, t); \
            *(bf16x8*)(hbo + (size_t)c * 2048 + (ks * 64 + lane) * 16) = hb[ks]; } \
        _Pragma("unroll") for (int m = 0; m < 4; ++m) { f32x4 nacc = h1[m] + lam[m] * hacc[m]; \
            _Pragma("unroll") for (int ks = 0; ks < 2; ++ks) nacc = MFMA16(gf[m * 2 + ks], hb[ks], nacc); hacc[m] = nacc; } \
        if (c + 2 < 32) RW2_LOADG(gf, h1, lam, base + (size_t)(c + 2) * RWI_BYTES); } while (0)
    RW2_LOADG(gfA, h1A, lamA, base); RW2_LOADG(gfB, h1B, lamB, base + RWI_BYTES);
#pragma unroll 1
    for (int c2 = 0; c2 < 32; c2 += 2) { RW2_STEP(c2, gfA, h1A, lamA); RW2_STEP(c2 + 1, gfB, h1B, lamB); }
#undef RW2_STEP
#undef RW2_LOADG
#pragma unroll
    for (int m = 0; m < 4; ++m) *(f32x4*)(a.out + OUT_WKV_P + (((size_t)bh * 64 + 16 * cb + l15) * 64 + 16 * m + 4 * q)) = hacc[m];
}
__device__ __forceinline__ void p5_rwkv_out(const Args& a, int item, int lane) {
    const int bh = item >> 5, c = item & 31, b = bh >> 4, h = bh & 15, l15 = lane & 15, q = lane >> 4;
    const unsigned char* cur = a.ws + WS_RWI + (size_t)item * RWI_BYTES;
    const bf16_t* BV = (const bf16_t*)((const unsigned char*)a.out + DO_BV);
    const bf16_t* P = (const bf16_t*)(a.ws + WS_P); bf16_t* A2 = (bf16_t*)(a.ws + WS_XN);
    bf16x8 hb[4][2], w2f[8];
#pragma unroll
    for (int cb = 0; cb < 4; ++cb)
#pragma unroll
        for (int ks = 0; ks < 2; ++ks) hb[cb][ks] = *(const bf16x8*)(a.ws + WS_HB + ((size_t)(bh * 4 + cb) * 32 + c) * 2048 + (ks * 64 + lane) * 16);
#pragma unroll
    for (int k2 = 0; k2 < 8; ++k2) w2f[k2] = *(const bf16x8*)(cur + RWI_W2F + (k2 * 64 + lane) * 16);
    f32x4 gw[4], gb[4];
#pragma unroll
    for (int cb = 0; cb < 4; ++cb) { gw[cb] = *(const f32x4*)(a.in[I_GNW] + h * 64 + 16 * cb + 4 * q); gb[cb] = *(const f32x4*)(a.in[I_GNB] + h * 64 + 16 * cb + 4 * q); }
#pragma unroll
    for (int n = 0; n < 4; ++n) {
        const size_t row = (size_t)b * SEQ + c * 64 + 16 * n + l15;
        f32x4 o[4]; u32x2 bvw[4], zw[4];
#pragma unroll
        for (int cb = 0; cb < 4; ++cb) { o[cb] = *(const f32x4*)(cur + RWI_O1F + ((cb * 4 + n) * 64 + lane) * 16);
            bvw[cb] = *(const u32x2*)(BV + row * 1024 + h * 64 + 16 * cb + 4 * q); zw[cb] = *(const u32x2*)(P + row * LDP + PC_ZR + h * 64 + 16 * cb + 4 * q); }
#pragma unroll
        for (int cb = 0; cb < 4; ++cb)
#pragma unroll
            for (int ks = 0; ks < 2; ++ks) o[cb] = MFMA16(hb[cb][ks], w2f[n * 2 + ks], o[cb]);
        float sm = 0.f;
#pragma unroll
        for (int cb = 0; cb < 4; ++cb) sm += (o[cb][0] + o[cb][1]) + (o[cb][2] + o[cb][3]);
        sm += __shfl_xor(sm, 16); sm += __shfl_xor(sm, 32);
        const float mean = sm * (1.0f / 64.0f); float sq = 0.f;
#pragma unroll
        for (int cb = 0; cb < 4; ++cb) { o[cb] = o[cb] - mean; sq += (o[cb][0] * o[cb][0] + o[cb][1] * o[cb][1]) + (o[cb][2] * o[cb][2] + o[cb][3] * o[cb][3]); }
        sq += __shfl_xor(sq, 16); sq += __shfl_xor(sq, 32);
        const float rstd = rsqrtf(sq * (1.0f / 64.0f) + GN_EPS);
#pragma unroll
        for (int cb = 0; cb < 4; ++cb) {
            const float r0 = (o[cb][0] * rstd * gw[cb][0] + gb[cb][0] + bf_lo(bvw[cb].x)) * bf_lo(zw[cb].x), r1 = (o[cb][1] * rstd * gw[cb][1] + gb[cb][1] + bf_hi(bvw[cb].x)) * bf_hi(zw[cb].x);
            const float r2 = (o[cb][2] * rstd * gw[cb][2] + gb[cb][2] + bf_lo(bvw[cb].y)) * bf_lo(zw[cb].y), r3 = (o[cb][3] * rstd * gw[cb][3] + gb[cb][3] + bf_hi(bvw[cb].y)) * bf_hi(zw[cb].y);
            *(u32x2*)(A2 + row * 2048 + 1024 + h * 64 + 16 * cb + 4 * q) = pack4(r0, r1, r2, r3); }
    }
}

__device__ __forceinline__ void p3_rwkv_sample(const Args& a, LAS unsigned char* lds, int bs, int h, int wave, int lane) {
    LAS float* Lw = (LAS float*)lds + wave * 768;
    const bf16_t* P = (const bf16_t*)(a.ws + WS_P);
    const bf16_t* pc = P + (size_t)(MP + bs) * LDP; const bf16_t* pp = P + (size_t)(MV + bs) * LDP;
    bf16_t* A2 = (bf16_t*)(a.ws + WS_XN);
    const float* mu = a.in[I_MU];
    const int hj = h * 64 + lane, rg = lane >> 4, cq = lane & 15;
    const size_t sbase = ((size_t)(bs * 16 + h) * 64) * 64;
    const float* S0 = a.in[I_WKV] + sbase; float* S1 = a.out + OUT_WKV_S + sbase;
    f32x4 S[16];
#pragma unroll
    for (int it = 0; it < 16; ++it) S[it] = *(const f32x4*)(S0 + (size_t)(4 * it + rg) * 64 + 4 * cq);
    { float wd = bf2f(pc[PC_WD + lane]), ad = bf2f(pc[PC_AD + lane]); wd += (bf2f(pp[PC_WD + lane]) - wd) * mu[3072 + lane]; ad += (bf2f(pp[PC_AD + lane]) - ad) * mu[3136 + lane];
      Lw[lane] = tanhf_(wd); Lw[64 + lane] = ad; }
    LDS_WAIT();
    float lw = 0.f, la = 0.f;
#pragma unroll 16
    for (int m = 0; m < 64; ++m) { lw += Lw[m] * a.in[I_W2][(size_t)m * 1024 + hj]; la += Lw[64 + m] * a.in[I_A2][(size_t)m * 1024 + hj]; }
    float r = bf2f(pc[PC_R + hj]), k = bf2f(pc[PC_K + hj]), v = bf2f(pc[PC_V + hj]);
    r += (bf2f(pp[PC_R + hj]) - r) * mu[hj]; k += (bf2f(pp[PC_K + hj]) - k) * mu[1024 + hj]; v += (bf2f(pp[PC_V + hj]) - v) * mu[2048 + hj];
    const RwTok o = rw_token(a, hj, r, k, v, lw, la);
    Lw[128 + lane] = o.kk; Lw[192 + lane] = o.dr; Lw[256 + lane] = o.dd; Lw[320 + lane] = o.bb; Lw[384 + lane] = o.kp; Lw[448 + lane] = o.v;
    LDS_WAIT();
    const f32x4 kk4 = *(const LAS f32x4*)(Lw + 128 + 4 * cq), dr4 = *(const LAS f32x4*)(Lw + 192 + 4 * cq), d4 = *(const LAS f32x4*)(Lw + 256 + 4 * cq), b4 = *(const LAS f32x4*)(Lw + 320 + 4 * cq), k4 = *(const LAS f32x4*)(Lw + 384 + 4 * cq);
#pragma unroll
    for (int it = 0; it < 16; ++it) { const int i = 4 * it + rg; const float vi = Lw[448 + i];
        float p1 = (S[it][0] * kk4[0] + S[it][1] * kk4[1]) + (S[it][2] * kk4[2] + S[it][3] * kk4[3]);
        float p2 = (S[it][0] * dr4[0] + S[it][1] * dr4[1]) + (S[it][2] * dr4[2] + S[it][3] * dr4[3]);
        p1 = row16_sum(p1); p2 = row16_sum(p2);
        const float sa = -p1, ov = p2 + sa * o.br + vi * o.kr;
        f32x4 Sn;
#pragma unroll
        for (int j = 0; j < 4; ++j) Sn[j] = S[it][j] * d4[j] + sa * b4[j] + vi * k4[j];
        *(f32x4*)(S1 + (size_t)i * 64 + 4 * cq) = Sn;
        if (cq == 0) Lw[512 + i] = ov; }
    LDS_WAIT();
    const float ov = Lw[512 + lane];
    const float mean = wave_sum_dpp(ov) * (1.0f / 64.0f); const float dv = ov - mean; const float var = wave_sum_dpp(dv * dv) * (1.0f / 64.0f);
    float on = dv * rsqrtf(var + GN_EPS) * a.in[I_GNW][hj] + a.in[I_GNB][hj] + o.bonus * o.v;
    on *= bf2f(pc[PC_ZR + hj]);
    A2[(size_t)(MP + bs) * 2048 + 1024 + hj] = f2bf(on);
    LDS_WAIT();
}

constexpr int S5_ELD = 132, S5_XLD = 136;
constexpr int S5_E_OFF = 0, S5_X_OFF = 128 * S5_ELD * 4;
__device__ __forceinline__ bf16x8 ldfrag(const unsigned char* base, int block, int lane) { return *(const bf16x8*)(base + (size_t)block * 1024 + lane * 16); }
__device__ __forceinline__ void p3_s5_prompt(const Args& a, LAS unsigned char* lds, int unit, int tid, int wave, int lane) {
    const int b = unit >> 6, g = unit & 63;
    const unsigned char* tab = (const unsigned char*)a.out + DO_S5TAB + (size_t)g * S5T_BYTES;
    const bf16_t* P = (const bf16_t*)(a.ws + WS_P);
    bf16_t* Yg = (bf16_t*)(a.ws + WS_YG);
    LAS float* EL = (LAS float*)(lds + S5_E_OFF); LAS bf16_t* XL = (LAS bf16_t*)(lds + S5_X_OFF);
    const int nt = wave & 3, hm = wave >> 2, r31 = lane & 31, hh = lane >> 5;
    const int n = 32 * nt + r31;
    { u32x4 tv[10];
#pragma unroll
      for (int i = 0; i < 10; ++i) tv[i] = *(const u32x4*)(tab + S5T_ME + (size_t)(tid + 512 * i) * 16);
#pragma unroll
      for (int i = 0; i < 10; ++i) *(LAS u32x4*)(lds + (tid + 512 * i) * 16) = tv[i]; }
    const bf16_t* ubase = (const bf16_t*)(a.ws + WS_U2) + (((size_t)b * 64 + g) * SEQ + 16 * n) * 16 + 8 * hh;
    bf16x8 bu[16];
#pragma unroll
    for (int s2 = 0; s2 < 16; ++s2) bu[s2] = *(const bf16x8*)(ubase + (size_t)s2 * 16);
    f32x16 accY[4], accE[2];
#pragma unroll
    for (int q = 0; q < 4; ++q)
#pragma unroll
        for (int r = 0; r < 16; ++r) accY[q][r] = 0.f;
#pragma unroll
    for (int q = 0; q < 2; ++q)
#pragma unroll
        for (int r = 0; r < 16; ++r) accE[q][r] = 0.f;
    const int mts[4] = {hm ? 1 : 0, hm ? 2 : 3, hm ? 5 : 4, hm ? 6 : 7};
    __syncthreads();
#pragma unroll
    for (int s2 = 0; s2 < 16; ++s2) {
#pragma unroll
        for (int e = 0; e < 2; ++e) accE[e] = __builtin_amdgcn_mfma_f32_32x32x16_bf16(*(const LAS bf16x8*)(lds + S5T_ME + (((2 * hm + e) * 16 + s2) * 64 + lane) * 16), bu[s2], accE[e], 0, 0, 0);
#pragma unroll
        for (int q = 0; q < 4; ++q) { const int mt = mts[q]; if (s2 <= 2 * mt + 1) accY[q] = __builtin_amdgcn_mfma_f32_32x32x16_bf16(*(const LAS bf16x8*)(lds + S5T_KT + ((2 * mt - s2 + 1) * 64 + lane) * 16), bu[s2], accY[q], 0, 0, 0); }
    }
    __syncthreads();
#pragma unroll
    for (int e = 0; e < 2; ++e)
#pragma unroll
        for (int q4 = 0; q4 < 4; ++q4) { f32x4 v; v[0] = accE[e][4 * q4]; v[1] = accE[e][4 * q4 + 1]; v[2] = accE[e][4 * q4 + 2]; v[3] = accE[e][4 * q4 + 3];
            *(LAS f32x4*)(EL + n * S5_ELD + 32 * (2 * hm + e) + 8 * q4 + 4 * hh) = v; }
    __syncthreads();
    if (wave == 0) { const float* hdr = (const float*)(tab + S5T_HDR); const float ar = hdr[lane], ai = hdr[64 + lane]; float xr = 0.f, xi = 0.f;
#pragma unroll 1
        for (int c0 = 0; c0 < 128; c0 += 16) { float er[16], ei[16];
#pragma unroll
            for (int j = 0; j < 16; ++j) { er[j] = EL[(c0 + j) * S5_ELD + lane]; ei[j] = EL[(c0 + j) * S5_ELD + 64 + lane]; }
#pragma unroll
            for (int j = 0; j < 16; ++j) { XL[(c0 + j) * S5_XLD + lane] = f2bf(xr); XL[(c0 + j) * S5_XLD + 64 + lane] = f2bf(xi);
                const float nr = ar * xr - ai * xi + er[j], ni = ar * xi + ai * xr + ei[j]; xr = nr; xi = ni; } }
        a.out[OUT_S5RE_P + (size_t)(b * 64 + g) * 64 + lane] = xr; a.out[OUT_S5IM_P + (size_t)(b * 64 + g) * 64 + lane] = xi; }
    __syncthreads();
#pragma unroll
    for (int ks = 0; ks < 8; ++ks) { const bf16x8 bx = *(const LAS bf16x8*)(XL + n * S5_XLD + 16 * ks + 8 * hh);
#pragma unroll
        for (int q = 0; q < 4; ++q) accY[q] = __builtin_amdgcn_mfma_f32_32x32x16_bf16(ldfrag(tab + S5T_CA, mts[q] * 8 + ks, lane), bx, accY[q], 0, 0, 0); }
#pragma unroll
    for (int q = 0; q < 4; ++q) { const int mt = mts[q];
#pragma unroll
        for (int q4 = 0; q4 < 4; ++q4) { const int dt = q4 >> 1, c0 = 8 * (q4 & 1) + 4 * hh; const size_t row = (size_t)b * SEQ + 16 * n + 2 * mt + dt;
            u32x2 w; w.x = cvt_pk_bf16(geluf_(accY[q][4 * q4]), geluf_(accY[q][4 * q4 + 1])); w.y = cvt_pk_bf16(geluf_(accY[q][4 * q4 + 2]), geluf_(accY[q][4 * q4 + 3]));
            *(u32x2*)(Yg + row * 1024 + g * 16 + c0) = w; } }
    __syncthreads();
}
__device__ __forceinline__ void p3_s5_sample(const Args& a, int g, int wave, int lane) {
    if (wave >= 4) return;
    const unsigned char* tab = (const unsigned char*)a.out + DO_S5TAB + (size_t)g * S5T_BYTES;
    const float* hdr = (const float*)(tab + S5T_HDR);
    const bf16_t* P = (const bf16_t*)(a.ws + WS_P);
    bf16_t* Yg = (bf16_t*)(a.ws + WS_YG);
    const int r31 = lane & 31, hh = lane >> 5, bs = 32 * wave + r31;
    const bf16x8 bu = *(const bf16x8*)((const bf16_t*)(a.ws + WS_U2S) + ((size_t)g * NSMP + bs) * 16 + 8 * hh);
    f32x16 z;
#pragma unroll
    for (int r = 0; r < 16; ++r) z[r] = 0.f;
    f32x16 x[4];
#pragma unroll
    for (int mtile = 0; mtile < 4; ++mtile) x[mtile] = __builtin_amdgcn_mfma_f32_32x32x16_bf16(ldfrag(tab + S5T_ME, mtile * 16 + 15, lane), bu, z, 0, 0, 0);
    const size_t sb = (size_t)(bs * 64 + g) * 64;
#pragma unroll
    for (int pt = 0; pt < 2; ++pt)
#pragma unroll
        for (int q4 = 0; q4 < 4; ++q4) { const int p0 = 32 * pt + 8 * q4 + 4 * hh;
            const f32x4 x0r = *(const f32x4*)(a.in[I_S5RE] + sb + p0), x0i = *(const f32x4*)(a.in[I_S5IM] + sb + p0);
            const f32x4 ar = *(const f32x4*)(hdr + 128 + p0), ai = *(const f32x4*)(hdr + 192 + p0);
            f32x4 nr, ni;
#pragma unroll
            for (int j = 0; j < 4; ++j) { nr[j] = ar[j] * x0r[j] - ai[j] * x0i[j] + x[pt][4 * q4 + j]; ni[j] = ar[j] * x0i[j] + ai[j] * x0r[j] + x[2 + pt][4 * q4 + j]; x[pt][4 * q4 + j] = nr[j]; x[2 + pt][4 * q4 + j] = ni[j]; }
            *(f32x4*)(a.out + OUT_S5RE_S + sb + p0) = nr; *(f32x4*)(a.out + OUT_S5IM_S + sb + p0) = ni; }
    f32x16 y = __builtin_amdgcn_mfma_f32_32x32x16_bf16(ldfrag(tab + S5T_DF, 0, lane), bu, z, 0, 0, 0);
#pragma unroll
    for (int mtile = 0; mtile < 4; ++mtile)
#pragma unroll
        for (int sp = 0; sp < 2; ++sp) { u32x4 t; t.x = cvt_pk_bf16(x[mtile][8 * sp], x[mtile][8 * sp + 1]); t.y = cvt_pk_bf16(x[mtile][8 * sp + 2], x[mtile][8 * sp + 3]);
            t.z = cvt_pk_bf16(x[mtile][8 * sp + 4], x[mtile][8 * sp + 5]); t.w = cvt_pk_bf16(x[mtile][8 * sp + 6], x[mtile][8 * sp + 7]);
            y = __builtin_amdgcn_mfma_f32_32x32x16_bf16(ldfrag(tab + S5T_C0, mtile * 2 + sp, lane), __builtin_bit_cast(bf16x8, t), y, 0, 0, 0); }
#pragma unroll
    for (int q4 = 0; q4 < 2; ++q4) { const int c0 = 8 * q4 + 4 * hh;
        u32x2 w; w.x = cvt_pk_bf16(geluf_(y[4 * q4]), geluf_(y[4 * q4 + 1])); w.y = cvt_pk_bf16(geluf_(y[4 * q4 + 2]), geluf_(y[4 * q4 + 3]));
        *(u32x2*)(Yg + (size_t)(MP + bs) * 1024 + g * 16 + c0) = w; }
}

__device__ __forceinline__ void p4_rwkv_post8(const Args& a, int item0, int lane) {
    const int item = item0 + (lane >> 3), cg = lane & 7, row = item >> 4, h = item & 15, ch = h * 64 + 8 * cg;
    const bf16_t* ORAW = (const bf16_t*)((const unsigned char*)a.out + DO_ORAW); const bf16_t* BV = (const bf16_t*)((const unsigned char*)a.out + DO_BV);
    const bf16_t* P = (const bf16_t*)(a.ws + WS_P); bf16_t* A2 = (bf16_t*)(a.ws + WS_XN);
    const u32x4 ow = *(const u32x4*)(ORAW + (size_t)row * 1024 + ch), bw = *(const u32x4*)(BV + (size_t)row * 1024 + ch), zw = *(const u32x4*)(P + (size_t)row * LDP + PC_ZR + ch);
    const f32x4 w0 = *(const f32x4*)(a.in[I_GNW] + ch), w1 = *(const f32x4*)(a.in[I_GNW] + ch + 4), b0 = *(const f32x4*)(a.in[I_GNB] + ch), b1 = *(const f32x4*)(a.in[I_GNB] + ch + 4);
    const float o[8] = {bf_lo(ow.x), bf_hi(ow.x), bf_lo(ow.y), bf_hi(ow.y), bf_lo(ow.z), bf_hi(ow.z), bf_lo(ow.w), bf_hi(ow.w)};
    const float bv[8] = {bf_lo(bw.x), bf_hi(bw.x), bf_lo(bw.y), bf_hi(bw.y), bf_lo(bw.z), bf_hi(bw.z), bf_lo(bw.w), bf_hi(bw.w)};
    const float z[8] = {bf_lo(zw.x), bf_hi(zw.x), bf_lo(zw.y), bf_hi(zw.y), bf_lo(zw.z), bf_hi(zw.z), bf_lo(zw.w), bf_hi(zw.w)};
    const float gw[8] = {w0[0], w0[1], w0[2], w0[3], w1[0], w1[1], w1[2], w1[3]}, gb[8] = {b0[0], b0[1], b0[2], b0[3], b1[0], b1[1], b1[2], b1[3]};
    float sm = ((o[0] + o[1]) + (o[2] + o[3])) + ((o[4] + o[5]) + (o[6] + o[7]));
    sm += dpp_f<0xB1>(sm); sm += dpp_f<0x4E>(sm); sm += dpp_f<0x141>(sm);
    const float mean = sm * (1.0f / 64.0f); float d[8], sq = 0.f;
#pragma unroll
    for (int j = 0; j < 8; ++j) { d[j] = o[j] - mean; sq += d[j] * d[j]; }
    sq += dpp_f<0xB1>(sq); sq += dpp_f<0x4E>(sq); sq += dpp_f<0x141>(sq);
    const float rstd = rsqrtf(sq * (1.0f / 64.0f) + GN_EPS); float r[8];
#pragma unroll
    for (int j = 0; j < 8; ++j) r[j] = (d[j] * rstd * gw[j] + gb[j] + bv[j]) * z[j];
    u32x4 w; w.x = cvt_pk_bf16(r[0], r[1]); w.y = cvt_pk_bf16(r[2], r[3]); w.z = cvt_pk_bf16(r[4], r[5]); w.w = cvt_pk_bf16(r[6], r[7]);
    *(u32x4*)(A2 + (size_t)row * 2048 + 1024 + ch) = w;
}

__device__ __forceinline__ void p6_row(const Args& a, int m, int lane) {
    float* y = a.out + (size_t)m * DM; const float* fg = a.in[I_FINALG];
    if (m < MP) {
        const float* rs = (const float*)(a.ws + WS_ROWSS) + (size_t)m * 32;
        const float ss = wave_sum(rs[lane & 31]) * 0.5f;
        const float rstd = rsqrtf(ss * (1.0f / DM) + RMS_EPS);
#pragma unroll
        for (int j = 0; j < 8; ++j) { const int k = 4 * lane + 256 * j; f32x4 v = *(const f32x4*)(y + k); const f32x4 gv = *(const f32x4*)(fg + k);
#pragma unroll
            for (int q = 0; q < 4; ++q) v[q] = v[q] * rstd * gv[q];
            *(f32x4*)(y + k) = v; }
    } else {
        const int r = m - MP; const float* slab = (const float*)(a.ws + WS_SLAB) + (size_t)r * DM; const float* x = a.in[I_XS] + (size_t)r * DM;
        const float* gtrow = (const float*)(a.ws + WS_MOD) + (size_t)(NB + r) * NMOD + 2 * DM;
        f32x4 v[8]; float ss = 0.f;
#pragma unroll
        for (int j = 0; j < 8; ++j) { const int k = 4 * lane + 256 * j; f32x4 mix = *(const f32x4*)(slab + k);
#pragma unroll
            for (int s2 = 1; s2 < 8; ++s2) mix += *(const f32x4*)(slab + (size_t)s2 * NSMP * DM + k);
            const f32x4 xv = *(const f32x4*)(x + k), gt = *(const f32x4*)(gtrow + k);
#pragma unroll
            for (int q = 0; q < 4; ++q) { v[j][q] = xv[q] + gt[q] * mix[q]; ss += v[j][q] * v[j][q]; } }
        const float rstd = rsqrtf(wave_sum(ss) * (1.0f / DM) + RMS_EPS);
#pragma unroll
        for (int j = 0; j < 8; ++j) { const int k = 4 * lane + 256 * j; const f32x4 gv = *(const f32x4*)(fg + k); f32x4 o;
#pragma unroll
            for (int q = 0; q < 4; ++q) o[q] = v[j][q] * rstd * gv[q];
            *(f32x4*)(y + k) = o; }
    }
}

__global__ void __launch_bounds__(512, 2) fwd_kernel(Args args) {
    extern __shared__ __attribute__((aligned(16))) unsigned char lds_raw[];
    LAS unsigned char* lds = (LAS unsigned char*)lds_raw;
    const int tid = threadIdx.x, lane = tid & 63, wave = __builtin_amdgcn_readfirstlane(tid >> 6);
    const int G = gridDim.x, bx = blockIdx.x;
    const int vcu = (G % 8 == 0) ? (bx % 8) * (G / 8) + bx / 8 : bx;
    volatile LAS unsigned* MISC = (volatile LAS unsigned*)(lds + MISC_OFF);
    for (int u = tid; u < (LDS_BYTES - LDSCTL_OFF) / 4; u += 512) ((LAS unsigned*)(lds + LDSCTL_OFF))[u] = 0u;
    __syncthreads();
    unsigned* ctl = (unsigned*)(args.ws + WS_CTL);
    XcdBarrier bar; bar.bar = ctl + CW_BAR + args.li * XCD_BAR_WORDS; bar.x = 0; bar.st = nullptr;
    const bool multi = (args.ph_hi - args.ph_lo) > 1;
    if (multi) bar = xcd_barrier_post(ctl + CW_BAR + args.li * XCD_BAR_WORDS, MISC + 8);
    const int lo = args.ph_lo, hi = args.ph_hi;
#define IN(k) (lo <= (k) && (k) < hi)
#define SEAM(k) do { if (IN(k) && IN((k) + 1)) xcd_barrier(bar); } while (0)
    const int gw = vcu * 8 + wave, NGW = G * 8;

    if (IN(0)) {
        if (vcu < 192) p0_mod(args, lds, vcu, wave, lane);
        else if (vcu - 192 < 64) { p0_s5_tables(args, lds, vcu - 192, tid);
            LAS float* scr = (LAS float*)(lds + wave * 16384);
            for (int it = (vcu - 192) * 8 + wave; it < 2048 + 512; it += 64 * 8) {
                if (it < 2048) { const int nb = it >> 5, kb = it & 31; transpose_item(args.in[I_WOUT], 2048, 2048, 32 * nb, (bf16_t*)(args.ws + WS_WOUT_T), 32 * nb, 64 * kb, scr, lane, false); }
                else { const int i2 = it - 2048, nb = i2 >> 4, kb = i2 & 15; transpose_item(args.in[I_WGLU], 1024, 1024, 32 * nb, (bf16_t*)(args.ws + WS_WGLU_T), 32 * nb, 64 * kb, scr, lane, false); } } }
    }
    SEAM(0);
    if (IN(1)) {
        { LAS float* scr = (LAS float*)(lds + wave * 16384);
          bf16_t* WT = (bf16_t*)(args.ws + WS_WT);
          for (int it = gw; it < 328 * 32; it += NGW) { const int nb = it >> 5, kb = it & 31; const int p0 = 32 * nb;
              const int src = (p0 < 5120) ? p0 : ((p0 < 10240) ? p0 + 128 : p0 - 5120);
              transpose_item(args.in[I_WIN], NIN, 2048, src, WT, p0, 64 * kb, scr, lane, p0 >= NIN); } }
        for (int m = gw; m < MT; m += NGW) p1_row(args, m, lane);
    }
    SEAM(1);
    const bool tail_mode = (G == 256);
    if (IN(2)) {
        pg8::Gemm g{(const bf16_t*)(args.ws + WS_XN), (const bf16_t*)(args.ws + WS_WT), 2048, 2048};
        EpiP E{(bf16_t*)(args.ws + WS_P), tail_mode, (bf16_t*)(args.ws + WS_U2)};
        if (tail_mode) {
            pg8::TailOrder S; S.init2(G, bx, ctl + CW_TILE);
            pg8::gemm_phase<EpiP, pg8::TailOrder, GEMM_ALIGN, GEMM_SP2>(lds, g, S, E);
            if (bx >= 73) {
                const int t = bx - 73;
                for (int u = t; u < 256; u += 183) { wait_count(ctl + CW_TILE + 64 * ((u >> 6) * 4 + ((u & 63) >> 4)), 64u, wave); p3_s5_prompt(args, lds, u, tid, wave, lane); }
                if (t >= 146 && t < 178) { const int pm2 = t - 146;
                    wait_count(ctl + CW_TILE + 64 * (57 + pm2), 8u, wave); if (pm2 & 7) wait_count(ctl + CW_TILE + 64 * (57 + pm2 - 1), 8u, wave);
                    p2_xw_panel(args, pm2, tid); }
                if (t >= 73 && t < 137) { const int g2 = t - 73; wait_count(ctl + CW_TILE + 64 * (16 + (g2 >> 4)), 8u, wave); p3_s5_sample(args, g2, wave, lane); }
            }
        } else {
            pg8::StaticOrder S; S.init(MT, LDP, 2048, G, bx);
            pg8::gemm_phase<EpiP, pg8::StaticOrder, GEMM_ALIGN, GEMM_SP2>(lds, g, S, E);
        }
    }
    SEAM(2);
    if (IN(3)) {
        p3_rwkv_chunks(args, lds, vcu >> 2, vcu & 3, tid, wave, lane);
        if (!tail_mode) {
            if (false) { LAS float* scr = (LAS float*)(lds + wave * 16384);
              for (int it = gw; it < 2048 + 512; it += NGW) {
                  if (it < 2048) { const int nb = it >> 5, kb = it & 31; transpose_item(args.in[I_WOUT], 2048, 2048, 32 * nb, (bf16_t*)(args.ws + WS_WOUT_T), 32 * nb, 64 * kb, scr, lane, false); }
                  else { const int i2 = it - 2048, nb = i2 >> 4, kb = i2 & 15; transpose_item(args.in[I_WGLU], 1024, 1024, 32 * nb, (bf16_t*)(args.ws + WS_WGLU_T), 32 * nb, 64 * kb, scr, lane, false); } } }
            __syncthreads();
            for (int u = vcu; u < 256; u += G) p3_s5_prompt(args, lds, u, tid, wave, lane);
            for (int g2 = vcu; g2 < 64; g2 += G) p3_s5_sample(args, g2, wave, lane);
            __syncthreads();
        }
        for (int it = vcu; it < 256; it += G) p3_rwkv_sample(args, lds, it >> 1, (it & 1) * 8 + wave, wave, lane);
    }
    SEAM(3);
    if (IN(4)) {
        pg8::StaticOrder S; S.init(MT, 1024, 1024, G, bx);
        pg8::Unit u0;
        if (S.next(0, u0)) {
            pg8::Gemm g{(const bf16_t*)(args.ws + WS_YG), (const bf16_t*)(args.ws + WS_WGLU_T), 1024, 1024};
            EpiGlu E{(const bf16_t*)(args.ws + WS_YG), (const bf16_t*)(args.ws + WS_P), args.in[I_BGLU], (bf16_t*)(args.ws + WS_XN)};
            pg8::gemm_phase<EpiGlu, pg8::StaticOrder, GEMM_ALIGN, GEMM_SP2>(lds, g, S, E);
        } else {
            const int nfree = G - 132, j = bx - 132, unit = wave * nfree + j;
            if (unit < 256) p3_rwkv_seq(args, unit, lane);
        }
    }
    SEAM(4);
    if (IN(5)) { for (int it = gw; it < 2048; it += NGW) p5_rwkv_out(args, it, lane); }
    SEAM(5);
    if (IN(6)) {
        pg8::Gemm g{(const bf16_t*)(args.ws + WS_XN), (const bf16_t*)(args.ws + WS_WOUT_T), 2048, 1024};
        pg8::OutOrder S; S.init(MP, DM, 1024, G, bx);
        EpiOut E{(const bf16_t*)(args.ws + WS_P), args.in[I_XP], (const float*)(args.ws + WS_MOD), args.out, (float*)(args.ws + WS_ROWSS), (bf16_t*)(args.ws + WS_TMP), (float*)(args.ws + WS_SLAB), ctl + CW_PANEL, args.in[I_FINALG]};
        pg8::gemm_phase<EpiOut, pg8::OutOrder, false, GEMM_SP2>(lds, g, S, E);
    }
    SEAM(6);
    if (IN(7)) { for (int m = MP + gw; m < MV; m += NGW) p6_row(args, m, lane); }
#undef IN
#undef SEAM
}

extern "C" void kernel_launch(void* const* d_in, const int* in_sizes, int n_in, void* d_out, int out_size, void* d_ws, size_t ws_size, hipStream_t stream) {
    static int grid = 0;
    if (grid == 0) {
        if (n_in != 34 || ws_size < WS_END) { fprintf(stderr, "kernel_launch: unexpected n_in %d / ws %zu\n", n_in, ws_size); grid = -1; return; }
        int dev = 0, cus = 0;
        if (hipGetDevice(&dev) != hipSuccess || hipDeviceGetAttribute(&cus, hipDeviceAttributeMultiprocessorCount, dev) != hipSuccess) { grid = -1; return; }
        if (hipFuncSetAttribute((const void*)fwd_kernel, hipFuncAttributeMaxDynamicSharedMemorySize, LDS_BYTES) != hipSuccess) { fprintf(stderr, "kernel_launch: hipFuncSetAttribute failed\n"); grid = -1; return; }
        int per_cu = 0;
        if (hipOccupancyMaxActiveBlocksPerMultiprocessor(&per_cu, (const void*)fwd_kernel, 512, LDS_BYTES) != hipSuccess || per_cu < 1) fprintf(stderr, "kernel_launch: occupancy query says %d\n", per_cu);
        (void)hipGetLastError();
        grid = cus;
        if (grid != 256) fprintf(stderr, "kernel_launch: note: %d CUs\n", grid);
    }
    if (grid < 0) return;
    (void)hipMemsetAsync((char*)d_ws + WS_CTL, 0, CTL_BYTES, stream);
    Args a{};
    for (int i = 0; i < 34; ++i) a.in[i] = (const float*)d_in[i];
    a.out = (float*)d_out; a.ws = (unsigned char*)d_ws;
    if (PROBE_PHASE >= 0) {
        a.ph_lo = 0; a.ph_hi = PROBE_PHASE + 1; a.li = 0; hipLaunchKernelGGL(fwd_kernel, dim3(grid), dim3(512), LDS_BYTES, stream, a);
        a.ph_lo = PROBE_PHASE; a.ph_hi = PROBE_PHASE + 1; a.li = 1; hipLaunchKernelGGL(fwd_kernel, dim3(grid), dim3(512), LDS_BYTES, stream, a);
        if (PROBE_PHASE + 1 < N_PHASES) { a.ph_lo = PROBE_PHASE + 1; a.ph_hi = N_PHASES; a.li = 2; hipLaunchKernelGGL(fwd_kernel, dim3(grid), dim3(512), LDS_BYTES, stream, a); }
    } else if (MK_N_LAUNCHES == 1) { a.ph_lo = 0; a.ph_hi = N_PHASES; a.li = 0; hipLaunchKernelGGL(fwd_kernel, dim3(grid), dim3(512), LDS_BYTES, stream, a); }
    else { for (int p = 0; p < N_PHASES; ++p) { a.ph_lo = p; a.ph_hi = p + 1; a.li = 0; hipLaunchKernelGGL(fwd_kernel, dim3(grid), dim3(512), LDS_BYTES, stream, a); } }
}
```

```cpp
#include <hip/hip_runtime.h>
#include <cstdio>
#include <cstdint>

#ifndef MK_N_LAUNCHES
#define MK_N_LAUNCHES 1
#endif
#ifndef PROBE_PHASE
#define PROBE_PHASE -1
#endif
constexpr int N_PHASES = 8;
#ifndef GEMM_SP2
#define GEMM_SP2 true
#endif
#ifndef GEMM_ALIGN
#define GEMM_ALIGN true
#endif

#define GAS __attribute__((address_space(1)))
#define LAS __attribute__((address_space(3)))
typedef unsigned short bf16_t;
typedef short bf16x8 __attribute__((ext_vector_type(8)));
typedef float f32x2 __attribute__((ext_vector_type(2)));
typedef float f32x4 __attribute__((ext_vector_type(4)));
typedef float f32x16 __attribute__((ext_vector_type(16)));
typedef unsigned u32x2 __attribute__((ext_vector_type(2)));
typedef unsigned u32x4 __attribute__((ext_vector_type(4)));
typedef GAS unsigned gu32;

constexpr int DM = 2048, SEQ = 2048, NB = 4, NSMP = 128;
constexpr int MP = NB * SEQ;
constexpr int MV = MP + NSMP;
constexpr int MT = MV + NSMP;
constexpr int NIN = 10368, LDP = 10496;
constexpr int NMOD = 6144, NMODROWS = NB + NSMP;
constexpr float RMS_EPS = 1e-6f, GN_EPS = 64e-5f;
constexpr int PC_U = 0, PC_ZS = 1024, PC_R = 2048, PC_K = 3072, PC_V = 4096, PC_ZR = 5120, PC_GS = 6144, PC_GR = 8192, PC_WD = 10240, PC_AD = 10304;

constexpr size_t WS_CTL = 0, CTL_BYTES = 131072;
constexpr size_t WS_MOD = CTL_BYTES;
constexpr size_t WS_WT = WS_MOD + 3276800;
constexpr size_t WS_XN = WS_WT + (size_t)LDP * 2048 * 2;
constexpr size_t WS_P = WS_XN + (size_t)MT * 2048 * 2;
constexpr size_t WS_RWI = WS_P + (size_t)MT * LDP * 2;
constexpr int RWI_GF = 0, RWI_W2F = 8192, RWI_H1F = 16384, RWI_O1F = 32768, RWI_LAM = 49152, RWI_BYTES = 49408;
constexpr size_t WS_TMP = WS_RWI;
constexpr size_t WS_SLAB = WS_TMP + (size_t)MP * 2048 * 2;
static_assert(WS_SLAB + (size_t)8 * NSMP * DM * 4 <= WS_RWI + (size_t)2048 * RWI_BYTES, "tmp/slab alias");
constexpr size_t WS_YG = WS_RWI + (size_t)2048 * RWI_BYTES;
constexpr size_t WS_WOUT_T = WS_YG + (size_t)MT * 1024 * 2;
constexpr size_t WS_WGLU_T = WS_WOUT_T + (size_t)2048 * 2048 * 2;
constexpr size_t WS_ROWSS = WS_WGLU_T + (size_t)1024 * 1024 * 2;
constexpr size_t WS_U2 = WS_ROWSS + (size_t)MP * 8 * 4;
constexpr size_t WS_U2S = WS_U2 + (size_t)MP * 1024 * 2;
constexpr size_t WS_HB = WS_U2S + (size_t)NSMP * 1024 * 2;
constexpr size_t WS_XW = WS_HB + (size_t)256 * 32 * 2048;
constexpr size_t WS_END = WS_XW + (size_t)MP * 128 * 2;
static_assert(WS_END <= ((size_t)412 << 20), "ws map");
constexpr size_t DO_ORAW = 0, DO_BV = (size_t)MP * 1024 * 2, DO_S5TAB = 2 * DO_BV;
constexpr int S5T_ME = 0, S5T_KT = 65536, S5T_CA = 81920, S5T_C0 = 147456, S5T_DF = 155648, S5T_HDR = 156672, S5T_BYTES = 157696;
static_assert(DO_S5TAB + (size_t)64 * S5T_BYTES <= (size_t)MV * DM * 4, "d_out scratch");
constexpr size_t OUT_Y = 0, OUT_S5RE_P = 17039360, OUT_S5IM_P = 17055744, OUT_WKV_P = 17072128, OUT_SHIFT_P = 17334272,
                 OUT_S5RE_S = 17342464, OUT_S5IM_S = 17866752, OUT_WKV_S = 18391040, OUT_SHIFT_S = 26779648;
constexpr int RING_BYTES = 131072, LDSCTL_OFF = RING_BYTES, MISC_OFF = LDSCTL_OFF + 320, LDS_BYTES = 147456;
constexpr int CW_BAR = 1024;
constexpr int CW_PANEL = 12288, CW_TILE = 16384;

#define LDS_WAIT() asm volatile("s_waitcnt lgkmcnt(0)" ::: "memory")
#define VM_WAIT() asm volatile("s_waitcnt vmcnt(0)" ::: "memory")
typedef __bf16 bf16x2_t __attribute__((ext_vector_type(2)));
__device__ __forceinline__ unsigned cvt_pk_bf16(float lo, float hi) { const f32x2 v = {lo, hi}; return __builtin_bit_cast(unsigned, __builtin_convertvector(v, bf16x2_t)); }
__device__ __forceinline__ u32x2 pack4(float a, float b, float c, float d) { u32x2 w; w.x = cvt_pk_bf16(a, b); w.y = cvt_pk_bf16(c, d); return w; }
__device__ __forceinline__ float bf_lo(unsigned w) { return __uint_as_float(w << 16); }
__device__ __forceinline__ float bf_hi(unsigned w) { return __uint_as_float(w & 0xffff0000u); }
__device__ __forceinline__ float bf2f(bf16_t b) { return __uint_as_float(((unsigned)b) << 16); }
__device__ __forceinline__ bf16_t f2bf(float f) { return (bf16_t)(cvt_pk_bf16(f, 0.f) & 0xffffu); }
__device__ __forceinline__ float rcpf_(float x) { return __builtin_amdgcn_rcpf(x); }
__device__ __forceinline__ float sigmoidf_(float x) { return rcpf_(1.0f + __expf(-x)); }
__device__ __forceinline__ float siluf_(float x) { return x * rcpf_(1.0f + __expf(-x)); }
__device__ __forceinline__ float tanhf_(float x) { const float e = __expf(2.0f * x); return 1.0f - 2.0f * rcpf_(e + 1.0f); }
__device__ __forceinline__ float geluf_(float y) { const float z = 0.7978845608028654f * (y + 0.044715f * y * y * y); return 0.5f * y * (1.0f + tanhf_(z)); }
__device__ __forceinline__ float wave_sum(float v) {
#pragma unroll
    for (int o = 1; o < 64; o <<= 1) v += __shfl_xor(v, o);
    return v;
}
template <int CTRL> __device__ __forceinline__ float dpp_f(float x) { return __builtin_bit_cast(float, __builtin_amdgcn_mov_dpp(__builtin_bit_cast(int, x), CTRL, 0xf, 0xf, true)); }
__device__ __forceinline__ float wave_sum_dpp(float v) {
    v += __builtin_bit_cast(float, __builtin_amdgcn_update_dpp(0, __builtin_bit_cast(int, v), 0x111, 0xf, 0xf, true));
    v += __builtin_bit_cast(float, __builtin_amdgcn_update_dpp(0, __builtin_bit_cast(int, v), 0x112, 0xf, 0xf, true));
    v += __builtin_bit_cast(float, __builtin_amdgcn_update_dpp(0, __builtin_bit_cast(int, v), 0x114, 0xf, 0xf, true));
    v += __builtin_bit_cast(float, __builtin_amdgcn_update_dpp(0, __builtin_bit_cast(int, v), 0x118, 0xf, 0xf, true));
    v += __builtin_bit_cast(float, __builtin_amdgcn_update_dpp(0, __builtin_bit_cast(int, v), 0x142, 0xa, 0xf, false));
    v += __builtin_bit_cast(float, __builtin_amdgcn_update_dpp(0, __builtin_bit_cast(int, v), 0x143, 0xc, 0xf, false));
    return __builtin_bit_cast(float, __builtin_amdgcn_readlane(__builtin_bit_cast(int, v), 63));
}
__device__ __forceinline__ float half_sum32(float v, bool upper) {
    v += __builtin_bit_cast(float, __builtin_amdgcn_update_dpp(0, __builtin_bit_cast(int, v), 0x111, 0xf, 0xf, true));
    v += __builtin_bit_cast(float, __builtin_amdgcn_update_dpp(0, __builtin_bit_cast(int, v), 0x112, 0xf, 0xf, true));
    v += __builtin_bit_cast(float, __builtin_amdgcn_update_dpp(0, __builtin_bit_cast(int, v), 0x114, 0xf, 0xf, true));
    v += __builtin_bit_cast(float, __builtin_amdgcn_update_dpp(0, __builtin_bit_cast(int, v), 0x118, 0xf, 0xf, true));
    v += __builtin_bit_cast(float, __builtin_amdgcn_update_dpp(0, __builtin_bit_cast(int, v), 0x142, 0xa, 0xf, false));
    const float s0 = __builtin_bit_cast(float, __builtin_amdgcn_readlane(__builtin_bit_cast(int, v), 31)), s1 = __builtin_bit_cast(float, __builtin_amdgcn_readlane(__builtin_bit_cast(int, v), 63));
    return upper ? s1 : s0;
}
__device__ __forceinline__ float row16_sum(float v) {
    v += dpp_f<0xB1>(v);
    v += dpp_f<0x4E>(v);
    v += dpp_f<0x141>(v);
    v += dpp_f<0x140>(v);
    return v;
}

#define XB_TMO      128
#define XB_XCNT(j)  (256  + 64 * (j))
#define XB_XSUB(j)  (1280 + 64 * (j))
#define XB_XGEN(j)  (2304 + 64 * (j))
#define XB_TOP      3328
#define XB_TOPGEN   3392
#define XCD_BAR_WORDS 3456
#define XB_SPIN_CAP (1u << 20)
__device__ __forceinline__ unsigned xb_ld(unsigned* p)              { return __hip_atomic_load(p, __ATOMIC_RELAXED, __HIP_MEMORY_SCOPE_AGENT); }
__device__ __forceinline__ unsigned xb_add(unsigned* p, unsigned v) { return __hip_atomic_fetch_add(p, v, __ATOMIC_RELAXED, __HIP_MEMORY_SCOPE_AGENT); }
__device__ __forceinline__ unsigned xb_xcc_id() { return (unsigned)__builtin_amdgcn_s_getreg((3 << 11) | 20) & 0xFu; }
#define XB_SPIN(cond, bar) do { unsigned _sp = 0; while (cond) { __builtin_amdgcn_s_sleep(1); \
    if ((++_sp & 255u) == 0u) { if (xb_ld(&(bar)[XB_TMO])) break; if (_sp > XB_SPIN_CAP) { atomicAdd(&(bar)[XB_TMO], 1u); break; } } } } while (0)
struct XcdBarrier { unsigned* bar; unsigned x; volatile LAS unsigned* st; };
__device__ __forceinline__ XcdBarrier xcd_barrier_post(unsigned* bar, volatile LAS unsigned* st) {
    XcdBarrier b; b.bar = bar; b.x = xb_xcc_id(); b.st = st;
    if (threadIdx.x == 0) (void)xb_add(&bar[XB_XCNT(b.x)], 1u);
    return b;
}
__device__ __forceinline__ void xcd_barrier_complete(unsigned* bar, unsigned x, unsigned& nloc, unsigned& nx) {
    const unsigned G = gridDim.x * gridDim.y * gridDim.z;
    unsigned sum, cnt, mine, sp = 0u;
    for (;;) {
        sum = 0u; cnt = 0u; mine = 0u;
#pragma unroll
        for (unsigned j = 0; j < 16; ++j) { const unsigned c = xb_ld(&bar[XB_XCNT(j)]); sum += c; cnt += (c > 0u) ? 1u : 0u; mine = (j == x) ? c : mine; }
        if (sum == G) break;
        __builtin_amdgcn_s_sleep(1);
        if ((++sp & 255u) == 0u) { if (xb_ld(&bar[XB_TMO])) break; if (sp > XB_SPIN_CAP) { atomicAdd(&bar[XB_TMO], 1u); break; } }
    }
    nloc = mine > 0u ? mine : 1u; nx = cnt > 0u ? cnt : 1u;
}
__device__ __forceinline__ void xcd_barrier(const XcdBarrier& b) {
    asm volatile("s_waitcnt vmcnt(0)" ::: "memory");
    __syncthreads();
    if (threadIdx.x == 0) {
        unsigned* bar = b.bar;
        __builtin_amdgcn_s_waitcnt(0);
        unsigned nloc = b.st[0], nx = b.st[1];
        if (nloc == 0u) { xcd_barrier_complete(bar, b.x, nloc, nx); b.st[0] = nloc; b.st[1] = nx; }
        const unsigned old = xb_add(&bar[XB_XSUB(b.x)], 1u);
        const unsigned gen = old / nloc;
        if (old + 1u == (gen + 1u) * nloc) {
            __builtin_amdgcn_fence(__ATOMIC_RELEASE, "agent");
            asm volatile("s_waitcnt vmcnt(0)" ::: "memory");
            const unsigned og = xb_add(&bar[XB_TOP], 1u);
            const unsigned tg = og / nx;
            if (og + 1u == (tg + 1u) * nx) xb_add(&bar[XB_TOPGEN], 1u);
            else XB_SPIN(xb_ld(&bar[XB_TOPGEN]) == tg, bar);
            __builtin_amdgcn_fence(__ATOMIC_ACQUIRE, "agent");
            xb_add(&bar[XB_XGEN(b.x)], 1u);
            asm volatile("s_waitcnt vmcnt(0)" ::: "memory");
        } else {
            XB_SPIN(xb_ld(&bar[XB_XGEN(b.x)]) == gen, bar);
            __builtin_amdgcn_fence(__ATOMIC_ACQUIRE, "agent");
            asm volatile("s_waitcnt vmcnt(0)" ::: "memory");
        }
    }
    __syncthreads();
}

namespace pg8 {
constexpr int BM = 256, BK = 64, HALF = 128, HTB = HALF * BK * 2, STAGE_BYTES = 8 * HTB, NXCD = 8, WGM = 8;
__host__ __device__ __forceinline__ int lds_byte(int r, int c) { const int st = (r >> 4) * 2 + (c >> 5), rr = r & 15, cc = c & 31, ob = rr * 64 + cc * 2; return st * 1024 + (ob ^ (((ob >> 9) & 1) << 5)); }
__host__ __device__ __forceinline__ void stage_rc(int b, int& R, int& C) { const int st = b / 1024, sb = b % 1024, swz = sb ^ (((sb >> 9) & 1) << 5); R = (st >> 1) * 16 + swz / 64; C = (st & 1) * 32 + (swz % 64) / 2; }
__host__ __device__ __forceinline__ int perm32(int rho) { const int n = rho >> 4, i = rho & 15; return 8 * (i >> 2) + 4 * n + (i & 3); }
struct Unit { int pm, pn, koff, kt, mode; };
struct Gemm { const bf16_t* A; const bf16_t* Bt; int ld, K; };
struct StaticOrder {
    int nM, nN, nwg, G, c, kt;
    __device__ void init(int M, int N, int K, int G_, int c_) { nM = M / BM; nN = N / BM; nwg = nM * nN; G = G_; c = c_; kt = K / BK; }
    __device__ __forceinline__ void tile(int L, Unit& u) const {
        int wgid = L; { const int q = nwg / NXCD, r = nwg % NXCD, xcd = wgid % NXCD, off = wgid / NXCD; wgid = (xcd < r ? xcd * (q + 1) : r * (q + 1) + (xcd - r) * q) + off; }
        const int nig = WGM * nN, gid = wgid / nig, fm = gid * WGM, gsz = (nM - fm) < WGM ? (nM - fm) : WGM;
        u.pm = fm + ((wgid % nig) % gsz); u.pn = (wgid % nig) / gsz; u.koff = 0; u.kt = kt; u.mode = 0;
    }
    __device__ __forceinline__ bool next(int i, Unit& u) const { const long L = (long)i * G + c; if (L >= nwg) return false; tile((int)L, u); return true; }
    __device__ __forceinline__ void done(const Unit&, int, int&) const {}
};
struct OutOrder : StaticOrder {
    __device__ __forceinline__ bool next(int i, Unit& u) const {
        const int i2 = (c < 64) ? i - 1 : i;
        if (i2 < 0) { u.pm = 32; u.pn = c >> 3; u.koff = (c & 7) * 256; u.kt = 4; u.mode = 2; return true; }
        if (i2 < 2 && c < nwg) { tile(c, u); u.koff = i2 * 1024; u.kt = 16; u.mode = i2; return true; }
        return false;
    }
};
struct TailOrder : StaticOrder {
    unsigned* cnt;
    __device__ void init2(int G_, int c_, unsigned* cnt_) { nM = 32; nN = 36; nwg = 32 * 36; G = G_; c = c_; kt = 32; cnt = cnt_; }
    __device__ __forceinline__ static bool flagged(const Unit& u) { return u.pm == 32 || u.pn < 4 || u.pn == 40; }
    __device__ __forceinline__ bool next(int i, Unit& u) const {
        const int L = i * G + c; if (L >= 201 + 1152) return false;
        if (L < 132) { const int x = L & 7, k = L >> 3; if (k < 16) { u.pm = 4 * x + (k >> 2); u.pn = k & 3; } else { u.pm = 32; u.pn = x; }
                       u.koff = 0; u.kt = 32; u.mode = 0; }
        else if (L < 169) { u.pm = 32; u.pn = 4 + (L - 132); u.koff = 0; u.kt = 32; u.mode = 0; }
        else if (L < 201) { u.pm = L - 169; u.pn = 40; u.koff = 0; u.kt = 32; u.mode = 0; }
        else { tile(L - 201, u); u.pn += 4; }
        return true;
    }
    __device__ __forceinline__ void done(const Unit& u, int lane, int& pend) const {
        if (pend >= 0) {
            asm volatile("s_waitcnt vmcnt(0)" ::: "memory");
            if (lane == 0) __hip_atomic_fetch_add(cnt + 64 * pend, 1u, __ATOMIC_RELAXED, __HIP_MEMORY_SCOPE_AGENT);
            pend = -1;
        }
        if (flagged(u)) pend = (u.pm == 32) ? 16 + u.pn : ((u.pn < 4) ? (u.pm >> 3) * 4 + u.pn : 57 + u.pm);
    }
};
template <class Epi, class Sched, bool ALIGN_EPI = false, bool SP2 = false>
__device__ __forceinline__ void gemm_phase(LAS unsigned char* lds, const Gemm g, const Sched& S, const Epi& E) {
    const int tid = threadIdx.x, wid = __builtin_amdgcn_readfirstlane(tid >> 6), lane = tid & 63, wr = wid >> 2, wc = wid & 3, fr = lane & 15, fq = lane >> 4;
    const int ld = g.ld;
    unsigned voffA[2], voffB[2];
#pragma unroll
    for (int i = 0; i < 2; ++i) { int R, C; stage_rc(tid * 16 + i * 8192, R, C); const int Rb = Epi::PERM ? ((R & ~31) + perm32(R & 31)) : R;
        voffA[i] = (unsigned)(R * ld + C) * 2u; voffB[i] = (unsigned)(Rb * ld + C) * 2u; }
    const size_t kstep = (size_t)(BK * 2);
    const size_t hstep = (size_t)HALF * ld * 2;
    const size_t tstep = 2 * hstep;
    const unsigned ldsw = (unsigned)wid * 1024u;
    const int aoff = lds_byte(wr * 64 + fr, fq * 8), boff = lds_byte(wc * 32 + fr, fq * 8);
#define PG8_SA(b, h) (((b) * 2 + (h)) * HTB)
#define PG8_SB(b, h) ((4 + (b) * 2 + (h)) * HTB)
#define PG8_STAGE(bufoff, gbase, voff) do { _Pragma("unroll") for (int _i = 0; _i < 2; ++_i) \
        __builtin_amdgcn_global_load_lds((const unsigned*)((const char*)(gbase) + (voff)[_i]), (LAS unsigned*)(lds + (bufoff) + ldsw + _i * 8192), 16, 0, 0); } while (0)
#define PG8_LDA(dst, b, h) do { _Pragma("unroll") for (int m = 0; m < 4; ++m) _Pragma("unroll") for (int k = 0; k < 2; ++k) dst[m][k] = *(const LAS bf16x8*)(lds + PG8_SA(b, h) + aoff + m * 2048 + k * 1024); } while (0)
#define PG8_LDB(dst, b, h) do { _Pragma("unroll") for (int n = 0; n < 2; ++n) _Pragma("unroll") for (int k = 0; k < 2; ++k) dst[n][k] = *(const LAS bf16x8*)(lds + PG8_SB(b, h) + boff + n * 2048 + k * 1024); } while (0)
#define PG8_MMA(ai, bj, At, Bt) do { __builtin_amdgcn_s_setprio(1); _Pragma("unroll") for (int m = 0; m < 4; ++m) _Pragma("unroll") for (int n = 0; n < 2; ++n) _Pragma("unroll") for (int k = 0; k < 2; ++k) \
        acc[ai][bj][m][n] = __builtin_amdgcn_mfma_f32_16x16x32_bf16(Bt[n][k], At[m][k], acc[ai][bj][m][n], 0, 0, 0); __builtin_amdgcn_s_setprio(0); } while (0)
#define PG8_WAIT_V(n) asm volatile("s_waitcnt vmcnt(" #n ")" ::: "memory")
#define PG8_WAIT_L(n) asm volatile("s_waitcnt lgkmcnt(" #n ")" ::: "memory")
#define PG8_BAR __builtin_amdgcn_s_barrier()
#define PG8_SCHED __builtin_amdgcn_sched_barrier(0)
    Unit cur, nxt; int ui = 0; bool deferred = false; int pend = -1;
    if (!S.next(0, cur)) return;
    f32x4 acc[2][2][4][2];
#pragma unroll
    for (int a = 0; a < 2; ++a)
#pragma unroll
        for (int b = 0; b < 2; ++b)
#pragma unroll
            for (int m = 0; m < 4; ++m)
#pragma unroll
                for (int n = 0; n < 2; ++n) acc[a][b][m][n] = (f32x4){0.f, 0.f, 0.f, 0.f};
    bf16x8 At[4][2], B0[2][2], B1[2][2];
    const char* cA = (const char*)g.A + (size_t)cur.pm * tstep + (size_t)cur.koff * 2; const char* cB = (const char*)g.Bt + (size_t)cur.pn * tstep + (size_t)cur.koff * 2;
    if constexpr (SP2) {
        PG8_STAGE(PG8_SB(0, 0), cB, voffB); PG8_STAGE(PG8_SB(0, 1), cB + hstep, voffB); PG8_STAGE(PG8_SA(0, 0), cA, voffA); PG8_STAGE(PG8_SA(0, 1), cA + hstep, voffA);
        if (wr == 1) PG8_BAR;
        PG8_WAIT_V(2); PG8_BAR;
        PG8_STAGE(PG8_SB(1, 0), cB + kstep, voffB); PG8_STAGE(PG8_SA(1, 0), cA + kstep, voffA); PG8_STAGE(PG8_SB(1, 1), cB + hstep + kstep, voffB);
        PG8_WAIT_V(6); PG8_BAR;
    } else {
    PG8_STAGE(PG8_SB(0, 0), cB, voffB); PG8_STAGE(PG8_SA(0, 0), cA, voffA); PG8_STAGE(PG8_SB(0, 1), cB + hstep, voffB); PG8_STAGE(PG8_SA(0, 1), cA + hstep, voffA);
    if (wr == 1) PG8_BAR;
    PG8_WAIT_V(4); PG8_BAR;
    PG8_STAGE(PG8_SB(1, 0), cB + kstep, voffB); PG8_STAGE(PG8_SA(1, 0), cA + kstep, voffA); PG8_STAGE(PG8_SB(1, 1), cB + hstep + kstep, voffB);
    PG8_WAIT_V(6); PG8_BAR;
    }
    for (;;) {
        const bool has_next = S.next(ui + 1, nxt);
        const char* nA = has_next ? (const char*)g.A + (size_t)nxt.pm * tstep + (size_t)nxt.koff * 2 : cA; const char* nB = has_next ? (const char*)g.Bt + (size_t)nxt.pn * tstep + (size_t)nxt.koff * 2 : cB;
        const int nt = cur.kt;
        for (int t = 0; t < nt; t += 2) {
            const bool last = (t == nt - 2);
            const char* a1 = cA + (size_t)(t + 1) * kstep;
            const char* a2 = last ? nA : cA + (size_t)(t + 2) * kstep; const char* b2 = last ? nB : cB + (size_t)(t + 2) * kstep;
            const char* a3 = a2 + kstep; const char* b3 = b2 + kstep;
            if constexpr (SP2) {
            PG8_LDB(B0, 0, 0); PG8_LDB(B1, 0, 1); PG8_SCHED; PG8_LDA(At, 0, 0); PG8_STAGE(PG8_SA(1, 1), a1 + hstep, voffA);
            PG8_WAIT_V(8); PG8_WAIT_L(0); PG8_BAR; PG8_MMA(0, 0, At, B0); PG8_MMA(0, 1, At, B1); PG8_BAR; PG8_SCHED;
            PG8_LDA(At, 0, 1); PG8_STAGE(PG8_SB(0, 0), b2, voffB); PG8_STAGE(PG8_SB(0, 1), b2 + hstep, voffB); PG8_STAGE(PG8_SA(0, 0), a2, voffA);
            PG8_WAIT_V(8); PG8_WAIT_L(0); PG8_BAR; PG8_MMA(1, 0, At, B0); PG8_MMA(1, 1, At, B1); PG8_BAR; PG8_SCHED;
            PG8_LDB(B0, 1, 0); PG8_LDB(B1, 1, 1); PG8_SCHED; PG8_LDA(At, 1, 0); PG8_STAGE(PG8_SA(0, 1), a2 + hstep, voffA);
            PG8_WAIT_V(8); PG8_WAIT_L(0); PG8_BAR; PG8_MMA(0, 0, At, B0); PG8_MMA(0, 1, At, B1); PG8_BAR; PG8_SCHED;
            PG8_LDA(At, 1, 1); PG8_STAGE(PG8_SB(1, 0), b3, voffB); PG8_STAGE(PG8_SB(1, 1), b3 + hstep, voffB); PG8_STAGE(PG8_SA(1, 0), a3, voffA);
            PG8_WAIT_V(8); PG8_WAIT_L(0); PG8_BAR; PG8_MMA(1, 0, At, B0); PG8_MMA(1, 1, At, B1); PG8_BAR; PG8_SCHED;
            } else {
            PG8_LDB(B0, 0, 0); PG8_SCHED; PG8_LDA(At, 0, 0); PG8_STAGE(PG8_SA(1, 1), a1 + hstep, voffA);
            PG8_WAIT_L(8); PG8_BAR; PG8_WAIT_L(0); PG8_MMA(0, 0, At, B0); PG8_BAR; PG8_SCHED;
            PG8_LDB(B1, 0, 1); PG8_STAGE(PG8_SB(0, 0), b2, voffB);
            PG8_BAR; PG8_WAIT_L(0); PG8_MMA(0, 1, At, B1); PG8_BAR;
            PG8_LDA(At, 0, 1); PG8_STAGE(PG8_SA(0, 0), a2, voffA);
            PG8_BAR; PG8_WAIT_L(0); PG8_MMA(1, 0, At, B0); PG8_BAR; PG8_SCHED;
            PG8_STAGE(PG8_SB(0, 1), b2 + hstep, voffB);
            PG8_WAIT_V(6); PG8_BAR; PG8_MMA(1, 1, At, B1); PG8_BAR;
            PG8_LDB(B0, 1, 0); PG8_SCHED; PG8_LDA(At, 1, 0); PG8_STAGE(PG8_SA(0, 1), a2 + hstep, voffA);
            PG8_WAIT_L(8); PG8_BAR; PG8_WAIT_L(0); PG8_MMA(0, 0, At, B0); PG8_BAR; PG8_SCHED;
            PG8_LDB(B1, 1, 1); PG8_STAGE(PG8_SB(1, 0), b3, voffB);
            PG8_BAR; PG8_WAIT_L(0); PG8_MMA(0, 1, At, B1); PG8_BAR;
            PG8_LDA(At, 1, 1); PG8_STAGE(PG8_SA(1, 0), a3, voffA);
            PG8_BAR; PG8_WAIT_L(0); PG8_MMA(1, 0, At, B0); PG8_BAR; PG8_SCHED;
            PG8_STAGE(PG8_SB(1, 1), b3 + hstep, voffB);
            PG8_WAIT_V(6); PG8_BAR; PG8_MMA(1, 1, At, B1); PG8_BAR;
            }
        }
        if constexpr (ALIGN_EPI) { if (wr == 0) PG8_BAR; }
        if (Epi::FUSED_LAST && !has_next && cur.mode == 1) deferred = true; else { E(acc, cur, wr, wc, fr, fq); S.done(cur, lane, pend); }
        const bool keep_acc = Epi::FUSED_LAST && cur.mode == 0;
        if (!has_next) break;
        if (!keep_acc) {
#pragma unroll
        for (int a = 0; a < 2; ++a)
#pragma unroll
            for (int b = 0; b < 2; ++b)
#pragma unroll
                for (int m = 0; m < 4; ++m)
#pragma unroll
                    for (int n = 0; n < 2; ++n) acc[a][b][m][n] = (f32x4){0.f, 0.f, 0.f, 0.f};
        }
        cur = nxt; cA = nA; cB = nB; ++ui;
        if constexpr (ALIGN_EPI) { if (wr == 1) PG8_BAR; }
    }
    PG8_WAIT_V(0);
    if constexpr (!ALIGN_EPI) { if (wr == 0) PG8_BAR; }
    PG8_BAR;
    if constexpr (Epi::FUSED_LAST) { if (deferred) E.fused(acc, cur, wr, wc, fr, fq, lds, wid, lane); }
#undef PG8_SA
#undef PG8_SB
#undef PG8_STAGE
#undef PG8_LDA
#undef PG8_LDB
#undef PG8_MMA
#undef PG8_WAIT_V
#undef PG8_WAIT_L
#undef PG8_BAR
#undef PG8_SCHED
}
}

struct EpiP {
    static constexpr bool PERM = true, FUSED_LAST = false;
    bf16_t* P; bool tail; bf16_t* U2;
    __device__ __forceinline__ void operator()(const f32x4 (&acc)[2][2][4][2], const pg8::Unit& u, int wr, int wc, int fr, int fq) const {
        const int row0 = u.pm * 256 + wr * 64 + fr, col0 = u.pn * 256 + wc * 32 + 8 * fq;
        const bool wt = tail && (u.pm == 32 || u.pn < 4 || u.pn == 40);
        const __amdgpu_buffer_rsrc_t rsrc = __builtin_amdgcn_make_buffer_rsrc(P, 0, (int)((size_t)MT * LDP * 2), 0x00020000);
        const __amdgpu_buffer_rsrc_t rsrc2 = __builtin_amdgcn_make_buffer_rsrc(U2, 0, (int)((size_t)MV * 1024 * 2), 0x00020000);
        const int act = ((u.pn >= 4 && u.pn < 8) || (u.pn >= 20 && u.pn < 24)) ? 1 : ((u.pn >= 24 && u.pn < 40) ? 2 : 0);
#pragma unroll
        for (int ai = 0; ai < 2; ++ai)
#pragma unroll
            for (int m = 0; m < 4; ++m) { bf16_t* rowp = P + (size_t)(row0 + ai * 128 + m * 16) * LDP + col0;
#pragma unroll
                for (int bj = 0; bj < 2; ++bj) { f32x4 v0 = acc[ai][bj][m][0], v1 = acc[ai][bj][m][1];
                    if (act == 1) {
#pragma unroll
                        for (int j = 0; j < 4; ++j) { v0[j] = siluf_(v0[j]); v1[j] = siluf_(v1[j]); } }
                    else if (act == 2) {
#pragma unroll
                        for (int j = 0; j < 4; ++j) { v0[j] = sigmoidf_(v0[j]); v1[j] = sigmoidf_(v1[j]); } }
                    u32x4 w; w.x = cvt_pk_bf16(v0[0], v0[1]); w.y = cvt_pk_bf16(v0[2], v0[3]); w.z = cvt_pk_bf16(v1[0], v1[1]); w.w = cvt_pk_bf16(v1[2], v1[3]);
                    if (u.pn < 4) {
                        const int row = row0 + ai * 128 + m * 16, col = col0 + bj * 128, g2 = col >> 4, hf = (col >> 3) & 1;
                        size_t eo; if (row < MP) eo = (((size_t)(row >> 11) * 64 + g2) * SEQ + (row & (SEQ - 1))) * 16 + hf * 8; else eo = (size_t)MP * 1024 + ((size_t)g2 * NSMP + ((row - MP) & (NSMP - 1))) * 16 + hf * 8;
                        if (row < MV) { if (wt) __builtin_amdgcn_raw_buffer_store_b128(w, rsrc2, (unsigned)(eo * 2), 0, 16); else *(u32x4*)(U2 + eo) = w; } }
                    else if (wt) __builtin_amdgcn_raw_buffer_store_b128(w, rsrc, (unsigned)((size_t)(row0 + ai * 128 + m * 16) * LDP + col0 + bj * 128) * 2u, 0, 16);
                    else *(u32x4*)(rowp + bj * 128) = w; } }
    }
};
struct EpiGlu {
    static constexpr bool PERM = true, FUSED_LAST = false;
    const bf16_t* Yg; const bf16_t* P; const float* bglu; bf16_t* A2;
    __device__ __forceinline__ void operator()(const f32x4 (&acc)[2][2][4][2], const pg8::Unit& u, int wr, int wc, int fr, int fq) const {
        const int row0 = u.pm * 256 + wr * 64 + fr, col0 = u.pn * 256 + wc * 32 + 8 * fq;
        f32x4 bv[2][2];
#pragma unroll
        for (int bj = 0; bj < 2; ++bj)
#pragma unroll
            for (int n = 0; n < 2; ++n) bv[bj][n] = *(const f32x4*)(bglu + col0 + bj * 128 + 4 * n);
#pragma unroll
        for (int ai = 0; ai < 2; ++ai)
#pragma unroll
            for (int m = 0; m < 4; ++m) { const size_t row = (size_t)(row0 + ai * 128 + m * 16);
#pragma unroll
                for (int bj = 0; bj < 2; ++bj) { const int c = col0 + bj * 128;
                    const u32x4 yg = *(const u32x4*)(Yg + row * 1024 + c), sz = *(const u32x4*)(P + row * LDP + PC_ZS + c);
                    const f32x4 a0 = acc[ai][bj][m][0] + bv[bj][0], a1 = acc[ai][bj][m][1] + bv[bj][1];
                    float o[8];
                    o[0] = bf_lo(yg.x) * sigmoidf_(a0[0]) * bf_lo(sz.x); o[1] = bf_hi(yg.x) * sigmoidf_(a0[1]) * bf_hi(sz.x);
                    o[2] = bf_lo(yg.y) * sigmoidf_(a0[2]) * bf_lo(sz.y); o[3] = bf_hi(yg.y) * sigmoidf_(a0[3]) * bf_hi(sz.y);
                    o[4] = bf_lo(yg.z) * sigmoidf_(a1[0]) * bf_lo(sz.z); o[5] = bf_hi(yg.z) * sigmoidf_(a1[1]) * bf_hi(sz.z);
                    o[6] = bf_lo(yg.w) * sigmoidf_(a1[2]) * bf_lo(sz.w); o[7] = bf_hi(yg.w) * sigmoidf_(a1[3]) * bf_hi(sz.w);
                    u32x4 w; w.x = cvt_pk_bf16(o[0], o[1]); w.y = cvt_pk_bf16(o[2], o[3]); w.z = cvt_pk_bf16(o[4], o[5]); w.w = cvt_pk_bf16(o[6], o[7]);
                    *(u32x4*)(A2 + row * 2048 + c) = w; } }
    }
};
struct EpiOut {
    static constexpr bool PERM = false, FUSED_LAST = true;
    const bf16_t* P; const float* xp; const float* mod; float* out; float* xbuf; bf16_t* tmp; float* slab; unsigned* cnt; const float* fg;
    __device__ __forceinline__ void operator()(f32x4 (&acc)[2][2][4][2], const pg8::Unit& u, int wr, int wc, int fr, int fq) const {
        const int row0 = u.pm * 256 + wr * 64 + fr, col0 = u.pn * 256 + wc * 32 + 4 * fq;
        if (u.mode == 0) {
#pragma unroll
            for (int ai = 0; ai < 2; ++ai)
#pragma unroll
                for (int m = 0; m < 4; ++m) { const size_t row = (size_t)(row0 + ai * 128 + m * 16); const bf16_t* p1 = P + row * LDP + PC_GS + col0; const bf16_t* p2 = P + row * LDP + PC_GR + col0;
#pragma unroll
                    for (int bj = 0; bj < 2; ++bj)
#pragma unroll
                        for (int n = 0; n < 2; ++n) { const int o = bj * 128 + n * 16; const u32x2 g1 = *(const u32x2*)(p1 + o), g2 = *(const u32x2*)(p2 + o); f32x4& a = acc[ai][bj][m][n];
                            a[0] *= bf_lo(g1.x) * rcpf_(bf_lo(g2.x)); a[1] *= bf_hi(g1.x) * rcpf_(bf_hi(g2.x)); a[2] *= bf_lo(g1.y) * rcpf_(bf_lo(g2.y)); a[3] *= bf_hi(g1.y) * rcpf_(bf_hi(g2.y)); } }
        } else {
            const int gc = (u.koff < 1024) ? PC_GS : PC_GR; float* sl = slab + (size_t)(u.koff >> 8) * NSMP * DM;
#pragma unroll
            for (int m = 0; m < 4; ++m) { const size_t row = (size_t)(row0 + m * 16); const bf16_t* prow = P + row * LDP + gc + col0; float* srow = sl + (row - MP) * DM + col0;
#pragma unroll
                for (int bj = 0; bj < 2; ++bj)
#pragma unroll
                    for (int n = 0; n < 2; ++n) { const int o = bj * 128 + n * 16; const u32x2 gg = *(const u32x2*)(prow + o); const f32x4 a = acc[0][bj][m][n];
                        *(f32x4*)(srow + o) = (f32x4){bf_lo(gg.x) * a[0], bf_hi(gg.x) * a[1], bf_lo(gg.y) * a[2], bf_hi(gg.y) * a[3]}; } }
        }
    }
    __device__ __forceinline__ void fused(f32x4 (&acc)[2][2][4][2], const pg8::Unit& u, int wr, int wc, int fr, int fq, LAS unsigned char* lds, int wid, int lane) const {
        const int row0 = u.pm * 256 + wr * 64 + fr, col0 = u.pn * 256 + wc * 32 + 4 * fq;
        LAS float* PT = (LAS float*)lds; LAS float* ST = (LAS float*)(lds + 4096);
        f32x4 gt[2][2];
        { const float* gtrow = mod + (size_t)(u.pm >> 3) * NMOD + 2 * DM + col0;
#pragma unroll
          for (int bj = 0; bj < 2; ++bj)
#pragma unroll
              for (int n = 0; n < 2; ++n) gt[bj][n] = *(const f32x4*)(gtrow + bj * 128 + n * 16); }
#pragma unroll
        for (int ai = 0; ai < 2; ++ai)
#pragma unroll
            for (int m = 0; m < 4; ++m) { const size_t row = (size_t)(row0 + ai * 128 + m * 16);
                const bf16_t* prow = P + row * LDP + PC_GR + col0; const float* xrow = xp + row * DM + col0;
                u32x2 gg[4]; f32x4 xv[4];
#pragma unroll
                for (int q = 0; q < 4; ++q) { const int o = (q >> 1) * 128 + (q & 1) * 16; gg[q] = *(const u32x2*)(prow + o); xv[q] = *(const f32x4*)(xrow + o); }
                float ss = 0.f;
#pragma unroll
                for (int q = 0; q < 4; ++q) { const f32x4 a = acc[ai][q >> 1][m][q & 1]; const f32x4 g4 = gt[q >> 1][q & 1];
                    f32x4 r; r[0] = xv[q][0] + g4[0] * (bf_lo(gg[q].x) * a[0]); r[1] = xv[q][1] + g4[1] * (bf_hi(gg[q].x) * a[1]);
                    r[2] = xv[q][2] + g4[2] * (bf_lo(gg[q].y) * a[2]); r[3] = xv[q][3] + g4[3] * (bf_hi(gg[q].y) * a[3]);
                    ss += (r[0] * r[0] + r[1] * r[1]) + (r[2] * r[2] + r[3] * r[3]);
                    acc[ai][q >> 1][m][q & 1] = r; }
                ss += __shfl_xor(ss, 16); ss += __shfl_xor(ss, 32);
                if (fq == 0) PT[(ai * 128 + wr * 64 + m * 16 + fr) * 4 + wc] = ss; }
        asm volatile("s_waitcnt lgkmcnt(0)" ::: "memory"); __builtin_amdgcn_s_barrier(); asm volatile("" ::: "memory");
        const int row = wid * 32 + (lane & 31);
        if (lane < 32) { const f32x4 p4 = *(const LAS f32x4*)(PT + row * 4);
            __hip_atomic_store(xbuf + ((size_t)(u.pm * 256 + row) * 8 + u.pn), (p4[0] + p4[1]) + (p4[2] + p4[3]), __ATOMIC_RELAXED, __HIP_MEMORY_SCOPE_AGENT); }
        asm volatile("s_waitcnt vmcnt(0)" ::: "memory");
        if (lane == 0) __hip_atomic_fetch_add(cnt + 64 * u.pm, 1u, __ATOMIC_RELAXED, __HIP_MEMORY_SCOPE_AGENT);
        if (wid == 0) {
            unsigned sp = 0;
            while ((unsigned)__builtin_amdgcn_readfirstlane(__hip_atomic_load(cnt + 64 * u.pm, __ATOMIC_RELAXED, __HIP_MEMORY_SCOPE_AGENT)) < 64u) { __builtin_amdgcn_s_sleep(2); if (++sp > (1u << 22)) break; }
            __builtin_amdgcn_fence(__ATOMIC_ACQUIRE, "agent");
        }
        asm volatile("s_waitcnt vmcnt(0) lgkmcnt(0)" ::: "memory"); __builtin_amdgcn_s_barrier(); asm volatile("" ::: "memory");
        if (lane < 32) { const float* sl = xbuf + (size_t)(u.pm * 256 + row) * 8; float s8 = 0.f;
#pragma unroll
            for (int t = 0; t < 8; ++t) s8 += __hip_atomic_load(sl + t, __ATOMIC_RELAXED, __HIP_MEMORY_SCOPE_AGENT);
            ST[row] = rsqrtf(s8 * (1.0f / DM) + RMS_EPS); }
        asm volatile("s_waitcnt lgkmcnt(0)" ::: "memory"); __builtin_amdgcn_s_barrier(); asm volatile("" ::: "memory");
        f32x4 fgv[2][2];
#pragma unroll
        for (int bj = 0; bj < 2; ++bj)
#pragma unroll
            for (int n = 0; n < 2; ++n) fgv[bj][n] = *(const f32x4*)(fg + col0 + bj * 128 + n * 16);
#pragma unroll
        for (int ai = 0; ai < 2; ++ai)
#pragma unroll
            for (int m = 0; m < 4; ++m) { const int rl = ai * 128 + wr * 64 + m * 16 + fr; const float rstd = ST[rl]; float* orow = out + (size_t)(u.pm * 256 + rl) * DM + col0;
#pragma unroll
                for (int bj = 0; bj < 2; ++bj)
#pragma unroll
                    for (int n = 0; n < 2; ++n) *(f32x4*)(orow + bj * 128 + n * 16) = acc[ai][bj][m][n] * rstd * fgv[bj][n]; }
    }
};

struct Args { const float* in[34]; float* out; unsigned char* ws; int ph_lo, ph_hi, li, pad; };
enum { I_XP = 0, I_XS, I_CP, I_CS, I_S5RE, I_S5IM, I_WKV, I_SHIFT, I_NORMG, I_WADA, I_BADA, I_WIN, I_MU, I_ARE, I_AIM, I_LOGSTEP, I_BRE, I_BIM, I_CRE, I_CIM, I_DSKIP,
       I_WGLU, I_BGLU, I_W0, I_W2, I_A0, I_A2, I_KK, I_KA, I_RK, I_GNW, I_GNB, I_WOUT, I_FINALG };

__device__ __forceinline__ void transpose_item(const float* W, int ldw, int K, int csrc, bf16_t* WT, int rdst, int k0, LAS float* scr, int lane, bool zero) {
    if (zero) {
#pragma unroll
        for (int j = 0; j < 4; ++j) { const int n = (lane >> 3) + 8 * j; *(u32x4*)(WT + (size_t)(rdst + n) * K + k0 + 8 * (lane & 7)) = (u32x4){0u, 0u, 0u, 0u}; }
        return;
    }
#pragma unroll 8
    for (int i = 0; i < 32; ++i) { const int kk = 2 * i + (lane >> 5); scr[kk * 33 + (lane & 31)] = W[(size_t)(k0 + kk) * ldw + csrc + (lane & 31)]; }
    LDS_WAIT(); asm volatile("" ::: "memory");
    const int c = lane & 7;
#pragma unroll
    for (int j = 0; j < 4; ++j) { const int n = (lane >> 3) + 8 * j; const LAS float* s = scr + (8 * c) * 33 + n;
        u32x4 o; o.x = cvt_pk_bf16(s[0 * 33], s[1 * 33]); o.y = cvt_pk_bf16(s[2 * 33], s[3 * 33]); o.z = cvt_pk_bf16(s[4 * 33], s[5 * 33]); o.w = cvt_pk_bf16(s[6 * 33], s[7 * 33]);
        *(u32x4*)(WT + (size_t)(rdst + n) * K + k0 + 8 * c) = o; }
    LDS_WAIT(); asm volatile("" ::: "memory");
}

__device__ __forceinline__ void lerp8(const bf16_t* cur, const bf16_t* prev, bool has_prev, const float* mu, float (&o)[8]) {
    const u32x4 c = *(const u32x4*)cur; u32x4 p = (u32x4){0u, 0u, 0u, 0u}; if (has_prev) p = *(const u32x4*)prev;
    const f32x4 m0 = *(const f32x4*)mu, m1 = *(const f32x4*)(mu + 4);
    const float cf[8] = {bf_lo(c.x), bf_hi(c.x), bf_lo(c.y), bf_hi(c.y), bf_lo(c.z), bf_hi(c.z), bf_lo(c.w), bf_hi(c.w)};
    const float pf[8] = {bf_lo(p.x), bf_hi(p.x), bf_lo(p.y), bf_hi(p.y), bf_lo(p.z), bf_hi(p.z), bf_lo(p.w), bf_hi(p.w)};
    const float mf[8] = {m0[0], m0[1], m0[2], m0[3], m1[0], m1[1], m1[2], m1[3]};
#pragma unroll
    for (int j = 0; j < 8; ++j) o[j] = cf[j] + (pf[j] - cf[j]) * mf[j];
}
__device__ __forceinline__ void p2_xw_panel(const Args& a, int pm, int tid) {
    const bf16_t* P = (const bf16_t*)(a.ws + WS_P); bf16_t* XW = (bf16_t*)(a.ws + WS_XW); const float* mu = a.in[I_MU];
    const int row = pm * 256 + (tid >> 1), hf = tid & 1; const bool hp = (row & (SEQ - 1)) != 0;
#pragma unroll
    for (int k8 = 0; k8 < 8; ++k8) { const int col = 64 * hf + 8 * k8; float x8[8];
        lerp8(P + (size_t)row * LDP + PC_WD + col, P + (size_t)(row - 1) * LDP + PC_WD + col, hp, mu + 3072 + col, x8);
        if (hf == 0) {
#pragma unroll
            for (int j = 0; j < 8; ++j) x8[j] = tanhf_(x8[j]); }
        u32x4 t; t.x = cvt_pk_bf16(x8[0], x8[1]); t.y = cvt_pk_bf16(x8[2], x8[3]); t.z = cvt_pk_bf16(x8[4], x8[5]); t.w = cvt_pk_bf16(x8[6], x8[7]);
        *(u32x4*)(XW + (size_t)row * 128 + col) = t; }
}
__device__ __forceinline__ void wait_count(unsigned* cnt, unsigned need, int wave) {
    if (wave == 0) { unsigned sp = 0;
        while ((unsigned)__builtin_amdgcn_readfirstlane(__hip_atomic_load(cnt, __ATOMIC_RELAXED, __HIP_MEMORY_SCOPE_AGENT)) < need) { __builtin_amdgcn_s_sleep(4); if (++sp > (1u << 22)) break; }
        __builtin_amdgcn_fence(__ATOMIC_ACQUIRE, "agent");
        asm volatile("s_waitcnt vmcnt(0)" ::: "memory"); }
    __syncthreads();
}
__device__ __forceinline__ void p0_mod(const Args& a, LAS unsigned char* lds, int s, int wave, int lane) {
    const float* cp = a.in[I_CP]; const float* cs = a.in[I_CS]; const float* W = a.in[I_WADA]; const float* bias = a.in[I_BADA];
    float* mod = (float*)(a.ws + WS_MOD);
    const int n0 = 32 * s, k0 = 256 * wave, r31 = lane & 31, h = lane >> 5;
    f32x16 acc[5];
#pragma unroll
    for (int t = 0; t < 5; ++t)
#pragma unroll
        for (int r = 0; r < 16; ++r) acc[t][r] = 0.f;
    float bw[8]; f32x4 c0[5], c1[5];
#define MOD_LOAD(ks_) do { const int kb_ = k0 + 16 * (ks_) + 8 * h; \
        _Pragma("unroll") for (int j = 0; j < 8; ++j) bw[j] = W[(size_t)(kb_ + j) * NMOD + n0 + r31]; \
        _Pragma("unroll") for (int t = 0; t < 5; ++t) { const int R = 32 * t + r31; c0[t] = (f32x4){0.f, 0.f, 0.f, 0.f}; c1[t] = c0[t]; \
            if (R < NMODROWS) { const float* src = (R < NB) ? cp + (size_t)R * DM + kb_ : cs + (size_t)(R - NB) * DM + kb_; c0[t] = *(const f32x4*)src; c1[t] = *(const f32x4*)(src + 4); } } } while (0)
    MOD_LOAD(0);
#pragma unroll 1
    for (int ks = 0; ks < 16; ++ks) {
        bf16x8 bfr; { u32x4 t; t.x = cvt_pk_bf16(bw[0], bw[1]); t.y = cvt_pk_bf16(bw[2], bw[3]); t.z = cvt_pk_bf16(bw[4], bw[5]); t.w = cvt_pk_bf16(bw[6], bw[7]); bfr = __builtin_bit_cast(bf16x8, t); }
        bf16x8 afr[5];
#pragma unroll
        for (int t = 0; t < 5; ++t) { u32x4 w; w.x = cvt_pk_bf16(siluf_(c0[t][0]), siluf_(c0[t][1])); w.y = cvt_pk_bf16(siluf_(c0[t][2]), siluf_(c0[t][3])); w.z = cvt_pk_bf16(siluf_(c1[t][0]), siluf_(c1[t][1])); w.w = cvt_pk_bf16(siluf_(c1[t][2]), siluf_(c1[t][3])); afr[t] = __builtin_bit_cast(bf16x8, w); }
        if (ks + 1 < 16) MOD_LOAD(ks + 1);
#pragma unroll
        for (int t = 0; t < 5; ++t) acc[t] = __builtin_amdgcn_mfma_f32_32x32x16_bf16(afr[t], bfr, acc[t], 0, 0, 0);
    }
#undef MOD_LOAD
    LAS float* red = (LAS float*)lds;
#pragma unroll
    for (int step = 4; step >= 1; step >>= 1) {
        if (wave >= step && wave < 2 * step) {
#pragma unroll
            for (int t = 0; t < 5; ++t)
#pragma unroll
                for (int r = 0; r < 16; ++r) red[(((wave - step) * 5 + t) * 16 + r) * 64 + lane] = acc[t][r];
        }
        __syncthreads();
        if (wave < step) {
#pragma unroll
            for (int t = 0; t < 5; ++t)
#pragma unroll
                for (int r = 0; r < 16; ++r) acc[t][r] += red[((wave * 5 + t) * 16 + r) * 64 + lane];
        }
        __syncthreads();
    }
    if (wave == 0) {
        const float bc = bias[n0 + r31];
#pragma unroll
        for (int t = 0; t < 5; ++t)
#pragma unroll
            for (int r = 0; r < 16; ++r) { const int R = 32 * t + (r & 3) + 8 * (r >> 2) + 4 * h; if (R < NMODROWS) mod[(size_t)R * NMOD + n0 + r31] = acc[t][r] + bc; }
    }
}

__device__ __forceinline__ void p0_s5_tables(const Args& a, LAS unsigned char* lds, int g, int tid) {
    LAS float* pw = (LAS float*)lds;
    LAS float* bbL = pw + 17 * 128;
    LAS float* ccL = bbL + 2048;
    LAS float* KF = ccL + 2048;
    LAS float* DL = KF + 4096;
    unsigned char* tab = (unsigned char*)a.out + DO_S5TAB + (size_t)g * S5T_BYTES;
    {
        const int p = tid & 63;
        const float step = expf(a.in[I_LOGSTEP][g]);
        const float lre = fminf(a.in[I_ARE][g * 64 + p], -1e-4f), lim = a.in[I_AIM][g * 64 + p];
        const float mag = expf(lre * step); float sn, cs; sincosf(lim * step, &sn, &cs);
        const float abr = mag * cs, abi = mag * sn, den = lre * lre + lim * lim;
        const float fr = ((abr - 1.0f) * lre + abi * lim) / den, fi = (abi * lre - (abr - 1.0f) * lim) / den;
        if (tid < 64) { float pr = 1.f, pi = 0.f;
            for (int e = 0; e <= 16; ++e) { pw[(e * 64 + p) * 2] = pr; pw[(e * 64 + p) * 2 + 1] = pi; const float nr = pr * abr - pi * abi, ni = pr * abi + pi * abr; pr = nr; pi = ni; } }
#pragma unroll
        for (int i = 0; i < 2; ++i) { const int c = (tid >> 6) + 8 * i; const float br = a.in[I_BRE][(g * 64 + p) * 16 + c], bi = a.in[I_BIM][(g * 64 + p) * 16 + c];
            bbL[(p * 16 + c) * 2] = fr * br - fi * bi; bbL[(p * 16 + c) * 2 + 1] = fr * bi + fi * br;
            ccL[(c * 64 + p) * 2] = a.in[I_CRE][(g * 16 + c) * 64 + p]; ccL[(c * 64 + p) * 2 + 1] = a.in[I_CIM][(g * 16 + c) * 64 + p]; }
        if (tid < 16) DL[tid] = a.in[I_DSKIP][g * 16 + tid];
    }
    __syncthreads();
    for (int idx = tid; idx < 4096; idx += 512) { const int e = idx >> 8, c = (idx >> 4) & 15, c2 = idx & 15; float s = 0.f;
        for (int p = 0; p < 64; ++p) { const float cr = ccL[(c * 64 + p) * 2], ci = ccL[(c * 64 + p) * 2 + 1], pr = pw[(e * 64 + p) * 2], pi = pw[(e * 64 + p) * 2 + 1];
            const float ar = cr * pr - ci * pi, ai = cr * pi + ci * pr; s += ar * bbL[(p * 16 + c2) * 2] - ai * bbL[(p * 16 + c2) * 2 + 1]; }
        if (e == 0 && c == c2) s += DL[c];
        KF[idx] = s; }
    __syncthreads();
    for (int it = tid; it < 4096; it += 512) { const int l = it & 63, s = (it >> 6) & 15, mtile = it >> 10; const int m = 32 * mtile + (l & 31), h = l >> 5, p = m & 63, im = m >> 6;
        const float pr = pw[((15 - s) * 64 + p) * 2], pi = pw[((15 - s) * 64 + p) * 2 + 1]; float v[8];
#pragma unroll
        for (int j = 0; j < 8; ++j) { const float br = bbL[(p * 16 + 8 * h + j) * 2], bi = bbL[(p * 16 + 8 * h + j) * 2 + 1]; v[j] = im ? (pr * bi + pi * br) : (pr * br - pi * bi); }
        u32x4 w; w.x = cvt_pk_bf16(v[0], v[1]); w.y = cvt_pk_bf16(v[2], v[3]); w.z = cvt_pk_bf16(v[4], v[5]); w.w = cvt_pk_bf16(v[6], v[7]);
        *(u32x4*)(tab + S5T_ME + (size_t)it * 16) = w; }
    for (int it = tid; it < 1024; it += 512) { const int l = it & 63, ti = it >> 6; const int rho = l & 31, dt = rho >> 4, c = rho & 15, h = l >> 5, e = ti - 1 + dt; float v[8];
#pragma unroll
        for (int j = 0; j < 8; ++j) v[j] = (e < 0) ? 0.f : KF[(e * 16 + c) * 16 + 8 * h + j];
        u32x4 w; w.x = cvt_pk_bf16(v[0], v[1]); w.y = cvt_pk_bf16(v[2], v[3]); w.z = cvt_pk_bf16(v[4], v[5]); w.w = cvt_pk_bf16(v[6], v[7]);
        *(u32x4*)(tab + S5T_KT + (size_t)it * 16) = w; }
    for (int it = tid; it < 4096; it += 512) { const int l = it & 63, ks = (it >> 6) & 7, mt = it >> 9; const int rho = l & 31, dt = rho >> 4, c = rho & 15, h = l >> 5, t = 2 * mt + dt; float v[8];
#pragma unroll
        for (int j = 0; j < 8; ++j) { const int m = 16 * ks + 8 * h + j, p = m & 63; const float cr = ccL[(c * 64 + p) * 2], ci = ccL[(c * 64 + p) * 2 + 1], pr = pw[((t + 1) * 64 + p) * 2], pi = pw[((t + 1) * 64 + p) * 2 + 1];
            v[j] = (m < 64) ? (cr * pr - ci * pi) : -(cr * pi + ci * pr); }
        u32x4 w; w.x = cvt_pk_bf16(v[0], v[1]); w.y = cvt_pk_bf16(v[2], v[3]); w.z = cvt_pk_bf16(v[4], v[5]); w.w = cvt_pk_bf16(v[6], v[7]);
        *(u32x4*)(tab + S5T_CA + (size_t)it * 16) = w; }
    { const int it = tid; const int l = it & 63, sp = (it >> 6) & 1, mtile = it >> 7; const int rho = l & 31, h = l >> 5; float v[8];
#pragma unroll
        for (int j = 0; j < 8; ++j) { const int m = 32 * mtile + 16 * sp + 8 * (j >> 2) + 4 * h + (j & 3), p = m & 63; v[j] = (rho < 16) ? ((m < 64) ? ccL[(rho * 64 + p) * 2] : -ccL[(rho * 64 + p) * 2 + 1]) : 0.f; }
        u32x4 w; w.x = cvt_pk_bf16(v[0], v[1]); w.y = cvt_pk_bf16(v[2], v[3]); w.z = cvt_pk_bf16(v[4], v[5]); w.w = cvt_pk_bf16(v[6], v[7]);
        *(u32x4*)(tab + S5T_C0 + (size_t)it * 16) = w; }
    if (tid < 64) { const int l = tid, rho = l & 31, h = l >> 5; float v[8];
#pragma unroll
        for (int j = 0; j < 8; ++j) v[j] = (rho < 16 && rho == 8 * h + j) ? DL[rho] : 0.f;
        u32x4 w; w.x = cvt_pk_bf16(v[0], v[1]); w.y = cvt_pk_bf16(v[2], v[3]); w.z = cvt_pk_bf16(v[4], v[5]); w.w = cvt_pk_bf16(v[6], v[7]);
        *(u32x4*)(tab + S5T_DF + (size_t)l * 16) = w;
        float* hdr = (float*)(tab + S5T_HDR);
        hdr[l] = pw[(16 * 64 + l) * 2]; hdr[64 + l] = pw[(16 * 64 + l) * 2 + 1]; hdr[128 + l] = pw[(64 + l) * 2]; hdr[192 + l] = pw[(64 + l) * 2 + 1]; }
    __syncthreads();
}

__device__ __forceinline__ void p1_row(const Args& a, int m, int lane) {
    bf16_t* XN = (bf16_t*)(a.ws + WS_XN) + (size_t)m * DM;
    if (m >= MV) {
        const float* src = a.in[I_SHIFT] + (size_t)(m - MV) * DM;
#pragma unroll
        for (int j = 0; j < 8; ++j) { const f32x4 v = *(const f32x4*)(src + 4 * lane + 256 * j); u32x2 w; w.x = cvt_pk_bf16(v[0], v[1]); w.y = cvt_pk_bf16(v[2], v[3]); *(u32x2*)(XN + 4 * lane + 256 * j) = w; }
        return;
    }
    const float* x = (m < MP) ? a.in[I_XP] + (size_t)m * DM : a.in[I_XS] + (size_t)(m - MP) * DM;
    const int mrow = (m < MP) ? (m >> 11) : (NB + m - MP);
    const float* mod = (const float*)(a.ws + WS_MOD) + (size_t)mrow * NMOD;
    const float* g = a.in[I_NORMG];
    f32x4 v[8]; float ss = 0.f;
#pragma unroll
    for (int j = 0; j < 8; ++j) { v[j] = *(const f32x4*)(x + 4 * lane + 256 * j); ss += (v[j][0] * v[j][0] + v[j][1] * v[j][1]) + (v[j][2] * v[j][2] + v[j][3] * v[j][3]); }
    const float rstd = rsqrtf(wave_sum(ss) * (1.0f / DM) + RMS_EPS);
    float* sh_out = nullptr;
    if (m >= MP) sh_out = a.out + OUT_SHIFT_S + (size_t)(m - MP) * DM;
    else if ((m & (SEQ - 1)) == SEQ - 1) sh_out = a.out + OUT_SHIFT_P + (size_t)(m >> 11) * DM;
#pragma unroll
    for (int j = 0; j < 8; ++j) { const int k = 4 * lane + 256 * j; const f32x4 gv = *(const f32x4*)(g + k), sh = *(const f32x4*)(mod + k), sc = *(const f32x4*)(mod + DM + k);
        f32x4 hv;
#pragma unroll
        for (int q = 0; q < 4; ++q) hv[q] = v[j][q] * rstd * gv[q] * (1.0f + sc[q]) + sh[q];
        u32x2 w; w.x = cvt_pk_bf16(hv[0], hv[1]); w.y = cvt_pk_bf16(hv[2], hv[3]); *(u32x2*)(XN + k) = w;
        if (sh_out) *(f32x4*)(sh_out + k) = hv; }
}

constexpr int RW_TB = 32;
constexpr int RW_KK = 0, RW_DR = 2048, RW_DD = 4096, RW_BB = 6144, RW_KP = 8192, RW_VV = 10240, RW_SC = 11264, RW_LW = 11392, RW_LA = 13440, RW_OB = 15488, RW_BVB = 16512, RW_END = 17536;
struct RwTok { float kk, dr, dd, bb, kp, v, br, kr, bonus; };
__device__ __forceinline__ RwTok rw_token(const Args& a, int hj, float r, float k, float v, float lw, float la) {
    RwTok o;
    const float wpre = a.in[I_W0][hj] + lw;
    const float nz = -wpre;
    const float sp = fmaxf(nz, 0.f) + log1pf(__expf(-fabsf(nz)));
    const float w = -sp - 0.5f;
    o.dd = __expf(-__expf(w));
    const float av = sigmoidf_(a.in[I_A0][hj] + la);
    const float kkv = k * a.in[I_KK][hj];
    const float nrm = sqrtf(wave_sum(kkv * kkv));
    o.kk = kkv / fmaxf(nrm, 1e-12f);
    o.kp = k * (1.0f + (av - 1.0f) * a.in[I_KA][hj]);
    o.bb = o.kk * av;
    o.dr = o.dd * r;
    o.v = v;
    o.br = wave_sum(o.bb * r);
    o.kr = wave_sum(o.kp * r);
    o.bonus = wave_sum(r * o.kp * a.in[I_RK][hj]);
    return o;
}
__device__ __forceinline__ void p3_rwkv_prompt(const Args& a, LAS unsigned char* lds, int unit, int tid, int wave, int lane) {
    const int b = unit >> 5, h = (unit >> 1) & 15, half = unit & 1;
    LAS float* L = (LAS float*)lds;
    const bf16_t* P = (const bf16_t*)(a.ws + WS_P);
    bf16_t* ORAW = (bf16_t*)((unsigned char*)a.out + DO_ORAW); bf16_t* BV = (bf16_t*)((unsigned char*)a.out + DO_BV);
    const float* mu = a.in[I_MU];
    const int r31 = lane & 31, hh = lane >> 5;
    bf16x8 bfr[4];
    if (wave < 4) { const float* W2 = (wave >> 1) ? a.in[I_A2] : a.in[I_W2]; const int col = h * 64 + 32 * (wave & 1) + r31;
#pragma unroll
        for (int ks = 0; ks < 4; ++ks) { float w[8];
#pragma unroll
            for (int j = 0; j < 8; ++j) w[j] = W2[(size_t)(16 * ks + 8 * hh + j) * 1024 + col];
            u32x4 t; t.x = cvt_pk_bf16(w[0], w[1]); t.y = cvt_pk_bf16(w[2], w[3]); t.z = cvt_pk_bf16(w[4], w[5]); t.w = cvt_pk_bf16(w[6], w[7]); bfr[ks] = __builtin_bit_cast(bf16x8, t); } }
    const int srow = 4 * wave + (lane >> 4), cq = lane & 15;
    f32x4 S = (f32x4){0.f, 0.f, 0.f, 0.f};
    for (int t0 = 0; t0 < SEQ; t0 += RW_TB) {
        const size_t rowbase = (size_t)b * SEQ + t0;
        if (wave < 4) { const int mat = wave >> 1, nt2 = wave & 1; const size_t row = rowbase + r31; const bool hp = (t0 + r31) > 0;
            f32x16 acc;
#pragma unroll
            for (int r = 0; r < 16; ++r) acc[r] = 0.f;
#pragma unroll
            for (int ks = 0; ks < 4; ++ks) { const int col = PC_WD + mat * 64 + 16 * ks + 8 * hh; float x8[8];
                lerp8(P + row * LDP + col, P + (row - 1) * LDP + col, hp, mu + 3072 + mat * 64 + 16 * ks + 8 * hh, x8);
                if (mat == 0) {
#pragma unroll
                    for (int j = 0; j < 8; ++j) x8[j] = tanhf_(x8[j]); }
                u32x4 t; t.x = cvt_pk_bf16(x8[0], x8[1]); t.y = cvt_pk_bf16(x8[2], x8[3]); t.z = cvt_pk_bf16(x8[4], x8[5]); t.w = cvt_pk_bf16(x8[6], x8[7]);
                acc = __builtin_amdgcn_mfma_f32_32x32x16_bf16(__builtin_bit_cast(bf16x8, t), bfr[ks], acc, 0, 0, 0); }
            LAS float* dst = L + (mat ? RW_LA : RW_LW);
#pragma unroll
            for (int r = 0; r < 16; ++r) { const int tl = (r & 3) + 8 * (r >> 2) + 4 * hh; dst[tl * 64 + 32 * nt2 + r31] = acc[r]; } }
        __syncthreads();
#pragma unroll
        for (int q = 0; q < 4; ++q) { const int tl = wave * 4 + q; const size_t row = rowbase + tl; const bool hp = (t0 + tl) > 0; const int hj = h * 64 + lane;
            const bf16_t* pc = P + row * LDP; const bf16_t* pp = pc - LDP;
            float r = bf2f(pc[PC_R + hj]), k = bf2f(pc[PC_K + hj]), v = bf2f(pc[PC_V + hj]);
            const float pr = hp ? bf2f(pp[PC_R + hj]) : 0.f, pk = hp ? bf2f(pp[PC_K + hj]) : 0.f, pv = hp ? bf2f(pp[PC_V + hj]) : 0.f;
            r += (pr - r) * mu[hj]; k += (pk - k) * mu[1024 + hj]; v += (pv - v) * mu[2048 + hj];
            const RwTok o = rw_token(a, hj, r, k, v, L[RW_LW + tl * 64 + lane], L[RW_LA + tl * 64 + lane]);
            L[RW_KK + tl * 64 + lane] = o.kk; L[RW_DR + tl * 64 + lane] = o.dr; L[RW_DD + tl * 64 + lane] = o.dd; L[RW_BB + tl * 64 + lane] = o.bb; L[RW_KP + tl * 64 + lane] = o.kp;
            if ((lane >> 5) == half) L[RW_VV + tl * 32 + (lane & 31)] = o.v;
            if (lane == 0) { L[RW_SC + tl * 4] = o.br; L[RW_SC + tl * 4 + 1] = o.kr; L[RW_SC + tl * 4 + 2] = o.bonus; } }
        __syncthreads();
#pragma unroll 4
        for (int tl = 0; tl < RW_TB; ++tl) {
            const f32x4 kk4 = *(const LAS f32x4*)(L + RW_KK + tl * 64 + 4 * cq), dr4 = *(const LAS f32x4*)(L + RW_DR + tl * 64 + 4 * cq), d4 = *(const LAS f32x4*)(L + RW_DD + tl * 64 + 4 * cq),
                        b4 = *(const LAS f32x4*)(L + RW_BB + tl * 64 + 4 * cq), k4 = *(const LAS f32x4*)(L + RW_KP + tl * 64 + 4 * cq);
            const float v = L[RW_VV + tl * 32 + srow]; const f32x4 sc = *(const LAS f32x4*)(L + RW_SC + tl * 4);
            float p1 = (S[0] * kk4[0] + S[1] * kk4[1]) + (S[2] * kk4[2] + S[3] * kk4[3]);
            float p2 = (S[0] * dr4[0] + S[1] * dr4[1]) + (S[2] * dr4[2] + S[3] * dr4[3]);
            p1 = row16_sum(p1); p2 = row16_sum(p2);
            const float sa = -p1;
            const float o = p2 + sa * sc[0] + v * sc[1];
#pragma unroll
            for (int j = 0; j < 4; ++j) S[j] = S[j] * d4[j] + sa * b4[j] + v * k4[j];
            if (cq == 0) { L[RW_OB + tl * 32 + srow] = o; L[RW_BVB + tl * 32 + srow] = sc[2] * v; }
        }
        __syncthreads();
        { const int tl = tid >> 4, r2 = 2 * (tid & 15); const size_t off = (rowbase + tl) * 1024 + h * 64 + 32 * half + r2;
          *(unsigned*)(ORAW + off) = cvt_pk_bf16(L[RW_OB + tl * 32 + r2], L[RW_OB + tl * 32 + r2 + 1]);
          *(unsigned*)(BV + off) = cvt_pk_bf16(L[RW_BVB + tl * 32 + r2], L[RW_BVB + tl * 32 + r2 + 1]); }
    }
    *(f32x4*)(a.out + OUT_WKV_P + (((size_t)(b * 16 + h) * 64 + 32 * half + srow) * 64 + 4 * cq)) = S;
    __syncthreads();
}


constexpr int RC_LD = 72, RC_MAT = 64 * RC_LD * 2;
constexpr int RC_QK = 0 * RC_MAT, RC_RT = 1 * RC_MAT, RC_KT = 2 * RC_MAT, RC_BT = 3 * RC_MAT, RC_QKT = 4 * RC_MAT, RC_BHT = 5 * RC_MAT, RC_KHT = 6 * RC_MAT, RC_VT = 7 * RC_MAT,
              RC_AKK = 8 * RC_MAT, RC_ARK = 9 * RC_MAT, RC_ARB = 10 * RC_MAT, RC_TB = 11 * RC_MAT, RC_AKB = 12 * RC_MAT, RC_W1T = 12 * RC_MAT, RC_U1T = 13 * RC_MAT,
              RC_AVT = RC_QK, RC_TF = RC_KT, RC_LWA = RC_AKK, RC_SEG = 14 * RC_MAT;
static_assert(RC_SEG + 2048 <= RING_BYTES, "rwkv chunk lds");
constexpr int RS_ROWB = 656, RS_BASE = 0;
static_assert(RS_BASE + 65 * RS_ROWB <= RC_AKK, "staging must stay inside R0..R7");
#define MFMA32(a, b, c) __builtin_amdgcn_mfma_f32_32x32x16_bf16((a), (b), (c), 0, 0, 0)
#define MFMA16(a, b, c) __builtin_amdgcn_mfma_f32_16x16x32_bf16((a), (b), (c), 0, 0, 0)
__device__ __forceinline__ bf16x8 lds_frag(LAS unsigned char* lds, int mat, int row, int k0) { return *(const LAS bf16x8*)(lds + mat + (row * RC_LD + k0) * 2); }

template <int MAT, int MS, int NT>
__device__ __forceinline__ void rwc_stage1_job(LAS unsigned char* lds, int r31, int hh) {
    constexpr int X = (MAT & 1) ? RC_BT : RC_KT, Y = (MAT & 2) ? RC_RT : RC_QK;
    constexpr bool incl = (MAT & 2) != 0, diag = (MS == NT);
    f32x16 acc;
#pragma unroll
    for (int r = 0; r < 16; ++r) acc[r] = 0.f;
#pragma unroll
    for (int ks = 0; ks < 4; ++ks) acc = MFMA32(lds_frag(lds, X, 32 * MS + r31, 16 * ks + 8 * hh), lds_frag(lds, Y, 32 * NT + r31, 16 * ks + 8 * hh), acc);
    const int t = 32 * NT + r31, d0 = r31 - 4 * hh;
#pragma unroll
    for (int g4 = 0; g4 < 4; ++g4) { const int s0 = 32 * MS + 8 * g4 + 4 * hh; float v[4];
#pragma unroll
        for (int e = 0; e < 4; ++e) v[e] = (!diag || (incl ? (8 * g4 + e <= d0) : (8 * g4 + e < d0))) ? acc[4 * g4 + e] : 0.f;
        if (MAT == 1) *(LAS f32x4*)(lds + RC_AKB + (t * 72 + s0) * 4) = (f32x4){v[0], v[1], v[2], v[3]};
        else { constexpr int dstm = (MAT == 0) ? RC_AKK : ((MAT == 2) ? RC_ARK : RC_ARB); *(LAS u32x2*)(lds + dstm + (t * RC_LD + s0) * 2) = pack4(v[0], v[1], v[2], v[3]); } }
}
__device__ __forceinline__ void p3_rwkv_chunks(const Args& a, LAS unsigned char* lds, int bh, int seg, int tid, int wave, int lane) {
    const int b = bh >> 4, h = bh & 15, r31_ = lane & 31, hh_ = lane >> 5, hj = h * 64 + lane;
    const bf16_t* P = (const bf16_t*)(a.ws + WS_P);
    bf16_t* BV = (bf16_t*)((unsigned char*)a.out + DO_BV);
    const float* mu = a.in[I_MU];
    LAS float* SEG = (LAS float*)(lds + RC_SEG);
    bf16x8 bfr[4];
    { const float* W2 = (wave >> 2) ? a.in[I_A2] : a.in[I_W2]; const int col = h * 64 + 32 * (wave & 1) + r31_;
#pragma unroll
      for (int ks = 0; ks < 4; ++ks) { float w[8];
#pragma unroll
          for (int j = 0; j < 8; ++j) w[j] = W2[(size_t)(16 * ks + 8 * hh_ + j) * 1024 + col];
          u32x4 t; t.x = cvt_pk_bf16(w[0], w[1]); t.y = cvt_pk_bf16(w[2], w[3]); t.z = cvt_pk_bf16(w[4], w[5]); t.w = cvt_pk_bf16(w[6], w[7]); bfr[ks] = __builtin_bit_cast(bf16x8, t); } }
    const int hj2 = h * 64 + 2 * r31_;
    const f32x2 w02 = *(const f32x2*)(a.in[I_W0] + hj2), a02 = *(const f32x2*)(a.in[I_A0] + hj2), kk2 = *(const f32x2*)(a.in[I_KK] + hj2), ka2 = *(const f32x2*)(a.in[I_KA] + hj2), rk2 = *(const f32x2*)(a.in[I_RK] + hj2);
    const f32x2 mur2 = *(const f32x2*)(mu + hj2), muk2 = *(const f32x2*)(mu + 1024 + hj2), muv2 = *(const f32x2*)(mu + 2048 + hj2);
    unsigned goff[6], loff[6]; u32x4 pf[6];
#pragma unroll
    for (int i = 0; i < 6; ++i) { const int idx = tid + 512 * i, row = idx / 40, c = idx - row * 40;
        const int col = (c < 8) ? PC_R + h * 64 + 8 * c : ((c < 16) ? PC_K + h * 64 + 8 * (c - 8) : PC_V + h * 64 + 8 * (c - 16));
        goff[i] = (c < 24) ? (unsigned)(row * LDP + col) * 2u : (0x80000000u | (unsigned)(row * 128 + 8 * (c - 24)) * 2u);   loff[i] = (unsigned)(RS_BASE + row * RS_ROWB + c * 16); }
#define RWC_PREFETCH(chunk_) do { const unsigned char* pb_ = (const unsigned char*)(P + ((size_t)b * SEQ + (size_t)(chunk_) * 64 - 1) * LDP); \
        const unsigned char* xb_ = a.ws + WS_XW + ((size_t)b * SEQ + (size_t)(chunk_) * 64) * 256 - 256; \
        _Pragma("unroll") for (int i = 0; i < 6; ++i) { const bool ok_ = (tid + 512 * i < 2600) && ((chunk_) > 0 || tid + 512 * i >= 40); \
            pf[i] = (u32x4){0u, 0u, 0u, 0u}; if (ok_) pf[i] = (goff[i] & 0x80000000u) ? *(const u32x4*)(xb_ + (goff[i] & 0x7fffffffu)) : *(const u32x4*)(pb_ + goff[i]); } } while (0)
    RWC_PREFETCH(seg * 8);
#pragma unroll 1
    for (int ci = 0; ci < 8; ++ci) {
        const int chunk = seg * 8 + ci; const size_t rowbase = (size_t)b * SEQ + chunk * 64;
#pragma unroll
        for (int i = 0; i < 6; ++i) if (tid + 512 * i < 2600) *(LAS u32x4*)(lds + loff[i]) = pf[i];
        if (ci + 1 < 8) RWC_PREFETCH(chunk + 1);
        __syncthreads();
        int r31 = r31_, hh = hh_; asm volatile("" : "+v"(r31), "+v"(hh));
        unsigned char* rwi = a.ws + WS_RWI + (size_t)((bh * 32) + chunk) * RWI_BYTES;
        { const int mat = wave >> 2, mtile = (wave >> 1) & 1, nt2 = wave & 1; const int tl = 32 * mtile + r31;
          f32x16 acc;
#pragma unroll
          for (int r = 0; r < 16; ++r) acc[r] = 0.f;
#pragma unroll
          for (int ks = 0; ks < 4; ++ks) acc = MFMA32(*(const LAS bf16x8*)(lds + RS_BASE + (tl + 1) * RS_ROWB + (24 + mat * 8 + 2 * ks + hh) * 16), bfr[ks], acc);
          LAS float* dst = (LAS float*)(lds + RC_LWA) + mat * 64 * 68;
#pragma unroll
          for (int r = 0; r < 16; ++r) { const int t2 = 32 * mtile + (r & 3) + 8 * (r >> 2) + 4 * hh; dst[t2 * 68 + 32 * nt2 + r31] = acc[r]; } }
        __syncthreads();
        f32x2 r4[4], kp4[4], kk4v[4], bb4[4], v4[4], cs4[4];
        LAS float* SEG2 = (LAS float*)(lds + RC_AKB);
        const int half = hh, j2 = 2 * r31, tq0 = 8 * wave + 4 * half;
        { const LAS float* LW = (const LAS float*)(lds + RC_LWA); const LAS float* LA = LW + 64 * 68;
#pragma unroll
          for (int q = 0; q < 4; ++q) { const int tl = tq0 + q; const size_t row = rowbase + tl;
              const LAS unsigned char* pc = lds + RS_BASE + (tl + 1) * RS_ROWB + j2 * 2; const LAS unsigned char* pp = lds + RS_BASE + tl * RS_ROWB + j2 * 2;
              const unsigned cr = *(const LAS unsigned*)pc, ck = *(const LAS unsigned*)(pc + 128), cv = *(const LAS unsigned*)(pc + 256);
              const unsigned qr = *(const LAS unsigned*)pp, qk_ = *(const LAS unsigned*)(pp + 128), qv = *(const LAS unsigned*)(pp + 256);
              f32x2 r = {bf_lo(cr), bf_hi(cr)}, k = {bf_lo(ck), bf_hi(ck)}, v = {bf_lo(cv), bf_hi(cv)};
              const f32x2 pr = {bf_lo(qr), bf_hi(qr)}, pk = {bf_lo(qk_), bf_hi(qk_)}, pv = {bf_lo(qv), bf_hi(qv)};
              r += (pr - r) * mur2; k += (pk - k) * muk2; v += (pv - v) * muv2;
              const f32x2 lw = *(const LAS f32x2*)(LW + tl * 68 + j2), la = *(const LAS f32x2*)(LA + tl * 68 + j2);
              const f32x2 xw = w02 + lw, xa = a02 + la;
              const f32x2 ld = {-0.6065306597126334f * sigmoidf_(xw[0]), -0.6065306597126334f * sigmoidf_(xw[1])};
              const f32x2 av = {sigmoidf_(xa[0]), sigmoidf_(xa[1])};
              const f32x2 kkv = k * kk2;
              const float rn = fminf(__builtin_amdgcn_rsqf(half_sum32(kkv[0] * kkv[0] + kkv[1] * kkv[1], half != 0)), 1e12f);
              kk4v[q] = kkv * rn; kp4[q] = k * (1.0f + (av - 1.0f) * ka2); bb4[q] = kk4v[q] * av; r4[q] = r; v4[q] = v;
              const f32x2 rk_ = r * kp4[q] * rk2;
              const float bonus = half_sum32(rk_[0] + rk_[1], half != 0);
              *(unsigned*)(BV + row * 1024 + h * 64 + j2) = cvt_pk_bf16(bonus * v[0], bonus * v[1]);
              cs4[q] = (q == 0) ? ld : cs4[q > 0 ? q - 1 : 0] + ld; }
          *(LAS f32x2*)(SEG2 + (2 * wave + half) * 64 + j2) = cs4[3]; }
        __syncthreads();
        { f32x2 off = {0.f, 0.f}, cL = {0.f, 0.f};
#pragma unroll
          for (int sg = 0; sg < 16; ++sg) { const f32x2 x = *(const LAS f32x2*)(SEG2 + sg * 64 + j2); cL += x; if (sg < 2 * wave + half) off += x; }
          const f32x2 eLtot = {__expf(cL[0]), __expf(cL[1])};
          if (wave == 0 && half == 0) *(f32x2*)(rwi + RWI_LAM + j2 * 4) = eLtot;
          f32x2 ecprev = {__expf(off[0]), __expf(off[1])};
          f32x2 qkT[4], bhT[4], khT[4];
#pragma unroll
          for (int q = 0; q < 4; ++q) { const int tl = tq0 + q; const f32x2 c = off + cs4[q];
              const f32x2 ec = {__expf(c[0]), __expf(c[1])}, ecp = ecprev, enc = {rcpf_(ec[0]), rcpf_(ec[1])}, eL = eLtot * enc; ecprev = ec;
              const f32x2 qk = kk4v[q] * ecp, rt = r4[q] * ec, kt = kp4[q] * enc, bt = bb4[q] * enc;
              *(LAS unsigned*)(lds + RC_QK + (tl * RC_LD + j2) * 2) = cvt_pk_bf16(qk[0], qk[1]); *(LAS unsigned*)(lds + RC_RT + (tl * RC_LD + j2) * 2) = cvt_pk_bf16(rt[0], rt[1]);
              *(LAS unsigned*)(lds + RC_KT + (tl * RC_LD + j2) * 2) = cvt_pk_bf16(kt[0], kt[1]); *(LAS unsigned*)(lds + RC_BT + (tl * RC_LD + j2) * 2) = cvt_pk_bf16(bt[0], bt[1]);
              qkT[q] = qk; bhT[q] = bb4[q] * eL; khT[q] = kp4[q] * eL; }
#pragma unroll
          for (int ch = 0; ch < 2; ++ch) { const int ro = ((j2 + ch) * RC_LD + tq0) * 2;
              *(LAS u32x2*)(lds + RC_QKT + ro) = pack4(qkT[0][ch], qkT[1][ch], qkT[2][ch], qkT[3][ch]); *(LAS u32x2*)(lds + RC_BHT + ro) = pack4(bhT[0][ch], bhT[1][ch], bhT[2][ch], bhT[3][ch]);
              *(LAS u32x2*)(lds + RC_KHT + ro) = pack4(khT[0][ch], khT[1][ch], khT[2][ch], khT[3][ch]); *(LAS u32x2*)(lds + RC_VT + ro) = pack4(v4[0][ch], v4[1][ch], v4[2][ch], v4[3][ch]); } }
        __syncthreads();
        switch (wave) {
            case 0: rwc_stage1_job<0, 0, 0>(lds, r31, hh); rwc_stage1_job<2, 1, 1>(lds, r31, hh); break;
            case 1: rwc_stage1_job<0, 0, 1>(lds, r31, hh); rwc_stage1_job<3, 0, 0>(lds, r31, hh); break;
            case 2: rwc_stage1_job<0, 1, 1>(lds, r31, hh); rwc_stage1_job<3, 0, 1>(lds, r31, hh); break;
            case 3: rwc_stage1_job<1, 0, 0>(lds, r31, hh); rwc_stage1_job<3, 1, 1>(lds, r31, hh); break;
            case 4: rwc_stage1_job<1, 0, 1>(lds, r31, hh); break;
            case 5: rwc_stage1_job<1, 1, 1>(lds, r31, hh); break;
            case 6: rwc_stage1_job<2, 0, 0>(lds, r31, hh); break;
            default: rwc_stage1_job<2, 0, 1>(lds, r31, hh); break;
        }
        __syncthreads();
        LAS float* TF = (LAS float*)(lds + RC_TF); const LAS float* AKB = (const LAS float*)(lds + RC_AKB); LAS float* YS = SEG;
        if (wave == 0) {
            const int I = lane >> 4, jj = lane & 15; float x[16];
#pragma unroll
            for (int r = 0; r < 16; ++r) { float sacc = (r == jj) ? 1.f : 0.f;
#pragma unroll
                for (int q = 0; q < r; ++q) sacc -= AKB[(16 * I + r) * 72 + 16 * I + q] * x[q];
                x[r] = sacc; TF[(16 * I + r) * 72 + 16 * I + jj] = sacc; }
        } else if (wave < 4) {
            const int t2 = tid - 64;
            for (int e = t2; e < 512; e += 192) { const int blk = e >> 8, rr = (e >> 4) & 15, cc = e & 15; TF[(32 * blk + rr) * 72 + 32 * blk + 16 + cc] = 0.f; }
        } else {
            const int mt = (wave >> 1) & 1, nt2 = wave & 1; f32x16 acc;
#pragma unroll
            for (int r = 0; r < 16; ++r) acc[r] = 0.f;
#pragma unroll
            for (int ks = 0; ks < 4; ++ks) if (ks < 2 || mt == 1) acc = MFMA32(lds_frag(lds, RC_AKK, 32 * mt + r31, 16 * ks + 8 * hh), lds_frag(lds, RC_VT, 32 * nt2 + r31, 16 * ks + 8 * hh), acc);
#pragma unroll
            for (int g4 = 0; g4 < 4; ++g4) *(LAS u32x2*)(lds + RC_AVT + ((32 * nt2 + r31) * RC_LD + 32 * mt + 8 * g4 + 4 * hh) * 2) = pack4(acc[4 * g4], acc[4 * g4 + 1], acc[4 * g4 + 2], acc[4 * g4 + 3]);
        }
        __syncthreads();
        { const int pr = tid >> 8, i = (tid >> 4) & 15, jj = tid & 15, ba = 2 * pr, bb = 2 * pr + 1;
          float y = 0.f;
#pragma unroll
          for (int q = 0; q < 16; ++q) y += AKB[(16 * bb + i) * 72 + 16 * ba + q] * TF[(16 * ba + q) * 72 + 16 * ba + jj];
          YS[tid] = y; }
        __syncthreads();
        { const int pr = tid >> 8, i = (tid >> 4) & 15, jj = tid & 15, ba = 2 * pr, bb = 2 * pr + 1; float tv = 0.f;
#pragma unroll
          for (int q = 0; q < 16; ++q) tv -= TF[(16 * bb + i) * 72 + 16 * bb + q] * YS[pr * 256 + q * 16 + jj];
          TF[(16 * bb + i) * 72 + 16 * ba + jj] = tv; }
        __syncthreads();
        { const int i = tid >> 4, j0 = (tid & 15) * 2; float z0 = 0.f, z1 = 0.f;
#pragma unroll 8
          for (int q = 0; q < 32; ++q) { const float av = AKB[(32 + i) * 72 + q]; z0 += av * TF[q * 72 + j0]; z1 += av * TF[q * 72 + j0 + 1]; }
          TF[i * 72 + 32 + j0] = z0; TF[i * 72 + 32 + j0 + 1] = z1; }
        __syncthreads();
        { const int i = tid >> 4, j0 = (tid & 15) * 2; float t0 = 0.f, t1 = 0.f;
#pragma unroll 8
          for (int q = 0; q < 32; ++q) { const float tb = TF[(32 + i) * 72 + 32 + q]; t0 -= tb * TF[q * 72 + 32 + j0]; t1 -= tb * TF[q * 72 + 32 + j0 + 1]; }
          TF[(32 + i) * 72 + j0] = t0; TF[(32 + i) * 72 + j0 + 1] = t1; }
        __syncthreads();
        { const int which = wave >> 2, mt = (wave >> 1) & 1, nt2 = wave & 1; const int Bm = which ? RC_AVT : RC_QKT, Dm = which ? RC_U1T : RC_W1T; f32x16 acc;
#pragma unroll
          for (int r = 0; r < 16; ++r) acc[r] = 0.f;
#pragma unroll
          for (int ks = 0; ks < 4; ++ks) if (ks < 2 || mt == 1) { const LAS float* tp = TF + (32 * mt + r31) * 72 + 16 * ks + 8 * hh; const f32x4 x0 = *(const LAS f32x4*)tp, x1 = *(const LAS f32x4*)(tp + 4);
              u32x4 w; w.x = cvt_pk_bf16(x0[0], x0[1]); w.y = cvt_pk_bf16(x0[2], x0[3]); w.z = cvt_pk_bf16(x1[0], x1[1]); w.w = cvt_pk_bf16(x1[2], x1[3]);
              acc = MFMA32(__builtin_bit_cast(bf16x8, w), lds_frag(lds, Bm, 32 * nt2 + r31, 16 * ks + 8 * hh), acc); }
#pragma unroll
          for (int g4 = 0; g4 < 4; ++g4) *(LAS u32x2*)(lds + Dm + ((32 * nt2 + r31) * RC_LD + 32 * mt + 8 * g4 + 4 * hh) * 2) = pack4(acc[4 * g4], acc[4 * g4 + 1], acc[4 * g4 + 2], acc[4 * g4 + 3]); }
        __syncthreads();
        { const int kind = wave >> 2, mt = (wave >> 1) & 1, nt2 = wave & 1; const int cidx = 32 * nt2 + r31;
          f32x16 acc;
#pragma unroll
          for (int r = 0; r < 16; ++r) acc[r] = 0.f;
          if (kind == 0) {
#pragma unroll
              for (int ks = 0; ks < 4; ++ks) acc = MFMA32(lds_frag(lds, RC_W1T, 32 * mt + r31, 16 * ks + 8 * hh), lds_frag(lds, RC_BHT, cidx, 16 * ks + 8 * hh), acc);
#pragma unroll
              for (int g4 = 0; g4 < 4; ++g4) { const int jo = 8 * g4 + 4 * hh, half = jo >> 4, q2 = (jo & 15) >> 2; const int blk = (cidx >> 4) * 2 + mt, lane2 = (cidx & 15) + 16 * q2;
                  *(u32x2*)(rwi + RWI_GF + (blk * 64 + lane2) * 16 + half * 8) = pack4(-acc[4 * g4], -acc[4 * g4 + 1], -acc[4 * g4 + 2], -acc[4 * g4 + 3]); }
          } else {
#pragma unroll
              for (int ks = 0; ks < 4; ++ks) if (ks < 2 || nt2 == 1) acc = MFMA32(lds_frag(lds, RC_W1T, 32 * mt + r31, 16 * ks + 8 * hh), lds_frag(lds, RC_ARB, cidx, 16 * ks + 8 * hh), acc);
#pragma unroll
              for (int g4 = 0; g4 < 4; ++g4) { const int jo = 8 * g4 + 4 * hh, half = jo >> 4, q2 = (jo & 15) >> 2; const int blk = (cidx >> 4) * 2 + mt, lane2 = (cidx & 15) + 16 * q2;
                  const u32x2 rt = *(const LAS u32x2*)(lds + RC_RT + (cidx * RC_LD + 32 * mt + jo) * 2);
                  *(u32x2*)(rwi + RWI_W2F + (blk * 64 + lane2) * 16 + half * 8) = pack4(bf_lo(rt.x) - acc[4 * g4], bf_hi(rt.x) - acc[4 * g4 + 1], bf_lo(rt.y) - acc[4 * g4 + 2], bf_hi(rt.y) - acc[4 * g4 + 3]); }
          }
          f32x16 ac1, ac2;
#pragma unroll
          for (int r = 0; r < 16; ++r) { ac1[r] = 0.f; ac2[r] = 0.f; }
          if (kind == 0) {
#pragma unroll
              for (int ks = 0; ks < 4; ++ks) { ac1 = MFMA32(lds_frag(lds, RC_KHT, 32 * mt + r31, 16 * ks + 8 * hh), lds_frag(lds, RC_VT, cidx, 16 * ks + 8 * hh), ac1);
                                               ac2 = MFMA32(lds_frag(lds, RC_BHT, 32 * mt + r31, 16 * ks + 8 * hh), lds_frag(lds, RC_U1T, cidx, 16 * ks + 8 * hh), ac2); }
#pragma unroll
              for (int g4 = 0; g4 < 4; ++g4) { const int ro = 32 * mt + 8 * g4 + 4 * hh, mt2 = ro >> 4, q2 = (ro & 15) >> 2, cb = cidx >> 4, lane2 = (cidx & 15) + 16 * q2;
                  *(f32x4*)(rwi + RWI_H1F + ((cb * 4 + mt2) * 64 + lane2) * 16) = (f32x4){ac1[4 * g4] - ac2[4 * g4], ac1[4 * g4 + 1] - ac2[4 * g4 + 1], ac1[4 * g4 + 2] - ac2[4 * g4 + 2], ac1[4 * g4 + 3] - ac2[4 * g4 + 3]}; }
          } else {
#pragma unroll
              for (int ks = 0; ks < 4; ++ks) if (ks < 2 || nt2 == 1) { ac1 = MFMA32(lds_frag(lds, RC_VT, 32 * mt + r31, 16 * ks + 8 * hh), lds_frag(lds, RC_ARK, cidx, 16 * ks + 8 * hh), ac1);
                                                                        ac2 = MFMA32(lds_frag(lds, RC_U1T, 32 * mt + r31, 16 * ks + 8 * hh), lds_frag(lds, RC_ARB, cidx, 16 * ks + 8 * hh), ac2); }
#pragma unroll
              for (int g4 = 0; g4 < 4; ++g4) { const int ro = 32 * mt + 8 * g4 + 4 * hh, cb = ro >> 4, q2 = (ro & 15) >> 2, nt3 = cidx >> 4, lane2 = (cidx & 15) + 16 * q2;
                  *(f32x4*)(rwi + RWI_O1F + ((cb * 4 + nt3) * 64 + lane2) * 16) = (f32x4){ac1[4 * g4] - ac2[4 * g4], ac1[4 * g4 + 1] - ac2[4 * g4 + 1], ac1[4 * g4 + 2] - ac2[4 * g4 + 2], ac1[4 * g4 + 3] - ac2[4 * g4 + 3]}; }
          } }
        __syncthreads();
    }
}

__device__ __forceinline__ void p3_rwkv_seq(const Args& a, int unit, int lane) {
    const int bh = unit >> 2, cb = unit & 3, l15 = lane & 15, q = lane >> 4;
    f32x4 hacc[4];
#pragma unroll
    for (int m = 0; m < 4; ++m) hacc[m] = (f32x4){0.f, 0.f, 0.f, 0.f};
    const unsigned char* base = a.ws + WS_RWI + (size_t)(bh * 32) * RWI_BYTES;
    unsigned char* hbo = a.ws + WS_HB + (size_t)unit * 32 * 2048;
    bf16x8 gfA[8], gfB[8]; f32x4 h1A[4], h1B[4], lamA[4], lamB[4];
#define RW2_LOADG(gf, h1, lam, src) do { _Pragma("unroll") for (int k2 = 0; k2 < 8; ++k2) gf[k2] = *(const bf16x8*)((src) + RWI_GF + (k2 * 64 + lane) * 16); \
        _Pragma("unroll") for (int m = 0; m < 4; ++m) { h1[m] = *(const f32x4*)((src) + RWI_H1F + ((cb * 4 + m) * 64 + lane) * 16); lam[m] = *(const f32x4*)((src) + RWI_LAM + (16 * m + 4 * q) * 4); } } while (0)
#define RW2_STEP(c_, gf, h1, lam) do { const int c = (c_); \
        bf16x8 hb[2]; \
        _Pragma("unroll") for (int ks = 0; ks < 2; ++ks) { u32x4 t; t.x = cvt_pk_bf16(hacc[2 * ks][0], hacc[2 * ks][1]); t.y = cvt_pk_bf16(hacc[2 * ks][2], hacc[2 * ks][3]); \
            t.z = cvt_pk_bf16(hacc[2 * ks + 1][0], hacc[2 * ks + 1][1]); t.w = cvt_pk_bf16(hacc[2 * ks + 1][2], hacc[2 * ks + 1][3]); hb[ks] = __builtin_bit_cast(bf16x8, t); \
            *(bf16x8*)(hbo + (size_t)c * 2048 + (ks * 64 + lane) * 16) = hb[ks]; } \
        _Pragma("unroll") for (int m = 0; m < 4; ++m) { f32x4 nacc = h1[m] + lam[m] * hacc[m]; \
            _Pragma("unroll") for (int ks = 0; ks < 2; ++ks) nacc = MFMA16(gf[m * 2 + ks], hb[ks], nacc); hacc[m] = nacc; } \
        if (c + 2 < 32) RW2_LOADG(gf, h1, lam, base + (size_t)(c + 2) * RWI_BYTES); } while (0)
    RW2_LOADG(gfA, h1A, lamA, base); RW2_LOADG(gfB, h1B, lamB, base + RWI_BYTES);
#pragma unroll 1
    for (int c2 = 0; c2 < 32; c2 += 2) { RW2_STEP(c2, gfA, h1A, lamA); RW2_STEP(c2 + 1, gfB, h1B, lamB); }
#undef RW2_STEP
#undef RW2_LOADG
#pragma unroll
    for (int m = 0; m < 4; ++m) *(f32x4*)(a.out + OUT_WKV_P + (((size_t)bh * 64 + 16 * cb + l15) * 64 + 16 * m + 4 * q)) = hacc[m];
}
__device__ __forceinline__ void p5_rwkv_out(const Args& a, int item, int lane) {
    const int bh = item >> 5, c = item & 31, b = bh >> 4, h = bh & 15, l15 = lane & 15, q = lane >> 4;
    const unsigned char* cur = a.ws + WS_RWI + (size_t)item * RWI_BYTES;
    const bf16_t* BV = (const bf16_t*)((const unsigned char*)a.out + DO_BV);
    const bf16_t* P = (const bf16_t*)(a.ws + WS_P); bf16_t* A2 = (bf16_t*)(a.ws + WS_XN);
    bf16x8 hb[4][2], w2f[8];
#pragma unroll
    for (int cb = 0; cb < 4; ++cb)
#pragma unroll
        for (int ks = 0; ks < 2; ++ks) hb[cb][ks] = *(const bf16x8*)(a.ws + WS_HB + ((size_t)(bh * 4 + cb) * 32 + c) * 2048 + (ks * 64 + lane) * 16);
#pragma unroll
    for (int k2 = 0; k2 < 8; ++k2) w2f[k2] = *(const bf16x8*)(cur + RWI_W2F + (k2 * 64 + lane) * 16);
    f32x4 gw[4], gb[4];
#pragma unroll
    for (int cb = 0; cb < 4; ++cb) { gw[cb] = *(const f32x4*)(a.in[I_GNW] + h * 64 + 16 * cb + 4 * q); gb[cb] = *(const f32x4*)(a.in[I_GNB] + h * 64 + 16 * cb + 4 * q); }
#pragma unroll
    for (int n = 0; n < 4; ++n) {
        const size_t row = (size_t)b * SEQ + c * 64 + 16 * n + l15;
        f32x4 o[4]; u32x2 bvw[4], zw[4];
#pragma unroll
        for (int cb = 0; cb < 4; ++cb) { o[cb] = *(const f32x4*)(cur + RWI_O1F + ((cb * 4 + n) * 64 + lane) * 16);
            bvw[cb] = *(const u32x2*)(BV + row * 1024 + h * 64 + 16 * cb + 4 * q); zw[cb] = *(const u32x2*)(P + row * LDP + PC_ZR + h * 64 + 16 * cb + 4 * q); }
#pragma unroll
        for (int cb = 0; cb < 4; ++cb)
#pragma unroll
            for (int ks = 0; ks < 2; ++ks) o[cb] = MFMA16(hb[cb][ks], w2f[n * 2 + ks], o[cb]);
        float sm = 0.f;
#pragma unroll
        for (int cb = 0; cb < 4; ++cb) sm += (o[cb][0] + o[cb][1]) + (o[cb][2] + o[cb][3]);
        sm += __shfl_xor(sm, 16); sm += __shfl_xor(sm, 32);
        const float mean = sm * (1.0f / 64.0f); float sq = 0.f;
#pragma unroll
        for (int cb = 0; cb < 4; ++cb) { o[cb] = o[cb] - mean; sq += (o[cb][0] * o[cb][0] + o[cb][1] * o[cb][1]) + (o[cb][2] * o[cb][2] + o[cb][3] * o[cb][3]); }
        sq += __shfl_xor(sq, 16); sq += __shfl_xor(sq, 32);
        const float rstd = rsqrtf(sq * (1.0f / 64.0f) + GN_EPS);
#pragma unroll
        for (int cb = 0; cb < 4; ++cb) {
            const float r0 = (o[cb][0] * rstd * gw[cb][0] + gb[cb][0] + bf_lo(bvw[cb].x)) * bf_lo(zw[cb].x), r1 = (o[cb][1] * rstd * gw[cb][1] + gb[cb][1] + bf_hi(bvw[cb].x)) * bf_hi(zw[cb].x);
            const float r2 = (o[cb][2] * rstd * gw[cb][2] + gb[cb][2] + bf_lo(bvw[cb].y)) * bf_lo(zw[cb].y), r3 = (o[cb][3] * rstd * gw[cb][3] + gb[cb][3] + bf_hi(bvw[cb].y)) * bf_hi(zw[cb].y);
            *(u32x2*)(A2 + row * 2048 + 1024 + h * 64 + 16 * cb + 4 * q) = pack4(r0, r1, r2, r3); }
    }
}

__device__ __forceinline__ void p3_rwkv_sample(const Args& a, LAS unsigned char* lds, int bs, int h, int wave, int lane) {
    LAS float* Lw = (LAS float*)lds + wave * 768;
    const bf16_t* P = (const bf16_t*)(a.ws + WS_P);
    const bf16_t* pc = P + (size_t)(MP + bs) * LDP; const bf16_t* pp = P + (size_t)(MV + bs) * LDP;
    bf16_t* A2 = (bf16_t*)(a.ws + WS_XN);
    const float* mu = a.in[I_MU];
    const int hj = h * 64 + lane, rg = lane >> 4, cq = lane & 15;
    const size_t sbase = ((size_t)(bs * 16 + h) * 64) * 64;
    const float* S0 = a.in[I_WKV] + sbase; float* S1 = a.out + OUT_WKV_S + sbase;
    f32x4 S[16];
#pragma unroll
    for (int it = 0; it < 16; ++it) S[it] = *(const f32x4*)(S0 + (size_t)(4 * it + rg) * 64 + 4 * cq);
    { float wd = bf2f(pc[PC_WD + lane]), ad = bf2f(pc[PC_AD + lane]); wd += (bf2f(pp[PC_WD + lane]) - wd) * mu[3072 + lane]; ad += (bf2f(pp[PC_AD + lane]) - ad) * mu[3136 + lane];
      Lw[lane] = tanhf_(wd); Lw[64 + lane] = ad; }
    LDS_WAIT();
    float lw = 0.f, la = 0.f;
#pragma unroll 16
    for (int m = 0; m < 64; ++m) { lw += Lw[m] * a.in[I_W2][(size_t)m * 1024 + hj]; la += Lw[64 + m] * a.in[I_A2][(size_t)m * 1024 + hj]; }
    float r = bf2f(pc[PC_R + hj]), k = bf2f(pc[PC_K + hj]), v = bf2f(pc[PC_V + hj]);
    r += (bf2f(pp[PC_R + hj]) - r) * mu[hj]; k += (bf2f(pp[PC_K + hj]) - k) * mu[1024 + hj]; v += (bf2f(pp[PC_V + hj]) - v) * mu[2048 + hj];
    const RwTok o = rw_token(a, hj, r, k, v, lw, la);
    Lw[128 + lane] = o.kk; Lw[192 + lane] = o.dr; Lw[256 + lane] = o.dd; Lw[320 + lane] = o.bb; Lw[384 + lane] = o.kp; Lw[448 + lane] = o.v;
    LDS_WAIT();
    const f32x4 kk4 = *(const LAS f32x4*)(Lw + 128 + 4 * cq), dr4 = *(const LAS f32x4*)(Lw + 192 + 4 * cq), d4 = *(const LAS f32x4*)(Lw + 256 + 4 * cq), b4 = *(const LAS f32x4*)(Lw + 320 + 4 * cq), k4 = *(const LAS f32x4*)(Lw + 384 + 4 * cq);
#pragma unroll
    for (int it = 0; it < 16; ++it) { const int i = 4 * it + rg; const float vi = Lw[448 + i];
        float p1 = (S[it][0] * kk4[0] + S[it][1] * kk4[1]) + (S[it][2] * kk4[2] + S[it][3] * kk4[3]);
        float p2 = (S[it][0] * dr4[0] + S[it][1] * dr4[1]) + (S[it][2] * dr4[2] + S[it][3] * dr4[3]);
        p1 = row16_sum(p1); p2 = row16_sum(p2);
        const float sa = -p1, ov = p2 + sa * o.br + vi * o.kr;
        f32x4 Sn;
#pragma unroll
        for (int j = 0; j < 4; ++j) Sn[j] = S[it][j] * d4[j] + sa * b4[j] + vi * k4[j];
        *(f32x4*)(S1 + (size_t)i * 64 + 4 * cq) = Sn;
        if (cq == 0) Lw[512 + i] = ov; }
    LDS_WAIT();
    const float ov = Lw[512 + lane];
    const float mean = wave_sum_dpp(ov) * (1.0f / 64.0f); const float dv = ov - mean; const float var = wave_sum_dpp(dv * dv) * (1.0f / 64.0f);
    float on = dv * rsqrtf(var + GN_EPS) * a.in[I_GNW][hj] + a.in[I_GNB][hj] + o.bonus * o.v;
    on *= bf2f(pc[PC_ZR + hj]);
    A2[(size_t)(MP + bs) * 2048 + 1024 + hj] = f2bf(on);
    LDS_WAIT();
}

constexpr int S5_ELD = 132, S5_XLD = 136;
constexpr int S5_E_OFF = 0, S5_X_OFF = 128 * S5_ELD * 4;
__device__ __forceinline__ bf16x8 ldfrag(const unsigned char* base, int block, int lane) { return *(const bf16x8*)(base + (size_t)block * 1024 + lane * 16); }
__device__ __forceinline__ void p3_s5_prompt(const Args& a, LAS unsigned char* lds, int unit, int tid, int wave, int lane) {
    const int b = unit >> 6, g = unit & 63;
    const unsigned char* tab = (const unsigned char*)a.out + DO_S5TAB + (size_t)g * S5T_BYTES;
    const bf16_t* P = (const bf16_t*)(a.ws + WS_P);
    bf16_t* Yg = (bf16_t*)(a.ws + WS_YG);
    LAS float* EL = (LAS float*)(lds + S5_E_OFF); LAS bf16_t* XL = (LAS bf16_t*)(lds + S5_X_OFF);
    const int nt = wave & 3, hm = wave >> 2, r31 = lane & 31, hh = lane >> 5;
    const int n = 32 * nt + r31;
    { u32x4 tv[10];
#pragma unroll
      for (int i = 0; i < 10; ++i) tv[i] = *(const u32x4*)(tab + S5T_ME + (size_t)(tid + 512 * i) * 16);
#pragma unroll
      for (int i = 0; i < 10; ++i) *(LAS u32x4*)(lds + (tid + 512 * i) * 16) = tv[i]; }
    const bf16_t* ubase = (const bf16_t*)(a.ws + WS_U2) + (((size_t)b * 64 + g) * SEQ + 16 * n) * 16 + 8 * hh;
    bf16x8 bu[16];
#pragma unroll
    for (int s2 = 0; s2 < 16; ++s2) bu[s2] = *(const bf16x8*)(ubase + (size_t)s2 * 16);
    f32x16 accY[4], accE[2];
#pragma unroll
    for (int q = 0; q < 4; ++q)
#pragma unroll
        for (int r = 0; r < 16; ++r) accY[q][r] = 0.f;
#pragma unroll
    for (int q = 0; q < 2; ++q)
#pragma unroll
        for (int r = 0; r < 16; ++r) accE[q][r] = 0.f;
    const int mts[4] = {hm ? 1 : 0, hm ? 2 : 3, hm ? 5 : 4, hm ? 6 : 7};
    __syncthreads();
#pragma unroll
    for (int s2 = 0; s2 < 16; ++s2) {
#pragma unroll
        for (int e = 0; e < 2; ++e) accE[e] = __builtin_amdgcn_mfma_f32_32x32x16_bf16(*(const LAS bf16x8*)(lds + S5T_ME + (((2 * hm + e) * 16 + s2) * 64 + lane) * 16), bu[s2], accE[e], 0, 0, 0);
#pragma unroll
        for (int q = 0; q < 4; ++q) { const int mt = mts[q]; if (s2 <= 2 * mt + 1) accY[q] = __builtin_amdgcn_mfma_f32_32x32x16_bf16(*(const LAS bf16x8*)(lds + S5T_KT + ((2 * mt - s2 + 1) * 64 + lane) * 16), bu[s2], accY[q], 0, 0, 0); }
    }
    __syncthreads();
#pragma unroll
    for (int e = 0; e < 2; ++e)
#pragma unroll
        for (int q4 = 0; q4 < 4; ++q4) { f32x4 v; v[0] = accE[e][4 * q4]; v[1] = accE[e][4 * q4 + 1]; v[2] = accE[e][4 * q4 + 2]; v[3] = accE[e][4 * q4 + 3];
            *(LAS f32x4*)(EL + n * S5_ELD + 32 * (2 * hm + e) + 8 * q4 + 4 * hh) = v; }
    __syncthreads();
    if (wave == 0) { const float* hdr = (const float*)(tab + S5T_HDR); const float ar = hdr[lane], ai = hdr[64 + lane]; float xr = 0.f, xi = 0.f;
#pragma unroll 1
        for (int c0 = 0; c0 < 128; c0 += 16) { float er[16], ei[16];
#pragma unroll
            for (int j = 0; j < 16; ++j) { er[j] = EL[(c0 + j) * S5_ELD + lane]; ei[j] = EL[(c0 + j) * S5_ELD + 64 + lane]; }
#pragma unroll
            for (int j = 0; j < 16; ++j) { XL[(c0 + j) * S5_XLD + lane] = f2bf(xr); XL[(c0 + j) * S5_XLD + 64 + lane] = f2bf(xi);
                const float nr = ar * xr - ai * xi + er[j], ni = ar * xi + ai * xr + ei[j]; xr = nr; xi = ni; } }
        a.out[OUT_S5RE_P + (size_t)(b * 64 + g) * 64 + lane] = xr; a.out[OUT_S5IM_P + (size_t)(b * 64 + g) * 64 + lane] = xi; }
    __syncthreads();
#pragma unroll
    for (int ks = 0; ks < 8; ++ks) { const bf16x8 bx = *(const LAS bf16x8*)(XL + n * S5_XLD + 16 * ks + 8 * hh);
#pragma unroll
        for (int q = 0; q < 4; ++q) accY[q] = __builtin_amdgcn_mfma_f32_32x32x16_bf16(ldfrag(tab + S5T_CA, mts[q] * 8 + ks, lane), bx, accY[q], 0, 0, 0); }
#pragma unroll
    for (int q = 0; q < 4; ++q) { const int mt = mts[q];
#pragma unroll
        for (int q4 = 0; q4 < 4; ++q4) { const int dt = q4 >> 1, c0 = 8 * (q4 & 1) + 4 * hh; const size_t row = (size_t)b * SEQ + 16 * n + 2 * mt + dt;
            u32x2 w; w.x = cvt_pk_bf16(geluf_(accY[q][4 * q4]), geluf_(accY[q][4 * q4 + 1])); w.y = cvt_pk_bf16(geluf_(accY[q][4 * q4 + 2]), geluf_(accY[q][4 * q4 + 3]));
            *(u32x2*)(Yg + row * 1024 + g * 16 + c0) = w; } }
    __syncthreads();
}
__device__ __forceinline__ void p3_s5_sample(const Args& a, int g, int wave, int lane) {
    if (wave >= 4) return;
    const unsigned char* tab = (const unsigned char*)a.out + DO_S5TAB + (size_t)g * S5T_BYTES;
    const float* hdr = (const float*)(tab + S5T_HDR);
    const bf16_t* P = (const bf16_t*)(a.ws + WS_P);
    bf16_t* Yg = (bf16_t*)(a.ws + WS_YG);
    const int r31 = lane & 31, hh = lane >> 5, bs = 32 * wave + r31;
    const bf16x8 bu = *(const bf16x8*)((const bf16_t*)(a.ws + WS_U2S) + ((size_t)g * NSMP + bs) * 16 + 8 * hh);
    f32x16 z;
#pragma unroll
    for (int r = 0; r < 16; ++r) z[r] = 0.f;
    f32x16 x[4];
#pragma unroll
    for (int mtile = 0; mtile < 4; ++mtile) x[mtile] = __builtin_amdgcn_mfma_f32_32x32x16_bf16(ldfrag(tab + S5T_ME, mtile * 16 + 15, lane), bu, z, 0, 0, 0);
    const size_t sb = (size_t)(bs * 64 + g) * 64;
#pragma unroll
    for (int pt = 0; pt < 2; ++pt)
#pragma unroll
        for (int q4 = 0; q4 < 4; ++q4) { const int p0 = 32 * pt + 8 * q4 + 4 * hh;
            const f32x4 x0r = *(const f32x4*)(a.in[I_S5RE] + sb + p0), x0i = *(const f32x4*)(a.in[I_S5IM] + sb + p0);
            const f32x4 ar = *(const f32x4*)(hdr + 128 + p0), ai = *(const f32x4*)(hdr + 192 + p0);
            f32x4 nr, ni;
#pragma unroll
            for (int j = 0; j < 4; ++j) { nr[j] = ar[j] * x0r[j] - ai[j] * x0i[j] + x[pt][4 * q4 + j]; ni[j] = ar[j] * x0i[j] + ai[j] * x0r[j] + x[2 + pt][4 * q4 + j]; x[pt][4 * q4 + j] = nr[j]; x[2 + pt][4 * q4 + j] = ni[j]; }
            *(f32x4*)(a.out + OUT_S5RE_S + sb + p0) = nr; *(f32x4*)(a.out + OUT_S5IM_S + sb + p0) = ni; }
    f32x16 y = __builtin_amdgcn_mfma_f32_32x32x16_bf16(ldfrag(tab + S5T_DF, 0, lane), bu, z, 0, 0, 0);
#pragma unroll
    for (int mtile = 0; mtile < 4; ++mtile)
#pragma unroll
        for (int sp = 0; sp < 2; ++sp) { u32x4 t; t.x = cvt_pk_bf16(x[mtile][8 * sp], x[mtile][8 * sp + 1]); t.y = cvt_pk_bf16(x[mtile][8 * sp + 2], x[mtile][8 * sp + 3]);
            t.z = cvt_pk_bf16(x[mtile][8 * sp + 4], x[mtile][8 * sp + 5]); t.w = cvt_pk_bf16(x[mtile][8 * sp + 6], x[mtile][8 * sp + 7]);
            y = __builtin_amdgcn_mfma_f32_32x32x16_bf16(ldfrag(tab + S5T_C0, mtile * 2 + sp, lane), __builtin_bit_cast(bf16x8, t), y, 0, 0, 0); }
#pragma unroll
    for (int q4 = 0; q4 < 2; ++q4) { const int c0 = 8 * q4 + 4 * hh;
        u32x2 w; w.x = cvt_pk_bf16(geluf_(y[4 * q4]), geluf_(y[4 * q4 + 1])); w.y = cvt_pk_bf16(geluf_(y[4 * q4 + 2]), geluf_(y[4 * q4 + 3]));
        *(u32x2*)(Yg + (size_t)(MP + bs) * 1024 + g * 16 + c0) = w; }
}

__device__ __forceinline__ void p4_rwkv_post8(const Args& a, int item0, int lane) {
    const int item = item0 + (lane >> 3), cg = lane & 7, row = item >> 4, h = item & 15, ch = h * 64 + 8 * cg;
    const bf16_t* ORAW = (const bf16_t*)((const unsigned char*)a.out + DO_ORAW); const bf16_t* BV = (const bf16_t*)((const unsigned char*)a.out + DO_BV);
    const bf16_t* P = (const bf16_t*)(a.ws + WS_P); bf16_t* A2 = (bf16_t*)(a.ws + WS_XN);
    const u32x4 ow = *(const u32x4*)(ORAW + (size_t)row * 1024 + ch), bw = *(const u32x4*)(BV + (size_t)row * 1024 + ch), zw = *(const u32x4*)(P + (size_t)row * LDP + PC_ZR + ch);
    const f32x4 w0 = *(const f32x4*)(a.in[I_GNW] + ch), w1 = *(const f32x4*)(a.in[I_GNW] + ch + 4), b0 = *(const f32x4*)(a.in[I_GNB] + ch), b1 = *(const f32x4*)(a.in[I_GNB] + ch + 4);
    const float o[8] = {bf_lo(ow.x), bf_hi(ow.x), bf_lo(ow.y), bf_hi(ow.y), bf_lo(ow.z), bf_hi(ow.z), bf_lo(ow.w), bf_hi(ow.w)};
    const float bv[8] = {bf_lo(bw.x), bf_hi(bw.x), bf_lo(bw.y), bf_hi(bw.y), bf_lo(bw.z), bf_hi(bw.z), bf_lo(bw.w), bf_hi(bw.w)};
    const float z[8] = {bf_lo(zw.x), bf_hi(zw.x), bf_lo(zw.y), bf_hi(zw.y), bf_lo(zw.z), bf_hi(zw.z), bf_lo(zw.w), bf_hi(zw.w)};
    const float gw[8] = {w0[0], w0[1], w0[2], w0[3], w1[0], w1[1], w1[2], w1[3]}, gb[8] = {b0[0], b0[1], b0[2], b0[3], b1[0], b1[1], b1[2], b1[3]};
    float sm = ((o[0] + o[1]) + (o[2] + o[3])) + ((o[4] + o[5]) + (o[6] + o[7]));
    sm += dpp_f<0xB1>(sm); sm += dpp_f<0x4E>(sm); sm += dpp_f<0x141>(sm);
    const float mean = sm * (1.0f / 64.0f); float d[8], sq = 0.f;
#pragma unroll
    for (int j = 0; j < 8; ++j) { d[j] = o[j] - mean; sq += d[j] * d[j]; }
    sq += dpp_f<0xB1>(sq); sq += dpp_f<0x4E>(sq); sq += dpp_f<0x141>(sq);
    const float rstd = rsqrtf(sq * (1.0f / 64.0f) + GN_EPS); float r[8];
#pragma unroll
    for (int j = 0; j < 8; ++j) r[j] = (d[j] * rstd * gw[j] + gb[j] + bv[j]) * z[j];
    u32x4 w; w.x = cvt_pk_bf16(r[0], r[1]); w.y = cvt_pk_bf16(r[2], r[3]); w.z = cvt_pk_bf16(r[4], r[5]); w.w = cvt_pk_bf16(r[6], r[7]);
    *(u32x4*)(A2 + (size_t)row * 2048 + 1024 + ch) = w;
}

__device__ __forceinline__ void p6_row(const Args& a, int m, int lane) {
    float* y = a.out + (size_t)m * DM; const float* fg = a.in[I_FINALG];
    if (m < MP) {
        const float* rs = (const float*)(a.ws + WS_ROWSS) + (size_t)m * 32;
        const float ss = wave_sum(rs[lane & 31]) * 0.5f;
        const float rstd = rsqrtf(ss * (1.0f / DM) + RMS_EPS);
#pragma unroll
        for (int j = 0; j < 8; ++j) { const int k = 4 * lane + 256 * j; f32x4 v = *(const f32x4*)(y + k); const f32x4 gv = *(const f32x4*)(fg + k);
#pragma unroll
            for (int q = 0; q < 4; ++q) v[q] = v[q] * rstd * gv[q];
            *(f32x4*)(y + k) = v; }
    } else {
        const int r = m - MP; const float* slab = (const float*)(a.ws + WS_SLAB) + (size_t)r * DM; const float* x = a.in[I_XS] + (size_t)r * DM;
        const float* gtrow = (const float*)(a.ws + WS_MOD) + (size_t)(NB + r) * NMOD + 2 * DM;
        f32x4 v[8]; float ss = 0.f;
#pragma unroll
        for (int j = 0; j < 8; ++j) { const int k = 4 * lane + 256 * j; f32x4 mix = *(const f32x4*)(slab + k);
#pragma unroll
            for (int s2 = 1; s2 < 8; ++s2) mix += *(const f32x4*)(slab + (size_t)s2 * NSMP * DM + k);
            const f32x4 xv = *(const f32x4*)(x + k), gt = *(const f32x4*)(gtrow + k);
#pragma unroll
            for (int q = 0; q < 4; ++q) { v[j][q] = xv[q] + gt[q] * mix[q]; ss += v[j][q] * v[j][q]; } }
        const float rstd = rsqrtf(wave_sum(ss) * (1.0f / DM) + RMS_EPS);
#pragma unroll
        for (int j = 0; j < 8; ++j) { const int k = 4 * lane + 256 * j; const f32x4 gv = *(const f32x4*)(fg + k); f32x4 o;
#pragma unroll
            for (int q = 0; q < 4; ++q) o[q] = v[j][q] * rstd * gv[q];
            *(f32x4*)(y + k) = o; }
    }
}

__global__ void __launch_bounds__(512, 2) fwd_kernel(Args args) {
    extern __shared__ __attribute__((aligned(16))) unsigned char lds_raw[];
    LAS unsigned char* lds = (LAS unsigned char*)lds_raw;
    const int tid = threadIdx.x, lane = tid & 63, wave = __builtin_amdgcn_readfirstlane(tid >> 6);
    const int G = gridDim.x, bx = blockIdx.x;
    const int vcu = (G % 8 == 0) ? (bx % 8) * (G / 8) + bx / 8 : bx;
    volatile LAS unsigned* MISC = (volatile LAS unsigned*)(lds + MISC_OFF);
    for (int u = tid; u < (LDS_BYTES - LDSCTL_OFF) / 4; u += 512) ((LAS unsigned*)(lds + LDSCTL_OFF))[u] = 0u;
    __syncthreads();
    unsigned* ctl = (unsigned*)(args.ws + WS_CTL);
    XcdBarrier bar; bar.bar = ctl + CW_BAR + args.li * XCD_BAR_WORDS; bar.x = 0; bar.st = nullptr;
    const bool multi = (args.ph_hi - args.ph_lo) > 1;
    if (multi) bar = xcd_barrier_post(ctl + CW_BAR + args.li * XCD_BAR_WORDS, MISC + 8);
    const int lo = args.ph_lo, hi = args.ph_hi;
#define IN(k) (lo <= (k) && (k) < hi)
#define SEAM(k) do { if (IN(k) && IN((k) + 1)) xcd_barrier(bar); } while (0)
    const int gw = vcu * 8 + wave, NGW = G * 8;

    if (IN(0)) {
        if (vcu < 192) p0_mod(args, lds, vcu, wave, lane);
        else if (vcu - 192 < 64) { p0_s5_tables(args, lds, vcu - 192, tid);
            LAS float* scr = (LAS float*)(lds + wave * 16384);
            for (int it = (vcu - 192) * 8 + wave; it < 2048 + 512; it += 64 * 8) {
                if (it < 2048) { const int nb = it >> 5, kb = it & 31; transpose_item(args.in[I_WOUT], 2048, 2048, 32 * nb, (bf16_t*)(args.ws + WS_WOUT_T), 32 * nb, 64 * kb, scr, lane, false); }
                else { const int i2 = it - 2048, nb = i2 >> 4, kb = i2 & 15; transpose_item(args.in[I_WGLU], 1024, 1024, 32 * nb, (bf16_t*)(args.ws + WS_WGLU_T), 32 * nb, 64 * kb, scr, lane, false); } } }
    }
    SEAM(0);
    if (IN(1)) {
        { LAS float* scr = (LAS float*)(lds + wave * 16384);
          bf16_t* WT = (bf16_t*)(args.ws + WS_WT);
          for (int it = gw; it < 328 * 32; it += NGW) { const int nb = it >> 5, kb = it & 31; const int p0 = 32 * nb;
              const int src = (p0 < 5120) ? p0 : ((p0 < 10240) ? p0 + 128 : p0 - 5120);
              transpose_item(args.in[I_WIN], NIN, 2048, src, WT, p0, 64 * kb, scr, lane, p0 >= NIN); } }
        for (int m = gw; m < MT; m += NGW) p1_row(args, m, lane);
    }
    SEAM(1);
    const bool tail_mode = (G == 256);
    if (IN(2)) {
        pg8::Gemm g{(const bf16_t*)(args.ws + WS_XN), (const bf16_t*)(args.ws + WS_WT), 2048, 2048};
        EpiP E{(bf16_t*)(args.ws + WS_P), tail_mode, (bf16_t*)(args.ws + WS_U2)};
        if (tail_mode) {
            pg8::TailOrder S; S.init2(G, bx, ctl + CW_TILE);
            pg8::gemm_phase<EpiP, pg8::TailOrder, GEMM_ALIGN, GEMM_SP2>(lds, g, S, E);
            if (bx >= 73) {
                const int t = bx - 73;
                for (int u = t; u < 256; u += 183) { wait_count(ctl + CW_TILE + 64 * ((u >> 6) * 4 + ((u & 63) >> 4)), 64u, wave); p3_s5_prompt(args, lds, u, tid, wave, lane); }
                if (t >= 146 && t < 178) { const int pm2 = t - 146;
                    wait_count(ctl + CW_TILE + 64 * (57 + pm2), 8u, wave); if (pm2 & 7) wait_count(ctl + CW_TILE + 64 * (57 + pm2 - 1), 8u, wave);
                    p2_xw_panel(args, pm2, tid); }
                if (t >= 73 && t < 137) { const int g2 = t - 73; wait_count(ctl + CW_TILE + 64 * (16 + (g2 >> 4)), 8u, wave); p3_s5_sample(args, g2, wave, lane); }
            }
        } else {
            pg8::StaticOrder S; S.init(MT, LDP, 2048, G, bx);
            pg8::gemm_phase<EpiP, pg8::StaticOrder, GEMM_ALIGN, GEMM_SP2>(lds, g, S, E);
        }
    }
    SEAM(2);
    if (IN(3)) {
        p3_rwkv_chunks(args, lds, vcu >> 2, vcu & 3, tid, wave, lane);
        if (!tail_mode) {
            if (false) { LAS float* scr = (LAS float*)(lds + wave * 16384);
              for (int it = gw; it < 2048 + 512; it += NGW) {
                  if (it < 2048) { const int nb = it >> 5, kb = it & 31; transpose_item(args.in[I_WOUT], 2048, 2048, 32 * nb, (bf16_t*)(args.ws + WS_WOUT_T), 32 * nb, 64 * kb, scr, lane, false); }
                  else { const int i2 = it - 2048, nb = i2 >> 4, kb = i2 & 15; transpose_item(args.in[I_WGLU], 1024, 1024, 32 * nb, (bf16_t*)(args.ws + WS_WGLU_T), 32 * nb, 64 * kb, scr, lane, false); } } }
            __syncthreads();
            for (int u = vcu; u < 256; u += G) p3_s5_prompt(args, lds, u, tid, wave, lane);
            for (int g2 = vcu; g2 < 64; g2 += G) p3_s5_sample(args, g2, wave, lane);
            __syncthreads();
        }
        for (int it = vcu; it < 256; it += G) p3_rwkv_sample(args, lds, it >> 1, (it & 1) * 8 + wave, wave, lane);
    }
    SEAM(3);
    if (IN(4)) {
        pg8::StaticOrder S; S.init(MT, 1024, 1024, G, bx);
        pg8::Unit u0;
        if (S.next(0, u0)) {
            pg8::Gemm g{(const bf16_t*)(args.ws + WS_YG), (const bf16_t*)(args.ws + WS_WGLU_T), 1024, 1024};
            EpiGlu E{(const bf16_t*)(args.ws + WS_YG), (const bf16_t*)(args.ws + WS_P), args.in[I_BGLU], (bf16_t*)(args.ws + WS_XN)};
            pg8::gemm_phase<EpiGlu, pg8::StaticOrder, GEMM_ALIGN, GEMM_SP2>(lds, g, S, E);
        } else {
            const int nfree = G - 132, j = bx - 132, unit = wave * nfree + j;
            if (unit < 256) p3_rwkv_seq(args, unit, lane);
        }
    }
    SEAM(4);
    if (IN(5)) { for (int it = gw; it < 2048; it += NGW) p5_rwkv_out(args, it, lane); }
    SEAM(5);
    if (IN(6)) {
        pg8::Gemm g{(const bf16_t*)(args.ws + WS_XN), (const bf16_t*)(args.ws + WS_WOUT_T), 2048, 1024};
        pg8::OutOrder S; S.init(MP, DM, 1024, G, bx);
        EpiOut E{(const bf16_t*)(args.ws + WS_P), args.in[I_XP], (const float*)(args.ws + WS_MOD), args.out, (float*)(args.ws + WS_ROWSS), (bf16_t*)(args.ws + WS_TMP), (float*)(args.ws + WS_SLAB), ctl + CW_PANEL, args.in[I_FINALG]};
        pg8::gemm_phase<EpiOut, pg8::OutOrder, false, GEMM_SP2>(lds, g, S, E);
    }
    SEAM(6);
    if (IN(7)) { for (int m = MP + gw; m < MV; m += NGW) p6_row(args, m, lane); }
#undef IN
#undef SEAM
}

extern "C" void kernel_launch(void* const* d_in, const int* in_sizes, int n_in, void* d_out, int out_size, void* d_ws, size_t ws_size, hipStream_t stream) {
    static int grid = 0;
    if (grid == 0) {
        if (n_in != 34 || ws_size < WS_END) { fprintf(stderr, "kernel_launch: unexpected n_in %d / ws %zu\n", n_in, ws_size); grid = -1; return; }
        int dev = 0, cus = 0;
        if (hipGetDevice(&dev) != hipSuccess || hipDeviceGetAttribute(&cus, hipDeviceAttributeMultiprocessorCount, dev) != hipSuccess) { grid = -1; return; }
        if (hipFuncSetAttribute((const void*)fwd_kernel, hipFuncAttributeMaxDynamicSharedMemorySize, LDS_BYTES) != hipSuccess) { fprintf(stderr, "kernel_launch: hipFuncSetAttribute failed\n"); grid = -1; return; }
        int per_cu = 0;
        if (hipOccupancyMaxActiveBlocksPerMultiprocessor(&per_cu, (const void*)fwd_kernel, 512, LDS_BYTES) != hipSuccess || per_cu < 1) fprintf(stderr, "kernel_launch: occupancy query says %d\n", per_cu);
        (void)hipGetLastError();
        grid = cus;
        if (grid != 256) fprintf(stderr, "kernel_launch: note: %d CUs\n", grid);
    }
    if (grid < 0) return;
    (void)hipMemsetAsync((char*)d_ws + WS_CTL, 0, CTL_BYTES, stream);
    Args a{};
    for (int i = 0; i < 34; ++i) a.in[i] = (const float*)d_in[i];
    a.out = (float*)d_out; a.ws = (unsigned char*)d_ws;
    if (PROBE_PHASE >= 0) {
        a.ph_lo = 0; a.ph_hi = PROBE_PHASE + 1; a.li = 0; hipLaunchKernelGGL(fwd_kernel, dim3(grid), dim3(512), LDS_BYTES, stream, a);
        a.ph_lo = PROBE_PHASE; a.ph_hi = PROBE_PHASE + 1; a.li = 1; hipLaunchKernelGGL(fwd_kernel, dim3(grid), dim3(512), LDS_BYTES, stream, a);
        if (PROBE_PHASE + 1 < N_PHASES) { a.ph_lo = PROBE_PHASE + 1; a.ph_hi = N_PHASES; a.li = 2; hipLaunchKernelGGL(fwd_kernel, dim3(grid), dim3(512), LDS_BYTES, stream, a); }
    } else if (MK_N_LAUNCHES == 1) { a.ph_lo = 0; a.ph_hi = N_PHASES; a.li = 0; hipLaunchKernelGGL(fwd_kernel, dim3(grid), dim3(512), LDS_BYTES, stream, a); }
    else { for (int p = 0; p < N_PHASES; ++p) { a.ph_lo = p; a.ph_hi = p + 1; a.li = 0; hipLaunchKernelGGL(fwd_kernel, dim3(grid), dim3(512), LDS_BYTES, stream, a); } }
}
```

```cpp
#include <hip/hip_runtime.h>
#include <cstdio>
#include <cstdint>

#ifndef MK_N_LAUNCHES
#define MK_N_LAUNCHES 1
#endif
#ifndef PROBE_PHASE
#define PROBE_PHASE -1
#endif
constexpr int N_PHASES = 8;
#ifndef GEMM_SP2
#define GEMM_SP2 true
#endif
#ifndef GEMM_ALIGN
#define GEMM_ALIGN true
#endif

#define GAS __attribute__((address_space(1)))
#define LAS __attribute__((address_space(3)))
typedef unsigned short bf16_t;
typedef short bf16x8 __attribute__((ext_vector_type(8)));
typedef float f32x2 __attribute__((ext_vector_type(2)));
typedef float f32x4 __attribute__((ext_vector_type(4)));
typedef float f32x16 __attribute__((ext_vector_type(16)));
typedef unsigned u32x2 __attribute__((ext_vector_type(2)));
typedef unsigned u32x4 __attribute__((ext_vector_type(4)));
typedef GAS unsigned gu32;

constexpr int DM = 2048, SEQ = 2048, NB = 4, NSMP = 128;
constexpr int MP = NB * SEQ;
constexpr int MV = MP + NSMP;
constexpr int MT = MV + NSMP;
constexpr int NIN = 10368, LDP = 10496;
constexpr int NMOD = 6144, NMODROWS = NB + NSMP;
constexpr float RMS_EPS = 1e-6f, GN_EPS = 64e-5f;
constexpr int PC_U = 0, PC_ZS = 1024, PC_R = 2048, PC_K = 3072, PC_V = 4096, PC_ZR = 5120, PC_GS = 6144, PC_GR = 8192, PC_WD = 10240, PC_AD = 10304;

constexpr size_t WS_CTL = 0, CTL_BYTES = 131072;
constexpr size_t WS_MOD = CTL_BYTES;
constexpr size_t WS_WT = WS_MOD + 3276800;
constexpr size_t WS_XN = WS_WT + (size_t)LDP * 2048 * 2;
constexpr size_t WS_P = WS_XN + (size_t)MT * 2048 * 2;
constexpr size_t WS_RWI = WS_P + (size_t)MT * LDP * 2;
constexpr int RWI_GF = 0, RWI_W2F = 8192, RWI_H1F = 16384, RWI_O1F = 32768, RWI_LAM = 49152, RWI_BYTES = 49408;
constexpr size_t WS_SA = WS_RWI;
constexpr size_t WS_TMP = WS_RWI;
constexpr size_t WS_SLAB = WS_TMP + (size_t)MP * 2048 * 2;
static_assert(WS_SLAB + (size_t)8 * NSMP * DM * 4 <= WS_RWI + (size_t)2048 * RWI_BYTES, "tmp/slab alias");
constexpr size_t WS_YG = WS_RWI + (size_t)2048 * RWI_BYTES;
constexpr size_t WS_WOUT_T = WS_YG + (size_t)MT * 1024 * 2;
constexpr size_t WS_WGLU_T = WS_WOUT_T + (size_t)2048 * 2048 * 2;
constexpr size_t WS_ROWSS = WS_WGLU_T + (size_t)1024 * 1024 * 2;
constexpr size_t WS_U2 = WS_ROWSS + (size_t)MP * 8 * 4;
constexpr size_t WS_U2S = WS_U2 + (size_t)MP * 1024 * 2;
constexpr size_t WS_HB = WS_U2S + (size_t)NSMP * 1024 * 2;
constexpr size_t WS_XW = WS_HB + (size_t)256 * 32 * 2048;
constexpr size_t WS_END = WS_XW + (size_t)MP * 128 * 2;
static_assert(WS_END <= ((size_t)412 << 20), "ws map");
constexpr size_t DO_ORAW = 0, DO_BV = (size_t)MP * 1024 * 2, DO_S5TAB = 2 * DO_BV;
constexpr int S5T_ME = 0, S5T_KT = 65536, S5T_CA = 81920, S5T_C0 = 147456, S5T_DF = 155648, S5T_HDR = 156672, S5T_BYTES = 157696;
static_assert(DO_S5TAB + (size_t)64 * S5T_BYTES <= (size_t)MV * DM * 4, "d_out scratch");
constexpr size_t OUT_Y = 0, OUT_S5RE_P = 17039360, OUT_S5IM_P = 17055744, OUT_WKV_P = 17072128, OUT_SHIFT_P = 17334272,
                 OUT_S5RE_S = 17342464, OUT_S5IM_S = 17866752, OUT_WKV_S = 18391040, OUT_SHIFT_S = 26779648;
constexpr int RING_BYTES = 131072, LDSCTL_OFF = RING_BYTES, MISC_OFF = LDSCTL_OFF + 320, LDS_BYTES = 147456;
constexpr int CW_BAR = 1024;
constexpr int CW_AREADY = 30000;
constexpr int CW_PANEL = 12288, CW_TILE = 16384;

#define LDS_WAIT() asm volatile("s_waitcnt lgkmcnt(0)" ::: "memory")
#define VM_WAIT() asm volatile("s_waitcnt vmcnt(0)" ::: "memory")
typedef __bf16 bf16x2_t __attribute__((ext_vector_type(2)));
__device__ __forceinline__ unsigned cvt_pk_bf16(float lo, float hi) { const f32x2 v = {lo, hi}; return __builtin_bit_cast(unsigned, __builtin_convertvector(v, bf16x2_t)); }
__device__ __forceinline__ u32x2 pack4(float a, float b, float c, float d) { u32x2 w; w.x = cvt_pk_bf16(a, b); w.y = cvt_pk_bf16(c, d); return w; }
__device__ __forceinline__ float bf_lo(unsigned w) { return __uint_as_float(w << 16); }
__device__ __forceinline__ float bf_hi(unsigned w) { return __uint_as_float(w & 0xffff0000u); }
__device__ __forceinline__ float bf2f(bf16_t b) { return __uint_as_float(((unsigned)b) << 16); }
__device__ __forceinline__ bf16_t f2bf(float f) { return (bf16_t)(cvt_pk_bf16(f, 0.f) & 0xffffu); }
__device__ __forceinline__ float rcpf_(float x) { return __builtin_amdgcn_rcpf(x); }
__device__ __forceinline__ float sigmoidf_(float x) { return rcpf_(1.0f + __expf(-x)); }
__device__ __forceinline__ float siluf_(float x) { return x * rcpf_(1.0f + __expf(-x)); }
__device__ __forceinline__ float tanhf_(float x) { const float e = __expf(2.0f * x); return 1.0f - 2.0f * rcpf_(e + 1.0f); }
__device__ __forceinline__ float geluf_(float y) { const float z = 0.7978845608028654f * (y + 0.044715f * y * y * y); return 0.5f * y * (1.0f + tanhf_(z)); }
__device__ __forceinline__ float wave_sum(float v) {
#pragma unroll
    for (int o = 1; o < 64; o <<= 1) v += __shfl_xor(v, o);
    return v;
}
template <int CTRL> __device__ __forceinline__ float dpp_f(float x) { return __builtin_bit_cast(float, __builtin_amdgcn_mov_dpp(__builtin_bit_cast(int, x), CTRL, 0xf, 0xf, true)); }
__device__ __forceinline__ float wave_sum_dpp(float v) {
    v += __builtin_bit_cast(float, __builtin_amdgcn_update_dpp(0, __builtin_bit_cast(int, v), 0x111, 0xf, 0xf, true));
    v += __builtin_bit_cast(float, __builtin_amdgcn_update_dpp(0, __builtin_bit_cast(int, v), 0x112, 0xf, 0xf, true));
    v += __builtin_bit_cast(float, __builtin_amdgcn_update_dpp(0, __builtin_bit_cast(int, v), 0x114, 0xf, 0xf, true));
    v += __builtin_bit_cast(float, __builtin_amdgcn_update_dpp(0, __builtin_bit_cast(int, v), 0x118, 0xf, 0xf, true));
    v += __builtin_bit_cast(float, __builtin_amdgcn_update_dpp(0, __builtin_bit_cast(int, v), 0x142, 0xa, 0xf, false));
    v += __builtin_bit_cast(float, __builtin_amdgcn_update_dpp(0, __builtin_bit_cast(int, v), 0x143, 0xc, 0xf, false));
    return __builtin_bit_cast(float, __builtin_amdgcn_readlane(__builtin_bit_cast(int, v), 63));
}
__device__ __forceinline__ float half_sum32(float v, bool upper) {
    v += __builtin_bit_cast(float, __builtin_amdgcn_update_dpp(0, __builtin_bit_cast(int, v), 0x111, 0xf, 0xf, true));
    v += __builtin_bit_cast(float, __builtin_amdgcn_update_dpp(0, __builtin_bit_cast(int, v), 0x112, 0xf, 0xf, true));
    v += __builtin_bit_cast(float, __builtin_amdgcn_update_dpp(0, __builtin_bit_cast(int, v), 0x114, 0xf, 0xf, true));
    v += __builtin_bit_cast(float, __builtin_amdgcn_update_dpp(0, __builtin_bit_cast(int, v), 0x118, 0xf, 0xf, true));
    v += __builtin_bit_cast(float, __builtin_amdgcn_update_dpp(0, __builtin_bit_cast(int, v), 0x142, 0xa, 0xf, false));
    const float s0 = __builtin_bit_cast(float, __builtin_amdgcn_readlane(__builtin_bit_cast(int, v), 31)), s1 = __builtin_bit_cast(float, __builtin_amdgcn_readlane(__builtin_bit_cast(int, v), 63));
    return upper ? s1 : s0;
}
__device__ __forceinline__ float row16_sum(float v) {
    v += dpp_f<0xB1>(v);
    v += dpp_f<0x4E>(v);
    v += dpp_f<0x141>(v);
    v += dpp_f<0x140>(v);
    return v;
}

#define XB_TMO      128
#define XB_XCNT(j)  (256  + 64 * (j))
#define XB_XSUB(j)  (1280 + 64 * (j))
#define XB_XGEN(j)  (2304 + 64 * (j))
#define XB_TOP      3328
#define XB_TOPGEN   3392
#define XCD_BAR_WORDS 3456
#define XB_SPIN_CAP (1u << 20)
__device__ __forceinline__ unsigned xb_ld(unsigned* p)              { return __hip_atomic_load(p, __ATOMIC_RELAXED, __HIP_MEMORY_SCOPE_AGENT); }
__device__ __forceinline__ unsigned xb_add(unsigned* p, unsigned v) { return __hip_atomic_fetch_add(p, v, __ATOMIC_RELAXED, __HIP_MEMORY_SCOPE_AGENT); }
__device__ __forceinline__ unsigned xb_xcc_id() { return (unsigned)__builtin_amdgcn_s_getreg((3 << 11) | 20) & 0xFu; }
#define XB_SPIN(cond, bar) do { unsigned _sp = 0; while (cond) { __builtin_amdgcn_s_sleep(1); \
    if ((++_sp & 255u) == 0u) { if (xb_ld(&(bar)[XB_TMO])) break; if (_sp > XB_SPIN_CAP) { atomicAdd(&(bar)[XB_TMO], 1u); break; } } } } while (0)
struct XcdBarrier { unsigned* bar; unsigned x; volatile LAS unsigned* st; };
__device__ __forceinline__ XcdBarrier xcd_barrier_post(unsigned* bar, volatile LAS unsigned* st) {
    XcdBarrier b; b.bar = bar; b.x = xb_xcc_id(); b.st = st;
    if (threadIdx.x == 0) (void)xb_add(&bar[XB_XCNT(b.x)], 1u);
    return b;
}
__device__ __forceinline__ void xcd_barrier_complete(unsigned* bar, unsigned x, unsigned& nloc, unsigned& nx) {
    const unsigned G = gridDim.x * gridDim.y * gridDim.z;
    unsigned sum, cnt, mine, sp = 0u;
    for (;;) {
        sum = 0u; cnt = 0u; mine = 0u;
#pragma unroll
        for (unsigned j = 0; j < 16; ++j) { const unsigned c = xb_ld(&bar[XB_XCNT(j)]); sum += c; cnt += (c > 0u) ? 1u : 0u; mine = (j == x) ? c : mine; }
        if (sum == G) break;
        __builtin_amdgcn_s_sleep(1);
        if ((++sp & 255u) == 0u) { if (xb_ld(&bar[XB_TMO])) break; if (sp > XB_SPIN_CAP) { atomicAdd(&bar[XB_TMO], 1u); break; } }
    }
    nloc = mine > 0u ? mine : 1u; nx = cnt > 0u ? cnt : 1u;
}
__device__ __forceinline__ void xcd_barrier(const XcdBarrier& b) {
    asm volatile("s_waitcnt vmcnt(0)" ::: "memory");
    __syncthreads();
    if (threadIdx.x == 0) {
        unsigned* bar = b.bar;
        __builtin_amdgcn_s_waitcnt(0);
        unsigned nloc = b.st[0], nx = b.st[1];
        if (nloc == 0u) { xcd_barrier_complete(bar, b.x, nloc, nx); b.st[0] = nloc; b.st[1] = nx; }
        const unsigned old = xb_add(&bar[XB_XSUB(b.x)], 1u);
        const unsigned gen = old / nloc;
        if (old + 1u == (gen + 1u) * nloc) {
            __builtin_amdgcn_fence(__ATOMIC_RELEASE, "agent");
            asm volatile("s_waitcnt vmcnt(0)" ::: "memory");
            const unsigned og = xb_add(&bar[XB_TOP], 1u);
            const unsigned tg = og / nx;
            if (og + 1u == (tg + 1u) * nx) xb_add(&bar[XB_TOPGEN], 1u);
            else XB_SPIN(xb_ld(&bar[XB_TOPGEN]) == tg, bar);
            __builtin_amdgcn_fence(__ATOMIC_ACQUIRE, "agent");
            xb_add(&bar[XB_XGEN(b.x)], 1u);
            asm volatile("s_waitcnt vmcnt(0)" ::: "memory");
        } else {
            XB_SPIN(xb_ld(&bar[XB_XGEN(b.x)]) == gen, bar);
            __builtin_amdgcn_fence(__ATOMIC_ACQUIRE, "agent");
            asm volatile("s_waitcnt vmcnt(0)" ::: "memory");
        }
    }
    __syncthreads();
}

namespace pg8 {
constexpr int BM = 256, BK = 64, HALF = 128, HTB = HALF * BK * 2, STAGE_BYTES = 8 * HTB, NXCD = 8, WGM = 8;
__host__ __device__ __forceinline__ int lds_byte(int r, int c) { const int st = (r >> 4) * 2 + (c >> 5), rr = r & 15, cc = c & 31, ob = rr * 64 + cc * 2; return st * 1024 + (ob ^ (((ob >> 9) & 1) << 5)); }
__host__ __device__ __forceinline__ void stage_rc(int b, int& R, int& C) { const int st = b / 1024, sb = b % 1024, swz = sb ^ (((sb >> 9) & 1) << 5); R = (st >> 1) * 16 + swz / 64; C = (st & 1) * 32 + (swz % 64) / 2; }
__host__ __device__ __forceinline__ int perm32(int rho) { const int n = rho >> 4, i = rho & 15; return 8 * (i >> 2) + 4 * n + (i & 3); }
struct Unit { int pm, pn, koff, kt, mode; };
struct Gemm { const bf16_t* A; const bf16_t* Bt; int ld, K; };
struct StaticOrder {
    int nM, nN, nwg, G, c, kt;
    __device__ void init(int M, int N, int K, int G_, int c_) { nM = M / BM; nN = N / BM; nwg = nM * nN; G = G_; c = c_; kt = K / BK; }
    __device__ __forceinline__ void tile(int L, Unit& u) const {
        int wgid = L; { const int q = nwg / NXCD, r = nwg % NXCD, xcd = wgid % NXCD, off = wgid / NXCD; wgid = (xcd < r ? xcd * (q + 1) : r * (q + 1) + (xcd - r) * q) + off; }
        const int nig = WGM * nN, gid = wgid / nig, fm = gid * WGM, gsz = (nM - fm) < WGM ? (nM - fm) : WGM;
        u.pm = fm + ((wgid % nig) % gsz); u.pn = (wgid % nig) / gsz; u.koff = 0; u.kt = kt; u.mode = 0;
    }
    __device__ __forceinline__ bool next(int i, Unit& u) const { const long L = (long)i * G + c; if (L >= nwg) return false; tile((int)L, u); return true; }
    __device__ __forceinline__ void done(const Unit&, int, int&) const {}
};
struct OutOrder : StaticOrder {
    __device__ __forceinline__ bool next(int i, Unit& u) const {
        const int i2 = (c < 64) ? i - 1 : i;
        if (i2 < 0) { u.pm = 32; u.pn = c >> 3; u.koff = (c & 7) * 256; u.kt = 4; u.mode = 2; return true; }
        if (i2 < 2 && c < nwg) { tile(c, u); u.koff = i2 * 1024; u.kt = 16; u.mode = i2; return true; }
        return false;
    }
};
struct TailOrder : StaticOrder {
    unsigned* cnt;
    __device__ void init2(int G_, int c_, unsigned* cnt_) { nM = 32; nN = 36; nwg = 32 * 36; G = G_; c = c_; kt = 32; cnt = cnt_; }
    __device__ __forceinline__ static bool flagged(const Unit& u) { return u.pm == 32 || u.pn < 4 || u.pn == 40; }
    __device__ __forceinline__ bool next(int i, Unit& u) const {
        const int L = i * G + c; if (L >= 201 + 1152) return false;
        if (L < 132) { const int x = L & 7, k = L >> 3; if (k < 16) { u.pm = 4 * x + (k >> 2); u.pn = k & 3; } else { u.pm = 32; u.pn = x; }
                       u.koff = 0; u.kt = 32; u.mode = 0; }
        else if (L < 169) { u.pm = 32; u.pn = 4 + (L - 132); u.koff = 0; u.kt = 32; u.mode = 0; }
        else if (L < 201) { u.pm = L - 169; u.pn = 40; u.koff = 0; u.kt = 32; u.mode = 0; }
        else { tile(L - 201, u); u.pn += 4; }
        return true;
    }
    __device__ __forceinline__ void done(const Unit& u, int lane, int& pend) const {
        if (pend >= 0) {
            asm volatile("s_waitcnt vmcnt(0)" ::: "memory");
            if (lane == 0) __hip_atomic_fetch_add(cnt + 64 * pend, 1u, __ATOMIC_RELAXED, __HIP_MEMORY_SCOPE_AGENT);
            pend = -1;
        }
        if (flagged(u)) pend = (u.pm == 32) ? 16 + u.pn : ((u.pn < 4) ? (u.pm >> 3) * 4 + u.pn : 57 + u.pm);
    }
};
template <class Epi, class Sched, bool ALIGN_EPI = false, bool SP2 = false>
__device__ __forceinline__ void gemm_phase(LAS unsigned char* lds, const Gemm g, const Sched& S, const Epi& E) {
    const int tid = threadIdx.x, wid = __builtin_amdgcn_readfirstlane(tid >> 6), lane = tid & 63, wr = wid >> 2, wc = wid & 3, fr = lane & 15, fq = lane >> 4;
    const int ld = g.ld;
    unsigned voffA[2], voffB[2];
#pragma unroll
    for (int i = 0; i < 2; ++i) { int R, C; stage_rc(tid * 16 + i * 8192, R, C); const int Rb = Epi::PERM ? ((R & ~31) + perm32(R & 31)) : R;
        voffA[i] = (unsigned)(R * ld + C) * 2u; voffB[i] = (unsigned)(Rb * ld + C) * 2u; }
    const size_t kstep = (size_t)(BK * 2);
    const size_t hstep = (size_t)HALF * ld * 2;
    const size_t tstep = 2 * hstep;
    const unsigned ldsw = (unsigned)wid * 1024u;
    const int aoff = lds_byte(wr * 64 + fr, fq * 8), boff = lds_byte(wc * 32 + fr, fq * 8);
#define PG8_SA(b, h) (((b) * 2 + (h)) * HTB)
#define PG8_SB(b, h) ((4 + (b) * 2 + (h)) * HTB)
#define PG8_STAGE(bufoff, gbase, voff) do { _Pragma("unroll") for (int _i = 0; _i < 2; ++_i) \
        __builtin_amdgcn_global_load_lds((const unsigned*)((const char*)(gbase) + (voff)[_i]), (LAS unsigned*)(lds + (bufoff) + ldsw + _i * 8192), 16, 0, 0); } while (0)
#define PG8_LDA(dst, b, h) do { _Pragma("unroll") for (int m = 0; m < 4; ++m) _Pragma("unroll") for (int k = 0; k < 2; ++k) dst[m][k] = *(const LAS bf16x8*)(lds + PG8_SA(b, h) + aoff + m * 2048 + k * 1024); } while (0)
#define PG8_LDB(dst, b, h) do { _Pragma("unroll") for (int n = 0; n < 2; ++n) _Pragma("unroll") for (int k = 0; k < 2; ++k) dst[n][k] = *(const LAS bf16x8*)(lds + PG8_SB(b, h) + boff + n * 2048 + k * 1024); } while (0)
#define PG8_MMA(ai, bj, At, Bt) do { __builtin_amdgcn_s_setprio(1); _Pragma("unroll") for (int m = 0; m < 4; ++m) _Pragma("unroll") for (int n = 0; n < 2; ++n) _Pragma("unroll") for (int k = 0; k < 2; ++k) \
        acc[ai][bj][m][n] = __builtin_amdgcn_mfma_f32_16x16x32_bf16(Bt[n][k], At[m][k], acc[ai][bj][m][n], 0, 0, 0); __builtin_amdgcn_s_setprio(0); } while (0)
#define PG8_WAIT_V(n) asm volatile("s_waitcnt vmcnt(" #n ")" ::: "memory")
#define PG8_WAIT_L(n) asm volatile("s_waitcnt lgkmcnt(" #n ")" ::: "memory")
#define PG8_BAR __builtin_amdgcn_s_barrier()
#define PG8_SCHED __builtin_amdgcn_sched_barrier(0)
    Unit cur, nxt; int ui = 0; bool deferred = false; int pend = -1;
    if (!S.next(0, cur)) return;
    f32x4 acc[2][2][4][2];
#pragma unroll
    for (int a = 0; a < 2; ++a)
#pragma unroll
        for (int b = 0; b < 2; ++b)
#pragma unroll
            for (int m = 0; m < 4; ++m)
#pragma unroll
                for (int n = 0; n < 2; ++n) acc[a][b][m][n] = (f32x4){0.f, 0.f, 0.f, 0.f};
    bf16x8 At[4][2], B0[2][2], B1[2][2];
    const char* cA = (const char*)g.A + (size_t)cur.pm * tstep + (size_t)cur.koff * 2; const char* cB = (const char*)g.Bt + (size_t)cur.pn * tstep + (size_t)cur.koff * 2;
    if constexpr (SP2) {
        PG8_STAGE(PG8_SB(0, 0), cB, voffB); PG8_STAGE(PG8_SB(0, 1), cB + hstep, voffB); PG8_STAGE(PG8_SA(0, 0), cA, voffA); PG8_STAGE(PG8_SA(0, 1), cA + hstep, voffA);
        if (wr == 1) PG8_BAR;
        PG8_WAIT_V(2); PG8_BAR;
        PG8_STAGE(PG8_SB(1, 0), cB + kstep, voffB); PG8_STAGE(PG8_SA(1, 0), cA + kstep, voffA); PG8_STAGE(PG8_SB(1, 1), cB + hstep + kstep, voffB);
        PG8_WAIT_V(6); PG8_BAR;
    } else {
    PG8_STAGE(PG8_SB(0, 0), cB, voffB); PG8_STAGE(PG8_SA(0, 0), cA, voffA); PG8_STAGE(PG8_SB(0, 1), cB + hstep, voffB); PG8_STAGE(PG8_SA(0, 1), cA + hstep, voffA);
    if (wr == 1) PG8_BAR;
    PG8_WAIT_V(4); PG8_BAR;
    PG8_STAGE(PG8_SB(1, 0), cB + kstep, voffB); PG8_STAGE(PG8_SA(1, 0), cA + kstep, voffA); PG8_STAGE(PG8_SB(1, 1), cB + hstep + kstep, voffB);
    PG8_WAIT_V(6); PG8_BAR;
    }
    for (;;) {
        const bool has_next = S.next(ui + 1, nxt);
        const char* nA = has_next ? (const char*)g.A + (size_t)nxt.pm * tstep + (size_t)nxt.koff * 2 : cA; const char* nB = has_next ? (const char*)g.Bt + (size_t)nxt.pn * tstep + (size_t)nxt.koff * 2 : cB;
        const int nt = cur.kt;
        for (int t = 0; t < nt; t += 2) {
            const bool last = (t == nt - 2);
            const char* a1 = cA + (size_t)(t + 1) * kstep;
            const char* a2 = last ? nA : cA + (size_t)(t + 2) * kstep; const char* b2 = last ? nB : cB + (size_t)(t + 2) * kstep;
            const char* a3 = a2 + kstep; const char* b3 = b2 + kstep;
            if constexpr (SP2) {
            PG8_LDB(B0, 0, 0); PG8_LDB(B1, 0, 1); PG8_SCHED; PG8_LDA(At, 0, 0); PG8_STAGE(PG8_SA(1, 1), a1 + hstep, voffA);
            PG8_WAIT_V(8); PG8_WAIT_L(0); PG8_BAR; PG8_MMA(0, 0, At, B0); PG8_MMA(0, 1, At, B1); PG8_BAR; PG8_SCHED;
            PG8_LDA(At, 0, 1); PG8_STAGE(PG8_SB(0, 0), b2, voffB); PG8_STAGE(PG8_SB(0, 1), b2 + hstep, voffB); PG8_STAGE(PG8_SA(0, 0), a2, voffA);
            PG8_WAIT_V(8); PG8_WAIT_L(0); PG8_BAR; PG8_MMA(1, 0, At, B0); PG8_MMA(1, 1, At, B1); PG8_BAR; PG8_SCHED;
            PG8_LDB(B0, 1, 0); PG8_LDB(B1, 1, 1); PG8_SCHED; PG8_LDA(At, 1, 0); PG8_STAGE(PG8_SA(0, 1), a2 + hstep, voffA);
            PG8_WAIT_V(8); PG8_WAIT_L(0); PG8_BAR; PG8_MMA(0, 0, At, B0); PG8_MMA(0, 1, At, B1); PG8_BAR; PG8_SCHED;
            PG8_LDA(At, 1, 1); PG8_STAGE(PG8_SB(1, 0), b3, voffB); PG8_STAGE(PG8_SB(1, 1), b3 + hstep, voffB); PG8_STAGE(PG8_SA(1, 0), a3, voffA);
            PG8_WAIT_V(8); PG8_WAIT_L(0); PG8_BAR; PG8_MMA(1, 0, At, B0); PG8_MMA(1, 1, At, B1); PG8_BAR; PG8_SCHED;
            } else {
            PG8_LDB(B0, 0, 0); PG8_SCHED; PG8_LDA(At, 0, 0); PG8_STAGE(PG8_SA(1, 1), a1 + hstep, voffA);
            PG8_WAIT_L(8); PG8_BAR; PG8_WAIT_L(0); PG8_MMA(0, 0, At, B0); PG8_BAR; PG8_SCHED;
            PG8_LDB(B1, 0, 1); PG8_STAGE(PG8_SB(0, 0), b2, voffB);
            PG8_BAR; PG8_WAIT_L(0); PG8_MMA(0, 1, At, B1); PG8_BAR;
            PG8_LDA(At, 0, 1); PG8_STAGE(PG8_SA(0, 0), a2, voffA);
            PG8_BAR; PG8_WAIT_L(0); PG8_MMA(1, 0, At, B0); PG8_BAR; PG8_SCHED;
            PG8_STAGE(PG8_SB(0, 1), b2 + hstep, voffB);
            PG8_WAIT_V(6); PG8_BAR; PG8_MMA(1, 1, At, B1); PG8_BAR;
            PG8_LDB(B0, 1, 0); PG8_SCHED; PG8_LDA(At, 1, 0); PG8_STAGE(PG8_SA(0, 1), a2 + hstep, voffA);
            PG8_WAIT_L(8); PG8_BAR; PG8_WAIT_L(0); PG8_MMA(0, 0, At, B0); PG8_BAR; PG8_SCHED;
            PG8_LDB(B1, 1, 1); PG8_STAGE(PG8_SB(1, 0), b3, voffB);
            PG8_BAR; PG8_WAIT_L(0); PG8_MMA(0, 1, At, B1); PG8_BAR;
            PG8_LDA(At, 1, 1); PG8_STAGE(PG8_SA(1, 0), a3, voffA);
            PG8_BAR; PG8_WAIT_L(0); PG8_MMA(1, 0, At, B0); PG8_BAR; PG8_SCHED;
            PG8_STAGE(PG8_SB(1, 1), b3 + hstep, voffB);
            PG8_WAIT_V(6); PG8_BAR; PG8_MMA(1, 1, At, B1); PG8_BAR;
            }
        }
        if constexpr (ALIGN_EPI) { if (wr == 0) PG8_BAR; }
        if (Epi::FUSED_LAST && !has_next && cur.mode == 1) deferred = true; else { E(acc, cur, wr, wc, fr, fq); S.done(cur, lane, pend); }
        const bool keep_acc = Epi::FUSED_LAST && cur.mode == 0;
        if (!has_next) break;
        if (!keep_acc) {
#pragma unroll
        for (int a = 0; a < 2; ++a)
#pragma unroll
            for (int b = 0; b < 2; ++b)
#pragma unroll
                for (int m = 0; m < 4; ++m)
#pragma unroll
                    for (int n = 0; n < 2; ++n) acc[a][b][m][n] = (f32x4){0.f, 0.f, 0.f, 0.f};
        }
        cur = nxt; cA = nA; cB = nB; ++ui;
        if constexpr (ALIGN_EPI) { if (wr == 1) PG8_BAR; }
    }
    PG8_WAIT_V(0);
    if constexpr (!ALIGN_EPI) { if (wr == 0) PG8_BAR; }
    PG8_BAR;
    if constexpr (Epi::FUSED_LAST) { if (deferred) E.fused(acc, cur, wr, wc, fr, fq, lds, wid, lane); }
#undef PG8_SA
#undef PG8_SB
#undef PG8_STAGE
#undef PG8_LDA
#undef PG8_LDB
#undef PG8_MMA
#undef PG8_WAIT_V
#undef PG8_WAIT_L
#undef PG8_BAR
#undef PG8_SCHED
}
}

struct EpiP {
    static constexpr bool PERM = true, FUSED_LAST = false;
    bf16_t* P; bool tail; bf16_t* U2;
    __device__ __forceinline__ void operator()(const f32x4 (&acc)[2][2][4][2], const pg8::Unit& u, int wr, int wc, int fr, int fq) const {
        const int row0 = u.pm * 256 + wr * 64 + fr, col0 = u.pn * 256 + wc * 32 + 8 * fq;
        const bool wt = tail && (u.pm == 32 || u.pn < 4 || u.pn == 40);
        const __amdgpu_buffer_rsrc_t rsrc = __builtin_amdgcn_make_buffer_rsrc(P, 0, (int)((size_t)MT * LDP * 2), 0x00020000);
        const __amdgpu_buffer_rsrc_t rsrc2 = __builtin_amdgcn_make_buffer_rsrc(U2, 0, (int)((size_t)MV * 1024 * 2), 0x00020000);
        const int act = ((u.pn >= 4 && u.pn < 8) || (u.pn >= 20 && u.pn < 24)) ? 1 : ((u.pn >= 24 && u.pn < 40) ? 2 : 0);
#pragma unroll
        for (int ai = 0; ai < 2; ++ai)
#pragma unroll
            for (int m = 0; m < 4; ++m) { bf16_t* rowp = P + (size_t)(row0 + ai * 128 + m * 16) * LDP + col0;
#pragma unroll
                for (int bj = 0; bj < 2; ++bj) { f32x4 v0 = acc[ai][bj][m][0], v1 = acc[ai][bj][m][1];
                    if (act == 1) {
#pragma unroll
                        for (int j = 0; j < 4; ++j) { v0[j] = siluf_(v0[j]); v1[j] = siluf_(v1[j]); } }
                    else if (act == 2) {
#pragma unroll
                        for (int j = 0; j < 4; ++j) { v0[j] = sigmoidf_(v0[j]); v1[j] = sigmoidf_(v1[j]); } }
                    u32x4 w; w.x = cvt_pk_bf16(v0[0], v0[1]); w.y = cvt_pk_bf16(v0[2], v0[3]); w.z = cvt_pk_bf16(v1[0], v1[1]); w.w = cvt_pk_bf16(v1[2], v1[3]);
                    if (u.pn < 4) {
                        const int row = row0 + ai * 128 + m * 16, col = col0 + bj * 128, g2 = col >> 4, hf = (col >> 3) & 1;
                        size_t eo; if (row < MP) eo = (((size_t)(row >> 11) * 64 + g2) * SEQ + (row & (SEQ - 1))) * 16 + hf * 8; else eo = (size_t)MP * 1024 + ((size_t)g2 * NSMP + ((row - MP) & (NSMP - 1))) * 16 + hf * 8;
                        if (row < MV) { if (wt) __builtin_amdgcn_raw_buffer_store_b128(w, rsrc2, (unsigned)(eo * 2), 0, 16); else *(u32x4*)(U2 + eo) = w; } }
                    else if (wt) __builtin_amdgcn_raw_buffer_store_b128(w, rsrc, (unsigned)((size_t)(row0 + ai * 128 + m * 16) * LDP + col0 + bj * 128) * 2u, 0, 16);
                    else *(u32x4*)(rowp + bj * 128) = w; } }
    }
};
struct EpiGlu {
    static constexpr bool PERM = true, FUSED_LAST = false;
    const bf16_t* Yg; const bf16_t* P; const float* bglu; bf16_t* A2;
    __device__ __forceinline__ void operator()(const f32x4 (&acc)[2][2][4][2], const pg8::Unit& u, int wr, int wc, int fr, int fq) const {
        const int row0 = u.pm * 256 + wr * 64 + fr, col0 = u.pn * 256 + wc * 32 + 8 * fq;
        f32x4 bv[2][2];
#pragma unroll
        for (int bj = 0; bj < 2; ++bj)
#pragma unroll
            for (int n = 0; n < 2; ++n) bv[bj][n] = *(const f32x4*)(bglu + col0 + bj * 128 + 4 * n);
#pragma unroll
        for (int ai = 0; ai < 2; ++ai)
#pragma unroll
            for (int m = 0; m < 4; ++m) { const size_t row = (size_t)(row0 + ai * 128 + m * 16);
#pragma unroll
                for (int bj = 0; bj < 2; ++bj) { const int c = col0 + bj * 128;
                    const u32x4 yg = *(const u32x4*)(Yg + row * 1024 + c), sz = *(const u32x4*)(P + row * LDP + PC_ZS + c);
                    const f32x4 a0 = acc[ai][bj][m][0] + bv[bj][0], a1 = acc[ai][bj][m][1] + bv[bj][1];
                    float o[8];
                    o[0] = bf_lo(yg.x) * sigmoidf_(a0[0]) * bf_lo(sz.x); o[1] = bf_hi(yg.x) * sigmoidf_(a0[1]) * bf_hi(sz.x);
                    o[2] = bf_lo(yg.y) * sigmoidf_(a0[2]) * bf_lo(sz.y); o[3] = bf_hi(yg.y) * sigmoidf_(a0[3]) * bf_hi(sz.y);
                    o[4] = bf_lo(yg.z) * sigmoidf_(a1[0]) * bf_lo(sz.z); o[5] = bf_hi(yg.z) * sigmoidf_(a1[1]) * bf_hi(sz.z);
                    o[6] = bf_lo(yg.w) * sigmoidf_(a1[2]) * bf_lo(sz.w); o[7] = bf_hi(yg.w) * sigmoidf_(a1[3]) * bf_hi(sz.w);
                    u32x4 w; w.x = cvt_pk_bf16(o[0], o[1]); w.y = cvt_pk_bf16(o[2], o[3]); w.z = cvt_pk_bf16(o[4], o[5]); w.w = cvt_pk_bf16(o[6], o[7]);
                    *(u32x4*)(A2 + row * 2048 + c) = w; } }
    }
};
struct EpiOut {
    static constexpr bool PERM = false, FUSED_LAST = true;
    const bf16_t* P; const float* xp; const float* mod; float* out; float* xbuf; bf16_t* tmp; float* slab; unsigned* cnt; const float* fg;
    __device__ __forceinline__ void operator()(f32x4 (&acc)[2][2][4][2], const pg8::Unit& u, int wr, int wc, int fr, int fq) const {
        const int row0 = u.pm * 256 + wr * 64 + fr, col0 = u.pn * 256 + wc * 32 + 4 * fq;
        if (u.mode == 0) {
#pragma unroll
            for (int ai = 0; ai < 2; ++ai)
#pragma unroll
                for (int m = 0; m < 4; ++m) { const size_t row = (size_t)(row0 + ai * 128 + m * 16); const bf16_t* p1 = P + row * LDP + PC_GS + col0; const bf16_t* p2 = P + row * LDP + PC_GR + col0;
#pragma unroll
                    for (int bj = 0; bj < 2; ++bj)
#pragma unroll
                        for (int n = 0; n < 2; ++n) { const int o = bj * 128 + n * 16; const u32x2 g1 = *(const u32x2*)(p1 + o), g2 = *(const u32x2*)(p2 + o); f32x4& a = acc[ai][bj][m][n];
                            a[0] *= bf_lo(g1.x) * rcpf_(bf_lo(g2.x)); a[1] *= bf_hi(g1.x) * rcpf_(bf_hi(g2.x)); a[2] *= bf_lo(g1.y) * rcpf_(bf_lo(g2.y)); a[3] *= bf_hi(g1.y) * rcpf_(bf_hi(g2.y)); } }
        } else {
            const int gc = (u.koff < 1024) ? PC_GS : PC_GR; float* sl = slab + (size_t)(u.koff >> 8) * NSMP * DM;
#pragma unroll
            for (int m = 0; m < 4; ++m) { const size_t row = (size_t)(row0 + m * 16); const bf16_t* prow = P + row * LDP + gc + col0; float* srow = sl + (row - MP) * DM + col0;
#pragma unroll
                for (int bj = 0; bj < 2; ++bj)
#pragma unroll
                    for (int n = 0; n < 2; ++n) { const int o = bj * 128 + n * 16; const u32x2 gg = *(const u32x2*)(prow + o); const f32x4 a = acc[0][bj][m][n];
                        *(f32x4*)(srow + o) = (f32x4){bf_lo(gg.x) * a[0], bf_hi(gg.x) * a[1], bf_lo(gg.y) * a[2], bf_hi(gg.y) * a[3]}; } }
        }
    }
    __device__ __forceinline__ void fused(f32x4 (&acc)[2][2][4][2], const pg8::Unit& u, int wr, int wc, int fr, int fq, LAS unsigned char* lds, int wid, int lane) const {
        const int row0 = u.pm * 256 + wr * 64 + fr, col0 = u.pn * 256 + wc * 32 + 4 * fq;
        LAS float* PT = (LAS float*)lds; LAS float* ST = (LAS float*)(lds + 4096);
        f32x4 gt[2][2];
        { const float* gtrow = mod + (size_t)(u.pm >> 3) * NMOD + 2 * DM + col0;
#pragma unroll
          for (int bj = 0; bj < 2; ++bj)
#pragma unroll
              for (int n = 0; n < 2; ++n) gt[bj][n] = *(const f32x4*)(gtrow + bj * 128 + n * 16); }
#pragma unroll
        for (int ai = 0; ai < 2; ++ai)
#pragma unroll
            for (int m = 0; m < 4; ++m) { const size_t row = (size_t)(row0 + ai * 128 + m * 16);
                const bf16_t* prow = P + row * LDP + PC_GR + col0; const float* xrow = xp + row * DM + col0;
                u32x2 gg[4]; f32x4 xv[4];
#pragma unroll
                for (int q = 0; q < 4; ++q) { const int o = (q >> 1) * 128 + (q & 1) * 16; gg[q] = *(const u32x2*)(prow + o); xv[q] = *(const f32x4*)(xrow + o); }
                float ss = 0.f;
#pragma unroll
                for (int q = 0; q < 4; ++q) { const f32x4 a = acc[ai][q >> 1][m][q & 1]; const f32x4 g4 = gt[q >> 1][q & 1];
                    f32x4 r; r[0] = xv[q][0] + g4[0] * (bf_lo(gg[q].x) * a[0]); r[1] = xv[q][1] + g4[1] * (bf_hi(gg[q].x) * a[1]);
                    r[2] = xv[q][2] + g4[2] * (bf_lo(gg[q].y) * a[2]); r[3] = xv[q][3] + g4[3] * (bf_hi(gg[q].y) * a[3]);
                    ss += (r[0] * r[0] + r[1] * r[1]) + (r[2] * r[2] + r[3] * r[3]);
                    acc[ai][q >> 1][m][q & 1] = r; }
                ss += __shfl_xor(ss, 16); ss += __shfl_xor(ss, 32);
                if (fq == 0) PT[(ai * 128 + wr * 64 + m * 16 + fr) * 4 + wc] = ss; }
        asm volatile("s_waitcnt lgkmcnt(0)" ::: "memory"); __builtin_amdgcn_s_barrier(); asm volatile("" ::: "memory");
        const int row = wid * 32 + (lane & 31);
        if (lane < 32) { const f32x4 p4 = *(const LAS f32x4*)(PT + row * 4);
            __hip_atomic_store(xbuf + ((size_t)(u.pm * 256 + row) * 8 + u.pn), (p4[0] + p4[1]) + (p4[2] + p4[3]), __ATOMIC_RELAXED, __HIP_MEMORY_SCOPE_AGENT); }
        asm volatile("s_waitcnt vmcnt(0)" ::: "memory");
        if (lane == 0) __hip_atomic_fetch_add(cnt + 64 * u.pm, 1u, __ATOMIC_RELAXED, __HIP_MEMORY_SCOPE_AGENT);
        if (wid == 0) {
            unsigned sp = 0;
            while ((unsigned)__builtin_amdgcn_readfirstlane(__hip_atomic_load(cnt + 64 * u.pm, __ATOMIC_RELAXED, __HIP_MEMORY_SCOPE_AGENT)) < 64u) { __builtin_amdgcn_s_sleep(2); if (++sp > (1u << 22)) break; }
            __builtin_amdgcn_fence(__ATOMIC_ACQUIRE, "agent");
        }
        asm volatile("s_waitcnt vmcnt(0) lgkmcnt(0)" ::: "memory"); __builtin_amdgcn_s_barrier(); asm volatile("" ::: "memory");
        if (lane < 32) { const float* sl = xbuf + (size_t)(u.pm * 256 + row) * 8; float s8 = 0.f;
#pragma unroll
            for (int t = 0; t < 8; ++t) s8 += __hip_atomic_load(sl + t, __ATOMIC_RELAXED, __HIP_MEMORY_SCOPE_AGENT);
            ST[row] = rsqrtf(s8 * (1.0f / DM) + RMS_EPS); }
        asm volatile("s_waitcnt lgkmcnt(0)" ::: "memory"); __builtin_amdgcn_s_barrier(); asm volatile("" ::: "memory");
        f32x4 fgv[2][2];
#pragma unroll
        for (int bj = 0; bj < 2; ++bj)
#pragma unroll
            for (int n = 0; n < 2; ++n) fgv[bj][n] = *(const f32x4*)(fg + col0 + bj * 128 + n * 16);
#pragma unroll
        for (int ai = 0; ai < 2; ++ai)
#pragma unroll
            for (int m = 0; m < 4; ++m) { const int rl = ai * 128 + wr * 64 + m * 16 + fr; const float rstd = ST[rl]; float* orow = out + (size_t)(u.pm * 256 + rl) * DM + col0;
#pragma unroll
                for (int bj = 0; bj < 2; ++bj)
#pragma unroll
                    for (int n = 0; n < 2; ++n) *(f32x4*)(orow + bj * 128 + n * 16) = acc[ai][bj][m][n] * rstd * fgv[bj][n]; }
    }
};

struct Args { const float* in[34]; float* out; unsigned char* ws; int ph_lo, ph_hi, li, pad; };
enum { I_XP = 0, I_XS, I_CP, I_CS, I_S5RE, I_S5IM, I_WKV, I_SHIFT, I_NORMG, I_WADA, I_BADA, I_WIN, I_MU, I_ARE, I_AIM, I_LOGSTEP, I_BRE, I_BIM, I_CRE, I_CIM, I_DSKIP,
       I_WGLU, I_BGLU, I_W0, I_W2, I_A0, I_A2, I_KK, I_KA, I_RK, I_GNW, I_GNB, I_WOUT, I_FINALG };

__device__ __forceinline__ void transpose_item(const float* W, int ldw, int K, int csrc, bf16_t* WT, int rdst, int k0, LAS float* scr, int lane, bool zero) {
    if (zero) {
#pragma unroll
        for (int j = 0; j < 4; ++j) { const int n = (lane >> 3) + 8 * j; *(u32x4*)(WT + (size_t)(rdst + n) * K + k0 + 8 * (lane & 7)) = (u32x4){0u, 0u, 0u, 0u}; }
        return;
    }
#pragma unroll 8
    for (int i = 0; i < 32; ++i) { const int kk = 2 * i + (lane >> 5); scr[kk * 33 + (lane & 31)] = W[(size_t)(k0 + kk) * ldw + csrc + (lane & 31)]; }
    LDS_WAIT(); asm volatile("" ::: "memory");
    const int c = lane & 7;
#pragma unroll
    for (int j = 0; j < 4; ++j) { const int n = (lane >> 3) + 8 * j; const LAS float* s = scr + (8 * c) * 33 + n;
        u32x4 o; o.x = cvt_pk_bf16(s[0 * 33], s[1 * 33]); o.y = cvt_pk_bf16(s[2 * 33], s[3 * 33]); o.z = cvt_pk_bf16(s[4 * 33], s[5 * 33]); o.w = cvt_pk_bf16(s[6 * 33], s[7 * 33]);
        *(u32x4*)(WT + (size_t)(rdst + n) * K + k0 + 8 * c) = o; }
    LDS_WAIT(); asm volatile("" ::: "memory");
}

__device__ __forceinline__ void lerp8(const bf16_t* cur, const bf16_t* prev, bool has_prev, const float* mu, float (&o)[8]) {
    const u32x4 c = *(const u32x4*)cur; u32x4 p = (u32x4){0u, 0u, 0u, 0u}; if (has_prev) p = *(const u32x4*)prev;
    const f32x4 m0 = *(const f32x4*)mu, m1 = *(const f32x4*)(mu + 4);
    const float cf[8] = {bf_lo(c.x), bf_hi(c.x), bf_lo(c.y), bf_hi(c.y), bf_lo(c.z), bf_hi(c.z), bf_lo(c.w), bf_hi(c.w)};
    const float pf[8] = {bf_lo(p.x), bf_hi(p.x), bf_lo(p.y), bf_hi(p.y), bf_lo(p.z), bf_hi(p.z), bf_lo(p.w), bf_hi(p.w)};
    const float mf[8] = {m0[0], m0[1], m0[2], m0[3], m1[0], m1[1], m1[2], m1[3]};
#pragma unroll
    for (int j = 0; j < 8; ++j) o[j] = cf[j] + (pf[j] - cf[j]) * mf[j];
}
__device__ __forceinline__ void p2_xw_panel(const Args& a, int pm, int tid) {
    const bf16_t* P = (const bf16_t*)(a.ws + WS_P); bf16_t* XW = (bf16_t*)(a.ws + WS_XW); const float* mu = a.in[I_MU];
    const int row = pm * 256 + (tid >> 1), hf = tid & 1; const bool hp = (row & (SEQ - 1)) != 0;
#pragma unroll
    for (int k8 = 0; k8 < 8; ++k8) { const int col = 64 * hf + 8 * k8; float x8[8];
        lerp8(P + (size_t)row * LDP + PC_WD + col, P + (size_t)(row - 1) * LDP + PC_WD + col, hp, mu + 3072 + col, x8);
        if (hf == 0) {
#pragma unroll
            for (int j = 0; j < 8; ++j) x8[j] = tanhf_(x8[j]); }
        u32x4 t; t.x = cvt_pk_bf16(x8[0], x8[1]); t.y = cvt_pk_bf16(x8[2], x8[3]); t.z = cvt_pk_bf16(x8[4], x8[5]); t.w = cvt_pk_bf16(x8[6], x8[7]);
        *(u32x4*)(XW + (size_t)row * 128 + col) = t; }
}
__device__ __forceinline__ void wait_count(unsigned* cnt, unsigned need, int wave) {
    if (wave == 0) { unsigned sp = 0;
        while ((unsigned)__builtin_amdgcn_readfirstlane(__hip_atomic_load(cnt, __ATOMIC_RELAXED, __HIP_MEMORY_SCOPE_AGENT)) < need) { __builtin_amdgcn_s_sleep(4); if (++sp > (1u << 22)) break; }
        __builtin_amdgcn_fence(__ATOMIC_ACQUIRE, "agent");
        asm volatile("s_waitcnt vmcnt(0)" ::: "memory"); }
    __syncthreads();
}
__device__ __forceinline__ void p0_silu_prep(const Args& a, int idx, int tid, unsigned* aready) {
    const float* cp = a.in[I_CP]; const float* cs = a.in[I_CS];
    const __amdgpu_buffer_rsrc_t rs = __builtin_amdgcn_make_buffer_rsrc((void*)(a.ws + WS_SA), 0, 128 * 5 * 64 * 16, 0x00020000);
    for (int it = idx * 512 + tid; it < 128 * 5 * 64; it += 64 * 512) { const int l = it & 63, q = it >> 6, S = q / 5, t = q - 5 * S; const int R = 32 * t + (l & 31), k = 16 * S + 8 * (l >> 5);
        u32x4 w = (u32x4){0u, 0u, 0u, 0u};
        if (R < NMODROWS) { const float* src = (R < NB) ? cp + (size_t)R * DM + k : cs + (size_t)(R - NB) * DM + k; const f32x4 c0 = *(const f32x4*)src, c1 = *(const f32x4*)(src + 4);
            w.x = cvt_pk_bf16(siluf_(c0[0]), siluf_(c0[1])); w.y = cvt_pk_bf16(siluf_(c0[2]), siluf_(c0[3])); w.z = cvt_pk_bf16(siluf_(c1[0]), siluf_(c1[1])); w.w = cvt_pk_bf16(siluf_(c1[2]), siluf_(c1[3])); }
        __builtin_amdgcn_raw_buffer_store_b128(w, rs, (unsigned)it * 16u, 0, 16); }
    asm volatile("s_waitcnt vmcnt(0)" ::: "memory");
    __syncthreads();
    if (tid == 0) __hip_atomic_fetch_add(aready, 1u, __ATOMIC_RELAXED, __HIP_MEMORY_SCOPE_AGENT);
}
__device__ __forceinline__ void p0_mod(const Args& a, LAS unsigned char* lds, int s, int wave, int lane, unsigned* aready) {
    const float* W = a.in[I_WADA]; const float* bias = a.in[I_BADA];
    float* mod = (float*)(a.ws + WS_MOD);
    const u32x4* SA = (const u32x4*)(a.ws + WS_SA);
    const int n0 = 32 * s, k0 = 256 * wave, r31 = lane & 31, h = lane >> 5;
    f32x16 acc[5];
#pragma unroll
    for (int t = 0; t < 5; ++t)
#pragma unroll
        for (int r = 0; r < 16; ++r) acc[t][r] = 0.f;
    float bw[4][8]; u32x4 af[4][5];
#define MOD_LW(st_, ks_) do { const float* wp_ = W + (size_t)(k0 + 16 * (ks_) + 8 * h) * NMOD + n0 + r31; \
        _Pragma("unroll") for (int j = 0; j < 8; ++j) bw[st_][j] = wp_[(size_t)j * NMOD]; } while (0)
#define MOD_LA(st_, ks_) do { const u32x4* ap_ = SA + ((size_t)(16 * wave + (ks_)) * 5) * 64 + lane; \
        _Pragma("unroll") for (int t = 0; t < 5; ++t) af[st_][t] = ap_[t * 64]; } while (0)
    MOD_LW(0, 0); MOD_LW(1, 1); MOD_LW(2, 2);
    { unsigned sp = 0;
      while ((unsigned)__builtin_amdgcn_readfirstlane(__hip_atomic_load(aready, __ATOMIC_RELAXED, __HIP_MEMORY_SCOPE_AGENT)) < 64u) { __builtin_amdgcn_s_sleep(2); if (++sp > (1u << 22)) break; }
      __builtin_amdgcn_fence(__ATOMIC_ACQUIRE, "agent"); }
    MOD_LA(0, 0); MOD_LA(1, 1); MOD_LA(2, 2);
#pragma unroll 1
    for (int ks = 0; ks < 16; ks += 4) {
#pragma unroll
        for (int u = 0; u < 4; ++u) {
            if (ks + u + 3 < 16) { MOD_LW((u + 3) & 3, ks + u + 3); MOD_LA((u + 3) & 3, ks + u + 3); }
            bf16x8 bfr; { u32x4 t; t.x = cvt_pk_bf16(bw[u][0], bw[u][1]); t.y = cvt_pk_bf16(bw[u][2], bw[u][3]); t.z = cvt_pk_bf16(bw[u][4], bw[u][5]); t.w = cvt_pk_bf16(bw[u][6], bw[u][7]); bfr = __builtin_bit_cast(bf16x8, t); }
#pragma unroll
            for (int t = 0; t < 5; ++t) acc[t] = __builtin_amdgcn_mfma_f32_32x32x16_bf16(__builtin_bit_cast(bf16x8, af[u][t]), bfr, acc[t], 0, 0, 0);
        }
    }
#undef MOD_LW
#undef MOD_LA
    LAS float* red = (LAS float*)lds;
#pragma unroll
    for (int step = 4; step >= 1; step >>= 1) {
        if (wave >= step && wave < 2 * step) {
#pragma unroll
            for (int t = 0; t < 5; ++t)
#pragma unroll
                for (int r = 0; r < 16; ++r) red[(((wave - step) * 5 + t) * 16 + r) * 64 + lane] = acc[t][r];
        }
        __syncthreads();
        if (wave < step) {
#pragma unroll
            for (int t = 0; t < 5; ++t)
#pragma unroll
                for (int r = 0; r < 16; ++r) acc[t][r] += red[((wave * 5 + t) * 16 + r) * 64 + lane];
        }
        __syncthreads();
    }
    if (wave == 0) {
        const float bc = bias[n0 + r31];
#pragma unroll
        for (int t = 0; t < 5; ++t)
#pragma unroll
            for (int r = 0; r < 16; ++r) { const int R = 32 * t + (r & 3) + 8 * (r >> 2) + 4 * h; if (R < NMODROWS) mod[(size_t)R * NMOD + n0 + r31] = acc[t][r] + bc; }
    }
}

__device__ __forceinline__ void p0_s5_tables(const Args& a, LAS unsigned char* lds, int g, int tid) {
    LAS float* pw = (LAS float*)lds;
    LAS float* bbL = pw + 17 * 128;
    LAS float* ccL = bbL + 2048;
    LAS float* KF = ccL + 2048;
    LAS float* DL = KF + 4096;
    unsigned char* tab = (unsigned char*)a.out + DO_S5TAB + (size_t)g * S5T_BYTES;
    {
        const int p = tid & 63;
        const float step = expf(a.in[I_LOGSTEP][g]);
        const float lre = fminf(a.in[I_ARE][g * 64 + p], -1e-4f), lim = a.in[I_AIM][g * 64 + p];
        const float mag = expf(lre * step); float sn, cs; sincosf(lim * step, &sn, &cs);
        const float abr = mag * cs, abi = mag * sn, den = lre * lre + lim * lim;
        const float fr = ((abr - 1.0f) * lre + abi * lim) / den, fi = (abi * lre - (abr - 1.0f) * lim) / den;
        if (tid < 64) { float pr = 1.f, pi = 0.f;
            for (int e = 0; e <= 16; ++e) { pw[(e * 64 + p) * 2] = pr; pw[(e * 64 + p) * 2 + 1] = pi; const float nr = pr * abr - pi * abi, ni = pr * abi + pi * abr; pr = nr; pi = ni; } }
#pragma unroll
        for (int i = 0; i < 2; ++i) { const int c = (tid >> 6) + 8 * i; const float br = a.in[I_BRE][(g * 64 + p) * 16 + c], bi = a.in[I_BIM][(g * 64 + p) * 16 + c];
            bbL[(p * 16 + c) * 2] = fr * br - fi * bi; bbL[(p * 16 + c) * 2 + 1] = fr * bi + fi * br;
            ccL[(c * 64 + p) * 2] = a.in[I_CRE][(g * 16 + c) * 64 + p]; ccL[(c * 64 + p) * 2 + 1] = a.in[I_CIM][(g * 16 + c) * 64 + p]; }
        if (tid < 16) DL[tid] = a.in[I_DSKIP][g * 16 + tid];
    }
    __syncthreads();
    if (tid < 256) { const int c = tid >> 4, c2 = tid & 15; float s = 0.f;
        for (int p = 0; p < 64; ++p) s += ccL[(c * 64 + p) * 2] * bbL[(p * 16 + c2) * 2] - ccL[(c * 64 + p) * 2 + 1] * bbL[(p * 16 + c2) * 2 + 1];
        if (c == c2) s += DL[c];
        KF[tid] = s; }
    for (int it = tid; it < 4096; it += 512) { const int l = it & 63, s = (it >> 6) & 15, mtile = it >> 10; const int m = 32 * mtile + (l & 31), h = l >> 5, p = m & 63, im = m >> 6;
        const float pr = pw[((15 - s) * 64 + p) * 2], pi = pw[((15 - s) * 64 + p) * 2 + 1]; float v[8];
#pragma unroll
        for (int j = 0; j < 8; ++j) { const float br = bbL[(p * 16 + 8 * h + j) * 2], bi = bbL[(p * 16 + 8 * h + j) * 2 + 1]; v[j] = im ? (pr * bi + pi * br) : (pr * br - pi * bi); }
        u32x4 w; w.x = cvt_pk_bf16(v[0], v[1]); w.y = cvt_pk_bf16(v[2], v[3]); w.z = cvt_pk_bf16(v[4], v[5]); w.w = cvt_pk_bf16(v[6], v[7]);
        *(u32x4*)(tab + S5T_ME + (size_t)it * 16) = w; }
    { const int l = tid & 63, mt = tid >> 6; const int rho = l & 31, dt = rho >> 4, c = rho & 15, h = l >> 5, t = 2 * mt + dt;
      f32x16 kacc;
#pragma unroll
      for (int r = 0; r < 16; ++r) kacc[r] = 0.f;
#pragma unroll 2
      for (int ks = 0; ks < 8; ++ks) { float v[8], b[8];
#pragma unroll
        for (int j = 0; j < 8; ++j) { const int m = 16 * ks + 8 * h + j, p = m & 63; const float cr = ccL[(c * 64 + p) * 2], ci = ccL[(c * 64 + p) * 2 + 1], pr = pw[((t + 1) * 64 + p) * 2], pi = pw[((t + 1) * 64 + p) * 2 + 1];
            v[j] = (m < 64) ? (cr * pr - ci * pi) : -(cr * pi + ci * pr);
            b[j] = (rho < 16) ? bbL[(p * 16 + rho) * 2 + (m >> 6)] : 0.f; }
        u32x4 w; w.x = cvt_pk_bf16(v[0], v[1]); w.y = cvt_pk_bf16(v[2], v[3]); w.z = cvt_pk_bf16(v[4], v[5]); w.w = cvt_pk_bf16(v[6], v[7]);
        *(u32x4*)(tab + S5T_CA + (size_t)((mt * 8 + ks) * 64 + l) * 16) = w;
        u32x4 wl; wl.x = cvt_pk_bf16(v[0] - bf_lo(w.x), v[1] - bf_hi(w.x)); wl.y = cvt_pk_bf16(v[2] - bf_lo(w.y), v[3] - bf_hi(w.y)); wl.z = cvt_pk_bf16(v[4] - bf_lo(w.z), v[5] - bf_hi(w.z)); wl.w = cvt_pk_bf16(v[6] - bf_lo(w.w), v[7] - bf_hi(w.w));
        u32x4 bh; bh.x = cvt_pk_bf16(b[0], b[1]); bh.y = cvt_pk_bf16(b[2], b[3]); bh.z = cvt_pk_bf16(b[4], b[5]); bh.w = cvt_pk_bf16(b[6], b[7]);
        u32x4 bl; bl.x = cvt_pk_bf16(b[0] - bf_lo(bh.x), b[1] - bf_hi(bh.x)); bl.y = cvt_pk_bf16(b[2] - bf_lo(bh.y), b[3] - bf_hi(bh.y)); bl.z = cvt_pk_bf16(b[4] - bf_lo(bh.z), b[5] - bf_hi(bh.z)); bl.w = cvt_pk_bf16(b[6] - bf_lo(bh.w), b[7] - bf_hi(bh.w));
        kacc = __builtin_amdgcn_mfma_f32_32x32x16_bf16(__builtin_bit_cast(bf16x8, w), __builtin_bit_cast(bf16x8, bh), kacc, 0, 0, 0);
        kacc = __builtin_amdgcn_mfma_f32_32x32x16_bf16(__builtin_bit_cast(bf16x8, wl), __builtin_bit_cast(bf16x8, bh), kacc, 0, 0, 0);
        kacc = __builtin_amdgcn_mfma_f32_32x32x16_bf16(__builtin_bit_cast(bf16x8, w), __builtin_bit_cast(bf16x8, bl), kacc, 0, 0, 0); }
      if (rho < 16) {
#pragma unroll
        for (int r = 0; r < 16; ++r) { const int row = (r & 3) + 8 * (r >> 2) + 4 * h; const int e = 2 * mt + (row >> 4) + 1; if (e < 16) KF[(e * 16 + (row & 15)) * 16 + rho] = kacc[r]; } }
    }
    { const int it = tid; const int l = it & 63, sp = (it >> 6) & 1, mtile = it >> 7; const int rho = l & 31, h = l >> 5; float v[8];
#pragma unroll
        for (int j = 0; j < 8; ++j) { const int m = 32 * mtile + 16 * sp + 8 * (j >> 2) + 4 * h + (j & 3), p = m & 63; v[j] = (rho < 16) ? ((m < 64) ? ccL[(rho * 64 + p) * 2] : -ccL[(rho * 64 + p) * 2 + 1]) : 0.f; }
        u32x4 w; w.x = cvt_pk_bf16(v[0], v[1]); w.y = cvt_pk_bf16(v[2], v[3]); w.z = cvt_pk_bf16(v[4], v[5]); w.w = cvt_pk_bf16(v[6], v[7]);
        *(u32x4*)(tab + S5T_C0 + (size_t)it * 16) = w; }
    if (tid < 64) { const int l = tid, rho = l & 31, h = l >> 5; float v[8];
#pragma unroll
        for (int j = 0; j < 8; ++j) v[j] = (rho < 16 && rho == 8 * h + j) ? DL[rho] : 0.f;
        u32x4 w; w.x = cvt_pk_bf16(v[0], v[1]); w.y = cvt_pk_bf16(v[2], v[3]); w.z = cvt_pk_bf16(v[4], v[5]); w.w = cvt_pk_bf16(v[6], v[7]);
        *(u32x4*)(tab + S5T_DF + (size_t)l * 16) = w;
        float* hdr = (float*)(tab + S5T_HDR);
        hdr[l] = pw[(16 * 64 + l) * 2]; hdr[64 + l] = pw[(16 * 64 + l) * 2 + 1]; hdr[128 + l] = pw[(64 + l) * 2]; hdr[192 + l] = pw[(64 + l) * 2 + 1]; }
    __syncthreads();
    for (int it = tid; it < 1024; it += 512) { const int l = it & 63, ti = it >> 6; const int rho = l & 31, dt = rho >> 4, c = rho & 15, h = l >> 5, e = ti - 1 + dt; float v[8];
#pragma unroll
        for (int j = 0; j < 8; ++j) v[j] = (e < 0) ? 0.f : KF[(e * 16 + c) * 16 + 8 * h + j];
        u32x4 w; w.x = cvt_pk_bf16(v[0], v[1]); w.y = cvt_pk_bf16(v[2], v[3]); w.z = cvt_pk_bf16(v[4], v[5]); w.w = cvt_pk_bf16(v[6], v[7]);
        *(u32x4*)(tab + S5T_KT + (size_t)it * 16) = w; }
    __syncthreads();
}

__device__ __forceinline__ void p1_row(const Args& a, int m, int lane) {
    bf16_t* XN = (bf16_t*)(a.ws + WS_XN) + (size_t)m * DM;
    if (m >= MV) {
        const float* src = a.in[I_SHIFT] + (size_t)(m - MV) * DM;
#pragma unroll
        for (int j = 0; j < 8; ++j) { const f32x4 v = *(const f32x4*)(src + 4 * lane + 256 * j); u32x2 w; w.x = cvt_pk_bf16(v[0], v[1]); w.y = cvt_pk_bf16(v[2], v[3]); *(u32x2*)(XN + 4 * lane + 256 * j) = w; }
        return;
    }
    const float* x = (m < MP) ? a.in[I_XP] + (size_t)m * DM : a.in[I_XS] + (size_t)(m - MP) * DM;
    const int mrow = (m < MP) ? (m >> 11) : (NB + m - MP);
    const float* mod = (const float*)(a.ws + WS_MOD) + (size_t)mrow * NMOD;
    const float* g = a.in[I_NORMG];
    f32x4 v[8]; float ss = 0.f;
#pragma unroll
    for (int j = 0; j < 8; ++j) { v[j] = *(const f32x4*)(x + 4 * lane + 256 * j); ss += (v[j][0] * v[j][0] + v[j][1] * v[j][1]) + (v[j][2] * v[j][2] + v[j][3] * v[j][3]); }
    const float rstd = rsqrtf(wave_sum(ss) * (1.0f / DM) + RMS_EPS);
    float* sh_out = nullptr;
    if (m >= MP) sh_out = a.out + OUT_SHIFT_S + (size_t)(m - MP) * DM;
    else if ((m & (SEQ - 1)) == SEQ - 1) sh_out = a.out + OUT_SHIFT_P + (size_t)(m >> 11) * DM;
#pragma unroll
    for (int j = 0; j < 8; ++j) { const int k = 4 * lane + 256 * j; const f32x4 gv = *(const f32x4*)(g + k), sh = *(const f32x4*)(mod + k), sc = *(const f32x4*)(mod + DM + k);
        f32x4 hv;
#pragma unroll
        for (int q = 0; q < 4; ++q) hv[q] = v[j][q] * rstd * gv[q] * (1.0f + sc[q]) + sh[q];
        u32x2 w; w.x = cvt_pk_bf16(hv[0], hv[1]); w.y = cvt_pk_bf16(hv[2], hv[3]); *(u32x2*)(XN + k) = w;
        if (sh_out) *(f32x4*)(sh_out + k) = hv; }
}

constexpr int RW_TB = 32;
constexpr int RW_KK = 0, RW_DR = 2048, RW_DD = 4096, RW_BB = 6144, RW_KP = 8192, RW_VV = 10240, RW_SC = 11264, RW_LW = 11392, RW_LA = 13440, RW_OB = 15488, RW_BVB = 16512, RW_END = 17536;
struct RwTok { float kk, dr, dd, bb, kp, v, br, kr, bonus; };
__device__ __forceinline__ RwTok rw_token(const Args& a, int hj, float r, float k, float v, float lw, float la) {
    RwTok o;
    const float wpre = a.in[I_W0][hj] + lw;
    const float nz = -wpre;
    const float sp = fmaxf(nz, 0.f) + log1pf(__expf(-fabsf(nz)));
    const float w = -sp - 0.5f;
    o.dd = __expf(-__expf(w));
    const float av = sigmoidf_(a.in[I_A0][hj] + la);
    const float kkv = k * a.in[I_KK][hj];
    const float nrm = sqrtf(wave_sum(kkv * kkv));
    o.kk = kkv / fmaxf(nrm, 1e-12f);
    o.kp = k * (1.0f + (av - 1.0f) * a.in[I_KA][hj]);
    o.bb = o.kk * av;
    o.dr = o.dd * r;
    o.v = v;
    o.br = wave_sum(o.bb * r);
    o.kr = wave_sum(o.kp * r);
    o.bonus = wave_sum(r * o.kp * a.in[I_RK][hj]);
    return o;
}
__device__ __forceinline__ void p3_rwkv_prompt(const Args& a, LAS unsigned char* lds, int unit, int tid, int wave, int lane) {
    const int b = unit >> 5, h = (unit >> 1) & 15, half = unit & 1;
    LAS float* L = (LAS float*)lds;
    const bf16_t* P = (const bf16_t*)(a.ws + WS_P);
    bf16_t* ORAW = (bf16_t*)((unsigned char*)a.out + DO_ORAW); bf16_t* BV = (bf16_t*)((unsigned char*)a.out + DO_BV);
    const float* mu = a.in[I_MU];
    const int r31 = lane & 31, hh = lane >> 5;
    bf16x8 bfr[4];
    if (wave < 4) { const float* W2 = (wave >> 1) ? a.in[I_A2] : a.in[I_W2]; const int col = h * 64 + 32 * (wave & 1) + r31;
#pragma unroll
        for (int ks = 0; ks < 4; ++ks) { float w[8];
#pragma unroll
            for (int j = 0; j < 8; ++j) w[j] = W2[(size_t)(16 * ks + 8 * hh + j) * 1024 + col];
            u32x4 t; t.x = cvt_pk_bf16(w[0], w[1]); t.y = cvt_pk_bf16(w[2], w[3]); t.z = cvt_pk_bf16(w[4], w[5]); t.w = cvt_pk_bf16(w[6], w[7]); bfr[ks] = __builtin_bit_cast(bf16x8, t); } }
    const int srow = 4 * wave + (lane >> 4), cq = lane & 15;
    f32x4 S = (f32x4){0.f, 0.f, 0.f, 0.f};
    for (int t0 = 0; t0 < SEQ; t0 += RW_TB) {
        const size_t rowbase = (size_t)b * SEQ + t0;
        if (wave < 4) { const int mat = wave >> 1, nt2 = wave & 1; const size_t row = rowbase + r31; const bool hp = (t0 + r31) > 0;
            f32x16 acc;
#pragma unroll
            for (int r = 0; r < 16; ++r) acc[r] = 0.f;
#pragma unroll
            for (int ks = 0; ks < 4; ++ks) { const int col = PC_WD + mat * 64 + 16 * ks + 8 * hh; float x8[8];
                lerp8(P + row * LDP + col, P + (row - 1) * LDP + col, hp, mu + 3072 + mat * 64 + 16 * ks + 8 * hh, x8);
                if (mat == 0) {
#pragma unroll
                    for (int j = 0; j < 8; ++j) x8[j] = tanhf_(x8[j]); }
                u32x4 t; t.x = cvt_pk_bf16(x8[0], x8[1]); t.y = cvt_pk_bf16(x8[2], x8[3]); t.z = cvt_pk_bf16(x8[4], x8[5]); t.w = cvt_pk_bf16(x8[6], x8[7]);
                acc = __builtin_amdgcn_mfma_f32_32x32x16_bf16(__builtin_bit_cast(bf16x8, t), bfr[ks], acc, 0, 0, 0); }
            LAS float* dst = L + (mat ? RW_LA : RW_LW);
#pragma unroll
            for (int r = 0; r < 16; ++r) { const int tl = (r & 3) + 8 * (r >> 2) + 4 * hh; dst[tl * 64 + 32 * nt2 + r31] = acc[r]; } }
        __syncthreads();
#pragma unroll
        for (int q = 0; q < 4; ++q) { const int tl = wave * 4 + q; const size_t row = rowbase + tl; const bool hp = (t0 + tl) > 0; const int hj = h * 64 + lane;
            const bf16_t* pc = P + row * LDP; const bf16_t* pp = pc - LDP;
            float r = bf2f(pc[PC_R + hj]), k = bf2f(pc[PC_K + hj]), v = bf2f(pc[PC_V + hj]);
            const float pr = hp ? bf2f(pp[PC_R + hj]) : 0.f, pk = hp ? bf2f(pp[PC_K + hj]) : 0.f, pv = hp ? bf2f(pp[PC_V + hj]) : 0.f;
            r += (pr - r) * mu[hj]; k += (pk - k) * mu[1024 + hj]; v += (pv - v) * mu[2048 + hj];
            const RwTok o = rw_token(a, hj, r, k, v, L[RW_LW + tl * 64 + lane], L[RW_LA + tl * 64 + lane]);
            L[RW_KK + tl * 64 + lane] = o.kk; L[RW_DR + tl * 64 + lane] = o.dr; L[RW_DD + tl * 64 + lane] = o.dd; L[RW_BB + tl * 64 + lane] = o.bb; L[RW_KP + tl * 64 + lane] = o.kp;
            if ((lane >> 5) == half) L[RW_VV + tl * 32 + (lane & 31)] = o.v;
            if (lane == 0) { L[RW_SC + tl * 4] = o.br; L[RW_SC + tl * 4 + 1] = o.kr; L[RW_SC + tl * 4 + 2] = o.bonus; } }
        __syncthreads();
#pragma unroll 4
        for (int tl = 0; tl < RW_TB; ++tl) {
            const f32x4 kk4 = *(const LAS f32x4*)(L + RW_KK + tl * 64 + 4 * cq), dr4 = *(const LAS f32x4*)(L + RW_DR + tl * 64 + 4 * cq), d4 = *(const LAS f32x4*)(L + RW_DD + tl * 64 + 4 * cq),
                        b4 = *(const LAS f32x4*)(L + RW_BB + tl * 64 + 4 * cq), k4 = *(const LAS f32x4*)(L + RW_KP + tl * 64 + 4 * cq);
            const float v = L[RW_VV + tl * 32 + srow]; const f32x4 sc = *(const LAS f32x4*)(L + RW_SC + tl * 4);
            float p1 = (S[0] * kk4[0] + S[1] * kk4[1]) + (S[2] * kk4[2] + S[3] * kk4[3]);
            float p2 = (S[0] * dr4[0] + S[1] * dr4[1]) + (S[2] * dr4[2] + S[3] * dr4[3]);
            p1 = row16_sum(p1); p2 = row16_sum(p2);
            const float sa = -p1;
            const float o = p2 + sa * sc[0] + v * sc[1];
#pragma unroll
            for (int j = 0; j < 4; ++j) S[j] = S[j] * d4[j] + sa * b4[j] + v * k4[j];
            if (cq == 0) { L[RW_OB + tl * 32 + srow] = o; L[RW_BVB + tl * 32 + srow] = sc[2] * v; }
        }
        __syncthreads();
        { const int tl = tid >> 4, r2 = 2 * (tid & 15); const size_t off = (rowbase + tl) * 1024 + h * 64 + 32 * half + r2;
          *(unsigned*)(ORAW + off) = cvt_pk_bf16(L[RW_OB + tl * 32 + r2], L[RW_OB + tl * 32 + r2 + 1]);
          *(unsigned*)(BV + off) = cvt_pk_bf16(L[RW_BVB + tl * 32 + r2], L[RW_BVB + tl * 32 + r2 + 1]); }
    }
    *(f32x4*)(a.out + OUT_WKV_P + (((size_t)(b * 16 + h) * 64 + 32 * half + srow) * 64 + 4 * cq)) = S;
    __syncthreads();
}


constexpr int RC_LD = 72, RC_MAT = 64 * RC_LD * 2;
constexpr int RC_QK = 0 * RC_MAT, RC_RT = 1 * RC_MAT, RC_KT = 2 * RC_MAT, RC_BT = 3 * RC_MAT, RC_QKT = 4 * RC_MAT, RC_BHT = 5 * RC_MAT, RC_KHT = 6 * RC_MAT, RC_VT = 7 * RC_MAT,
              RC_AKK = 8 * RC_MAT, RC_ARK = 9 * RC_MAT, RC_ARB = 10 * RC_MAT, RC_TB = 11 * RC_MAT, RC_AKB = 12 * RC_MAT, RC_W1T = 12 * RC_MAT, RC_U1T = 13 * RC_MAT,
              RC_AVT = RC_QK, RC_TF = RC_KT, RC_LWA = RC_AKK, RC_SEG = 14 * RC_MAT;
static_assert(RC_SEG + 2048 <= RING_BYTES, "rwkv chunk lds");
constexpr int RS_ROWB = 656, RS_BASE = 0;
static_assert(RS_BASE + 65 * RS_ROWB <= RC_AKK, "staging must stay inside R0..R7");
#define MFMA32(a, b, c) __builtin_amdgcn_mfma_f32_32x32x16_bf16((a), (b), (c), 0, 0, 0)
#define MFMA16(a, b, c) __builtin_amdgcn_mfma_f32_16x16x32_bf16((a), (b), (c), 0, 0, 0)
__device__ __forceinline__ bf16x8 lds_frag(LAS unsigned char* lds, int mat, int row, int k0) { return *(const LAS bf16x8*)(lds + mat + (row * RC_LD + k0) * 2); }

template <int MAT, int MS, int NT>
__device__ __forceinline__ void rwc_stage1_job(LAS unsigned char* lds, int r31, int hh) {
    constexpr int X = (MAT & 1) ? RC_BT : RC_KT, Y = (MAT & 2) ? RC_RT : RC_QK;
    constexpr bool incl = (MAT & 2) != 0, diag = (MS == NT);
    f32x16 acc;
#pragma unroll
    for (int r = 0; r < 16; ++r) acc[r] = 0.f;
#pragma unroll
    for (int ks = 0; ks < 4; ++ks) acc = MFMA32(lds_frag(lds, X, 32 * MS + r31, 16 * ks + 8 * hh), lds_frag(lds, Y, 32 * NT + r31, 16 * ks + 8 * hh), acc);
    const int t = 32 * NT + r31, d0 = r31 - 4 * hh;
#pragma unroll
    for (int g4 = 0; g4 < 4; ++g4) { const int s0 = 32 * MS + 8 * g4 + 4 * hh; float v[4];
#pragma unroll
        for (int e = 0; e < 4; ++e) v[e] = (!diag || (incl ? (8 * g4 + e <= d0) : (8 * g4 + e < d0))) ? acc[4 * g4 + e] : 0.f;
        if (MAT == 1) *(LAS f32x4*)(lds + RC_AKB + (t * 72 + s0) * 4) = (f32x4){v[0], v[1], v[2], v[3]};
        else { constexpr int dstm = (MAT == 0) ? RC_AKK : ((MAT == 2) ? RC_ARK : RC_ARB); *(LAS u32x2*)(lds + dstm + (t * RC_LD + s0) * 2) = pack4(v[0], v[1], v[2], v[3]); } }
}
__device__ __forceinline__ void p3_rwkv_chunks(const Args& a, LAS unsigned char* lds, int bh, int seg, int tid, int wave, int lane) {
    const int b = bh >> 4, h = bh & 15, r31_ = lane & 31, hh_ = lane >> 5, hj = h * 64 + lane;
    const bf16_t* P = (const bf16_t*)(a.ws + WS_P);
    bf16_t* BV = (bf16_t*)((unsigned char*)a.out + DO_BV);
    const float* mu = a.in[I_MU];
    LAS float* SEG = (LAS float*)(lds + RC_SEG);
    bf16x8 bfr[4];
    { const float* W2 = (wave >> 2) ? a.in[I_A2] : a.in[I_W2]; const int col = h * 64 + 32 * (wave & 1) + r31_;
#pragma unroll
      for (int ks = 0; ks < 4; ++ks) { float w[8];
#pragma unroll
          for (int j = 0; j < 8; ++j) w[j] = W2[(size_t)(16 * ks + 8 * hh_ + j) * 1024 + col];
          u32x4 t; t.x = cvt_pk_bf16(w[0], w[1]); t.y = cvt_pk_bf16(w[2], w[3]); t.z = cvt_pk_bf16(w[4], w[5]); t.w = cvt_pk_bf16(w[6], w[7]); bfr[ks] = __builtin_bit_cast(bf16x8, t); } }
    const int hj2 = h * 64 + 2 * r31_;
    const f32x2 w02 = *(const f32x2*)(a.in[I_W0] + hj2), a02 = *(const f32x2*)(a.in[I_A0] + hj2), kk2 = *(const f32x2*)(a.in[I_KK] + hj2), ka2 = *(const f32x2*)(a.in[I_KA] + hj2), rk2 = *(const f32x2*)(a.in[I_RK] + hj2);
    const f32x2 mur2 = *(const f32x2*)(mu + hj2), muk2 = *(const f32x2*)(mu + 1024 + hj2), muv2 = *(const f32x2*)(mu + 2048 + hj2);
    unsigned goff[6], loff[6]; u32x4 pf[6];
#pragma unroll
    for (int i = 0; i < 6; ++i) { const int idx = tid + 512 * i, row = idx / 40, c = idx - row * 40;
        const int col = (c < 8) ? PC_R + h * 64 + 8 * c : ((c < 16) ? PC_K + h * 64 + 8 * (c - 8) : PC_V + h * 64 + 8 * (c - 16));
        goff[i] = (c < 24) ? (unsigned)(row * LDP + col) * 2u : (0x80000000u | (unsigned)(row * 128 + 8 * (c - 24)) * 2u);   loff[i] = (unsigned)(RS_BASE + row * RS_ROWB + c * 16); }
#define RWC_PREFETCH(chunk_) do { const unsigned char* pb_ = (const unsigned char*)(P + ((size_t)b * SEQ + (size_t)(chunk_) * 64 - 1) * LDP); \
        const unsigned char* xb_ = a.ws + WS_XW + ((size_t)b * SEQ + (size_t)(chunk_) * 64) * 256 - 256; \
        _Pragma("unroll") for (int i = 0; i < 6; ++i) { const bool ok_ = (tid + 512 * i < 2600) && ((chunk_) > 0 || tid + 512 * i >= 40); \
            pf[i] = (u32x4){0u, 0u, 0u, 0u}; if (ok_) pf[i] = (goff[i] & 0x80000000u) ? *(const u32x4*)(xb_ + (goff[i] & 0x7fffffffu)) : *(const u32x4*)(pb_ + goff[i]); } } while (0)
    RWC_PREFETCH(seg * 8);
#pragma unroll 1
    for (int ci = 0; ci < 8; ++ci) {
        const int chunk = seg * 8 + ci; const size_t rowbase = (size_t)b * SEQ + chunk * 64;
#pragma unroll
        for (int i = 0; i < 6; ++i) if (tid + 512 * i < 2600) *(LAS u32x4*)(lds + loff[i]) = pf[i];
        if (ci + 1 < 8) RWC_PREFETCH(chunk + 1);
        __syncthreads();
        int r31 = r31_, hh = hh_; asm volatile("" : "+v"(r31), "+v"(hh));
        unsigned char* rwi = a.ws + WS_RWI + (size_t)((bh * 32) + chunk) * RWI_BYTES;
        { const int mat = wave >> 2, mtile = (wave >> 1) & 1, nt2 = wave & 1; const int tl = 32 * mtile + r31;
          f32x16 acc;
#pragma unroll
          for (int r = 0; r < 16; ++r) acc[r] = 0.f;
#pragma unroll
          for (int ks = 0; ks < 4; ++ks) acc = MFMA32(*(const LAS bf16x8*)(lds + RS_BASE + (tl + 1) * RS_ROWB + (24 + mat * 8 + 2 * ks + hh) * 16), bfr[ks], acc);
          LAS float* dst = (LAS float*)(lds + RC_LWA) + mat * 64 * 68;
#pragma unroll
          for (int r = 0; r < 16; ++r) { const int t2 = 32 * mtile + (r & 3) + 8 * (r >> 2) + 4 * hh; dst[t2 * 68 + 32 * nt2 + r31] = acc[r]; } }
        __syncthreads();
        f32x2 r4[4], kp4[4], kk4v[4], bb4[4], v4[4], cs4[4];
        LAS float* SEG2 = (LAS float*)(lds + RC_AKB);
        const int half = hh, j2 = 2 * r31, tq0 = 8 * wave + 4 * half;
        { const LAS float* LW = (const LAS float*)(lds + RC_LWA); const LAS float* LA = LW + 64 * 68;
#pragma unroll
          for (int q = 0; q < 4; ++q) { const int tl = tq0 + q; const size_t row = rowbase + tl;
              const LAS unsigned char* pc = lds + RS_BASE + (tl + 1) * RS_ROWB + j2 * 2; const LAS unsigned char* pp = lds + RS_BASE + tl * RS_ROWB + j2 * 2;
              const unsigned cr = *(const LAS unsigned*)pc, ck = *(const LAS unsigned*)(pc + 128), cv = *(const LAS unsigned*)(pc + 256);
              const unsigned qr = *(const LAS unsigned*)pp, qk_ = *(const LAS unsigned*)(pp + 128), qv = *(const LAS unsigned*)(pp + 256);
              f32x2 r = {bf_lo(cr), bf_hi(cr)}, k = {bf_lo(ck), bf_hi(ck)}, v = {bf_lo(cv), bf_hi(cv)};
              const f32x2 pr = {bf_lo(qr), bf_hi(qr)}, pk = {bf_lo(qk_), bf_hi(qk_)}, pv = {bf_lo(qv), bf_hi(qv)};
              r += (pr - r) * mur2; k += (pk - k) * muk2; v += (pv - v) * muv2;
              const f32x2 lw = *(const LAS f32x2*)(LW + tl * 68 + j2), la = *(const LAS f32x2*)(LA + tl * 68 + j2);
              const f32x2 xw = w02 + lw, xa = a02 + la;
              const f32x2 ld = {-0.6065306597126334f * sigmoidf_(xw[0]), -0.6065306597126334f * sigmoidf_(xw[1])};
              const f32x2 av = {sigmoidf_(xa[0]), sigmoidf_(xa[1])};
              const f32x2 kkv = k * kk2;
              const float rn = fminf(__builtin_amdgcn_rsqf(half_sum32(kkv[0] * kkv[0] + kkv[1] * kkv[1], half != 0)), 1e12f);
              kk4v[q] = kkv * rn; kp4[q] = k * (1.0f + (av - 1.0f) * ka2); bb4[q] = kk4v[q] * av; r4[q] = r; v4[q] = v;
              const f32x2 rk_ = r * kp4[q] * rk2;
              const float bonus = half_sum32(rk_[0] + rk_[1], half != 0);
              *(unsigned*)(BV + row * 1024 + h * 64 + j2) = cvt_pk_bf16(bonus * v[0], bonus * v[1]);
              cs4[q] = (q == 0) ? ld : cs4[q > 0 ? q - 1 : 0] + ld; }
          *(LAS f32x2*)(SEG2 + (2 * wave + half) * 64 + j2) = cs4[3]; }
        __syncthreads();
        { f32x2 off = {0.f, 0.f}, cL = {0.f, 0.f};
#pragma unroll
          for (int sg = 0; sg < 16; ++sg) { const f32x2 x = *(const LAS f32x2*)(SEG2 + sg * 64 + j2); cL += x; if (sg < 2 * wave + half) off += x; }
          const f32x2 eLtot = {__expf(cL[0]), __expf(cL[1])};
          if (wave == 0 && half == 0) *(f32x2*)(rwi + RWI_LAM + j2 * 4) = eLtot;
          f32x2 ecprev = {__expf(off[0]), __expf(off[1])};
          f32x2 qkT[4], bhT[4], khT[4];
#pragma unroll
          for (int q = 0; q < 4; ++q) { const int tl = tq0 + q; const f32x2 c = off + cs4[q];
              const f32x2 ec = {__expf(c[0]), __expf(c[1])}, ecp = ecprev, enc = {rcpf_(ec[0]), rcpf_(ec[1])}, eL = eLtot * enc; ecprev = ec;
              const f32x2 qk = kk4v[q] * ecp, rt = r4[q] * ec, kt = kp4[q] * enc, bt = bb4[q] * enc;
              *(LAS unsigned*)(lds + RC_QK + (tl * RC_LD + j2) * 2) = cvt_pk_bf16(qk[0], qk[1]); *(LAS unsigned*)(lds + RC_RT + (tl * RC_LD + j2) * 2) = cvt_pk_bf16(rt[0], rt[1]);
              *(LAS unsigned*)(lds + RC_KT + (tl * RC_LD + j2) * 2) = cvt_pk_bf16(kt[0], kt[1]); *(LAS unsigned*)(lds + RC_BT + (tl * RC_LD + j2) * 2) = cvt_pk_bf16(bt[0], bt[1]);
              qkT[q] = qk; bhT[q] = bb4[q] * eL; khT[q] = kp4[q] * eL; }
#pragma unroll
          for (int ch = 0; ch < 2; ++ch) { const int ro = ((j2 + ch) * RC_LD + tq0) * 2;
              *(LAS u32x2*)(lds + RC_QKT + ro) = pack4(qkT[0][ch], qkT[1][ch], qkT[2][ch], qkT[3][ch]); *(LAS u32x2*)(lds + RC_BHT + ro) = pack4(bhT[0][ch], bhT[1][ch], bhT[2][ch], bhT[3][ch]);
              *(LAS u32x2*)(lds + RC_KHT + ro) = pack4(khT[0][ch], khT[1][ch], khT[2][ch], khT[3][ch]); *(LAS u32x2*)(lds + RC_VT + ro) = pack4(v4[0][ch], v4[1][ch], v4[2][ch], v4[3][ch]); } }
        __syncthreads();
        switch (wave) {
            case 0: rwc_stage1_job<0, 0, 0>(lds, r31, hh); rwc_stage1_job<2, 1, 1>(lds, r31, hh); break;
            case 1: rwc_stage1_job<0, 0, 1>(lds, r31, hh); rwc_stage1_job<3, 0, 0>(lds, r31, hh); break;
            case 2: rwc_stage1_job<0, 1, 1>(lds, r31, hh); rwc_stage1_job<3, 0, 1>(lds, r31, hh); break;
            case 3: rwc_stage1_job<1, 0, 0>(lds, r31, hh); rwc_stage1_job<3, 1, 1>(lds, r31, hh); break;
            case 4: rwc_stage1_job<1, 0, 1>(lds, r31, hh); break;
            case 5: rwc_stage1_job<1, 1, 1>(lds, r31, hh); break;
            case 6: rwc_stage1_job<2, 0, 0>(lds, r31, hh); break;
            default: rwc_stage1_job<2, 0, 1>(lds, r31, hh); break;
        }
        __syncthreads();
        LAS float* TF = (LAS float*)(lds + RC_TF); const LAS float* AKB = (const LAS float*)(lds + RC_AKB); LAS float* YS = SEG;
        if (wave == 0) {
            const int I = lane >> 4, jj = lane & 15; float x[16];
#pragma unroll
            for (int r = 0; r < 16; ++r) { float sacc = (r == jj) ? 1.f : 0.f;
#pragma unroll
                for (int q = 0; q < r; ++q) sacc -= AKB[(16 * I + r) * 72 + 16 * I + q] * x[q];
                x[r] = sacc; TF[(16 * I + r) * 72 + 16 * I + jj] = sacc; }
        } else if (wave < 4) {
            const int t2 = tid - 64;
            for (int e = t2; e < 512; e += 192) { const int blk = e >> 8, rr = (e >> 4) & 15, cc = e & 15; TF[(32 * blk + rr) * 72 + 32 * blk + 16 + cc] = 0.f; }
        } else {
            const int mt = (wave >> 1) & 1, nt2 = wave & 1; f32x16 acc;
#pragma unroll
            for (int r = 0; r < 16; ++r) acc[r] = 0.f;
#pragma unroll
            for (int ks = 0; ks < 4; ++ks) if (ks < 2 || mt == 1) acc = MFMA32(lds_frag(lds, RC_AKK, 32 * mt + r31, 16 * ks + 8 * hh), lds_frag(lds, RC_VT, 32 * nt2 + r31, 16 * ks + 8 * hh), acc);
#pragma unroll
            for (int g4 = 0; g4 < 4; ++g4) *(LAS u32x2*)(lds + RC_AVT + ((32 * nt2 + r31) * RC_LD + 32 * mt + 8 * g4 + 4 * hh) * 2) = pack4(acc[4 * g4], acc[4 * g4 + 1], acc[4 * g4 + 2], acc[4 * g4 + 3]);
        }
        __syncthreads();
        { const int pr = tid >> 8, i = (tid >> 4) & 15, jj = tid & 15, ba = 2 * pr, bb = 2 * pr + 1;
          float y = 0.f;
#pragma unroll
          for (int q = 0; q < 16; ++q) y += AKB[(16 * bb + i) * 72 + 16 * ba + q] * TF[(16 * ba + q) * 72 + 16 * ba + jj];
          YS[tid] = y; }
        __syncthreads();
        { const int pr = tid >> 8, i = (tid >> 4) & 15, jj = tid & 15, ba = 2 * pr, bb = 2 * pr + 1; float tv = 0.f;
#pragma unroll
          for (int q = 0; q < 16; ++q) tv -= TF[(16 * bb + i) * 72 + 16 * bb + q] * YS[pr * 256 + q * 16 + jj];
          TF[(16 * bb + i) * 72 + 16 * ba + jj] = tv; }
        __syncthreads();
        { const int i = tid >> 4, j0 = (tid & 15) * 2; float z0 = 0.f, z1 = 0.f;
#pragma unroll 8
          for (int q = 0; q < 32; ++q) { const float av = AKB[(32 + i) * 72 + q]; z0 += av * TF[q * 72 + j0]; z1 += av * TF[q * 72 + j0 + 1]; }
          TF[i * 72 + 32 + j0] = z0; TF[i * 72 + 32 + j0 + 1] = z1; }
        __syncthreads();
        { const int i = tid >> 4, j0 = (tid & 15) * 2; float t0 = 0.f, t1 = 0.f;
#pragma unroll 8
          for (int q = 0; q < 32; ++q) { const float tb = TF[(32 + i) * 72 + 32 + q]; t0 -= tb * TF[q * 72 + 32 + j0]; t1 -= tb * TF[q * 72 + 32 + j0 + 1]; }
          TF[(32 + i) * 72 + j0] = t0; TF[(32 + i) * 72 + j0 + 1] = t1; }
        __syncthreads();
        { const int which = wave >> 2, mt = (wave >> 1) & 1, nt2 = wave & 1; const int Bm = which ? RC_AVT : RC_QKT, Dm = which ? RC_U1T : RC_W1T; f32x16 acc;
#pragma unroll
          for (int r = 0; r < 16; ++r) acc[r] = 0.f;
#pragma unroll
          for (int ks = 0; ks < 4; ++ks) if (ks < 2 || mt == 1) { const LAS float* tp = TF + (32 * mt + r31) * 72 + 16 * ks + 8 * hh; const f32x4 x0 = *(const LAS f32x4*)tp, x1 = *(const LAS f32x4*)(tp + 4);
              u32x4 w; w.x = cvt_pk_bf16(x0[0], x0[1]); w.y = cvt_pk_bf16(x0[2], x0[3]); w.z = cvt_pk_bf16(x1[0], x1[1]); w.w = cvt_pk_bf16(x1[2], x1[3]);
              acc = MFMA32(__builtin_bit_cast(bf16x8, w), lds_frag(lds, Bm, 32 * nt2 + r31, 16 * ks + 8 * hh), acc); }
#pragma unroll
          for (int g4 = 0; g4 < 4; ++g4) *(LAS u32x2*)(lds + Dm + ((32 * nt2 + r31) * RC_LD + 32 * mt + 8 * g4 + 4 * hh) * 2) = pack4(acc[4 * g4], acc[4 * g4 + 1], acc[4 * g4 + 2], acc[4 * g4 + 3]); }
        __syncthreads();
        { const int kind = wave >> 2, mt = (wave >> 1) & 1, nt2 = wave & 1; const int cidx = 32 * nt2 + r31;
          f32x16 acc;
#pragma unroll
          for (int r = 0; r < 16; ++r) acc[r] = 0.f;
          if (kind == 0) {
#pragma unroll
              for (int ks = 0; ks < 4; ++ks) acc = MFMA32(lds_frag(lds, RC_W1T, 32 * mt + r31, 16 * ks + 8 * hh), lds_frag(lds, RC_BHT, cidx, 16 * ks + 8 * hh), acc);
#pragma unroll
              for (int g4 = 0; g4 < 4; ++g4) { const int jo = 8 * g4 + 4 * hh, half = jo >> 4, q2 = (jo & 15) >> 2; const int blk = (cidx >> 4) * 2 + mt, lane2 = (cidx & 15) + 16 * q2;
                  *(u32x2*)(rwi + RWI_GF + (blk * 64 + lane2) * 16 + half * 8) = pack4(-acc[4 * g4], -acc[4 * g4 + 1], -acc[4 * g4 + 2], -acc[4 * g4 + 3]); }
          } else {
#pragma unroll
              for (int ks = 0; ks < 4; ++ks) if (ks < 2 || nt2 == 1) acc = MFMA32(lds_frag(lds, RC_W1T, 32 * mt + r31, 16 * ks + 8 * hh), lds_frag(lds, RC_ARB, cidx, 16 * ks + 8 * hh), acc);
#pragma unroll
              for (int g4 = 0; g4 < 4; ++g4) { const int jo = 8 * g4 + 4 * hh, half = jo >> 4, q2 = (jo & 15) >> 2; const int blk = (cidx >> 4) * 2 + mt, lane2 = (cidx & 15) + 16 * q2;
                  const u32x2 rt = *(const LAS u32x2*)(lds + RC_RT + (cidx * RC_LD + 32 * mt + jo) * 2);
                  *(u32x2*)(rwi + RWI_W2F + (blk * 64 + lane2) * 16 + half * 8) = pack4(bf_lo(rt.x) - acc[4 * g4], bf_hi(rt.x) - acc[4 * g4 + 1], bf_lo(rt.y) - acc[4 * g4 + 2], bf_hi(rt.y) - acc[4 * g4 + 3]); }
          }
          f32x16 ac1, ac2;
#pragma unroll
          for (int r = 0; r < 16; ++r) { ac1[r] = 0.f; ac2[r] = 0.f; }
          if (kind == 0) {
#pragma unroll
              for (int ks = 0; ks < 4; ++ks) { ac1 = MFMA32(lds_frag(lds, RC_KHT, 32 * mt + r31, 16 * ks + 8 * hh), lds_frag(lds, RC_VT, cidx, 16 * ks + 8 * hh), ac1);
                                               ac2 = MFMA32(lds_frag(lds, RC_BHT, 32 * mt + r31, 16 * ks + 8 * hh), lds_frag(lds, RC_U1T, cidx, 16 * ks + 8 * hh), ac2); }
#pragma unroll
              for (int g4 = 0; g4 < 4; ++g4) { const int ro = 32 * mt + 8 * g4 + 4 * hh, mt2 = ro >> 4, q2 = (ro & 15) >> 2, cb = cidx >> 4, lane2 = (cidx & 15) + 16 * q2;
                  *(f32x4*)(rwi + RWI_H1F + ((cb * 4 + mt2) * 64 + lane2) * 16) = (f32x4){ac1[4 * g4] - ac2[4 * g4], ac1[4 * g4 + 1] - ac2[4 * g4 + 1], ac1[4 * g4 + 2] - ac2[4 * g4 + 2], ac1[4 * g4 + 3] - ac2[4 * g4 + 3]}; }
          } else {
#pragma unroll
              for (int ks = 0; ks < 4; ++ks) if (ks < 2 || nt2 == 1) { ac1 = MFMA32(lds_frag(lds, RC_VT, 32 * mt + r31, 16 * ks + 8 * hh), lds_frag(lds, RC_ARK, cidx, 16 * ks + 8 * hh), ac1);
                                                                        ac2 = MFMA32(lds_frag(lds, RC_U1T, 32 * mt + r31, 16 * ks + 8 * hh), lds_frag(lds, RC_ARB, cidx, 16 * ks + 8 * hh), ac2); }
#pragma unroll
              for (int g4 = 0; g4 < 4; ++g4) { const int ro = 32 * mt + 8 * g4 + 4 * hh, cb = ro >> 4, q2 = (ro & 15) >> 2, nt3 = cidx >> 4, lane2 = (cidx & 15) + 16 * q2;
                  *(f32x4*)(rwi + RWI_O1F + ((cb * 4 + nt3) * 64 + lane2) * 16) = (f32x4){ac1[4 * g4] - ac2[4 * g4], ac1[4 * g4 + 1] - ac2[4 * g4 + 1], ac1[4 * g4 + 2] - ac2[4 * g4 + 2], ac1[4 * g4 + 3] - ac2[4 * g4 + 3]}; }
          } }
        __syncthreads();
    }
}

__device__ __forceinline__ void p3_rwkv_seq(const Args& a, int unit, int lane) {
    const int bh = unit >> 2, cb = unit & 3, l15 = lane & 15, q = lane >> 4;
    f32x4 hacc[4];
#pragma unroll
    for (int m = 0; m < 4; ++m) hacc[m] = (f32x4){0.f, 0.f, 0.f, 0.f};
    const unsigned char* base = a.ws + WS_RWI + (size_t)(bh * 32) * RWI_BYTES;
    unsigned char* hbo = a.ws + WS_HB + (size_t)unit * 32 * 2048;
    bf16x8 gfA[8], gfB[8]; f32x4 h1A[4], h1B[4], lamA[4], lamB[4];
#define RW2_LOADG(gf, h1, lam, src) do { _Pragma("unroll") for (int k2 = 0; k2 < 8; ++k2) gf[k2] = *(const bf16x8*)((src) + RWI_GF + (k2 * 64 + lane) * 16); \
        _Pragma("unroll") for (int m = 0; m < 4; ++m) { h1[m] = *(const f32x4*)((src) + RWI_H1F + ((cb * 4 + m) * 64 + lane) * 16); lam[m] = *(const f32x4*)((src) + RWI_LAM + (16 * m + 4 * q) * 4); } } while (0)
#define RW2_STEP(c_, gf, h1, lam) do { const int c = (c_); \
        bf16x8 hb[2]; \
        _Pragma("unroll") for (int ks = 0; ks < 2; ++ks) { u32x4 t; t.x = cvt_pk_bf16(hacc[2 * ks][0], hacc[2 * ks][1]); t.y = cvt_pk_bf16(hacc[2 * ks][2], hacc[2 * ks][3]); \
            t.z = cvt_pk_bf16(hacc[2 * ks + 1][0], hacc[2 * ks + 1][1]); t.w = cvt_pk_bf16(hacc[2 * ks + 1][2], hacc[2 * ks + 1][3]); hb[ks] = __builtin_bit_cast(bf16x8, t); \
            *(bf16x8*)(hbo + (size_t)c * 2048 + (ks * 64 + lane) * 16) = hb[ks]; } \
        _Pragma("unroll") for (int m = 0; m < 4; ++m) { f32x4 nacc = h1[m] + lam[m] * hacc[m]; \
            _Pragma("unroll") for (int ks = 0; ks < 2; ++ks) nacc = MFMA16(gf[m * 2 + ks], hb[ks], nacc); hacc[m] = nacc; } \
        if (c + 2 < 32) RW2_LOADG(gf, h1, lam, base + (size_t)(c + 2) * RWI_BYTES); } while (0)
    RW2_LOADG(gfA, h1A, lamA, base); RW2_LOADG(gfB, h1B, lamB, base + RWI_BYTES);
#pragma unroll 1
    for (int c2 = 0; c2 < 32; c2 += 2) { RW2_STEP(c2, gfA, h1A, lamA); RW2_STEP(c2 + 1, gfB, h1B, lamB); }
#undef RW2_STEP
#undef RW2_LOADG
#pragma unroll
    for (int m = 0; m < 4; ++m) *(f32x4*)(a.out + OUT_WKV_P + (((size_t)bh * 64 + 16 * cb + l15) * 64 + 16 * m + 4 * q)) = hacc[m];
}
__device__ __forceinline__ void p5_rwkv_out(const Args& a, int item, int lane) {
    const int bh = item >> 5, c = item & 31, b = bh >> 4, h = bh & 15, l15 = lane & 15, q = lane >> 4;
    const unsigned char* cur = a.ws + WS_RWI + (size_t)item * RWI_BYTES;
    const bf16_t* BV = (const bf16_t*)((const unsigned char*)a.out + DO_BV);
    const bf16_t* P = (const bf16_t*)(a.ws + WS_P); bf16_t* A2 = (bf16_t*)(a.ws + WS_XN);
    bf16x8 hb[4][2], w2f[8];
#pragma unroll
    for (int cb = 0; cb < 4; ++cb)
#pragma unroll
        for (int ks = 0; ks < 2; ++ks) hb[cb][ks] = *(const bf16x8*)(a.ws + WS_HB + ((size_t)(bh * 4 + cb) * 32 + c) * 2048 + (ks * 64 + lane) * 16);
#pragma unroll
    for (int k2 = 0; k2 < 8; ++k2) w2f[k2] = *(const bf16x8*)(cur + RWI_W2F + (k2 * 64 + lane) * 16);
    f32x4 gw[4], gb[4];
#pragma unroll
    for (int cb = 0; cb < 4; ++cb) { gw[cb] = *(const f32x4*)(a.in[I_GNW] + h * 64 + 16 * cb + 4 * q); gb[cb] = *(const f32x4*)(a.in[I_GNB] + h * 64 + 16 * cb + 4 * q); }
#pragma unroll
    for (int n = 0; n < 4; ++n) {
        const size_t row = (size_t)b * SEQ + c * 64 + 16 * n + l15;
        f32x4 o[4]; u32x2 bvw[4], zw[4];
#pragma unroll
        for (int cb = 0; cb < 4; ++cb) { o[cb] = *(const f32x4*)(cur + RWI_O1F + ((cb * 4 + n) * 64 + lane) * 16);
            bvw[cb] = *(const u32x2*)(BV + row * 1024 + h * 64 + 16 * cb + 4 * q); zw[cb] = *(const u32x2*)(P + row * LDP + PC_ZR + h * 64 + 16 * cb + 4 * q); }
#pragma unroll
        for (int cb = 0; cb < 4; ++cb)
#pragma unroll
            for (int ks = 0; ks < 2; ++ks) o[cb] = MFMA16(hb[cb][ks], w2f[n * 2 + ks], o[cb]);
        float sm = 0.f;
#pragma unroll
        for (int cb = 0; cb < 4; ++cb) sm += (o[cb][0] + o[cb][1]) + (o[cb][2] + o[cb][3]);
        sm += __shfl_xor(sm, 16); sm += __shfl_xor(sm, 32);
        const float mean = sm * (1.0f / 64.0f); float sq = 0.f;
#pragma unroll
        for (int cb = 0; cb < 4; ++cb) { o[cb] = o[cb] - mean; sq += (o[cb][0] * o[cb][0] + o[cb][1] * o[cb][1]) + (o[cb][2] * o[cb][2] + o[cb][3] * o[cb][3]); }
        sq += __shfl_xor(sq, 16); sq += __shfl_xor(sq, 32);
        const float rstd = rsqrtf(sq * (1.0f / 64.0f) + GN_EPS);
#pragma unroll
        for (int cb = 0; cb < 4; ++cb) {
            const float r0 = (o[cb][0] * rstd * gw[cb][0] + gb[cb][0] + bf_lo(bvw[cb].x)) * bf_lo(zw[cb].x), r1 = (o[cb][1] * rstd * gw[cb][1] + gb[cb][1] + bf_hi(bvw[cb].x)) * bf_hi(zw[cb].x);
            const float r2 = (o[cb][2] * rstd * gw[cb][2] + gb[cb][2] + bf_lo(bvw[cb].y)) * bf_lo(zw[cb].y), r3 = (o[cb][3] * rstd * gw[cb][3] + gb[cb][3] + bf_hi(bvw[cb].y)) * bf_hi(zw[cb].y);
            *(u32x2*)(A2 + row * 2048 + 1024 + h * 64 + 16 * cb + 4 * q) = pack4(r0, r1, r2, r3); }
    }
}

__device__ __forceinline__ void p3_rwkv_sample(const Args& a, LAS unsigned char* lds, int bs, int h, int wave, int lane) {
    LAS float* Lw = (LAS float*)lds + wave * 768;
    const bf16_t* P = (const bf16_t*)(a.ws + WS_P);
    const bf16_t* pc = P + (size_t)(MP + bs) * LDP; const bf16_t* pp = P + (size_t)(MV + bs) * LDP;
    bf16_t* A2 = (bf16_t*)(a.ws + WS_XN);
    const float* mu = a.in[I_MU];
    const int hj = h * 64 + lane, rg = lane >> 4, cq = lane & 15;
    const size_t sbase = ((size_t)(bs * 16 + h) * 64) * 64;
    const float* S0 = a.in[I_WKV] + sbase; float* S1 = a.out + OUT_WKV_S + sbase;
    f32x4 S[16];
#pragma unroll
    for (int it = 0; it < 16; ++it) S[it] = *(const f32x4*)(S0 + (size_t)(4 * it + rg) * 64 + 4 * cq);
    { float wd = bf2f(pc[PC_WD + lane]), ad = bf2f(pc[PC_AD + lane]); wd += (bf2f(pp[PC_WD + lane]) - wd) * mu[3072 + lane]; ad += (bf2f(pp[PC_AD + lane]) - ad) * mu[3136 + lane];
      Lw[lane] = tanhf_(wd); Lw[64 + lane] = ad; }
    LDS_WAIT();
    float lw = 0.f, la = 0.f;
#pragma unroll 16
    for (int m = 0; m < 64; ++m) { lw += Lw[m] * a.in[I_W2][(size_t)m * 1024 + hj]; la += Lw[64 + m] * a.in[I_A2][(size_t)m * 1024 + hj]; }
    float r = bf2f(pc[PC_R + hj]), k = bf2f(pc[PC_K + hj]), v = bf2f(pc[PC_V + hj]);
    r += (bf2f(pp[PC_R + hj]) - r) * mu[hj]; k += (bf2f(pp[PC_K + hj]) - k) * mu[1024 + hj]; v += (bf2f(pp[PC_V + hj]) - v) * mu[2048 + hj];
    const RwTok o = rw_token(a, hj, r, k, v, lw, la);
    Lw[128 + lane] = o.kk; Lw[192 + lane] = o.dr; Lw[256 + lane] = o.dd; Lw[320 + lane] = o.bb; Lw[384 + lane] = o.kp; Lw[448 + lane] = o.v;
    LDS_WAIT();
    const f32x4 kk4 = *(const LAS f32x4*)(Lw + 128 + 4 * cq), dr4 = *(const LAS f32x4*)(Lw + 192 + 4 * cq), d4 = *(const LAS f32x4*)(Lw + 256 + 4 * cq), b4 = *(const LAS f32x4*)(Lw + 320 + 4 * cq), k4 = *(const LAS f32x4*)(Lw + 384 + 4 * cq);
#pragma unroll
    for (int it = 0; it < 16; ++it) { const int i = 4 * it + rg; const float vi = Lw[448 + i];
        float p1 = (S[it][0] * kk4[0] + S[it][1] * kk4[1]) + (S[it][2] * kk4[2] + S[it][3] * kk4[3]);
        float p2 = (S[it][0] * dr4[0] + S[it][1] * dr4[1]) + (S[it][2] * dr4[2] + S[it][3] * dr4[3]);
        p1 = row16_sum(p1); p2 = row16_sum(p2);
        const float sa = -p1, ov = p2 + sa * o.br + vi * o.kr;
        f32x4 Sn;
#pragma unroll
        for (int j = 0; j < 4; ++j) Sn[j] = S[it][j] * d4[j] + sa * b4[j] + vi * k4[j];
        *(f32x4*)(S1 + (size_t)i * 64 + 4 * cq) = Sn;
        if (cq == 0) Lw[512 + i] = ov; }
    LDS_WAIT();
    const float ov = Lw[512 + lane];
    const float mean = wave_sum_dpp(ov) * (1.0f / 64.0f); const float dv = ov - mean; const float var = wave_sum_dpp(dv * dv) * (1.0f / 64.0f);
    float on = dv * rsqrtf(var + GN_EPS) * a.in[I_GNW][hj] + a.in[I_GNB][hj] + o.bonus * o.v;
    on *= bf2f(pc[PC_ZR + hj]);
    A2[(size_t)(MP + bs) * 2048 + 1024 + hj] = f2bf(on);
    LDS_WAIT();
}

constexpr int S5_ELD = 132, S5_XLD = 136;
constexpr int S5_E_OFF = 0, S5_X_OFF = 128 * S5_ELD * 4;
__device__ __forceinline__ bf16x8 ldfrag(const unsigned char* base, int block, int lane) { return *(const bf16x8*)(base + (size_t)block * 1024 + lane * 16); }
__device__ __forceinline__ void p3_s5_prompt(const Args& a, LAS unsigned char* lds, int unit, int tid, int wave, int lane) {
    const int b = unit >> 6, g = unit & 63;
    const unsigned char* tab = (const unsigned char*)a.out + DO_S5TAB + (size_t)g * S5T_BYTES;
    const bf16_t* P = (const bf16_t*)(a.ws + WS_P);
    bf16_t* Yg = (bf16_t*)(a.ws + WS_YG);
    LAS float* EL = (LAS float*)(lds + S5_E_OFF); LAS bf16_t* XL = (LAS bf16_t*)(lds + S5_X_OFF);
    const int nt = wave & 3, hm = wave >> 2, r31 = lane & 31, hh = lane >> 5;
    const int n = 32 * nt + r31;
    { u32x4 tv[10];
#pragma unroll
      for (int i = 0; i < 10; ++i) tv[i] = *(const u32x4*)(tab + S5T_ME + (size_t)(tid + 512 * i) * 16);
#pragma unroll
      for (int i = 0; i < 10; ++i) *(LAS u32x4*)(lds + (tid + 512 * i) * 16) = tv[i]; }
    const bf16_t* ubase = (const bf16_t*)(a.ws + WS_U2) + (((size_t)b * 64 + g) * SEQ + 16 * n) * 16 + 8 * hh;
    bf16x8 bu[16];
#pragma unroll
    for (int s2 = 0; s2 < 16; ++s2) bu[s2] = *(const bf16x8*)(ubase + (size_t)s2 * 16);
    f32x16 accY[4], accE[2];
#pragma unroll
    for (int q = 0; q < 4; ++q)
#pragma unroll
        for (int r = 0; r < 16; ++r) accY[q][r] = 0.f;
#pragma unroll
    for (int q = 0; q < 2; ++q)
#pragma unroll
        for (int r = 0; r < 16; ++r) accE[q][r] = 0.f;
    const int mts[4] = {hm ? 1 : 0, hm ? 2 : 3, hm ? 5 : 4, hm ? 6 : 7};
    __syncthreads();
#pragma unroll
    for (int s2 = 0; s2 < 16; ++s2) {
#pragma unroll
        for (int e = 0; e < 2; ++e) accE[e] = __builtin_amdgcn_mfma_f32_32x32x16_bf16(*(const LAS bf16x8*)(lds + S5T_ME + (((2 * hm + e) * 16 + s2) * 64 + lane) * 16), bu[s2], accE[e], 0, 0, 0);
#pragma unroll
        for (int q = 0; q < 4; ++q) { const int mt = mts[q]; if (s2 <= 2 * mt + 1) accY[q] = __builtin_amdgcn_mfma_f32_32x32x16_bf16(*(const LAS bf16x8*)(lds + S5T_KT + ((2 * mt - s2 + 1) * 64 + lane) * 16), bu[s2], accY[q], 0, 0, 0); }
    }
    __syncthreads();
#pragma unroll
    for (int e = 0; e < 2; ++e)
#pragma unroll
        for (int q4 = 0; q4 < 4; ++q4) { f32x4 v; v[0] = accE[e][4 * q4]; v[1] = accE[e][4 * q4 + 1]; v[2] = accE[e][4 * q4 + 2]; v[3] = accE[e][4 * q4 + 3];
            *(LAS f32x4*)(EL + n * S5_ELD + 32 * (2 * hm + e) + 8 * q4 + 4 * hh) = v; }
    __syncthreads();
    if (wave == 0) { const float* hdr = (const float*)(tab + S5T_HDR); const float ar = hdr[lane], ai = hdr[64 + lane]; float xr = 0.f, xi = 0.f;
#pragma unroll 1
        for (int c0 = 0; c0 < 128; c0 += 16) { float er[16], ei[16];
#pragma unroll
            for (int j = 0; j < 16; ++j) { er[j] = EL[(c0 + j) * S5_ELD + lane]; ei[j] = EL[(c0 + j) * S5_ELD + 64 + lane]; }
#pragma unroll
            for (int j = 0; j < 16; ++j) { XL[(c0 + j) * S5_XLD + lane] = f2bf(xr); XL[(c0 + j) * S5_XLD + 64 + lane] = f2bf(xi);
                const float nr = ar * xr - ai * xi + er[j], ni = ar * xi + ai * xr + ei[j]; xr = nr; xi = ni; } }
        a.out[OUT_S5RE_P + (size_t)(b * 64 + g) * 64 + lane] = xr; a.out[OUT_S5IM_P + (size_t)(b * 64 + g) * 64 + lane] = xi; }
    __syncthreads();
#pragma unroll
    for (int ks = 0; ks < 8; ++ks) { const bf16x8 bx = *(const LAS bf16x8*)(XL + n * S5_XLD + 16 * ks + 8 * hh);
#pragma unroll
        for (int q = 0; q < 4; ++q) accY[q] = __builtin_amdgcn_mfma_f32_32x32x16_bf16(ldfrag(tab + S5T_CA, mts[q] * 8 + ks, lane), bx, accY[q], 0, 0, 0); }
#pragma unroll
    for (int q = 0; q < 4; ++q) { const int mt = mts[q];
#pragma unroll
        for (int q4 = 0; q4 < 4; ++q4) { const int dt = q4 >> 1, c0 = 8 * (q4 & 1) + 4 * hh; const size_t row = (size_t)b * SEQ + 16 * n + 2 * mt + dt;
            u32x2 w; w.x = cvt_pk_bf16(geluf_(accY[q][4 * q4]), geluf_(accY[q][4 * q4 + 1])); w.y = cvt_pk_bf16(geluf_(accY[q][4 * q4 + 2]), geluf_(accY[q][4 * q4 + 3]));
            *(u32x2*)(Yg + row * 1024 + g * 16 + c0) = w; } }
    __syncthreads();
}
__device__ __forceinline__ void p3_s5_sample(const Args& a, int g, int wave, int lane) {
    if (wave >= 4) return;
    const unsigned char* tab = (const unsigned char*)a.out + DO_S5TAB + (size_t)g * S5T_BYTES;
    const float* hdr = (const float*)(tab + S5T_HDR);
    const bf16_t* P = (const bf16_t*)(a.ws + WS_P);
    bf16_t* Yg = (bf16_t*)(a.ws + WS_YG);
    const int r31 = lane & 31, hh = lane >> 5, bs = 32 * wave + r31;
    const bf16x8 bu = *(const bf16x8*)((const bf16_t*)(a.ws + WS_U2S) + ((size_t)g * NSMP + bs) * 16 + 8 * hh);
    f32x16 z;
#pragma unroll
    for (int r = 0; r < 16; ++r) z[r] = 0.f;
    f32x16 x[4];
#pragma unroll
    for (int mtile = 0; mtile < 4; ++mtile) x[mtile] = __builtin_amdgcn_mfma_f32_32x32x16_bf16(ldfrag(tab + S5T_ME, mtile * 16 + 15, lane), bu, z, 0, 0, 0);
    const size_t sb = (size_t)(bs * 64 + g) * 64;
#pragma unroll
    for (int pt = 0; pt < 2; ++pt)
#pragma unroll
        for (int q4 = 0; q4 < 4; ++q4) { const int p0 = 32 * pt + 8 * q4 + 4 * hh;
            const f32x4 x0r = *(const f32x4*)(a.in[I_S5RE] + sb + p0), x0i = *(const f32x4*)(a.in[I_S5IM] + sb + p0);
            const f32x4 ar = *(const f32x4*)(hdr + 128 + p0), ai = *(const f32x4*)(hdr + 192 + p0);
            f32x4 nr, ni;
#pragma unroll
            for (int j = 0; j < 4; ++j) { nr[j] = ar[j] * x0r[j] - ai[j] * x0i[j] + x[pt][4 * q4 + j]; ni[j] = ar[j] * x0i[j] + ai[j] * x0r[j] + x[2 + pt][4 * q4 + j]; x[pt][4 * q4 + j] = nr[j]; x[2 + pt][4 * q4 + j] = ni[j]; }
            *(f32x4*)(a.out + OUT_S5RE_S + sb + p0) = nr; *(f32x4*)(a.out + OUT_S5IM_S + sb + p0) = ni; }
    f32x16 y = __builtin_amdgcn_mfma_f32_32x32x16_bf16(ldfrag(tab + S5T_DF, 0, lane), bu, z, 0, 0, 0);
#pragma unroll
    for (int mtile = 0; mtile < 4; ++mtile)
#pragma unroll
        for (int sp = 0; sp < 2; ++sp) { u32x4 t; t.x = cvt_pk_bf16(x[mtile][8 * sp], x[mtile][8 * sp + 1]); t.y = cvt_pk_bf16(x[mtile][8 * sp + 2], x[mtile][8 * sp + 3]);
            t.z = cvt_pk_bf16(x[mtile][8 * sp + 4], x[mtile][8 * sp + 5]); t.w = cvt_pk_bf16(x[mtile][8 * sp + 6], x[mtile][8 * sp + 7]);
            y = __builtin_amdgcn_mfma_f32_32x32x16_bf16(ldfrag(tab + S5T_C0, mtile * 2 + sp, lane), __builtin_bit_cast(bf16x8, t), y, 0, 0, 0); }
#pragma unroll
    for (int q4 = 0; q4 < 2; ++q4) { const int c0 = 8 * q4 + 4 * hh;
        u32x2 w; w.x = cvt_pk_bf16(geluf_(y[4 * q4]), geluf_(y[4 * q4 + 1])); w.y = cvt_pk_bf16(geluf_(y[4 * q4 + 2]), geluf_(y[4 * q4 + 3]));
        *(u32x2*)(Yg + (size_t)(MP + bs) * 1024 + g * 16 + c0) = w; }
}

__device__ __forceinline__ void p4_rwkv_post8(const Args& a, int item0, int lane) {
    const int item = item0 + (lane >> 3), cg = lane & 7, row = item >> 4, h = item & 15, ch = h * 64 + 8 * cg;
    const bf16_t* ORAW = (const bf16_t*)((const unsigned char*)a.out + DO_ORAW); const bf16_t* BV = (const bf16_t*)((const unsigned char*)a.out + DO_BV);
    const bf16_t* P = (const bf16_t*)(a.ws + WS_P); bf16_t* A2 = (bf16_t*)(a.ws + WS_XN);
    const u32x4 ow = *(const u32x4*)(ORAW + (size_t)row * 1024 + ch), bw = *(const u32x4*)(BV + (size_t)row * 1024 + ch), zw = *(const u32x4*)(P + (size_t)row * LDP + PC_ZR + ch);
    const f32x4 w0 = *(const f32x4*)(a.in[I_GNW] + ch), w1 = *(const f32x4*)(a.in[I_GNW] + ch + 4), b0 = *(const f32x4*)(a.in[I_GNB] + ch), b1 = *(const f32x4*)(a.in[I_GNB] + ch + 4);
    const float o[8] = {bf_lo(ow.x), bf_hi(ow.x), bf_lo(ow.y), bf_hi(ow.y), bf_lo(ow.z), bf_hi(ow.z), bf_lo(ow.w), bf_hi(ow.w)};
    const float bv[8] = {bf_lo(bw.x), bf_hi(bw.x), bf_lo(bw.y), bf_hi(bw.y), bf_lo(bw.z), bf_hi(bw.z), bf_lo(bw.w), bf_hi(bw.w)};
    const float z[8] = {bf_lo(zw.x), bf_hi(zw.x), bf_lo(zw.y), bf_hi(zw.y), bf_lo(zw.z), bf_hi(zw.z), bf_lo(zw.w), bf_hi(zw.w)};
    const float gw[8] = {w0[0], w0[1], w0[2], w0[3], w1[0], w1[1], w1[2], w1[3]}, gb[8] = {b0[0], b0[1], b0[2], b0[3], b1[0], b1[1], b1[2], b1[3]};
    float sm = ((o[0] + o[1]) + (o[2] + o[3])) + ((o[4] + o[5]) + (o[6] + o[7]));
    sm += dpp_f<0xB1>(sm); sm += dpp_f<0x4E>(sm); sm += dpp_f<0x141>(sm);
    const float mean = sm * (1.0f / 64.0f); float d[8], sq = 0.f;
#pragma unroll
    for (int j = 0; j < 8; ++j) { d[j] = o[j] - mean; sq += d[j] * d[j]; }
    sq += dpp_f<0xB1>(sq); sq += dpp_f<0x4E>(sq); sq += dpp_f<0x141>(sq);
    const float rstd = rsqrtf(sq * (1.0f / 64.0f) + GN_EPS); float r[8];
#pragma unroll
    for (int j = 0; j < 8; ++j) r[j] = (d[j] * rstd * gw[j] + gb[j] + bv[j]) * z[j];
    u32x4 w; w.x = cvt_pk_bf16(r[0], r[1]); w.y = cvt_pk_bf16(r[2], r[3]); w.z = cvt_pk_bf16(r[4], r[5]); w.w = cvt_pk_bf16(r[6], r[7]);
    *(u32x4*)(A2 + (size_t)row * 2048 + 1024 + ch) = w;
}

__device__ __forceinline__ void p6_row(const Args& a, int m, int lane) {
    float* y = a.out + (size_t)m * DM; const float* fg = a.in[I_FINALG];
    if (m < MP) {
        const float* rs = (const float*)(a.ws + WS_ROWSS) + (size_t)m * 32;
        const float ss = wave_sum(rs[lane & 31]) * 0.5f;
        const float rstd = rsqrtf(ss * (1.0f / DM) + RMS_EPS);
#pragma unroll
        for (int j = 0; j < 8; ++j) { const int k = 4 * lane + 256 * j; f32x4 v = *(const f32x4*)(y + k); const f32x4 gv = *(const f32x4*)(fg + k);
#pragma unroll
            for (int q = 0; q < 4; ++q) v[q] = v[q] * rstd * gv[q];
            *(f32x4*)(y + k) = v; }
    } else {
        const int r = m - MP; const float* slab = (const float*)(a.ws + WS_SLAB) + (size_t)r * DM; const float* x = a.in[I_XS] + (size_t)r * DM;
        const float* gtrow = (const float*)(a.ws + WS_MOD) + (size_t)(NB + r) * NMOD + 2 * DM;
        f32x4 v[8]; float ss = 0.f;
#pragma unroll
        for (int j = 0; j < 8; ++j) { const int k = 4 * lane + 256 * j; f32x4 mix = *(const f32x4*)(slab + k);
#pragma unroll
            for (int s2 = 1; s2 < 8; ++s2) mix += *(const f32x4*)(slab + (size_t)s2 * NSMP * DM + k);
            const f32x4 xv = *(const f32x4*)(x + k), gt = *(const f32x4*)(gtrow + k);
#pragma unroll
            for (int q = 0; q < 4; ++q) { v[j][q] = xv[q] + gt[q] * mix[q]; ss += v[j][q] * v[j][q]; } }
        const float rstd = rsqrtf(wave_sum(ss) * (1.0f / DM) + RMS_EPS);
#pragma unroll
        for (int j = 0; j < 8; ++j) { const int k = 4 * lane + 256 * j; const f32x4 gv = *(const f32x4*)(fg + k); f32x4 o;
#pragma unroll
            for (int q = 0; q < 4; ++q) o[q] = v[j][q] * rstd * gv[q];
            *(f32x4*)(y + k) = o; }
    }
}

__global__ void __launch_bounds__(512, 2) fwd_kernel(Args args) {
    extern __shared__ __attribute__((aligned(16))) unsigned char lds_raw[];
    LAS unsigned char* lds = (LAS unsigned char*)lds_raw;
    const int tid = threadIdx.x, lane = tid & 63, wave = __builtin_amdgcn_readfirstlane(tid >> 6);
    const int G = gridDim.x, bx = blockIdx.x;
    const int vcu = (G % 8 == 0) ? (bx % 8) * (G / 8) + bx / 8 : bx;
    volatile LAS unsigned* MISC = (volatile LAS unsigned*)(lds + MISC_OFF);
    for (int u = tid; u < (LDS_BYTES - LDSCTL_OFF) / 4; u += 512) ((LAS unsigned*)(lds + LDSCTL_OFF))[u] = 0u;
    __syncthreads();
    unsigned* ctl = (unsigned*)(args.ws + WS_CTL);
    XcdBarrier bar; bar.bar = ctl + CW_BAR + args.li * XCD_BAR_WORDS; bar.x = 0; bar.st = nullptr;
    const bool multi = (args.ph_hi - args.ph_lo) > 1;
    if (multi) bar = xcd_barrier_post(ctl + CW_BAR + args.li * XCD_BAR_WORDS, MISC + 8);
    const int lo = args.ph_lo, hi = args.ph_hi;
#define IN(k) (lo <= (k) && (k) < hi)
#define SEAM(k) do { if (IN(k) && IN((k) + 1)) xcd_barrier(bar); } while (0)
    const int gw = vcu * 8 + wave, NGW = G * 8;

    if (IN(0)) {
        if (vcu < 192) { p0_mod(args, lds, vcu, wave, lane, ctl + CW_AREADY);
            LAS float* scr = (LAS float*)(lds + wave * 16384);
            for (int it = vcu * 8 + wave; it < 2048 + 512; it += 192 * 8) {
                if (it < 2048) { const int nb = it >> 5, kb = it & 31; transpose_item(args.in[I_WOUT], 2048, 2048, 32 * nb, (bf16_t*)(args.ws + WS_WOUT_T), 32 * nb, 64 * kb, scr, lane, false); }
                else { const int i2 = it - 2048, nb = i2 >> 4, kb = i2 & 15; transpose_item(args.in[I_WGLU], 1024, 1024, 32 * nb, (bf16_t*)(args.ws + WS_WGLU_T), 32 * nb, 64 * kb, scr, lane, false); } } }
        else if (vcu - 192 < 64) { p0_silu_prep(args, vcu - 192, tid, ctl + CW_AREADY); p0_s5_tables(args, lds, vcu - 192, tid); }
    }
    SEAM(0);
    if (IN(1)) {
        { LAS float* scr = (LAS float*)(lds + wave * 16384);
          bf16_t* WT = (bf16_t*)(args.ws + WS_WT);
          for (int it = gw; it < 328 * 32; it += NGW) { const int nb = it >> 5, kb = it & 31; const int p0 = 32 * nb;
              const int src = (p0 < 5120) ? p0 : ((p0 < 10240) ? p0 + 128 : p0 - 5120);
              transpose_item(args.in[I_WIN], NIN, 2048, src, WT, p0, 64 * kb, scr, lane, p0 >= NIN); } }
        for (int m = gw; m < MT; m += NGW) p1_row(args, m, lane);
    }
    SEAM(1);
    const bool tail_mode = (G == 256);
    if (IN(2)) {
        pg8::Gemm g{(const bf16_t*)(args.ws + WS_XN), (const bf16_t*)(args.ws + WS_WT), 2048, 2048};
        EpiP E{(bf16_t*)(args.ws + WS_P), tail_mode, (bf16_t*)(args.ws + WS_U2)};
        if (tail_mode) {
            pg8::TailOrder S; S.init2(G, bx, ctl + CW_TILE);
            pg8::gemm_phase<EpiP, pg8::TailOrder, GEMM_ALIGN, GEMM_SP2>(lds, g, S, E);
            if (bx >= 73) {
                const int t = bx - 73;
                for (int u = t; u < 256; u += 183) { wait_count(ctl + CW_TILE + 64 * ((u >> 6) * 4 + ((u & 63) >> 4)), 64u, wave); p3_s5_prompt(args, lds, u, tid, wave, lane); }
                if (t >= 146 && t < 178) { const int pm2 = t - 146;
                    wait_count(ctl + CW_TILE + 64 * (57 + pm2), 8u, wave); if (pm2 & 7) wait_count(ctl + CW_TILE + 64 * (57 + pm2 - 1), 8u, wave);
                    p2_xw_panel(args, pm2, tid); }
                if (t >= 73 && t < 137) { const int g2 = t - 73; wait_count(ctl + CW_TILE + 64 * (16 + (g2 >> 4)), 8u, wave); p3_s5_sample(args, g2, wave, lane); }
            }
        } else {
            pg8::StaticOrder S; S.init(MT, LDP, 2048, G, bx);
            pg8::gemm_phase<EpiP, pg8::StaticOrder, GEMM_ALIGN, GEMM_SP2>(lds, g, S, E);
        }
    }
    SEAM(2);
    if (IN(3)) {
        p3_rwkv_chunks(args, lds, vcu >> 2, vcu & 3, tid, wave, lane);
        if (!tail_mode) {
            if (false) { LAS float* scr = (LAS float*)(lds + wave * 16384);
              for (int it = gw; it < 2048 + 512; it += NGW) {
                  if (it < 2048) { const int nb = it >> 5, kb = it & 31; transpose_item(args.in[I_WOUT], 2048, 2048, 32 * nb, (bf16_t*)(args.ws + WS_WOUT_T), 32 * nb, 64 * kb, scr, lane, false); }
                  else { const int i2 = it - 2048, nb = i2 >> 4, kb = i2 & 15; transpose_item(args.in[I_WGLU], 1024, 1024, 32 * nb, (bf16_t*)(args.ws + WS_WGLU_T), 32 * nb, 64 * kb, scr, lane, false); } } }
            __syncthreads();
            for (int u = vcu; u < 256; u += G) p3_s5_prompt(args, lds, u, tid, wave, lane);
            for (int g2 = vcu; g2 < 64; g2 += G) p3_s5_sample(args, g2, wave, lane);
            __syncthreads();
        }
        for (int it = vcu; it < 256; it += G) p3_rwkv_sample(args, lds, it >> 1, (it & 1) * 8 + wave, wave, lane);
    }
    SEAM(3);
    if (IN(4)) {
        pg8::StaticOrder S; S.init(MT, 1024, 1024, G, bx);
        pg8::Unit u0;
        if (S.next(0, u0)) {
            pg8::Gemm g{(const bf16_t*)(args.ws + WS_YG), (const bf16_t*)(args.ws + WS_WGLU_T), 1024, 1024};
            EpiGlu E{(const bf16_t*)(args.ws + WS_YG), (const bf16_t*)(args.ws + WS_P), args.in[I_BGLU], (bf16_t*)(args.ws + WS_XN)};
            pg8::gemm_phase<EpiGlu, pg8::StaticOrder, GEMM_ALIGN, GEMM_SP2>(lds, g, S, E);
        } else {
            const int nfree = G - 132, j = bx - 132, unit = wave * nfree + j;
            if (unit < 256) p3_rwkv_seq(args, unit, lane);
        }
    }
    SEAM(4);
    if (IN(5)) { for (int it = gw; it < 2048; it += NGW) p5_rwkv_out(args, it, lane); }
    SEAM(5);
    if (IN(6)) {
        pg8::Gemm g{(const bf16_t*)(args.ws + WS_XN), (const bf16_t*)(args.ws + WS_WOUT_T), 2048, 1024};
        pg8::OutOrder S; S.init(MP, DM, 1024, G, bx);
        EpiOut E{(const bf16_t*)(args.ws + WS_P), args.in[I_XP], (const float*)(args.ws + WS_MOD), args.out, (float*)(args.ws + WS_ROWSS), (bf16_t*)(args.ws + WS_TMP), (float*)(args.ws + WS_SLAB), ctl + CW_PANEL, args.in[I_FINALG]};
        pg8::gemm_phase<EpiOut, pg8::OutOrder, false, GEMM_SP2>(lds, g, S, E);
    }
    SEAM(6);
    if (IN(7)) { for (int m = MP + gw; m < MV; m += NGW) p6_row(args, m, lane); }
#undef IN
#undef SEAM
}

extern "C" void kernel_launch(void* const* d_in, const int* in_sizes, int n_in, void* d_out, int out_size, void* d_ws, size_t ws_size, hipStream_t stream) {
    static int grid = 0;
    if (grid == 0) {
        if (n_in != 34 || ws_size < WS_END) { fprintf(stderr, "kernel_launch: unexpected n_in %d / ws %zu\n", n_in, ws_size); grid = -1; return; }
        int dev = 0, cus = 0;
        if (hipGetDevice(&dev) != hipSuccess || hipDeviceGetAttribute(&cus, hipDeviceAttributeMultiprocessorCount, dev) != hipSuccess) { grid = -1; return; }
        if (hipFuncSetAttribute((const void*)fwd_kernel, hipFuncAttributeMaxDynamicSharedMemorySize, LDS_BYTES) != hipSuccess) { fprintf(stderr, "kernel_launch: hipFuncSetAttribute failed\n"); grid = -1; return; }
        int per_cu = 0;
        if (hipOccupancyMaxActiveBlocksPerMultiprocessor(&per_cu, (const void*)fwd_kernel, 512, LDS_BYTES) != hipSuccess || per_cu < 1) fprintf(stderr, "kernel_launch: occupancy query says %d\n", per_cu);
        (void)hipGetLastError();
        grid = cus;
        if (grid != 256) fprintf(stderr, "kernel_launch: note: %d CUs\n", grid);
    }
    if (grid < 0) return;
    (void)hipMemsetAsync((char*)d_ws + WS_CTL, 0, CTL_BYTES, stream);
    Args a{};
    for (int i = 0; i < 34; ++i) a.in[i] = (const float*)d_in[i];
    a.out = (float*)d_out; a.ws = (unsigned char*)d_ws;
    if (PROBE_PHASE >= 0) {
        a.ph_lo = 0; a.ph_hi = PROBE_PHASE + 1; a.li = 0; hipLaunchKernelGGL(fwd_kernel, dim3(grid), dim3(512), LDS_BYTES, stream, a);
        a.ph_lo = PROBE_PHASE; a.ph_hi = PROBE_PHASE + 1; a.li = 1; hipLaunchKernelGGL(fwd_kernel, dim3(grid), dim3(512), LDS_BYTES, stream, a);
        if (PROBE_PHASE + 1 < N_PHASES) { a.ph_lo = PROBE_PHASE + 1; a.ph_hi = N_PHASES; a.li = 2; hipLaunchKernelGGL(fwd_kernel, dim3(grid), dim3(512), LDS_BYTES, stream, a); }
    } else if (MK_N_LAUNCHES == 1) { a.ph_lo = 0; a.ph_hi = N_PHASES; a.li = 0; hipLaunchKernelGGL(fwd_kernel, dim3(grid), dim3(512), LDS_BYTES, stream, a); }
    else { for (int p = 0; p < N_PHASES; ++p) { a.ph_lo = p; a.ph_hi = p + 1; a.li = 0; hipLaunchKernelGGL(fwd_kernel, dim3(grid), dim3(512), LDS_BYTES, stream, a); } }
}
```

```cpp
#include <hip/hip_runtime.h>
#include <cstdio>
#include <cstdint>

#ifndef MK_N_LAUNCHES
#define MK_N_LAUNCHES 1
#endif
#ifndef PROBE_PHASE
#define PROBE_PHASE -1
#endif
constexpr int N_PHASES = 8;
#ifndef GEMM_SP2
#define GEMM_SP2 true
#endif
#ifndef GEMM_ALIGN
#define GEMM_ALIGN true
#endif

#define GAS __attribute__((address_space(1)))
#define LAS __attribute__((address_space(3)))
typedef unsigned short bf16_t;
typedef short bf16x8 __attribute__((ext_vector_type(8)));
typedef float f32x2 __attribute__((ext_vector_type(2)));
typedef float f32x4 __attribute__((ext_vector_type(4)));
typedef float f32x16 __attribute__((ext_vector_type(16)));
typedef unsigned u32x2 __attribute__((ext_vector_type(2)));
typedef unsigned u32x4 __attribute__((ext_vector_type(4)));
typedef GAS unsigned gu32;

constexpr int DM = 2048, SEQ = 2048, NB = 4, NSMP = 128;
constexpr int MP = NB * SEQ;
constexpr int MV = MP + NSMP;
constexpr int MT = MV + NSMP;
constexpr int NIN = 10368, LDP = 10496;
constexpr int NMOD = 6144, NMODROWS = NB + NSMP;
constexpr float RMS_EPS = 1e-6f, GN_EPS = 64e-5f;
constexpr int PC_U = 0, PC_ZS = 1024, PC_R = 2048, PC_K = 3072, PC_V = 4096, PC_ZR = 5120, PC_GS = 6144, PC_GR = 8192, PC_WD = 10240, PC_AD = 10304;

constexpr size_t WS_CTL = 0, CTL_BYTES = 131072;
constexpr size_t WS_MOD = CTL_BYTES;
constexpr size_t WS_WT = WS_MOD + 3276800;
constexpr size_t WS_XN = WS_WT + (size_t)LDP * 2048 * 2;
constexpr size_t WS_P = WS_XN + (size_t)MT * 2048 * 2;
constexpr size_t WS_RWI = WS_P + (size_t)MT * LDP * 2;
constexpr int RWI_GF = 0, RWI_W2F = 8192, RWI_H1F = 16384, RWI_O1F = 32768, RWI_LAM = 49152, RWI_BYTES = 49408;
constexpr size_t WS_SA = WS_RWI;
constexpr size_t WS_TMP = WS_RWI;
constexpr size_t WS_SLAB = WS_WT;
static_assert((size_t)8 * NSMP * DM * 4 <= (size_t)LDP * 2048 * 2, "slab alias");
constexpr size_t WS_YG = WS_RWI + (size_t)2048 * RWI_BYTES;
constexpr size_t WS_WOUT_T = WS_YG + (size_t)MT * 1024 * 2;
constexpr size_t WS_WGLU_T = WS_WOUT_T + (size_t)2048 * 2048 * 2;
constexpr size_t WS_ROWSS = WS_WGLU_T + (size_t)1024 * 1024 * 2;
constexpr size_t WS_U2 = WS_ROWSS + (size_t)MP * 8 * 4;
constexpr size_t WS_U2S = WS_U2 + (size_t)MP * 1024 * 2;
constexpr size_t WS_HB = WS_U2S + (size_t)NSMP * 1024 * 2;
constexpr size_t WS_XW = WS_HB + (size_t)256 * 32 * 2048;
constexpr size_t WS_END = WS_XW + (size_t)MP * 128 * 2;
static_assert(WS_END <= ((size_t)412 << 20), "ws map");
constexpr size_t DO_ORAW = 0, DO_BV = (size_t)MP * 1024 * 2, DO_S5TAB = 2 * DO_BV;
constexpr int S5T_ME = 0, S5T_KT = 65536, S5T_CA = 81920, S5T_C0 = 147456, S5T_DF = 155648, S5T_HDR = 156672, S5T_BYTES = 157696;
static_assert(DO_S5TAB + (size_t)64 * S5T_BYTES <= (size_t)MV * DM * 4, "d_out scratch");
constexpr size_t OUT_Y = 0, OUT_S5RE_P = 17039360, OUT_S5IM_P = 17055744, OUT_WKV_P = 17072128, OUT_SHIFT_P = 17334272,
                 OUT_S5RE_S = 17342464, OUT_S5IM_S = 17866752, OUT_WKV_S = 18391040, OUT_SHIFT_S = 26779648;
constexpr int RING_BYTES = 131072, LDSCTL_OFF = RING_BYTES, MISC_OFF = LDSCTL_OFF + 320, LDS_BYTES = 147456;
constexpr int CW_BAR = 1024;
constexpr int CW_SAMPLE = 30064;
constexpr int CW_MODDONE = 30128;
constexpr int CW_AREADY = 30000;
constexpr int CW_PANEL = 12288, CW_TILE = 16384;

#define LDS_WAIT() asm volatile("s_waitcnt lgkmcnt(0)" ::: "memory")
#define VM_WAIT() asm volatile("s_waitcnt vmcnt(0)" ::: "memory")
typedef __bf16 bf16x2_t __attribute__((ext_vector_type(2)));
__device__ __forceinline__ unsigned cvt_pk_bf16(float lo, float hi) { const f32x2 v = {lo, hi}; return __builtin_bit_cast(unsigned, __builtin_convertvector(v, bf16x2_t)); }
__device__ __forceinline__ u32x2 pack4(float a, float b, float c, float d) { u32x2 w; w.x = cvt_pk_bf16(a, b); w.y = cvt_pk_bf16(c, d); return w; }
__device__ __forceinline__ float bf_lo(unsigned w) { return __uint_as_float(w << 16); }
__device__ __forceinline__ float bf_hi(unsigned w) { return __uint_as_float(w & 0xffff0000u); }
__device__ __forceinline__ float bf2f(bf16_t b) { return __uint_as_float(((unsigned)b) << 16); }
__device__ __forceinline__ bf16_t f2bf(float f) { return (bf16_t)(cvt_pk_bf16(f, 0.f) & 0xffffu); }
__device__ __forceinline__ float rcpf_(float x) { return __builtin_amdgcn_rcpf(x); }
__device__ __forceinline__ float sigmoidf_(float x) { return rcpf_(1.0f + __expf(-x)); }
__device__ __forceinline__ float siluf_(float x) { return x * rcpf_(1.0f + __expf(-x)); }
__device__ __forceinline__ float tanhf_(float x) { const float e = __expf(2.0f * x); return 1.0f - 2.0f * rcpf_(e + 1.0f); }
__device__ __forceinline__ float geluf_(float y) { const float z = 0.7978845608028654f * (y + 0.044715f * y * y * y); return 0.5f * y * (1.0f + tanhf_(z)); }
__device__ __forceinline__ float wave_sum(float v) {
#pragma unroll
    for (int o = 1; o < 64; o <<= 1) v += __shfl_xor(v, o);
    return v;
}
template <int CTRL> __device__ __forceinline__ float dpp_f(float x) { return __builtin_bit_cast(float, __builtin_amdgcn_mov_dpp(__builtin_bit_cast(int, x), CTRL, 0xf, 0xf, true)); }
__device__ __forceinline__ float wave_sum_dpp(float v) {
    v += __builtin_bit_cast(float, __builtin_amdgcn_update_dpp(0, __builtin_bit_cast(int, v), 0x111, 0xf, 0xf, true));
    v += __builtin_bit_cast(float, __builtin_amdgcn_update_dpp(0, __builtin_bit_cast(int, v), 0x112, 0xf, 0xf, true));
    v += __builtin_bit_cast(float, __builtin_amdgcn_update_dpp(0, __builtin_bit_cast(int, v), 0x114, 0xf, 0xf, true));
    v += __builtin_bit_cast(float, __builtin_amdgcn_update_dpp(0, __builtin_bit_cast(int, v), 0x118, 0xf, 0xf, true));
    v += __builtin_bit_cast(float, __builtin_amdgcn_update_dpp(0, __builtin_bit_cast(int, v), 0x142, 0xa, 0xf, false));
    v += __builtin_bit_cast(float, __builtin_amdgcn_update_dpp(0, __builtin_bit_cast(int, v), 0x143, 0xc, 0xf, false));
    return __builtin_bit_cast(float, __builtin_amdgcn_readlane(__builtin_bit_cast(int, v), 63));
}
__device__ __forceinline__ float half_sum32(float v, bool upper) {
    v += __builtin_bit_cast(float, __builtin_amdgcn_update_dpp(0, __builtin_bit_cast(int, v), 0x111, 0xf, 0xf, true));
    v += __builtin_bit_cast(float, __builtin_amdgcn_update_dpp(0, __builtin_bit_cast(int, v), 0x112, 0xf, 0xf, true));
    v += __builtin_bit_cast(float, __builtin_amdgcn_update_dpp(0, __builtin_bit_cast(int, v), 0x114, 0xf, 0xf, true));
    v += __builtin_bit_cast(float, __builtin_amdgcn_update_dpp(0, __builtin_bit_cast(int, v), 0x118, 0xf, 0xf, true));
    v += __builtin_bit_cast(float, __builtin_amdgcn_update_dpp(0, __builtin_bit_cast(int, v), 0x142, 0xa, 0xf, false));
    const float s0 = __builtin_bit_cast(float, __builtin_amdgcn_readlane(__builtin_bit_cast(int, v), 31)), s1 = __builtin_bit_cast(float, __builtin_amdgcn_readlane(__builtin_bit_cast(int, v), 63));
    return upper ? s1 : s0;
}
__device__ __forceinline__ float row16_sum(float v) {
    v += dpp_f<0xB1>(v);
    v += dpp_f<0x4E>(v);
    v += dpp_f<0x141>(v);
    v += dpp_f<0x140>(v);
    return v;
}

#define XB_TMO      128
#define XB_XCNT(j)  (256  + 64 * (j))
#define XB_XSUB(j)  (1280 + 64 * (j))
#define XB_XGEN(j)  (2304 + 64 * (j))
#define XB_TOP      3328
#define XB_TOPGEN   3392
#define XCD_BAR_WORDS 3456
#define XB_SPIN_CAP (1u << 20)
__device__ __forceinline__ unsigned xb_ld(unsigned* p)              { return __hip_atomic_load(p, __ATOMIC_RELAXED, __HIP_MEMORY_SCOPE_AGENT); }
__device__ __forceinline__ unsigned xb_add(unsigned* p, unsigned v) { return __hip_atomic_fetch_add(p, v, __ATOMIC_RELAXED, __HIP_MEMORY_SCOPE_AGENT); }
__device__ __forceinline__ unsigned xb_xcc_id() { return (unsigned)__builtin_amdgcn_s_getreg((3 << 11) | 20) & 0xFu; }
#define XB_SPIN(cond, bar) do { unsigned _sp = 0; while (cond) { __builtin_amdgcn_s_sleep(1); \
    if ((++_sp & 255u) == 0u) { if (xb_ld(&(bar)[XB_TMO])) break; if (_sp > XB_SPIN_CAP) { atomicAdd(&(bar)[XB_TMO], 1u); break; } } } } while (0)
struct XcdBarrier { unsigned* bar; unsigned x; volatile LAS unsigned* st; };
__device__ __forceinline__ XcdBarrier xcd_barrier_post(unsigned* bar, volatile LAS unsigned* st) {
    XcdBarrier b; b.bar = bar; b.x = xb_xcc_id(); b.st = st;
    if (threadIdx.x == 0) (void)xb_add(&bar[XB_XCNT(b.x)], 1u);
    return b;
}
__device__ __forceinline__ void xcd_barrier_complete(unsigned* bar, unsigned x, unsigned& nloc, unsigned& nx) {
    const unsigned G = gridDim.x * gridDim.y * gridDim.z;
    unsigned sum, cnt, mine, sp = 0u;
    for (;;) {
        sum = 0u; cnt = 0u; mine = 0u;
#pragma unroll
        for (unsigned j = 0; j < 16; ++j) { const unsigned c = xb_ld(&bar[XB_XCNT(j)]); sum += c; cnt += (c > 0u) ? 1u : 0u; mine = (j == x) ? c : mine; }
        if (sum == G) break;
        __builtin_amdgcn_s_sleep(1);
        if ((++sp & 255u) == 0u) { if (xb_ld(&bar[XB_TMO])) break; if (sp > XB_SPIN_CAP) { atomicAdd(&bar[XB_TMO], 1u); break; } }
    }
    nloc = mine > 0u ? mine : 1u; nx = cnt > 0u ? cnt : 1u;
}
__device__ __forceinline__ void xcd_barrier(const XcdBarrier& b) {
    asm volatile("s_waitcnt vmcnt(0)" ::: "memory");
    __syncthreads();
    if (threadIdx.x == 0) {
        unsigned* bar = b.bar;
        __builtin_amdgcn_s_waitcnt(0);
        unsigned nloc = b.st[0], nx = b.st[1];
        if (nloc == 0u) { xcd_barrier_complete(bar, b.x, nloc, nx); b.st[0] = nloc; b.st[1] = nx; }
        const unsigned old = xb_add(&bar[XB_XSUB(b.x)], 1u);
        const unsigned gen = old / nloc;
        if (old + 1u == (gen + 1u) * nloc) {
            __builtin_amdgcn_fence(__ATOMIC_RELEASE, "agent");
            asm volatile("s_waitcnt vmcnt(0)" ::: "memory");
            const unsigned og = xb_add(&bar[XB_TOP], 1u);
            const unsigned tg = og / nx;
            if (og + 1u == (tg + 1u) * nx) xb_add(&bar[XB_TOPGEN], 1u);
            else XB_SPIN(xb_ld(&bar[XB_TOPGEN]) == tg, bar);
            __builtin_amdgcn_fence(__ATOMIC_ACQUIRE, "agent");
            xb_add(&bar[XB_XGEN(b.x)], 1u);
            asm volatile("s_waitcnt vmcnt(0)" ::: "memory");
        } else {
            XB_SPIN(xb_ld(&bar[XB_XGEN(b.x)]) == gen, bar);
            __builtin_amdgcn_fence(__ATOMIC_ACQUIRE, "agent");
            asm volatile("s_waitcnt vmcnt(0)" ::: "memory");
        }
    }
    __syncthreads();
}

__device__ __forceinline__ void xcd_barrier_arrive(const XcdBarrier& b) {
    asm volatile("s_waitcnt vmcnt(0)" ::: "memory");
    __syncthreads();
    if (threadIdx.x == 0) {
        unsigned* bar = b.bar;
        __builtin_amdgcn_s_waitcnt(0);
        unsigned nloc = b.st[0], nx = b.st[1];
        if (nloc == 0u) { xcd_barrier_complete(bar, b.x, nloc, nx); b.st[0] = nloc; b.st[1] = nx; }
        const unsigned old = xb_add(&bar[XB_XSUB(b.x)], 1u);
        const unsigned gen = old / nloc;
        if (old + 1u == (gen + 1u) * nloc) {
            __builtin_amdgcn_fence(__ATOMIC_RELEASE, "agent");
            asm volatile("s_waitcnt vmcnt(0)" ::: "memory");
            const unsigned og = xb_add(&bar[XB_TOP], 1u);
            const unsigned tg = og / nx;
            if (og + 1u == (tg + 1u) * nx) xb_add(&bar[XB_TOPGEN], 1u);
            else XB_SPIN(xb_ld(&bar[XB_TOPGEN]) == tg, bar);
            __builtin_amdgcn_fence(__ATOMIC_ACQUIRE, "agent");
            xb_add(&bar[XB_XGEN(b.x)], 1u);
            asm volatile("s_waitcnt vmcnt(0)" ::: "memory");
            b.st[3] = 0u;
        } else b.st[3] = gen + 1u;
    }
    __syncthreads();
}
__device__ __forceinline__ void xcd_barrier_finish_w0(const XcdBarrier& b, int wid) {
    if (wid == 0) { const unsigned p = b.st[3];
        if (p != 0u) { unsigned* bar = b.bar; XB_SPIN(xb_ld(&bar[XB_XGEN(b.x)]) == p - 1u, bar); __builtin_amdgcn_fence(__ATOMIC_ACQUIRE, "agent"); asm volatile("s_waitcnt vmcnt(0)" ::: "memory"); if ((threadIdx.x & 63) == 0) b.st[3] = 0u; } }
}
__device__ __forceinline__ void xcd_barrier_finish(const XcdBarrier& b) {
    if (threadIdx.x == 0) {
        const unsigned p = b.st[3];
        if (p != 0u) { unsigned* bar = b.bar; XB_SPIN(xb_ld(&bar[XB_XGEN(b.x)]) == p - 1u, bar); __builtin_amdgcn_fence(__ATOMIC_ACQUIRE, "agent"); asm volatile("s_waitcnt vmcnt(0)" ::: "memory"); b.st[3] = 0u; }
    }
    __syncthreads();
}

namespace pg8 {
constexpr int BM = 256, BK = 64, HALF = 128, HTB = HALF * BK * 2, STAGE_BYTES = 8 * HTB, NXCD = 8, WGM = 8;
__host__ __device__ __forceinline__ int lds_byte(int r, int c) { const int st = (r >> 4) * 2 + (c >> 5), rr = r & 15, cc = c & 31, ob = rr * 64 + cc * 2; return st * 1024 + (ob ^ (((ob >> 9) & 1) << 5)); }
__host__ __device__ __forceinline__ void stage_rc(int b, int& R, int& C) { const int st = b / 1024, sb = b % 1024, swz = sb ^ (((sb >> 9) & 1) << 5); R = (st >> 1) * 16 + swz / 64; C = (st & 1) * 32 + (swz % 64) / 2; }
__host__ __device__ __forceinline__ int perm32(int rho) { const int n = rho >> 4, i = rho & 15; return 8 * (i >> 2) + 4 * n + (i & 3); }
struct Unit { int pm, pn, koff, kt, mode; };
struct Gemm { const bf16_t* A; const bf16_t* Bt; int ld, K; };
struct StaticOrder {
    int nM, nN, nwg, G, c, kt;
    __device__ void init(int M, int N, int K, int G_, int c_) { nM = M / BM; nN = N / BM; nwg = nM * nN; G = G_; c = c_; kt = K / BK; }
    __device__ __forceinline__ void tile(int L, Unit& u) const {
        int wgid = L; { const int q = nwg / NXCD, r = nwg % NXCD, xcd = wgid % NXCD, off = wgid / NXCD; wgid = (xcd < r ? xcd * (q + 1) : r * (q + 1) + (xcd - r) * q) + off; }
        const int nig = WGM * nN, gid = wgid / nig, fm = gid * WGM, gsz = (nM - fm) < WGM ? (nM - fm) : WGM;
        u.pm = fm + ((wgid % nig) % gsz); u.pn = (wgid % nig) / gsz; u.koff = 0; u.kt = kt; u.mode = 0;
    }
    __device__ __forceinline__ bool next(int i, Unit& u) const { const long L = (long)i * G + c; if (L >= nwg) return false; tile((int)L, u); return true; }
    __device__ __forceinline__ void done(const Unit&, int, int&) const {}
    __device__ __forceinline__ void pre_next(const Unit&, int) const {}
};
struct OutOrder : StaticOrder {
    int slice;
    unsigned* cnt; unsigned* xgen; unsigned want;
    __device__ __forceinline__ void pre_next(const Unit& n, int wid) const {
        if (n.mode == 1 && want != 0u && wid == 0) { unsigned sp = 0;
            while (__hip_atomic_load(xgen, __ATOMIC_RELAXED, __HIP_MEMORY_SCOPE_AGENT) == want - 1u) { __builtin_amdgcn_s_sleep(1); if (++sp > (1u << 22)) break; }
            __builtin_amdgcn_fence(__ATOMIC_ACQUIRE, "agent"); }
    }
    __device__ __forceinline__ void done(const Unit& u, int lane, int& pend) const {
        if (pend >= 0) { asm volatile("s_waitcnt vmcnt(0)" ::: "memory"); if (lane == 0) __hip_atomic_fetch_add(cnt, 1u, __ATOMIC_RELAXED, __HIP_MEMORY_SCOPE_AGENT); pend = -1; }
        if (u.mode == 2) pend = 0;
    }
    __device__ __forceinline__ bool next(int i, Unit& u) const {
        const int i2 = (slice >= 0) ? i - 1 : i;
        if (i2 < 0) { u.pm = 32; u.pn = slice >> 3; u.koff = (slice & 7) * 256; u.kt = 4; u.mode = 2; return true; }
        if (i2 < 2 && c < nwg) { tile(c, u); u.koff = i2 * 1024; u.kt = 16; u.mode = i2; return true; }
        return false;
    }
};
struct TailOrder : StaticOrder {
    unsigned* cnt;
    __device__ void init2(int G_, int c_, unsigned* cnt_) { nM = 32; nN = 36; nwg = 32 * 36; G = G_; c = c_; kt = 32; cnt = cnt_; }
    __device__ __forceinline__ static bool flagged(const Unit& u) { return u.pm == 32 || u.pn < 4 || u.pn == 40; }
    __device__ __forceinline__ bool next(int i, Unit& u) const {
        const int L = i * G + c; if (L >= 201 + 1152) return false;
        if (L < 132) { const int x = L & 7, k = L >> 3; if (k < 16) { u.pm = 4 * x + (k >> 2); u.pn = k & 3; } else { u.pm = 32; u.pn = x; }
                       u.koff = 0; u.kt = 32; u.mode = 0; }
        else if (L < 169) { u.pm = 32; u.pn = 4 + (L - 132); u.koff = 0; u.kt = 32; u.mode = 0; }
        else if (L < 201) { u.pm = L - 169; u.pn = 40; u.koff = 0; u.kt = 32; u.mode = 0; }
        else { tile(L - 201, u); u.pn += 4; }
        return true;
    }
    __device__ __forceinline__ void done(const Unit& u, int lane, int& pend) const {
        if (pend >= 0) {
            asm volatile("s_waitcnt vmcnt(0)" ::: "memory");
            if (lane == 0) __hip_atomic_fetch_add(cnt + 64 * pend, 1u, __ATOMIC_RELAXED, __HIP_MEMORY_SCOPE_AGENT);
            pend = -1;
        }
        if (flagged(u)) pend = (u.pm == 32) ? 16 + u.pn : ((u.pn < 4) ? (u.pm >> 3) * 4 + u.pn : 57 + u.pm);
    }
};
template <class Epi, class Sched, bool ALIGN_EPI = false, bool SP2 = false>
__device__ __forceinline__ void gemm_phase(LAS unsigned char* lds, const Gemm g, const Sched& S, const Epi& E) {
    const int tid = threadIdx.x, wid = __builtin_amdgcn_readfirstlane(tid >> 6), lane = tid & 63, wr = wid >> 2, wc = wid & 3, fr = lane & 15, fq = lane >> 4;
    const int ld = g.ld;
    unsigned voffA[2], voffB[2];
#pragma unroll
    for (int i = 0; i < 2; ++i) { int R, C; stage_rc(tid * 16 + i * 8192, R, C); const int Rb = Epi::PERM ? ((R & ~31) + perm32(R & 31)) : R;
        voffA[i] = (unsigned)(R * ld + C) * 2u; voffB[i] = (unsigned)(Rb * ld + C) * 2u; }
    const size_t kstep = (size_t)(BK * 2);
    const size_t hstep = (size_t)HALF * ld * 2;
    const size_t tstep = 2 * hstep;
    const unsigned ldsw = (unsigned)wid * 1024u;
    const int aoff = lds_byte(wr * 64 + fr, fq * 8), boff = lds_byte(wc * 32 + fr, fq * 8);
#define PG8_SA(b, h) (((b) * 2 + (h)) * HTB)
#define PG8_SB(b, h) ((4 + (b) * 2 + (h)) * HTB)
#define PG8_STAGE(bufoff, gbase, voff) do { _Pragma("unroll") for (int _i = 0; _i < 2; ++_i) \
        __builtin_amdgcn_global_load_lds((const unsigned*)((const char*)(gbase) + (voff)[_i]), (LAS unsigned*)(lds + (bufoff) + ldsw + _i * 8192), 16, 0, 0); } while (0)
#define PG8_LDA(dst, b, h) do { _Pragma("unroll") for (int m = 0; m < 4; ++m) _Pragma("unroll") for (int k = 0; k < 2; ++k) dst[m][k] = *(const LAS bf16x8*)(lds + PG8_SA(b, h) + aoff + m * 2048 + k * 1024); } while (0)
#define PG8_LDB(dst, b, h) do { _Pragma("unroll") for (int n = 0; n < 2; ++n) _Pragma("unroll") for (int k = 0; k < 2; ++k) dst[n][k] = *(const LAS bf16x8*)(lds + PG8_SB(b, h) + boff + n * 2048 + k * 1024); } while (0)
#define PG8_MMA(ai, bj, At, Bt) do { __builtin_amdgcn_s_setprio(1); _Pragma("unroll") for (int m = 0; m < 4; ++m) _Pragma("unroll") for (int n = 0; n < 2; ++n) _Pragma("unroll") for (int k = 0; k < 2; ++k) \
        acc[ai][bj][m][n] = __builtin_amdgcn_mfma_f32_16x16x32_bf16(Bt[n][k], At[m][k], acc[ai][bj][m][n], 0, 0, 0); __builtin_amdgcn_s_setprio(0); } while (0)
#define PG8_WAIT_V(n) asm volatile("s_waitcnt vmcnt(" #n ")" ::: "memory")
#define PG8_WAIT_L(n) asm volatile("s_waitcnt lgkmcnt(" #n ")" ::: "memory")
#define PG8_BAR __builtin_amdgcn_s_barrier()
#define PG8_SCHED __builtin_amdgcn_sched_barrier(0)
    Unit cur, nxt; int ui = 0; bool deferred = false; int pend = -1;
    if (!S.next(0, cur)) return;
    f32x4 acc[2][2][4][2];
#pragma unroll
    for (int a = 0; a < 2; ++a)
#pragma unroll
        for (int b = 0; b < 2; ++b)
#pragma unroll
            for (int m = 0; m < 4; ++m)
#pragma unroll
                for (int n = 0; n < 2; ++n) acc[a][b][m][n] = (f32x4){0.f, 0.f, 0.f, 0.f};
    bf16x8 At[4][2], B0[2][2], B1[2][2];
    const char* cA = (const char*)g.A + (size_t)cur.pm * tstep + (size_t)cur.koff * 2; const char* cB = (const char*)g.Bt + (size_t)cur.pn * tstep + (size_t)cur.koff * 2;
    if constexpr (SP2) {
        PG8_STAGE(PG8_SB(0, 0), cB, voffB); PG8_STAGE(PG8_SB(0, 1), cB + hstep, voffB); PG8_STAGE(PG8_SA(0, 0), cA, voffA); PG8_STAGE(PG8_SA(0, 1), cA + hstep, voffA);
        if (wr == 1) PG8_BAR;
        PG8_WAIT_V(2); PG8_BAR;
        PG8_STAGE(PG8_SB(1, 0), cB + kstep, voffB); PG8_STAGE(PG8_SA(1, 0), cA + kstep, voffA); PG8_STAGE(PG8_SB(1, 1), cB + hstep + kstep, voffB);
        PG8_WAIT_V(6); PG8_BAR;
    } else {
    PG8_STAGE(PG8_SB(0, 0), cB, voffB); PG8_STAGE(PG8_SA(0, 0), cA, voffA); PG8_STAGE(PG8_SB(0, 1), cB + hstep, voffB); PG8_STAGE(PG8_SA(0, 1), cA + hstep, voffA);
    if (wr == 1) PG8_BAR;
    PG8_WAIT_V(4); PG8_BAR;
    PG8_STAGE(PG8_SB(1, 0), cB + kstep, voffB); PG8_STAGE(PG8_SA(1, 0), cA + kstep, voffA); PG8_STAGE(PG8_SB(1, 1), cB + hstep + kstep, voffB);
    PG8_WAIT_V(6); PG8_BAR;
    }
    for (;;) {
        const bool has_next = S.next(ui + 1, nxt);
        const char* nA = has_next ? (const char*)g.A + (size_t)nxt.pm * tstep + (size_t)nxt.koff * 2 : cA; const char* nB = has_next ? (const char*)g.Bt + (size_t)nxt.pn * tstep + (size_t)nxt.koff * 2 : cB;
        const int nt = cur.kt;
        for (int t = 0; t < nt; t += 2) {
            const bool last = (t == nt - 2);
            if (last && has_next) S.pre_next(nxt, wid);
            const char* a1 = cA + (size_t)(t + 1) * kstep;
            const char* a2 = last ? nA : cA + (size_t)(t + 2) * kstep; const char* b2 = last ? nB : cB + (size_t)(t + 2) * kstep;
            const char* a3 = a2 + kstep; const char* b3 = b2 + kstep;
            if constexpr (SP2) {
            PG8_LDB(B0, 0, 0); PG8_LDB(B1, 0, 1); PG8_SCHED; PG8_LDA(At, 0, 0); PG8_STAGE(PG8_SA(1, 1), a1 + hstep, voffA);
            PG8_WAIT_V(8); PG8_WAIT_L(0); PG8_BAR; PG8_MMA(0, 0, At, B0); PG8_MMA(0, 1, At, B1); PG8_BAR; PG8_SCHED;
            PG8_LDA(At, 0, 1); PG8_STAGE(PG8_SB(0, 0), b2, voffB); PG8_STAGE(PG8_SB(0, 1), b2 + hstep, voffB); PG8_STAGE(PG8_SA(0, 0), a2, voffA);
            PG8_WAIT_V(8); PG8_WAIT_L(0); PG8_BAR; PG8_MMA(1, 0, At, B0); PG8_MMA(1, 1, At, B1); PG8_BAR; PG8_SCHED;
            PG8_LDB(B0, 1, 0); PG8_LDB(B1, 1, 1); PG8_SCHED; PG8_LDA(At, 1, 0); PG8_STAGE(PG8_SA(0, 1), a2 + hstep, voffA);
            PG8_WAIT_V(8); PG8_WAIT_L(0); PG8_BAR; PG8_MMA(0, 0, At, B0); PG8_MMA(0, 1, At, B1); PG8_BAR; PG8_SCHED;
            PG8_LDA(At, 1, 1); PG8_STAGE(PG8_SB(1, 0), b3, voffB); PG8_STAGE(PG8_SB(1, 1), b3 + hstep, voffB); PG8_STAGE(PG8_SA(1, 0), a3, voffA);
            PG8_WAIT_V(8); PG8_WAIT_L(0); PG8_BAR; PG8_MMA(1, 0, At, B0); PG8_MMA(1, 1, At, B1); PG8_BAR; PG8_SCHED;
            } else {
            PG8_LDB(B0, 0, 0); PG8_SCHED; PG8_LDA(At, 0, 0); PG8_STAGE(PG8_SA(1, 1), a1 + hstep, voffA);
            PG8_WAIT_L(8); PG8_BAR; PG8_WAIT_L(0); PG8_MMA(0, 0, At, B0); PG8_BAR; PG8_SCHED;
            PG8_LDB(B1, 0, 1); PG8_STAGE(PG8_SB(0, 0), b2, voffB);
            PG8_BAR; PG8_WAIT_L(0); PG8_MMA(0, 1, At, B1); PG8_BAR;
            PG8_LDA(At, 0, 1); PG8_STAGE(PG8_SA(0, 0), a2, voffA);
            PG8_BAR; PG8_WAIT_L(0); PG8_MMA(1, 0, At, B0); PG8_BAR; PG8_SCHED;
            PG8_STAGE(PG8_SB(0, 1), b2 + hstep, voffB);
            PG8_WAIT_V(6); PG8_BAR; PG8_MMA(1, 1, At, B1); PG8_BAR;
            PG8_LDB(B0, 1, 0); PG8_SCHED; PG8_LDA(At, 1, 0); PG8_STAGE(PG8_SA(0, 1), a2 + hstep, voffA);
            PG8_WAIT_L(8); PG8_BAR; PG8_WAIT_L(0); PG8_MMA(0, 0, At, B0); PG8_BAR; PG8_SCHED;
            PG8_LDB(B1, 1, 1); PG8_STAGE(PG8_SB(1, 0), b3, voffB);
            PG8_BAR; PG8_WAIT_L(0); PG8_MMA(0, 1, At, B1); PG8_BAR;
            PG8_LDA(At, 1, 1); PG8_STAGE(PG8_SA(1, 0), a3, voffA);
            PG8_BAR; PG8_WAIT_L(0); PG8_MMA(1, 0, At, B0); PG8_BAR; PG8_SCHED;
            PG8_STAGE(PG8_SB(1, 1), b3 + hstep, voffB);
            PG8_WAIT_V(6); PG8_BAR; PG8_MMA(1, 1, At, B1); PG8_BAR;
            }
        }
        if constexpr (ALIGN_EPI) { if (wr == 0) PG8_BAR; }
        if (Epi::FUSED_LAST && !has_next && cur.mode == 1) deferred = true; else { E(acc, cur, wr, wc, fr, fq); S.done(cur, lane, pend); }
        const bool keep_acc = Epi::FUSED_LAST && cur.mode == 0;
        if (!has_next) break;
        if (!keep_acc) {
#pragma unroll
        for (int a = 0; a < 2; ++a)
#pragma unroll
            for (int b = 0; b < 2; ++b)
#pragma unroll
                for (int m = 0; m < 4; ++m)
#pragma unroll
                    for (int n = 0; n < 2; ++n) acc[a][b][m][n] = (f32x4){0.f, 0.f, 0.f, 0.f};
        }
        cur = nxt; cA = nA; cB = nB; ++ui;
        if constexpr (ALIGN_EPI) { if (wr == 1) PG8_BAR; }
    }
    PG8_WAIT_V(0);
    if constexpr (!ALIGN_EPI) { if (wr == 0) PG8_BAR; }
    PG8_BAR;
    if constexpr (Epi::FUSED_LAST) { if (deferred) E.fused(acc, cur, wr, wc, fr, fq, lds, wid, lane); }
#undef PG8_SA
#undef PG8_SB
#undef PG8_STAGE
#undef PG8_LDA
#undef PG8_LDB
#undef PG8_MMA
#undef PG8_WAIT_V
#undef PG8_WAIT_L
#undef PG8_BAR
#undef PG8_SCHED
}
}

struct EpiP {
    static constexpr bool PERM = true, FUSED_LAST = false;
    bf16_t* P; bool tail; bf16_t* U2;
    __device__ __forceinline__ void operator()(const f32x4 (&acc)[2][2][4][2], const pg8::Unit& u, int wr, int wc, int fr, int fq) const {
        const int row0 = u.pm * 256 + wr * 64 + fr, col0 = u.pn * 256 + wc * 32 + 8 * fq;
        const bool wt = tail && (u.pm == 32 || u.pn < 4 || u.pn == 40);
        const __amdgpu_buffer_rsrc_t rsrc = __builtin_amdgcn_make_buffer_rsrc(P, 0, (int)((size_t)MT * LDP * 2), 0x00020000);
        const __amdgpu_buffer_rsrc_t rsrc2 = __builtin_amdgcn_make_buffer_rsrc(U2, 0, (int)((size_t)MV * 1024 * 2), 0x00020000);
        const int act = ((u.pn >= 4 && u.pn < 8) || (u.pn >= 20 && u.pn < 24)) ? 1 : ((u.pn >= 24 && u.pn < 40) ? 2 : 0);
#pragma unroll
        for (int ai = 0; ai < 2; ++ai)
#pragma unroll
            for (int m = 0; m < 4; ++m) { bf16_t* rowp = P + (size_t)(row0 + ai * 128 + m * 16) * LDP + col0;
#pragma unroll
                for (int bj = 0; bj < 2; ++bj) { f32x4 v0 = acc[ai][bj][m][0], v1 = acc[ai][bj][m][1];
                    if (act == 1) {
#pragma unroll
                        for (int j = 0; j < 4; ++j) { v0[j] = siluf_(v0[j]); v1[j] = siluf_(v1[j]); } }
                    else if (act == 2) {
#pragma unroll
                        for (int j = 0; j < 4; ++j) { v0[j] = sigmoidf_(v0[j]); v1[j] = sigmoidf_(v1[j]); } }
                    u32x4 w; w.x = cvt_pk_bf16(v0[0], v0[1]); w.y = cvt_pk_bf16(v0[2], v0[3]); w.z = cvt_pk_bf16(v1[0], v1[1]); w.w = cvt_pk_bf16(v1[2], v1[3]);
                    if (u.pn < 4) {
                        const int row = row0 + ai * 128 + m * 16, col = col0 + bj * 128, g2 = col >> 4, hf = (col >> 3) & 1;
                        size_t eo; if (row < MP) eo = (((size_t)(row >> 11) * 64 + g2) * SEQ + (row & (SEQ - 1))) * 16 + hf * 8; else eo = (size_t)MP * 1024 + ((size_t)g2 * NSMP + ((row - MP) & (NSMP - 1))) * 16 + hf * 8;
                        if (row < MV) { if (wt) __builtin_amdgcn_raw_buffer_store_b128(w, rsrc2, (unsigned)(eo * 2), 0, 16); else *(u32x4*)(U2 + eo) = w; } }
                    else if (wt) __builtin_amdgcn_raw_buffer_store_b128(w, rsrc, (unsigned)((size_t)(row0 + ai * 128 + m * 16) * LDP + col0 + bj * 128) * 2u, 0, 16);
                    else *(u32x4*)(rowp + bj * 128) = w; } }
    }
};
struct EpiGlu {
    static constexpr bool PERM = true, FUSED_LAST = false;
    const bf16_t* Yg; const bf16_t* P; const float* bglu; bf16_t* A2;
    __device__ __forceinline__ void operator()(const f32x4 (&acc)[2][2][4][2], const pg8::Unit& u, int wr, int wc, int fr, int fq) const {
        const int row0 = u.pm * 256 + wr * 64 + fr, col0 = u.pn * 256 + wc * 32 + 8 * fq;
        f32x4 bv[2][2];
#pragma unroll
        for (int bj = 0; bj < 2; ++bj)
#pragma unroll
            for (int n = 0; n < 2; ++n) bv[bj][n] = *(const f32x4*)(bglu + col0 + bj * 128 + 4 * n);
#pragma unroll
        for (int ai = 0; ai < 2; ++ai)
#pragma unroll
            for (int m = 0; m < 4; ++m) { const size_t row = (size_t)(row0 + ai * 128 + m * 16);
#pragma unroll
                for (int bj = 0; bj < 2; ++bj) { const int c = col0 + bj * 128;
                    const u32x4 yg = *(const u32x4*)(Yg + row * 1024 + c), sz = *(const u32x4*)(P + row * LDP + PC_ZS + c);
                    const f32x4 a0 = acc[ai][bj][m][0] + bv[bj][0], a1 = acc[ai][bj][m][1] + bv[bj][1];
                    float o[8];
                    o[0] = bf_lo(yg.x) * sigmoidf_(a0[0]) * bf_lo(sz.x); o[1] = bf_hi(yg.x) * sigmoidf_(a0[1]) * bf_hi(sz.x);
                    o[2] = bf_lo(yg.y) * sigmoidf_(a0[2]) * bf_lo(sz.y); o[3] = bf_hi(yg.y) * sigmoidf_(a0[3]) * bf_hi(sz.y);
                    o[4] = bf_lo(yg.z) * sigmoidf_(a1[0]) * bf_lo(sz.z); o[5] = bf_hi(yg.z) * sigmoidf_(a1[1]) * bf_hi(sz.z);
                    o[6] = bf_lo(yg.w) * sigmoidf_(a1[2]) * bf_lo(sz.w); o[7] = bf_hi(yg.w) * sigmoidf_(a1[3]) * bf_hi(sz.w);
                    u32x4 w; w.x = cvt_pk_bf16(o[0], o[1]); w.y = cvt_pk_bf16(o[2], o[3]); w.z = cvt_pk_bf16(o[4], o[5]); w.w = cvt_pk_bf16(o[6], o[7]);
                    *(u32x4*)(A2 + row * 2048 + c) = w; } }
    }
};
struct EpiOut {
    static constexpr bool PERM = false, FUSED_LAST = true;
    const bf16_t* P; const float* xp; const float* mod; float* out; float* xbuf; bf16_t* tmp; float* slab; unsigned* cnt; const float* fg;
    __device__ __forceinline__ void operator()(f32x4 (&acc)[2][2][4][2], const pg8::Unit& u, int wr, int wc, int fr, int fq) const {
        const int row0 = u.pm * 256 + wr * 64 + fr, col0 = u.pn * 256 + wc * 32 + 4 * fq;
        if (u.mode == 0) {
#pragma unroll
            for (int ai = 0; ai < 2; ++ai)
#pragma unroll
                for (int m = 0; m < 4; ++m) { const size_t row = (size_t)(row0 + ai * 128 + m * 16); const bf16_t* p1 = P + row * LDP + PC_GS + col0; const bf16_t* p2 = P + row * LDP + PC_GR + col0;
#pragma unroll
                    for (int bj = 0; bj < 2; ++bj)
#pragma unroll
                        for (int n = 0; n < 2; ++n) { const int o = bj * 128 + n * 16; const u32x2 g1 = *(const u32x2*)(p1 + o), g2 = *(const u32x2*)(p2 + o); f32x4& a = acc[ai][bj][m][n];
                            a[0] *= bf_lo(g1.x) * rcpf_(bf_lo(g2.x)); a[1] *= bf_hi(g1.x) * rcpf_(bf_hi(g2.x)); a[2] *= bf_lo(g1.y) * rcpf_(bf_lo(g2.y)); a[3] *= bf_hi(g1.y) * rcpf_(bf_hi(g2.y)); } }
        } else {
            const int gc = (u.koff < 1024) ? PC_GS : PC_GR; float* sl = slab + (size_t)(u.koff >> 8) * NSMP * DM;
            const __amdgpu_buffer_rsrc_t rs = __builtin_amdgcn_make_buffer_rsrc((void*)sl, 0, NSMP * DM * 4, 0x00020000);
#pragma unroll
            for (int m = 0; m < 4; ++m) { const size_t row = (size_t)(row0 + m * 16); const bf16_t* prow = P + row * LDP + gc + col0; const unsigned so = (unsigned)(((row - MP) * DM + col0) * 4);
#pragma unroll
                for (int bj = 0; bj < 2; ++bj)
#pragma unroll
                    for (int n = 0; n < 2; ++n) { const int o = bj * 128 + n * 16; const u32x2 gg = *(const u32x2*)(prow + o); const f32x4 a = acc[0][bj][m][n];
                        const f32x4 r4 = (f32x4){bf_lo(gg.x) * a[0], bf_hi(gg.x) * a[1], bf_lo(gg.y) * a[2], bf_hi(gg.y) * a[3]};
                        __builtin_amdgcn_raw_buffer_store_b128(__builtin_bit_cast(u32x4, r4), rs, so + (unsigned)o * 4u, 0, 16); } }
        }
    }
    __device__ __forceinline__ void fused(f32x4 (&acc)[2][2][4][2], const pg8::Unit& u, int wr, int wc, int fr, int fq, LAS unsigned char* lds, int wid, int lane) const {
        const int row0 = u.pm * 256 + wr * 64 + fr, col0 = u.pn * 256 + wc * 32 + 4 * fq;
        LAS float* PT = (LAS float*)lds; LAS float* ST = (LAS float*)(lds + 4096);
        f32x4 gt[2][2];
        { const float* gtrow = mod + (size_t)(u.pm >> 3) * NMOD + 2 * DM + col0;
#pragma unroll
          for (int bj = 0; bj < 2; ++bj)
#pragma unroll
              for (int n = 0; n < 2; ++n) gt[bj][n] = *(const f32x4*)(gtrow + bj * 128 + n * 16); }
        const int row = wid * 32 + (lane & 31);
        unsigned* cnth = cnt + 64 * u.pm;
#define FE_PASS1(ai) do { \
            _Pragma("unroll") for (int m = 0; m < 4; ++m) { const size_t rowg = (size_t)(row0 + (ai) * 128 + m * 16); \
                const bf16_t* prow = P + rowg * LDP + PC_GR + col0; const float* xrow = xp + rowg * DM + col0; \
                u32x2 gg[4]; f32x4 xv[4]; \
                _Pragma("unroll") for (int q = 0; q < 4; ++q) { const int o = (q >> 1) * 128 + (q & 1) * 16; gg[q] = *(const u32x2*)(prow + o); xv[q] = *(const f32x4*)(xrow + o); } \
                float ss = 0.f; \
                _Pragma("unroll") for (int q = 0; q < 4; ++q) { const f32x4 a = acc[ai][q >> 1][m][q & 1]; const f32x4 g4 = gt[q >> 1][q & 1]; \
                    f32x4 r; r[0] = xv[q][0] + g4[0] * (bf_lo(gg[q].x) * a[0]); r[1] = xv[q][1] + g4[1] * (bf_hi(gg[q].x) * a[1]); \
                    r[2] = xv[q][2] + g4[2] * (bf_lo(gg[q].y) * a[2]); r[3] = xv[q][3] + g4[3] * (bf_hi(gg[q].y) * a[3]); \
                    ss += (r[0] * r[0] + r[1] * r[1]) + (r[2] * r[2] + r[3] * r[3]); \
                    acc[ai][q >> 1][m][q & 1] = r; } \
                ss += __shfl_xor(ss, 16); ss += __shfl_xor(ss, 32); \
                if (fq == 0) PT[((ai) * 128 + wr * 64 + m * 16 + fr) * 4 + wc] = ss; } \
            asm volatile("s_waitcnt lgkmcnt(0)" ::: "memory"); __builtin_amdgcn_s_barrier(); asm volatile("" ::: "memory"); \
            if ((wid >> 2) == (ai)) { \
                if (lane < 32) { const f32x4 p4 = *(const LAS f32x4*)(PT + row * 4); \
                    __hip_atomic_store(xbuf + ((size_t)(u.pm * 256 + row) * 8 + u.pn), (p4[0] + p4[1]) + (p4[2] + p4[3]), __ATOMIC_RELAXED, __HIP_MEMORY_SCOPE_AGENT); } \
                asm volatile("s_waitcnt vmcnt(0)" ::: "memory"); \
                if (lane == 0) __hip_atomic_fetch_add(cnth + 32 * (ai), 1u, __ATOMIC_RELAXED, __HIP_MEMORY_SCOPE_AGENT); } } while (0)
#define FE_PASS2(ai) do { \
            if (wid == 0) { unsigned sp = 0; \
                while ((unsigned)__builtin_amdgcn_readfirstlane(__hip_atomic_load(cnth + 32 * (ai), __ATOMIC_RELAXED, __HIP_MEMORY_SCOPE_AGENT)) < 32u) { __builtin_amdgcn_s_sleep(2); if (++sp > (1u << 22)) break; } } \
            asm volatile("s_waitcnt vmcnt(0) lgkmcnt(0)" ::: "memory"); __builtin_amdgcn_s_barrier(); asm volatile("" ::: "memory"); \
            if ((wid >> 2) == (ai) && lane < 32) { const float* sl = xbuf + (size_t)(u.pm * 256 + row) * 8; float s8 = 0.f;     \
                _Pragma("unroll") for (int t = 0; t < 8; ++t) s8 += __hip_atomic_load(sl + t, __ATOMIC_RELAXED, __HIP_MEMORY_SCOPE_AGENT); \
                ST[row] = rsqrtf(s8 * (1.0f / DM) + RMS_EPS); } \
            asm volatile("s_waitcnt lgkmcnt(0)" ::: "memory"); __builtin_amdgcn_s_barrier(); asm volatile("" ::: "memory"); \
            _Pragma("unroll") for (int m = 0; m < 4; ++m) { const int rl = (ai) * 128 + wr * 64 + m * 16 + fr; const float rstd = ST[rl]; float* orow = out + (size_t)(u.pm * 256 + rl) * DM + col0; \
                _Pragma("unroll") for (int bj = 0; bj < 2; ++bj) \
                    _Pragma("unroll") for (int n = 0; n < 2; ++n) *(f32x4*)(orow + bj * 128 + n * 16) = acc[ai][bj][m][n] * rstd * fgv[bj][n]; } } while (0)
        FE_PASS1(0);
        FE_PASS1(1);
        f32x4 fgv[2][2];
#pragma unroll
        for (int bj = 0; bj < 2; ++bj)
#pragma unroll
            for (int n = 0; n < 2; ++n) fgv[bj][n] = *(const f32x4*)(fg + col0 + bj * 128 + n * 16);
        FE_PASS2(0);
        FE_PASS2(1);
#undef FE_PASS1
#undef FE_PASS2
    }
};

struct Args { const float* in[34]; float* out; unsigned char* ws; int ph_lo, ph_hi, li, pad; };
enum { I_XP = 0, I_XS, I_CP, I_CS, I_S5RE, I_S5IM, I_WKV, I_SHIFT, I_NORMG, I_WADA, I_BADA, I_WIN, I_MU, I_ARE, I_AIM, I_LOGSTEP, I_BRE, I_BIM, I_CRE, I_CIM, I_DSKIP,
       I_WGLU, I_BGLU, I_W0, I_W2, I_A0, I_A2, I_KK, I_KA, I_RK, I_GNW, I_GNB, I_WOUT, I_FINALG };

__device__ __forceinline__ void transpose_item(const float* W, int ldw, int K, int csrc, bf16_t* WT, int rdst, int k0, LAS float* scr, int lane, bool zero) {
    if (zero) {
#pragma unroll
        for (int j = 0; j < 4; ++j) { const int n = (lane >> 3) + 8 * j; *(u32x4*)(WT + (size_t)(rdst + n) * K + k0 + 8 * (lane & 7)) = (u32x4){0u, 0u, 0u, 0u}; }
        return;
    }
    { f32x4 v[8]; const float* src = W + (size_t)(k0 + (lane >> 3)) * ldw + csrc + 4 * (lane & 7);
#pragma unroll
      for (int i = 0; i < 8; ++i) v[i] = *(const f32x4*)(src + (size_t)(8 * i) * ldw);
#pragma unroll
      for (int i = 0; i < 8; ++i) { LAS float* d = scr + ((lane >> 3) + 8 * i) * 33 + 4 * (lane & 7); d[0] = v[i][0]; d[1] = v[i][1]; d[2] = v[i][2]; d[3] = v[i][3]; } }
    LDS_WAIT(); asm volatile("" ::: "memory");
    const int c = lane & 7;
#pragma unroll
    for (int j = 0; j < 4; ++j) { const int n = (lane >> 3) + 8 * j; const LAS float* s = scr + (8 * c) * 33 + n;
        u32x4 o; o.x = cvt_pk_bf16(s[0 * 33], s[1 * 33]); o.y = cvt_pk_bf16(s[2 * 33], s[3 * 33]); o.z = cvt_pk_bf16(s[4 * 33], s[5 * 33]); o.w = cvt_pk_bf16(s[6 * 33], s[7 * 33]);
        *(u32x4*)(WT + (size_t)(rdst + n) * K + k0 + 8 * c) = o; }
    LDS_WAIT(); asm volatile("" ::: "memory");
}

__device__ __forceinline__ void p0_wconv_item(const Args& args, int it, LAS float* scr, int lane) {
    if (it < 2048) { const int nb = it >> 5, kb = it & 31; transpose_item(args.in[I_WOUT], 2048, 2048, 32 * nb, (bf16_t*)(args.ws + WS_WOUT_T), 32 * nb, 64 * kb, scr, lane, false); }
    else { const int i2 = it - 2048, nb = i2 >> 4, kb = i2 & 15; transpose_item(args.in[I_WGLU], 1024, 1024, 32 * nb, (bf16_t*)(args.ws + WS_WGLU_T), 32 * nb, 64 * kb, scr, lane, false); }
}
__device__ __forceinline__ void lerp8(const bf16_t* cur, const bf16_t* prev, bool has_prev, const float* mu, float (&o)[8]) {
    const u32x4 c = *(const u32x4*)cur; u32x4 p = (u32x4){0u, 0u, 0u, 0u}; if (has_prev) p = *(const u32x4*)prev;
    const f32x4 m0 = *(const f32x4*)mu, m1 = *(const f32x4*)(mu + 4);
    const float cf[8] = {bf_lo(c.x), bf_hi(c.x), bf_lo(c.y), bf_hi(c.y), bf_lo(c.z), bf_hi(c.z), bf_lo(c.w), bf_hi(c.w)};
    const float pf[8] = {bf_lo(p.x), bf_hi(p.x), bf_lo(p.y), bf_hi(p.y), bf_lo(p.z), bf_hi(p.z), bf_lo(p.w), bf_hi(p.w)};
    const float mf[8] = {m0[0], m0[1], m0[2], m0[3], m1[0], m1[1], m1[2], m1[3]};
#pragma unroll
    for (int j = 0; j < 8; ++j) o[j] = cf[j] + (pf[j] - cf[j]) * mf[j];
}
__device__ __forceinline__ void p2_xw_panel(const Args& a, int pm, int tid) {
    const bf16_t* P = (const bf16_t*)(a.ws + WS_P); bf16_t* XW = (bf16_t*)(a.ws + WS_XW); const float* mu = a.in[I_MU];
    const int row = pm * 256 + (tid >> 1), hf = tid & 1; const bool hp = (row & (SEQ - 1)) != 0;
#pragma unroll
    for (int k8 = 0; k8 < 8; ++k8) { const int col = 64 * hf + 8 * k8; float x8[8];
        lerp8(P + (size_t)row * LDP + PC_WD + col, P + (size_t)(row - 1) * LDP + PC_WD + col, hp, mu + 3072 + col, x8);
        if (hf == 0) {
#pragma unroll
            for (int j = 0; j < 8; ++j) x8[j] = tanhf_(x8[j]); }
        u32x4 t; t.x = cvt_pk_bf16(x8[0], x8[1]); t.y = cvt_pk_bf16(x8[2], x8[3]); t.z = cvt_pk_bf16(x8[4], x8[5]); t.w = cvt_pk_bf16(x8[6], x8[7]);
        *(u32x4*)(XW + (size_t)row * 128 + col) = t; }
}
__device__ __forceinline__ void wait_count(unsigned* cnt, unsigned need, int wave) {
    if (wave == 0) { unsigned sp = 0;
        while ((unsigned)__builtin_amdgcn_readfirstlane(__hip_atomic_load(cnt, __ATOMIC_RELAXED, __HIP_MEMORY_SCOPE_AGENT)) < need) { __builtin_amdgcn_s_sleep(4); if (++sp > (1u << 22)) break; }
        __builtin_amdgcn_fence(__ATOMIC_ACQUIRE, "agent");
        asm volatile("s_waitcnt vmcnt(0)" ::: "memory"); }
    __syncthreads();
}
__device__ __forceinline__ void p0_silu_prep(const Args& a, int idx, int tid, unsigned* aready) {
    const float* cp = a.in[I_CP]; const float* cs = a.in[I_CS];
    const __amdgpu_buffer_rsrc_t rs = __builtin_amdgcn_make_buffer_rsrc((void*)(a.ws + WS_SA), 0, 128 * 5 * 64 * 16, 0x00020000);
    for (int it = idx * 512 + tid; it < 128 * 5 * 64; it += 64 * 512) { const int l = it & 63, q = it >> 6, S = q / 5, t = q - 5 * S; const int R = 32 * t + (l & 31), k = 16 * S + 8 * (l >> 5);
        u32x4 w = (u32x4){0u, 0u, 0u, 0u};
        if (R < NMODROWS) { const float* src = (R < NB) ? cp + (size_t)R * DM + k : cs + (size_t)(R - NB) * DM + k; const f32x4 c0 = *(const f32x4*)src, c1 = *(const f32x4*)(src + 4);
            w.x = cvt_pk_bf16(siluf_(c0[0]), siluf_(c0[1])); w.y = cvt_pk_bf16(siluf_(c0[2]), siluf_(c0[3])); w.z = cvt_pk_bf16(siluf_(c1[0]), siluf_(c1[1])); w.w = cvt_pk_bf16(siluf_(c1[2]), siluf_(c1[3])); }
        __builtin_amdgcn_raw_buffer_store_b128(w, rs, (unsigned)it * 16u, 0, 16); }
    asm volatile("s_waitcnt vmcnt(0)" ::: "memory");
    __syncthreads();
    if (tid == 0) __hip_atomic_fetch_add(aready, 1u, __ATOMIC_RELAXED, __HIP_MEMORY_SCOPE_AGENT);
}
__device__ __forceinline__ void p0_mod(const Args& a, LAS unsigned char* lds, int s, int wave, int lane, unsigned* aready) {
    const float* W = a.in[I_WADA]; const float* bias = a.in[I_BADA];
    float* mod = (float*)(a.ws + WS_MOD);
    const u32x4* SA = (const u32x4*)(a.ws + WS_SA);
    const int n0 = 32 * s, k0 = 256 * wave, r31 = lane & 31, h = lane >> 5;
    f32x16 acc[5];
#pragma unroll
    for (int t = 0; t < 5; ++t)
#pragma unroll
        for (int r = 0; r < 16; ++r) acc[t][r] = 0.f;
    float bw[4][8]; u32x4 af[4][5];
#define MOD_LW(st_, ks_) do { const float* wp_ = W + (size_t)(k0 + 16 * (ks_) + 8 * h) * NMOD + n0 + r31; \
        _Pragma("unroll") for (int j = 0; j < 8; ++j) bw[st_][j] = wp_[(size_t)j * NMOD]; } while (0)
#define MOD_LA(st_, ks_) do { const u32x4* ap_ = SA + ((size_t)(16 * wave + (ks_)) * 5) * 64 + lane; \
        _Pragma("unroll") for (int t = 0; t < 5; ++t) af[st_][t] = ap_[t * 64]; } while (0)
    MOD_LW(0, 0); MOD_LW(1, 1); MOD_LW(2, 2);
    { unsigned sp = 0;
      while ((unsigned)__builtin_amdgcn_readfirstlane(__hip_atomic_load(aready, __ATOMIC_RELAXED, __HIP_MEMORY_SCOPE_AGENT)) < 64u) { __builtin_amdgcn_s_sleep(2); if (++sp > (1u << 22)) break; }
      __builtin_amdgcn_fence(__ATOMIC_ACQUIRE, "agent"); }
    MOD_LA(0, 0); MOD_LA(1, 1); MOD_LA(2, 2);
#pragma unroll 1
    for (int ks = 0; ks < 16; ks += 4) {
#pragma unroll
        for (int u = 0; u < 4; ++u) {
            if (ks + u + 3 < 16) { MOD_LW((u + 3) & 3, ks + u + 3); MOD_LA((u + 3) & 3, ks + u + 3); }
            bf16x8 bfr; { u32x4 t; t.x = cvt_pk_bf16(bw[u][0], bw[u][1]); t.y = cvt_pk_bf16(bw[u][2], bw[u][3]); t.z = cvt_pk_bf16(bw[u][4], bw[u][5]); t.w = cvt_pk_bf16(bw[u][6], bw[u][7]); bfr = __builtin_bit_cast(bf16x8, t); }
#pragma unroll
            for (int t = 0; t < 5; ++t) acc[t] = __builtin_amdgcn_mfma_f32_32x32x16_bf16(__builtin_bit_cast(bf16x8, af[u][t]), bfr, acc[t], 0, 0, 0);
        }
    }
#undef MOD_LW
#undef MOD_LA
    LAS float* red = (LAS float*)lds;
#pragma unroll
    for (int step = 4; step >= 1; step >>= 1) {
        if (wave >= step && wave < 2 * step) {
#pragma unroll
            for (int t = 0; t < 5; ++t)
#pragma unroll
                for (int r = 0; r < 16; ++r) red[(((wave - step) * 5 + t) * 16 + r) * 64 + lane] = acc[t][r];
        }
        __syncthreads();
        if (wave < step) {
#pragma unroll
            for (int t = 0; t < 5; ++t)
#pragma unroll
                for (int r = 0; r < 16; ++r) acc[t][r] += red[((wave * 5 + t) * 16 + r) * 64 + lane];
        }
        __syncthreads();
    }
    if (wave == 0) {
        const float bc = bias[n0 + r31];
        const __amdgpu_buffer_rsrc_t rs = __builtin_amdgcn_make_buffer_rsrc((void*)mod, 0, NMODROWS * NMOD * 4, 0x00020000);
#pragma unroll
        for (int t = 0; t < 5; ++t)
#pragma unroll
            for (int r = 0; r < 16; ++r) { const int R = 32 * t + (r & 3) + 8 * (r >> 2) + 4 * h; if (R < NMODROWS) __builtin_amdgcn_raw_buffer_store_b32(__builtin_bit_cast(unsigned, acc[t][r] + bc), rs, (unsigned)((R * NMOD + n0 + r31) * 4), 0, 16); }
        asm volatile("s_waitcnt vmcnt(0)" ::: "memory");
        if (lane == 0) __hip_atomic_fetch_add(aready + (CW_MODDONE - CW_AREADY), 1u, __ATOMIC_RELAXED, __HIP_MEMORY_SCOPE_AGENT);
    }
}

__device__ __forceinline__ void p0_s5_tables(const Args& a, LAS unsigned char* lds, int g, int tid) {
    LAS float* pw = (LAS float*)lds;
    LAS float* bbL = pw + 17 * 128;
    LAS float* ccL = bbL + 2048;
    LAS float* KF = ccL + 2048;
    LAS float* DL = KF + 4096;
    unsigned char* tab = (unsigned char*)a.out + DO_S5TAB + (size_t)g * S5T_BYTES;
    {
        const int p = tid & 63;
        const float step = expf(a.in[I_LOGSTEP][g]);
        const float lre = fminf(a.in[I_ARE][g * 64 + p], -1e-4f), lim = a.in[I_AIM][g * 64 + p];
        const float mag = expf(lre * step); float sn, cs; sincosf(lim * step, &sn, &cs);
        const float abr = mag * cs, abi = mag * sn, den = lre * lre + lim * lim;
        const float fr = ((abr - 1.0f) * lre + abi * lim) / den, fi = (abi * lre - (abr - 1.0f) * lim) / den;
        if (tid < 64) { float pr = 1.f, pi = 0.f;
            for (int e = 0; e <= 16; ++e) { pw[(e * 64 + p) * 2] = pr; pw[(e * 64 + p) * 2 + 1] = pi; const float nr = pr * abr - pi * abi, ni = pr * abi + pi * abr; pr = nr; pi = ni; } }
#pragma unroll
        for (int i = 0; i < 2; ++i) { const int c = (tid >> 6) + 8 * i; const float br = a.in[I_BRE][(g * 64 + p) * 16 + c], bi = a.in[I_BIM][(g * 64 + p) * 16 + c];
            bbL[(p * 16 + c) * 2] = fr * br - fi * bi; bbL[(p * 16 + c) * 2 + 1] = fr * bi + fi * br;
            ccL[(c * 64 + p) * 2] = a.in[I_CRE][(g * 16 + c) * 64 + p]; ccL[(c * 64 + p) * 2 + 1] = a.in[I_CIM][(g * 16 + c) * 64 + p]; }
        if (tid < 16) DL[tid] = a.in[I_DSKIP][g * 16 + tid];
    }
    __syncthreads();
    if (tid < 256) { const int c = tid >> 4, c2 = tid & 15; float s = 0.f;
        for (int p = 0; p < 64; ++p) s += ccL[(c * 64 + p) * 2] * bbL[(p * 16 + c2) * 2] - ccL[(c * 64 + p) * 2 + 1] * bbL[(p * 16 + c2) * 2 + 1];
        if (c == c2) s += DL[c];
        KF[tid] = s; }
    for (int it = tid; it < 4096; it += 512) { const int l = it & 63, s = (it >> 6) & 15, mtile = it >> 10; const int m = 32 * mtile + (l & 31), h = l >> 5, p = m & 63, im = m >> 6;
        const float pr = pw[((15 - s) * 64 + p) * 2], pi = pw[((15 - s) * 64 + p) * 2 + 1]; float v[8];
#pragma unroll
        for (int j = 0; j < 8; ++j) { const float br = bbL[(p * 16 + 8 * h + j) * 2], bi = bbL[(p * 16 + 8 * h + j) * 2 + 1]; v[j] = im ? (pr * bi + pi * br) : (pr * br - pi * bi); }
        u32x4 w; w.x = cvt_pk_bf16(v[0], v[1]); w.y = cvt_pk_bf16(v[2], v[3]); w.z = cvt_pk_bf16(v[4], v[5]); w.w = cvt_pk_bf16(v[6], v[7]);
        *(u32x4*)(tab + S5T_ME + (size_t)it * 16) = w; }
    { const int l = tid & 63, mt = tid >> 6; const int rho = l & 31, dt = rho >> 4, c = rho & 15, h = l >> 5, t = 2 * mt + dt;
      f32x16 kacc;
#pragma unroll
      for (int r = 0; r < 16; ++r) kacc[r] = 0.f;
#pragma unroll 2
      for (int ks = 0; ks < 8; ++ks) { float v[8], b[8];
#pragma unroll
        for (int j = 0; j < 8; ++j) { const int m = 16 * ks + 8 * h + j, p = m & 63; const float cr = ccL[(c * 64 + p) * 2], ci = ccL[(c * 64 + p) * 2 + 1], pr = pw[((t + 1) * 64 + p) * 2], pi = pw[((t + 1) * 64 + p) * 2 + 1];
            v[j] = (m < 64) ? (cr * pr - ci * pi) : -(cr * pi + ci * pr);
            b[j] = (rho < 16) ? bbL[(p * 16 + rho) * 2 + (m >> 6)] : 0.f; }
        u32x4 w; w.x = cvt_pk_bf16(v[0], v[1]); w.y = cvt_pk_bf16(v[2], v[3]); w.z = cvt_pk_bf16(v[4], v[5]); w.w = cvt_pk_bf16(v[6], v[7]);
        *(u32x4*)(tab + S5T_CA + (size_t)((mt * 8 + ks) * 64 + l) * 16) = w;
        u32x4 wl; wl.x = cvt_pk_bf16(v[0] - bf_lo(w.x), v[1] - bf_hi(w.x)); wl.y = cvt_pk_bf16(v[2] - bf_lo(w.y), v[3] - bf_hi(w.y)); wl.z = cvt_pk_bf16(v[4] - bf_lo(w.z), v[5] - bf_hi(w.z)); wl.w = cvt_pk_bf16(v[6] - bf_lo(w.w), v[7] - bf_hi(w.w));
        u32x4 bh; bh.x = cvt_pk_bf16(b[0], b[1]); bh.y = cvt_pk_bf16(b[2], b[3]); bh.z = cvt_pk_bf16(b[4], b[5]); bh.w = cvt_pk_bf16(b[6], b[7]);
        u32x4 bl; bl.x = cvt_pk_bf16(b[0] - bf_lo(bh.x), b[1] - bf_hi(bh.x)); bl.y = cvt_pk_bf16(b[2] - bf_lo(bh.y), b[3] - bf_hi(bh.y)); bl.z = cvt_pk_bf16(b[4] - bf_lo(bh.z), b[5] - bf_hi(bh.z)); bl.w = cvt_pk_bf16(b[6] - bf_lo(bh.w), b[7] - bf_hi(bh.w));
        kacc = __builtin_amdgcn_mfma_f32_32x32x16_bf16(__builtin_bit_cast(bf16x8, w), __builtin_bit_cast(bf16x8, bh), kacc, 0, 0, 0);
        kacc = __builtin_amdgcn_mfma_f32_32x32x16_bf16(__builtin_bit_cast(bf16x8, wl), __builtin_bit_cast(bf16x8, bh), kacc, 0, 0, 0);
        kacc = __builtin_amdgcn_mfma_f32_32x32x16_bf16(__builtin_bit_cast(bf16x8, w), __builtin_bit_cast(bf16x8, bl), kacc, 0, 0, 0); }
      if (rho < 16) {
#pragma unroll
        for (int r = 0; r < 16; ++r) { const int row = (r & 3) + 8 * (r >> 2) + 4 * h; const int e = 2 * mt + (row >> 4) + 1; if (e < 16) KF[(e * 16 + (row & 15)) * 16 + rho] = kacc[r]; } }
    }
    { const int it = tid; const int l = it & 63, sp = (it >> 6) & 1, mtile = it >> 7; const int rho = l & 31, h = l >> 5; float v[8];
#pragma unroll
        for (int j = 0; j < 8; ++j) { const int m = 32 * mtile + 16 * sp + 8 * (j >> 2) + 4 * h + (j & 3), p = m & 63; v[j] = (rho < 16) ? ((m < 64) ? ccL[(rho * 64 + p) * 2] : -ccL[(rho * 64 + p) * 2 + 1]) : 0.f; }
        u32x4 w; w.x = cvt_pk_bf16(v[0], v[1]); w.y = cvt_pk_bf16(v[2], v[3]); w.z = cvt_pk_bf16(v[4], v[5]); w.w = cvt_pk_bf16(v[6], v[7]);
        *(u32x4*)(tab + S5T_C0 + (size_t)it * 16) = w; }
    if (tid < 64) { const int l = tid, rho = l & 31, h = l >> 5; float v[8];
#pragma unroll
        for (int j = 0; j < 8; ++j) v[j] = (rho < 16 && rho == 8 * h + j) ? DL[rho] : 0.f;
        u32x4 w; w.x = cvt_pk_bf16(v[0], v[1]); w.y = cvt_pk_bf16(v[2], v[3]); w.z = cvt_pk_bf16(v[4], v[5]); w.w = cvt_pk_bf16(v[6], v[7]);
        *(u32x4*)(tab + S5T_DF + (size_t)l * 16) = w;
        float* hdr = (float*)(tab + S5T_HDR);
        hdr[l] = pw[(16 * 64 + l) * 2]; hdr[64 + l] = pw[(16 * 64 + l) * 2 + 1]; hdr[128 + l] = pw[(64 + l) * 2]; hdr[192 + l] = pw[(64 + l) * 2 + 1]; }
    __syncthreads();
    for (int it = tid; it < 1024; it += 512) { const int l = it & 63, ti = it >> 6; const int rho = l & 31, dt = rho >> 4, c = rho & 15, h = l >> 5, e = ti - 1 + dt; float v[8];
#pragma unroll
        for (int j = 0; j < 8; ++j) v[j] = (e < 0) ? 0.f : KF[(e * 16 + c) * 16 + 8 * h + j];
        u32x4 w; w.x = cvt_pk_bf16(v[0], v[1]); w.y = cvt_pk_bf16(v[2], v[3]); w.z = cvt_pk_bf16(v[4], v[5]); w.w = cvt_pk_bf16(v[6], v[7]);
        *(u32x4*)(tab + S5T_KT + (size_t)it * 16) = w; }
    __syncthreads();
}

__device__ __forceinline__ void p1_row(const Args& a, int m, int lane) {
    bf16_t* XN = (bf16_t*)(a.ws + WS_XN) + (size_t)m * DM;
    if (m >= MV) {
        const float* src = a.in[I_SHIFT] + (size_t)(m - MV) * DM;
#pragma unroll
        for (int j = 0; j < 8; ++j) { const f32x4 v = *(const f32x4*)(src + 4 * lane + 256 * j); u32x2 w; w.x = cvt_pk_bf16(v[0], v[1]); w.y = cvt_pk_bf16(v[2], v[3]); *(u32x2*)(XN + 4 * lane + 256 * j) = w; }
        return;
    }
    const float* x = (m < MP) ? a.in[I_XP] + (size_t)m * DM : a.in[I_XS] + (size_t)(m - MP) * DM;
    const int mrow = (m < MP) ? (m >> 11) : (NB + m - MP);
    const float* mod = (const float*)(a.ws + WS_MOD) + (size_t)mrow * NMOD;
    const float* g = a.in[I_NORMG];
    f32x4 v[8]; float ss = 0.f;
#pragma unroll
    for (int j = 0; j < 8; ++j) { v[j] = *(const f32x4*)(x + 4 * lane + 256 * j); ss += (v[j][0] * v[j][0] + v[j][1] * v[j][1]) + (v[j][2] * v[j][2] + v[j][3] * v[j][3]); }
    const float rstd = rsqrtf(wave_sum(ss) * (1.0f / DM) + RMS_EPS);
    float* sh_out = nullptr;
    if (m >= MP) sh_out = a.out + OUT_SHIFT_S + (size_t)(m - MP) * DM;
    else if ((m & (SEQ - 1)) == SEQ - 1) sh_out = a.out + OUT_SHIFT_P + (size_t)(m >> 11) * DM;
#pragma unroll
    for (int j = 0; j < 8; ++j) { const int k = 4 * lane + 256 * j; const f32x4 gv = *(const f32x4*)(g + k), sh = *(const f32x4*)(mod + k), sc = *(const f32x4*)(mod + DM + k);
        f32x4 hv;
#pragma unroll
        for (int q = 0; q < 4; ++q) hv[q] = v[j][q] * rstd * gv[q] * (1.0f + sc[q]) + sh[q];
        u32x2 w; w.x = cvt_pk_bf16(hv[0], hv[1]); w.y = cvt_pk_bf16(hv[2], hv[3]); *(u32x2*)(XN + k) = w;
        if (sh_out) *(f32x4*)(sh_out + k) = hv; }
}

constexpr int RW_TB = 32;
constexpr int RW_KK = 0, RW_DR = 2048, RW_DD = 4096, RW_BB = 6144, RW_KP = 8192, RW_VV = 10240, RW_SC = 11264, RW_LW = 11392, RW_LA = 13440, RW_OB = 15488, RW_BVB = 16512, RW_END = 17536;
struct RwTok { float kk, dr, dd, bb, kp, v, br, kr, bonus; };
__device__ __forceinline__ RwTok rw_token(const Args& a, int hj, float r, float k, float v, float lw, float la) {
    RwTok o;
    const float wpre = a.in[I_W0][hj] + lw;
    const float nz = -wpre;
    const float sp = fmaxf(nz, 0.f) + log1pf(__expf(-fabsf(nz)));
    const float w = -sp - 0.5f;
    o.dd = __expf(-__expf(w));
    const float av = sigmoidf_(a.in[I_A0][hj] + la);
    const float kkv = k * a.in[I_KK][hj];
    const float nrm = sqrtf(wave_sum(kkv * kkv));
    o.kk = kkv / fmaxf(nrm, 1e-12f);
    o.kp = k * (1.0f + (av - 1.0f) * a.in[I_KA][hj]);
    o.bb = o.kk * av;
    o.dr = o.dd * r;
    o.v = v;
    o.br = wave_sum(o.bb * r);
    o.kr = wave_sum(o.kp * r);
    o.bonus = wave_sum(r * o.kp * a.in[I_RK][hj]);
    return o;
}
__device__ __forceinline__ void p3_rwkv_prompt(const Args& a, LAS unsigned char* lds, int unit, int tid, int wave, int lane) {
    const int b = unit >> 5, h = (unit >> 1) & 15, half = unit & 1;
    LAS float* L = (LAS float*)lds;
    const bf16_t* P = (const bf16_t*)(a.ws + WS_P);
    bf16_t* ORAW = (bf16_t*)((unsigned char*)a.out + DO_ORAW); bf16_t* BV = (bf16_t*)((unsigned char*)a.out + DO_BV);
    const float* mu = a.in[I_MU];
    const int r31 = lane & 31, hh = lane >> 5;
    bf16x8 bfr[4];
    if (wave < 4) { const float* W2 = (wave >> 1) ? a.in[I_A2] : a.in[I_W2]; const int col = h * 64 + 32 * (wave & 1) + r31;
#pragma unroll
        for (int ks = 0; ks < 4; ++ks) { float w[8];
#pragma unroll
            for (int j = 0; j < 8; ++j) w[j] = W2[(size_t)(16 * ks + 8 * hh + j) * 1024 + col];
            u32x4 t; t.x = cvt_pk_bf16(w[0], w[1]); t.y = cvt_pk_bf16(w[2], w[3]); t.z = cvt_pk_bf16(w[4], w[5]); t.w = cvt_pk_bf16(w[6], w[7]); bfr[ks] = __builtin_bit_cast(bf16x8, t); } }
    const int srow = 4 * wave + (lane >> 4), cq = lane & 15;
    f32x4 S = (f32x4){0.f, 0.f, 0.f, 0.f};
    for (int t0 = 0; t0 < SEQ; t0 += RW_TB) {
        const size_t rowbase = (size_t)b * SEQ + t0;
        if (wave < 4) { const int mat = wave >> 1, nt2 = wave & 1; const size_t row = rowbase + r31; const bool hp = (t0 + r31) > 0;
            f32x16 acc;
#pragma unroll
            for (int r = 0; r < 16; ++r) acc[r] = 0.f;
#pragma unroll
            for (int ks = 0; ks < 4; ++ks) { const int col = PC_WD + mat * 64 + 16 * ks + 8 * hh; float x8[8];
                lerp8(P + row * LDP + col, P + (row - 1) * LDP + col, hp, mu + 3072 + mat * 64 + 16 * ks + 8 * hh, x8);
                if (mat == 0) {
#pragma unroll
                    for (int j = 0; j < 8; ++j) x8[j] = tanhf_(x8[j]); }
                u32x4 t; t.x = cvt_pk_bf16(x8[0], x8[1]); t.y = cvt_pk_bf16(x8[2], x8[3]); t.z = cvt_pk_bf16(x8[4], x8[5]); t.w = cvt_pk_bf16(x8[6], x8[7]);
                acc = __builtin_amdgcn_mfma_f32_32x32x16_bf16(__builtin_bit_cast(bf16x8, t), bfr[ks], acc, 0, 0, 0); }
            LAS float* dst = L + (mat ? RW_LA : RW_LW);
#pragma unroll
            for (int r = 0; r < 16; ++r) { const int tl = (r & 3) + 8 * (r >> 2) + 4 * hh; dst[tl * 64 + 32 * nt2 + r31] = acc[r]; } }
        __syncthreads();
#pragma unroll
        for (int q = 0; q < 4; ++q) { const int tl = wave * 4 + q; const size_t row = rowbase + tl; const bool hp = (t0 + tl) > 0; const int hj = h * 64 + lane;
            const bf16_t* pc = P + row * LDP; const bf16_t* pp = pc - LDP;
            float r = bf2f(pc[PC_R + hj]), k = bf2f(pc[PC_K + hj]), v = bf2f(pc[PC_V + hj]);
            const float pr = hp ? bf2f(pp[PC_R + hj]) : 0.f, pk = hp ? bf2f(pp[PC_K + hj]) : 0.f, pv = hp ? bf2f(pp[PC_V + hj]) : 0.f;
            r += (pr - r) * mu[hj]; k += (pk - k) * mu[1024 + hj]; v += (pv - v) * mu[2048 + hj];
            const RwTok o = rw_token(a, hj, r, k, v, L[RW_LW + tl * 64 + lane], L[RW_LA + tl * 64 + lane]);
            L[RW_KK + tl * 64 + lane] = o.kk; L[RW_DR + tl * 64 + lane] = o.dr; L[RW_DD + tl * 64 + lane] = o.dd; L[RW_BB + tl * 64 + lane] = o.bb; L[RW_KP + tl * 64 + lane] = o.kp;
            if ((lane >> 5) == half) L[RW_VV + tl * 32 + (lane & 31)] = o.v;
            if (lane == 0) { L[RW_SC + tl * 4] = o.br; L[RW_SC + tl * 4 + 1] = o.kr; L[RW_SC + tl * 4 + 2] = o.bonus; } }
        __syncthreads();
#pragma unroll 4
        for (int tl = 0; tl < RW_TB; ++tl) {
            const f32x4 kk4 = *(const LAS f32x4*)(L + RW_KK + tl * 64 + 4 * cq), dr4 = *(const LAS f32x4*)(L + RW_DR + tl * 64 + 4 * cq), d4 = *(const LAS f32x4*)(L + RW_DD + tl * 64 + 4 * cq),
                        b4 = *(const LAS f32x4*)(L + RW_BB + tl * 64 + 4 * cq), k4 = *(const LAS f32x4*)(L + RW_KP + tl * 64 + 4 * cq);
            const float v = L[RW_VV + tl * 32 + srow]; const f32x4 sc = *(const LAS f32x4*)(L + RW_SC + tl * 4);
            float p1 = (S[0] * kk4[0] + S[1] * kk4[1]) + (S[2] * kk4[2] + S[3] * kk4[3]);
            float p2 = (S[0] * dr4[0] + S[1] * dr4[1]) + (S[2] * dr4[2] + S[3] * dr4[3]);
            p1 = row16_sum(p1); p2 = row16_sum(p2);
            const float sa = -p1;
            const float o = p2 + sa * sc[0] + v * sc[1];
#pragma unroll
            for (int j = 0; j < 4; ++j) S[j] = S[j] * d4[j] + sa * b4[j] + v * k4[j];
            if (cq == 0) { L[RW_OB + tl * 32 + srow] = o; L[RW_BVB + tl * 32 + srow] = sc[2] * v; }
        }
        __syncthreads();
        { const int tl = tid >> 4, r2 = 2 * (tid & 15); const size_t off = (rowbase + tl) * 1024 + h * 64 + 32 * half + r2;
          *(unsigned*)(ORAW + off) = cvt_pk_bf16(L[RW_OB + tl * 32 + r2], L[RW_OB + tl * 32 + r2 + 1]);
          *(unsigned*)(BV + off) = cvt_pk_bf16(L[RW_BVB + tl * 32 + r2], L[RW_BVB + tl * 32 + r2 + 1]); }
    }
    *(f32x4*)(a.out + OUT_WKV_P + (((size_t)(b * 16 + h) * 64 + 32 * half + srow) * 64 + 4 * cq)) = S;
    __syncthreads();
}


constexpr int RC_LD = 72, RC_MAT = 64 * RC_LD * 2;
constexpr int RC_QK = 0 * RC_MAT, RC_RT = 1 * RC_MAT, RC_KT = 2 * RC_MAT, RC_BT = 3 * RC_MAT, RC_QKT = 4 * RC_MAT, RC_BHT = 5 * RC_MAT, RC_KHT = 6 * RC_MAT, RC_VT = 7 * RC_MAT,
              RC_AKK = 8 * RC_MAT, RC_ARK = 9 * RC_MAT, RC_ARB = 10 * RC_MAT, RC_TB = 11 * RC_MAT, RC_AKB = 12 * RC_MAT, RC_W1T = 12 * RC_MAT, RC_U1T = 13 * RC_MAT,
              RC_AVT = RC_QK, RC_TF = RC_KT, RC_LWA = RC_AKK, RC_SEG = 14 * RC_MAT;
static_assert(RC_SEG + 2048 <= RING_BYTES, "rwkv chunk lds");
constexpr int RS_ROWB = 656, RS_BASE = 0;
static_assert(RS_BASE + 65 * RS_ROWB <= RC_AKK, "staging must stay inside R0..R7");
#define MFMA32(a, b, c) __builtin_amdgcn_mfma_f32_32x32x16_bf16((a), (b), (c), 0, 0, 0)
#define MFMA16(a, b, c) __builtin_amdgcn_mfma_f32_16x16x32_bf16((a), (b), (c), 0, 0, 0)
__device__ __forceinline__ bf16x8 lds_frag(LAS unsigned char* lds, int mat, int row, int k0) { return *(const LAS bf16x8*)(lds + mat + (row * RC_LD + k0) * 2); }

template <int MAT, int MS, int NT>
__device__ __forceinline__ void rwc_stage1_job(LAS unsigned char* lds, int r31, int hh) {
    constexpr int X = (MAT & 1) ? RC_BT : RC_KT, Y = (MAT & 2) ? RC_RT : RC_QK;
    constexpr bool incl = (MAT & 2) != 0, diag = (MS == NT);
    f32x16 acc;
#pragma unroll
    for (int r = 0; r < 16; ++r) acc[r] = 0.f;
#pragma unroll
    for (int ks = 0; ks < 4; ++ks) acc = MFMA32(lds_frag(lds, X, 32 * MS + r31, 16 * ks + 8 * hh), lds_frag(lds, Y, 32 * NT + r31, 16 * ks + 8 * hh), acc);
    const int t = 32 * NT + r31, d0 = r31 - 4 * hh;
#pragma unroll
    for (int g4 = 0; g4 < 4; ++g4) { const int s0 = 32 * MS + 8 * g4 + 4 * hh; float v[4];
#pragma unroll
        for (int e = 0; e < 4; ++e) v[e] = (!diag || (incl ? (8 * g4 + e <= d0) : (8 * g4 + e < d0))) ? acc[4 * g4 + e] : 0.f;
        if (MAT == 1) *(LAS f32x4*)(lds + RC_AKB + (t * 72 + s0) * 4) = (f32x4){v[0], v[1], v[2], v[3]};
        else { constexpr int dstm = (MAT == 0) ? RC_AKK : ((MAT == 2) ? RC_ARK : RC_ARB); *(LAS u32x2*)(lds + dstm + (t * RC_LD + s0) * 2) = pack4(v[0], v[1], v[2], v[3]); } }
}
__device__ __forceinline__ void p3_rwkv_chunks(const Args& a, LAS unsigned char* lds, int bh, int seg, int tid, int wave, int lane) {
    const int b = bh >> 4, h = bh & 15, r31_ = lane & 31, hh_ = lane >> 5, hj = h * 64 + lane;
    const bf16_t* P = (const bf16_t*)(a.ws + WS_P);
    bf16_t* BV = (bf16_t*)((unsigned char*)a.out + DO_BV);
    const float* mu = a.in[I_MU];
    LAS float* SEG = (LAS float*)(lds + RC_SEG);
    bf16x8 bfr[4];
    { const float* W2 = (wave >> 2) ? a.in[I_A2] : a.in[I_W2]; const int col = h * 64 + 32 * (wave & 1) + r31_;
#pragma unroll
      for (int ks = 0; ks < 4; ++ks) { float w[8];
#pragma unroll
          for (int j = 0; j < 8; ++j) w[j] = W2[(size_t)(16 * ks + 8 * hh_ + j) * 1024 + col];
          u32x4 t; t.x = cvt_pk_bf16(w[0], w[1]); t.y = cvt_pk_bf16(w[2], w[3]); t.z = cvt_pk_bf16(w[4], w[5]); t.w = cvt_pk_bf16(w[6], w[7]); bfr[ks] = __builtin_bit_cast(bf16x8, t); } }
    const int hj2 = h * 64 + 2 * r31_;
    const f32x2 w02 = *(const f32x2*)(a.in[I_W0] + hj2), a02 = *(const f32x2*)(a.in[I_A0] + hj2), kk2 = *(const f32x2*)(a.in[I_KK] + hj2), ka2 = *(const f32x2*)(a.in[I_KA] + hj2), rk2 = *(const f32x2*)(a.in[I_RK] + hj2);
    const f32x2 mur2 = *(const f32x2*)(mu + hj2), muk2 = *(const f32x2*)(mu + 1024 + hj2), muv2 = *(const f32x2*)(mu + 2048 + hj2);
    unsigned goff[6], loff[6]; u32x4 pf[6];
#pragma unroll
    for (int i = 0; i < 6; ++i) { const int idx = tid + 512 * i, row = idx / 40, c = idx - row * 40;
        const int col = (c < 8) ? PC_R + h * 64 + 8 * c : ((c < 16) ? PC_K + h * 64 + 8 * (c - 8) : PC_V + h * 64 + 8 * (c - 16));
        goff[i] = (c < 24) ? (unsigned)(row * LDP + col) * 2u : (0x80000000u | (unsigned)(row * 128 + 8 * (c - 24)) * 2u);   loff[i] = (unsigned)(RS_BASE + row * RS_ROWB + c * 16); }
#define RWC_PREFETCH(chunk_) do { const unsigned char* pb_ = (const unsigned char*)(P + ((size_t)b * SEQ + (size_t)(chunk_) * 64 - 1) * LDP); \
        const unsigned char* xb_ = a.ws + WS_XW + ((size_t)b * SEQ + (size_t)(chunk_) * 64) * 256 - 256; \
        _Pragma("unroll") for (int i = 0; i < 6; ++i) { const bool ok_ = (tid + 512 * i < 2600) && ((chunk_) > 0 || tid + 512 * i >= 40); \
            pf[i] = (u32x4){0u, 0u, 0u, 0u}; if (ok_) pf[i] = (goff[i] & 0x80000000u) ? *(const u32x4*)(xb_ + (goff[i] & 0x7fffffffu)) : *(const u32x4*)(pb_ + goff[i]); } } while (0)
    RWC_PREFETCH(seg * 8);
#pragma unroll 1
    for (int ci = 0; ci < 8; ++ci) {
        const int chunk = seg * 8 + ci; const size_t rowbase = (size_t)b * SEQ + chunk * 64;
#pragma unroll
        for (int i = 0; i < 6; ++i) if (tid + 512 * i < 2600) *(LAS u32x4*)(lds + loff[i]) = pf[i];
        if (ci + 1 < 8) RWC_PREFETCH(chunk + 1);
        __syncthreads();
        int r31 = r31_, hh = hh_; asm volatile("" : "+v"(r31), "+v"(hh));
        unsigned char* rwi = a.ws + WS_RWI + (size_t)((bh * 32) + chunk) * RWI_BYTES;
        { const int mat = wave >> 2, mtile = (wave >> 1) & 1, nt2 = wave & 1; const int tl = 32 * mtile + r31;
          f32x16 acc;
#pragma unroll
          for (int r = 0; r < 16; ++r) acc[r] = 0.f;
#pragma unroll
          for (int ks = 0; ks < 4; ++ks) acc = MFMA32(*(const LAS bf16x8*)(lds + RS_BASE + (tl + 1) * RS_ROWB + (24 + mat * 8 + 2 * ks + hh) * 16), bfr[ks], acc);
          LAS float* dst = (LAS float*)(lds + RC_LWA) + mat * 64 * 68;
#pragma unroll
          for (int r = 0; r < 16; ++r) { const int t2 = 32 * mtile + (r & 3) + 8 * (r >> 2) + 4 * hh; dst[t2 * 68 + 32 * nt2 + r31] = acc[r]; } }
        __syncthreads();
        f32x2 r4[4], kp4[4], kk4v[4], bb4[4], v4[4], cs4[4];
        LAS float* SEG2 = (LAS float*)(lds + RC_AKB);
        const int half = hh, j2 = 2 * r31, tq0 = 8 * wave + 4 * half;
        { const LAS float* LW = (const LAS float*)(lds + RC_LWA); const LAS float* LA = LW + 64 * 68;
#pragma unroll
          for (int q = 0; q < 4; ++q) { const int tl = tq0 + q; const size_t row = rowbase + tl;
              const LAS unsigned char* pc = lds + RS_BASE + (tl + 1) * RS_ROWB + j2 * 2; const LAS unsigned char* pp = lds + RS_BASE + tl * RS_ROWB + j2 * 2;
              const unsigned cr = *(const LAS unsigned*)pc, ck = *(const LAS unsigned*)(pc + 128), cv = *(const LAS unsigned*)(pc + 256);
              const unsigned qr = *(const LAS unsigned*)pp, qk_ = *(const LAS unsigned*)(pp + 128), qv = *(const LAS unsigned*)(pp + 256);
              f32x2 r = {bf_lo(cr), bf_hi(cr)}, k = {bf_lo(ck), bf_hi(ck)}, v = {bf_lo(cv), bf_hi(cv)};
              const f32x2 pr = {bf_lo(qr), bf_hi(qr)}, pk = {bf_lo(qk_), bf_hi(qk_)}, pv = {bf_lo(qv), bf_hi(qv)};
              r += (pr - r) * mur2; k += (pk - k) * muk2; v += (pv - v) * muv2;
              const f32x2 lw = *(const LAS f32x2*)(LW + tl * 68 + j2), la = *(const LAS f32x2*)(LA + tl * 68 + j2);
              const f32x2 xw = w02 + lw, xa = a02 + la;
              const f32x2 ld = {-0.6065306597126334f * sigmoidf_(xw[0]), -0.6065306597126334f * sigmoidf_(xw[1])};
              const f32x2 av = {sigmoidf_(xa[0]), sigmoidf_(xa[1])};
              const f32x2 kkv = k * kk2;
              const float rn = fminf(__builtin_amdgcn_rsqf(half_sum32(kkv[0] * kkv[0] + kkv[1] * kkv[1], half != 0)), 1e12f);
              kk4v[q] = kkv * rn; kp4[q] = k * (1.0f + (av - 1.0f) * ka2); bb4[q] = kk4v[q] * av; r4[q] = r; v4[q] = v;
              const f32x2 rk_ = r * kp4[q] * rk2;
              const float bonus = half_sum32(rk_[0] + rk_[1], half != 0);
              *(unsigned*)(BV + row * 1024 + h * 64 + j2) = cvt_pk_bf16(bonus * v[0], bonus * v[1]);
              cs4[q] = (q == 0) ? ld : cs4[q > 0 ? q - 1 : 0] + ld; }
          *(LAS f32x2*)(SEG2 + (2 * wave + half) * 64 + j2) = cs4[3]; }
        __syncthreads();
        { f32x2 off = {0.f, 0.f}, cL = {0.f, 0.f};
#pragma unroll
          for (int sg = 0; sg < 16; ++sg) { const f32x2 x = *(const LAS f32x2*)(SEG2 + sg * 64 + j2); cL += x; if (sg < 2 * wave + half) off += x; }
          const f32x2 eLtot = {__expf(cL[0]), __expf(cL[1])};
          if (wave == 0 && half == 0) *(f32x2*)(rwi + RWI_LAM + j2 * 4) = eLtot;
          f32x2 ecprev = {__expf(off[0]), __expf(off[1])};
          f32x2 qkT[4], bhT[4], khT[4];
#pragma unroll
          for (int q = 0; q < 4; ++q) { const int tl = tq0 + q; const f32x2 c = off + cs4[q];
              const f32x2 ec = {__expf(c[0]), __expf(c[1])}, ecp = ecprev, enc = {rcpf_(ec[0]), rcpf_(ec[1])}, eL = eLtot * enc; ecprev = ec;
              const f32x2 qk = kk4v[q] * ecp, rt = r4[q] * ec, kt = kp4[q] * enc, bt = bb4[q] * enc;
              *(LAS unsigned*)(lds + RC_QK + (tl * RC_LD + j2) * 2) = cvt_pk_bf16(qk[0], qk[1]); *(LAS unsigned*)(lds + RC_RT + (tl * RC_LD + j2) * 2) = cvt_pk_bf16(rt[0], rt[1]);
              *(LAS unsigned*)(lds + RC_KT + (tl * RC_LD + j2) * 2) = cvt_pk_bf16(kt[0], kt[1]); *(LAS unsigned*)(lds + RC_BT + (tl * RC_LD + j2) * 2) = cvt_pk_bf16(bt[0], bt[1]);
              qkT[q] = qk; bhT[q] = bb4[q] * eL; khT[q] = kp4[q] * eL; }
#pragma unroll
          for (int ch = 0; ch < 2; ++ch) { const int ro = ((j2 + ch) * RC_LD + tq0) * 2;
              *(LAS u32x2*)(lds + RC_QKT + ro) = pack4(qkT[0][ch], qkT[1][ch], qkT[2][ch], qkT[3][ch]); *(LAS u32x2*)(lds + RC_BHT + ro) = pack4(bhT[0][ch], bhT[1][ch], bhT[2][ch], bhT[3][ch]);
              *(LAS u32x2*)(lds + RC_KHT + ro) = pack4(khT[0][ch], khT[1][ch], khT[2][ch], khT[3][ch]); *(LAS u32x2*)(lds + RC_VT + ro) = pack4(v4[0][ch], v4[1][ch], v4[2][ch], v4[3][ch]); } }
        __syncthreads();
        switch (wave) {
            case 0: rwc_stage1_job<0, 0, 0>(lds, r31, hh); rwc_stage1_job<2, 1, 1>(lds, r31, hh); break;
            case 1: rwc_stage1_job<0, 0, 1>(lds, r31, hh); rwc_stage1_job<3, 0, 0>(lds, r31, hh); break;
            case 2: rwc_stage1_job<0, 1, 1>(lds, r31, hh); rwc_stage1_job<3, 0, 1>(lds, r31, hh); break;
            case 3: rwc_stage1_job<1, 0, 0>(lds, r31, hh); rwc_stage1_job<3, 1, 1>(lds, r31, hh); break;
            case 4: rwc_stage1_job<1, 0, 1>(lds, r31, hh); break;
            case 5: rwc_stage1_job<1, 1, 1>(lds, r31, hh); break;
            case 6: rwc_stage1_job<2, 0, 0>(lds, r31, hh); break;
            default: rwc_stage1_job<2, 0, 1>(lds, r31, hh); break;
        }
        __syncthreads();
        LAS float* TF = (LAS float*)(lds + RC_TF); const LAS float* AKB = (const LAS float*)(lds + RC_AKB); LAS float* YS = SEG;
        if (wave == 0) {
            const int I = lane >> 4, jj = lane & 15; float x[16];
#pragma unroll
            for (int r = 0; r < 16; ++r) { float sacc = (r == jj) ? 1.f : 0.f;
#pragma unroll
                for (int q = 0; q < r; ++q) sacc -= AKB[(16 * I + r) * 72 + 16 * I + q] * x[q];
                x[r] = sacc; TF[(16 * I + r) * 72 + 16 * I + jj] = sacc; }
        } else if (wave < 4) {
            const int t2 = tid - 64;
            for (int e = t2; e < 512; e += 192) { const int blk = e >> 8, rr = (e >> 4) & 15, cc = e & 15; TF[(32 * blk + rr) * 72 + 32 * blk + 16 + cc] = 0.f; }
        } else {
            const int mt = (wave >> 1) & 1, nt2 = wave & 1; f32x16 acc;
#pragma unroll
            for (int r = 0; r < 16; ++r) acc[r] = 0.f;
#pragma unroll
            for (int ks = 0; ks < 4; ++ks) if (ks < 2 || mt == 1) acc = MFMA32(lds_frag(lds, RC_AKK, 32 * mt + r31, 16 * ks + 8 * hh), lds_frag(lds, RC_VT, 32 * nt2 + r31, 16 * ks + 8 * hh), acc);
#pragma unroll
            for (int g4 = 0; g4 < 4; ++g4) *(LAS u32x2*)(lds + RC_AVT + ((32 * nt2 + r31) * RC_LD + 32 * mt + 8 * g4 + 4 * hh) * 2) = pack4(acc[4 * g4], acc[4 * g4 + 1], acc[4 * g4 + 2], acc[4 * g4 + 3]);
        }
        __syncthreads();
        if (wave < 2) { const int pr = wave, ba = 2 * pr, bb = 2 * pr + 1, lr = lane & 15, lk = lane >> 4;
            f32x4 yc = (f32x4){0.f, 0.f, 0.f, 0.f};
#pragma unroll
            for (int ks = 0; ks < 4; ++ks) yc = __builtin_amdgcn_mfma_f32_16x16x4f32(AKB[(16 * bb + lr) * 72 + 16 * ba + 4 * ks + lk], TF[(16 * ba + 4 * ks + lk) * 72 + 16 * ba + lr], yc, 0, 0, 0);
#pragma unroll
            for (int r = 0; r < 4; ++r) YS[pr * 256 + (4 * lk + r) * 16 + lr] = yc[r];
            LDS_WAIT();
            f32x4 tc = (f32x4){0.f, 0.f, 0.f, 0.f};
#pragma unroll
            for (int ks = 0; ks < 4; ++ks) tc = __builtin_amdgcn_mfma_f32_16x16x4f32(TF[(16 * bb + lr) * 72 + 16 * bb + 4 * ks + lk], YS[pr * 256 + (4 * ks + lk) * 16 + lr], tc, 0, 0, 0);
#pragma unroll
            for (int r = 0; r < 4; ++r) TF[(16 * bb + 4 * lk + r) * 72 + 16 * ba + lr] = -tc[r]; }
        __syncthreads();
        if (wave < 4) { const int ti = wave >> 1, tj = wave & 1, lr = lane & 15, lk = lane >> 4;
            f32x4 zc = (f32x4){0.f, 0.f, 0.f, 0.f};
#pragma unroll
            for (int ks = 0; ks < 8; ++ks) zc = __builtin_amdgcn_mfma_f32_16x16x4f32(AKB[(32 + 16 * ti + lr) * 72 + 4 * ks + lk], TF[(4 * ks + lk) * 72 + 16 * tj + lr], zc, 0, 0, 0);
#pragma unroll
            for (int r = 0; r < 4; ++r) TF[(16 * ti + 4 * lk + r) * 72 + 32 + 16 * tj + lr] = zc[r]; }
        __syncthreads();
        if (wave < 4) { const int ti = wave >> 1, tj = wave & 1, lr = lane & 15, lk = lane >> 4;
            f32x4 tc = (f32x4){0.f, 0.f, 0.f, 0.f};
#pragma unroll
            for (int ks = 0; ks < 8; ++ks) tc = __builtin_amdgcn_mfma_f32_16x16x4f32(TF[(32 + 16 * ti + lr) * 72 + 32 + 4 * ks + lk], TF[(4 * ks + lk) * 72 + 32 + 16 * tj + lr], tc, 0, 0, 0);
#pragma unroll
            for (int r = 0; r < 4; ++r) TF[(32 + 16 * ti + 4 * lk + r) * 72 + 16 * tj + lr] = -tc[r]; }
        __syncthreads();
        { const int which = wave >> 2, mt = (wave >> 1) & 1, nt2 = wave & 1; const int Bm = which ? RC_AVT : RC_QKT, Dm = which ? RC_U1T : RC_W1T; f32x16 acc;
#pragma unroll
          for (int r = 0; r < 16; ++r) acc[r] = 0.f;
#pragma unroll
          for (int ks = 0; ks < 4; ++ks) if (ks < 2 || mt == 1) { const LAS float* tp = TF + (32 * mt + r31) * 72 + 16 * ks + 8 * hh; const f32x4 x0 = *(const LAS f32x4*)tp, x1 = *(const LAS f32x4*)(tp + 4);
              u32x4 w; w.x = cvt_pk_bf16(x0[0], x0[1]); w.y = cvt_pk_bf16(x0[2], x0[3]); w.z = cvt_pk_bf16(x1[0], x1[1]); w.w = cvt_pk_bf16(x1[2], x1[3]);
              acc = MFMA32(__builtin_bit_cast(bf16x8, w), lds_frag(lds, Bm, 32 * nt2 + r31, 16 * ks + 8 * hh), acc); }
#pragma unroll
          for (int g4 = 0; g4 < 4; ++g4) *(LAS u32x2*)(lds + Dm + ((32 * nt2 + r31) * RC_LD + 32 * mt + 8 * g4 + 4 * hh) * 2) = pack4(acc[4 * g4], acc[4 * g4 + 1], acc[4 * g4 + 2], acc[4 * g4 + 3]); }
        __syncthreads();
        { const int kind = wave >> 2, mt = (wave >> 1) & 1, nt2 = wave & 1; const int cidx = 32 * nt2 + r31;
          f32x16 acc;
#pragma unroll
          for (int r = 0; r < 16; ++r) acc[r] = 0.f;
          if (kind == 0) {
#pragma unroll
              for (int ks = 0; ks < 4; ++ks) acc = MFMA32(lds_frag(lds, RC_W1T, 32 * mt + r31, 16 * ks + 8 * hh), lds_frag(lds, RC_BHT, cidx, 16 * ks + 8 * hh), acc);
#pragma unroll
              for (int g4 = 0; g4 < 4; ++g4) { const int jo = 8 * g4 + 4 * hh, half = jo >> 4, q2 = (jo & 15) >> 2; const int blk = (cidx >> 4) * 2 + mt, lane2 = (cidx & 15) + 16 * q2;
                  *(u32x2*)(rwi + RWI_GF + (blk * 64 + lane2) * 16 + half * 8) = pack4(-acc[4 * g4], -acc[4 * g4 + 1], -acc[4 * g4 + 2], -acc[4 * g4 + 3]); }
          } else {
#pragma unroll
              for (int ks = 0; ks < 4; ++ks) if (ks < 2 || nt2 == 1) acc = MFMA32(lds_frag(lds, RC_W1T, 32 * mt + r31, 16 * ks + 8 * hh), lds_frag(lds, RC_ARB, cidx, 16 * ks + 8 * hh), acc);
#pragma unroll
              for (int g4 = 0; g4 < 4; ++g4) { const int jo = 8 * g4 + 4 * hh, half = jo >> 4, q2 = (jo & 15) >> 2; const int blk = (cidx >> 4) * 2 + mt, lane2 = (cidx & 15) + 16 * q2;
                  const u32x2 rt = *(const LAS u32x2*)(lds + RC_RT + (cidx * RC_LD + 32 * mt + jo) * 2);
                  *(u32x2*)(rwi + RWI_W2F + (blk * 64 + lane2) * 16 + half * 8) = pack4(bf_lo(rt.x) - acc[4 * g4], bf_hi(rt.x) - acc[4 * g4 + 1], bf_lo(rt.y) - acc[4 * g4 + 2], bf_hi(rt.y) - acc[4 * g4 + 3]); }
          }
          f32x16 ac1, ac2;
#pragma unroll
          for (int r = 0; r < 16; ++r) { ac1[r] = 0.f; ac2[r] = 0.f; }
          if (kind == 0) {
#pragma unroll
              for (int ks = 0; ks < 4; ++ks) { ac1 = MFMA32(lds_frag(lds, RC_KHT, 32 * mt + r31, 16 * ks + 8 * hh), lds_frag(lds, RC_VT, cidx, 16 * ks + 8 * hh), ac1);
                                               ac2 = MFMA32(lds_frag(lds, RC_BHT, 32 * mt + r31, 16 * ks + 8 * hh), lds_frag(lds, RC_U1T, cidx, 16 * ks + 8 * hh), ac2); }
#pragma unroll
              for (int g4 = 0; g4 < 4; ++g4) { const int ro = 32 * mt + 8 * g4 + 4 * hh, mt2 = ro >> 4, q2 = (ro & 15) >> 2, cb = cidx >> 4, lane2 = (cidx & 15) + 16 * q2;
                  *(u32x2*)(rwi + RWI_H1F + ((cb * 4 + mt2) * 64 + lane2) * 8) = pack4(ac1[4 * g4] - ac2[4 * g4], ac1[4 * g4 + 1] - ac2[4 * g4 + 1], ac1[4 * g4 + 2] - ac2[4 * g4 + 2], ac1[4 * g4 + 3] - ac2[4 * g4 + 3]); }
          } else {
#pragma unroll
              for (int ks = 0; ks < 4; ++ks) if (ks < 2 || nt2 == 1) { ac1 = MFMA32(lds_frag(lds, RC_VT, 32 * mt + r31, 16 * ks + 8 * hh), lds_frag(lds, RC_ARK, cidx, 16 * ks + 8 * hh), ac1);
                                                                        ac2 = MFMA32(lds_frag(lds, RC_U1T, 32 * mt + r31, 16 * ks + 8 * hh), lds_frag(lds, RC_ARB, cidx, 16 * ks + 8 * hh), ac2); }
#pragma unroll
              for (int g4 = 0; g4 < 4; ++g4) { const int ro = 32 * mt + 8 * g4 + 4 * hh, cb = ro >> 4, q2 = (ro & 15) >> 2, nt3 = cidx >> 4, lane2 = (cidx & 15) + 16 * q2;
                  *(u32x2*)(rwi + RWI_O1F + ((cb * 4 + nt3) * 64 + lane2) * 8) = pack4(ac1[4 * g4] - ac2[4 * g4], ac1[4 * g4 + 1] - ac2[4 * g4 + 1], ac1[4 * g4 + 2] - ac2[4 * g4 + 2], ac1[4 * g4 + 3] - ac2[4 * g4 + 3]); }
          } }
        __syncthreads();
    }
}

__device__ __forceinline__ void p3_rwkv_seq(const Args& a, int unit, int lane) {
    const int bh = unit >> 2, cb = unit & 3, l15 = lane & 15, q = lane >> 4;
    f32x4 hacc[4];
#pragma unroll
    for (int m = 0; m < 4; ++m) hacc[m] = (f32x4){0.f, 0.f, 0.f, 0.f};
    const unsigned char* base = a.ws + WS_RWI + (size_t)(bh * 32) * RWI_BYTES;
    unsigned char* hbo = a.ws + WS_HB + (size_t)unit * 32 * 2048;
    bf16x8 gfA[8], gfB[8]; u32x2 h1A[4], h1B[4]; f32x4 lamA[4], lamB[4];
#define RW2_LOADG(gf, h1, lam, src) do { _Pragma("unroll") for (int k2 = 0; k2 < 8; ++k2) gf[k2] = *(const bf16x8*)((src) + RWI_GF + (k2 * 64 + lane) * 16); \
        _Pragma("unroll") for (int m = 0; m < 4; ++m) { h1[m] = *(const u32x2*)((src) + RWI_H1F + ((cb * 4 + m) * 64 + lane) * 8); lam[m] = *(const f32x4*)((src) + RWI_LAM + (16 * m + 4 * q) * 4); } } while (0)
#define RW2_STEP(c_, gf, h1, lam) do { const int c = (c_); \
        bf16x8 hb[2]; \
        _Pragma("unroll") for (int ks = 0; ks < 2; ++ks) { u32x4 t; t.x = cvt_pk_bf16(hacc[2 * ks][0], hacc[2 * ks][1]); t.y = cvt_pk_bf16(hacc[2 * ks][2], hacc[2 * ks][3]); \
            t.z = cvt_pk_bf16(hacc[2 * ks + 1][0], hacc[2 * ks + 1][1]); t.w = cvt_pk_bf16(hacc[2 * ks + 1][2], hacc[2 * ks + 1][3]); hb[ks] = __builtin_bit_cast(bf16x8, t); \
            *(bf16x8*)(hbo + (size_t)c * 2048 + (ks * 64 + lane) * 16) = hb[ks]; } \
        _Pragma("unroll") for (int m = 0; m < 4; ++m) { f32x4 nacc = (f32x4){bf_lo(h1[m].x), bf_hi(h1[m].x), bf_lo(h1[m].y), bf_hi(h1[m].y)} + lam[m] * hacc[m]; \
            _Pragma("unroll") for (int ks = 0; ks < 2; ++ks) nacc = MFMA16(gf[m * 2 + ks], hb[ks], nacc); hacc[m] = nacc; } \
        if (c + 2 < 32) RW2_LOADG(gf, h1, lam, base + (size_t)(c + 2) * RWI_BYTES); } while (0)
    RW2_LOADG(gfA, h1A, lamA, base); RW2_LOADG(gfB, h1B, lamB, base + RWI_BYTES);
#pragma unroll 1
    for (int c2 = 0; c2 < 32; c2 += 2) { RW2_STEP(c2, gfA, h1A, lamA); RW2_STEP(c2 + 1, gfB, h1B, lamB); }
#undef RW2_STEP
#undef RW2_LOADG
#pragma unroll
    for (int m = 0; m < 4; ++m) *(f32x4*)(a.out + OUT_WKV_P + (((size_t)bh * 64 + 16 * cb + l15) * 64 + 16 * m + 4 * q)) = hacc[m];
}
__device__ __forceinline__ void p5_rwkv_out(const Args& a, int item, int lane) {
    const int bh = item >> 5, c = item & 31, b = bh >> 4, h = bh & 15, l15 = lane & 15, q = lane >> 4;
    const unsigned char* cur = a.ws + WS_RWI + (size_t)item * RWI_BYTES;
    const bf16_t* BV = (const bf16_t*)((const unsigned char*)a.out + DO_BV);
    const bf16_t* P = (const bf16_t*)(a.ws + WS_P); bf16_t* A2 = (bf16_t*)(a.ws + WS_XN);
    bf16x8 hb[4][2], w2f[8];
#pragma unroll
    for (int cb = 0; cb < 4; ++cb)
#pragma unroll
        for (int ks = 0; ks < 2; ++ks) hb[cb][ks] = *(const bf16x8*)(a.ws + WS_HB + ((size_t)(bh * 4 + cb) * 32 + c) * 2048 + (ks * 64 + lane) * 16);
#pragma unroll
    for (int k2 = 0; k2 < 8; ++k2) w2f[k2] = *(const bf16x8*)(cur + RWI_W2F + (k2 * 64 + lane) * 16);
    f32x4 gw[4], gb[4];
#pragma unroll
    for (int cb = 0; cb < 4; ++cb) { gw[cb] = *(const f32x4*)(a.in[I_GNW] + h * 64 + 16 * cb + 4 * q); gb[cb] = *(const f32x4*)(a.in[I_GNB] + h * 64 + 16 * cb + 4 * q); }
    f32x4 oo[4][4]; u32x2 bvv[4][4], zww[4][4];
#pragma unroll
    for (int n = 0; n < 4; ++n) { const size_t row = (size_t)b * SEQ + c * 64 + 16 * n + l15;
#pragma unroll
        for (int cb = 0; cb < 4; ++cb) { { const u32x2 t8 = *(const u32x2*)(cur + RWI_O1F + ((cb * 4 + n) * 64 + lane) * 8); oo[n][cb] = (f32x4){bf_lo(t8.x), bf_hi(t8.x), bf_lo(t8.y), bf_hi(t8.y)}; }
            bvv[n][cb] = *(const u32x2*)(BV + row * 1024 + h * 64 + 16 * cb + 4 * q); zww[n][cb] = *(const u32x2*)(P + row * LDP + PC_ZR + h * 64 + 16 * cb + 4 * q); } }
#pragma unroll
    for (int n = 0; n < 4; ++n) {
        const size_t row = (size_t)b * SEQ + c * 64 + 16 * n + l15;
        f32x4 o[4]; u32x2 bvw[4], zw[4];
#pragma unroll
        for (int cb = 0; cb < 4; ++cb) { o[cb] = oo[n][cb]; bvw[cb] = bvv[n][cb]; zw[cb] = zww[n][cb]; }
#pragma unroll
        for (int cb = 0; cb < 4; ++cb)
#pragma unroll
            for (int ks = 0; ks < 2; ++ks) o[cb] = MFMA16(hb[cb][ks], w2f[n * 2 + ks], o[cb]);
        float sm = 0.f;
#pragma unroll
        for (int cb = 0; cb < 4; ++cb) sm += (o[cb][0] + o[cb][1]) + (o[cb][2] + o[cb][3]);
        sm += __shfl_xor(sm, 16); sm += __shfl_xor(sm, 32);
        const float mean = sm * (1.0f / 64.0f); float sq = 0.f;
#pragma unroll
        for (int cb = 0; cb < 4; ++cb) { o[cb] = o[cb] - mean; sq += (o[cb][0] * o[cb][0] + o[cb][1] * o[cb][1]) + (o[cb][2] * o[cb][2] + o[cb][3] * o[cb][3]); }
        sq += __shfl_xor(sq, 16); sq += __shfl_xor(sq, 32);
        const float rstd = rsqrtf(sq * (1.0f / 64.0f) + GN_EPS);
#pragma unroll
        for (int cb = 0; cb < 4; ++cb) {
            const float r0 = (o[cb][0] * rstd * gw[cb][0] + gb[cb][0] + bf_lo(bvw[cb].x)) * bf_lo(zw[cb].x), r1 = (o[cb][1] * rstd * gw[cb][1] + gb[cb][1] + bf_hi(bvw[cb].x)) * bf_hi(zw[cb].x);
            const float r2 = (o[cb][2] * rstd * gw[cb][2] + gb[cb][2] + bf_lo(bvw[cb].y)) * bf_lo(zw[cb].y), r3 = (o[cb][3] * rstd * gw[cb][3] + gb[cb][3] + bf_hi(bvw[cb].y)) * bf_hi(zw[cb].y);
            *(u32x2*)(A2 + row * 2048 + 1024 + h * 64 + 16 * cb + 4 * q) = pack4(r0, r1, r2, r3); }
    }
}

__device__ __forceinline__ void p3_rwkv_sample(const Args& a, LAS unsigned char* lds, int bs, int h, int wave, int lane) {
    LAS float* Lw = (LAS float*)lds + wave * 768;
    const bf16_t* P = (const bf16_t*)(a.ws + WS_P);
    const bf16_t* pc = P + (size_t)(MP + bs) * LDP; const bf16_t* pp = P + (size_t)(MV + bs) * LDP;
    bf16_t* A2 = (bf16_t*)(a.ws + WS_XN);
    const float* mu = a.in[I_MU];
    const int hj = h * 64 + lane, rg = lane >> 4, cq = lane & 15;
    const size_t sbase = ((size_t)(bs * 16 + h) * 64) * 64;
    const float* S0 = a.in[I_WKV] + sbase; float* S1 = a.out + OUT_WKV_S + sbase;
    f32x4 S[16];
#pragma unroll
    for (int it = 0; it < 16; ++it) S[it] = *(const f32x4*)(S0 + (size_t)(4 * it + rg) * 64 + 4 * cq);
    { float wd = bf2f(pc[PC_WD + lane]), ad = bf2f(pc[PC_AD + lane]); wd += (bf2f(pp[PC_WD + lane]) - wd) * mu[3072 + lane]; ad += (bf2f(pp[PC_AD + lane]) - ad) * mu[3136 + lane];
      Lw[lane] = tanhf_(wd); Lw[64 + lane] = ad; }
    LDS_WAIT();
    float lw = 0.f, la = 0.f;
#pragma unroll 16
    for (int m = 0; m < 64; ++m) { lw += Lw[m] * a.in[I_W2][(size_t)m * 1024 + hj]; la += Lw[64 + m] * a.in[I_A2][(size_t)m * 1024 + hj]; }
    float r = bf2f(pc[PC_R + hj]), k = bf2f(pc[PC_K + hj]), v = bf2f(pc[PC_V + hj]);
    r += (bf2f(pp[PC_R + hj]) - r) * mu[hj]; k += (bf2f(pp[PC_K + hj]) - k) * mu[1024 + hj]; v += (bf2f(pp[PC_V + hj]) - v) * mu[2048 + hj];
    const RwTok o = rw_token(a, hj, r, k, v, lw, la);
    Lw[128 + lane] = o.kk; Lw[192 + lane] = o.dr; Lw[256 + lane] = o.dd; Lw[320 + lane] = o.bb; Lw[384 + lane] = o.kp; Lw[448 + lane] = o.v;
    LDS_WAIT();
    const f32x4 kk4 = *(const LAS f32x4*)(Lw + 128 + 4 * cq), dr4 = *(const LAS f32x4*)(Lw + 192 + 4 * cq), d4 = *(const LAS f32x4*)(Lw + 256 + 4 * cq), b4 = *(const LAS f32x4*)(Lw + 320 + 4 * cq), k4 = *(const LAS f32x4*)(Lw + 384 + 4 * cq);
#pragma unroll
    for (int it = 0; it < 16; ++it) { const int i = 4 * it + rg; const float vi = Lw[448 + i];
        float p1 = (S[it][0] * kk4[0] + S[it][1] * kk4[1]) + (S[it][2] * kk4[2] + S[it][3] * kk4[3]);
        float p2 = (S[it][0] * dr4[0] + S[it][1] * dr4[1]) + (S[it][2] * dr4[2] + S[it][3] * dr4[3]);
        p1 = row16_sum(p1); p2 = row16_sum(p2);
        const float sa = -p1, ov = p2 + sa * o.br + vi * o.kr;
        f32x4 Sn;
#pragma unroll
        for (int j = 0; j < 4; ++j) Sn[j] = S[it][j] * d4[j] + sa * b4[j] + vi * k4[j];
        *(f32x4*)(S1 + (size_t)i * 64 + 4 * cq) = Sn;
        if (cq == 0) Lw[512 + i] = ov; }
    LDS_WAIT();
    const float ov = Lw[512 + lane];
    const float mean = wave_sum_dpp(ov) * (1.0f / 64.0f); const float dv = ov - mean; const float var = wave_sum_dpp(dv * dv) * (1.0f / 64.0f);
    float on = dv * rsqrtf(var + GN_EPS) * a.in[I_GNW][hj] + a.in[I_GNB][hj] + o.bonus * o.v;
    on *= bf2f(pc[PC_ZR + hj]);
    A2[(size_t)(MP + bs) * 2048 + 1024 + hj] = f2bf(on);
    LDS_WAIT();
}

constexpr int S5_ELD = 132, S5_XLD = 136;
constexpr int S5_E_OFF = 0, S5_X_OFF = 128 * S5_ELD * 4;
__device__ __forceinline__ bf16x8 ldfrag(const unsigned char* base, int block, int lane) { return *(const bf16x8*)(base + (size_t)block * 1024 + lane * 16); }
__device__ __forceinline__ void p3_s5_prompt(const Args& a, LAS unsigned char* lds, int unit, int tid, int wave, int lane) {
    const int b = unit >> 6, g = unit & 63;
    const unsigned char* tab = (const unsigned char*)a.out + DO_S5TAB + (size_t)g * S5T_BYTES;
    const bf16_t* P = (const bf16_t*)(a.ws + WS_P);
    bf16_t* Yg = (bf16_t*)(a.ws + WS_YG);
    LAS float* EL = (LAS float*)(lds + S5_E_OFF); LAS bf16_t* XL = (LAS bf16_t*)(lds + S5_X_OFF);
    const int nt = wave & 3, hm = wave >> 2, r31 = lane & 31, hh = lane >> 5;
    const int n = 32 * nt + r31;
    { u32x4 tv[10];
#pragma unroll
      for (int i = 0; i < 10; ++i) tv[i] = *(const u32x4*)(tab + S5T_ME + (size_t)(tid + 512 * i) * 16);
#pragma unroll
      for (int i = 0; i < 10; ++i) *(LAS u32x4*)(lds + (tid + 512 * i) * 16) = tv[i]; }
    const bf16_t* ubase = (const bf16_t*)(a.ws + WS_U2) + (((size_t)b * 64 + g) * SEQ + 16 * n) * 16 + 8 * hh;
    bf16x8 bu[16];
#pragma unroll
    for (int s2 = 0; s2 < 16; ++s2) bu[s2] = *(const bf16x8*)(ubase + (size_t)s2 * 16);
    f32x16 accY[4], accE[2];
#pragma unroll
    for (int q = 0; q < 4; ++q)
#pragma unroll
        for (int r = 0; r < 16; ++r) accY[q][r] = 0.f;
#pragma unroll
    for (int q = 0; q < 2; ++q)
#pragma unroll
        for (int r = 0; r < 16; ++r) accE[q][r] = 0.f;
    const int mts[4] = {hm ? 1 : 0, hm ? 2 : 3, hm ? 5 : 4, hm ? 6 : 7};
    __syncthreads();
#pragma unroll
    for (int s2 = 0; s2 < 16; ++s2) {
#pragma unroll
        for (int e = 0; e < 2; ++e) accE[e] = __builtin_amdgcn_mfma_f32_32x32x16_bf16(*(const LAS bf16x8*)(lds + S5T_ME + (((2 * hm + e) * 16 + s2) * 64 + lane) * 16), bu[s2], accE[e], 0, 0, 0);
#pragma unroll
        for (int q = 0; q < 4; ++q) { const int mt = mts[q]; if (s2 <= 2 * mt + 1) accY[q] = __builtin_amdgcn_mfma_f32_32x32x16_bf16(*(const LAS bf16x8*)(lds + S5T_KT + ((2 * mt - s2 + 1) * 64 + lane) * 16), bu[s2], accY[q], 0, 0, 0); }
    }
    __syncthreads();
#pragma unroll
    for (int e = 0; e < 2; ++e)
#pragma unroll
        for (int q4 = 0; q4 < 4; ++q4) { f32x4 v; v[0] = accE[e][4 * q4]; v[1] = accE[e][4 * q4 + 1]; v[2] = accE[e][4 * q4 + 2]; v[3] = accE[e][4 * q4 + 3];
            *(LAS f32x4*)(EL + n * S5_ELD + 32 * (2 * hm + e) + 8 * q4 + 4 * hh) = v; }
    __syncthreads();
    if (wave == 0) { const float* hdr = (const float*)(tab + S5T_HDR); const float ar = hdr[lane], ai = hdr[64 + lane]; float xr = 0.f, xi = 0.f;
#pragma unroll 1
        for (int c0 = 0; c0 < 128; c0 += 16) { float er[16], ei[16];
#pragma unroll
            for (int j = 0; j < 16; ++j) { er[j] = EL[(c0 + j) * S5_ELD + lane]; ei[j] = EL[(c0 + j) * S5_ELD + 64 + lane]; }
#pragma unroll
            for (int j = 0; j < 16; ++j) { XL[(c0 + j) * S5_XLD + lane] = f2bf(xr); XL[(c0 + j) * S5_XLD + 64 + lane] = f2bf(xi);
                const float nr = ar * xr - ai * xi + er[j], ni = ar * xi + ai * xr + ei[j]; xr = nr; xi = ni; } }
        a.out[OUT_S5RE_P + (size_t)(b * 64 + g) * 64 + lane] = xr; a.out[OUT_S5IM_P + (size_t)(b * 64 + g) * 64 + lane] = xi; }
    __syncthreads();
#pragma unroll
    for (int ks = 0; ks < 8; ++ks) { const bf16x8 bx = *(const LAS bf16x8*)(XL + n * S5_XLD + 16 * ks + 8 * hh);
#pragma unroll
        for (int q = 0; q < 4; ++q) accY[q] = __builtin_amdgcn_mfma_f32_32x32x16_bf16(ldfrag(tab + S5T_CA, mts[q] * 8 + ks, lane), bx, accY[q], 0, 0, 0); }
#pragma unroll
    for (int q = 0; q < 4; ++q) { const int mt = mts[q];
#pragma unroll
        for (int q4 = 0; q4 < 4; ++q4) { const int dt = q4 >> 1, c0 = 8 * (q4 & 1) + 4 * hh; const size_t row = (size_t)b * SEQ + 16 * n + 2 * mt + dt;
            u32x2 w; w.x = cvt_pk_bf16(geluf_(accY[q][4 * q4]), geluf_(accY[q][4 * q4 + 1])); w.y = cvt_pk_bf16(geluf_(accY[q][4 * q4 + 2]), geluf_(accY[q][4 * q4 + 3]));
            *(u32x2*)(Yg + row * 1024 + g * 16 + c0) = w; } }
    __syncthreads();
}
__device__ __forceinline__ void p3_s5_sample(const Args& a, int g, int wave, int lane) {
    if (wave >= 4) return;
    const unsigned char* tab = (const unsigned char*)a.out + DO_S5TAB + (size_t)g * S5T_BYTES;
    const float* hdr = (const float*)(tab + S5T_HDR);
    const bf16_t* P = (const bf16_t*)(a.ws + WS_P);
    bf16_t* Yg = (bf16_t*)(a.ws + WS_YG);
    const int r31 = lane & 31, hh = lane >> 5, bs = 32 * wave + r31;
    const bf16x8 bu = *(const bf16x8*)((const bf16_t*)(a.ws + WS_U2S) + ((size_t)g * NSMP + bs) * 16 + 8 * hh);
    f32x16 z;
#pragma unroll
    for (int r = 0; r < 16; ++r) z[r] = 0.f;
    f32x16 x[4];
#pragma unroll
    for (int mtile = 0; mtile < 4; ++mtile) x[mtile] = __builtin_amdgcn_mfma_f32_32x32x16_bf16(ldfrag(tab + S5T_ME, mtile * 16 + 15, lane), bu, z, 0, 0, 0);
    const size_t sb = (size_t)(bs * 64 + g) * 64;
#pragma unroll
    for (int pt = 0; pt < 2; ++pt)
#pragma unroll
        for (int q4 = 0; q4 < 4; ++q4) { const int p0 = 32 * pt + 8 * q4 + 4 * hh;
            const f32x4 x0r = *(const f32x4*)(a.in[I_S5RE] + sb + p0), x0i = *(const f32x4*)(a.in[I_S5IM] + sb + p0);
            const f32x4 ar = *(const f32x4*)(hdr + 128 + p0), ai = *(const f32x4*)(hdr + 192 + p0);
            f32x4 nr, ni;
#pragma unroll
            for (int j = 0; j < 4; ++j) { nr[j] = ar[j] * x0r[j] - ai[j] * x0i[j] + x[pt][4 * q4 + j]; ni[j] = ar[j] * x0i[j] + ai[j] * x0r[j] + x[2 + pt][4 * q4 + j]; x[pt][4 * q4 + j] = nr[j]; x[2 + pt][4 * q4 + j] = ni[j]; }
            *(f32x4*)(a.out + OUT_S5RE_S + sb + p0) = nr; *(f32x4*)(a.out + OUT_S5IM_S + sb + p0) = ni; }
    f32x16 y = __builtin_amdgcn_mfma_f32_32x32x16_bf16(ldfrag(tab + S5T_DF, 0, lane), bu, z, 0, 0, 0);
#pragma unroll
    for (int mtile = 0; mtile < 4; ++mtile)
#pragma unroll
        for (int sp = 0; sp < 2; ++sp) { u32x4 t; t.x = cvt_pk_bf16(x[mtile][8 * sp], x[mtile][8 * sp + 1]); t.y = cvt_pk_bf16(x[mtile][8 * sp + 2], x[mtile][8 * sp + 3]);
            t.z = cvt_pk_bf16(x[mtile][8 * sp + 4], x[mtile][8 * sp + 5]); t.w = cvt_pk_bf16(x[mtile][8 * sp + 6], x[mtile][8 * sp + 7]);
            y = __builtin_amdgcn_mfma_f32_32x32x16_bf16(ldfrag(tab + S5T_C0, mtile * 2 + sp, lane), __builtin_bit_cast(bf16x8, t), y, 0, 0, 0); }
#pragma unroll
    for (int q4 = 0; q4 < 2; ++q4) { const int c0 = 8 * q4 + 4 * hh;
        u32x2 w; w.x = cvt_pk_bf16(geluf_(y[4 * q4]), geluf_(y[4 * q4 + 1])); w.y = cvt_pk_bf16(geluf_(y[4 * q4 + 2]), geluf_(y[4 * q4 + 3]));
        *(u32x2*)(Yg + (size_t)(MP + bs) * 1024 + g * 16 + c0) = w; }
}

__device__ __forceinline__ void p4_rwkv_post8(const Args& a, int item0, int lane) {
    const int item = item0 + (lane >> 3), cg = lane & 7, row = item >> 4, h = item & 15, ch = h * 64 + 8 * cg;
    const bf16_t* ORAW = (const bf16_t*)((const unsigned char*)a.out + DO_ORAW); const bf16_t* BV = (const bf16_t*)((const unsigned char*)a.out + DO_BV);
    const bf16_t* P = (const bf16_t*)(a.ws + WS_P); bf16_t* A2 = (bf16_t*)(a.ws + WS_XN);
    const u32x4 ow = *(const u32x4*)(ORAW + (size_t)row * 1024 + ch), bw = *(const u32x4*)(BV + (size_t)row * 1024 + ch), zw = *(const u32x4*)(P + (size_t)row * LDP + PC_ZR + ch);
    const f32x4 w0 = *(const f32x4*)(a.in[I_GNW] + ch), w1 = *(const f32x4*)(a.in[I_GNW] + ch + 4), b0 = *(const f32x4*)(a.in[I_GNB] + ch), b1 = *(const f32x4*)(a.in[I_GNB] + ch + 4);
    const float o[8] = {bf_lo(ow.x), bf_hi(ow.x), bf_lo(ow.y), bf_hi(ow.y), bf_lo(ow.z), bf_hi(ow.z), bf_lo(ow.w), bf_hi(ow.w)};
    const float bv[8] = {bf_lo(bw.x), bf_hi(bw.x), bf_lo(bw.y), bf_hi(bw.y), bf_lo(bw.z), bf_hi(bw.z), bf_lo(bw.w), bf_hi(bw.w)};
    const float z[8] = {bf_lo(zw.x), bf_hi(zw.x), bf_lo(zw.y), bf_hi(zw.y), bf_lo(zw.z), bf_hi(zw.z), bf_lo(zw.w), bf_hi(zw.w)};
    const float gw[8] = {w0[0], w0[1], w0[2], w0[3], w1[0], w1[1], w1[2], w1[3]}, gb[8] = {b0[0], b0[1], b0[2], b0[3], b1[0], b1[1], b1[2], b1[3]};
    float sm = ((o[0] + o[1]) + (o[2] + o[3])) + ((o[4] + o[5]) + (o[6] + o[7]));
    sm += dpp_f<0xB1>(sm); sm += dpp_f<0x4E>(sm); sm += dpp_f<0x141>(sm);
    const float mean = sm * (1.0f / 64.0f); float d[8], sq = 0.f;
#pragma unroll
    for (int j = 0; j < 8; ++j) { d[j] = o[j] - mean; sq += d[j] * d[j]; }
    sq += dpp_f<0xB1>(sq); sq += dpp_f<0x4E>(sq); sq += dpp_f<0x141>(sq);
    const float rstd = rsqrtf(sq * (1.0f / 64.0f) + GN_EPS); float r[8];
#pragma unroll
    for (int j = 0; j < 8; ++j) r[j] = (d[j] * rstd * gw[j] + gb[j] + bv[j]) * z[j];
    u32x4 w; w.x = cvt_pk_bf16(r[0], r[1]); w.y = cvt_pk_bf16(r[2], r[3]); w.z = cvt_pk_bf16(r[4], r[5]); w.w = cvt_pk_bf16(r[6], r[7]);
    *(u32x4*)(A2 + (size_t)row * 2048 + 1024 + ch) = w;
}

__device__ __forceinline__ void p6_row(const Args& a, int m, int lane) {
    float* y = a.out + (size_t)m * DM; const float* fg = a.in[I_FINALG];
    if (m < MP) {
        const float* rs = (const float*)(a.ws + WS_ROWSS) + (size_t)m * 32;
        const float ss = wave_sum(rs[lane & 31]) * 0.5f;
        const float rstd = rsqrtf(ss * (1.0f / DM) + RMS_EPS);
#pragma unroll
        for (int j = 0; j < 8; ++j) { const int k = 4 * lane + 256 * j; f32x4 v = *(const f32x4*)(y + k); const f32x4 gv = *(const f32x4*)(fg + k);
#pragma unroll
            for (int q = 0; q < 4; ++q) v[q] = v[q] * rstd * gv[q];
            *(f32x4*)(y + k) = v; }
    } else {
        const int r = m - MP; const float* slab = (const float*)(a.ws + WS_SLAB) + (size_t)r * DM; const float* x = a.in[I_XS] + (size_t)r * DM;
        const float* gtrow = (const float*)(a.ws + WS_MOD) + (size_t)(NB + r) * NMOD + 2 * DM;
        f32x4 v[8]; float ss = 0.f;
#pragma unroll
        for (int j = 0; j < 8; ++j) { const int k = 4 * lane + 256 * j; f32x4 mix = *(const f32x4*)(slab + k);
#pragma unroll
            for (int s2 = 1; s2 < 8; ++s2) mix += *(const f32x4*)(slab + (size_t)s2 * NSMP * DM + k);
            const f32x4 xv = *(const f32x4*)(x + k), gt = *(const f32x4*)(gtrow + k);
#pragma unroll
            for (int q = 0; q < 4; ++q) { v[j][q] = xv[q] + gt[q] * mix[q]; ss += v[j][q] * v[j][q]; } }
        const float rstd = rsqrtf(wave_sum(ss) * (1.0f / DM) + RMS_EPS);
#pragma unroll
        for (int j = 0; j < 8; ++j) { const int k = 4 * lane + 256 * j; const f32x4 gv = *(const f32x4*)(fg + k); f32x4 o;
#pragma unroll
            for (int q = 0; q < 4; ++q) o[q] = v[j][q] * rstd * gv[q];
            *(f32x4*)(y + k) = o; }
    }
}

__global__ void __launch_bounds__(512, 2) fwd_kernel(Args args) {
    extern __shared__ __attribute__((aligned(16))) unsigned char lds_raw[];
    LAS unsigned char* lds = (LAS unsigned char*)lds_raw;
    const int tid = threadIdx.x, lane = tid & 63, wave = __builtin_amdgcn_readfirstlane(tid >> 6);
    const int G = gridDim.x, bx = blockIdx.x;
    const int vcu = (G % 8 == 0) ? (bx % 8) * (G / 8) + bx / 8 : bx;
    volatile LAS unsigned* MISC = (volatile LAS unsigned*)(lds + MISC_OFF);
    for (int u = tid; u < (LDS_BYTES - LDSCTL_OFF) / 4; u += 512) ((LAS unsigned*)(lds + LDSCTL_OFF))[u] = 0u;
    __syncthreads();
    unsigned* ctl = (unsigned*)(args.ws + WS_CTL);
    XcdBarrier bar; bar.bar = ctl + CW_BAR + args.li * XCD_BAR_WORDS; bar.x = 0; bar.st = nullptr;
    const bool multi = (args.ph_hi - args.ph_lo) > 1;
    if (multi) bar = xcd_barrier_post(ctl + CW_BAR + args.li * XCD_BAR_WORDS, MISC + 8);
    const int lo = args.ph_lo, hi = args.ph_hi;
#define IN(k) (lo <= (k) && (k) < hi)
#define SEAM(k) do { if (IN(k) && IN((k) + 1)) xcd_barrier(bar); } while (0)
    const int gw = vcu * 8 + wave, NGW = G * 8;

    if (IN(0)) {
        if (vcu < 192) { p0_mod(args, lds, vcu, wave, lane, ctl + CW_AREADY);
            LAS float* scr = (LAS float*)(lds + wave * 16384);
            p0_wconv_item(args, vcu * 8 + wave, scr, lane); }
        else if (vcu - 192 < 64) { p0_silu_prep(args, vcu - 192, tid, ctl + CW_AREADY); p0_s5_tables(args, lds, vcu - 192, tid);
            LAS float* scr = (LAS float*)(lds + wave * 16384);
            p0_wconv_item(args, 1536 + (vcu - 192) * 8 + wave, scr, lane); p0_wconv_item(args, 2048 + (vcu - 192) * 8 + wave, scr, lane); }
    }
    if (IN(1)) {
        { LAS float* scr = (LAS float*)(lds + wave * 16384);
          bf16_t* WT = (bf16_t*)(args.ws + WS_WT);
          for (int it = gw; it < 328 * 32; it += NGW) { const int nb = it >> 5, kb = it & 31; const int p0 = 32 * nb;
              const int src = (p0 < 5120) ? p0 : ((p0 < 10240) ? p0 + 128 : p0 - 5120);
              transpose_item(args.in[I_WIN], NIN, 2048, src, WT, p0, 64 * kb, scr, lane, p0 >= NIN); } }
        wait_count(ctl + CW_MODDONE, 192u, wave);
        for (int m = gw; m < MT; m += NGW) p1_row(args, m, lane);
    }
    SEAM(1);
    const bool tail_mode = (G == 256);
    if (IN(2)) {
        pg8::Gemm g{(const bf16_t*)(args.ws + WS_XN), (const bf16_t*)(args.ws + WS_WT), 2048, 2048};
        EpiP E{(bf16_t*)(args.ws + WS_P), tail_mode, (bf16_t*)(args.ws + WS_U2)};
        if (tail_mode) {
            pg8::TailOrder S; S.init2(G, bx, ctl + CW_TILE);
            pg8::gemm_phase<EpiP, pg8::TailOrder, GEMM_ALIGN, GEMM_SP2>(lds, g, S, E);
            if (bx >= 73) {
                const int t = bx - 73;
                for (int u = t; u < 256; u += 183) { wait_count(ctl + CW_TILE + 64 * ((u >> 6) * 4 + ((u & 63) >> 4)), 64u, wave); p3_s5_prompt(args, lds, u, tid, wave, lane); }
                if (t >= 146 && t < 178) { const int pm2 = t - 146;
                    wait_count(ctl + CW_TILE + 64 * (57 + pm2), 8u, wave); if (pm2 & 7) wait_count(ctl + CW_TILE + 64 * (57 + pm2 - 1), 8u, wave);
                    p2_xw_panel(args, pm2, tid); }
                if (t >= 73 && t < 137) { const int g2 = t - 73; wait_count(ctl + CW_TILE + 64 * (16 + (g2 >> 4)), 8u, wave); p3_s5_sample(args, g2, wave, lane); }
            }
        } else {
            pg8::StaticOrder S; S.init(MT, LDP, 2048, G, bx);
            pg8::gemm_phase<EpiP, pg8::StaticOrder, GEMM_ALIGN, GEMM_SP2>(lds, g, S, E);
        }
    }
    SEAM(2);
    if (IN(3)) {
        const bool smp_first = tail_mode && bx >= 132;
        if (smp_first) { for (int it = vcu; it < 256; it += G) p3_rwkv_sample(args, lds, it >> 1, (it & 1) * 8 + wave, wave, lane); __syncthreads(); }
        p3_rwkv_chunks(args, lds, vcu >> 2, vcu & 3, tid, wave, lane);
        if (!tail_mode) {
            if (false) { LAS float* scr = (LAS float*)(lds + wave * 16384);
              for (int it = gw; it < 2048 + 512; it += NGW) {
                  if (it < 2048) { const int nb = it >> 5, kb = it & 31; transpose_item(args.in[I_WOUT], 2048, 2048, 32 * nb, (bf16_t*)(args.ws + WS_WOUT_T), 32 * nb, 64 * kb, scr, lane, false); }
                  else { const int i2 = it - 2048, nb = i2 >> 4, kb = i2 & 15; transpose_item(args.in[I_WGLU], 1024, 1024, 32 * nb, (bf16_t*)(args.ws + WS_WGLU_T), 32 * nb, 64 * kb, scr, lane, false); } } }
            __syncthreads();
            for (int u = vcu; u < 256; u += G) p3_s5_prompt(args, lds, u, tid, wave, lane);
            for (int g2 = vcu; g2 < 64; g2 += G) p3_s5_sample(args, g2, wave, lane);
            __syncthreads();
        }
        if (!smp_first) for (int it = vcu; it < 256; it += G) p3_rwkv_sample(args, lds, it >> 1, (it & 1) * 8 + wave, wave, lane);
    }
    const bool glu_early = tail_mode && bx < 132 && IN(3) && IN(4);
    if (glu_early) xcd_barrier_arrive(bar); else SEAM(3);
    if (IN(4)) {
        pg8::StaticOrder S; S.init(MT, 1024, 1024, G, bx);
        pg8::Unit u0;
        if (S.next(0, u0)) {
            pg8::Gemm g{(const bf16_t*)(args.ws + WS_YG), (const bf16_t*)(args.ws + WS_WGLU_T), 1024, 1024};
            EpiGlu E{(const bf16_t*)(args.ws + WS_YG), (const bf16_t*)(args.ws + WS_P), args.in[I_BGLU], (bf16_t*)(args.ws + WS_XN)};
            pg8::gemm_phase<EpiGlu, pg8::StaticOrder, GEMM_ALIGN, GEMM_SP2>(lds, g, S, E);
            if (glu_early) xcd_barrier_finish(bar);
        } else {
            const int nfree = G - 132, j = bx - 132, unit = wave * nfree + j;
            if (unit < 256) p3_rwkv_seq(args, unit, lane);
        }
    }
    SEAM(4);
    const bool stag = tail_mode && IN(5) && IN(6);
    pg8::OutOrder S6; S6.init(MP, DM, 1024, G, bx);
    pg8::Unit u6; S6.tile(bx < 256 ? bx : 0, u6);
    if (IN(5)) {
        if (stag) { const int jc = (u6.pm >> 1) * 8 + u6.pn;
            if (u6.pm & 1) { if (wave < 2) { p5_rwkv_out(args, jc * 10 + 2 * wave, lane); p5_rwkv_out(args, jc * 10 + 2 * wave + 1, lane); } else p5_rwkv_out(args, jc * 10 + 2 + wave, lane); }
            else if (wave < 6) p5_rwkv_out(args, 1280 + jc * 6 + wave, lane); }
        else { for (int it = gw; it < 2048; it += NGW) p5_rwkv_out(args, it, lane); }
    }
    if (stag) xcd_barrier_arrive(bar); else SEAM(5);
    if (IN(6)) {
        pg8::Gemm g{(const bf16_t*)(args.ws + WS_XN), (const bf16_t*)(args.ws + WS_WOUT_T), 2048, 1024};
        pg8::OutOrder& S = S6; S.cnt = ctl + CW_SAMPLE; S.xgen = bar.bar + XB_XGEN(bar.x); S.want = stag ? (unsigned)__builtin_amdgcn_readfirstlane(MISC[11]) : 0u;
        S.slice = stag ? (((u6.pm & 3) == 0) ? (u6.pm >> 2) * 8 + u6.pn : -1) : ((bx < 64) ? bx : -1);
        const int frow = stag ? (((u6.pm & 3) == 2 && wave < 2) ? ((u6.pm >> 2) * 8 + u6.pn) * 2 + wave : -1) : ((tail_mode && bx >= 64 && bx < 64 + NSMP && wave == 0) ? bx - 64 : -1);
        EpiOut E{(const bf16_t*)(args.ws + WS_P), args.in[I_XP], (const float*)(args.ws + WS_MOD), args.out, (float*)(args.ws + WS_ROWSS), (bf16_t*)(args.ws + WS_TMP), (float*)(args.ws + WS_SLAB), ctl + CW_PANEL, args.in[I_FINALG]};
        pg8::gemm_phase<EpiOut, pg8::OutOrder, false, GEMM_SP2>(lds, g, S, E);
        if (tail_mode && frow >= 0) {
            unsigned sp = 0;
            while ((unsigned)__builtin_amdgcn_readfirstlane(__hip_atomic_load(ctl + CW_SAMPLE, __ATOMIC_RELAXED, __HIP_MEMORY_SCOPE_AGENT)) < 512u) { __builtin_amdgcn_s_sleep(4); if (++sp > (1u << 22)) break; }
            __builtin_amdgcn_fence(__ATOMIC_ACQUIRE, "agent");
            p6_row(args, MP + frow, lane);
        }
    }
    if (!tail_mode) SEAM(6);
    if (IN(7) && !tail_mode) { for (int m = MP + gw; m < MV; m += NGW) p6_row(args, m, lane); }
#undef IN
#undef SEAM
}

extern "C" void kernel_launch(void* const* d_in, const int* in_sizes, int n_in, void* d_out, int out_size, void* d_ws, size_t ws_size, hipStream_t stream) {
    static int grid = 0;
    if (grid == 0) {
        if (n_in != 34 || ws_size < WS_END) { fprintf(stderr, "kernel_launch: unexpected n_in %d / ws %zu\n", n_in, ws_size); grid = -1; return; }
        int dev = 0, cus = 0;
        if (hipGetDevice(&dev) != hipSuccess || hipDeviceGetAttribute(&cus, hipDeviceAttributeMultiprocessorCount, dev) != hipSuccess) { grid = -1; return; }
        if (hipFuncSetAttribute((const void*)fwd_kernel, hipFuncAttributeMaxDynamicSharedMemorySize, LDS_BYTES) != hipSuccess) { fprintf(stderr, "kernel_launch: hipFuncSetAttribute failed\n"); grid = -1; return; }
        int per_cu = 0;
        if (hipOccupancyMaxActiveBlocksPerMultiprocessor(&per_cu, (const void*)fwd_kernel, 512, LDS_BYTES) != hipSuccess || per_cu < 1) fprintf(stderr, "kernel_launch: occupancy query says %d\n", per_cu);
        (void)hipGetLastError();
        grid = cus;
        if (grid != 256) fprintf(stderr, "kernel_launch: note: %d CUs\n", grid);
    }
    if (grid < 0) return;
    (void)hipMemsetAsync((char*)d_ws + WS_CTL, 0, CTL_BYTES, stream);
    Args a{};
    for (int i = 0; i < 34; ++i) a.in[i] = (const float*)d_in[i];
    a.out = (float*)d_out; a.ws = (unsigned char*)d_ws;
    if (PROBE_PHASE >= 0) {
        a.ph_lo = 0; a.ph_hi = PROBE_PHASE + 1; a.li = 0; hipLaunchKernelGGL(fwd_kernel, dim3(grid), dim3(512), LDS_BYTES, stream, a);
        a.ph_lo = PROBE_PHASE; a.ph_hi = PROBE_PHASE + 1; a.li = 1; hipLaunchKernelGGL(fwd_kernel, dim3(grid), dim3(512), LDS_BYTES, stream, a);
        if (PROBE_PHASE + 1 < N_PHASES) { a.ph_lo = PROBE_PHASE + 1; a.ph_hi = N_PHASES; a.li = 2; hipLaunchKernelGGL(fwd_kernel, dim3(grid), dim3(512), LDS_BYTES, stream, a); }
    } else if (MK_N_LAUNCHES == 1) { a.ph_lo = 0; a.ph_hi = N_PHASES; a.li = 0; hipLaunchKernelGGL(fwd_kernel, dim3(grid), dim3(512), LDS_BYTES, stream, a); }
    else { for (int p = 0; p < N_PHASES; ++p) { a.ph_lo = p; a.ph_hi = p + 1; a.li = 0; hipLaunchKernelGGL(fwd_kernel, dim3(grid), dim3(512), LDS_BYTES, stream, a); } }
}
```
